# Optimizing an MI355X kernel written in HIP

```python
import math
import jax, jax.numpy as jnp
from jax import lax
import numpy as np

D_MODEL = 1024
BATCH = 2
SEQ = 16384
DEPTH = 2

D_MIX = D_MODEL
D_SGU = D_MIX // 2
D_ATT = D_MIX - D_SGU
SGU_GROUPS = 8
SGU_GROUP_DIM = D_SGU // SGU_GROUPS
SGU_CHUNK = 128
ATT_HEADS = 8
HEAD_DIM = D_ATT // ATT_HEADS
MOBA_BLOCK = 256
MOBA_TOPK = 3
Q_CHUNK = 128
REL_BUCKETS = 32
REL_MAX_DIST = 128
NORM_EPS = 1e-6
LN_EPS = 1e-5
NEG = -1e30
D_IN = 3 * D_SGU + 4 * D_ATT
SPLITS = [D_SGU, 2 * D_SGU, 3 * D_SGU, 3 * D_SGU + D_ATT, 3 * D_SGU + 2 * D_ATT, 3 * D_SGU + 3 * D_ATT]

kernel_name = "hymba_sgu_moba_hybrid"


def rms_norm(x, g):
    xf = x.astype(jnp.float32)
    y = xf * lax.rsqrt(jnp.mean(xf * xf, axis=-1, keepdims=True) + NORM_EPS)
    return (y * g.astype(jnp.float32)).astype(x.dtype)


def layer_norm(x, g, b):
    xf = x.astype(jnp.float32)
    mu = jnp.mean(xf, axis=-1, keepdims=True)
    var = jnp.mean(jnp.square(xf - mu), axis=-1, keepdims=True)
    y = (xf - mu) * lax.rsqrt(var + LN_EPS)
    return (y * g.astype(jnp.float32) + b.astype(jnp.float32)).astype(x.dtype)


def rel_bucket(dist):
    n = jnp.maximum(dist, 0)
    max_exact = REL_BUCKETS // 2
    nf = jnp.maximum(n, 1).astype(jnp.float32)
    large = max_exact + (jnp.log(nf / max_exact) / math.log(REL_MAX_DIST / max_exact)
                         * (REL_BUCKETS - max_exact)).astype(jnp.int32)
    large = jnp.minimum(large, REL_BUCKETS - 1)
    return jnp.where(n < max_exact, n, large)


def sgu_mixer(ua, va, za, ln_g, ln_b, w_s, b_s):
    B, S, _ = ua.shape
    nc = S // SGU_CHUNK
    u = jax.nn.gelu(ua)
    v = layer_norm(jax.nn.gelu(va), ln_g, ln_b)
    v = v.reshape(B, nc, SGU_CHUNK, SGU_GROUPS, SGU_GROUP_DIM)
    causal = jnp.tril(jnp.ones((SGU_CHUNK, SGU_CHUNK), dtype=bool))
    w = jnp.where(causal[None], w_s, jnp.zeros((), w_s.dtype)).astype(v.dtype)
    mixed = jnp.einsum('gts,bcsgd->bctgd', w, v) + b_s.T.astype(v.dtype)[None, None, :, :, None]
    return u * mixed.reshape(B, S, D_SGU) * jax.nn.silu(za)


def moba_mixer(q, k, v, zb, rel_bias):
    B, S, _ = q.shape
    H, dh = ATT_HEADS, HEAD_DIM

    def heads(t):
        return t.reshape(B, S, H, dh).transpose(0, 2, 1, 3)

    q, k, v = heads(q), heads(k), heads(v)
    nb = -(-S // MOBA_BLOCK)
    pad = nb * MOBA_BLOCK - S
    kp = jnp.pad(k, ((0, 0), (0, 0), (0, pad), (0, 0)))
    vp = jnp.pad(v, ((0, 0), (0, 0), (0, pad), (0, 0)))
    k_blocks = kp.reshape(B, H, nb, MOBA_BLOCK, dh)
    v_blocks = vp.reshape(B, H, nb, MOBA_BLOCK, dh)
    k_mean = jnp.mean(k_blocks.astype(jnp.float32), axis=3)

    pos = jnp.arange(S, dtype=jnp.int32)
    own = pos // MOBA_BLOCK
    gate = jnp.einsum('bhsd,bhnd->bhsn', q.astype(jnp.float32), k_mean)
    past = jnp.arange(nb, dtype=jnp.int32)[None, :] < own[:, None]
    gate = jnp.where(past[None, None], gate, NEG)
    ksel = min(MOBA_TOPK, nb)
    _, idx = lax.top_k(gate, ksel)
    valid = jnp.arange(ksel, dtype=jnp.int32)[None, :] < own[:, None]

    nqc = S // Q_CHUNK
    q_ch = q.reshape(B, H, nqc, Q_CHUNK, dh).transpose(2, 0, 1, 3, 4)
    idx_ch = idx.reshape(B, H, nqc, Q_CHUNK, ksel).transpose(2, 0, 1, 3, 4)
    valid_ch = valid.reshape(nqc, Q_CHUNK, ksel)
    scale = HEAD_DIM ** -0.5
    table = rel_bias.T
    b_ix = jnp.arange(B)[:, None, None, None]
    h_ix = jnp.arange(H)[None, :, None, None]
    blk_ar = jnp.arange(MOBA_BLOCK, dtype=jnp.int32)

    def chunk(args):
        c, q_c, idx_c, valid_c = args
        q_pos = c * Q_CHUNK + jnp.arange(Q_CHUNK, dtype=jnp.int32)
        kb = (c * Q_CHUNK) // MOBA_BLOCK
        k_own = lax.dynamic_slice_in_dim(kp, kb * MOBA_BLOCK, MOBA_BLOCK, axis=2)
        v_own = lax.dynamic_slice_in_dim(vp, kb * MOBA_BLOCK, MOBA_BLOCK, axis=2)
        d_own = q_pos[:, None] - (kb * MOBA_BLOCK + blk_ar)[None, :]
        s_own = (jnp.einsum('bhqd,bhkd->bhqk', q_c, k_own).astype(jnp.float32) * scale
                 + table[:, rel_bucket(d_own)][None].astype(jnp.float32))
        s_own = jnp.where((d_own >= 0)[None, None], s_own, NEG)
        k_sel = k_blocks[b_ix, h_ix, idx_c]
        v_sel = v_blocks[b_ix, h_ix, idx_c]
        k_pos_sel = idx_c[..., None] * MOBA_BLOCK + blk_ar
        d_sel = q_pos[None, None, :, None, None] - k_pos_sel
        bias_sel = table[h_ix[..., None], rel_bucket(d_sel)].astype(jnp.float32)
        s_sel = jnp.einsum('bhqd,bhqjkd->bhqjk', q_c, k_sel).astype(jnp.float32) * scale + bias_sel
        s_sel = jnp.where(valid_c[None, None, :, :, None], s_sel, NEG)
        logits = jnp.concatenate([s_own, s_sel.reshape(B, H, Q_CHUNK, ksel * MOBA_BLOCK)], axis=-1)
        p = jax.nn.softmax(logits, axis=-1).astype(v_own.dtype)
        p_own = p[..., :MOBA_BLOCK]
        p_sel = p[..., MOBA_BLOCK:].reshape(B, H, Q_CHUNK, ksel, MOBA_BLOCK)
        return (jnp.einsum('bhqk,bhkd->bhqd', p_own, v_own)
                + jnp.einsum('bhqjk,bhqjkd->bhqd', p_sel, v_sel))

    out = lax.map(chunk, (jnp.arange(nqc, dtype=jnp.int32), q_ch, idx_ch, valid_ch))
    out = out.transpose(1, 2, 0, 3, 4).reshape(B, H, S, dh).transpose(0, 2, 1, 3).reshape(B, S, D_ATT)
    return out * jax.nn.silu(zb)


def hybrid_layer(x, norm_g, w_in, ln_g, ln_b, w_s, b_s, w_out, rel_bias):
    h = rms_norm(x, norm_g)
    proj = h @ w_in
    ua, va, za, q, k, v, zb = jnp.split(proj, SPLITS, axis=-1)
    y_a = sgu_mixer(ua, va, za, ln_g, ln_b, w_s, b_s)
    y_b = moba_mixer(q, k, v, zb, rel_bias)
    y = jnp.concatenate([y_a, y_b], axis=-1) @ w_out
    return x + y


def setup_inputs(seed: int = 0) -> dict:
    key = jax.random.key(seed)
    ks = jax.random.split(key, 10)
    f32 = jnp.float32
    x = jax.random.normal(ks[0], (BATCH, SEQ, D_MODEL), f32)
    norm_g = 1.0 + 0.02 * jax.random.normal(ks[1], (DEPTH, D_MODEL), f32)
    w_in = jax.random.normal(ks[2], (DEPTH, D_MODEL, D_IN), f32) * D_MODEL ** -0.5
    sgu_ln_g = 1.0 + 0.02 * jax.random.normal(ks[3], (DEPTH, D_SGU), f32)
    sgu_ln_b = 0.02 * jax.random.normal(ks[4], (DEPTH, D_SGU), f32)
    sgu_w = jax.random.normal(ks[5], (DEPTH, SGU_GROUPS, SGU_CHUNK, SGU_CHUNK), f32) * SGU_CHUNK ** -0.5
    sgu_b = 1.0 + 0.02 * jax.random.normal(ks[6], (DEPTH, SGU_GROUPS, SGU_CHUNK), f32)
    w_out = jax.random.normal(ks[7], (DEPTH, D_MIX, D_MODEL), f32) * D_MIX ** -0.5
    rel_bias = 0.1 * jax.random.normal(ks[8], (REL_BUCKETS, ATT_HEADS), f32)
    final_g = 1.0 + 0.02 * jax.random.normal(ks[9], (D_MODEL,), f32)
    return {"x": x, "norm_g": norm_g, "w_in": w_in, "sgu_ln_g": sgu_ln_g, "sgu_ln_b": sgu_ln_b,
            "sgu_w": sgu_w, "sgu_b": sgu_b, "w_out": w_out, "rel_bias": rel_bias, "final_g": final_g}


def reference(x, norm_g, w_in, sgu_ln_g, sgu_ln_b, sgu_w, sgu_b, w_out, rel_bias, final_g):
    for l in range(DEPTH):
        x = hybrid_layer(x, norm_g[l], w_in[l], sgu_ln_g[l], sgu_ln_b[l], sgu_w[l], sgu_b[l],
                         w_out[l], rel_bias)
    return rms_norm(x, final_g)
```

```cpp
#include <hip/hip_runtime.h>
#include <hip/hip_cooperative_groups.h>
#include <cstdio>
#include <cstdint>
namespace cg = cooperative_groups;

constexpr int BATCH = 2, SEQ = 16384, DM = 1024, MROWS = BATCH * SEQ, DIN = 3584, DSUB = 512;
constexpr int NH = 8, DH = 64, NBLK = SEQ / 256, NBH = BATCH * NH, DEPTH = 2;
constexpr float NORM_EPS = 1e-6f, LN_EPS = 1e-5f;
constexpr float LOG2E = 1.4426950408889634f;
constexpr float QSCALE = 0.125f * LOG2E;
namespace pg8 {
#define PG8_LAS __attribute__((address_space(3)))
typedef unsigned short bf16_t;
typedef short bf16x8 __attribute__((ext_vector_type(8)));
typedef float f32x4 __attribute__((ext_vector_type(4)));
typedef unsigned u32x4 __attribute__((ext_vector_type(4)));
constexpr int BM = 256, BK = 64, HALF = 128, HTB = HALF * BK * 2  , STAGE_BYTES = 8 * HTB, NXCD = 8, WGM = 8;

__host__ __device__ __forceinline__ int lds_byte(int r, int c) { const int st = (r >> 4) * 2 + (c >> 5), rr = r & 15, cc = c & 31, ob = rr * 64 + cc * 2; return st * 1024 + (ob ^ (((ob >> 9) & 1) << 5)); }
__host__ __device__ __forceinline__ void stage_rc(int b, int& R, int& C) { const int st = b / 1024, sb = b % 1024, swz = sb ^ (((sb >> 9) & 1) << 5); R = (st >> 1) * 16 + swz / 64; C = (st & 1) * 32 + (swz % 64) / 2; }
__host__ __device__ __forceinline__ int perm32(int rho) { const int n = rho >> 4, i = rho & 15; return 8 * (i >> 2) + 4 * n + (i & 3); }

struct Unit { int pm, pn; };
struct Gemm { const bf16_t* A; const bf16_t* Bt; int M, N, K; };

struct StaticOrder {
    int nM, nN, nwg, G, c;
    __host__ __device__ void init(int M, int N, int G_, int c_) { nM = M / BM; nN = N / BM; nwg = nM * nN; G = G_; c = c_; }
    __host__ __device__ bool next(int i, Unit& u) const {
        const long L = (long)i * G + c; if (L >= nwg) return false;
        int wgid = (int)L; { const int q = nwg / NXCD, r = nwg % NXCD, xcd = wgid % NXCD, off = wgid / NXCD; wgid = (xcd < r ? xcd * (q + 1) : r * (q + 1) + (xcd - r) * q) + off; }
        const int nig = WGM * nN, gid = wgid / nig, fm = gid * WGM, gsz = (nM - fm) < WGM ? (nM - fm) : WGM;
        u.pm = fm + ((wgid % nig) % gsz); u.pn = (wgid % nig) / gsz; return true;
    }
    __device__ __forceinline__ void a_ready(const Unit&) const {}
    __device__ __forceinline__ void done(const Unit&) const {}
};

__device__ __forceinline__ unsigned cvt_pk_bf16(float lo, float hi) { unsigned r; asm volatile("v_cvt_pk_bf16_f32 %0, %1, %2" : "=v"(r) : "v"(lo), "v"(hi)); return r; }
typedef float f32x2 __attribute__((ext_vector_type(2)));
typedef float f32x2 __attribute__((ext_vector_type(2)));
__device__ __forceinline__ float act_gelu(float x) {
    const float u = x * (1.0f + 0.044715f * x * x);
    const float e = __builtin_amdgcn_exp2f(u * (-2.0f * 0.7978845608028654f * 1.4426950408889634f));
    return x * __builtin_amdgcn_rcpf(1.0f + e);
}
__device__ __forceinline__ float act_silu(float x) {
    const float e = __builtin_amdgcn_exp2f(x * (-1.4426950408889634f));
    return x * __builtin_amdgcn_rcpf(1.0f + e);
}
struct EpiProj {
    static constexpr bool PERM = true, AFTER_DRAIN = false;
    bf16_t* P; size_t sub_stride; const float* rowss;
    __device__ __forceinline__ void operator()(const f32x4 (&acc)[2][2][4][2], const Unit& u, int wr, int wc, int fr, int fq) const {
        const int t = u.pn >> 1;
        bf16_t* base = P + (size_t)t * sub_stride;
        const int col0 = (u.pn & 1) * 256 + wc * 32 + 8 * fq;
        const int row0 = u.pm * BM + wr * 64 + fr;
#pragma unroll
        for (int ai = 0; ai < 2; ++ai)
#pragma unroll
            for (int m = 0; m < 4; ++m) {
                const int row = row0 + ai * HALF + m * 16;
                const f32x4* rp = (const f32x4*)(rowss + (size_t)row * 16);
                const f32x4 s0 = rp[0], s1 = rp[1], s2 = rp[2], s3 = rp[3];
                const float ss = ((s0[0] + s0[1]) + (s0[2] + s0[3])) + ((s1[0] + s1[1]) + (s1[2] + s1[3])) + ((s2[0] + s2[1]) + (s2[2] + s2[3])) + ((s3[0] + s3[1]) + (s3[2] + s3[3]));
                const float rs = __builtin_amdgcn_rsqf(ss * (1.0f / 1024.0f) + 1e-6f);
                bf16_t* rowp = base + (size_t)row * 512 + col0;
#pragma unroll
                for (int bj = 0; bj < 2; ++bj) {
                    f32x4 v0 = acc[ai][bj][m][0] * rs, v1 = acc[ai][bj][m][1] * rs;
                    if (t <= 1) {
#pragma unroll
                        for (int e = 0; e < 4; ++e) { v0[e] = act_gelu(v0[e]); v1[e] = act_gelu(v1[e]); }
                    } else if (t == 2 || t == 6) {
#pragma unroll
                        for (int e = 0; e < 4; ++e) { v0[e] = act_silu(v0[e]); v1[e] = act_silu(v1[e]); }
                    } else if (t == 3) { v0 = v0 * (0.125f * 1.4426950408889634f); v1 = v1 * (0.125f * 1.4426950408889634f); }
                    u32x4 w; w.x = cvt_pk_bf16(v0[0], v0[1]); w.y = cvt_pk_bf16(v0[2], v0[3]); w.z = cvt_pk_bf16(v1[0], v1[1]); w.w = cvt_pk_bf16(v1[2], v1[3]);
                    *(u32x4*)(rowp + bj * HALF) = w;
                }
            }
    }
};
struct EpiRes {
    static constexpr bool PERM = false, AFTER_DRAIN = false;
    const float* res; float* out; bf16_t* xb; float* rowss;
    __device__ __forceinline__ void operator()(const f32x4 (&acc)[2][2][4][2], const Unit& u, int wr, int wc, int fr, int fq) const {
        typedef unsigned u32x2v __attribute__((ext_vector_type(2)));
        const int col0 = u.pn * BM + wc * 32 + 4 * fq;
#pragma unroll
        for (int ai = 0; ai < 2; ++ai)
#pragma unroll
            for (int m = 0; m < 4; ++m) {
                const int row = u.pm * BM + ai * HALF + wr * 64 + m * 16 + fr;
                const size_t off = (size_t)row * 1024 + col0;
                float ss = 0.f;
#pragma unroll
                for (int bj = 0; bj < 2; ++bj)
#pragma unroll
                    for (int n = 0; n < 2; ++n) {
                        const f32x4 r = *(const f32x4*)(res + off + bj * HALF + n * 16);
                        const f32x4 o = r + acc[ai][bj][m][n];
                        *(f32x4*)(out + off + bj * HALF + n * 16) = o;
                        ss += (o[0] * o[0] + o[1] * o[1]) + (o[2] * o[2] + o[3] * o[3]);
                        if (xb) { u32x2v w; w.x = cvt_pk_bf16(o[0], o[1]); w.y = cvt_pk_bf16(o[2], o[3]); *(u32x2v*)(xb + off + bj * HALF + n * 16) = w; }
                    }
                ss += __shfl_xor(ss, 16); ss += __shfl_xor(ss, 32);
                if (fq == 0) rowss[(size_t)row * 16 + u.pn * 4 + wc] = ss;
            }
    }
};
template <class Epi, class Sched, bool ALIGN_EPI = false, bool SP2 = false>
__device__ __forceinline__ void gemm_phase(PG8_LAS unsigned char* lds, const Gemm g, const Sched& S, const Epi& E) {
    const int tid = threadIdx.x, wid = __builtin_amdgcn_readfirstlane(tid >> 6), lane = tid & 63, wr = wid >> 2, wc = wid & 3, fr = lane & 15, fq = lane >> 4;
    const int K = g.K, nt = K / BK;
    unsigned voffA[2], voffB[2];
#pragma unroll
    for (int i = 0; i < 2; ++i) { int R, C; stage_rc(tid * 16 + i * 8192, R, C); const int Rb = Epi::PERM ? ((R & ~31) + perm32(R & 31)) : R;
        voffA[i] = (unsigned)(R * K + C) * 2u; voffB[i] = (unsigned)(Rb * K + C) * 2u; }
    const size_t kstep = (size_t)(BK * 2);
    const size_t hstep = (size_t)HALF * K * 2;
    const size_t tstep = 2 * hstep;
    const unsigned ldsw = (unsigned)wid * 1024u;
    const int aoff = lds_byte(wr * 64 + fr, fq * 8), boff = lds_byte(wc * 32 + fr, fq * 8);
#define PG8_SA(b, h) (((b) * 2 + (h)) * HTB)
#define PG8_SB(b, h) ((4 + (b) * 2 + (h)) * HTB)
#define PG8_STAGE(bufoff, gbase, voff) do { _Pragma("unroll") for (int _i = 0; _i < 2; ++_i) \
        __builtin_amdgcn_global_load_lds((const unsigned*)((const char*)(gbase) + (voff)[_i]), (PG8_LAS unsigned*)(lds + (bufoff) + ldsw + _i * 8192), 16, 0, 0); } while (0)
#define PG8_LDA(dst, b, h) do { _Pragma("unroll") for (int m = 0; m < 4; ++m) _Pragma("unroll") for (int k = 0; k < 2; ++k) dst[m][k] = *(const PG8_LAS bf16x8*)(lds + PG8_SA(b, h) + aoff + m * 2048 + k * 1024); } while (0)
#define PG8_LDB(dst, b, h) do { _Pragma("unroll") for (int n = 0; n < 2; ++n) _Pragma("unroll") for (int k = 0; k < 2; ++k) dst[n][k] = *(const PG8_LAS bf16x8*)(lds + PG8_SB(b, h) + boff + n * 2048 + k * 1024); } while (0)
#define PG8_MMA(ai, bj, At, Bt) do { __builtin_amdgcn_s_setprio(1); _Pragma("unroll") for (int m = 0; m < 4; ++m) _Pragma("unroll") for (int n = 0; n < 2; ++n) _Pragma("unroll") for (int k = 0; k < 2; ++k) \
        acc[ai][bj][m][n] = __builtin_amdgcn_mfma_f32_16x16x32_bf16(Bt[n][k], At[m][k], acc[ai][bj][m][n], 0, 0, 0); __builtin_amdgcn_s_setprio(0); } while (0)
#define PG8_WAIT_V(n) asm volatile("s_waitcnt vmcnt(" #n ")" ::: "memory")
#define PG8_WAIT_L(n) asm volatile("s_waitcnt lgkmcnt(" #n ")" ::: "memory")
#define PG8_BAR __builtin_amdgcn_s_barrier()
#define PG8_SCHED __builtin_amdgcn_sched_barrier(0)
    Unit cur, nxt; int ui = 0;
    if (!S.next(0, cur)) return;
    f32x4 acc[2][2][4][2];
#pragma unroll
    for (int a = 0; a < 2; ++a)
#pragma unroll
        for (int b = 0; b < 2; ++b)
#pragma unroll
            for (int m = 0; m < 4; ++m)
#pragma unroll
                for (int n = 0; n < 2; ++n) acc[a][b][m][n] = (f32x4){0.f, 0.f, 0.f, 0.f};
    bf16x8 At[4][2], B0[2][2], B1[2][2];
    const char* cA = (const char*)g.A + (size_t)cur.pm * tstep; const char* cB = (const char*)g.Bt + (size_t)cur.pn * tstep;
    S.a_ready(cur);
    if constexpr (SP2) {
        PG8_STAGE(PG8_SB(0, 0), cB, voffB); PG8_STAGE(PG8_SB(0, 1), cB + hstep, voffB); PG8_STAGE(PG8_SA(0, 0), cA, voffA); PG8_STAGE(PG8_SA(0, 1), cA + hstep, voffA);
        if (wr == 1) PG8_BAR;
        PG8_WAIT_V(2); PG8_BAR;
        PG8_STAGE(PG8_SB(1, 0), cB + kstep, voffB); PG8_STAGE(PG8_SA(1, 0), cA + kstep, voffA); PG8_STAGE(PG8_SB(1, 1), cB + hstep + kstep, voffB);
        PG8_WAIT_V(6); PG8_BAR;
    } else {
        PG8_STAGE(PG8_SB(0, 0), cB, voffB); PG8_STAGE(PG8_SA(0, 0), cA, voffA); PG8_STAGE(PG8_SB(0, 1), cB + hstep, voffB); PG8_STAGE(PG8_SA(0, 1), cA + hstep, voffA);
        if (wr == 1) PG8_BAR;
        PG8_WAIT_V(4); PG8_BAR;
        PG8_STAGE(PG8_SB(1, 0), cB + kstep, voffB); PG8_STAGE(PG8_SA(1, 0), cA + kstep, voffA); PG8_STAGE(PG8_SB(1, 1), cB + hstep + kstep, voffB);
        PG8_WAIT_V(6); PG8_BAR;
    }
    for (;;) {
        const bool has_next = S.next(ui + 1, nxt);
        const char* nA = has_next ? (const char*)g.A + (size_t)nxt.pm * tstep : cA; const char* nB = has_next ? (const char*)g.Bt + (size_t)nxt.pn * tstep : cB;
        for (int t = 0; t < nt; t += 2) {
            const bool last = (t == nt - 2);
            const char* a1 = cA + (size_t)(t + 1) * kstep;
            const char* a2 = last ? nA : cA + (size_t)(t + 2) * kstep; const char* b2 = last ? nB : cB + (size_t)(t + 2) * kstep;
            const char* a3 = a2 + kstep; const char* b3 = b2 + kstep;
            if (last && has_next) S.a_ready(nxt);
            if constexpr (SP2) {
            PG8_LDB(B0, 0, 0); PG8_LDB(B1, 0, 1); PG8_SCHED; PG8_LDA(At, 0, 0); PG8_STAGE(PG8_SA(1, 1), a1 + hstep, voffA);
            PG8_WAIT_V(8); PG8_WAIT_L(0); PG8_BAR; PG8_MMA(0, 0, At, B0); PG8_MMA(0, 1, At, B1); PG8_BAR; PG8_SCHED;
            PG8_LDA(At, 0, 1); PG8_STAGE(PG8_SB(0, 0), b2, voffB); PG8_STAGE(PG8_SB(0, 1), b2 + hstep, voffB); PG8_STAGE(PG8_SA(0, 0), a2, voffA);
            PG8_WAIT_V(8); PG8_WAIT_L(0); PG8_BAR; PG8_MMA(1, 0, At, B0); PG8_MMA(1, 1, At, B1); PG8_BAR; PG8_SCHED;
            PG8_LDB(B0, 1, 0); PG8_LDB(B1, 1, 1); PG8_SCHED; PG8_LDA(At, 1, 0); PG8_STAGE(PG8_SA(0, 1), a2 + hstep, voffA);
            PG8_WAIT_V(8); PG8_WAIT_L(0); PG8_BAR; PG8_MMA(0, 0, At, B0); PG8_MMA(0, 1, At, B1); PG8_BAR; PG8_SCHED;
            PG8_LDA(At, 1, 1); PG8_STAGE(PG8_SB(1, 0), b3, voffB); PG8_STAGE(PG8_SB(1, 1), b3 + hstep, voffB); PG8_STAGE(PG8_SA(1, 0), a3, voffA);
            PG8_WAIT_V(8); PG8_WAIT_L(0); PG8_BAR; PG8_MMA(1, 0, At, B0); PG8_MMA(1, 1, At, B1); PG8_BAR; PG8_SCHED;
            } else {
            PG8_LDB(B0, 0, 0); PG8_SCHED; PG8_LDA(At, 0, 0); PG8_STAGE(PG8_SA(1, 1), a1 + hstep, voffA);
            PG8_WAIT_L(8); PG8_BAR; PG8_WAIT_L(0); PG8_MMA(0, 0, At, B0); PG8_BAR; PG8_SCHED;
            PG8_LDB(B1, 0, 1); PG8_STAGE(PG8_SB(0, 0), b2, voffB);
            PG8_BAR; PG8_WAIT_L(0); PG8_MMA(0, 1, At, B1); PG8_BAR;
            PG8_LDA(At, 0, 1); PG8_STAGE(PG8_SA(0, 0), a2, voffA);
            PG8_BAR; PG8_WAIT_L(0); PG8_MMA(1, 0, At, B0); PG8_BAR; PG8_SCHED;
            PG8_STAGE(PG8_SB(0, 1), b2 + hstep, voffB);
            PG8_WAIT_V(6); PG8_BAR; PG8_MMA(1, 1, At, B1); PG8_BAR;
            PG8_LDB(B0, 1, 0); PG8_SCHED; PG8_LDA(At, 1, 0); PG8_STAGE(PG8_SA(0, 1), a2 + hstep, voffA);
            PG8_WAIT_L(8); PG8_BAR; PG8_WAIT_L(0); PG8_MMA(0, 0, At, B0); PG8_BAR; PG8_SCHED;
            PG8_LDB(B1, 1, 1); PG8_STAGE(PG8_SB(1, 0), b3, voffB);
            PG8_BAR; PG8_WAIT_L(0); PG8_MMA(0, 1, At, B1); PG8_BAR;
            PG8_LDA(At, 1, 1); PG8_STAGE(PG8_SA(1, 0), a3, voffA);
            PG8_BAR; PG8_WAIT_L(0); PG8_MMA(1, 0, At, B0); PG8_BAR; PG8_SCHED;
            PG8_STAGE(PG8_SB(1, 1), b3 + hstep, voffB);
            PG8_WAIT_V(6); PG8_BAR; PG8_MMA(1, 1, At, B1); PG8_BAR;
            }
        }
        if constexpr (ALIGN_EPI) { if (wr == 0) PG8_BAR; }
        if constexpr (!Epi::AFTER_DRAIN) { E(acc, cur, wr, wc, fr, fq); S.done(cur); }
        if (!has_next) break;
#pragma unroll
        for (int a = 0; a < 2; ++a)
#pragma unroll
            for (int b = 0; b < 2; ++b)
#pragma unroll
                for (int m = 0; m < 4; ++m)
#pragma unroll
                    for (int n = 0; n < 2; ++n) acc[a][b][m][n] = (f32x4){0.f, 0.f, 0.f, 0.f};
        cur = nxt; cA = nA; cB = nB; ++ui;
        if constexpr (ALIGN_EPI) { if (wr == 1) PG8_BAR; }
    }
    PG8_WAIT_V(0);
    if constexpr (!ALIGN_EPI) { if (wr == 0) PG8_BAR; }
    PG8_BAR;
    if constexpr (Epi::AFTER_DRAIN) { E.fused(acc, cur, wr, wc, fr, fq, lds, wid, lane); S.done(cur); }
#undef PG8_SA
#undef PG8_SB
#undef PG8_STAGE
#undef PG8_LDA
#undef PG8_LDB
#undef PG8_MMA
#undef PG8_WAIT_V
#undef PG8_WAIT_L
#undef PG8_BAR
#undef PG8_SCHED
}
}

constexpr size_t MiB = 1u << 20;
constexpr size_t WS_CTL = 0, CTL_ZERO_BYTES = 1 * MiB;
constexpr size_t WS_WIN = 2 * MiB;
constexpr size_t WS_WOUT = 16 * MiB;
constexpr size_t WS_WST = 20 * MiB;
constexpr size_t WS_BT = 21 * MiB;
constexpr size_t WS_KMEAN = 22 * MiB;
constexpr size_t WS_LOFF = 23 * MiB;
constexpr size_t WS_ROWSS = 24 * MiB;
constexpr size_t WS_PL = 26 * MiB;
constexpr size_t WS_LIST = 30 * MiB;
constexpr size_t WS_SEL = 32 * MiB;
constexpr size_t WS_XB = 40 * MiB;
constexpr size_t WS_PO = 40 * MiB;
constexpr size_t WS_PROJ = 168 * MiB;
constexpr size_t WS_MIX = 392 * MiB;
constexpr size_t WS_END = 456 * MiB;
constexpr size_t SUBSTRIDE = (size_t)MROWS * 512;
enum { T_U = 0, T_V = 1, T_ZA = 2, T_Q = 3, T_K = 4, T_VV = 5, T_ZB = 6 };

constexpr int NWAVES = 8;
constexpr int LDS_BYTES = 160 * 1024;
constexpr int RING_BYTES = 131072;

#define LAS __attribute__((address_space(3)))
typedef unsigned short bf16;
typedef unsigned v4u __attribute__((ext_vector_type(4)));
typedef float f32x4 __attribute__((ext_vector_type(4)));
#define LDS_WAIT() asm volatile("s_waitcnt lgkmcnt(0)" ::: "memory")
__device__ __forceinline__ unsigned f2bf(float f) { unsigned u = __builtin_bit_cast(unsigned, f); return (u + 0x7fffu + ((u >> 16) & 1u)) >> 16; }
__device__ __forceinline__ unsigned pk2(float lo, float hi) { return f2bf(lo) | (f2bf(hi) << 16); }
__device__ __forceinline__ float bflo(unsigned w) { return __uint_as_float(w << 16); }
__device__ __forceinline__ float bfhi(unsigned w) { return __uint_as_float(w & 0xffff0000u); }
__device__ __forceinline__ float wave_sum(float v) {
#pragma unroll
    for (int o = 1; o < 64; o <<= 1) v += __shfl_xor(v, o);
    return v;
}

struct Args { const float* in[10]; float* out; unsigned char* ws; int layer, pad; };

struct Ctx {
    unsigned char* lds;
    int tid, lane, wave, G, bid;
    const float *x, *norm_g, *w_in, *ln_g, *ln_b, *sgu_w, *sgu_b, *w_out, *rel_bias, *final_g;
    float* out; unsigned char* ws;
};

__device__ __forceinline__ void p0_transpose_item(const float* W, const float* gs, int K, int N, bf16* WT, float* scr, int item, int lane) {
    const int nblk = N / 32, kb = item / nblk, nb = item % nblk, k0 = 64 * kb, n0 = 32 * nb;
#pragma unroll 8
    for (int i = 0; i < 32; ++i) { const int kk = 2 * i + (lane >> 5); const float sc = gs ? gs[k0 + kk] : 1.0f; scr[kk * 33 + (lane & 31)] = W[(size_t)(k0 + kk) * N + n0 + (lane & 31)] * sc; }
    LDS_WAIT(); asm volatile("" ::: "memory");
    const int c = lane & 7;
#pragma unroll
    for (int j = 0; j < 4; ++j) { const int n = (lane >> 3) + 8 * j; const float* s = scr + (8 * c) * 33 + n;
        v4u o; o.x = pk2(s[0 * 33], s[1 * 33]); o.y = pk2(s[2 * 33], s[3 * 33]); o.z = pk2(s[4 * 33], s[5 * 33]); o.w = pk2(s[6 * 33], s[7 * 33]);
        *(v4u*)(WT + (size_t)(n0 + n) * K + k0 + 8 * c) = o; }
    LDS_WAIT(); asm volatile("" ::: "memory");
}
__device__ __forceinline__ int rel_bucket(int d) {
    if (d < 16) return d;
    int b = 16;
    b += (d >= 19); b += (d >= 21); b += (d >= 24); b += (d >= 27); b += (d >= 31); b += (d >= 35); b += (d >= 40); b += (d >= 46);
    b += (d >= 52); b += (d >= 59); b += (d >= 67); b += (d >= 77); b += (d >= 87); b += (d >= 99); b += (d >= 113);
    return b;
}
__device__ __forceinline__ void phase_prologue(const Ctx& C) {
    float* scr = (float*)(C.lds + C.wave * 16384);
    const int gw = C.bid * NWAVES + C.wave, NGW = C.G * NWAVES;
    constexpr int I_IN = (DM / 64) * (DIN / 32), I_OUT = (DM / 64) * (DM / 32);
    constexpr int NITEMS = DEPTH * (I_IN + I_OUT);
    for (int it = gw; it < NITEMS; it += NGW) {
        const int l = it / (I_IN + I_OUT); int r = it % (I_IN + I_OUT);
        if (r < I_IN) p0_transpose_item(C.w_in + (size_t)l * DM * DIN, C.norm_g + l * DM, DM, DIN, (bf16*)(C.ws + WS_WIN) + (size_t)l * DIN * DM, scr, r, C.lane);
        else p0_transpose_item(C.w_out + (size_t)l * DM * DM, nullptr, DM, DM, (bf16*)(C.ws + WS_WOUT) + (size_t)l * DM * DM, scr, r - I_IN, C.lane);
    }
    { bf16* wst = (bf16*)(C.ws + WS_WST); const int gt = C.bid * 512 + C.tid, NT = C.G * 512;
      for (int e = gt; e < DEPTH * 8 * 128 * 128; e += NT) { const int s = e & 127, t = (e >> 7) & 127; wst[e] = (s <= t) ? (bf16)f2bf(C.sgu_w[e]) : (bf16)0; } }
    if (C.bid == 0) { float* bt = (float*)(C.ws + WS_BT); for (int e = C.tid; e < 8 * 128; e += 512) { const int h = e >> 7, d = e & 127; bt[e] = C.rel_bias[rel_bucket(d) * 8 + h] * LOG2E; } }
    { bf16* xb = (bf16*)(C.ws + WS_XB); float* rowss = (float*)(C.ws + WS_ROWSS);
      for (int m = gw; m < MROWS; m += NGW) {
        const f32x4* xr = (const f32x4*)(C.x + (size_t)m * DM) + C.lane;
        f32x4 v[4]; float s = 0.f;
#pragma unroll
        for (int j = 0; j < 4; ++j) { v[j] = xr[64 * j]; s += (v[j].x * v[j].x + v[j].y * v[j].y) + (v[j].z * v[j].z + v[j].w * v[j].w); }
        s = wave_sum(s);
        unsigned long long* o8 = (unsigned long long*)(xb + (size_t)m * DM) + C.lane;
#pragma unroll
        for (int j = 0; j < 4; ++j) o8[64 * j] = (unsigned long long)pk2(v[j].x, v[j].y) | ((unsigned long long)pk2(v[j].z, v[j].w) << 32);
        if (C.lane < 16) rowss[(size_t)m * 16 + C.lane] = (C.lane == 0) ? s : 0.f;
      } }
}

__device__ __forceinline__ void phase_kmean(const Ctx& C) {
    const bf16* K = (const bf16*)(C.ws + WS_PROJ) + (size_t)T_K * SUBSTRIDE;
    float* km = (float*)(C.ws + WS_KMEAN);
    float* red = (float*)C.lds;
    const int cgp = C.tid & 63, rg = C.tid >> 6;
    for (int u = C.bid; u < BATCH * NBLK; u += C.G) {
        const int b = u / NBLK, n = u % NBLK;
        float s[8];
#pragma unroll
        for (int e = 0; e < 8; ++e) s[e] = 0.f;
        for (int r = rg; r < 256; r += 8) {
            const v4u v = *(const v4u*)(K + ((size_t)(b * SEQ + n * 256 + r)) * 512 + cgp * 8);
            s[0] += bflo(v.x); s[1] += bfhi(v.x); s[2] += bflo(v.y); s[3] += bfhi(v.y); s[4] += bflo(v.z); s[5] += bfhi(v.z); s[6] += bflo(v.w); s[7] += bfhi(v.w);
        }
#pragma unroll
        for (int e = 0; e < 8; ++e) red[rg * 512 + cgp * 8 + e] = s[e];
        __syncthreads();
        { const int col = C.tid; float t = 0.f;
#pragma unroll
          for (int r = 0; r < 8; ++r) t += red[r * 512 + col];
          km[((size_t)((b * NH + (col >> 6)) * NBLK + n)) * 64 + (col & 63)] = t * (1.0f / 256.0f); }
        __syncthreads();
    }
}

__device__ __forceinline__ void phase_gate(const Ctx& C) {
    const bf16* Q = (const bf16*)(C.ws + WS_PROJ) + (size_t)T_Q * SUBSTRIDE;
    const float* KM = (const float*)(C.ws + WS_KMEAN);
    int* SEL = (int*)(C.ws + WS_SEL); int* LOFF = (int*)(C.ws + WS_LOFF); unsigned short* LIST = (unsigned short*)(C.ws + WS_LIST);
    float* km = (float*)C.lds;
    float* cval = (float*)(C.lds + 16384);
    int* cidx = (int*)(C.lds + 16384 + 3072);
    int* cnt = (int*)(C.lds + 16384 + 6144);
    int* offs = (int*)(C.lds + 16384 + 6144 + 256);
    const int q = C.tid & 255, half = C.tid >> 8;
    for (int u = C.bid; u < NBH * NBLK; u += C.G) {
        const int bh = u >> 6, i = u & 63, b = bh >> 3, h = bh & 7;
        const int pos = i * 256 + q;
        if (i == 0) { if (half == 0) { int* sp = SEL + ((size_t)bh * SEQ + pos) * 4; sp[0] = -1; sp[1] = -1; sp[2] = -1; sp[3] = -1; } continue; }
        for (int e = C.tid; e < i * 64; e += 512) km[e] = KM[(size_t)bh * NBLK * 64 + e];
        if (C.tid < 64) cnt[C.tid] = 0;
        float qv[64];
        { const v4u* qp = (const v4u*)(Q + ((size_t)(b * SEQ + pos)) * 512 + h * 64);
#pragma unroll
          for (int c = 0; c < 8; ++c) { const v4u v = qp[c]; qv[8 * c + 0] = bflo(v.x); qv[8 * c + 1] = bfhi(v.x); qv[8 * c + 2] = bflo(v.y); qv[8 * c + 3] = bfhi(v.y);
              qv[8 * c + 4] = bflo(v.z); qv[8 * c + 5] = bfhi(v.z); qv[8 * c + 6] = bflo(v.w); qv[8 * c + 7] = bfhi(v.w); } }
        __syncthreads();
        const int nmid = (i + 1) >> 1, n0 = half ? nmid : 0, n1 = half ? i : nmid;
        float b0 = -INFINITY, b1 = -INFINITY, b2 = -INFINITY; int i0 = -1, i1 = -1, i2 = -1;
#define TOP3_INS(v, idx) do { if ((v) > b0) { b2 = b1; i2 = i1; b1 = b0; i1 = i0; b0 = (v); i0 = (idx); } else if ((v) > b1) { b2 = b1; i2 = i1; b1 = (v); i1 = (idx); } else if ((v) > b2) { b2 = (v); i2 = (idx); } } while (0)
        for (int n = n0; n < n1; ++n) {
            const f32x4* kr = (const f32x4*)(km + n * 64);
            float a0 = 0.f, a1 = 0.f, a2 = 0.f, a3 = 0.f;
#pragma unroll
            for (int d4 = 0; d4 < 16; ++d4) { const f32x4 kv = kr[d4]; a0 += qv[4 * d4] * kv.x; a1 += qv[4 * d4 + 1] * kv.y; a2 += qv[4 * d4 + 2] * kv.z; a3 += qv[4 * d4 + 3] * kv.w; }
            const float g = (a0 + a1) + (a2 + a3);
            TOP3_INS(g, n);
        }
        if (half) { cval[q * 3 + 0] = b0; cval[q * 3 + 1] = b1; cval[q * 3 + 2] = b2; cidx[q * 3 + 0] = i0; cidx[q * 3 + 1] = i1; cidx[q * 3 + 2] = i2; }
        __syncthreads();
        int p0 = 0, p1 = 0, p2 = 0;
        const int nsel = i < 3 ? i : 3;
        if (!half) {
#pragma unroll
            for (int j = 0; j < 3; ++j) { const float v = cval[q * 3 + j]; const int id = cidx[q * 3 + j]; if (id >= 0) TOP3_INS(v, id); }
            if (nsel < 3) i2 = -1;
            if (nsel < 2) i1 = -1;
            int* sp = SEL + ((size_t)bh * SEQ + pos) * 4; sp[0] = i0; sp[1] = i1; sp[2] = i2; sp[3] = -1;
            p0 = atomicAdd(&cnt[i0], 1);
            if (i1 >= 0) p1 = atomicAdd(&cnt[i1], 1);
            if (i2 >= 0) p2 = atomicAdd(&cnt[i2], 1);
        }
#undef TOP3_INS
        __syncthreads();
        if (C.tid == 0) { int a = 0; for (int n = 0; n < 64; ++n) { offs[n] = a; a += cnt[n]; } offs[64] = a; }
        __syncthreads();
        if (!half) {
            unsigned short* lp = LIST + (size_t)u * 768;
            lp[offs[i0] + p0] = (unsigned short)(q | (0 << 8));
            if (i1 >= 0) lp[offs[i1] + p1] = (unsigned short)(q | (1 << 8));
            if (i2 >= 0) lp[offs[i2] + p2] = (unsigned short)(q | (2 << 8));
        }
        if (C.tid < 65) LOFF[(size_t)u * 80 + C.tid] = offs[C.tid];
        __syncthreads();
    }
}

__device__ __forceinline__ void phase_sgu_simple(const Ctx& C, int layer) {
    const bf16* U = (const bf16*)(C.ws + WS_PROJ) + (size_t)T_U * SUBSTRIDE;
    const bf16* V = (const bf16*)(C.ws + WS_PROJ) + (size_t)T_V * SUBSTRIDE;
    const bf16* ZA = (const bf16*)(C.ws + WS_PROJ) + (size_t)T_ZA * SUBSTRIDE;
    bf16* MIX = (bf16*)(C.ws + WS_MIX);
    const float* lng = C.ln_g + layer * 512; const float* lnb = C.ln_b + layer * 512;
    const float* Wl = C.sgu_w + (size_t)layer * 8 * 128 * 128; const float* bl = C.sgu_b + layer * 8 * 128;
    bf16* vh = (bf16*)C.lds;
    for (int u = C.bid; u < MROWS / 128; u += C.G) {
        const size_t row0 = (size_t)u * 128;
        for (int r = 0; r < 16; ++r) {
            const int t = C.wave * 16 + r;
            const v4u v = *(const v4u*)(V + (row0 + t) * 512 + C.lane * 8);
            float f[8] = {bflo(v.x), bfhi(v.x), bflo(v.y), bfhi(v.y), bflo(v.z), bfhi(v.z), bflo(v.w), bfhi(v.w)};
            float s = 0.f;
#pragma unroll
            for (int e = 0; e < 8; ++e) s += f[e];
            const float mean = wave_sum(s) * (1.0f / 512.0f);
            float s2 = 0.f;
#pragma unroll
            for (int e = 0; e < 8; ++e) { f[e] -= mean; s2 += f[e] * f[e]; }
            const float rstd = 1.0f / sqrtf(wave_sum(s2) * (1.0f / 512.0f) + LN_EPS);
            v4u o;
            float g8[8], b8[8];
#pragma unroll
            for (int e = 0; e < 8; ++e) { g8[e] = lng[C.lane * 8 + e]; b8[e] = lnb[C.lane * 8 + e]; }
            o.x = pk2(f[0] * rstd * g8[0] + b8[0], f[1] * rstd * g8[1] + b8[1]); o.y = pk2(f[2] * rstd * g8[2] + b8[2], f[3] * rstd * g8[3] + b8[3]);
            o.z = pk2(f[4] * rstd * g8[4] + b8[4], f[5] * rstd * g8[5] + b8[5]); o.w = pk2(f[6] * rstd * g8[6] + b8[6], f[7] * rstd * g8[7] + b8[7]);
            *(v4u*)(vh + t * 512 + C.lane * 8) = o;
        }
        __syncthreads();
        { const int c = C.tid, g = c >> 6;
          const float* Wg = Wl + (size_t)g * 128 * 128;
          for (int t = 0; t < 128; ++t) {
              float acc = 0.f;
              for (int s = 0; s <= t; ++s) acc += Wg[t * 128 + s] * __uint_as_float((unsigned)vh[s * 512 + c] << 16);
              acc += bl[g * 128 + t];
              const float uu = __uint_as_float((unsigned)U[(row0 + t) * 512 + c] << 16), zz = __uint_as_float((unsigned)ZA[(row0 + t) * 512 + c] << 16);
              MIX[(row0 + t) * 1024 + c] = (bf16)f2bf(uu * acc * zz);
          } }
        __syncthreads();
    }
}

__device__ __forceinline__ void phase_attn_simple(const Ctx& C) {
    const bf16* Q = (const bf16*)(C.ws + WS_PROJ) + (size_t)T_Q * SUBSTRIDE;
    const bf16* K = (const bf16*)(C.ws + WS_PROJ) + (size_t)T_K * SUBSTRIDE;
    const bf16* VV = (const bf16*)(C.ws + WS_PROJ) + (size_t)T_VV * SUBSTRIDE;
    const bf16* ZB = (const bf16*)(C.ws + WS_PROJ) + (size_t)T_ZB * SUBSTRIDE;
    const int* SEL = (const int*)(C.ws + WS_SEL); const float* BT = (const float*)(C.ws + WS_BT);
    bf16* MIX = (bf16*)(C.ws + WS_MIX);
    const int gt = C.bid * 512 + C.tid, NT = C.G * 512;
    for (int item = gt; item < NBH * SEQ; item += NT) {
        const int bh = item >> 14, pos = item & (SEQ - 1), b = bh >> 3, h = bh & 7, own = pos >> 8;
        const size_t rowq = (size_t)(b * SEQ + pos);
        float qv[64], o[64];
        { const v4u* qp = (const v4u*)(Q + rowq * 512 + h * 64);
#pragma unroll
          for (int c = 0; c < 8; ++c) { const v4u v = qp[c]; qv[8 * c + 0] = bflo(v.x); qv[8 * c + 1] = bfhi(v.x); qv[8 * c + 2] = bflo(v.y); qv[8 * c + 3] = bfhi(v.y);
              qv[8 * c + 4] = bflo(v.z); qv[8 * c + 5] = bfhi(v.z); qv[8 * c + 6] = bflo(v.w); qv[8 * c + 7] = bfhi(v.w); } }
#pragma unroll
        for (int d = 0; d < 64; ++d) o[d] = 0.f;
        float m = -INFINITY, l = 0.f;
        const float* bt = BT + h * 128;
        for (int slot = 0; slot < 4; ++slot) {
            int blk, klim;
            if (slot == 0) { blk = own; klim = (pos & 255) + 1; } else { blk = SEL[(size_t)item * 4 + slot - 1]; klim = 256; if (blk < 0) klim = 0; }
            for (int kl = 0; kl < klim; ++kl) {
                const int kpos = blk * 256 + kl;
                const v4u* kp = (const v4u*)(K + ((size_t)(b * SEQ + kpos)) * 512 + h * 64);
                float a0 = 0.f, a1 = 0.f;
#pragma unroll
                for (int c = 0; c < 8; ++c) { const v4u v = kp[c];
                    a0 += qv[8 * c + 0] * bflo(v.x) + qv[8 * c + 2] * bflo(v.y) + qv[8 * c + 4] * bflo(v.z) + qv[8 * c + 6] * bflo(v.w);
                    a1 += qv[8 * c + 1] * bfhi(v.x) + qv[8 * c + 3] * bfhi(v.y) + qv[8 * c + 5] * bfhi(v.z) + qv[8 * c + 7] * bfhi(v.w); }
                int dd = pos - kpos; dd = dd > 127 ? 127 : dd;
                const float s = (a0 + a1) + bt[dd];
                if (s > m) { const float al = __builtin_amdgcn_exp2f(m - s); l *= al;
#pragma unroll
                    for (int d = 0; d < 64; ++d) o[d] *= al;
                    m = s; }
                const float p = __builtin_amdgcn_exp2f(s - m);
                l += p;
                const v4u* vp = (const v4u*)(VV + ((size_t)(b * SEQ + kpos)) * 512 + h * 64);
#pragma unroll
                for (int c = 0; c < 8; ++c) { const v4u v = vp[c];
                    o[8 * c + 0] += p * bflo(v.x); o[8 * c + 1] += p * bfhi(v.x); o[8 * c + 2] += p * bflo(v.y); o[8 * c + 3] += p * bfhi(v.y);
                    o[8 * c + 4] += p * bflo(v.z); o[8 * c + 5] += p * bfhi(v.z); o[8 * c + 6] += p * bflo(v.w); o[8 * c + 7] += p * bfhi(v.w); }
            }
        }
        const float rl = 1.0f / l;
        const v4u* zp = (const v4u*)(ZB + rowq * 512 + h * 64);
        v4u* op = (v4u*)(MIX + rowq * 1024 + 512 + h * 64);
#pragma unroll
        for (int c = 0; c < 8; ++c) { const v4u z = zp[c]; v4u w;
            w.x = pk2(o[8 * c + 0] * rl * bflo(z.x), o[8 * c + 1] * rl * bfhi(z.x)); w.y = pk2(o[8 * c + 2] * rl * bflo(z.y), o[8 * c + 3] * rl * bfhi(z.y));
            w.z = pk2(o[8 * c + 4] * rl * bflo(z.z), o[8 * c + 5] * rl * bfhi(z.z)); w.w = pk2(o[8 * c + 6] * rl * bflo(z.w), o[8 * c + 7] * rl * bfhi(z.w));
            op[c] = w; }
    }
}

__device__ __forceinline__ void phase_final(const Ctx& C) {
    const float* rowss = (const float*)(C.ws + WS_ROWSS);
    const int gw = C.bid * NWAVES + C.wave, NGW = C.G * NWAVES;
    f32x4 g[4];
#pragma unroll
    for (int j = 0; j < 4; ++j) g[j] = ((const f32x4*)C.final_g)[64 * j + C.lane];
    for (int m = gw; m < MROWS; m += NGW) {
        float ss = (C.lane < 16) ? rowss[(size_t)m * 16 + C.lane] : 0.f;
        ss = wave_sum(ss);
        const float rs = 1.0f / sqrtf(ss * (1.0f / 1024.0f) + NORM_EPS);
        f32x4* xr = (f32x4*)(C.out + (size_t)m * DM) + C.lane;
#pragma unroll
        for (int j = 0; j < 4; ++j) { const f32x4 v = xr[64 * j]; xr[64 * j] = v * rs * g[j]; }
    }
}

template <int ST> __device__ __forceinline__ void run_stage(const Ctx& C, unsigned char* lds, int L) {
    if constexpr (ST == 0) phase_prologue(C);
    else if constexpr (ST == 1) {
        pg8::Gemm g{(const pg8::bf16_t*)(C.ws + WS_XB), (const pg8::bf16_t*)(C.ws + WS_WIN) + (size_t)L * DIN * DM, MROWS, DIN, DM};
        pg8::StaticOrder S; S.init(MROWS, DIN, C.G, C.bid);
        pg8::EpiProj E{(pg8::bf16_t*)(C.ws + WS_PROJ), SUBSTRIDE, (const float*)(C.ws + WS_ROWSS)};
        pg8::gemm_phase<pg8::EpiProj, pg8::StaticOrder, true, true>((PG8_LAS unsigned char*)lds, g, S, E);
    } else if constexpr (ST == 2) phase_kmean(C);
    else if constexpr (ST == 3) { phase_gate(C); phase_sgu_simple(C, L); }
    else if constexpr (ST == 4) phase_attn_simple(C);
    else if constexpr (ST == 5) {
        pg8::Gemm g{(const pg8::bf16_t*)(C.ws + WS_MIX), (const pg8::bf16_t*)(C.ws + WS_WOUT) + (size_t)L * DM * DM, MROWS, DM, DM};
        pg8::StaticOrder S; S.init(MROWS, DM, C.G, C.bid);
        pg8::EpiRes E{L == 0 ? C.x : (const float*)C.out, C.out, L == 0 ? (pg8::bf16_t*)(C.ws + WS_XB) : (pg8::bf16_t*)nullptr, (float*)(C.ws + WS_ROWSS)};
        pg8::gemm_phase<pg8::EpiRes, pg8::StaticOrder, true, true>((PG8_LAS unsigned char*)lds, g, S, E);
    } else if constexpr (ST == 6) phase_final(C);
}
#define GRID_SYNC() do { __threadfence(); cg::this_grid().sync(); } while (0)
template <int SEL> __global__ void __launch_bounds__(NWAVES * 64, 2) fwd(Args args) {
    extern __shared__ __attribute__((aligned(16))) unsigned char lds[];
    Ctx C;
    C.lds = lds; C.tid = threadIdx.x; C.lane = C.tid & 63; C.wave = __builtin_amdgcn_readfirstlane(C.tid >> 6); C.G = gridDim.x; C.bid = blockIdx.x;
    C.x = args.in[0]; C.norm_g = args.in[1]; C.w_in = args.in[2]; C.ln_g = args.in[3]; C.ln_b = args.in[4]; C.sgu_w = args.in[5]; C.sgu_b = args.in[6];
    C.w_out = args.in[7]; C.rel_bias = args.in[8]; C.final_g = args.in[9]; C.out = args.out; C.ws = args.ws;
    if constexpr (SEL >= 0) run_stage<SEL>(C, lds, args.layer);
    else {
        run_stage<0>(C, lds, 0); GRID_SYNC();
        for (int L = 0; L < DEPTH; ++L) {
            run_stage<1>(C, lds, L); GRID_SYNC();
            run_stage<2>(C, lds, L); GRID_SYNC();
            run_stage<3>(C, lds, L); GRID_SYNC();
            run_stage<4>(C, lds, L); GRID_SYNC();
            run_stage<5>(C, lds, L); GRID_SYNC();
        }
        run_stage<6>(C, lds, 0);
    }
}

#ifndef MK_N_LAUNCHES
#define MK_N_LAUNCHES 12
#endif
template <int SEL> static void launch_stage(int grid, Args a, int layer, hipStream_t stream) {
    static bool attr = false;
    if (!attr) { (void)hipFuncSetAttribute((const void*)fwd<SEL>, hipFuncAttributeMaxDynamicSharedMemorySize, LDS_BYTES); attr = true; }
    a.layer = layer;
    hipLaunchKernelGGL(fwd<SEL>, dim3(grid), dim3(NWAVES * 64), LDS_BYTES, stream, a);
}
extern "C" void kernel_launch(void* const* d_in, const int* in_sizes, int n_in, void* d_out, int out_size, void* d_ws, size_t ws_size, hipStream_t stream) {
    static int grid = 0;
    if (grid == 0) {
        if (n_in != 10 || out_size != MROWS * DM || ws_size < WS_END) { fprintf(stderr, "kernel_launch: unexpected shapes (n_in %d out %d ws %zu)\n", n_in, out_size, ws_size); grid = -1; return; }
        int dev = 0, cus = 0;
        (void)hipGetDevice(&dev); (void)hipDeviceGetAttribute(&cus, hipDeviceAttributeMultiprocessorCount, dev);
        grid = cus;
#if MK_N_LAUNCHES == 1
        int per_cu = 0;
        if (hipFuncSetAttribute((const void*)fwd<-1>, hipFuncAttributeMaxDynamicSharedMemorySize, LDS_BYTES) != hipSuccess) { fprintf(stderr, "kernel_launch: hipFuncSetAttribute failed\n"); grid = -1; return; }
        if (hipOccupancyMaxActiveBlocksPerMultiprocessor(&per_cu, (const void*)fwd<-1>, NWAVES * 64, LDS_BYTES) != hipSuccess || per_cu < 1) { fprintf(stderr, "kernel_launch: occupancy query says %d\n", per_cu); grid = -1; return; }
        (void)hipGetLastError();
#endif
    }
    if (grid < 0) return;
    (void)hipMemsetAsync((char*)d_ws + WS_CTL, 0, CTL_ZERO_BYTES, stream);
    Args a{};
    for (int i = 0; i < 10; ++i) a.in[i] = (const float*)d_in[i];
    a.out = (float*)d_out; a.ws = (unsigned char*)d_ws;
#if MK_N_LAUNCHES == 1
    void* kargs[] = {&a};
    hipError_t e = hipLaunchCooperativeKernel((const void*)fwd<-1>, dim3(grid), dim3(NWAVES * 64), kargs, LDS_BYTES, stream);
    if (e != hipSuccess) fprintf(stderr, "kernel_launch: cooperative launch failed: %s\n", hipGetErrorString(e));
#else
    launch_stage<0>(grid, a, 0, stream);
    for (int L = 0; L < DEPTH; ++L) {
        launch_stage<1>(grid, a, L, stream); launch_stage<2>(grid, a, L, stream); launch_stage<3>(grid, a, L, stream);
        launch_stage<4>(grid, a, L, stream); launch_stage<5>(grid, a, L, stream);
    }
    launch_stage<6>(grid, a, 0, stream);
#endif
}
```

```cpp
#include <hip/hip_runtime.h>
#include <hip/hip_cooperative_groups.h>
#include <cstdio>
#include <cstdint>
namespace cg = cooperative_groups;

constexpr int BATCH = 2, SEQ = 16384, DM = 1024, MROWS = BATCH * SEQ, DIN = 3584, DSUB = 512;
constexpr int NH = 8, DH = 64, NBLK = SEQ / 256, NBH = BATCH * NH, DEPTH = 2;
constexpr float NORM_EPS = 1e-6f, LN_EPS = 1e-5f;
constexpr float LOG2E = 1.4426950408889634f;
constexpr float QSCALE = 0.125f * LOG2E;
namespace pg8 {
#define PG8_LAS __attribute__((address_space(3)))
typedef unsigned short bf16_t;
typedef short bf16x8 __attribute__((ext_vector_type(8)));
typedef float f32x4 __attribute__((ext_vector_type(4)));
typedef unsigned u32x4 __attribute__((ext_vector_type(4)));
constexpr int BM = 256, BK = 64, HALF = 128, HTB = HALF * BK * 2  , STAGE_BYTES = 8 * HTB, NXCD = 8, WGM = 8;

__host__ __device__ __forceinline__ int lds_byte(int r, int c) { const int st = (r >> 4) * 2 + (c >> 5), rr = r & 15, cc = c & 31, ob = rr * 64 + cc * 2; return st * 1024 + (ob ^ (((ob >> 9) & 1) << 5)); }
__host__ __device__ __forceinline__ void stage_rc(int b, int& R, int& C) { const int st = b / 1024, sb = b % 1024, swz = sb ^ (((sb >> 9) & 1) << 5); R = (st >> 1) * 16 + swz / 64; C = (st & 1) * 32 + (swz % 64) / 2; }
__host__ __device__ __forceinline__ int perm32(int rho) { const int n = rho >> 4, i = rho & 15; return 8 * (i >> 2) + 4 * n + (i & 3); }

struct Unit { int pm, pn; };
struct Gemm { const bf16_t* A; const bf16_t* Bt; int M, N, K; };

struct StaticOrder {
    int nM, nN, nwg, G, c;
    __host__ __device__ void init(int M, int N, int G_, int c_) { nM = M / BM; nN = N / BM; nwg = nM * nN; G = G_; c = c_; }
    __host__ __device__ bool next(int i, Unit& u) const {
        const long L = (long)i * G + c; if (L >= nwg) return false;
        int wgid = (int)L; { const int q = nwg / NXCD, r = nwg % NXCD, xcd = wgid % NXCD, off = wgid / NXCD; wgid = (xcd < r ? xcd * (q + 1) : r * (q + 1) + (xcd - r) * q) + off; }
        const int nig = WGM * nN, gid = wgid / nig, fm = gid * WGM, gsz = (nM - fm) < WGM ? (nM - fm) : WGM;
        u.pm = fm + ((wgid % nig) % gsz); u.pn = (wgid % nig) / gsz; return true;
    }
    __device__ __forceinline__ void a_ready(const Unit&) const {}
    __device__ __forceinline__ void done(const Unit&) const {}
};

__device__ __forceinline__ unsigned cvt_pk_bf16(float lo, float hi) { unsigned r; asm volatile("v_cvt_pk_bf16_f32 %0, %1, %2" : "=v"(r) : "v"(lo), "v"(hi)); return r; }
typedef float f32x2 __attribute__((ext_vector_type(2)));
typedef float f32x2 __attribute__((ext_vector_type(2)));
__device__ __forceinline__ float act_gelu(float x) {
    const float u = x * (1.0f + 0.044715f * x * x);
    const float e = __builtin_amdgcn_exp2f(u * (-2.0f * 0.7978845608028654f * 1.4426950408889634f));
    return x * __builtin_amdgcn_rcpf(1.0f + e);
}
__device__ __forceinline__ float act_silu(float x) {
    const float e = __builtin_amdgcn_exp2f(x * (-1.4426950408889634f));
    return x * __builtin_amdgcn_rcpf(1.0f + e);
}
struct EpiProj {
    static constexpr bool PERM = true, AFTER_DRAIN = false;
    bf16_t* P; size_t sub_stride; const float* rowss;
    __device__ __forceinline__ void operator()(const f32x4 (&acc)[2][2][4][2], const Unit& u, int wr, int wc, int fr, int fq) const {
        const int t = u.pn >> 1;
        bf16_t* base = P + (size_t)t * sub_stride;
        const int col0 = (u.pn & 1) * 256 + wc * 32 + 8 * fq;
        const int row0 = u.pm * BM + wr * 64 + fr;
#pragma unroll
        for (int ai = 0; ai < 2; ++ai)
#pragma unroll
            for (int m = 0; m < 4; ++m) {
                const int row = row0 + ai * HALF + m * 16;
                const f32x4* rp = (const f32x4*)(rowss + (size_t)row * 16);
                const f32x4 s0 = rp[0], s1 = rp[1], s2 = rp[2], s3 = rp[3];
                const float ss = ((s0[0] + s0[1]) + (s0[2] + s0[3])) + ((s1[0] + s1[1]) + (s1[2] + s1[3])) + ((s2[0] + s2[1]) + (s2[2] + s2[3])) + ((s3[0] + s3[1]) + (s3[2] + s3[3]));
                const float rs = __builtin_amdgcn_rsqf(ss * (1.0f / 1024.0f) + 1e-6f);
                bf16_t* rowp = base + (size_t)row * 512 + col0;
#pragma unroll
                for (int bj = 0; bj < 2; ++bj) {
                    f32x4 v0 = acc[ai][bj][m][0] * rs, v1 = acc[ai][bj][m][1] * rs;
                    if (t <= 1) {
#pragma unroll
                        for (int e = 0; e < 4; ++e) { v0[e] = act_gelu(v0[e]); v1[e] = act_gelu(v1[e]); }
                    } else if (t == 2 || t == 6) {
#pragma unroll
                        for (int e = 0; e < 4; ++e) { v0[e] = act_silu(v0[e]); v1[e] = act_silu(v1[e]); }
                    } else if (t == 3) { v0 = v0 * (0.125f * 1.4426950408889634f); v1 = v1 * (0.125f * 1.4426950408889634f); }
                    u32x4 w; w.x = cvt_pk_bf16(v0[0], v0[1]); w.y = cvt_pk_bf16(v0[2], v0[3]); w.z = cvt_pk_bf16(v1[0], v1[1]); w.w = cvt_pk_bf16(v1[2], v1[3]);
                    *(u32x4*)(rowp + bj * HALF) = w;
                }
            }
    }
};
struct EpiRes {
    static constexpr bool PERM = false, AFTER_DRAIN = false;
    const float* res; float* out; bf16_t* xb; float* rowss;
    __device__ __forceinline__ void operator()(const f32x4 (&acc)[2][2][4][2], const Unit& u, int wr, int wc, int fr, int fq) const {
        typedef unsigned u32x2v __attribute__((ext_vector_type(2)));
        const int col0 = u.pn * BM + wc * 32 + 4 * fq;
#pragma unroll
        for (int ai = 0; ai < 2; ++ai)
#pragma unroll
            for (int m = 0; m < 4; ++m) {
                const int row = u.pm * BM + ai * HALF + wr * 64 + m * 16 + fr;
                const size_t off = (size_t)row * 1024 + col0;
                float ss = 0.f;
#pragma unroll
                for (int bj = 0; bj < 2; ++bj)
#pragma unroll
                    for (int n = 0; n < 2; ++n) {
                        const f32x4 r = *(const f32x4*)(res + off + bj * HALF + n * 16);
                        const f32x4 o = r + acc[ai][bj][m][n];
                        *(f32x4*)(out + off + bj * HALF + n * 16) = o;
                        ss += (o[0] * o[0] + o[1] * o[1]) + (o[2] * o[2] + o[3] * o[3]);
                        if (xb) { u32x2v w; w.x = cvt_pk_bf16(o[0], o[1]); w.y = cvt_pk_bf16(o[2], o[3]); *(u32x2v*)(xb + off + bj * HALF + n * 16) = w; }
                    }
                ss += __shfl_xor(ss, 16); ss += __shfl_xor(ss, 32);
                if (fq == 0) rowss[(size_t)row * 16 + u.pn * 4 + wc] = ss;
            }
    }
};
template <class Epi, class Sched, bool ALIGN_EPI = false, bool SP2 = false>
__device__ __forceinline__ void gemm_phase(PG8_LAS unsigned char* lds, const Gemm g, const Sched& S, const Epi& E, const int tid) {
    const int wid = __builtin_amdgcn_readfirstlane(tid >> 6), lane = tid & 63, wr = wid >> 2, wc = wid & 3, fr = lane & 15, fq = lane >> 4;
    const int K = g.K, nt = K / BK;
    unsigned voffA[2], voffB[2];
#pragma unroll
    for (int i = 0; i < 2; ++i) { int R, C; stage_rc(tid * 16 + i * 8192, R, C); const int Rb = Epi::PERM ? ((R & ~31) + perm32(R & 31)) : R;
        voffA[i] = (unsigned)(R * K + C) * 2u; voffB[i] = (unsigned)(Rb * K + C) * 2u; }
    const size_t kstep = (size_t)(BK * 2);
    const size_t hstep = (size_t)HALF * K * 2;
    const size_t tstep = 2 * hstep;
    const unsigned ldsw = (unsigned)wid * 1024u;
    const int aoff = lds_byte(wr * 64 + fr, fq * 8), boff = lds_byte(wc * 32 + fr, fq * 8);
#define PG8_SA(b, h) (((b) * 2 + (h)) * HTB)
#define PG8_SB(b, h) ((4 + (b) * 2 + (h)) * HTB)
#define PG8_STAGE(bufoff, gbase, voff) do { _Pragma("unroll") for (int _i = 0; _i < 2; ++_i) \
        __builtin_amdgcn_global_load_lds((const unsigned*)((const char*)(gbase) + (voff)[_i]), (PG8_LAS unsigned*)(lds + (bufoff) + ldsw + _i * 8192), 16, 0, 0); } while (0)
#define PG8_LDA(dst, b, h) do { _Pragma("unroll") for (int m = 0; m < 4; ++m) _Pragma("unroll") for (int k = 0; k < 2; ++k) dst[m][k] = *(const PG8_LAS bf16x8*)(lds + PG8_SA(b, h) + aoff + m * 2048 + k * 1024); } while (0)
#define PG8_LDB(dst, b, h) do { _Pragma("unroll") for (int n = 0; n < 2; ++n) _Pragma("unroll") for (int k = 0; k < 2; ++k) dst[n][k] = *(const PG8_LAS bf16x8*)(lds + PG8_SB(b, h) + boff + n * 2048 + k * 1024); } while (0)
#define PG8_MMA(ai, bj, At, Bt) do { __builtin_amdgcn_s_setprio(1); _Pragma("unroll") for (int m = 0; m < 4; ++m) _Pragma("unroll") for (int n = 0; n < 2; ++n) _Pragma("unroll") for (int k = 0; k < 2; ++k) \
        acc[ai][bj][m][n] = __builtin_amdgcn_mfma_f32_16x16x32_bf16(Bt[n][k], At[m][k], acc[ai][bj][m][n], 0, 0, 0); __builtin_amdgcn_s_setprio(0); } while (0)
#define PG8_WAIT_V(n) asm volatile("s_waitcnt vmcnt(" #n ")" ::: "memory")
#define PG8_WAIT_L(n) asm volatile("s_waitcnt lgkmcnt(" #n ")" ::: "memory")
#define PG8_BAR __builtin_amdgcn_s_barrier()
#define PG8_SCHED __builtin_amdgcn_sched_barrier(0)
    Unit cur, nxt; int ui = 0;
    if (!S.next(0, cur)) return;
    f32x4 acc[2][2][4][2];
#pragma unroll
    for (int a = 0; a < 2; ++a)
#pragma unroll
        for (int b = 0; b < 2; ++b)
#pragma unroll
            for (int m = 0; m < 4; ++m)
#pragma unroll
                for (int n = 0; n < 2; ++n) acc[a][b][m][n] = (f32x4){0.f, 0.f, 0.f, 0.f};
    bf16x8 At[4][2], B0[2][2], B1[2][2];
    const char* cA = (const char*)g.A + (size_t)cur.pm * tstep; const char* cB = (const char*)g.Bt + (size_t)cur.pn * tstep;
    S.a_ready(cur);
    if constexpr (SP2) {
        PG8_STAGE(PG8_SB(0, 0), cB, voffB); PG8_STAGE(PG8_SB(0, 1), cB + hstep, voffB); PG8_STAGE(PG8_SA(0, 0), cA, voffA); PG8_STAGE(PG8_SA(0, 1), cA + hstep, voffA);
        if (wr == 1) PG8_BAR;
        PG8_WAIT_V(2); PG8_BAR;
        PG8_STAGE(PG8_SB(1, 0), cB + kstep, voffB); PG8_STAGE(PG8_SA(1, 0), cA + kstep, voffA); PG8_STAGE(PG8_SB(1, 1), cB + hstep + kstep, voffB);
        PG8_WAIT_V(6); PG8_BAR;
    } else {
        PG8_STAGE(PG8_SB(0, 0), cB, voffB); PG8_STAGE(PG8_SA(0, 0), cA, voffA); PG8_STAGE(PG8_SB(0, 1), cB + hstep, voffB); PG8_STAGE(PG8_SA(0, 1), cA + hstep, voffA);
        if (wr == 1) PG8_BAR;
        PG8_WAIT_V(4); PG8_BAR;
        PG8_STAGE(PG8_SB(1, 0), cB + kstep, voffB); PG8_STAGE(PG8_SA(1, 0), cA + kstep, voffA); PG8_STAGE(PG8_SB(1, 1), cB + hstep + kstep, voffB);
        PG8_WAIT_V(6); PG8_BAR;
    }
    for (;;) {
        const bool has_next = S.next(ui + 1, nxt);
        const char* nA = has_next ? (const char*)g.A + (size_t)nxt.pm * tstep : cA; const char* nB = has_next ? (const char*)g.Bt + (size_t)nxt.pn * tstep : cB;
        for (int t = 0; t < nt; t += 2) {
            const bool last = (t == nt - 2);
            const char* a1 = cA + (size_t)(t + 1) * kstep;
            const char* a2 = last ? nA : cA + (size_t)(t + 2) * kstep; const char* b2 = last ? nB : cB + (size_t)(t + 2) * kstep;
            const char* a3 = a2 + kstep; const char* b3 = b2 + kstep;
            if (last && has_next) S.a_ready(nxt);
            if constexpr (SP2) {
            PG8_LDB(B0, 0, 0); PG8_LDB(B1, 0, 1); PG8_SCHED; PG8_LDA(At, 0, 0); PG8_STAGE(PG8_SA(1, 1), a1 + hstep, voffA);
            PG8_WAIT_V(8); PG8_WAIT_L(0); PG8_BAR; PG8_MMA(0, 0, At, B0); PG8_MMA(0, 1, At, B1); PG8_BAR; PG8_SCHED;
            PG8_LDA(At, 0, 1); PG8_STAGE(PG8_SB(0, 0), b2, voffB); PG8_STAGE(PG8_SB(0, 1), b2 + hstep, voffB); PG8_STAGE(PG8_SA(0, 0), a2, voffA);
            PG8_WAIT_V(8); PG8_WAIT_L(0); PG8_BAR; PG8_MMA(1, 0, At, B0); PG8_MMA(1, 1, At, B1); PG8_BAR; PG8_SCHED;
            PG8_LDB(B0, 1, 0); PG8_LDB(B1, 1, 1); PG8_SCHED; PG8_LDA(At, 1, 0); PG8_STAGE(PG8_SA(0, 1), a2 + hstep, voffA);
            PG8_WAIT_V(8); PG8_WAIT_L(0); PG8_BAR; PG8_MMA(0, 0, At, B0); PG8_MMA(0, 1, At, B1); PG8_BAR; PG8_SCHED;
            PG8_LDA(At, 1, 1); PG8_STAGE(PG8_SB(1, 0), b3, voffB); PG8_STAGE(PG8_SB(1, 1), b3 + hstep, voffB); PG8_STAGE(PG8_SA(1, 0), a3, voffA);
            PG8_WAIT_V(8); PG8_WAIT_L(0); PG8_BAR; PG8_MMA(1, 0, At, B0); PG8_MMA(1, 1, At, B1); PG8_BAR; PG8_SCHED;
            } else {
            PG8_LDB(B0, 0, 0); PG8_SCHED; PG8_LDA(At, 0, 0); PG8_STAGE(PG8_SA(1, 1), a1 + hstep, voffA);
            PG8_WAIT_L(8); PG8_BAR; PG8_WAIT_L(0); PG8_MMA(0, 0, At, B0); PG8_BAR; PG8_SCHED;
            PG8_LDB(B1, 0, 1); PG8_STAGE(PG8_SB(0, 0), b2, voffB);
            PG8_BAR; PG8_WAIT_L(0); PG8_MMA(0, 1, At, B1); PG8_BAR;
            PG8_LDA(At, 0, 1); PG8_STAGE(PG8_SA(0, 0), a2, voffA);
            PG8_BAR; PG8_WAIT_L(0); PG8_MMA(1, 0, At, B0); PG8_BAR; PG8_SCHED;
            PG8_STAGE(PG8_SB(0, 1), b2 + hstep, voffB);
            PG8_WAIT_V(6); PG8_BAR; PG8_MMA(1, 1, At, B1); PG8_BAR;
            PG8_LDB(B0, 1, 0); PG8_SCHED; PG8_LDA(At, 1, 0); PG8_STAGE(PG8_SA(0, 1), a2 + hstep, voffA);
            PG8_WAIT_L(8); PG8_BAR; PG8_WAIT_L(0); PG8_MMA(0, 0, At, B0); PG8_BAR; PG8_SCHED;
            PG8_LDB(B1, 1, 1); PG8_STAGE(PG8_SB(1, 0), b3, voffB);
            PG8_BAR; PG8_WAIT_L(0); PG8_MMA(0, 1, At, B1); PG8_BAR;
            PG8_LDA(At, 1, 1); PG8_STAGE(PG8_SA(1, 0), a3, voffA);
            PG8_BAR; PG8_WAIT_L(0); PG8_MMA(1, 0, At, B0); PG8_BAR; PG8_SCHED;
            PG8_STAGE(PG8_SB(1, 1), b3 + hstep, voffB);
            PG8_WAIT_V(6); PG8_BAR; PG8_MMA(1, 1, At, B1); PG8_BAR;
            }
        }
        if constexpr (ALIGN_EPI) { if (wr == 0) PG8_BAR; }
        if constexpr (!Epi::AFTER_DRAIN) { E(acc, cur, wr, wc, fr, fq); S.done(cur); }
        if (!has_next) break;
#pragma unroll
        for (int a = 0; a < 2; ++a)
#pragma unroll
            for (int b = 0; b < 2; ++b)
#pragma unroll
                for (int m = 0; m < 4; ++m)
#pragma unroll
                    for (int n = 0; n < 2; ++n) acc[a][b][m][n] = (f32x4){0.f, 0.f, 0.f, 0.f};
        cur = nxt; cA = nA; cB = nB; ++ui;
        if constexpr (ALIGN_EPI) { if (wr == 1) PG8_BAR; }
    }
    PG8_WAIT_V(0);
    if constexpr (!ALIGN_EPI) { if (wr == 0) PG8_BAR; }
    PG8_BAR;
    if constexpr (Epi::AFTER_DRAIN) { E.fused(acc, cur, wr, wc, fr, fq, lds, wid, lane); S.done(cur); }
#undef PG8_SA
#undef PG8_SB
#undef PG8_STAGE
#undef PG8_LDA
#undef PG8_LDB
#undef PG8_MMA
#undef PG8_WAIT_V
#undef PG8_WAIT_L
#undef PG8_BAR
#undef PG8_SCHED
}
}

constexpr size_t MiB = 1u << 20;
constexpr size_t WS_CTL = 0, CTL_ZERO_BYTES = 1 * MiB;
constexpr size_t WS_WIN = 2 * MiB;
constexpr size_t WS_WOUT = 16 * MiB;
constexpr size_t WS_WST = 20 * MiB;
constexpr size_t WS_BT = 21 * MiB;
constexpr size_t WS_KMEAN = 22 * MiB;
constexpr size_t WS_LOFF = 23 * MiB;
constexpr size_t WS_ROWSS = 24 * MiB;
constexpr size_t WS_PL = 26 * MiB;
constexpr size_t WS_LIST = 30 * MiB;
constexpr size_t WS_SEL = 32 * MiB;
constexpr size_t WS_XB = 40 * MiB;
constexpr size_t WS_PO = 40 * MiB;
constexpr size_t WS_PROJ = 168 * MiB;
constexpr size_t WS_MIX = 392 * MiB;
constexpr size_t WS_END = 456 * MiB;
constexpr size_t SUBSTRIDE = (size_t)MROWS * 512;
enum { T_U = 0, T_V = 1, T_ZA = 2, T_Q = 3, T_K = 4, T_VV = 5, T_ZB = 6 };

constexpr int NWAVES = 8;
constexpr int LDS_BYTES = 160 * 1024;
constexpr int RING_BYTES = 131072;

#define LAS __attribute__((address_space(3)))
typedef unsigned short bf16;
typedef unsigned v4u __attribute__((ext_vector_type(4)));
typedef float f32x4 __attribute__((ext_vector_type(4)));
#define LDS_WAIT() asm volatile("s_waitcnt lgkmcnt(0)" ::: "memory")
__device__ __forceinline__ unsigned f2bf(float f) { unsigned u = __builtin_bit_cast(unsigned, f); return (u + 0x7fffu + ((u >> 16) & 1u)) >> 16; }
__device__ __forceinline__ unsigned pk2(float lo, float hi) { return f2bf(lo) | (f2bf(hi) << 16); }
__device__ __forceinline__ float bflo(unsigned w) { return __uint_as_float(w << 16); }
__device__ __forceinline__ float bfhi(unsigned w) { return __uint_as_float(w & 0xffff0000u); }
__device__ __forceinline__ float wave_sum(float v) {
#pragma unroll
    for (int o = 1; o < 64; o <<= 1) v += __shfl_xor(v, o);
    return v;
}

struct Args { const float* in[10]; float* out; unsigned char* ws; int layer, pad; };

struct Ctx {
    unsigned char* lds;
    int tid, lane, wave, G, bid;
    const float *x, *norm_g, *w_in, *ln_g, *ln_b, *sgu_w, *sgu_b, *w_out, *rel_bias, *final_g;
    float* out; unsigned char* ws;
};

__device__ __forceinline__ void p0_transpose_item(const float* W, const float* gs, int K, int N, bf16* WT, float* scr, int item, int lane) {
    const int nblk = N / 32, kb = item / nblk, nb = item % nblk, k0 = 64 * kb, n0 = 32 * nb;
#pragma unroll 8
    for (int i = 0; i < 32; ++i) { const int kk = 2 * i + (lane >> 5); const float sc = gs ? gs[k0 + kk] : 1.0f; scr[kk * 33 + (lane & 31)] = W[(size_t)(k0 + kk) * N + n0 + (lane & 31)] * sc; }
    LDS_WAIT(); asm volatile("" ::: "memory");
    const int c = lane & 7;
#pragma unroll
    for (int j = 0; j < 4; ++j) { const int n = (lane >> 3) + 8 * j; const float* s = scr + (8 * c) * 33 + n;
        v4u o; o.x = pk2(s[0 * 33], s[1 * 33]); o.y = pk2(s[2 * 33], s[3 * 33]); o.z = pk2(s[4 * 33], s[5 * 33]); o.w = pk2(s[6 * 33], s[7 * 33]);
        *(v4u*)(WT + (size_t)(n0 + n) * K + k0 + 8 * c) = o; }
    LDS_WAIT(); asm volatile("" ::: "memory");
}
__device__ __forceinline__ int rel_bucket(int d) {
    if (d < 16) return d;
    int b = 16;
    b += (d >= 19); b += (d >= 21); b += (d >= 24); b += (d >= 27); b += (d >= 31); b += (d >= 35); b += (d >= 40); b += (d >= 46);
    b += (d >= 52); b += (d >= 59); b += (d >= 67); b += (d >= 77); b += (d >= 87); b += (d >= 99); b += (d >= 113);
    return b;
}
__device__ __forceinline__ void phase_prologue(const Ctx& C) {
    float* scr = (float*)(C.lds + C.wave * 16384);
    const int gw = C.bid * NWAVES + C.wave, NGW = C.G * NWAVES;
    constexpr int I_IN = (DM / 64) * (DIN / 32), I_OUT = (DM / 64) * (DM / 32);
    constexpr int NITEMS = DEPTH * (I_IN + I_OUT);
    for (int it = gw; it < NITEMS; it += NGW) {
        const int l = it / (I_IN + I_OUT); int r = it % (I_IN + I_OUT);
        if (r < I_IN) p0_transpose_item(C.w_in + (size_t)l * DM * DIN, C.norm_g + l * DM, DM, DIN, (bf16*)(C.ws + WS_WIN) + (size_t)l * DIN * DM, scr, r, C.lane);
        else p0_transpose_item(C.w_out + (size_t)l * DM * DM, nullptr, DM, DM, (bf16*)(C.ws + WS_WOUT) + (size_t)l * DM * DM, scr, r - I_IN, C.lane);
    }
    { bf16* wst = (bf16*)(C.ws + WS_WST); const int gt = C.bid * 512 + C.tid, NT = C.G * 512;
      for (int e = gt; e < DEPTH * 8 * 128 * 128; e += NT) { const int s = e & 127, t = (e >> 7) & 127; wst[e] = (s <= t) ? (bf16)f2bf(C.sgu_w[e]) : (bf16)0; } }
    if (C.bid == 0) { float* bt = (float*)(C.ws + WS_BT); for (int e = C.tid; e < 8 * 128; e += 512) { const int h = e >> 7, d = e & 127; bt[e] = C.rel_bias[rel_bucket(d) * 8 + h] * LOG2E; } }
    { bf16* xb = (bf16*)(C.ws + WS_XB); float* rowss = (float*)(C.ws + WS_ROWSS);
      for (int m = gw; m < MROWS; m += NGW) {
        const f32x4* xr = (const f32x4*)(C.x + (size_t)m * DM) + C.lane;
        f32x4 v[4]; float s = 0.f;
#pragma unroll
        for (int j = 0; j < 4; ++j) { v[j] = xr[64 * j]; s += (v[j].x * v[j].x + v[j].y * v[j].y) + (v[j].z * v[j].z + v[j].w * v[j].w); }
        s = wave_sum(s);
        unsigned long long* o8 = (unsigned long long*)(xb + (size_t)m * DM) + C.lane;
#pragma unroll
        for (int j = 0; j < 4; ++j) o8[64 * j] = (unsigned long long)pk2(v[j].x, v[j].y) | ((unsigned long long)pk2(v[j].z, v[j].w) << 32);
        if (C.lane < 16) rowss[(size_t)m * 16 + C.lane] = (C.lane == 0) ? s : 0.f;
      } }
}

__device__ __forceinline__ void phase_kmean(const Ctx& C) {
    const bf16* K = (const bf16*)(C.ws + WS_PROJ) + (size_t)T_K * SUBSTRIDE;
    float* km = (float*)(C.ws + WS_KMEAN);
    float* red = (float*)C.lds;
    const int cgp = C.tid & 63, rg = C.tid >> 6;
    for (int u = C.bid; u < BATCH * NBLK; u += C.G) {
        const int b = u / NBLK, n = u % NBLK;
        float s[8];
#pragma unroll
        for (int e = 0; e < 8; ++e) s[e] = 0.f;
        for (int r = rg; r < 256; r += 8) {
            const v4u v = *(const v4u*)(K + ((size_t)(b * SEQ + n * 256 + r)) * 512 + cgp * 8);
            s[0] += bflo(v.x); s[1] += bfhi(v.x); s[2] += bflo(v.y); s[3] += bfhi(v.y); s[4] += bflo(v.z); s[5] += bfhi(v.z); s[6] += bflo(v.w); s[7] += bfhi(v.w);
        }
#pragma unroll
        for (int e = 0; e < 8; ++e) red[rg * 512 + cgp * 8 + e] = s[e];
        __syncthreads();
        { const int col = C.tid; float t = 0.f;
#pragma unroll
          for (int r = 0; r < 8; ++r) t += red[r * 512 + col];
          km[((size_t)((b * NH + (col >> 6)) * NBLK + n)) * 64 + (col & 63)] = t * (1.0f / 256.0f); }
        __syncthreads();
    }
}

__device__ __forceinline__ void phase_gate(const Ctx& C) {
    const bf16* Q = (const bf16*)(C.ws + WS_PROJ) + (size_t)T_Q * SUBSTRIDE;
    const float* KM = (const float*)(C.ws + WS_KMEAN);
    int* SEL = (int*)(C.ws + WS_SEL); int* LOFF = (int*)(C.ws + WS_LOFF); unsigned short* LIST = (unsigned short*)(C.ws + WS_LIST);
    float* km = (float*)C.lds;
    float* cval = (float*)(C.lds + 16384);
    int* cidx = (int*)(C.lds + 16384 + 3072);
    int* cnt = (int*)(C.lds + 16384 + 6144);
    int* offs = (int*)(C.lds + 16384 + 6144 + 256);
    const int q = C.tid & 255, half = C.tid >> 8;
    for (int u = C.bid; u < NBH * NBLK; u += C.G) {
        const int bh = u >> 6, i = u & 63, b = bh >> 3, h = bh & 7;
        const int pos = i * 256 + q;
        if (i == 0) { if (half == 0) { int* sp = SEL + ((size_t)bh * SEQ + pos) * 4; sp[0] = -1; sp[1] = -1; sp[2] = -1; sp[3] = -1; } continue; }
        for (int e = C.tid; e < i * 64; e += 512) km[e] = KM[(size_t)bh * NBLK * 64 + e];
        if (C.tid < 64) cnt[C.tid] = 0;
        float qv[64];
        { const v4u* qp = (const v4u*)(Q + ((size_t)(b * SEQ + pos)) * 512 + h * 64);
#pragma unroll
          for (int c = 0; c < 8; ++c) { const v4u v = qp[c]; qv[8 * c + 0] = bflo(v.x); qv[8 * c + 1] = bfhi(v.x); qv[8 * c + 2] = bflo(v.y); qv[8 * c + 3] = bfhi(v.y);
              qv[8 * c + 4] = bflo(v.z); qv[8 * c + 5] = bfhi(v.z); qv[8 * c + 6] = bflo(v.w); qv[8 * c + 7] = bfhi(v.w); } }
        __syncthreads();
        const int nmid = (i + 1) >> 1, n0 = half ? nmid : 0, n1 = half ? i : nmid;
        float b0 = -INFINITY, b1 = -INFINITY, b2 = -INFINITY; int i0 = -1, i1 = -1, i2 = -1;
#define TOP3_INS(v, idx) do { if ((v) > b0) { b2 = b1; i2 = i1; b1 = b0; i1 = i0; b0 = (v); i0 = (idx); } else if ((v) > b1) { b2 = b1; i2 = i1; b1 = (v); i1 = (idx); } else if ((v) > b2) { b2 = (v); i2 = (idx); } } while (0)
        for (int n = n0; n < n1; ++n) {
            const f32x4* kr = (const f32x4*)(km + n * 64);
            float a0 = 0.f, a1 = 0.f, a2 = 0.f, a3 = 0.f;
#pragma unroll
            for (int d4 = 0; d4 < 16; ++d4) { const f32x4 kv = kr[d4]; a0 += qv[4 * d4] * kv.x; a1 += qv[4 * d4 + 1] * kv.y; a2 += qv[4 * d4 + 2] * kv.z; a3 += qv[4 * d4 + 3] * kv.w; }
            const float g = (a0 + a1) + (a2 + a3);
            TOP3_INS(g, n);
        }
        if (half) { cval[q * 3 + 0] = b0; cval[q * 3 + 1] = b1; cval[q * 3 + 2] = b2; cidx[q * 3 + 0] = i0; cidx[q * 3 + 1] = i1; cidx[q * 3 + 2] = i2; }
        __syncthreads();
        int p0 = 0, p1 = 0, p2 = 0;
        const int nsel = i < 3 ? i : 3;
        if (!half) {
#pragma unroll
            for (int j = 0; j < 3; ++j) { const float v = cval[q * 3 + j]; const int id = cidx[q * 3 + j]; if (id >= 0) TOP3_INS(v, id); }
            if (nsel < 3) i2 = -1;
            if (nsel < 2) i1 = -1;
            int* sp = SEL + ((size_t)bh * SEQ + pos) * 4; sp[0] = i0; sp[1] = i1; sp[2] = i2; sp[3] = -1;
            p0 = atomicAdd(&cnt[i0], 1);
            if (i1 >= 0) p1 = atomicAdd(&cnt[i1], 1);
            if (i2 >= 0) p2 = atomicAdd(&cnt[i2], 1);
        }
#undef TOP3_INS
        __syncthreads();
        if (C.tid == 0) { int a = 0; for (int n = 0; n < 64; ++n) { offs[n] = a; a += cnt[n]; } offs[64] = a; }
        __syncthreads();
        if (!half) {
            unsigned short* lp = LIST + (size_t)u * 768;
            lp[offs[i0] + p0] = (unsigned short)(q | (0 << 8));
            if (i1 >= 0) lp[offs[i1] + p1] = (unsigned short)(q | (1 << 8));
            if (i2 >= 0) lp[offs[i2] + p2] = (unsigned short)(q | (2 << 8));
        }
        if (C.tid < 65) LOFF[(size_t)u * 80 + C.tid] = offs[C.tid];
        __syncthreads();
    }
}

__device__ __forceinline__ void phase_sgu_simple(const Ctx& C, int layer) {
    const bf16* U = (const bf16*)(C.ws + WS_PROJ) + (size_t)T_U * SUBSTRIDE;
    const bf16* V = (const bf16*)(C.ws + WS_PROJ) + (size_t)T_V * SUBSTRIDE;
    const bf16* ZA = (const bf16*)(C.ws + WS_PROJ) + (size_t)T_ZA * SUBSTRIDE;
    bf16* MIX = (bf16*)(C.ws + WS_MIX);
    const float* lng = C.ln_g + layer * 512; const float* lnb = C.ln_b + layer * 512;
    const float* Wl = C.sgu_w + (size_t)layer * 8 * 128 * 128; const float* bl = C.sgu_b + layer * 8 * 128;
    bf16* vh = (bf16*)C.lds;
    for (int u = C.bid; u < MROWS / 128; u += C.G) {
        const size_t row0 = (size_t)u * 128;
        for (int r = 0; r < 16; ++r) {
            const int t = C.wave * 16 + r;
            const v4u v = *(const v4u*)(V + (row0 + t) * 512 + C.lane * 8);
            float f[8] = {bflo(v.x), bfhi(v.x), bflo(v.y), bfhi(v.y), bflo(v.z), bfhi(v.z), bflo(v.w), bfhi(v.w)};
            float s = 0.f;
#pragma unroll
            for (int e = 0; e < 8; ++e) s += f[e];
            const float mean = wave_sum(s) * (1.0f / 512.0f);
            float s2 = 0.f;
#pragma unroll
            for (int e = 0; e < 8; ++e) { f[e] -= mean; s2 += f[e] * f[e]; }
            const float rstd = 1.0f / sqrtf(wave_sum(s2) * (1.0f / 512.0f) + LN_EPS);
            v4u o;
            float g8[8], b8[8];
#pragma unroll
            for (int e = 0; e < 8; ++e) { g8[e] = lng[C.lane * 8 + e]; b8[e] = lnb[C.lane * 8 + e]; }
            o.x = pk2(f[0] * rstd * g8[0] + b8[0], f[1] * rstd * g8[1] + b8[1]); o.y = pk2(f[2] * rstd * g8[2] + b8[2], f[3] * rstd * g8[3] + b8[3]);
            o.z = pk2(f[4] * rstd * g8[4] + b8[4], f[5] * rstd * g8[5] + b8[5]); o.w = pk2(f[6] * rstd * g8[6] + b8[6], f[7] * rstd * g8[7] + b8[7]);
            *(v4u*)(vh + t * 512 + C.lane * 8) = o;
        }
        __syncthreads();
        { const int c = C.tid, g = c >> 6;
          const float* Wg = Wl + (size_t)g * 128 * 128;
          for (int t = 0; t < 128; ++t) {
              float acc = 0.f;
              for (int s = 0; s <= t; ++s) acc += Wg[t * 128 + s] * __uint_as_float((unsigned)vh[s * 512 + c] << 16);
              acc += bl[g * 128 + t];
              const float uu = __uint_as_float((unsigned)U[(row0 + t) * 512 + c] << 16), zz = __uint_as_float((unsigned)ZA[(row0 + t) * 512 + c] << 16);
              MIX[(row0 + t) * 1024 + c] = (bf16)f2bf(uu * acc * zz);
          } }
        __syncthreads();
    }
}

__device__ __forceinline__ void phase_attn_simple(const Ctx& C) {
    const bf16* Q = (const bf16*)(C.ws + WS_PROJ) + (size_t)T_Q * SUBSTRIDE;
    const bf16* K = (const bf16*)(C.ws + WS_PROJ) + (size_t)T_K * SUBSTRIDE;
    const bf16* VV = (const bf16*)(C.ws + WS_PROJ) + (size_t)T_VV * SUBSTRIDE;
    const bf16* ZB = (const bf16*)(C.ws + WS_PROJ) + (size_t)T_ZB * SUBSTRIDE;
    const int* SEL = (const int*)(C.ws + WS_SEL); const float* BT = (const float*)(C.ws + WS_BT);
    bf16* MIX = (bf16*)(C.ws + WS_MIX);
    const int gt = C.bid * 512 + C.tid, NT = C.G * 512;
    for (int item = gt; item < NBH * SEQ; item += NT) {
        const int bh = item >> 14, pos = item & (SEQ - 1), b = bh >> 3, h = bh & 7, own = pos >> 8;
        const size_t rowq = (size_t)(b * SEQ + pos);
        float qv[64], o[64];
        { const v4u* qp = (const v4u*)(Q + rowq * 512 + h * 64);
#pragma unroll
          for (int c = 0; c < 8; ++c) { const v4u v = qp[c]; qv[8 * c + 0] = bflo(v.x); qv[8 * c + 1] = bfhi(v.x); qv[8 * c + 2] = bflo(v.y); qv[8 * c + 3] = bfhi(v.y);
              qv[8 * c + 4] = bflo(v.z); qv[8 * c + 5] = bfhi(v.z); qv[8 * c + 6] = bflo(v.w); qv[8 * c + 7] = bfhi(v.w); } }
#pragma unroll
        for (int d = 0; d < 64; ++d) o[d] = 0.f;
        float m = -INFINITY, l = 0.f;
        const float* bt = BT + h * 128;
        for (int slot = 0; slot < 4; ++slot) {
            int blk, klim;
            if (slot == 0) { blk = own; klim = (pos & 255) + 1; } else { blk = SEL[(size_t)item * 4 + slot - 1]; klim = 256; if (blk < 0) klim = 0; }
            for (int kl = 0; kl < klim; ++kl) {
                const int kpos = blk * 256 + kl;
                const v4u* kp = (const v4u*)(K + ((size_t)(b * SEQ + kpos)) * 512 + h * 64);
                float a0 = 0.f, a1 = 0.f;
#pragma unroll
                for (int c = 0; c < 8; ++c) { const v4u v = kp[c];
                    a0 += qv[8 * c + 0] * bflo(v.x) + qv[8 * c + 2] * bflo(v.y) + qv[8 * c + 4] * bflo(v.z) + qv[8 * c + 6] * bflo(v.w);
                    a1 += qv[8 * c + 1] * bfhi(v.x) + qv[8 * c + 3] * bfhi(v.y) + qv[8 * c + 5] * bfhi(v.z) + qv[8 * c + 7] * bfhi(v.w); }
                int dd = pos - kpos; dd = dd > 127 ? 127 : dd;
                const float s = (a0 + a1) + bt[dd];
                if (s > m) { const float al = __builtin_amdgcn_exp2f(m - s); l *= al;
#pragma unroll
                    for (int d = 0; d < 64; ++d) o[d] *= al;
                    m = s; }
                const float p = __builtin_amdgcn_exp2f(s - m);
                l += p;
                const v4u* vp = (const v4u*)(VV + ((size_t)(b * SEQ + kpos)) * 512 + h * 64);
#pragma unroll
                for (int c = 0; c < 8; ++c) { const v4u v = vp[c];
                    o[8 * c + 0] += p * bflo(v.x); o[8 * c + 1] += p * bfhi(v.x); o[8 * c + 2] += p * bflo(v.y); o[8 * c + 3] += p * bfhi(v.y);
                    o[8 * c + 4] += p * bflo(v.z); o[8 * c + 5] += p * bfhi(v.z); o[8 * c + 6] += p * bflo(v.w); o[8 * c + 7] += p * bfhi(v.w); }
            }
        }
        const float rl = 1.0f / l;
        const v4u* zp = (const v4u*)(ZB + rowq * 512 + h * 64);
        v4u* op = (v4u*)(MIX + rowq * 1024 + 512 + h * 64);
#pragma unroll
        for (int c = 0; c < 8; ++c) { const v4u z = zp[c]; v4u w;
            w.x = pk2(o[8 * c + 0] * rl * bflo(z.x), o[8 * c + 1] * rl * bfhi(z.x)); w.y = pk2(o[8 * c + 2] * rl * bflo(z.y), o[8 * c + 3] * rl * bfhi(z.y));
            w.z = pk2(o[8 * c + 4] * rl * bflo(z.z), o[8 * c + 5] * rl * bfhi(z.z)); w.w = pk2(o[8 * c + 6] * rl * bflo(z.w), o[8 * c + 7] * rl * bfhi(z.w));
            op[c] = w; }
    }
}

__device__ __forceinline__ void phase_final(const Ctx& C) {
    const float* rowss = (const float*)(C.ws + WS_ROWSS);
    const int gw = C.bid * NWAVES + C.wave, NGW = C.G * NWAVES;
    f32x4 g[4];
#pragma unroll
    for (int j = 0; j < 4; ++j) g[j] = ((const f32x4*)C.final_g)[64 * j + C.lane];
    for (int m = gw; m < MROWS; m += NGW) {
        float ss = (C.lane < 16) ? rowss[(size_t)m * 16 + C.lane] : 0.f;
        ss = wave_sum(ss);
        const float rs = 1.0f / sqrtf(ss * (1.0f / 1024.0f) + NORM_EPS);
        f32x4* xr = (f32x4*)(C.out + (size_t)m * DM) + C.lane;
#pragma unroll
        for (int j = 0; j < 4; ++j) { const f32x4 v = xr[64 * j]; xr[64 * j] = v * rs * g[j]; }
    }
}

template <int ST> __device__ __forceinline__ void run_stage(const Args& args, unsigned char* lds, int L) {
    Ctx C;
    { int t = threadIdx.x; asm volatile("" : "+v"(t)); C.tid = t; }
    C.lds = lds; C.lane = C.tid & 63; C.wave = __builtin_amdgcn_readfirstlane(C.tid >> 6); C.G = gridDim.x; C.bid = blockIdx.x;
    C.x = args.in[0]; C.norm_g = args.in[1]; C.w_in = args.in[2]; C.ln_g = args.in[3]; C.ln_b = args.in[4]; C.sgu_w = args.in[5]; C.sgu_b = args.in[6];
    C.w_out = args.in[7]; C.rel_bias = args.in[8]; C.final_g = args.in[9]; C.out = args.out; C.ws = args.ws;
    if constexpr (ST == 0) phase_prologue(C);
    else if constexpr (ST == 1) {
        pg8::Gemm g{(const pg8::bf16_t*)(C.ws + WS_XB), (const pg8::bf16_t*)(C.ws + WS_WIN) + (size_t)L * DIN * DM, MROWS, DIN, DM};
        pg8::StaticOrder S; S.init(MROWS, DIN, C.G, C.bid);
        pg8::EpiProj E{(pg8::bf16_t*)(C.ws + WS_PROJ), SUBSTRIDE, (const float*)(C.ws + WS_ROWSS)};
        pg8::gemm_phase<pg8::EpiProj, pg8::StaticOrder, true, true>((PG8_LAS unsigned char*)lds, g, S, E, C.tid);
    } else if constexpr (ST == 2) phase_kmean(C);
    else if constexpr (ST == 3) { phase_gate(C); phase_sgu_simple(C, L); }
    else if constexpr (ST == 4) phase_attn_simple(C);
    else if constexpr (ST == 5) {
        pg8::Gemm g{(const pg8::bf16_t*)(C.ws + WS_MIX), (const pg8::bf16_t*)(C.ws + WS_WOUT) + (size_t)L * DM * DM, MROWS, DM, DM};
        pg8::StaticOrder S; S.init(MROWS, DM, C.G, C.bid);
        pg8::EpiRes E{L == 0 ? C.x : (const float*)C.out, C.out, L == 0 ? (pg8::bf16_t*)(C.ws + WS_XB) : (pg8::bf16_t*)nullptr, (float*)(C.ws + WS_ROWSS)};
        pg8::gemm_phase<pg8::EpiRes, pg8::StaticOrder, true, true>((PG8_LAS unsigned char*)lds, g, S, E, C.tid);
    } else if constexpr (ST == 6) phase_final(C);
}
#define GRID_SYNC() do { __threadfence(); cg::this_grid().sync(); } while (0)
template <int SEL> __global__ void __launch_bounds__(NWAVES * 64, 2) fwd(Args args) {
    extern __shared__ __attribute__((aligned(16))) unsigned char lds[];
    if constexpr (SEL >= 0) run_stage<SEL>(args, lds, args.layer);
    else {
        run_stage<0>(args, lds, 0); GRID_SYNC();
        for (int L = 0; L < DEPTH; ++L) {
            run_stage<1>(args, lds, L); GRID_SYNC();
            run_stage<2>(args, lds, L); GRID_SYNC();
            run_stage<3>(args, lds, L); GRID_SYNC();
            run_stage<4>(args, lds, L); GRID_SYNC();
            run_stage<5>(args, lds, L); GRID_SYNC();
        }
        run_stage<6>(args, lds, 0);
    }
}

#ifndef MK_N_LAUNCHES
#define MK_N_LAUNCHES 1
#endif
template <int SEL> static void launch_stage(int grid, Args a, int layer, hipStream_t stream) {
    static bool attr = false;
    if (!attr) { (void)hipFuncSetAttribute((const void*)fwd<SEL>, hipFuncAttributeMaxDynamicSharedMemorySize, LDS_BYTES); attr = true; }
    a.layer = layer;
    hipLaunchKernelGGL(fwd<SEL>, dim3(grid), dim3(NWAVES * 64), LDS_BYTES, stream, a);
}
extern "C" void kernel_launch(void* const* d_in, const int* in_sizes, int n_in, void* d_out, int out_size, void* d_ws, size_t ws_size, hipStream_t stream) {
    static int grid = 0;
    if (grid == 0) {
        if (n_in != 10 || out_size != MROWS * DM || ws_size < WS_END) { fprintf(stderr, "kernel_launch: unexpected shapes (n_in %d out %d ws %zu)\n", n_in, out_size, ws_size); grid = -1; return; }
        int dev = 0, cus = 0;
        (void)hipGetDevice(&dev); (void)hipDeviceGetAttribute(&cus, hipDeviceAttributeMultiprocessorCount, dev);
        grid = cus;
#if MK_N_LAUNCHES == 1
        int per_cu = 0;
        if (hipFuncSetAttribute((const void*)fwd<-1>, hipFuncAttributeMaxDynamicSharedMemorySize, LDS_BYTES) != hipSuccess) { fprintf(stderr, "kernel_launch: hipFuncSetAttribute failed\n"); grid = -1; return; }
        if (hipOccupancyMaxActiveBlocksPerMultiprocessor(&per_cu, (const void*)fwd<-1>, NWAVES * 64, LDS_BYTES) != hipSuccess || per_cu < 1) { fprintf(stderr, "kernel_launch: occupancy query says %d\n", per_cu); grid = -1; return; }
        (void)hipGetLastError();
#endif
    }
    if (grid < 0) return;
    (void)hipMemsetAsync((char*)d_ws + WS_CTL, 0, CTL_ZERO_BYTES, stream);
    Args a{};
    for (int i = 0; i < 10; ++i) a.in[i] = (const float*)d_in[i];
    a.out = (float*)d_out; a.ws = (unsigned char*)d_ws;
#if MK_N_LAUNCHES == 1
    void* kargs[] = {&a};
    hipError_t e = hipLaunchCooperativeKernel((const void*)fwd<-1>, dim3(grid), dim3(NWAVES * 64), kargs, LDS_BYTES, stream);
    if (e != hipSuccess) fprintf(stderr, "kernel_launch: cooperative launch failed: %s\n", hipGetErrorString(e));
#else
    launch_stage<0>(grid, a, 0, stream);
    for (int L = 0; L < DEPTH; ++L) {
        launch_stage<1>(grid, a, L, stream); launch_stage<2>(grid, a, L, stream); launch_stage<3>(grid, a, L, stream);
        launch_stage<4>(grid, a, L, stream); launch_stage<5>(grid, a, L, stream);
    }
    launch_stage<6>(grid, a, 0, stream);
#endif
}
```

```cpp
#include <hip/hip_runtime.h>
#include <hip/hip_cooperative_groups.h>
#include <cstdio>
#include <cstdint>
namespace cg = cooperative_groups;

constexpr int BATCH = 2, SEQ = 16384, DM = 1024, MROWS = BATCH * SEQ, DIN = 3584, DSUB = 512;
constexpr int NH = 8, DH = 64, NBLK = SEQ / 256, NBH = BATCH * NH, DEPTH = 2;
constexpr float NORM_EPS = 1e-6f, LN_EPS = 1e-5f;
constexpr float LOG2E = 1.4426950408889634f;
constexpr float QSCALE = 0.125f * LOG2E;
namespace pg8 {
#define PG8_LAS __attribute__((address_space(3)))
typedef unsigned short bf16_t;
typedef short bf16x8 __attribute__((ext_vector_type(8)));
typedef float f32x4 __attribute__((ext_vector_type(4)));
typedef unsigned u32x4 __attribute__((ext_vector_type(4)));
constexpr int BM = 256, BK = 64, HALF = 128, HTB = HALF * BK * 2  , STAGE_BYTES = 8 * HTB, NXCD = 8, WGM = 8;

__host__ __device__ __forceinline__ int lds_byte(int r, int c) { const int st = (r >> 4) * 2 + (c >> 5), rr = r & 15, cc = c & 31, ob = rr * 64 + cc * 2; return st * 1024 + (ob ^ (((ob >> 9) & 1) << 5)); }
__host__ __device__ __forceinline__ void stage_rc(int b, int& R, int& C) { const int st = b / 1024, sb = b % 1024, swz = sb ^ (((sb >> 9) & 1) << 5); R = (st >> 1) * 16 + swz / 64; C = (st & 1) * 32 + (swz % 64) / 2; }
__host__ __device__ __forceinline__ int perm32(int rho) { const int n = rho >> 4, i = rho & 15; return 8 * (i >> 2) + 4 * n + (i & 3); }

struct Unit { int pm, pn; };
struct Gemm { const bf16_t* A; const bf16_t* Bt; int M, N, K; };

struct StaticOrder {
    int nM, nN, nwg, G, c;
    __host__ __device__ void init(int M, int N, int G_, int c_) { nM = M / BM; nN = N / BM; nwg = nM * nN; G = G_; c = c_; }
    __host__ __device__ bool next(int i, Unit& u) const {
        const long L = (long)i * G + c; if (L >= nwg) return false;
        int wgid = (int)L; { const int q = nwg / NXCD, r = nwg % NXCD, xcd = wgid % NXCD, off = wgid / NXCD; wgid = (xcd < r ? xcd * (q + 1) : r * (q + 1) + (xcd - r) * q) + off; }
        const int nig = WGM * nN, gid = wgid / nig, fm = gid * WGM, gsz = (nM - fm) < WGM ? (nM - fm) : WGM;
        u.pm = fm + ((wgid % nig) % gsz); u.pn = (wgid % nig) / gsz; return true;
    }
    __device__ __forceinline__ void a_ready(const Unit&) const {}
    __device__ __forceinline__ void done(const Unit&) const {}
};

__device__ __forceinline__ unsigned cvt_pk_bf16(float lo, float hi) { unsigned r; asm volatile("v_cvt_pk_bf16_f32 %0, %1, %2" : "=v"(r) : "v"(lo), "v"(hi)); return r; }
typedef float f32x2 __attribute__((ext_vector_type(2)));
typedef float f32x2 __attribute__((ext_vector_type(2)));
__device__ __forceinline__ float act_gelu(float x) {
    const float u = x * (1.0f + 0.044715f * x * x);
    const float e = __builtin_amdgcn_exp2f(u * (-2.0f * 0.7978845608028654f * 1.4426950408889634f));
    return x * __builtin_amdgcn_rcpf(1.0f + e);
}
__device__ __forceinline__ float act_silu(float x) {
    const float e = __builtin_amdgcn_exp2f(x * (-1.4426950408889634f));
    return x * __builtin_amdgcn_rcpf(1.0f + e);
}
struct EpiProj {
    static constexpr bool PERM = true, AFTER_DRAIN = false;
    bf16_t* P; size_t sub_stride; const float* rowss;
    __device__ __forceinline__ void operator()(const f32x4 (&acc)[2][2][4][2], const Unit& u, int wr, int wc, int fr, int fq) const {
        const int t = u.pn >> 1;
        bf16_t* base = P + (size_t)t * sub_stride;
        const int col0 = (u.pn & 1) * 256 + wc * 32 + 8 * fq;
        const int row0 = u.pm * BM + wr * 64 + fr;
#pragma unroll
        for (int ai = 0; ai < 2; ++ai)
#pragma unroll
            for (int m = 0; m < 4; ++m) {
                const int row = row0 + ai * HALF + m * 16;
                const f32x4* rp = (const f32x4*)(rowss + (size_t)row * 16);
                const f32x4 s0 = rp[0], s1 = rp[1], s2 = rp[2], s3 = rp[3];
                const float ss = ((s0[0] + s0[1]) + (s0[2] + s0[3])) + ((s1[0] + s1[1]) + (s1[2] + s1[3])) + ((s2[0] + s2[1]) + (s2[2] + s2[3])) + ((s3[0] + s3[1]) + (s3[2] + s3[3]));
                const float rs = __builtin_amdgcn_rsqf(ss * (1.0f / 1024.0f) + 1e-6f);
                bf16_t* rowp = base + (size_t)row * 512 + col0;
#pragma unroll
                for (int bj = 0; bj < 2; ++bj) {
                    f32x4 v0 = acc[ai][bj][m][0] * rs, v1 = acc[ai][bj][m][1] * rs;
                    if (t <= 1) {
#pragma unroll
                        for (int e = 0; e < 4; ++e) { v0[e] = act_gelu(v0[e]); v1[e] = act_gelu(v1[e]); }
                    } else if (t == 2 || t == 6) {
#pragma unroll
                        for (int e = 0; e < 4; ++e) { v0[e] = act_silu(v0[e]); v1[e] = act_silu(v1[e]); }
                    } else if (t == 3) { v0 = v0 * (0.125f * 1.4426950408889634f); v1 = v1 * (0.125f * 1.4426950408889634f); }
                    u32x4 w; w.x = cvt_pk_bf16(v0[0], v0[1]); w.y = cvt_pk_bf16(v0[2], v0[3]); w.z = cvt_pk_bf16(v1[0], v1[1]); w.w = cvt_pk_bf16(v1[2], v1[3]);
                    *(u32x4*)(rowp + bj * HALF) = w;
                }
            }
    }
};
struct EpiRes {
    static constexpr bool PERM = false, AFTER_DRAIN = false;
    const float* res; float* out; bf16_t* xb; float* rowss;
    __device__ __forceinline__ void operator()(const f32x4 (&acc)[2][2][4][2], const Unit& u, int wr, int wc, int fr, int fq) const {
        typedef unsigned u32x2v __attribute__((ext_vector_type(2)));
        const int col0 = u.pn * BM + wc * 32 + 4 * fq;
#pragma unroll
        for (int ai = 0; ai < 2; ++ai)
#pragma unroll
            for (int m = 0; m < 4; ++m) {
                const int row = u.pm * BM + ai * HALF + wr * 64 + m * 16 + fr;
                const size_t off = (size_t)row * 1024 + col0;
                float ss = 0.f;
#pragma unroll
                for (int bj = 0; bj < 2; ++bj)
#pragma unroll
                    for (int n = 0; n < 2; ++n) {
                        const f32x4 r = *(const f32x4*)(res + off + bj * HALF + n * 16);
                        const f32x4 o = r + acc[ai][bj][m][n];
                        *(f32x4*)(out + off + bj * HALF + n * 16) = o;
                        ss += (o[0] * o[0] + o[1] * o[1]) + (o[2] * o[2] + o[3] * o[3]);
                        if (xb) { u32x2v w; w.x = cvt_pk_bf16(o[0], o[1]); w.y = cvt_pk_bf16(o[2], o[3]); *(u32x2v*)(xb + off + bj * HALF + n * 16) = w; }
                    }
                ss += __shfl_xor(ss, 16); ss += __shfl_xor(ss, 32);
                if (fq == 0) rowss[(size_t)row * 16 + u.pn * 4 + wc] = ss;
            }
    }
};
template <class Epi, class Sched, bool ALIGN_EPI = false, bool SP2 = false>
__device__ __forceinline__ void gemm_phase(PG8_LAS unsigned char* lds, const Gemm g, const Sched& S, const Epi& E, const int tid) {
    const int wid = __builtin_amdgcn_readfirstlane(tid >> 6), lane = tid & 63, wr = wid >> 2, wc = wid & 3, fr = lane & 15, fq = lane >> 4;
    const int K = g.K, nt = K / BK;
    unsigned voffA[2], voffB[2];
#pragma unroll
    for (int i = 0; i < 2; ++i) { int R, C; stage_rc(tid * 16 + i * 8192, R, C); const int Rb = Epi::PERM ? ((R & ~31) + perm32(R & 31)) : R;
        voffA[i] = (unsigned)(R * K + C) * 2u; voffB[i] = (unsigned)(Rb * K + C) * 2u; }
    const size_t kstep = (size_t)(BK * 2);
    const size_t hstep = (size_t)HALF * K * 2;
    const size_t tstep = 2 * hstep;
    const unsigned ldsw = (unsigned)wid * 1024u;
    const int aoff = lds_byte(wr * 64 + fr, fq * 8), boff = lds_byte(wc * 32 + fr, fq * 8);
#define PG8_SA(b, h) (((b) * 2 + (h)) * HTB)
#define PG8_SB(b, h) ((4 + (b) * 2 + (h)) * HTB)
#define PG8_STAGE(bufoff, gbase, voff) do { _Pragma("unroll") for (int _i = 0; _i < 2; ++_i) \
        __builtin_amdgcn_global_load_lds((const unsigned*)((const char*)(gbase) + (voff)[_i]), (PG8_LAS unsigned*)(lds + (bufoff) + ldsw + _i * 8192), 16, 0, 0); } while (0)
#define PG8_LDA(dst, b, h) do { _Pragma("unroll") for (int m = 0; m < 4; ++m) _Pragma("unroll") for (int k = 0; k < 2; ++k) dst[m][k] = *(const PG8_LAS bf16x8*)(lds + PG8_SA(b, h) + aoff + m * 2048 + k * 1024); } while (0)
#define PG8_LDB(dst, b, h) do { _Pragma("unroll") for (int n = 0; n < 2; ++n) _Pragma("unroll") for (int k = 0; k < 2; ++k) dst[n][k] = *(const PG8_LAS bf16x8*)(lds + PG8_SB(b, h) + boff + n * 2048 + k * 1024); } while (0)
#define PG8_MMA(ai, bj, At, Bt) do { __builtin_amdgcn_s_setprio(1); _Pragma("unroll") for (int m = 0; m < 4; ++m) _Pragma("unroll") for (int n = 0; n < 2; ++n) _Pragma("unroll") for (int k = 0; k < 2; ++k) \
        acc[ai][bj][m][n] = __builtin_amdgcn_mfma_f32_16x16x32_bf16(Bt[n][k], At[m][k], acc[ai][bj][m][n], 0, 0, 0); __builtin_amdgcn_s_setprio(0); } while (0)
#define PG8_WAIT_V(n) asm volatile("s_waitcnt vmcnt(" #n ")" ::: "memory")
#define PG8_WAIT_L(n) asm volatile("s_waitcnt lgkmcnt(" #n ")" ::: "memory")
#define PG8_BAR __builtin_amdgcn_s_barrier()
#define PG8_SCHED __builtin_amdgcn_sched_barrier(0)
    Unit cur, nxt; int ui = 0;
    if (!S.next(0, cur)) return;
    f32x4 acc[2][2][4][2];
#pragma unroll
    for (int a = 0; a < 2; ++a)
#pragma unroll
        for (int b = 0; b < 2; ++b)
#pragma unroll
            for (int m = 0; m < 4; ++m)
#pragma unroll
                for (int n = 0; n < 2; ++n) acc[a][b][m][n] = (f32x4){0.f, 0.f, 0.f, 0.f};
    bf16x8 At[4][2], B0[2][2], B1[2][2];
    const char* cA = (const char*)g.A + (size_t)cur.pm * tstep; const char* cB = (const char*)g.Bt + (size_t)cur.pn * tstep;
    S.a_ready(cur);
    if constexpr (SP2) {
        PG8_STAGE(PG8_SB(0, 0), cB, voffB); PG8_STAGE(PG8_SB(0, 1), cB + hstep, voffB); PG8_STAGE(PG8_SA(0, 0), cA, voffA); PG8_STAGE(PG8_SA(0, 1), cA + hstep, voffA);
        if (wr == 1) PG8_BAR;
        PG8_WAIT_V(2); PG8_BAR;
        PG8_STAGE(PG8_SB(1, 0), cB + kstep, voffB); PG8_STAGE(PG8_SA(1, 0), cA + kstep, voffA); PG8_STAGE(PG8_SB(1, 1), cB + hstep + kstep, voffB);
        PG8_WAIT_V(6); PG8_BAR;
    } else {
        PG8_STAGE(PG8_SB(0, 0), cB, voffB); PG8_STAGE(PG8_SA(0, 0), cA, voffA); PG8_STAGE(PG8_SB(0, 1), cB + hstep, voffB); PG8_STAGE(PG8_SA(0, 1), cA + hstep, voffA);
        if (wr == 1) PG8_BAR;
        PG8_WAIT_V(4); PG8_BAR;
        PG8_STAGE(PG8_SB(1, 0), cB + kstep, voffB); PG8_STAGE(PG8_SA(1, 0), cA + kstep, voffA); PG8_STAGE(PG8_SB(1, 1), cB + hstep + kstep, voffB);
        PG8_WAIT_V(6); PG8_BAR;
    }
    for (;;) {
        const bool has_next = S.next(ui + 1, nxt);
        const char* nA = has_next ? (const char*)g.A + (size_t)nxt.pm * tstep : cA; const char* nB = has_next ? (const char*)g.Bt + (size_t)nxt.pn * tstep : cB;
        for (int t = 0; t < nt; t += 2) {
            const bool last = (t == nt - 2);
            const char* a1 = cA + (size_t)(t + 1) * kstep;
            const char* a2 = last ? nA : cA + (size_t)(t + 2) * kstep; const char* b2 = last ? nB : cB + (size_t)(t + 2) * kstep;
            const char* a3 = a2 + kstep; const char* b3 = b2 + kstep;
            if (last && has_next) S.a_ready(nxt);
            if constexpr (SP2) {
            PG8_LDB(B0, 0, 0); PG8_LDB(B1, 0, 1); PG8_SCHED; PG8_LDA(At, 0, 0); PG8_STAGE(PG8_SA(1, 1), a1 + hstep, voffA);
            PG8_WAIT_V(8); PG8_WAIT_L(0); PG8_BAR; PG8_MMA(0, 0, At, B0); PG8_MMA(0, 1, At, B1); PG8_BAR; PG8_SCHED;
            PG8_LDA(At, 0, 1); PG8_STAGE(PG8_SB(0, 0), b2, voffB); PG8_STAGE(PG8_SB(0, 1), b2 + hstep, voffB); PG8_STAGE(PG8_SA(0, 0), a2, voffA);
            PG8_WAIT_V(8); PG8_WAIT_L(0); PG8_BAR; PG8_MMA(1, 0, At, B0); PG8_MMA(1, 1, At, B1); PG8_BAR; PG8_SCHED;
            PG8_LDB(B0, 1, 0); PG8_LDB(B1, 1, 1); PG8_SCHED; PG8_LDA(At, 1, 0); PG8_STAGE(PG8_SA(0, 1), a2 + hstep, voffA);
            PG8_WAIT_V(8); PG8_WAIT_L(0); PG8_BAR; PG8_MMA(0, 0, At, B0); PG8_MMA(0, 1, At, B1); PG8_BAR; PG8_SCHED;
            PG8_LDA(At, 1, 1); PG8_STAGE(PG8_SB(1, 0), b3, voffB); PG8_STAGE(PG8_SB(1, 1), b3 + hstep, voffB); PG8_STAGE(PG8_SA(1, 0), a3, voffA);
            PG8_WAIT_V(8); PG8_WAIT_L(0); PG8_BAR; PG8_MMA(1, 0, At, B0); PG8_MMA(1, 1, At, B1); PG8_BAR; PG8_SCHED;
            } else {
            PG8_LDB(B0, 0, 0); PG8_SCHED; PG8_LDA(At, 0, 0); PG8_STAGE(PG8_SA(1, 1), a1 + hstep, voffA);
            PG8_WAIT_L(8); PG8_BAR; PG8_WAIT_L(0); PG8_MMA(0, 0, At, B0); PG8_BAR; PG8_SCHED;
            PG8_LDB(B1, 0, 1); PG8_STAGE(PG8_SB(0, 0), b2, voffB);
            PG8_BAR; PG8_WAIT_L(0); PG8_MMA(0, 1, At, B1); PG8_BAR;
            PG8_LDA(At, 0, 1); PG8_STAGE(PG8_SA(0, 0), a2, voffA);
            PG8_BAR; PG8_WAIT_L(0); PG8_MMA(1, 0, At, B0); PG8_BAR; PG8_SCHED;
            PG8_STAGE(PG8_SB(0, 1), b2 + hstep, voffB);
            PG8_WAIT_V(6); PG8_BAR; PG8_MMA(1, 1, At, B1); PG8_BAR;
            PG8_LDB(B0, 1, 0); PG8_SCHED; PG8_LDA(At, 1, 0); PG8_STAGE(PG8_SA(0, 1), a2 + hstep, voffA);
            PG8_WAIT_L(8); PG8_BAR; PG8_WAIT_L(0); PG8_MMA(0, 0, At, B0); PG8_BAR; PG8_SCHED;
            PG8_LDB(B1, 1, 1); PG8_STAGE(PG8_SB(1, 0), b3, voffB);
            PG8_BAR; PG8_WAIT_L(0); PG8_MMA(0, 1, At, B1); PG8_BAR;
            PG8_LDA(At, 1, 1); PG8_STAGE(PG8_SA(1, 0), a3, voffA);
            PG8_BAR; PG8_WAIT_L(0); PG8_MMA(1, 0, At, B0); PG8_BAR; PG8_SCHED;
            PG8_STAGE(PG8_SB(1, 1), b3 + hstep, voffB);
            PG8_WAIT_V(6); PG8_BAR; PG8_MMA(1, 1, At, B1); PG8_BAR;
            }
        }
        if constexpr (ALIGN_EPI) { if (wr == 0) PG8_BAR; }
        if constexpr (!Epi::AFTER_DRAIN) { E(acc, cur, wr, wc, fr, fq); S.done(cur); }
        if (!has_next) break;
#pragma unroll
        for (int a = 0; a < 2; ++a)
#pragma unroll
            for (int b = 0; b < 2; ++b)
#pragma unroll
                for (int m = 0; m < 4; ++m)
#pragma unroll
                    for (int n = 0; n < 2; ++n) acc[a][b][m][n] = (f32x4){0.f, 0.f, 0.f, 0.f};
        cur = nxt; cA = nA; cB = nB; ++ui;
        if constexpr (ALIGN_EPI) { if (wr == 1) PG8_BAR; }
    }
    PG8_WAIT_V(0);
    if constexpr (!ALIGN_EPI) { if (wr == 0) PG8_BAR; }
    PG8_BAR;
    if constexpr (Epi::AFTER_DRAIN) { E.fused(acc, cur, wr, wc, fr, fq, lds, wid, lane); S.done(cur); }
#undef PG8_SA
#undef PG8_SB
#undef PG8_STAGE
#undef PG8_LDA
#undef PG8_LDB
#undef PG8_MMA
#undef PG8_WAIT_V
#undef PG8_WAIT_L
#undef PG8_BAR
#undef PG8_SCHED
}
}

constexpr size_t MiB = 1u << 20;
constexpr size_t WS_CTL = 0, CTL_ZERO_BYTES = 1 * MiB;
constexpr size_t WS_WIN = 2 * MiB;
constexpr size_t WS_WOUT = 16 * MiB;
constexpr size_t WS_WST = 20 * MiB;
constexpr size_t WS_BT = 21 * MiB;
constexpr size_t WS_KMEAN = 22 * MiB;
constexpr size_t WS_LOFF = 23 * MiB;
constexpr size_t WS_ROWSS = 24 * MiB;
constexpr size_t WS_PL = 26 * MiB;
constexpr size_t WS_LIST = 30 * MiB;
constexpr size_t WS_SEL = 32 * MiB;
constexpr size_t WS_XB = 40 * MiB;
constexpr size_t WS_PO = 40 * MiB;
constexpr size_t WS_PROJ = 168 * MiB;
constexpr size_t WS_MIX = 392 * MiB;
constexpr size_t WS_END = 456 * MiB;
constexpr size_t SUBSTRIDE = (size_t)MROWS * 512;
enum { T_U = 0, T_V = 1, T_ZA = 2, T_Q = 3, T_K = 4, T_VV = 5, T_ZB = 6 };

#ifndef SGU_OPT
#define SGU_OPT 1
#endif
#ifndef REPEAT_MASK
#define REPEAT_MASK 0
#endif
#ifndef CHECK_ATTN
#define CHECK_ATTN 0
#endif
#ifndef CHECK_TOL_ABS
#define CHECK_TOL_ABS 2e-4f
#define CHECK_TOL_REL 0.02f
#endif
constexpr int NWAVES = 8;
constexpr int LDS_BYTES = 160 * 1024;
constexpr int RING_BYTES = 131072;

#define LAS __attribute__((address_space(3)))
typedef unsigned short bf16;
typedef unsigned v4u __attribute__((ext_vector_type(4)));
typedef float f32x4 __attribute__((ext_vector_type(4)));
#define LDS_WAIT() asm volatile("s_waitcnt lgkmcnt(0)" ::: "memory")
__device__ __forceinline__ unsigned f2bf(float f) { unsigned u = __builtin_bit_cast(unsigned, f); return (u + 0x7fffu + ((u >> 16) & 1u)) >> 16; }
__device__ __forceinline__ unsigned pk2(float lo, float hi) { return f2bf(lo) | (f2bf(hi) << 16); }
__device__ __forceinline__ float bflo(unsigned w) { return __uint_as_float(w << 16); }
__device__ __forceinline__ float bfhi(unsigned w) { return __uint_as_float(w & 0xffff0000u); }
__device__ __forceinline__ float wave_sum(float v) {
#pragma unroll
    for (int o = 1; o < 64; o <<= 1) v += __shfl_xor(v, o);
    return v;
}

struct Args { const float* in[10]; float* out; unsigned char* ws; int layer, pad; };

struct Ctx {
    unsigned char* lds;
    int tid, lane, wave, G, bid;
    const float *x, *norm_g, *w_in, *ln_g, *ln_b, *sgu_w, *sgu_b, *w_out, *rel_bias, *final_g;
    float* out; unsigned char* ws;
};

__device__ __forceinline__ void p0_transpose_item(const float* W, const float* gs, int K, int N, bf16* WT, float* scr, int item, int lane) {
    const int nblk = N / 32, kb = item / nblk, nb = item % nblk, k0 = 64 * kb, n0 = 32 * nb;
#pragma unroll 8
    for (int i = 0; i < 32; ++i) { const int kk = 2 * i + (lane >> 5); const float sc = gs ? gs[k0 + kk] : 1.0f; scr[kk * 33 + (lane & 31)] = W[(size_t)(k0 + kk) * N + n0 + (lane & 31)] * sc; }
    LDS_WAIT(); asm volatile("" ::: "memory");
    const int c = lane & 7;
#pragma unroll
    for (int j = 0; j < 4; ++j) { const int n = (lane >> 3) + 8 * j; const float* s = scr + (8 * c) * 33 + n;
        v4u o; o.x = pk2(s[0 * 33], s[1 * 33]); o.y = pk2(s[2 * 33], s[3 * 33]); o.z = pk2(s[4 * 33], s[5 * 33]); o.w = pk2(s[6 * 33], s[7 * 33]);
        *(v4u*)(WT + (size_t)(n0 + n) * K + k0 + 8 * c) = o; }
    LDS_WAIT(); asm volatile("" ::: "memory");
}
__device__ __forceinline__ int rel_bucket(int d) {
    if (d < 16) return d;
    int b = 16;
    b += (d >= 19); b += (d >= 21); b += (d >= 24); b += (d >= 27); b += (d >= 31); b += (d >= 35); b += (d >= 40); b += (d >= 46);
    b += (d >= 52); b += (d >= 59); b += (d >= 67); b += (d >= 77); b += (d >= 87); b += (d >= 99); b += (d >= 113);
    return b;
}
__device__ __forceinline__ void phase_prologue(const Ctx& C) {
    float* scr = (float*)(C.lds + C.wave * 16384);
    const int gw = C.bid * NWAVES + C.wave, NGW = C.G * NWAVES;
    constexpr int I_IN = (DM / 64) * (DIN / 32), I_OUT = (DM / 64) * (DM / 32);
    constexpr int NITEMS = DEPTH * (I_IN + I_OUT);
    for (int it = gw; it < NITEMS; it += NGW) {
        const int l = it / (I_IN + I_OUT); int r = it % (I_IN + I_OUT);
        if (r < I_IN) p0_transpose_item(C.w_in + (size_t)l * DM * DIN, C.norm_g + l * DM, DM, DIN, (bf16*)(C.ws + WS_WIN) + (size_t)l * DIN * DM, scr, r, C.lane);
        else p0_transpose_item(C.w_out + (size_t)l * DM * DM, nullptr, DM, DM, (bf16*)(C.ws + WS_WOUT) + (size_t)l * DM * DM, scr, r - I_IN, C.lane);
    }
    { bf16* wst = (bf16*)(C.ws + WS_WST); const int gt = C.bid * 512 + C.tid, NT = C.G * 512;
      for (int e = gt; e < DEPTH * 8 * 128 * 128; e += NT) { const int s = e & 127, t = (e >> 7) & 127; wst[e] = (s <= t) ? (bf16)f2bf(C.sgu_w[e]) : (bf16)0; } }
    if (C.bid == 0) { float* bt = (float*)(C.ws + WS_BT); for (int e = C.tid; e < 8 * 128; e += 512) { const int h = e >> 7, d = e & 127; bt[e] = C.rel_bias[rel_bucket(d) * 8 + h] * LOG2E; } }
    { bf16* xb = (bf16*)(C.ws + WS_XB); float* rowss = (float*)(C.ws + WS_ROWSS);
      for (int m = gw; m < MROWS; m += NGW) {
        const f32x4* xr = (const f32x4*)(C.x + (size_t)m * DM) + C.lane;
        f32x4 v[4]; float s = 0.f;
#pragma unroll
        for (int j = 0; j < 4; ++j) { v[j] = xr[64 * j]; s += (v[j].x * v[j].x + v[j].y * v[j].y) + (v[j].z * v[j].z + v[j].w * v[j].w); }
        s = wave_sum(s);
        unsigned long long* o8 = (unsigned long long*)(xb + (size_t)m * DM) + C.lane;
#pragma unroll
        for (int j = 0; j < 4; ++j) o8[64 * j] = (unsigned long long)pk2(v[j].x, v[j].y) | ((unsigned long long)pk2(v[j].z, v[j].w) << 32);
        if (C.lane < 16) rowss[(size_t)m * 16 + C.lane] = (C.lane == 0) ? s : 0.f;
      } }
}

__device__ __forceinline__ void phase_kmean(const Ctx& C) {
    const bf16* K = (const bf16*)(C.ws + WS_PROJ) + (size_t)T_K * SUBSTRIDE;
    float* km = (float*)(C.ws + WS_KMEAN);
    float* red = (float*)C.lds;
    const int cgp = C.tid & 63, rg = C.tid >> 6;
    for (int u = C.bid; u < BATCH * NBLK; u += C.G) {
        const int b = u / NBLK, n = u % NBLK;
        float s[8];
#pragma unroll
        for (int e = 0; e < 8; ++e) s[e] = 0.f;
        for (int r = rg; r < 256; r += 8) {
            const v4u v = *(const v4u*)(K + ((size_t)(b * SEQ + n * 256 + r)) * 512 + cgp * 8);
            s[0] += bflo(v.x); s[1] += bfhi(v.x); s[2] += bflo(v.y); s[3] += bfhi(v.y); s[4] += bflo(v.z); s[5] += bfhi(v.z); s[6] += bflo(v.w); s[7] += bfhi(v.w);
        }
#pragma unroll
        for (int e = 0; e < 8; ++e) red[rg * 512 + cgp * 8 + e] = s[e];
        __syncthreads();
        { const int col = C.tid; float t = 0.f;
#pragma unroll
          for (int r = 0; r < 8; ++r) t += red[r * 512 + col];
          km[((size_t)((b * NH + (col >> 6)) * NBLK + n)) * 64 + (col & 63)] = t * (1.0f / 256.0f); }
        __syncthreads();
    }
}

__device__ __forceinline__ void phase_gate(const Ctx& C) {
    const bf16* Q = (const bf16*)(C.ws + WS_PROJ) + (size_t)T_Q * SUBSTRIDE;
    const float* KM = (const float*)(C.ws + WS_KMEAN);
    int* SEL = (int*)(C.ws + WS_SEL); int* LOFF = (int*)(C.ws + WS_LOFF); unsigned short* LIST = (unsigned short*)(C.ws + WS_LIST);
    float* km = (float*)C.lds;
    float* cval = (float*)(C.lds + 16384);
    int* cidx = (int*)(C.lds + 16384 + 3072);
    int* cnt = (int*)(C.lds + 16384 + 6144);
    int* offs = (int*)(C.lds + 16384 + 6144 + 256);
    const int q = C.tid & 255, half = C.tid >> 8;
    for (int u = C.bid; u < NBH * NBLK; u += C.G) {
        const int bh = u >> 6, i = u & 63, b = bh >> 3, h = bh & 7;
        const int pos = i * 256 + q;
        if (i == 0) { if (half == 0) { int* sp = SEL + ((size_t)bh * SEQ + pos) * 4; sp[0] = -1; sp[1] = -1; sp[2] = -1; sp[3] = -1; } continue; }
        for (int e = C.tid; e < i * 64; e += 512) km[e] = KM[(size_t)bh * NBLK * 64 + e];
        if (C.tid < 64) cnt[C.tid] = 0;
        float qv[64];
        { const v4u* qp = (const v4u*)(Q + ((size_t)(b * SEQ + pos)) * 512 + h * 64);
#pragma unroll
          for (int c = 0; c < 8; ++c) { const v4u v = qp[c]; qv[8 * c + 0] = bflo(v.x); qv[8 * c + 1] = bfhi(v.x); qv[8 * c + 2] = bflo(v.y); qv[8 * c + 3] = bfhi(v.y);
              qv[8 * c + 4] = bflo(v.z); qv[8 * c + 5] = bfhi(v.z); qv[8 * c + 6] = bflo(v.w); qv[8 * c + 7] = bfhi(v.w); } }
        __syncthreads();
        const int nmid = (i + 1) >> 1, n0 = half ? nmid : 0, n1 = half ? i : nmid;
        float b0 = -INFINITY, b1 = -INFINITY, b2 = -INFINITY; int i0 = -1, i1 = -1, i2 = -1;
#define TOP3_INS(v, idx) do { if ((v) > b0) { b2 = b1; i2 = i1; b1 = b0; i1 = i0; b0 = (v); i0 = (idx); } else if ((v) > b1) { b2 = b1; i2 = i1; b1 = (v); i1 = (idx); } else if ((v) > b2) { b2 = (v); i2 = (idx); } } while (0)
        for (int n = n0; n < n1; ++n) {
            const f32x4* kr = (const f32x4*)(km + n * 64);
            float a0 = 0.f, a1 = 0.f, a2 = 0.f, a3 = 0.f;
#pragma unroll
            for (int d4 = 0; d4 < 16; ++d4) { const f32x4 kv = kr[d4]; a0 += qv[4 * d4] * kv.x; a1 += qv[4 * d4 + 1] * kv.y; a2 += qv[4 * d4 + 2] * kv.z; a3 += qv[4 * d4 + 3] * kv.w; }
            const float g = (a0 + a1) + (a2 + a3);
            TOP3_INS(g, n);
        }
        if (half) { cval[q * 3 + 0] = b0; cval[q * 3 + 1] = b1; cval[q * 3 + 2] = b2; cidx[q * 3 + 0] = i0; cidx[q * 3 + 1] = i1; cidx[q * 3 + 2] = i2; }
        __syncthreads();
        int p0 = 0, p1 = 0, p2 = 0;
        const int nsel = i < 3 ? i : 3;
        if (!half) {
#pragma unroll
            for (int j = 0; j < 3; ++j) { const float v = cval[q * 3 + j]; const int id = cidx[q * 3 + j]; if (id >= 0) TOP3_INS(v, id); }
            if (nsel < 3) i2 = -1;
            if (nsel < 2) i1 = -1;
            int* sp = SEL + ((size_t)bh * SEQ + pos) * 4; sp[0] = i0; sp[1] = i1; sp[2] = i2; sp[3] = -1;
            p0 = atomicAdd(&cnt[i0], 1);
            if (i1 >= 0) p1 = atomicAdd(&cnt[i1], 1);
            if (i2 >= 0) p2 = atomicAdd(&cnt[i2], 1);
        }
#undef TOP3_INS
        __syncthreads();
        if (C.tid == 0) { int a = 0; for (int n = 0; n < 64; ++n) { offs[n] = a; a += cnt[n]; } offs[64] = a; }
        __syncthreads();
        if (!half) {
            unsigned short* lp = LIST + (size_t)u * 768;
            lp[offs[i0] + p0] = (unsigned short)(q | (0 << 8));
            if (i1 >= 0) lp[offs[i1] + p1] = (unsigned short)(q | (1 << 8));
            if (i2 >= 0) lp[offs[i2] + p2] = (unsigned short)(q | (2 << 8));
        }
        if (C.tid < 65) LOFF[(size_t)u * 80 + C.tid] = offs[C.tid];
        __syncthreads();
    }
}

__device__ __forceinline__ void phase_sgu_simple(const Ctx& C, int layer) {
    const bf16* U = (const bf16*)(C.ws + WS_PROJ) + (size_t)T_U * SUBSTRIDE;
    const bf16* V = (const bf16*)(C.ws + WS_PROJ) + (size_t)T_V * SUBSTRIDE;
    const bf16* ZA = (const bf16*)(C.ws + WS_PROJ) + (size_t)T_ZA * SUBSTRIDE;
    bf16* MIX = (bf16*)(C.ws + WS_MIX);
    const float* lng = C.ln_g + layer * 512; const float* lnb = C.ln_b + layer * 512;
    const float* Wl = C.sgu_w + (size_t)layer * 8 * 128 * 128; const float* bl = C.sgu_b + layer * 8 * 128;
    bf16* vh = (bf16*)C.lds;
    for (int u = C.bid; u < MROWS / 128; u += C.G) {
        const size_t row0 = (size_t)u * 128;
        for (int r = 0; r < 16; ++r) {
            const int t = C.wave * 16 + r;
            const v4u v = *(const v4u*)(V + (row0 + t) * 512 + C.lane * 8);
            float f[8] = {bflo(v.x), bfhi(v.x), bflo(v.y), bfhi(v.y), bflo(v.z), bfhi(v.z), bflo(v.w), bfhi(v.w)};
            float s = 0.f;
#pragma unroll
            for (int e = 0; e < 8; ++e) s += f[e];
            const float mean = wave_sum(s) * (1.0f / 512.0f);
            float s2 = 0.f;
#pragma unroll
            for (int e = 0; e < 8; ++e) { f[e] -= mean; s2 += f[e] * f[e]; }
            const float rstd = 1.0f / sqrtf(wave_sum(s2) * (1.0f / 512.0f) + LN_EPS);
            v4u o;
            float g8[8], b8[8];
#pragma unroll
            for (int e = 0; e < 8; ++e) { g8[e] = lng[C.lane * 8 + e]; b8[e] = lnb[C.lane * 8 + e]; }
            o.x = pk2(f[0] * rstd * g8[0] + b8[0], f[1] * rstd * g8[1] + b8[1]); o.y = pk2(f[2] * rstd * g8[2] + b8[2], f[3] * rstd * g8[3] + b8[3]);
            o.z = pk2(f[4] * rstd * g8[4] + b8[4], f[5] * rstd * g8[5] + b8[5]); o.w = pk2(f[6] * rstd * g8[6] + b8[6], f[7] * rstd * g8[7] + b8[7]);
            *(v4u*)(vh + t * 512 + C.lane * 8) = o;
        }
        __syncthreads();
        { const int c = C.tid, g = c >> 6;
          const float* Wg = Wl + (size_t)g * 128 * 128;
          for (int t = 0; t < 128; ++t) {
              float acc = 0.f;
              for (int s = 0; s <= t; ++s) acc += Wg[t * 128 + s] * __uint_as_float((unsigned)vh[s * 512 + c] << 16);
              acc += bl[g * 128 + t];
              const float uu = __uint_as_float((unsigned)U[(row0 + t) * 512 + c] << 16), zz = __uint_as_float((unsigned)ZA[(row0 + t) * 512 + c] << 16);
              MIX[(row0 + t) * 1024 + c] = (bf16)f2bf(uu * acc * zz);
          } }
        __syncthreads();
    }
}

__device__ __forceinline__ void phase_attn_simple(const Ctx& C, bf16* MIX) {
    const bf16* Q = (const bf16*)(C.ws + WS_PROJ) + (size_t)T_Q * SUBSTRIDE;
    const bf16* K = (const bf16*)(C.ws + WS_PROJ) + (size_t)T_K * SUBSTRIDE;
    const bf16* VV = (const bf16*)(C.ws + WS_PROJ) + (size_t)T_VV * SUBSTRIDE;
    const bf16* ZB = (const bf16*)(C.ws + WS_PROJ) + (size_t)T_ZB * SUBSTRIDE;
    const int* SEL = (const int*)(C.ws + WS_SEL); const float* BT = (const float*)(C.ws + WS_BT);
    const int gt = C.bid * 512 + C.tid, NT = C.G * 512;
    for (int item = gt; item < NBH * SEQ; item += NT) {
        const int bh = item >> 14, pos = item & (SEQ - 1), b = bh >> 3, h = bh & 7, own = pos >> 8;
        const size_t rowq = (size_t)(b * SEQ + pos);
        float qv[64], o[64];
        { const v4u* qp = (const v4u*)(Q + rowq * 512 + h * 64);
#pragma unroll
          for (int c = 0; c < 8; ++c) { const v4u v = qp[c]; qv[8 * c + 0] = bflo(v.x); qv[8 * c + 1] = bfhi(v.x); qv[8 * c + 2] = bflo(v.y); qv[8 * c + 3] = bfhi(v.y);
              qv[8 * c + 4] = bflo(v.z); qv[8 * c + 5] = bfhi(v.z); qv[8 * c + 6] = bflo(v.w); qv[8 * c + 7] = bfhi(v.w); } }
#pragma unroll
        for (int d = 0; d < 64; ++d) o[d] = 0.f;
        float m = -INFINITY, l = 0.f;
        const float* bt = BT + h * 128;
        for (int slot = 0; slot < 4; ++slot) {
            int blk, klim;
            if (slot == 0) { blk = own; klim = (pos & 255) + 1; } else { blk = SEL[(size_t)item * 4 + slot - 1]; klim = 256; if (blk < 0) klim = 0; }
            for (int kl = 0; kl < klim; ++kl) {
                const int kpos = blk * 256 + kl;
                const v4u* kp = (const v4u*)(K + ((size_t)(b * SEQ + kpos)) * 512 + h * 64);
                float a0 = 0.f, a1 = 0.f;
#pragma unroll
                for (int c = 0; c < 8; ++c) { const v4u v = kp[c];
                    a0 += qv[8 * c + 0] * bflo(v.x) + qv[8 * c + 2] * bflo(v.y) + qv[8 * c + 4] * bflo(v.z) + qv[8 * c + 6] * bflo(v.w);
                    a1 += qv[8 * c + 1] * bfhi(v.x) + qv[8 * c + 3] * bfhi(v.y) + qv[8 * c + 5] * bfhi(v.z) + qv[8 * c + 7] * bfhi(v.w); }
                int dd = pos - kpos; dd = dd > 127 ? 127 : dd;
                const float s = (a0 + a1) + bt[dd];
                if (s > m) { const float al = __builtin_amdgcn_exp2f(m - s); l *= al;
#pragma unroll
                    for (int d = 0; d < 64; ++d) o[d] *= al;
                    m = s; }
                const float p = __builtin_amdgcn_exp2f(s - m);
                l += p;
                const v4u* vp = (const v4u*)(VV + ((size_t)(b * SEQ + kpos)) * 512 + h * 64);
#pragma unroll
                for (int c = 0; c < 8; ++c) { const v4u v = vp[c];
                    o[8 * c + 0] += p * bflo(v.x); o[8 * c + 1] += p * bfhi(v.x); o[8 * c + 2] += p * bflo(v.y); o[8 * c + 3] += p * bfhi(v.y);
                    o[8 * c + 4] += p * bflo(v.z); o[8 * c + 5] += p * bfhi(v.z); o[8 * c + 6] += p * bflo(v.w); o[8 * c + 7] += p * bfhi(v.w); }
            }
        }
        const float rl = 1.0f / l;
        const v4u* zp = (const v4u*)(ZB + rowq * 512 + h * 64);
        v4u* op = (v4u*)(MIX + rowq * 1024 + 512 + h * 64);
#pragma unroll
        for (int c = 0; c < 8; ++c) { const v4u z = zp[c]; v4u w;
            w.x = pk2(o[8 * c + 0] * rl * bflo(z.x), o[8 * c + 1] * rl * bfhi(z.x)); w.y = pk2(o[8 * c + 2] * rl * bflo(z.y), o[8 * c + 3] * rl * bfhi(z.y));
            w.z = pk2(o[8 * c + 4] * rl * bflo(z.z), o[8 * c + 5] * rl * bfhi(z.z)); w.w = pk2(o[8 * c + 6] * rl * bflo(z.w), o[8 * c + 7] * rl * bfhi(z.w));
            op[c] = w; }
    }
}

typedef short bf16x8 __attribute__((ext_vector_type(8)));
typedef short bf16x4s __attribute__((ext_vector_type(4)));
typedef float f32x16 __attribute__((ext_vector_type(16)));
constexpr int AT_KS = 0, AT_KPITCH = 144;
constexpr int AT_VT = 36864, AT_VPITCH = 520;
constexpr int AT_DT = AT_VT + 64 * AT_VPITCH;
constexpr int AT_ENT = AT_DT + 512, AT_CAP = 4096;
constexpr int AT_PRE = AT_ENT + AT_CAP * 4;
constexpr int AT_OST = AT_PRE + 1024;
constexpr int AT_MISC = AT_OST + 8 * 4096;
constexpr int AT_NSEL_A = 60 * NBH, AT_NOWN = NBLK * NBH, AT_NUNITS = 63 * NBH + AT_NOWN;
__device__ __forceinline__ int crow(int r, int hi) { return (r & 3) + 8 * (r >> 2) + 4 * hi; }
__device__ __forceinline__ unsigned cvtpk(float lo, float hi) { unsigned r; asm volatile("v_cvt_pk_bf16_f32 %0, %1, %2" : "=v"(r) : "v"(lo), "v"(hi)); return r; }

template <bool OWN>
__device__ __forceinline__ void attn_tile(const Ctx& C, unsigned char* lds, int b, int h, int bh, int e0, int cnt, int nkt2) {
    const bf16* Q = (const bf16*)(C.ws + WS_PROJ) + (size_t)T_Q * SUBSTRIDE;
    bf16* PO = (bf16*)(C.ws + WS_PO); float* PL = (float*)(C.ws + WS_PL);
    const unsigned* ENT = (const unsigned*)(lds + AT_ENT);
    const float* DT = (const float*)(lds + AT_DT);
    const int lane = C.lane, q = lane & 31, hi = lane >> 5;
    const unsigned ent = ENT[(e0 + q < cnt) ? (e0 + q) : e0];
    const int pos = ent & 16383, qoff = (ent >> 16) & 1023;
    const bf16* qrow = Q + ((size_t)(b * SEQ + pos)) * 512 + h * 64 + hi * 8;
    bf16x8 qf[4];
#pragma unroll
    for (int ks = 0; ks < 4; ++ks) qf[ks] = *(const bf16x8*)(qrow + ks * 16);
    f32x16 o0 = {}, o1 = {};
    float l = 0.f;
    const bool anybias = OWN ? true : (__any(qoff < 112) != 0);
    const unsigned char* kbase = lds + AT_KS + q * AT_KPITCH + hi * 16;
    const unsigned char* vbase = lds + AT_VT + q * AT_VPITCH + hi * 8;
    for (int kt2 = 0; kt2 < nkt2; ++kt2) {
        f32x16 p0 = {}, p1 = {};
#pragma unroll
        for (int ks = 0; ks < 4; ++ks) {
            const bf16x8 k0 = *(const bf16x8*)(kbase + (64 * kt2) * AT_KPITCH + ks * 32);
            const bf16x8 k1 = *(const bf16x8*)(kbase + (64 * kt2 + 32) * AT_KPITCH + ks * 32);
            p0 = __builtin_amdgcn_mfma_f32_32x32x16_bf16(k0, qf[ks], p0, 0, 0, 0);
            p1 = __builtin_amdgcn_mfma_f32_32x32x16_bf16(k1, qf[ks], p1, 0, 0, 0);
        }
        if (anybias && (OWN || kt2 >= 2)) {
            const int dq = (OWN ? 0 : 256) + qoff - 64 * kt2;
#pragma unroll
            for (int r = 0; r < 16; ++r) {
                const int d0 = dq - crow(r, hi), d1 = d0 - 32;
                const float b0 = DT[d0 < 0 ? 0 : (d0 > 127 ? 127 : d0)], b1 = DT[d1 < 0 ? 0 : (d1 > 127 ? 127 : d1)];
                p0[r] = (OWN && d0 < 0) ? -INFINITY : p0[r] + b0;
                p1[r] = (OWN && d1 < 0) ? -INFINITY : p1[r] + b1;
            }
        }
#pragma unroll
        for (int r = 0; r < 16; ++r) { p0[r] = __builtin_amdgcn_exp2f(p0[r]); p1[r] = __builtin_amdgcn_exp2f(p1[r]); }
        float sa = 0.f, sb = 0.f;
#pragma unroll
        for (int r = 0; r < 16; ++r) { sa += p0[r]; sb += p1[r]; }
        l += sa + sb;
        v4u pa[4];
#pragma unroll
        for (int s = 0; s < 2; ++s) {
            pa[s] = (v4u){cvtpk(p0[8 * s + 0], p0[8 * s + 1]), cvtpk(p0[8 * s + 2], p0[8 * s + 3]), cvtpk(p0[8 * s + 4], p0[8 * s + 5]), cvtpk(p0[8 * s + 6], p0[8 * s + 7])};
            pa[2 + s] = (v4u){cvtpk(p1[8 * s + 0], p1[8 * s + 1]), cvtpk(p1[8 * s + 2], p1[8 * s + 3]), cvtpk(p1[8 * s + 4], p1[8 * s + 5]), cvtpk(p1[8 * s + 6], p1[8 * s + 7])};
        }
#pragma unroll
        for (int s = 0; s < 4; ++s) {
            const unsigned char* vp = vbase + (64 * kt2 + 16 * s) * 2;
            const bf16x4s a0 = *(const bf16x4s*)(vp), a1 = *(const bf16x4s*)(vp + 16);
            const bf16x4s c0 = *(const bf16x4s*)(vp + 32 * AT_VPITCH), c1 = *(const bf16x4s*)(vp + 32 * AT_VPITCH + 16);
            const bf16x8 vb0 = (bf16x8){a0[0], a0[1], a0[2], a0[3], a1[0], a1[1], a1[2], a1[3]};
            const bf16x8 vb1 = (bf16x8){c0[0], c0[1], c0[2], c0[3], c1[0], c1[1], c1[2], c1[3]};
            const bf16x8 paf = __builtin_bit_cast(bf16x8, pa[s]);
            o0 = __builtin_amdgcn_mfma_f32_32x32x16_bf16(paf, vb0, o0, 0, 0, 0);
            o1 = __builtin_amdgcn_mfma_f32_32x32x16_bf16(paf, vb1, o1, 0, 0, 0);
        }
    }
    l += __shfl_xor(l, 32);
    bf16* stg = (bf16*)(lds + AT_OST + C.wave * 4096);
#pragma unroll
    for (int r = 0; r < 16; ++r) { const int orow = crow(r, hi); stg[orow * 64 + q] = (bf16)f2bf(o0[r]); stg[orow * 64 + 32 + q] = (bf16)f2bf(o1[r]); }
    LDS_WAIT(); asm volatile("" ::: "memory");
#pragma unroll
    for (int it = 0; it < 4; ++it) {
        const int row = it * 8 + (lane >> 3), ch = lane & 7;
        if (e0 + row < cnt) {
            const unsigned er = ENT[e0 + row];
            const int pr = er & 16383, jr = (er >> 14) & 3;
            *(v4u*)(PO + (((size_t)bh * SEQ + pr) * 4 + jr) * 64 + ch * 8) = *(const v4u*)(stg + row * 64 + ch * 8);
        }
    }
    if (hi == 0 && e0 + q < cnt) PL[((size_t)bh * SEQ + pos) * 4 + ((ent >> 14) & 3)] = l;
    LDS_WAIT(); asm volatile("" ::: "memory");
}

__device__ __forceinline__ void phase_attn(const Ctx& C, int layer) {
    unsigned char* lds = C.lds;
    const bf16* K = (const bf16*)(C.ws + WS_PROJ) + (size_t)T_K * SUBSTRIDE;
    const bf16* VV = (const bf16*)(C.ws + WS_PROJ) + (size_t)T_VV * SUBSTRIDE;
    const int* LOFF = (const int*)(C.ws + WS_LOFF); const unsigned short* LIST = (const unsigned short*)(C.ws + WS_LIST);
    const float* BT = (const float*)(C.ws + WS_BT);
    unsigned* ctr = (unsigned*)(C.ws + WS_CTL) + 64 + 64 * layer;
    unsigned* ENT = (unsigned*)(lds + AT_ENT);
    int* PRE = (int*)(lds + AT_PRE); int* LO = PRE + 68;
    volatile unsigned* MISC = (volatile unsigned*)(lds + AT_MISC);
    const int tid = C.tid;
    for (;;) {
        if (tid == 0) MISC[0] = atomicAdd(ctr, 1u);
        __syncthreads();
        const int u = (int)MISC[0];
        if (u >= AT_NUNITS) break;
        bool own; int bh, n;
        if (u < AT_NSEL_A) { own = false; n = u >> 4; bh = u & 15; }
        else if (u < AT_NSEL_A + AT_NOWN) { own = true; const int k = u - AT_NSEL_A; n = 63 - (k >> 4); bh = k & 15; }
        else { own = false; const int k = u - AT_NSEL_A - AT_NOWN; n = 60 + (k >> 4); bh = k & 15; }
        const int b = bh >> 3, h = bh & 7;
        { const bf16* Kg = K + ((size_t)(b * SEQ + n * 256)) * 512 + h * 64;
          const bf16* Vg = VV + ((size_t)(b * SEQ + n * 256)) * 512 + h * 64;
#pragma unroll
          for (int it = 0; it < 4; ++it) { const int idx = tid + 512 * it, row = idx >> 3, ch = idx & 7;
              *(v4u*)(lds + AT_KS + row * AT_KPITCH + ch * 16) = *(const v4u*)(Kg + (size_t)row * 512 + ch * 8); }
#pragma unroll
          for (int it = 0; it < 4; ++it) { const int idx = tid + 512 * it, ch = idx >> 8, kv = idx & 255;
              const v4u v = *(const v4u*)(Vg + (size_t)kv * 512 + ch * 8);
              unsigned short* vt = (unsigned short*)(lds + AT_VT + (8 * ch) * AT_VPITCH + kv * 2);
              vt[0 * (AT_VPITCH / 2)] = (unsigned short)(v.x & 0xffff); vt[1 * (AT_VPITCH / 2)] = (unsigned short)(v.x >> 16);
              vt[2 * (AT_VPITCH / 2)] = (unsigned short)(v.y & 0xffff); vt[3 * (AT_VPITCH / 2)] = (unsigned short)(v.y >> 16);
              vt[4 * (AT_VPITCH / 2)] = (unsigned short)(v.z & 0xffff); vt[5 * (AT_VPITCH / 2)] = (unsigned short)(v.z >> 16);
              vt[6 * (AT_VPITCH / 2)] = (unsigned short)(v.w & 0xffff); vt[7 * (AT_VPITCH / 2)] = (unsigned short)(v.w >> 16); }
          if (tid < 128) ((float*)(lds + AT_DT))[tid] = BT[h * 128 + tid] - BT[h * 128 + 127]; }
        int total;
        if (own) total = 256;
        else {
            if (tid < 64) {
                const int i = n + 1 + tid; int c = 0, lo = 0;
                if (i < NBLK) { const int* lp = LOFF + ((size_t)(bh * NBLK + i)) * 80 + n; lo = lp[0]; c = lp[1] - lo; }
                int inc = c;
#pragma unroll
                for (int o = 1; o < 64; o <<= 1) { const int t = __shfl_up(inc, o); if (tid >= o) inc += t; }
                PRE[tid + 1] = inc; LO[tid] = lo; if (tid == 0) PRE[0] = 0;
            }
            __syncthreads();
            total = PRE[63 - n];
        }
        for (int base = 0; base < total; base += AT_CAP) {
            const int cnt = (total - base < AT_CAP) ? (total - base) : AT_CAP;
            if (own) { if (tid < 256) ENT[tid] = (unsigned)(n * 256 + tid) | (3u << 14) | ((unsigned)tid << 16); }
            else {
                for (int ii = C.wave; ii < 63 - n; ii += 8) {
                    const int i = n + 1 + ii, s0 = PRE[ii], s1 = PRE[ii + 1];
                    const int lo = s0 > base ? s0 : base, hi_ = s1 < base + cnt ? s1 : base + cnt;
                    const unsigned short* lp = LIST + ((size_t)(bh * NBLK + i)) * 768 + LO[ii];
                    for (int e = lo + C.lane; e < hi_; e += 64) {
                        const unsigned val = lp[e - s0]; const unsigned ql = val & 255u, j = val >> 8;
                        ENT[e - base] = (unsigned)(i * 256 + ql) | (j << 14) | ((ii == 0 ? ql : 1023u) << 16);
                    }
                }
            }
            __syncthreads();
            const int ntiles = (cnt + 31) >> 5;
            for (int tile = C.wave; tile < ntiles; tile += 8) {
                if (own) attn_tile<true>(C, lds, b, h, bh, tile * 32, cnt, (tile >> 1) + 1);
                else attn_tile<false>(C, lds, b, h, bh, tile * 32, cnt, 4);
            }
            __syncthreads();
        }
        __syncthreads();
    }
}

__device__ __forceinline__ void phase_combine(const Ctx& C) {
    const bf16* PO = (const bf16*)(C.ws + WS_PO); const float* PL = (const float*)(C.ws + WS_PL);
    const bf16* ZB = (const bf16*)(C.ws + WS_PROJ) + (size_t)T_ZB * SUBSTRIDE;
    bf16* MIX = (bf16*)(C.ws + WS_MIX);
    const int gt = C.bid * 512 + C.tid, NT = C.G * 512;
    for (int idx = gt; idx < MROWS * 64; idx += NT) {
        const int ch = idx & 7, h = (idx >> 3) & 7, row = idx >> 6, b = row >> 14, pos = row & (SEQ - 1), i = pos >> 8;
        const size_t pb = ((size_t)(b * NH + h) * SEQ + pos) * 4;
        const f32x4 lv = *(const f32x4*)(PL + pb);
        float L = lv[3];
        float acc[8];
        { const v4u v = *(const v4u*)(PO + (pb + 3) * 64 + ch * 8);
          acc[0] = bflo(v.x); acc[1] = bfhi(v.x); acc[2] = bflo(v.y); acc[3] = bfhi(v.y); acc[4] = bflo(v.z); acc[5] = bfhi(v.z); acc[6] = bflo(v.w); acc[7] = bfhi(v.w); }
#pragma unroll
        for (int j = 0; j < 3; ++j) if (j < i) {
            const v4u v = *(const v4u*)(PO + (pb + j) * 64 + ch * 8);
            L += lv[j];
            acc[0] += bflo(v.x); acc[1] += bfhi(v.x); acc[2] += bflo(v.y); acc[3] += bfhi(v.y); acc[4] += bflo(v.z); acc[5] += bfhi(v.z); acc[6] += bflo(v.w); acc[7] += bfhi(v.w);
        }
        const float rl = 1.0f / L;
        const v4u z = *(const v4u*)(ZB + (size_t)row * 512 + h * 64 + ch * 8);
        v4u w;
        w.x = pk2(acc[0] * rl * bflo(z.x), acc[1] * rl * bfhi(z.x)); w.y = pk2(acc[2] * rl * bflo(z.y), acc[3] * rl * bfhi(z.y));
        w.z = pk2(acc[4] * rl * bflo(z.z), acc[5] * rl * bfhi(z.z)); w.w = pk2(acc[6] * rl * bflo(z.w), acc[7] * rl * bfhi(z.w));
        *(v4u*)(MIX + (size_t)row * 1024 + 512 + h * 64 + ch * 8) = w;
    }
}

constexpr int SG_VPITCH = 272, SG_MPITCH = 144, SG_WREG = 128 * SG_MPITCH;
constexpr int SG_STATS = 8 * SG_WREG;
constexpr int SG_MR = SG_STATS + 8192;
constexpr int SG_LN = SG_MR + 1024;
__device__ __forceinline__ void phase_sgu(const Ctx& C, int layer) {
    typedef float f32x2v __attribute__((ext_vector_type(2)));
    unsigned char* lds = C.lds;
    const bf16* U = (const bf16*)(C.ws + WS_PROJ) + (size_t)T_U * SUBSTRIDE;
    const bf16* V = (const bf16*)(C.ws + WS_PROJ) + (size_t)T_V * SUBSTRIDE;
    const bf16* ZA = (const bf16*)(C.ws + WS_PROJ) + (size_t)T_ZA * SUBSTRIDE;
    bf16* MIX = (bf16*)(C.ws + WS_MIX);
    const int g = C.wave; int lane = C.lane;
    const float* lng = C.ln_g + layer * 512 + g * 64; const float* lnb = C.ln_b + layer * 512 + g * 64;
    const bf16* Wg = (const bf16*)(C.ws + WS_WST) + ((size_t)(layer * 8 + g)) * 128 * 128;
    const float* bg = C.sgu_b + (layer * 8 + g) * 128;
    unsigned char* myreg = lds + g * SG_WREG;
    f32x2v* stats = (f32x2v*)(lds + SG_STATS); f32x2v* mr = (f32x2v*)(lds + SG_MR);
    float* lnl = (float*)(lds + SG_LN + g * 512);
    lnl[lane] = lng[lane]; lnl[64 + lane] = lnb[lane];
    for (int u = C.bid; u < MROWS / 128; u += C.G) {
        const size_t row0 = (size_t)u * 128;
        asm volatile("" : "+v"(lane));
        v4u xv[2][8];
#pragma unroll
        for (int rr = 0; rr < 2; ++rr) {
            const v4u* vp = (const v4u*)(V + (row0 + lane + 64 * rr) * 512 + g * 64);
#pragma unroll
            for (int c = 0; c < 8; ++c) xv[rr][c] = vp[c];
        }
#pragma unroll
        for (int rr = 0; rr < 2; ++rr) {
            float s1 = 0.f, s2 = 0.f;
#pragma unroll
            for (int c = 0; c < 8; ++c) { const v4u v = xv[rr][c];
                const float f0 = bflo(v.x), f1 = bfhi(v.x), f2 = bflo(v.y), f3 = bfhi(v.y), f4 = bflo(v.z), f5 = bfhi(v.z), f6 = bflo(v.w), f7 = bfhi(v.w);
                s1 += ((f0 + f1) + (f2 + f3)) + ((f4 + f5) + (f6 + f7));
                s2 += ((f0 * f0 + f1 * f1) + (f2 * f2 + f3 * f3)) + ((f4 * f4 + f5 * f5) + (f6 * f6 + f7 * f7)); }
            stats[g * 128 + lane + 64 * rr] = (f32x2v){s1, s2};
        }
        __syncthreads();
        if (C.tid < 128) {
            float s1 = 0.f, s2 = 0.f;
#pragma unroll
            for (int w = 0; w < 8; ++w) { const f32x2v t = stats[w * 128 + C.tid]; s1 += t.x; s2 += t.y; }
            const float mean = s1 * (1.0f / 512.0f), var = s2 * (1.0f / 512.0f) - mean * mean;
            mr[C.tid] = (f32x2v){mean, 1.0f / sqrtf(var + LN_EPS)};
        }
        __syncthreads();
#pragma unroll
        for (int c = 0; c < 8; ++c) asm volatile("" : "+v"(xv[0][c]), "+v"(xv[1][c]));
        { const f32x2v m0 = mr[lane], m1 = mr[lane + 64];
          unsigned short* vt = (unsigned short*)(myreg + lane * 2);
#pragma unroll
          for (int c = 0; c < 8; ++c) {
              const v4u v0 = xv[0][c], v1 = xv[1][c];
              const float f0[8] = {bflo(v0.x), bfhi(v0.x), bflo(v0.y), bfhi(v0.y), bflo(v0.z), bfhi(v0.z), bflo(v0.w), bfhi(v0.w)};
              const float f1[8] = {bflo(v1.x), bfhi(v1.x), bflo(v1.y), bfhi(v1.y), bflo(v1.z), bfhi(v1.z), bflo(v1.w), bfhi(v1.w)};
#pragma unroll
              for (int e = 0; e < 8; ++e) { const int d = 8 * c + e; const float gg = lnl[d], bbv = lnl[64 + d];
                  vt[d * (SG_VPITCH / 2)] = (unsigned short)f2bf((f0[e] - m0.x) * m0.y * gg + bbv);
                  vt[d * (SG_VPITCH / 2) + 64] = (unsigned short)f2bf((f1[e] - m1.x) * m1.y * gg + bbv); }
              asm volatile("" ::: "memory");
          } }
        LDS_WAIT(); asm volatile("" ::: "memory");
        { const int q = lane & 31, hi = lane >> 5;
          const bf16* wa = Wg + (size_t)q * 128 + hi * 8;
          unsigned pk[2][4][8];
#pragma unroll
          for (int dt = 0; dt < 2; ++dt) {
              const unsigned char* bb = myreg + (32 * dt + q) * SG_VPITCH + hi * 16;
              f32x16 acc[4];
#pragma unroll
              for (int tt = 0; tt < 4; ++tt) acc[tt] = (f32x16){};
              bf16x8 an[4];
#pragma unroll
              for (int tt = 0; tt < 4; ++tt) an[tt] = *(const bf16x8*)(wa + (size_t)tt * 32 * 128);
#pragma unroll
              for (int ks = 0; ks < 8; ++ks) {
                  bf16x8 ac[4];
#pragma unroll
                  for (int tt = 0; tt < 4; ++tt) ac[tt] = an[tt];
                  if (ks < 7) {
#pragma unroll
                      for (int tt = 0; tt < 4; ++tt) if (tt >= ((ks + 1) >> 1)) an[tt] = *(const bf16x8*)(wa + (size_t)tt * 32 * 128 + (ks + 1) * 16);
                  }
                  const bf16x8 b0 = *(const bf16x8*)(bb + ks * 32);
#pragma unroll
                  for (int tt = 0; tt < 4; ++tt) if (tt >= (ks >> 1)) acc[tt] = __builtin_amdgcn_mfma_f32_32x32x16_bf16(ac[tt], b0, acc[tt], 0, 0, 0);
                  asm volatile("" ::: "memory");
              }
#pragma unroll
              for (int tt = 0; tt < 4; ++tt)
#pragma unroll
                  for (int rp = 0; rp < 8; ++rp) pk[dt][tt][rp] = cvtpk(acc[tt][2 * rp], acc[tt][2 * rp + 1]);
          }
          LDS_WAIT(); asm volatile("" ::: "memory");
          unsigned char* mxb = myreg + (4 * hi) * SG_MPITCH + q * 2;
#pragma unroll
          for (int dt = 0; dt < 2; ++dt)
#pragma unroll
              for (int tt = 0; tt < 4; ++tt)
#pragma unroll
                  for (int r = 0; r < 16; ++r)
                      *(unsigned short*)(mxb + (32 * tt + (r & 3) + 8 * (r >> 2)) * SG_MPITCH + 64 * dt) = (unsigned short)((r & 1) ? (pk[dt][tt][r >> 1] >> 16) : (pk[dt][tt][r >> 1] & 0xffffu));
        }
        LDS_WAIT(); asm volatile("" ::: "memory");
        { const int ch = lane & 7, r8 = lane >> 3;
#pragma unroll 4
          for (int it = 0; it < 16; ++it) {
              const int t = it * 8 + r8;
              const v4u mv = *(const v4u*)(myreg + t * SG_MPITCH + ch * 16);
              const v4u uv = *(const v4u*)(U + (row0 + t) * 512 + g * 64 + ch * 8), zv = *(const v4u*)(ZA + (row0 + t) * 512 + g * 64 + ch * 8);
              const float bt = bg[t];
              v4u o;
              o.x = pk2(bflo(uv.x) * (bflo(mv.x) + bt) * bflo(zv.x), bfhi(uv.x) * (bfhi(mv.x) + bt) * bfhi(zv.x));
              o.y = pk2(bflo(uv.y) * (bflo(mv.y) + bt) * bflo(zv.y), bfhi(uv.y) * (bfhi(mv.y) + bt) * bfhi(zv.y));
              o.z = pk2(bflo(uv.z) * (bflo(mv.z) + bt) * bflo(zv.z), bfhi(uv.z) * (bfhi(mv.z) + bt) * bfhi(zv.z));
              o.w = pk2(bflo(uv.w) * (bflo(mv.w) + bt) * bflo(zv.w), bfhi(uv.w) * (bfhi(mv.w) + bt) * bfhi(zv.w));
              *(v4u*)(MIX + (row0 + t) * 1024 + g * 64 + ch * 8) = o;
          } }
        __syncthreads();
    }
}

__device__ __forceinline__ void phase_final(const Ctx& C) {
    const float* rowss = (const float*)(C.ws + WS_ROWSS);
    const float chk = CHECK_ATTN ? __uint_as_float(((const unsigned*)(C.ws + WS_CTL))[32]) : 0.f;
    const int gw = C.bid * NWAVES + C.wave, NGW = C.G * NWAVES;
    f32x4 g[4];
#pragma unroll
    for (int j = 0; j < 4; ++j) g[j] = ((const f32x4*)C.final_g)[64 * j + C.lane];
    for (int m = gw; m < MROWS; m += NGW) {
        float ss = (C.lane < 16) ? rowss[(size_t)m * 16 + C.lane] : 0.f;
        ss = wave_sum(ss);
        float rs = 1.0f / sqrtf(ss * (1.0f / 1024.0f) + NORM_EPS);
        f32x4* xr = (f32x4*)(C.out + (size_t)m * DM) + C.lane;
#pragma unroll
        for (int j = 0; j < 4; ++j) { f32x4 v = xr[64 * j]; v = v * rs * g[j]; if (CHECK_ATTN && m == 0 && j == 0 && C.lane == 0) v.x = chk * 1e6f; xr[64 * j] = v; }
    }
}

#define GAS __attribute__((address_space(1)))
typedef GAS unsigned gu32;
#define RLX_AGENT __ATOMIC_RELAXED, __HIP_MEMORY_SCOPE_AGENT
constexpr int CW_BAR = 4096;
constexpr int LDS_BARST = LDS_BYTES - 64;
#define XB_TMO      128
#define XB_XCNT(j)  (256  + 64 * (j))
#define XB_XSUB(j)  (1280 + 64 * (j))
#define XB_XGEN(j)  (2304 + 64 * (j))
#define XB_TOP      3328
#define XB_TOPGEN   3392
#define XCD_BAR_WORDS 3456
#define XB_SPIN_CAP (1u << 18)

__device__ __forceinline__ unsigned xb_ld(unsigned* p)              { return __hip_atomic_load(p, __ATOMIC_RELAXED, __HIP_MEMORY_SCOPE_AGENT); }
__device__ __forceinline__ unsigned xb_add(unsigned* p, unsigned v) { return __hip_atomic_fetch_add(p, v, __ATOMIC_RELAXED, __HIP_MEMORY_SCOPE_AGENT); }
__device__ __forceinline__ unsigned xb_xcc_id() { return (unsigned)__builtin_amdgcn_s_getreg((3 << 11) | 20) & 0xFu; }
#define XB_SPIN(cond, bar) do { unsigned _sp = 0; while (cond) { __builtin_amdgcn_s_sleep(1); \
    if ((++_sp & 255u) == 0u) { if (xb_ld(&(bar)[XB_TMO])) break; if (_sp > XB_SPIN_CAP) { atomicAdd(&(bar)[XB_TMO], 1u); break; } } } } while (0)

struct XcdBarrier {
    unsigned* bar; unsigned x;
    volatile LAS unsigned* st;
};

__device__ __forceinline__ XcdBarrier xcd_barrier_post(unsigned* bar, volatile LAS unsigned* st) {
    XcdBarrier b; b.bar = bar; b.x = xb_xcc_id(); b.st = st;
    if (threadIdx.x == 0) (void)xb_add(&bar[XB_XCNT(b.x)], 1u);
    return b;
}
__device__ __forceinline__ void xcd_barrier_complete(unsigned* bar, unsigned x, unsigned& nloc, unsigned& nx) {
    const unsigned G = gridDim.x * gridDim.y * gridDim.z;
    unsigned sum, cnt, mine, sp = 0u;
    for (;;) {
        sum = 0u; cnt = 0u; mine = 0u;
#pragma unroll
        for (unsigned j = 0; j < 16; ++j) { const unsigned c = xb_ld(&bar[XB_XCNT(j)]); sum += c; cnt += (c > 0u) ? 1u : 0u; mine = (j == x) ? c : mine; }
        if (sum == G) break;
        __builtin_amdgcn_s_sleep(1);
        if ((++sp & 255u) == 0u) { if (xb_ld(&bar[XB_TMO])) break; if (sp > XB_SPIN_CAP) { atomicAdd(&bar[XB_TMO], 1u); break; } }
    }
    nloc = mine > 0u ? mine : 1u; nx = cnt > 0u ? cnt : 1u;
}

__device__ __forceinline__ void xcd_barrier(const XcdBarrier& b) {
    asm volatile("s_waitcnt vmcnt(0)" ::: "memory");
    __syncthreads();
    if (threadIdx.x == 0) {
        unsigned* bar = b.bar;
        __builtin_amdgcn_s_waitcnt(0);
        unsigned nloc = b.st[0], nx = b.st[1];
        if (nloc == 0u) { xcd_barrier_complete(bar, b.x, nloc, nx); b.st[0] = nloc; b.st[1] = nx; }
        const unsigned old = xb_add(&bar[XB_XSUB(b.x)], 1u);
        const unsigned gen = old / nloc;
        if (old + 1u == (gen + 1u) * nloc) {
            __builtin_amdgcn_fence(__ATOMIC_RELEASE, "agent");
            asm volatile("s_waitcnt vmcnt(0)" ::: "memory");
            const unsigned og = xb_add(&bar[XB_TOP], 1u);
            const unsigned tg = og / nx;
            if (og + 1u == (tg + 1u) * nx) xb_add(&bar[XB_TOPGEN], 1u);
            else XB_SPIN(xb_ld(&bar[XB_TOPGEN]) == tg, bar);
            __builtin_amdgcn_fence(__ATOMIC_ACQUIRE, "agent");
            xb_add(&bar[XB_XGEN(b.x)], 1u);
            asm volatile("s_waitcnt vmcnt(0)" ::: "memory");
        } else {
            XB_SPIN(xb_ld(&bar[XB_XGEN(b.x)]) == gen, bar);
            __builtin_amdgcn_fence(__ATOMIC_ACQUIRE, "agent");
            asm volatile("s_waitcnt vmcnt(0)" ::: "memory");
        }
    }
    __syncthreads();
}

#ifndef ATTN_OPT
#define ATTN_OPT 1
#endif
template <int ST> __device__ __forceinline__ void run_stage(const Args& args, unsigned char* lds, int Lr) {
    const int L = Lr & 15, rep = Lr >> 4;
    Ctx C;
    { int t = threadIdx.x; asm volatile("" : "+v"(t)); C.tid = t; }
    C.lds = lds; C.lane = C.tid & 63; C.wave = __builtin_amdgcn_readfirstlane(C.tid >> 6); C.G = gridDim.x; C.bid = blockIdx.x;
    C.x = args.in[0]; C.norm_g = args.in[1]; C.w_in = args.in[2]; C.ln_g = args.in[3]; C.ln_b = args.in[4]; C.sgu_w = args.in[5]; C.sgu_b = args.in[6];
    C.w_out = args.in[7]; C.rel_bias = args.in[8]; C.final_g = args.in[9]; C.out = args.out; C.ws = args.ws;
    asm volatile("" : "+s"(C.ws), "+s"(C.out), "+s"(C.x), "+s"(C.sgu_b), "+s"(C.ln_g), "+s"(C.ln_b));
    if constexpr (ST == 0) phase_prologue(C);
    else if constexpr (ST == 1) {
        pg8::Gemm g{(const pg8::bf16_t*)(C.ws + WS_XB), (const pg8::bf16_t*)(C.ws + WS_WIN) + (size_t)L * DIN * DM, MROWS, DIN, DM};
        pg8::StaticOrder S; S.init(MROWS, DIN, C.G, C.bid);
        pg8::EpiProj E{(pg8::bf16_t*)(C.ws + WS_PROJ), SUBSTRIDE, (const float*)(C.ws + WS_ROWSS)};
        pg8::gemm_phase<pg8::EpiProj, pg8::StaticOrder, true, true>((PG8_LAS unsigned char*)lds, g, S, E, C.tid);
    } else if constexpr (ST == 2) phase_kmean(C);
    else if constexpr (ST == 3) { phase_gate(C); if (SGU_OPT) phase_sgu(C, L); else phase_sgu_simple(C, L); }
    else if constexpr (ST == 4) { if (ATTN_OPT) phase_attn(C, L + 2 * rep); else phase_attn_simple(C, (bf16*)(C.ws + WS_MIX)); }
    else if constexpr (ST == 5) { if (ATTN_OPT) phase_combine(C); }
    else if constexpr (ST == 6) {
        pg8::Gemm g{(const pg8::bf16_t*)(C.ws + WS_MIX), (const pg8::bf16_t*)(C.ws + WS_WOUT) + (size_t)L * DM * DM, MROWS, DM, DM};
        pg8::StaticOrder S; S.init(MROWS, DM, C.G, C.bid);
        pg8::EpiRes E{L == 0 ? C.x : (const float*)C.out, C.out, L == 0 ? (pg8::bf16_t*)(C.ws + WS_XB) : (pg8::bf16_t*)nullptr, (float*)(C.ws + WS_ROWSS)};
        pg8::gemm_phase<pg8::EpiRes, pg8::StaticOrder, true, true>((PG8_LAS unsigned char*)lds, g, S, E, C.tid);
    } else if constexpr (ST == 7) phase_final(C);
    else if constexpr (ST == 8) phase_attn_simple(C, (bf16*)C.out);
    else if constexpr (ST == 9) {
        const bf16* A = (const bf16*)(C.ws + WS_MIX); const bf16* B = (const bf16*)C.out; unsigned* flag = (unsigned*)(C.ws + WS_CTL) + 32;
        float md = 0.f;
        for (size_t idx = (size_t)C.bid * 512 + C.tid; idx < (size_t)MROWS * 512; idx += (size_t)C.G * 512) {
            const size_t row = idx >> 9, col = 512 + (idx & 511);
            const float a = __uint_as_float((unsigned)A[row * 1024 + col] << 16), r = __uint_as_float((unsigned)B[row * 1024 + col] << 16);
            float sc = fabsf(r);
#pragma unroll
            for (int o = 1; o < 64; o <<= 1) sc = fmaxf(sc, __shfl_xor(sc, o));
            const float d = fabsf(a - r) / (0.02f + sc);
            md = (d > md || !(d == d)) ? (d == d ? d : 1e6f) : md;
        }
        atomicMax(flag, __float_as_uint(md));
    }
}
template <int SEL> __global__ void __launch_bounds__(NWAVES * 64, 2) fwd(Args args) {
    extern __shared__ __attribute__((aligned(16))) unsigned char lds[];
    if constexpr (SEL >= 0) run_stage<SEL>(args, lds, args.layer);
    else {
        if (args.pad == 0x7fffffff) cg::this_grid().sync();
        volatile LAS unsigned* bst = (volatile LAS unsigned*)((LAS unsigned char*)lds + LDS_BARST);
        if (threadIdx.x == 0) { bst[0] = 0u; bst[1] = 0u; }
        __syncthreads();
        XcdBarrier bar = xcd_barrier_post((unsigned*)(args.ws + WS_CTL) + CW_BAR, bst);
#define GRID_SYNC() xcd_barrier(bar)
#define RUN(k, L) do { run_stage<k>(args, lds, L); GRID_SYNC(); if (REPEAT_MASK & (1 << k)) { run_stage<k>(args, lds, L + 16); GRID_SYNC(); } } while (0)
        RUN(0, 0);
        for (int L = 0; L < DEPTH; ++L) {
            RUN(1, L); RUN(2, L); RUN(3, L); RUN(4, L);
            if (ATTN_OPT) RUN(5, L);
            RUN(6, L);
        }
        run_stage<7>(args, lds, 0);
    }
}

#ifndef MK_N_LAUNCHES
#define MK_N_LAUNCHES 1
#endif
template <int SEL> static void launch_stage(int grid, Args a, int layer, hipStream_t stream) {
    static bool attr = false;
    if (!attr) { (void)hipFuncSetAttribute((const void*)fwd<SEL>, hipFuncAttributeMaxDynamicSharedMemorySize, LDS_BYTES); attr = true; }
    a.layer = layer;
    hipLaunchKernelGGL(fwd<SEL>, dim3(grid), dim3(NWAVES * 64), LDS_BYTES, stream, a);
}
extern "C" void kernel_launch(void* const* d_in, const int* in_sizes, int n_in, void* d_out, int out_size, void* d_ws, size_t ws_size, hipStream_t stream) {
    static int grid = 0;
    if (grid == 0) {
        if (n_in != 10 || out_size != MROWS * DM || ws_size < WS_END) { fprintf(stderr, "kernel_launch: unexpected shapes (n_in %d out %d ws %zu)\n", n_in, out_size, ws_size); grid = -1; return; }
        int dev = 0, cus = 0;
        (void)hipGetDevice(&dev); (void)hipDeviceGetAttribute(&cus, hipDeviceAttributeMultiprocessorCount, dev);
        grid = cus;
#if MK_N_LAUNCHES == 1
        int per_cu = 0;
        if (hipFuncSetAttribute((const void*)fwd<-1>, hipFuncAttributeMaxDynamicSharedMemorySize, LDS_BYTES) != hipSuccess) { fprintf(stderr, "kernel_launch: hipFuncSetAttribute failed\n"); grid = -1; return; }
        if (hipOccupancyMaxActiveBlocksPerMultiprocessor(&per_cu, (const void*)fwd<-1>, NWAVES * 64, LDS_BYTES) != hipSuccess || per_cu < 1) { fprintf(stderr, "kernel_launch: occupancy query says %d\n", per_cu); grid = -1; return; }
        (void)hipGetLastError();
#endif
    }
    if (grid < 0) return;
    (void)hipMemsetAsync((char*)d_ws + WS_CTL, 0, CTL_ZERO_BYTES, stream);
    Args a{};
    for (int i = 0; i < 10; ++i) a.in[i] = (const float*)d_in[i];
    a.out = (float*)d_out; a.ws = (unsigned char*)d_ws;
#if MK_N_LAUNCHES == 1
    void* kargs[] = {&a};
    hipError_t e = hipLaunchCooperativeKernel((const void*)fwd<-1>, dim3(grid), dim3(NWAVES * 64), kargs, LDS_BYTES, stream);
    if (e != hipSuccess) fprintf(stderr, "kernel_launch: cooperative launch failed: %s\n", hipGetErrorString(e));
#else
    launch_stage<0>(grid, a, 0, stream);
    for (int L = 0; L < DEPTH; ++L) {
        launch_stage<1>(grid, a, L, stream); launch_stage<2>(grid, a, L, stream); launch_stage<3>(grid, a, L, stream);
        launch_stage<4>(grid, a, L, stream); launch_stage<5>(grid, a, L, stream);
        if (CHECK_ATTN && L == 0) { launch_stage<8>(grid, a, L, stream); launch_stage<9>(grid, a, L, stream); }
        launch_stage<6>(grid, a, L, stream);
    }
    launch_stage<7>(grid, a, 0, stream);
#endif
}
```

```cpp
#include <hip/hip_runtime.h>
#include <hip/hip_cooperative_groups.h>
#include <cstdio>
#include <cstdint>
namespace cg = cooperative_groups;

constexpr int BATCH = 2, SEQ = 16384, DM = 1024, MROWS = BATCH * SEQ, DIN = 3584, DSUB = 512;
constexpr int NH = 8, DH = 64, NBLK = SEQ / 256, NBH = BATCH * NH, DEPTH = 2;
constexpr float NORM_EPS = 1e-6f, LN_EPS = 1e-5f;
constexpr float LOG2E = 1.4426950408889634f;
constexpr float QSCALE = 0.125f * LOG2E;
namespace pg8 {
#define PG8_LAS __attribute__((address_space(3)))
typedef unsigned short bf16_t;
typedef short bf16x8 __attribute__((ext_vector_type(8)));
typedef float f32x4 __attribute__((ext_vector_type(4)));
typedef unsigned u32x4 __attribute__((ext_vector_type(4)));
constexpr int BM = 256, BK = 64, HALF = 128, HTB = HALF * BK * 2  , STAGE_BYTES = 8 * HTB, NXCD = 8, WGM = 8;

__host__ __device__ __forceinline__ int lds_byte(int r, int c) { const int st = (r >> 4) * 2 + (c >> 5), rr = r & 15, cc = c & 31, ob = rr * 64 + cc * 2; return st * 1024 + (ob ^ (((ob >> 9) & 1) << 5)); }
__host__ __device__ __forceinline__ void stage_rc(int b, int& R, int& C) { const int st = b / 1024, sb = b % 1024, swz = sb ^ (((sb >> 9) & 1) << 5); R = (st >> 1) * 16 + swz / 64; C = (st & 1) * 32 + (swz % 64) / 2; }
__host__ __device__ __forceinline__ int perm32(int rho) { const int n = rho >> 4, i = rho & 15; return 8 * (i >> 2) + 4 * n + (i & 3); }

struct Unit { int pm, pn; };
struct Gemm { const bf16_t* A; const bf16_t* Bt; int M, N, K; };

struct StaticOrder {
    int nM, nN, nwg, G, c;
    __host__ __device__ void init(int M, int N, int G_, int c_) { nM = M / BM; nN = N / BM; nwg = nM * nN; G = G_; c = c_; }
    __host__ __device__ bool next(int i, Unit& u) const {
        const long L = (long)i * G + c; if (L >= nwg) return false;
        int wgid = (int)L; { const int q = nwg / NXCD, r = nwg % NXCD, xcd = wgid % NXCD, off = wgid / NXCD; wgid = (xcd < r ? xcd * (q + 1) : r * (q + 1) + (xcd - r) * q) + off; }
        const int nig = WGM * nN, gid = wgid / nig, fm = gid * WGM, gsz = (nM - fm) < WGM ? (nM - fm) : WGM;
        u.pm = fm + ((wgid % nig) % gsz); u.pn = (wgid % nig) / gsz; return true;
    }
    __device__ __forceinline__ void a_ready(const Unit&) const {}
    __device__ __forceinline__ void done(const Unit&) const {}
};

__device__ __forceinline__ unsigned cvt_pk_bf16(float lo, float hi) { unsigned r; asm volatile("v_cvt_pk_bf16_f32 %0, %1, %2" : "=v"(r) : "v"(lo), "v"(hi)); return r; }
typedef float f32x2 __attribute__((ext_vector_type(2)));
typedef float f32x2 __attribute__((ext_vector_type(2)));
__device__ __forceinline__ float act_gelu(float x) {
    const float u = x * (1.0f + 0.044715f * x * x);
    const float e = __builtin_amdgcn_exp2f(u * (-2.0f * 0.7978845608028654f * 1.4426950408889634f));
    return x * __builtin_amdgcn_rcpf(1.0f + e);
}
__device__ __forceinline__ float act_silu(float x) {
    const float e = __builtin_amdgcn_exp2f(x * (-1.4426950408889634f));
    return x * __builtin_amdgcn_rcpf(1.0f + e);
}
struct EpiProj {
    static constexpr bool PERM = true, AFTER_DRAIN = false;
    bf16_t* P; size_t sub_stride; const float* rowss; float* kmean;
    __device__ __forceinline__ void operator()(const f32x4 (&acc)[2][2][4][2], const Unit& u, int wr, int wc, int fr, int fq) const {
        const int t = u.pn >> 1;
        bf16_t* base = P + (size_t)t * sub_stride;
        const int col0 = (u.pn & 1) * 256 + wc * 32 + 8 * fq;
        const int row0 = u.pm * BM + wr * 64 + fr;
        float ks[2][8];
#pragma unroll
        for (int bj = 0; bj < 2; ++bj)
#pragma unroll
            for (int e = 0; e < 8; ++e) ks[bj][e] = 0.f;
#pragma unroll
        for (int ai = 0; ai < 2; ++ai)
#pragma unroll
            for (int m = 0; m < 4; ++m) {
                const int row = row0 + ai * HALF + m * 16;
                const f32x4* rp = (const f32x4*)(rowss + (size_t)row * 16);
                const f32x4 s0 = rp[0], s1 = rp[1], s2 = rp[2], s3 = rp[3];
                const float ss = ((s0[0] + s0[1]) + (s0[2] + s0[3])) + ((s1[0] + s1[1]) + (s1[2] + s1[3])) + ((s2[0] + s2[1]) + (s2[2] + s2[3])) + ((s3[0] + s3[1]) + (s3[2] + s3[3]));
                const float rs = __builtin_amdgcn_rsqf(ss * (1.0f / 1024.0f) + 1e-6f);
                bf16_t* rowp = base + (size_t)row * 512 + col0;
#pragma unroll
                for (int bj = 0; bj < 2; ++bj) {
                    f32x4 v0 = acc[ai][bj][m][0] * rs, v1 = acc[ai][bj][m][1] * rs;
                    if (t <= 1) {
#pragma unroll
                        for (int e = 0; e < 4; ++e) { v0[e] = act_gelu(v0[e]); v1[e] = act_gelu(v1[e]); }
                    } else if (t == 2 || t == 6) {
#pragma unroll
                        for (int e = 0; e < 4; ++e) { v0[e] = act_silu(v0[e]); v1[e] = act_silu(v1[e]); }
                    } else if (t == 3) { v0 = v0 * (0.125f * 1.4426950408889634f); v1 = v1 * (0.125f * 1.4426950408889634f); }
                    else if (t == 4) {
#pragma unroll
                        for (int e = 0; e < 4; ++e) { ks[bj][e] += v0[e]; ks[bj][4 + e] += v1[e]; }
                    }
                    u32x4 w; w.x = cvt_pk_bf16(v0[0], v0[1]); w.y = cvt_pk_bf16(v0[2], v0[3]); w.z = cvt_pk_bf16(v1[0], v1[1]); w.w = cvt_pk_bf16(v1[2], v1[3]);
                    *(u32x4*)(rowp + bj * HALF) = w;
                }
            }
        if (t == 4) {
            const int b = u.pm >> 6, n = u.pm & 63;
#pragma unroll
            for (int bj = 0; bj < 2; ++bj)
#pragma unroll
                for (int e = 0; e < 8; ++e) {
                    float v = ks[bj][e];
                    v += __shfl_xor(v, 1); v += __shfl_xor(v, 2); v += __shfl_xor(v, 4); v += __shfl_xor(v, 8);
                    if (fr == 0) { const int col = col0 + bj * HALF + e; atomicAdd(kmean + ((size_t)((b * 8 + (col >> 6)) * 64 + n)) * 64 + (col & 63), v * (1.0f / 256.0f)); }
                }
        }
    }
};
template <bool LAST> struct EpiRes {
    static constexpr bool PERM = false, AFTER_DRAIN = false;
    const float* res; float* out; bf16_t* xb; float* rowss;
    __device__ __forceinline__ void operator()(const f32x4 (&acc)[2][2][4][2], const Unit& u, int wr, int wc, int fr, int fq) const {
        typedef unsigned u32x2v __attribute__((ext_vector_type(2)));
        const int col0 = u.pn * BM + wc * 32 + 4 * fq;
#pragma unroll
        for (int ai = 0; ai < 2; ++ai)
#pragma unroll
            for (int m = 0; m < 4; ++m) {
                const int row = u.pm * BM + ai * HALF + wr * 64 + m * 16 + fr;
                const size_t off = (size_t)row * 1024 + col0;
                float ss = 0.f;
#pragma unroll
                for (int bj = 0; bj < 2; ++bj)
#pragma unroll
                    for (int n = 0; n < 2; ++n) {
                        f32x4 r;
                        if (LAST) { const u32x2v w = *(const u32x2v*)(xb + off + bj * HALF + n * 16);
                            r = (f32x4){__uint_as_float(w.x << 16), __uint_as_float(w.x & 0xffff0000u), __uint_as_float(w.y << 16), __uint_as_float(w.y & 0xffff0000u)}; }
                        else r = *(const f32x4*)(res + off + bj * HALF + n * 16);
                        const f32x4 o = r + acc[ai][bj][m][n];
                        ss += (o[0] * o[0] + o[1] * o[1]) + (o[2] * o[2] + o[3] * o[3]);
                        if (LAST) *(f32x4*)(out + off + bj * HALF + n * 16) = o;
                        else { u32x2v w; w.x = cvt_pk_bf16(o[0], o[1]); w.y = cvt_pk_bf16(o[2], o[3]); *(u32x2v*)(xb + off + bj * HALF + n * 16) = w; }
                    }
                ss += __shfl_xor(ss, 16); ss += __shfl_xor(ss, 32);
                if (fq == 0) rowss[(size_t)row * 16 + u.pn * 4 + wc] = ss;
            }
    }
};
template <class Epi, class Sched, bool ALIGN_EPI = false, bool SP2 = false>
__device__ __forceinline__ void gemm_phase(PG8_LAS unsigned char* lds, const Gemm g, const Sched& S, const Epi& E, const int tid) {
    const int wid = __builtin_amdgcn_readfirstlane(tid >> 6), lane = tid & 63, wr = wid >> 2, wc = wid & 3, fr = lane & 15, fq = lane >> 4;
    const int K = g.K, nt = K / BK;
    unsigned voffA[2], voffB[2];
#pragma unroll
    for (int i = 0; i < 2; ++i) { int R, C; stage_rc(tid * 16 + i * 8192, R, C); const int Rb = Epi::PERM ? ((R & ~31) + perm32(R & 31)) : R;
        voffA[i] = (unsigned)(R * K + C) * 2u; voffB[i] = (unsigned)(Rb * K + C) * 2u; }
    const size_t kstep = (size_t)(BK * 2);
    const size_t hstep = (size_t)HALF * K * 2;
    const size_t tstep = 2 * hstep;
    const unsigned ldsw = (unsigned)wid * 1024u;
    const int aoff = lds_byte(wr * 64 + fr, fq * 8), boff = lds_byte(wc * 32 + fr, fq * 8);
#define PG8_SA(b, h) (((b) * 2 + (h)) * HTB)
#define PG8_SB(b, h) ((4 + (b) * 2 + (h)) * HTB)
#define PG8_STAGE(bufoff, gbase, voff) do { _Pragma("unroll") for (int _i = 0; _i < 2; ++_i) \
        __builtin_amdgcn_global_load_lds((const unsigned*)((const char*)(gbase) + (voff)[_i]), (PG8_LAS unsigned*)(lds + (bufoff) + ldsw + _i * 8192), 16, 0, 0); } while (0)
#define PG8_LDA(dst, b, h) do { _Pragma("unroll") for (int m = 0; m < 4; ++m) _Pragma("unroll") for (int k = 0; k < 2; ++k) dst[m][k] = *(const PG8_LAS bf16x8*)(lds + PG8_SA(b, h) + aoff + m * 2048 + k * 1024); } while (0)
#define PG8_LDB(dst, b, h) do { _Pragma("unroll") for (int n = 0; n < 2; ++n) _Pragma("unroll") for (int k = 0; k < 2; ++k) dst[n][k] = *(const PG8_LAS bf16x8*)(lds + PG8_SB(b, h) + boff + n * 2048 + k * 1024); } while (0)
#define PG8_MMA(ai, bj, At, Bt) do { __builtin_amdgcn_s_setprio(1); _Pragma("unroll") for (int m = 0; m < 4; ++m) _Pragma("unroll") for (int n = 0; n < 2; ++n) _Pragma("unroll") for (int k = 0; k < 2; ++k) \
        acc[ai][bj][m][n] = __builtin_amdgcn_mfma_f32_16x16x32_bf16(Bt[n][k], At[m][k], acc[ai][bj][m][n], 0, 0, 0); __builtin_amdgcn_s_setprio(0); } while (0)
#define PG8_WAIT_V(n) asm volatile("s_waitcnt vmcnt(" #n ")" ::: "memory")
#define PG8_WAIT_L(n) asm volatile("s_waitcnt lgkmcnt(" #n ")" ::: "memory")
#define PG8_BAR __builtin_amdgcn_s_barrier()
#define PG8_SCHED __builtin_amdgcn_sched_barrier(0)
    Unit cur, nxt; int ui = 0;
    if (!S.next(0, cur)) return;
    f32x4 acc[2][2][4][2];
#pragma unroll
    for (int a = 0; a < 2; ++a)
#pragma unroll
        for (int b = 0; b < 2; ++b)
#pragma unroll
            for (int m = 0; m < 4; ++m)
#pragma unroll
                for (int n = 0; n < 2; ++n) acc[a][b][m][n] = (f32x4){0.f, 0.f, 0.f, 0.f};
    bf16x8 At[4][2], B0[2][2], B1[2][2];
    const char* cA = (const char*)g.A + (size_t)cur.pm * tstep; const char* cB = (const char*)g.Bt + (size_t)cur.pn * tstep;
    S.a_ready(cur);
    if constexpr (SP2) {
        PG8_STAGE(PG8_SB(0, 0), cB, voffB); PG8_STAGE(PG8_SB(0, 1), cB + hstep, voffB); PG8_STAGE(PG8_SA(0, 0), cA, voffA); PG8_STAGE(PG8_SA(0, 1), cA + hstep, voffA);
        if (wr == 1) PG8_BAR;
        PG8_WAIT_V(2); PG8_BAR;
        PG8_STAGE(PG8_SB(1, 0), cB + kstep, voffB); PG8_STAGE(PG8_SA(1, 0), cA + kstep, voffA); PG8_STAGE(PG8_SB(1, 1), cB + hstep + kstep, voffB);
        PG8_WAIT_V(6); PG8_BAR;
    } else {
        PG8_STAGE(PG8_SB(0, 0), cB, voffB); PG8_STAGE(PG8_SA(0, 0), cA, voffA); PG8_STAGE(PG8_SB(0, 1), cB + hstep, voffB); PG8_STAGE(PG8_SA(0, 1), cA + hstep, voffA);
        if (wr == 1) PG8_BAR;
        PG8_WAIT_V(4); PG8_BAR;
        PG8_STAGE(PG8_SB(1, 0), cB + kstep, voffB); PG8_STAGE(PG8_SA(1, 0), cA + kstep, voffA); PG8_STAGE(PG8_SB(1, 1), cB + hstep + kstep, voffB);
        PG8_WAIT_V(6); PG8_BAR;
    }
    for (;;) {
        const bool has_next = S.next(ui + 1, nxt);
        const char* nA = has_next ? (const char*)g.A + (size_t)nxt.pm * tstep : cA; const char* nB = has_next ? (const char*)g.Bt + (size_t)nxt.pn * tstep : cB;
        for (int t = 0; t < nt; t += 2) {
            const bool last = (t == nt - 2);
            const char* a1 = cA + (size_t)(t + 1) * kstep;
            const char* a2 = last ? nA : cA + (size_t)(t + 2) * kstep; const char* b2 = last ? nB : cB + (size_t)(t + 2) * kstep;
            const char* a3 = a2 + kstep; const char* b3 = b2 + kstep;
            if (last && has_next) S.a_ready(nxt);
            if constexpr (SP2) {
            PG8_LDB(B0, 0, 0); PG8_LDB(B1, 0, 1); PG8_SCHED; PG8_LDA(At, 0, 0); PG8_STAGE(PG8_SA(1, 1), a1 + hstep, voffA);
            PG8_WAIT_V(8); PG8_WAIT_L(0); PG8_BAR; PG8_MMA(0, 0, At, B0); PG8_MMA(0, 1, At, B1); PG8_BAR; PG8_SCHED;
            PG8_LDA(At, 0, 1); PG8_STAGE(PG8_SB(0, 0), b2, voffB); PG8_STAGE(PG8_SB(0, 1), b2 + hstep, voffB); PG8_STAGE(PG8_SA(0, 0), a2, voffA);
            PG8_WAIT_V(8); PG8_WAIT_L(0); PG8_BAR; PG8_MMA(1, 0, At, B0); PG8_MMA(1, 1, At, B1); PG8_BAR; PG8_SCHED;
            PG8_LDB(B0, 1, 0); PG8_LDB(B1, 1, 1); PG8_SCHED; PG8_LDA(At, 1, 0); PG8_STAGE(PG8_SA(0, 1), a2 + hstep, voffA);
            PG8_WAIT_V(8); PG8_WAIT_L(0); PG8_BAR; PG8_MMA(0, 0, At, B0); PG8_MMA(0, 1, At, B1); PG8_BAR; PG8_SCHED;
            PG8_LDA(At, 1, 1); PG8_STAGE(PG8_SB(1, 0), b3, voffB); PG8_STAGE(PG8_SB(1, 1), b3 + hstep, voffB); PG8_STAGE(PG8_SA(1, 0), a3, voffA);
            PG8_WAIT_V(8); PG8_WAIT_L(0); PG8_BAR; PG8_MMA(1, 0, At, B0); PG8_MMA(1, 1, At, B1); PG8_BAR; PG8_SCHED;
            } else {
            PG8_LDB(B0, 0, 0); PG8_SCHED; PG8_LDA(At, 0, 0); PG8_STAGE(PG8_SA(1, 1), a1 + hstep, voffA);
            PG8_WAIT_L(8); PG8_BAR; PG8_WAIT_L(0); PG8_MMA(0, 0, At, B0); PG8_BAR; PG8_SCHED;
            PG8_LDB(B1, 0, 1); PG8_STAGE(PG8_SB(0, 0), b2, voffB);
            PG8_BAR; PG8_WAIT_L(0); PG8_MMA(0, 1, At, B1); PG8_BAR;
            PG8_LDA(At, 0, 1); PG8_STAGE(PG8_SA(0, 0), a2, voffA);
            PG8_BAR; PG8_WAIT_L(0); PG8_MMA(1, 0, At, B0); PG8_BAR; PG8_SCHED;
            PG8_STAGE(PG8_SB(0, 1), b2 + hstep, voffB);
            PG8_WAIT_V(6); PG8_BAR; PG8_MMA(1, 1, At, B1); PG8_BAR;
            PG8_LDB(B0, 1, 0); PG8_SCHED; PG8_LDA(At, 1, 0); PG8_STAGE(PG8_SA(0, 1), a2 + hstep, voffA);
            PG8_WAIT_L(8); PG8_BAR; PG8_WAIT_L(0); PG8_MMA(0, 0, At, B0); PG8_BAR; PG8_SCHED;
            PG8_LDB(B1, 1, 1); PG8_STAGE(PG8_SB(1, 0), b3, voffB);
            PG8_BAR; PG8_WAIT_L(0); PG8_MMA(0, 1, At, B1); PG8_BAR;
            PG8_LDA(At, 1, 1); PG8_STAGE(PG8_SA(1, 0), a3, voffA);
            PG8_BAR; PG8_WAIT_L(0); PG8_MMA(1, 0, At, B0); PG8_BAR; PG8_SCHED;
            PG8_STAGE(PG8_SB(1, 1), b3 + hstep, voffB);
            PG8_WAIT_V(6); PG8_BAR; PG8_MMA(1, 1, At, B1); PG8_BAR;
            }
        }
        if constexpr (ALIGN_EPI) { if (wr == 0) PG8_BAR; }
        if constexpr (!Epi::AFTER_DRAIN) { E(acc, cur, wr, wc, fr, fq); S.done(cur); }
        if (!has_next) break;
#pragma unroll
        for (int a = 0; a < 2; ++a)
#pragma unroll
            for (int b = 0; b < 2; ++b)
#pragma unroll
                for (int m = 0; m < 4; ++m)
#pragma unroll
                    for (int n = 0; n < 2; ++n) acc[a][b][m][n] = (f32x4){0.f, 0.f, 0.f, 0.f};
        cur = nxt; cA = nA; cB = nB; ++ui;
        if constexpr (ALIGN_EPI) { if (wr == 1) PG8_BAR; }
    }
    PG8_WAIT_V(0);
    if constexpr (!ALIGN_EPI) { if (wr == 0) PG8_BAR; }
    PG8_BAR;
    if constexpr (Epi::AFTER_DRAIN) { E.fused(acc, cur, wr, wc, fr, fq, lds, wid, lane); S.done(cur); }
#undef PG8_SA
#undef PG8_SB
#undef PG8_STAGE
#undef PG8_LDA
#undef PG8_LDB
#undef PG8_MMA
#undef PG8_WAIT_V
#undef PG8_WAIT_L
#undef PG8_BAR
#undef PG8_SCHED
}
}

constexpr size_t MiB = 1u << 20;
constexpr size_t WS_CTL = 0, CTL_ZERO_BYTES = 1 * MiB;
constexpr size_t WS_WIN = 2 * MiB;
constexpr size_t WS_WOUT = 16 * MiB;
constexpr size_t WS_WST = 20 * MiB;
constexpr size_t WS_BT = 21 * MiB;
constexpr size_t WS_KMEAN = 22 * MiB;
constexpr size_t WS_LOFF = 23 * MiB;
constexpr size_t WS_ROWSS = 24 * MiB;
constexpr size_t WS_PL = 26 * MiB;
constexpr size_t WS_LIST = 30 * MiB;
constexpr size_t WS_SEL = 32 * MiB;
constexpr size_t WS_XB = 40 * MiB;
constexpr size_t WS_PROJ = 168 * MiB;
constexpr size_t WS_MIX = 392 * MiB;
constexpr size_t WS_END = 456 * MiB;
constexpr size_t SUBSTRIDE = (size_t)MROWS * 512;
enum { T_U = 0, T_V = 1, T_ZA = 2, T_Q = 3, T_K = 4, T_VV = 5, T_ZB = 6 };

#ifndef SGU_OPT
#define SGU_OPT 1
#endif
#ifndef REPEAT_MASK
#define REPEAT_MASK 0
#endif
#ifndef CHECK_ATTN
#define CHECK_ATTN 0
#endif
#ifndef CHECK_TOL_ABS
#define CHECK_TOL_ABS 2e-4f
#define CHECK_TOL_REL 0.02f
#endif
constexpr int NWAVES = 8;
constexpr int LDS_BYTES = 160 * 1024;
constexpr int RING_BYTES = 131072;

#define LAS __attribute__((address_space(3)))
typedef unsigned short bf16;
typedef unsigned v4u __attribute__((ext_vector_type(4)));
typedef float f32x4 __attribute__((ext_vector_type(4)));
#define LDS_WAIT() asm volatile("s_waitcnt lgkmcnt(0)" ::: "memory")
__device__ __forceinline__ unsigned f2bf(float f) { unsigned u = __builtin_bit_cast(unsigned, f); return (u + 0x7fffu + ((u >> 16) & 1u)) >> 16; }
__device__ __forceinline__ unsigned pk2(float lo, float hi) { return f2bf(lo) | (f2bf(hi) << 16); }
__device__ __forceinline__ float bflo(unsigned w) { return __uint_as_float(w << 16); }
__device__ __forceinline__ float bfhi(unsigned w) { return __uint_as_float(w & 0xffff0000u); }
__device__ __forceinline__ float wave_sum(float v) {
#pragma unroll
    for (int o = 1; o < 64; o <<= 1) v += __shfl_xor(v, o);
    return v;
}

struct Args { const float* in[10]; float* out; unsigned char* ws; int layer, pad; };

struct Ctx {
    unsigned char* lds;
    int tid, lane, wave, G, bid;
    const float *x, *norm_g, *w_in, *ln_g, *ln_b, *sgu_w, *sgu_b, *w_out, *rel_bias, *final_g;
    float* out; unsigned char* ws;
};

__device__ __forceinline__ void p0_transpose_item(const float* W, const float* gs, int K, int N, bf16* WT, float* scr, int item, int lane) {
    const int nblk = N / 32, kb = item / nblk, nb = item % nblk, k0 = 64 * kb, n0 = 32 * nb;
#pragma unroll 8
    for (int i = 0; i < 32; ++i) { const int kk = 2 * i + (lane >> 5); const float sc = gs ? gs[k0 + kk] : 1.0f; scr[kk * 33 + (lane & 31)] = W[(size_t)(k0 + kk) * N + n0 + (lane & 31)] * sc; }
    LDS_WAIT(); asm volatile("" ::: "memory");
    const int c = lane & 7;
#pragma unroll
    for (int j = 0; j < 4; ++j) { const int n = (lane >> 3) + 8 * j; const float* s = scr + (8 * c) * 33 + n;
        v4u o; o.x = pk2(s[0 * 33], s[1 * 33]); o.y = pk2(s[2 * 33], s[3 * 33]); o.z = pk2(s[4 * 33], s[5 * 33]); o.w = pk2(s[6 * 33], s[7 * 33]);
        *(v4u*)(WT + (size_t)(n0 + n) * K + k0 + 8 * c) = o; }
    LDS_WAIT(); asm volatile("" ::: "memory");
}
__device__ __forceinline__ int rel_bucket(int d) {
    if (d < 16) return d;
    int b = 16;
    b += (d >= 19); b += (d >= 21); b += (d >= 24); b += (d >= 27); b += (d >= 31); b += (d >= 35); b += (d >= 40); b += (d >= 46);
    b += (d >= 52); b += (d >= 59); b += (d >= 67); b += (d >= 77); b += (d >= 87); b += (d >= 99); b += (d >= 113);
    return b;
}
__device__ __forceinline__ void phase_prologue(const Ctx& C) {
    float* scr = (float*)(C.lds + C.wave * 16384);
    const int gw = C.bid * NWAVES + C.wave, NGW = C.G * NWAVES;
    constexpr int I_IN = (DM / 64) * (DIN / 32), I_OUT = (DM / 64) * (DM / 32);
    constexpr int NITEMS = DEPTH * (I_IN + I_OUT);
    for (int it = gw; it < NITEMS; it += NGW) {
        const int l = it / (I_IN + I_OUT); int r = it % (I_IN + I_OUT);
        if (r < I_IN) p0_transpose_item(C.w_in + (size_t)l * DM * DIN, C.norm_g + l * DM, DM, DIN, (bf16*)(C.ws + WS_WIN) + (size_t)l * DIN * DM, scr, r, C.lane);
        else p0_transpose_item(C.w_out + (size_t)l * DM * DM, nullptr, DM, DM, (bf16*)(C.ws + WS_WOUT) + (size_t)l * DM * DM, scr, r - I_IN, C.lane);
    }
    { float* km = (float*)(C.ws + WS_KMEAN); for (int e = C.bid * 512 + C.tid; e < DEPTH * NBH * NBLK * 64; e += C.G * 512) km[e] = 0.f; }
    { bf16* wst = (bf16*)(C.ws + WS_WST); const int gt = C.bid * 512 + C.tid, NT = C.G * 512;
      for (int e = gt; e < DEPTH * 8 * 128 * 128; e += NT) { const int s = e & 127, t = (e >> 7) & 127; wst[e] = (s <= t) ? (bf16)f2bf(C.sgu_w[e]) : (bf16)0; } }
    if (C.bid == 0) { float* bt = (float*)(C.ws + WS_BT); for (int e = C.tid; e < 8 * 128; e += 512) { const int h = e >> 7, d = e & 127; bt[e] = C.rel_bias[rel_bucket(d) * 8 + h] * LOG2E; } }
    { bf16* xb = (bf16*)(C.ws + WS_XB); float* rowss = (float*)(C.ws + WS_ROWSS);
      for (int m = gw; m < MROWS; m += NGW) {
        const f32x4* xr = (const f32x4*)(C.x + (size_t)m * DM) + C.lane;
        f32x4 v[4]; float s = 0.f;
#pragma unroll
        for (int j = 0; j < 4; ++j) { v[j] = xr[64 * j]; s += (v[j].x * v[j].x + v[j].y * v[j].y) + (v[j].z * v[j].z + v[j].w * v[j].w); }
        s = wave_sum(s);
        unsigned long long* o8 = (unsigned long long*)(xb + (size_t)m * DM) + C.lane;
#pragma unroll
        for (int j = 0; j < 4; ++j) o8[64 * j] = (unsigned long long)pk2(v[j].x, v[j].y) | ((unsigned long long)pk2(v[j].z, v[j].w) << 32);
        if (C.lane < 16) rowss[(size_t)m * 16 + C.lane] = (C.lane == 0) ? s : 0.f;
      } }
}

__device__ __forceinline__ void phase_kmean(const Ctx& C) {
    const bf16* K = (const bf16*)(C.ws + WS_PROJ) + (size_t)T_K * SUBSTRIDE;
    float* km = (float*)(C.ws + WS_KMEAN);
    float* red = (float*)C.lds;
    const int cgp = C.tid & 63, rg = C.tid >> 6;
    for (int u = C.bid; u < BATCH * NBLK; u += C.G) {
        const int b = u / NBLK, n = u % NBLK;
        float s[8];
#pragma unroll
        for (int e = 0; e < 8; ++e) s[e] = 0.f;
        for (int r = rg; r < 256; r += 8) {
            const v4u v = *(const v4u*)(K + ((size_t)(b * SEQ + n * 256 + r)) * 512 + cgp * 8);
            s[0] += bflo(v.x); s[1] += bfhi(v.x); s[2] += bflo(v.y); s[3] += bfhi(v.y); s[4] += bflo(v.z); s[5] += bfhi(v.z); s[6] += bflo(v.w); s[7] += bfhi(v.w);
        }
#pragma unroll
        for (int e = 0; e < 8; ++e) red[rg * 512 + cgp * 8 + e] = s[e];
        __syncthreads();
        { const int col = C.tid; float t = 0.f;
#pragma unroll
          for (int r = 0; r < 8; ++r) t += red[r * 512 + col];
          km[((size_t)((b * NH + (col >> 6)) * NBLK + n)) * 64 + (col & 63)] = t * (1.0f / 256.0f); }
        __syncthreads();
    }
}

__device__ __forceinline__ void phase_gate(const Ctx& C, int layer) {
    const bf16* Q = (const bf16*)(C.ws + WS_PROJ) + (size_t)T_Q * SUBSTRIDE;
    const float* KM = (const float*)(C.ws + WS_KMEAN) + (size_t)layer * NBH * NBLK * 64;
    int* SEL = (int*)(C.ws + WS_SEL); int* LOFF = (int*)(C.ws + WS_LOFF); unsigned short* LIST = (unsigned short*)(C.ws + WS_LIST);
    float* km = (float*)C.lds;
    float* cval = (float*)(C.lds + 16384);
    int* cidx = (int*)(C.lds + 16384 + 3072);
    int* cnt = (int*)(C.lds + 16384 + 6144);
    int* offs = (int*)(C.lds + 16384 + 6144 + 256);
    const int q = C.tid & 255, half = C.tid >> 8;
    for (int u = C.bid; u < NBH * NBLK; u += C.G) {
        const int bh = u >> 6, i = u & 63, b = bh >> 3, h = bh & 7;
        const int pos = i * 256 + q;
        if (i == 0) { if (half == 0) { int* sp = SEL + ((size_t)bh * SEQ + pos) * 4; sp[0] = -1; sp[1] = -1; sp[2] = -1; sp[3] = -1; } continue; }
        for (int e = C.tid; e < i * 64; e += 512) km[e] = KM[(size_t)bh * NBLK * 64 + e];
        if (C.tid < 64) cnt[C.tid] = 0;
        float qv[64];
        { const v4u* qp = (const v4u*)(Q + ((size_t)(b * SEQ + pos)) * 512 + h * 64);
#pragma unroll
          for (int c = 0; c < 8; ++c) { const v4u v = qp[c]; qv[8 * c + 0] = bflo(v.x); qv[8 * c + 1] = bfhi(v.x); qv[8 * c + 2] = bflo(v.y); qv[8 * c + 3] = bfhi(v.y);
              qv[8 * c + 4] = bflo(v.z); qv[8 * c + 5] = bfhi(v.z); qv[8 * c + 6] = bflo(v.w); qv[8 * c + 7] = bfhi(v.w); } }
        __syncthreads();
        const int nmid = (i + 1) >> 1, n0 = half ? nmid : 0, n1 = half ? i : nmid;
        float b0 = -INFINITY, b1 = -INFINITY, b2 = -INFINITY; int i0 = -1, i1 = -1, i2 = -1;
#define TOP3_INS(v, idx) do { if ((v) > b0) { b2 = b1; i2 = i1; b1 = b0; i1 = i0; b0 = (v); i0 = (idx); } else if ((v) > b1) { b2 = b1; i2 = i1; b1 = (v); i1 = (idx); } else if ((v) > b2) { b2 = (v); i2 = (idx); } } while (0)
        for (int n = n0; n < n1; ++n) {
            const f32x4* kr = (const f32x4*)(km + n * 64);
            float a0 = 0.f, a1 = 0.f, a2 = 0.f, a3 = 0.f;
#pragma unroll
            for (int d4 = 0; d4 < 16; ++d4) { const f32x4 kv = kr[d4]; a0 += qv[4 * d4] * kv.x; a1 += qv[4 * d4 + 1] * kv.y; a2 += qv[4 * d4 + 2] * kv.z; a3 += qv[4 * d4 + 3] * kv.w; }
            const float g = (a0 + a1) + (a2 + a3);
            TOP3_INS(g, n);
        }
        if (half) { cval[q * 3 + 0] = b0; cval[q * 3 + 1] = b1; cval[q * 3 + 2] = b2; cidx[q * 3 + 0] = i0; cidx[q * 3 + 1] = i1; cidx[q * 3 + 2] = i2; }
        __syncthreads();
        int p0 = 0, p1 = 0, p2 = 0;
        const int nsel = i < 3 ? i : 3;
        if (!half) {
#pragma unroll
            for (int j = 0; j < 3; ++j) { const float v = cval[q * 3 + j]; const int id = cidx[q * 3 + j]; if (id >= 0) TOP3_INS(v, id); }
            if (nsel < 3) i2 = -1;
            if (nsel < 2) i1 = -1;
            int* sp = SEL + ((size_t)bh * SEQ + pos) * 4; sp[0] = i0; sp[1] = i1; sp[2] = i2; sp[3] = -1;
            p0 = atomicAdd(&cnt[i0], 1);
            if (i1 >= 0) p1 = atomicAdd(&cnt[i1], 1);
            if (i2 >= 0) p2 = atomicAdd(&cnt[i2], 1);
        }
#undef TOP3_INS
        __syncthreads();
        if (C.tid == 0) { int a = 0; for (int n = 0; n < 64; ++n) { offs[n] = a; a += cnt[n]; } offs[64] = a; }
        __syncthreads();
        if (!half) {
            unsigned short* lp = LIST + (size_t)u * 768;
            lp[offs[i0] + p0] = (unsigned short)(q | (0 << 8));
            if (i1 >= 0) lp[offs[i1] + p1] = (unsigned short)(q | (1 << 8));
            if (i2 >= 0) lp[offs[i2] + p2] = (unsigned short)(q | (2 << 8));
        }
        if (C.tid < 65) LOFF[(size_t)u * 80 + C.tid] = offs[C.tid];
        __syncthreads();
    }
}

__device__ __forceinline__ void phase_sgu_simple(const Ctx& C, int layer) {
    const bf16* U = (const bf16*)(C.ws + WS_PROJ) + (size_t)T_U * SUBSTRIDE;
    const bf16* V = (const bf16*)(C.ws + WS_PROJ) + (size_t)T_V * SUBSTRIDE;
    const bf16* ZA = (const bf16*)(C.ws + WS_PROJ) + (size_t)T_ZA * SUBSTRIDE;
    bf16* MIX = (bf16*)(C.ws + WS_MIX);
    const float* lng = C.ln_g + layer * 512; const float* lnb = C.ln_b + layer * 512;
    const float* Wl = C.sgu_w + (size_t)layer * 8 * 128 * 128; const float* bl = C.sgu_b + layer * 8 * 128;
    bf16* vh = (bf16*)C.lds;
    for (int u = C.bid; u < MROWS / 128; u += C.G) {
        const size_t row0 = (size_t)u * 128;
        for (int r = 0; r < 16; ++r) {
            const int t = C.wave * 16 + r;
            const v4u v = *(const v4u*)(V + (row0 + t) * 512 + C.lane * 8);
            float f[8] = {bflo(v.x), bfhi(v.x), bflo(v.y), bfhi(v.y), bflo(v.z), bfhi(v.z), bflo(v.w), bfhi(v.w)};
            float s = 0.f;
#pragma unroll
            for (int e = 0; e < 8; ++e) s += f[e];
            const float mean = wave_sum(s) * (1.0f / 512.0f);
            float s2 = 0.f;
#pragma unroll
            for (int e = 0; e < 8; ++e) { f[e] -= mean; s2 += f[e] * f[e]; }
            const float rstd = 1.0f / sqrtf(wave_sum(s2) * (1.0f / 512.0f) + LN_EPS);
            v4u o;
            float g8[8], b8[8];
#pragma unroll
            for (int e = 0; e < 8; ++e) { g8[e] = lng[C.lane * 8 + e]; b8[e] = lnb[C.lane * 8 + e]; }
            o.x = pk2(f[0] * rstd * g8[0] + b8[0], f[1] * rstd * g8[1] + b8[1]); o.y = pk2(f[2] * rstd * g8[2] + b8[2], f[3] * rstd * g8[3] + b8[3]);
            o.z = pk2(f[4] * rstd * g8[4] + b8[4], f[5] * rstd * g8[5] + b8[5]); o.w = pk2(f[6] * rstd * g8[6] + b8[6], f[7] * rstd * g8[7] + b8[7]);
            *(v4u*)(vh + t * 512 + C.lane * 8) = o;
        }
        __syncthreads();
        { const int c = C.tid, g = c >> 6;
          const float* Wg = Wl + (size_t)g * 128 * 128;
          for (int t = 0; t < 128; ++t) {
              float acc = 0.f;
              for (int s = 0; s <= t; ++s) acc += Wg[t * 128 + s] * __uint_as_float((unsigned)vh[s * 512 + c] << 16);
              acc += bl[g * 128 + t];
              const float uu = __uint_as_float((unsigned)U[(row0 + t) * 512 + c] << 16), zz = __uint_as_float((unsigned)ZA[(row0 + t) * 512 + c] << 16);
              MIX[(row0 + t) * 1024 + c] = (bf16)f2bf(uu * acc * zz);
          } }
        __syncthreads();
    }
}

__device__ __forceinline__ void phase_attn_simple(const Ctx& C, bf16* MIX) {
    const bf16* Q = (const bf16*)(C.ws + WS_PROJ) + (size_t)T_Q * SUBSTRIDE;
    const bf16* K = (const bf16*)(C.ws + WS_PROJ) + (size_t)T_K * SUBSTRIDE;
    const bf16* VV = (const bf16*)(C.ws + WS_PROJ) + (size_t)T_VV * SUBSTRIDE;
    const bf16* ZB = (const bf16*)(C.ws + WS_PROJ) + (size_t)T_ZB * SUBSTRIDE;
    const int* SEL = (const int*)(C.ws + WS_SEL); const float* BT = (const float*)(C.ws + WS_BT);
    const int gt = C.bid * 512 + C.tid, NT = C.G * 512;
    for (int item = gt; item < NBH * SEQ; item += NT) {
        const int bh = item >> 14, pos = item & (SEQ - 1), b = bh >> 3, h = bh & 7, own = pos >> 8;
        const size_t rowq = (size_t)(b * SEQ + pos);
        float qv[64], o[64];
        { const v4u* qp = (const v4u*)(Q + rowq * 512 + h * 64);
#pragma unroll
          for (int c = 0; c < 8; ++c) { const v4u v = qp[c]; qv[8 * c + 0] = bflo(v.x); qv[8 * c + 1] = bfhi(v.x); qv[8 * c + 2] = bflo(v.y); qv[8 * c + 3] = bfhi(v.y);
              qv[8 * c + 4] = bflo(v.z); qv[8 * c + 5] = bfhi(v.z); qv[8 * c + 6] = bflo(v.w); qv[8 * c + 7] = bfhi(v.w); } }
#pragma unroll
        for (int d = 0; d < 64; ++d) o[d] = 0.f;
        float m = -INFINITY, l = 0.f;
        const float* bt = BT + h * 128;
        for (int slot = 0; slot < 4; ++slot) {
            int blk, klim;
            if (slot == 0) { blk = own; klim = (pos & 255) + 1; } else { blk = SEL[(size_t)item * 4 + slot - 1]; klim = 256; if (blk < 0) klim = 0; }
            for (int kl = 0; kl < klim; ++kl) {
                const int kpos = blk * 256 + kl;
                const v4u* kp = (const v4u*)(K + ((size_t)(b * SEQ + kpos)) * 512 + h * 64);
                float a0 = 0.f, a1 = 0.f;
#pragma unroll
                for (int c = 0; c < 8; ++c) { const v4u v = kp[c];
                    a0 += qv[8 * c + 0] * bflo(v.x) + qv[8 * c + 2] * bflo(v.y) + qv[8 * c + 4] * bflo(v.z) + qv[8 * c + 6] * bflo(v.w);
                    a1 += qv[8 * c + 1] * bfhi(v.x) + qv[8 * c + 3] * bfhi(v.y) + qv[8 * c + 5] * bfhi(v.z) + qv[8 * c + 7] * bfhi(v.w); }
                int dd = pos - kpos; dd = dd > 127 ? 127 : dd;
                const float s = (a0 + a1) + bt[dd];
                if (s > m) { const float al = __builtin_amdgcn_exp2f(m - s); l *= al;
#pragma unroll
                    for (int d = 0; d < 64; ++d) o[d] *= al;
                    m = s; }
                const float p = __builtin_amdgcn_exp2f(s - m);
                l += p;
                const v4u* vp = (const v4u*)(VV + ((size_t)(b * SEQ + kpos)) * 512 + h * 64);
#pragma unroll
                for (int c = 0; c < 8; ++c) { const v4u v = vp[c];
                    o[8 * c + 0] += p * bflo(v.x); o[8 * c + 1] += p * bfhi(v.x); o[8 * c + 2] += p * bflo(v.y); o[8 * c + 3] += p * bfhi(v.y);
                    o[8 * c + 4] += p * bflo(v.z); o[8 * c + 5] += p * bfhi(v.z); o[8 * c + 6] += p * bflo(v.w); o[8 * c + 7] += p * bfhi(v.w); }
            }
        }
        const float rl = 1.0f / l;
        const v4u* zp = (const v4u*)(ZB + rowq * 512 + h * 64);
        v4u* op = (v4u*)(MIX + rowq * 1024 + 512 + h * 64);
#pragma unroll
        for (int c = 0; c < 8; ++c) { const v4u z = zp[c]; v4u w;
            w.x = pk2(o[8 * c + 0] * rl * bflo(z.x), o[8 * c + 1] * rl * bfhi(z.x)); w.y = pk2(o[8 * c + 2] * rl * bflo(z.y), o[8 * c + 3] * rl * bfhi(z.y));
            w.z = pk2(o[8 * c + 4] * rl * bflo(z.z), o[8 * c + 5] * rl * bfhi(z.z)); w.w = pk2(o[8 * c + 6] * rl * bflo(z.w), o[8 * c + 7] * rl * bfhi(z.w));
            op[c] = w; }
    }
}

typedef short bf16x8 __attribute__((ext_vector_type(8)));
typedef short bf16x4s __attribute__((ext_vector_type(4)));
typedef float f32x16 __attribute__((ext_vector_type(16)));
constexpr int AT_KS = 0, AT_KPITCH = 144;
constexpr int AT_VT = 36864, AT_VPITCH = 520;
constexpr int AT_DT = AT_VT + 64 * AT_VPITCH;
constexpr int AT_ENT = AT_DT + 512, AT_CAP = 4096;
constexpr int AT_PRE = AT_ENT + AT_CAP * 4;
constexpr int AT_OST = AT_PRE + 1024;
constexpr int AT_MISC = AT_OST + 8 * 4096;
constexpr int AT_NSEL_A = 60 * NBH, AT_NOWN = NBLK * NBH, AT_NUNITS = 63 * NBH + AT_NOWN;
__device__ __forceinline__ int crow(int r, int hi) { return (r & 3) + 8 * (r >> 2) + 4 * hi; }
__device__ __forceinline__ unsigned cvtpk(float lo, float hi) { unsigned r; asm volatile("v_cvt_pk_bf16_f32 %0, %1, %2" : "=v"(r) : "v"(lo), "v"(hi)); return r; }

template <bool OWN>
__device__ __forceinline__ void attn_tile(const Ctx& C, unsigned char* lds, int b, int h, int bh, int e0, int cnt, int nkt2) {
    const bf16* Q = (const bf16*)(C.ws + WS_PROJ) + (size_t)T_Q * SUBSTRIDE;
    bf16* PO = (bf16*)C.out; float* PL = (float*)(C.ws + WS_PL);
    const unsigned* ENT = (const unsigned*)(lds + AT_ENT);
    const float* DT = (const float*)(lds + AT_DT);
    const int lane = C.lane, q = lane & 31, hi = lane >> 5;
    const unsigned ent = ENT[(e0 + q < cnt) ? (e0 + q) : e0];
    const int pos = ent & 16383, qoff = (ent >> 16) & 1023;
    const bf16* qrow = Q + ((size_t)(b * SEQ + pos)) * 512 + h * 64 + hi * 8;
    bf16x8 qf[4];
#pragma unroll
    for (int ks = 0; ks < 4; ++ks) qf[ks] = *(const bf16x8*)(qrow + ks * 16);
    f32x16 o0 = {}, o1 = {};
    float l = 0.f;
    const bool anybias = OWN ? true : (__any(qoff < 112) != 0);
    const unsigned char* kbase = lds + AT_KS + q * AT_KPITCH + hi * 16;
    const unsigned char* vbase = lds + AT_VT + q * AT_VPITCH + hi * 8;
    for (int kt2 = 0; kt2 < nkt2; ++kt2) {
        f32x16 p0 = {}, p1 = {};
#pragma unroll
        for (int ks = 0; ks < 4; ++ks) {
            const bf16x8 k0 = *(const bf16x8*)(kbase + (64 * kt2) * AT_KPITCH + ks * 32);
            const bf16x8 k1 = *(const bf16x8*)(kbase + (64 * kt2 + 32) * AT_KPITCH + ks * 32);
            p0 = __builtin_amdgcn_mfma_f32_32x32x16_bf16(k0, qf[ks], p0, 0, 0, 0);
            p1 = __builtin_amdgcn_mfma_f32_32x32x16_bf16(k1, qf[ks], p1, 0, 0, 0);
        }
        if (anybias && (OWN || kt2 >= 2)) {
            const int dq = (OWN ? 0 : 256) + qoff - 64 * kt2;
#pragma unroll
            for (int r = 0; r < 16; ++r) {
                const int d0 = dq - crow(r, hi), d1 = d0 - 32;
                const float b0 = DT[d0 < 0 ? 0 : (d0 > 127 ? 127 : d0)], b1 = DT[d1 < 0 ? 0 : (d1 > 127 ? 127 : d1)];
                p0[r] = (OWN && d0 < 0) ? -INFINITY : p0[r] + b0;
                p1[r] = (OWN && d1 < 0) ? -INFINITY : p1[r] + b1;
            }
        }
#pragma unroll
        for (int r = 0; r < 16; ++r) { p0[r] = __builtin_amdgcn_exp2f(p0[r]); p1[r] = __builtin_amdgcn_exp2f(p1[r]); }
        float sa = 0.f, sb = 0.f;
#pragma unroll
        for (int r = 0; r < 16; ++r) { sa += p0[r]; sb += p1[r]; }
        l += sa + sb;
        v4u pa[4];
#pragma unroll
        for (int s = 0; s < 2; ++s) {
            pa[s] = (v4u){cvtpk(p0[8 * s + 0], p0[8 * s + 1]), cvtpk(p0[8 * s + 2], p0[8 * s + 3]), cvtpk(p0[8 * s + 4], p0[8 * s + 5]), cvtpk(p0[8 * s + 6], p0[8 * s + 7])};
            pa[2 + s] = (v4u){cvtpk(p1[8 * s + 0], p1[8 * s + 1]), cvtpk(p1[8 * s + 2], p1[8 * s + 3]), cvtpk(p1[8 * s + 4], p1[8 * s + 5]), cvtpk(p1[8 * s + 6], p1[8 * s + 7])};
        }
#pragma unroll
        for (int s = 0; s < 4; ++s) {
            const unsigned char* vp = vbase + (64 * kt2 + 16 * s) * 2;
            const bf16x4s a0 = *(const bf16x4s*)(vp), a1 = *(const bf16x4s*)(vp + 16);
            const bf16x4s c0 = *(const bf16x4s*)(vp + 32 * AT_VPITCH), c1 = *(const bf16x4s*)(vp + 32 * AT_VPITCH + 16);
            const bf16x8 vb0 = (bf16x8){a0[0], a0[1], a0[2], a0[3], a1[0], a1[1], a1[2], a1[3]};
            const bf16x8 vb1 = (bf16x8){c0[0], c0[1], c0[2], c0[3], c1[0], c1[1], c1[2], c1[3]};
            const bf16x8 paf = __builtin_bit_cast(bf16x8, pa[s]);
            o0 = __builtin_amdgcn_mfma_f32_32x32x16_bf16(paf, vb0, o0, 0, 0, 0);
            o1 = __builtin_amdgcn_mfma_f32_32x32x16_bf16(paf, vb1, o1, 0, 0, 0);
        }
    }
    l += __shfl_xor(l, 32);
    bf16* stg = (bf16*)(lds + AT_OST + C.wave * 4096);
#pragma unroll
    for (int r = 0; r < 16; ++r) { const int orow = crow(r, hi); stg[orow * 64 + q] = (bf16)f2bf(o0[r]); stg[orow * 64 + 32 + q] = (bf16)f2bf(o1[r]); }
    LDS_WAIT(); asm volatile("" ::: "memory");
#pragma unroll
    for (int it = 0; it < 4; ++it) {
        const int row = it * 8 + (lane >> 3), ch = lane & 7;
        if (e0 + row < cnt) {
            const unsigned er = ENT[e0 + row];
            const int pr = er & 16383, jr = (er >> 14) & 3;
            *(v4u*)(PO + (((size_t)bh * SEQ + pr) * 4 + jr) * 64 + ch * 8) = *(const v4u*)(stg + row * 64 + ch * 8);
        }
    }
    if (hi == 0 && e0 + q < cnt) PL[((size_t)bh * SEQ + pos) * 4 + ((ent >> 14) & 3)] = l;
    LDS_WAIT(); asm volatile("" ::: "memory");
}

__device__ __forceinline__ void phase_attn(const Ctx& C, int layer) {
    unsigned char* lds = C.lds;
    const bf16* K = (const bf16*)(C.ws + WS_PROJ) + (size_t)T_K * SUBSTRIDE;
    const bf16* VV = (const bf16*)(C.ws + WS_PROJ) + (size_t)T_VV * SUBSTRIDE;
    const int* LOFF = (const int*)(C.ws + WS_LOFF); const unsigned short* LIST = (const unsigned short*)(C.ws + WS_LIST);
    const float* BT = (const float*)(C.ws + WS_BT);
    unsigned* ctr = (unsigned*)(C.ws + WS_CTL) + 64 + 64 * layer;
    unsigned* ENT = (unsigned*)(lds + AT_ENT);
    int* PRE = (int*)(lds + AT_PRE); int* LO = PRE + 68;
    volatile unsigned* MISC = (volatile unsigned*)(lds + AT_MISC);
    const int tid = C.tid;
    for (;;) {
        if (tid == 0) MISC[0] = atomicAdd(ctr, 1u);
        __syncthreads();
        const int u = (int)MISC[0];
        if (u >= AT_NUNITS) break;
        bool own; int bh, n;
        if (u < AT_NSEL_A) { own = false; n = u >> 4; bh = u & 15; }
        else if (u < AT_NSEL_A + AT_NOWN) { own = true; const int k = u - AT_NSEL_A; n = 63 - (k >> 4); bh = k & 15; }
        else { own = false; const int k = u - AT_NSEL_A - AT_NOWN; n = 60 + (k >> 4); bh = k & 15; }
        const int b = bh >> 3, h = bh & 7;
        { const bf16* Kg = K + ((size_t)(b * SEQ + n * 256)) * 512 + h * 64;
          const bf16* Vg = VV + ((size_t)(b * SEQ + n * 256)) * 512 + h * 64;
#pragma unroll
          for (int it = 0; it < 4; ++it) { const int idx = tid + 512 * it, row = idx >> 3, ch = idx & 7;
              *(v4u*)(lds + AT_KS + row * AT_KPITCH + ch * 16) = *(const v4u*)(Kg + (size_t)row * 512 + ch * 8); }
#pragma unroll
          for (int it = 0; it < 4; ++it) { const int idx = tid + 512 * it, ch = idx >> 8, kv = idx & 255;
              const v4u v = *(const v4u*)(Vg + (size_t)kv * 512 + ch * 8);
              unsigned short* vt = (unsigned short*)(lds + AT_VT + (8 * ch) * AT_VPITCH + kv * 2);
              vt[0 * (AT_VPITCH / 2)] = (unsigned short)(v.x & 0xffff); vt[1 * (AT_VPITCH / 2)] = (unsigned short)(v.x >> 16);
              vt[2 * (AT_VPITCH / 2)] = (unsigned short)(v.y & 0xffff); vt[3 * (AT_VPITCH / 2)] = (unsigned short)(v.y >> 16);
              vt[4 * (AT_VPITCH / 2)] = (unsigned short)(v.z & 0xffff); vt[5 * (AT_VPITCH / 2)] = (unsigned short)(v.z >> 16);
              vt[6 * (AT_VPITCH / 2)] = (unsigned short)(v.w & 0xffff); vt[7 * (AT_VPITCH / 2)] = (unsigned short)(v.w >> 16); }
          if (tid < 128) ((float*)(lds + AT_DT))[tid] = BT[h * 128 + tid] - BT[h * 128 + 127]; }
        int total;
        if (own) total = 256;
        else {
            if (tid < 64) {
                const int i = n + 1 + tid; int c = 0, lo = 0;
                if (i < NBLK) { const int* lp = LOFF + ((size_t)(bh * NBLK + i)) * 80 + n; lo = lp[0]; c = lp[1] - lo; }
                int inc = c;
#pragma unroll
                for (int o = 1; o < 64; o <<= 1) { const int t = __shfl_up(inc, o); if (tid >= o) inc += t; }
                PRE[tid + 1] = inc; LO[tid] = lo; if (tid == 0) PRE[0] = 0;
            }
            __syncthreads();
            total = PRE[63 - n];
        }
        for (int base = 0; base < total; base += AT_CAP) {
            const int cnt = (total - base < AT_CAP) ? (total - base) : AT_CAP;
            if (own) { if (tid < 256) ENT[tid] = (unsigned)(n * 256 + tid) | (3u << 14) | ((unsigned)tid << 16); }
            else {
                for (int ii = C.wave; ii < 63 - n; ii += 8) {
                    const int i = n + 1 + ii, s0 = PRE[ii], s1 = PRE[ii + 1];
                    const int lo = s0 > base ? s0 : base, hi_ = s1 < base + cnt ? s1 : base + cnt;
                    const unsigned short* lp = LIST + ((size_t)(bh * NBLK + i)) * 768 + LO[ii];
                    for (int e = lo + C.lane; e < hi_; e += 64) {
                        const unsigned val = lp[e - s0]; const unsigned ql = val & 255u, j = val >> 8;
                        ENT[e - base] = (unsigned)(i * 256 + ql) | (j << 14) | ((ii == 0 ? ql : 1023u) << 16);
                    }
                }
            }
            __syncthreads();
            const int ntiles = (cnt + 31) >> 5;
            for (int tile = C.wave; tile < ntiles; tile += 8) {
                if (own) attn_tile<true>(C, lds, b, h, bh, tile * 32, cnt, (tile >> 1) + 1);
                else attn_tile<false>(C, lds, b, h, bh, tile * 32, cnt, 4);
            }
            __syncthreads();
        }
        __syncthreads();
    }
}

__device__ __forceinline__ void phase_combine(const Ctx& C) {
    const bf16* PO = (const bf16*)C.out; const float* PL = (const float*)(C.ws + WS_PL);
    const bf16* ZB = (const bf16*)(C.ws + WS_PROJ) + (size_t)T_ZB * SUBSTRIDE;
    bf16* MIX = (bf16*)(C.ws + WS_MIX);
    const int gt = C.bid * 512 + C.tid, NT = C.G * 512;
    for (int idx = gt; idx < MROWS * 64; idx += NT) {
        const int ch = idx & 7, h = (idx >> 3) & 7, row = idx >> 6, b = row >> 14, pos = row & (SEQ - 1), i = pos >> 8;
        const size_t pb = ((size_t)(b * NH + h) * SEQ + pos) * 4;
        const f32x4 lv = *(const f32x4*)(PL + pb);
        float L = lv[3];
        float acc[8];
        { const v4u v = *(const v4u*)(PO + (pb + 3) * 64 + ch * 8);
          acc[0] = bflo(v.x); acc[1] = bfhi(v.x); acc[2] = bflo(v.y); acc[3] = bfhi(v.y); acc[4] = bflo(v.z); acc[5] = bfhi(v.z); acc[6] = bflo(v.w); acc[7] = bfhi(v.w); }
#pragma unroll
        for (int j = 0; j < 3; ++j) if (j < i) {
            const v4u v = *(const v4u*)(PO + (pb + j) * 64 + ch * 8);
            L += lv[j];
            acc[0] += bflo(v.x); acc[1] += bfhi(v.x); acc[2] += bflo(v.y); acc[3] += bfhi(v.y); acc[4] += bflo(v.z); acc[5] += bfhi(v.z); acc[6] += bflo(v.w); acc[7] += bfhi(v.w);
        }
        const float rl = 1.0f / L;
        const v4u z = *(const v4u*)(ZB + (size_t)row * 512 + h * 64 + ch * 8);
        v4u w;
        w.x = pk2(acc[0] * rl * bflo(z.x), acc[1] * rl * bfhi(z.x)); w.y = pk2(acc[2] * rl * bflo(z.y), acc[3] * rl * bfhi(z.y));
        w.z = pk2(acc[4] * rl * bflo(z.z), acc[5] * rl * bfhi(z.z)); w.w = pk2(acc[6] * rl * bflo(z.w), acc[7] * rl * bfhi(z.w));
        *(v4u*)(MIX + (size_t)row * 1024 + 512 + h * 64 + ch * 8) = w;
    }
}

constexpr int SG_VPITCH = 272, SG_MPITCH = 144, SG_WREG = 128 * SG_MPITCH;
constexpr int SG_STATS = 8 * SG_WREG;
constexpr int SG_MR = SG_STATS + 8192;
constexpr int SG_LN = SG_MR + 1024;
__device__ __forceinline__ void phase_sgu(const Ctx& C, int layer) {
    typedef float f32x2v __attribute__((ext_vector_type(2)));
    unsigned char* lds = C.lds;
    const bf16* U = (const bf16*)(C.ws + WS_PROJ) + (size_t)T_U * SUBSTRIDE;
    const bf16* V = (const bf16*)(C.ws + WS_PROJ) + (size_t)T_V * SUBSTRIDE;
    const bf16* ZA = (const bf16*)(C.ws + WS_PROJ) + (size_t)T_ZA * SUBSTRIDE;
    bf16* MIX = (bf16*)(C.ws + WS_MIX);
    const int g = C.wave; int lane = C.lane;
    const float* lng = C.ln_g + layer * 512 + g * 64; const float* lnb = C.ln_b + layer * 512 + g * 64;
    const bf16* Wg = (const bf16*)(C.ws + WS_WST) + ((size_t)(layer * 8 + g)) * 128 * 128;
    const float* bg = C.sgu_b + (layer * 8 + g) * 128;
    unsigned char* myreg = lds + g * SG_WREG;
    f32x2v* stats = (f32x2v*)(lds + SG_STATS); f32x2v* mr = (f32x2v*)(lds + SG_MR);
    float* lnl = (float*)(lds + SG_LN + g * 512);
    lnl[lane] = lng[lane]; lnl[64 + lane] = lnb[lane];
    for (int u = C.bid; u < MROWS / 128; u += C.G) {
        const size_t row0 = (size_t)u * 128;
        asm volatile("" : "+v"(lane));
        v4u xv[2][8];
#pragma unroll
        for (int rr = 0; rr < 2; ++rr) {
            const v4u* vp = (const v4u*)(V + (row0 + lane + 64 * rr) * 512 + g * 64);
#pragma unroll
            for (int c = 0; c < 8; ++c) xv[rr][c] = vp[c];
        }
#pragma unroll
        for (int rr = 0; rr < 2; ++rr) {
            float s1 = 0.f, s2 = 0.f;
#pragma unroll
            for (int c = 0; c < 8; ++c) { const v4u v = xv[rr][c];
                const float f0 = bflo(v.x), f1 = bfhi(v.x), f2 = bflo(v.y), f3 = bfhi(v.y), f4 = bflo(v.z), f5 = bfhi(v.z), f6 = bflo(v.w), f7 = bfhi(v.w);
                s1 += ((f0 + f1) + (f2 + f3)) + ((f4 + f5) + (f6 + f7));
                s2 += ((f0 * f0 + f1 * f1) + (f2 * f2 + f3 * f3)) + ((f4 * f4 + f5 * f5) + (f6 * f6 + f7 * f7)); }
            stats[g * 128 + lane + 64 * rr] = (f32x2v){s1, s2};
        }
        __syncthreads();
        if (C.tid < 128) {
            float s1 = 0.f, s2 = 0.f;
#pragma unroll
            for (int w = 0; w < 8; ++w) { const f32x2v t = stats[w * 128 + C.tid]; s1 += t.x; s2 += t.y; }
            const float mean = s1 * (1.0f / 512.0f), var = s2 * (1.0f / 512.0f) - mean * mean;
            mr[C.tid] = (f32x2v){mean, 1.0f / sqrtf(var + LN_EPS)};
        }
        __syncthreads();
#pragma unroll
        for (int c = 0; c < 8; ++c) asm volatile("" : "+v"(xv[0][c]), "+v"(xv[1][c]));
        { const f32x2v m0 = mr[lane], m1 = mr[lane + 64];
          unsigned short* vt = (unsigned short*)(myreg + lane * 2);
#pragma unroll
          for (int c = 0; c < 8; ++c) {
              const v4u v0 = xv[0][c], v1 = xv[1][c];
              const float f0[8] = {bflo(v0.x), bfhi(v0.x), bflo(v0.y), bfhi(v0.y), bflo(v0.z), bfhi(v0.z), bflo(v0.w), bfhi(v0.w)};
              const float f1[8] = {bflo(v1.x), bfhi(v1.x), bflo(v1.y), bfhi(v1.y), bflo(v1.z), bfhi(v1.z), bflo(v1.w), bfhi(v1.w)};
#pragma unroll
              for (int e = 0; e < 8; ++e) { const int d = 8 * c + e; const float gg = lnl[d], bbv = lnl[64 + d];
                  vt[d * (SG_VPITCH / 2)] = (unsigned short)f2bf((f0[e] - m0.x) * m0.y * gg + bbv);
                  vt[d * (SG_VPITCH / 2) + 64] = (unsigned short)f2bf((f1[e] - m1.x) * m1.y * gg + bbv); }
              asm volatile("" ::: "memory");
          } }
        LDS_WAIT(); asm volatile("" ::: "memory");
        { const int q = lane & 31, hi = lane >> 5;
          const bf16* wa = Wg + (size_t)q * 128 + hi * 8;
          unsigned pk[2][4][8];
#pragma unroll
          for (int dt = 0; dt < 2; ++dt) {
              const unsigned char* bb = myreg + (32 * dt + q) * SG_VPITCH + hi * 16;
              f32x16 acc[4];
#pragma unroll
              for (int tt = 0; tt < 4; ++tt) acc[tt] = (f32x16){};
              bf16x8 an[4];
#pragma unroll
              for (int tt = 0; tt < 4; ++tt) an[tt] = *(const bf16x8*)(wa + (size_t)tt * 32 * 128);
#pragma unroll
              for (int ks = 0; ks < 8; ++ks) {
                  bf16x8 ac[4];
#pragma unroll
                  for (int tt = 0; tt < 4; ++tt) ac[tt] = an[tt];
                  if (ks < 7) {
#pragma unroll
                      for (int tt = 0; tt < 4; ++tt) if (tt >= ((ks + 1) >> 1)) an[tt] = *(const bf16x8*)(wa + (size_t)tt * 32 * 128 + (ks + 1) * 16);
                  }
                  const bf16x8 b0 = *(const bf16x8*)(bb + ks * 32);
#pragma unroll
                  for (int tt = 0; tt < 4; ++tt) if (tt >= (ks >> 1)) acc[tt] = __builtin_amdgcn_mfma_f32_32x32x16_bf16(ac[tt], b0, acc[tt], 0, 0, 0);
                  asm volatile("" ::: "memory");
              }
#pragma unroll
              for (int tt = 0; tt < 4; ++tt)
#pragma unroll
                  for (int rp = 0; rp < 8; ++rp) pk[dt][tt][rp] = cvtpk(acc[tt][2 * rp], acc[tt][2 * rp + 1]);
          }
          LDS_WAIT(); asm volatile("" ::: "memory");
          unsigned char* mxb = myreg + (4 * hi) * SG_MPITCH + q * 2;
#pragma unroll
          for (int dt = 0; dt < 2; ++dt)
#pragma unroll
              for (int tt = 0; tt < 4; ++tt)
#pragma unroll
                  for (int r = 0; r < 16; ++r)
                      *(unsigned short*)(mxb + (32 * tt + (r & 3) + 8 * (r >> 2)) * SG_MPITCH + 64 * dt) = (unsigned short)((r & 1) ? (pk[dt][tt][r >> 1] >> 16) : (pk[dt][tt][r >> 1] & 0xffffu));
        }
        LDS_WAIT(); asm volatile("" ::: "memory");
        { const int ch = lane & 7, r8 = lane >> 3;
#pragma unroll 4
          for (int it = 0; it < 16; ++it) {
              const int t = it * 8 + r8;
              const v4u mv = *(const v4u*)(myreg + t * SG_MPITCH + ch * 16);
              const v4u uv = *(const v4u*)(U + (row0 + t) * 512 + g * 64 + ch * 8), zv = *(const v4u*)(ZA + (row0 + t) * 512 + g * 64 + ch * 8);
              const float bt = bg[t];
              v4u o;
              o.x = pk2(bflo(uv.x) * (bflo(mv.x) + bt) * bflo(zv.x), bfhi(uv.x) * (bfhi(mv.x) + bt) * bfhi(zv.x));
              o.y = pk2(bflo(uv.y) * (bflo(mv.y) + bt) * bflo(zv.y), bfhi(uv.y) * (bfhi(mv.y) + bt) * bfhi(zv.y));
              o.z = pk2(bflo(uv.z) * (bflo(mv.z) + bt) * bflo(zv.z), bfhi(uv.z) * (bfhi(mv.z) + bt) * bfhi(zv.z));
              o.w = pk2(bflo(uv.w) * (bflo(mv.w) + bt) * bflo(zv.w), bfhi(uv.w) * (bfhi(mv.w) + bt) * bfhi(zv.w));
              *(v4u*)(MIX + (row0 + t) * 1024 + g * 64 + ch * 8) = o;
          } }
        __syncthreads();
    }
}

__device__ __forceinline__ void phase_final(const Ctx& C) {
    const float* rowss = (const float*)(C.ws + WS_ROWSS);
    const float chk = CHECK_ATTN ? __uint_as_float(((const unsigned*)(C.ws + WS_CTL))[32]) : 0.f;
    const int gw = C.bid * NWAVES + C.wave, NGW = C.G * NWAVES;
    f32x4 g[4];
#pragma unroll
    for (int j = 0; j < 4; ++j) g[j] = ((const f32x4*)C.final_g)[64 * j + C.lane];
    for (int m = gw; m < MROWS; m += NGW) {
        float ss = (C.lane < 16) ? rowss[(size_t)m * 16 + C.lane] : 0.f;
        ss = wave_sum(ss);
        float rs = 1.0f / sqrtf(ss * (1.0f / 1024.0f) + NORM_EPS);
        f32x4* xr = (f32x4*)(C.out + (size_t)m * DM) + C.lane;
#pragma unroll
        for (int j = 0; j < 4; ++j) { f32x4 v = xr[64 * j]; v = v * rs * g[j]; if (CHECK_ATTN && m == 0 && j == 0 && C.lane == 0) v.x = chk * 1e6f; xr[64 * j] = v; }
    }
}

#define GAS __attribute__((address_space(1)))
typedef GAS unsigned gu32;
#define RLX_AGENT __ATOMIC_RELAXED, __HIP_MEMORY_SCOPE_AGENT
constexpr int CW_BAR = 4096;
constexpr int LDS_BARST = LDS_BYTES - 64;
#define XB_TMO      128
#define XB_XCNT(j)  (256  + 64 * (j))
#define XB_XSUB(j)  (1280 + 64 * (j))
#define XB_XGEN(j)  (2304 + 64 * (j))
#define XB_TOP      3328
#define XB_TOPGEN   3392
#define XCD_BAR_WORDS 3456
#define XB_SPIN_CAP (1u << 18)

__device__ __forceinline__ unsigned xb_ld(unsigned* p)              { return __hip_atomic_load(p, __ATOMIC_RELAXED, __HIP_MEMORY_SCOPE_AGENT); }
__device__ __forceinline__ unsigned xb_add(unsigned* p, unsigned v) { return __hip_atomic_fetch_add(p, v, __ATOMIC_RELAXED, __HIP_MEMORY_SCOPE_AGENT); }
__device__ __forceinline__ unsigned xb_xcc_id() { return (unsigned)__builtin_amdgcn_s_getreg((3 << 11) | 20) & 0xFu; }
#define XB_SPIN(cond, bar) do { unsigned _sp = 0; while (cond) { __builtin_amdgcn_s_sleep(1); \
    if ((++_sp & 255u) == 0u) { if (xb_ld(&(bar)[XB_TMO])) break; if (_sp > XB_SPIN_CAP) { atomicAdd(&(bar)[XB_TMO], 1u); break; } } } } while (0)

struct XcdBarrier {
    unsigned* bar; unsigned x;
    volatile LAS unsigned* st;
};

__device__ __forceinline__ XcdBarrier xcd_barrier_post(unsigned* bar, volatile LAS unsigned* st) {
    XcdBarrier b; b.bar = bar; b.x = xb_xcc_id(); b.st = st;
    if (threadIdx.x == 0) (void)xb_add(&bar[XB_XCNT(b.x)], 1u);
    return b;
}
__device__ __forceinline__ void xcd_barrier_complete(unsigned* bar, unsigned x, unsigned& nloc, unsigned& nx) {
    const unsigned G = gridDim.x * gridDim.y * gridDim.z;
    unsigned sum, cnt, mine, sp = 0u;
    for (;;) {
        sum = 0u; cnt = 0u; mine = 0u;
#pragma unroll
        for (unsigned j = 0; j < 16; ++j) { const unsigned c = xb_ld(&bar[XB_XCNT(j)]); sum += c; cnt += (c > 0u) ? 1u : 0u; mine = (j == x) ? c : mine; }
        if (sum == G) break;
        __builtin_amdgcn_s_sleep(1);
        if ((++sp & 255u) == 0u) { if (xb_ld(&bar[XB_TMO])) break; if (sp > XB_SPIN_CAP) { atomicAdd(&bar[XB_TMO], 1u); break; } }
    }
    nloc = mine > 0u ? mine : 1u; nx = cnt > 0u ? cnt : 1u;
}

__device__ __forceinline__ void xcd_barrier(const XcdBarrier& b) {
    asm volatile("s_waitcnt vmcnt(0)" ::: "memory");
    __syncthreads();
    if (threadIdx.x == 0) {
        unsigned* bar = b.bar;
        __builtin_amdgcn_s_waitcnt(0);
        unsigned nloc = b.st[0], nx = b.st[1];
        if (nloc == 0u) { xcd_barrier_complete(bar, b.x, nloc, nx); b.st[0] = nloc; b.st[1] = nx; }
        const unsigned old = xb_add(&bar[XB_XSUB(b.x)], 1u);
        const unsigned gen = old / nloc;
        if (old + 1u == (gen + 1u) * nloc) {
            __builtin_amdgcn_fence(__ATOMIC_RELEASE, "agent");
            asm volatile("s_waitcnt vmcnt(0)" ::: "memory");
            const unsigned og = xb_add(&bar[XB_TOP], 1u);
            const unsigned tg = og / nx;
            if (og + 1u == (tg + 1u) * nx) xb_add(&bar[XB_TOPGEN], 1u);
            else XB_SPIN(xb_ld(&bar[XB_TOPGEN]) == tg, bar);
            __builtin_amdgcn_fence(__ATOMIC_ACQUIRE, "agent");
            xb_add(&bar[XB_XGEN(b.x)], 1u);
            asm volatile("s_waitcnt vmcnt(0)" ::: "memory");
        } else {
            XB_SPIN(xb_ld(&bar[XB_XGEN(b.x)]) == gen, bar);
            __builtin_amdgcn_fence(__ATOMIC_ACQUIRE, "agent");
            asm volatile("s_waitcnt vmcnt(0)" ::: "memory");
        }
    }
    __syncthreads();
}

#ifndef ATTN_OPT
#define ATTN_OPT 1
#endif
template <int ST> __device__ __forceinline__ void run_stage(const Args& args, unsigned char* lds, int Lr) {
    const int L = Lr & 15, rep = Lr >> 4;
    Ctx C;
    { int t = threadIdx.x; asm volatile("" : "+v"(t)); C.tid = t; }
    C.lds = lds; C.lane = C.tid & 63; C.wave = __builtin_amdgcn_readfirstlane(C.tid >> 6); C.G = gridDim.x; C.bid = blockIdx.x;
    C.x = args.in[0]; C.norm_g = args.in[1]; C.w_in = args.in[2]; C.ln_g = args.in[3]; C.ln_b = args.in[4]; C.sgu_w = args.in[5]; C.sgu_b = args.in[6];
    C.w_out = args.in[7]; C.rel_bias = args.in[8]; C.final_g = args.in[9]; C.out = args.out; C.ws = args.ws;
    asm volatile("" : "+s"(C.ws), "+s"(C.out), "+s"(C.x), "+s"(C.sgu_b), "+s"(C.ln_g), "+s"(C.ln_b));
    if constexpr (ST == 0) phase_prologue(C);
    else if constexpr (ST == 1) {
        pg8::Gemm g{(const pg8::bf16_t*)(C.ws + WS_XB), (const pg8::bf16_t*)(C.ws + WS_WIN) + (size_t)L * DIN * DM, MROWS, DIN, DM};
        pg8::StaticOrder S; S.init(MROWS, DIN, C.G, C.bid);
        pg8::EpiProj E{(pg8::bf16_t*)(C.ws + WS_PROJ), SUBSTRIDE, (const float*)(C.ws + WS_ROWSS), (float*)(C.ws + WS_KMEAN) + (size_t)L * NBH * NBLK * 64};
        pg8::gemm_phase<pg8::EpiProj, pg8::StaticOrder, true, true>((PG8_LAS unsigned char*)lds, g, S, E, C.tid);
    } else if constexpr (ST == 2) phase_kmean(C);
    else if constexpr (ST == 3) { phase_gate(C, L); if (SGU_OPT) phase_sgu(C, L); else phase_sgu_simple(C, L); }
    else if constexpr (ST == 4) { if (ATTN_OPT) phase_attn(C, L + 2 * rep); else phase_attn_simple(C, (bf16*)(C.ws + WS_MIX)); }
    else if constexpr (ST == 5) { if (ATTN_OPT) phase_combine(C); }
    else if constexpr (ST == 6) {
        pg8::Gemm g{(const pg8::bf16_t*)(C.ws + WS_MIX), (const pg8::bf16_t*)(C.ws + WS_WOUT) + (size_t)L * DM * DM, MROWS, DM, DM};
        pg8::StaticOrder S; S.init(MROWS, DM, C.G, C.bid);
        if (L == 0) { pg8::EpiRes<false> E{C.x, C.out, (pg8::bf16_t*)(C.ws + WS_XB), (float*)(C.ws + WS_ROWSS)};
            pg8::gemm_phase<pg8::EpiRes<false>, pg8::StaticOrder, true, true>((PG8_LAS unsigned char*)lds, g, S, E, C.tid); }
        else { pg8::EpiRes<true> E{C.x, C.out, (pg8::bf16_t*)(C.ws + WS_XB), (float*)(C.ws + WS_ROWSS)};
            pg8::gemm_phase<pg8::EpiRes<true>, pg8::StaticOrder, true, true>((PG8_LAS unsigned char*)lds, g, S, E, C.tid); }
    } else if constexpr (ST == 7) phase_final(C);
    else if constexpr (ST == 8) phase_attn_simple(C, (bf16*)(C.ws + 104 * MiB));
    else if constexpr (ST == 9) {
        const bf16* A = (const bf16*)(C.ws + WS_MIX); const bf16* B = (const bf16*)(C.ws + 104 * MiB); unsigned* flag = (unsigned*)(C.ws + WS_CTL) + 32;
        float md = 0.f;
        for (size_t idx = (size_t)C.bid * 512 + C.tid; idx < (size_t)MROWS * 512; idx += (size_t)C.G * 512) {
            const size_t row = idx >> 9, col = 512 + (idx & 511);
            const float a = __uint_as_float((unsigned)A[row * 1024 + col] << 16), r = __uint_as_float((unsigned)B[row * 1024 + col] << 16);
            float sc = fabsf(r);
#pragma unroll
            for (int o = 1; o < 64; o <<= 1) sc = fmaxf(sc, __shfl_xor(sc, o));
            const float d = fabsf(a - r) / (0.02f + sc);
            md = (d > md || !(d == d)) ? (d == d ? d : 1e6f) : md;
        }
        atomicMax(flag, __float_as_uint(md));
    }
}
template <int SEL> __global__ void __launch_bounds__(NWAVES * 64, 2) fwd(Args args) {
    extern __shared__ __attribute__((aligned(16))) unsigned char lds[];
    if constexpr (SEL >= 0) run_stage<SEL>(args, lds, args.layer);
    else {
        if (args.pad == 0x7fffffff) cg::this_grid().sync();
        volatile LAS unsigned* bst = (volatile LAS unsigned*)((LAS unsigned char*)lds + LDS_BARST);
        if (threadIdx.x == 0) { bst[0] = 0u; bst[1] = 0u; }
        __syncthreads();
        XcdBarrier bar = xcd_barrier_post((unsigned*)(args.ws + WS_CTL) + CW_BAR, bst);
#define GRID_SYNC() xcd_barrier(bar)
#define RUN(k, L) do { run_stage<k>(args, lds, L); GRID_SYNC(); if (REPEAT_MASK & (1 << k)) { run_stage<k>(args, lds, L + 16); GRID_SYNC(); } } while (0)
        RUN(0, 0);
        for (int L = 0; L < DEPTH; ++L) {
            RUN(1, L); RUN(3, L); RUN(4, L);
            if (ATTN_OPT) RUN(5, L);
            RUN(6, L);
        }
        run_stage<7>(args, lds, 0);
    }
}

#ifndef MK_N_LAUNCHES
#define MK_N_LAUNCHES 1
#endif
template <int SEL> static void launch_stage(int grid, Args a, int layer, hipStream_t stream) {
    static bool attr = false;
    if (!attr) { (void)hipFuncSetAttribute((const void*)fwd<SEL>, hipFuncAttributeMaxDynamicSharedMemorySize, LDS_BYTES); attr = true; }
    a.layer = layer;
    hipLaunchKernelGGL(fwd<SEL>, dim3(grid), dim3(NWAVES * 64), LDS_BYTES, stream, a);
}
extern "C" void kernel_launch(void* const* d_in, const int* in_sizes, int n_in, void* d_out, int out_size, void* d_ws, size_t ws_size, hipStream_t stream) {
    static int grid = 0;
    if (grid == 0) {
        if (n_in != 10 || out_size != MROWS * DM || ws_size < WS_END) { fprintf(stderr, "kernel_launch: unexpected shapes (n_in %d out %d ws %zu)\n", n_in, out_size, ws_size); grid = -1; return; }
        int dev = 0, cus = 0;
        (void)hipGetDevice(&dev); (void)hipDeviceGetAttribute(&cus, hipDeviceAttributeMultiprocessorCount, dev);
        grid = cus;
#if MK_N_LAUNCHES == 1
        int per_cu = 0;
        if (hipFuncSetAttribute((const void*)fwd<-1>, hipFuncAttributeMaxDynamicSharedMemorySize, LDS_BYTES) != hipSuccess) { fprintf(stderr, "kernel_launch: hipFuncSetAttribute failed\n"); grid = -1; return; }
        if (hipOccupancyMaxActiveBlocksPerMultiprocessor(&per_cu, (const void*)fwd<-1>, NWAVES * 64, LDS_BYTES) != hipSuccess || per_cu < 1) { fprintf(stderr, "kernel_launch: occupancy query says %d\n", per_cu); grid = -1; return; }
        (void)hipGetLastError();
#endif
    }
    if (grid < 0) return;
    (void)hipMemsetAsync((char*)d_ws + WS_CTL, 0, CTL_ZERO_BYTES, stream);
    Args a{};
    for (int i = 0; i < 10; ++i) a.in[i] = (const float*)d_in[i];
    a.out = (float*)d_out; a.ws = (unsigned char*)d_ws;
#if MK_N_LAUNCHES == 1
    void* kargs[] = {&a};
    hipError_t e = hipLaunchCooperativeKernel((const void*)fwd<-1>, dim3(grid), dim3(NWAVES * 64), kargs, LDS_BYTES, stream);
    if (e != hipSuccess) fprintf(stderr, "kernel_launch: cooperative launch failed: %s\n", hipGetErrorString(e));
#else
    launch_stage<0>(grid, a, 0, stream);
    for (int L = 0; L < DEPTH; ++L) {
        launch_stage<1>(grid, a, L, stream); launch_stage<3>(grid, a, L, stream);
        launch_stage<4>(grid, a, L, stream); launch_stage<5>(grid, a, L, stream);
        if (CHECK_ATTN && L == 0) { launch_stage<8>(grid, a, L, stream); launch_stage<9>(grid, a, L, stream); }
        launch_stage<6>(grid, a, L, stream);
    }
    launch_stage<7>(grid, a, 0, stream);
#endif
}
```

```cpp
#include <hip/hip_runtime.h>
#include <hip/hip_cooperative_groups.h>
#include <cstdio>
#include <cstdint>
namespace cg = cooperative_groups;

constexpr int BATCH = 2, SEQ = 16384, DM = 1024, MROWS = BATCH * SEQ, DIN = 3584, DSUB = 512;
constexpr int NH = 8, DH = 64, NBLK = SEQ / 256, NBH = BATCH * NH, DEPTH = 2;
constexpr float NORM_EPS = 1e-6f, LN_EPS = 1e-5f;
constexpr float LOG2E = 1.4426950408889634f;
#ifndef SGU_OPT
#define SGU_OPT 1
#endif
#ifndef REPEAT_MASK
#define REPEAT_MASK 0
#endif
#ifndef CHECK_ATTN
#define CHECK_ATTN 0
#endif
#ifndef CHECK_TOL_ABS
#define CHECK_TOL_ABS 2e-4f
#define CHECK_TOL_REL 0.02f
#endif
constexpr float QSCALE = 0.125f * LOG2E;
namespace pg8 {
#define PG8_LAS __attribute__((address_space(3)))
typedef unsigned short bf16_t;
typedef short bf16x8 __attribute__((ext_vector_type(8)));
typedef float f32x4 __attribute__((ext_vector_type(4)));
typedef unsigned u32x4 __attribute__((ext_vector_type(4)));
constexpr int BM = 256, BK = 64, HALF = 128, HTB = HALF * BK * 2  , STAGE_BYTES = 8 * HTB, NXCD = 8, WGM = 8;

__host__ __device__ __forceinline__ int lds_byte(int r, int c) { const int st = (r >> 4) * 2 + (c >> 5), rr = r & 15, cc = c & 31, ob = rr * 64 + cc * 2; return st * 1024 + (ob ^ (((ob >> 9) & 1) << 5)); }
__host__ __device__ __forceinline__ void stage_rc(int b, int& R, int& C) { const int st = b / 1024, sb = b % 1024, swz = sb ^ (((sb >> 9) & 1) << 5); R = (st >> 1) * 16 + swz / 64; C = (st & 1) * 32 + (swz % 64) / 2; }
__host__ __device__ __forceinline__ int perm32(int rho) { const int n = rho >> 4, i = rho & 15; return 8 * (i >> 2) + 4 * n + (i & 3); }

struct Unit { int pm, pn; };
struct Gemm { const bf16_t* A; const bf16_t* Bt; int M, N, K; };

struct StaticOrder {
    int nM, nN, nwg, G, c;
    __host__ __device__ void init(int M, int N, int G_, int c_) { nM = M / BM; nN = N / BM; nwg = nM * nN; G = G_; c = c_; }
    __host__ __device__ bool next(int i, Unit& u) const {
        const long L = (long)i * G + c; if (L >= nwg) return false;
        int wgid = (int)L; { const int q = nwg / NXCD, r = nwg % NXCD, xcd = wgid % NXCD, off = wgid / NXCD; wgid = (xcd < r ? xcd * (q + 1) : r * (q + 1) + (xcd - r) * q) + off; }
        const int nig = WGM * nN, gid = wgid / nig, fm = gid * WGM, gsz = (nM - fm) < WGM ? (nM - fm) : WGM;
        u.pm = fm + ((wgid % nig) % gsz); u.pn = (wgid % nig) / gsz; return true;
    }
    __device__ __forceinline__ void a_ready(const Unit&) const {}
    __device__ __forceinline__ void done(const Unit&) const {}
};

__device__ __forceinline__ unsigned cvt_pk_bf16(float lo, float hi) { unsigned r; asm volatile("v_cvt_pk_bf16_f32 %0, %1, %2" : "=v"(r) : "v"(lo), "v"(hi)); return r; }
typedef float f32x2 __attribute__((ext_vector_type(2)));
typedef float f32x2 __attribute__((ext_vector_type(2)));
__device__ __forceinline__ float act_gelu(float x) {
    const float u = x * (1.0f + 0.044715f * x * x);
    const float e = __builtin_amdgcn_exp2f(u * (-2.0f * 0.7978845608028654f * 1.4426950408889634f));
    return x * __builtin_amdgcn_rcpf(1.0f + e);
}
__device__ __forceinline__ float act_silu(float x) {
    const float e = __builtin_amdgcn_exp2f(x * (-1.4426950408889634f));
    return x * __builtin_amdgcn_rcpf(1.0f + e);
}
struct EpiProj {
    static constexpr bool PERM = true, AFTER_DRAIN = false;
    bf16_t* P; size_t sub_stride; const float* rowss; float* kmean;
    __device__ __forceinline__ void operator()(const f32x4 (&acc)[2][2][4][2], const Unit& u, int wr, int wc, int fr, int fq) const {
        const int t = u.pn >> 1;
        bf16_t* base = P + (size_t)t * sub_stride;
        const int col0 = (u.pn & 1) * 256 + wc * 32 + 8 * fq;
        const int row0 = u.pm * BM + wr * 64 + fr;
        float ks[2][8];
#pragma unroll
        for (int bj = 0; bj < 2; ++bj)
#pragma unroll
            for (int e = 0; e < 8; ++e) ks[bj][e] = 0.f;
#pragma unroll
        for (int ai = 0; ai < 2; ++ai)
#pragma unroll
            for (int m = 0; m < 4; ++m) {
                const int row = row0 + ai * HALF + m * 16;
                const f32x4* rp = (const f32x4*)(rowss + (size_t)row * 16);
                const f32x4 s0 = rp[0], s1 = rp[1], s2 = rp[2], s3 = rp[3];
                const float ss = ((s0[0] + s0[1]) + (s0[2] + s0[3])) + ((s1[0] + s1[1]) + (s1[2] + s1[3])) + ((s2[0] + s2[1]) + (s2[2] + s2[3])) + ((s3[0] + s3[1]) + (s3[2] + s3[3]));
                const float rs = __builtin_amdgcn_rsqf(ss * (1.0f / 1024.0f) + 1e-6f);
                bf16_t* rowp = base + (size_t)row * 512 + col0;
#pragma unroll
                for (int bj = 0; bj < 2; ++bj) {
                    f32x4 v0 = acc[ai][bj][m][0] * rs, v1 = acc[ai][bj][m][1] * rs;
                    if (t <= 1) {
#pragma unroll
                        for (int e = 0; e < 4; ++e) { v0[e] = act_gelu(v0[e]); v1[e] = act_gelu(v1[e]); }
                    } else if (t == 2 || t == 6) {
#pragma unroll
                        for (int e = 0; e < 4; ++e) { v0[e] = act_silu(v0[e]); v1[e] = act_silu(v1[e]); }
                    } else if (t == 3) { v0 = v0 * (0.125f * 1.4426950408889634f); v1 = v1 * (0.125f * 1.4426950408889634f); }
                    else if (t == 4) {
#pragma unroll
                        for (int e = 0; e < 4; ++e) { ks[bj][e] += v0[e]; ks[bj][4 + e] += v1[e]; }
                    }
                    u32x4 w; w.x = cvt_pk_bf16(v0[0], v0[1]); w.y = cvt_pk_bf16(v0[2], v0[3]); w.z = cvt_pk_bf16(v1[0], v1[1]); w.w = cvt_pk_bf16(v1[2], v1[3]);
                    *(u32x4*)(rowp + bj * HALF) = w;
                }
            }
        if (t == 4) {
            const int b = u.pm >> 6, n = u.pm & 63;
#pragma unroll
            for (int bj = 0; bj < 2; ++bj)
#pragma unroll
                for (int e = 0; e < 8; ++e) {
                    float v = ks[bj][e];
                    v += __shfl_xor(v, 1); v += __shfl_xor(v, 2); v += __shfl_xor(v, 4); v += __shfl_xor(v, 8);
                    if (fr == 0) { const int col = col0 + bj * HALF + e; atomicAdd(kmean + ((size_t)((b * 8 + (col >> 6)) * 64 + n)) * 64 + (col & 63), v * (1.0f / 256.0f)); }
                }
        }
    }
};
template <bool LAST> struct EpiRes {
    static constexpr bool PERM = false, AFTER_DRAIN = false;
    const float* res; float* out; bf16_t* xb; float* rowss;
    __device__ __forceinline__ void operator()(const f32x4 (&acc)[2][2][4][2], const Unit& u, int wr, int wc, int fr, int fq) const {
        typedef unsigned u32x2v __attribute__((ext_vector_type(2)));
        const int col0 = u.pn * BM + wc * 32 + 4 * fq;
#pragma unroll
        for (int ai = 0; ai < 2; ++ai)
#pragma unroll
            for (int m = 0; m < 4; ++m) {
                const int row = u.pm * BM + ai * HALF + wr * 64 + m * 16 + fr;
                const size_t off = (size_t)row * 1024 + col0;
                float ss = 0.f;
#pragma unroll
                for (int bj = 0; bj < 2; ++bj)
#pragma unroll
                    for (int n = 0; n < 2; ++n) {
                        f32x4 r;
                        if (LAST) { const u32x2v w = *(const u32x2v*)(xb + off + bj * HALF + n * 16);
                            r = (f32x4){__uint_as_float(w.x << 16), __uint_as_float(w.x & 0xffff0000u), __uint_as_float(w.y << 16), __uint_as_float(w.y & 0xffff0000u)}; }
                        else r = *(const f32x4*)(res + off + bj * HALF + n * 16);
                        const f32x4 o = r + acc[ai][bj][m][n];
                        ss += (o[0] * o[0] + o[1] * o[1]) + (o[2] * o[2] + o[3] * o[3]);
                        if (LAST) *(f32x4*)(out + off + bj * HALF + n * 16) = o;
                        else { u32x2v w; w.x = cvt_pk_bf16(o[0], o[1]); w.y = cvt_pk_bf16(o[2], o[3]); *(u32x2v*)(xb + off + bj * HALF + n * 16) = w; }
                    }
                ss += __shfl_xor(ss, 16); ss += __shfl_xor(ss, 32);
                if (fq == 0) rowss[(size_t)row * 16 + u.pn * 4 + wc] = ss;
            }
    }
};
template <class Epi, class Sched, bool ALIGN_EPI = false, bool SP2 = false>
__device__ __forceinline__ void gemm_phase(PG8_LAS unsigned char* lds, const Gemm g, const Sched& S, const Epi& E, const int tid) {
    const int wid = __builtin_amdgcn_readfirstlane(tid >> 6), lane = tid & 63, wr = wid >> 2, wc = wid & 3, fr = lane & 15, fq = lane >> 4;
    const int K = g.K, nt = K / BK;
    unsigned voffA[2], voffB[2];
#pragma unroll
    for (int i = 0; i < 2; ++i) { int R, C; stage_rc(tid * 16 + i * 8192, R, C); const int Rb = Epi::PERM ? ((R & ~31) + perm32(R & 31)) : R;
        voffA[i] = (unsigned)(R * K + C) * 2u; voffB[i] = (unsigned)(Rb * K + C) * 2u; }
    const size_t kstep = (size_t)(BK * 2);
    const size_t hstep = (size_t)HALF * K * 2;
    const size_t tstep = 2 * hstep;
    const unsigned ldsw = (unsigned)wid * 1024u;
    const int aoff = lds_byte(wr * 64 + fr, fq * 8), boff = lds_byte(wc * 32 + fr, fq * 8);
#define PG8_SA(b, h) (((b) * 2 + (h)) * HTB)
#define PG8_SB(b, h) ((4 + (b) * 2 + (h)) * HTB)
#define PG8_STAGE(bufoff, gbase, voff) do { _Pragma("unroll") for (int _i = 0; _i < 2; ++_i) \
        __builtin_amdgcn_global_load_lds((const unsigned*)((const char*)(gbase) + (voff)[_i]), (PG8_LAS unsigned*)(lds + (bufoff) + ldsw + _i * 8192), 16, 0, 0); } while (0)
#define PG8_LDA(dst, b, h) do { _Pragma("unroll") for (int m = 0; m < 4; ++m) _Pragma("unroll") for (int k = 0; k < 2; ++k) dst[m][k] = *(const PG8_LAS bf16x8*)(lds + PG8_SA(b, h) + aoff + m * 2048 + k * 1024); } while (0)
#define PG8_LDB(dst, b, h) do { _Pragma("unroll") for (int n = 0; n < 2; ++n) _Pragma("unroll") for (int k = 0; k < 2; ++k) dst[n][k] = *(const PG8_LAS bf16x8*)(lds + PG8_SB(b, h) + boff + n * 2048 + k * 1024); } while (0)
#define PG8_MMA(ai, bj, At, Bt) do { __builtin_amdgcn_s_setprio(1); _Pragma("unroll") for (int m = 0; m < 4; ++m) _Pragma("unroll") for (int n = 0; n < 2; ++n) _Pragma("unroll") for (int k = 0; k < 2; ++k) \
        acc[ai][bj][m][n] = __builtin_amdgcn_mfma_f32_16x16x32_bf16(Bt[n][k], At[m][k], acc[ai][bj][m][n], 0, 0, 0); __builtin_amdgcn_s_setprio(0); } while (0)
#define PG8_WAIT_V(n) asm volatile("s_waitcnt vmcnt(" #n ")" ::: "memory")
#define PG8_WAIT_L(n) asm volatile("s_waitcnt lgkmcnt(" #n ")" ::: "memory")
#define PG8_BAR __builtin_amdgcn_s_barrier()
#define PG8_SCHED __builtin_amdgcn_sched_barrier(0)
    Unit cur, nxt; int ui = 0;
    if (!S.next(0, cur)) return;
    f32x4 acc[2][2][4][2];
#pragma unroll
    for (int a = 0; a < 2; ++a)
#pragma unroll
        for (int b = 0; b < 2; ++b)
#pragma unroll
            for (int m = 0; m < 4; ++m)
#pragma unroll
                for (int n = 0; n < 2; ++n) acc[a][b][m][n] = (f32x4){0.f, 0.f, 0.f, 0.f};
    bf16x8 At[4][2], B0[2][2], B1[2][2];
    const char* cA = (const char*)g.A + (size_t)cur.pm * tstep; const char* cB = (const char*)g.Bt + (size_t)cur.pn * tstep;
    S.a_ready(cur);
    if constexpr (SP2) {
        PG8_STAGE(PG8_SB(0, 0), cB, voffB); PG8_STAGE(PG8_SB(0, 1), cB + hstep, voffB); PG8_STAGE(PG8_SA(0, 0), cA, voffA); PG8_STAGE(PG8_SA(0, 1), cA + hstep, voffA);
        if (wr == 1) PG8_BAR;
        PG8_WAIT_V(2); PG8_BAR;
        PG8_STAGE(PG8_SB(1, 0), cB + kstep, voffB); PG8_STAGE(PG8_SA(1, 0), cA + kstep, voffA); PG8_STAGE(PG8_SB(1, 1), cB + hstep + kstep, voffB);
        PG8_WAIT_V(6); PG8_BAR;
    } else {
        PG8_STAGE(PG8_SB(0, 0), cB, voffB); PG8_STAGE(PG8_SA(0, 0), cA, voffA); PG8_STAGE(PG8_SB(0, 1), cB + hstep, voffB); PG8_STAGE(PG8_SA(0, 1), cA + hstep, voffA);
        if (wr == 1) PG8_BAR;
        PG8_WAIT_V(4); PG8_BAR;
        PG8_STAGE(PG8_SB(1, 0), cB + kstep, voffB); PG8_STAGE(PG8_SA(1, 0), cA + kstep, voffA); PG8_STAGE(PG8_SB(1, 1), cB + hstep + kstep, voffB);
        PG8_WAIT_V(6); PG8_BAR;
    }
    for (;;) {
        const bool has_next = S.next(ui + 1, nxt);
        const char* nA = has_next ? (const char*)g.A + (size_t)nxt.pm * tstep : cA; const char* nB = has_next ? (const char*)g.Bt + (size_t)nxt.pn * tstep : cB;
        for (int t = 0; t < nt; t += 2) {
            const bool last = (t == nt - 2);
            const char* a1 = cA + (size_t)(t + 1) * kstep;
            const char* a2 = last ? nA : cA + (size_t)(t + 2) * kstep; const char* b2 = last ? nB : cB + (size_t)(t + 2) * kstep;
            const char* a3 = a2 + kstep; const char* b3 = b2 + kstep;
            if (last && has_next) S.a_ready(nxt);
            if constexpr (SP2) {
            PG8_LDB(B0, 0, 0); PG8_LDB(B1, 0, 1); PG8_SCHED; PG8_LDA(At, 0, 0); PG8_STAGE(PG8_SA(1, 1), a1 + hstep, voffA);
            PG8_WAIT_V(8); PG8_WAIT_L(0); PG8_BAR; PG8_MMA(0, 0, At, B0); PG8_MMA(0, 1, At, B1); PG8_BAR; PG8_SCHED;
            PG8_LDA(At, 0, 1); PG8_STAGE(PG8_SB(0, 0), b2, voffB); PG8_STAGE(PG8_SB(0, 1), b2 + hstep, voffB); PG8_STAGE(PG8_SA(0, 0), a2, voffA);
            PG8_WAIT_V(8); PG8_WAIT_L(0); PG8_BAR; PG8_MMA(1, 0, At, B0); PG8_MMA(1, 1, At, B1); PG8_BAR; PG8_SCHED;
            PG8_LDB(B0, 1, 0); PG8_LDB(B1, 1, 1); PG8_SCHED; PG8_LDA(At, 1, 0); PG8_STAGE(PG8_SA(0, 1), a2 + hstep, voffA);
            PG8_WAIT_V(8); PG8_WAIT_L(0); PG8_BAR; PG8_MMA(0, 0, At, B0); PG8_MMA(0, 1, At, B1); PG8_BAR; PG8_SCHED;
            PG8_LDA(At, 1, 1); PG8_STAGE(PG8_SB(1, 0), b3, voffB); PG8_STAGE(PG8_SB(1, 1), b3 + hstep, voffB); PG8_STAGE(PG8_SA(1, 0), a3, voffA);
            PG8_WAIT_V(8); PG8_WAIT_L(0); PG8_BAR; PG8_MMA(1, 0, At, B0); PG8_MMA(1, 1, At, B1); PG8_BAR; PG8_SCHED;
            } else {
            PG8_LDB(B0, 0, 0); PG8_SCHED; PG8_LDA(At, 0, 0); PG8_STAGE(PG8_SA(1, 1), a1 + hstep, voffA);
            PG8_WAIT_L(8); PG8_BAR; PG8_WAIT_L(0); PG8_MMA(0, 0, At, B0); PG8_BAR; PG8_SCHED;
            PG8_LDB(B1, 0, 1); PG8_STAGE(PG8_SB(0, 0), b2, voffB);
            PG8_BAR; PG8_WAIT_L(0); PG8_MMA(0, 1, At, B1); PG8_BAR;
            PG8_LDA(At, 0, 1); PG8_STAGE(PG8_SA(0, 0), a2, voffA);
            PG8_BAR; PG8_WAIT_L(0); PG8_MMA(1, 0, At, B0); PG8_BAR; PG8_SCHED;
            PG8_STAGE(PG8_SB(0, 1), b2 + hstep, voffB);
            PG8_WAIT_V(6); PG8_BAR; PG8_MMA(1, 1, At, B1); PG8_BAR;
            PG8_LDB(B0, 1, 0); PG8_SCHED; PG8_LDA(At, 1, 0); PG8_STAGE(PG8_SA(0, 1), a2 + hstep, voffA);
            PG8_WAIT_L(8); PG8_BAR; PG8_WAIT_L(0); PG8_MMA(0, 0, At, B0); PG8_BAR; PG8_SCHED;
            PG8_LDB(B1, 1, 1); PG8_STAGE(PG8_SB(1, 0), b3, voffB);
            PG8_BAR; PG8_WAIT_L(0); PG8_MMA(0, 1, At, B1); PG8_BAR;
            PG8_LDA(At, 1, 1); PG8_STAGE(PG8_SA(1, 0), a3, voffA);
            PG8_BAR; PG8_WAIT_L(0); PG8_MMA(1, 0, At, B0); PG8_BAR; PG8_SCHED;
            PG8_STAGE(PG8_SB(1, 1), b3 + hstep, voffB);
            PG8_WAIT_V(6); PG8_BAR; PG8_MMA(1, 1, At, B1); PG8_BAR;
            }
        }
        if constexpr (ALIGN_EPI) { if (wr == 0) PG8_BAR; }
        if constexpr (!Epi::AFTER_DRAIN) { E(acc, cur, wr, wc, fr, fq); S.done(cur); }
        if (!has_next) break;
#pragma unroll
        for (int a = 0; a < 2; ++a)
#pragma unroll
            for (int b = 0; b < 2; ++b)
#pragma unroll
                for (int m = 0; m < 4; ++m)
#pragma unroll
                    for (int n = 0; n < 2; ++n) acc[a][b][m][n] = (f32x4){0.f, 0.f, 0.f, 0.f};
        cur = nxt; cA = nA; cB = nB; ++ui;
        if constexpr (ALIGN_EPI) { if (wr == 1) PG8_BAR; }
    }
    PG8_WAIT_V(0);
    if constexpr (!ALIGN_EPI) { if (wr == 0) PG8_BAR; }
    PG8_BAR;
    if constexpr (Epi::AFTER_DRAIN) { E.fused(acc, cur, wr, wc, fr, fq, lds, wid, lane); S.done(cur); }
#undef PG8_SA
#undef PG8_SB
#undef PG8_STAGE
#undef PG8_LDA
#undef PG8_LDB
#undef PG8_MMA
#undef PG8_WAIT_V
#undef PG8_WAIT_L
#undef PG8_BAR
#undef PG8_SCHED
}
}

constexpr size_t MiB = 1u << 20;
constexpr size_t WS_CTL = 0, CTL_ZERO_BYTES = 1 * MiB;
constexpr size_t WS_WIN = 2 * MiB;
constexpr size_t WS_WOUT = 16 * MiB;
constexpr size_t WS_WST = 20 * MiB;
constexpr size_t WS_BT = 21 * MiB;
constexpr size_t WS_KMEAN = 22 * MiB;
constexpr size_t WS_LOFF = 23 * MiB;
constexpr size_t WS_ROWSS = 24 * MiB;
constexpr size_t WS_PL = 26 * MiB;
constexpr size_t WS_LIST = 30 * MiB;
constexpr size_t WS_SEL = 32 * MiB;
constexpr size_t WS_XB = 40 * MiB;
constexpr size_t WS_PROJ = 168 * MiB;
constexpr size_t WS_MIX = 392 * MiB;
constexpr size_t WS_END = 456 * MiB;
constexpr size_t SUBSTRIDE = (size_t)MROWS * 512;
enum { T_U = 0, T_V = 1, T_ZA = 2, T_Q = 3, T_K = 4, T_VV = 5, T_ZB = 6 };

constexpr int NWAVES = 8;
constexpr int LDS_BYTES = 160 * 1024;
constexpr int RING_BYTES = 131072;

#define LAS __attribute__((address_space(3)))
typedef unsigned short bf16;
typedef unsigned v4u __attribute__((ext_vector_type(4)));
typedef float f32x4 __attribute__((ext_vector_type(4)));
#define LDS_WAIT() asm volatile("s_waitcnt lgkmcnt(0)" ::: "memory")
__device__ __forceinline__ unsigned f2bf(float f) { unsigned u = __builtin_bit_cast(unsigned, f); return (u + 0x7fffu + ((u >> 16) & 1u)) >> 16; }
__device__ __forceinline__ unsigned pk2(float lo, float hi) { return f2bf(lo) | (f2bf(hi) << 16); }
__device__ __forceinline__ float bflo(unsigned w) { return __uint_as_float(w << 16); }
__device__ __forceinline__ float bfhi(unsigned w) { return __uint_as_float(w & 0xffff0000u); }
__device__ __forceinline__ float wave_sum(float v) {
#pragma unroll
    for (int o = 1; o < 64; o <<= 1) v += __shfl_xor(v, o);
    return v;
}

struct Args { const float* in[10]; float* out; unsigned char* ws; int layer, pad; };

struct Ctx {
    unsigned char* lds;
    int tid, lane, wave, G, bid;
    const float *x, *norm_g, *w_in, *ln_g, *ln_b, *sgu_w, *sgu_b, *w_out, *rel_bias, *final_g;
    float* out; unsigned char* ws;
};

__device__ __forceinline__ void p0_transpose_item(const float* W, const float* gs, int K, int N, bf16* WT, float* scr, int item, int lane) {
    const int nblk = N / 32, kb = item / nblk, nb = item % nblk, k0 = 64 * kb, n0 = 32 * nb;
#pragma unroll 8
    for (int i = 0; i < 32; ++i) { const int kk = 2 * i + (lane >> 5); const float sc = gs ? gs[k0 + kk] : 1.0f; scr[kk * 33 + (lane & 31)] = W[(size_t)(k0 + kk) * N + n0 + (lane & 31)] * sc; }
    LDS_WAIT(); asm volatile("" ::: "memory");
    const int c = lane & 7;
#pragma unroll
    for (int j = 0; j < 4; ++j) { const int n = (lane >> 3) + 8 * j; const float* s = scr + (8 * c) * 33 + n;
        v4u o; o.x = pk2(s[0 * 33], s[1 * 33]); o.y = pk2(s[2 * 33], s[3 * 33]); o.z = pk2(s[4 * 33], s[5 * 33]); o.w = pk2(s[6 * 33], s[7 * 33]);
        *(v4u*)(WT + (size_t)(n0 + n) * K + k0 + 8 * c) = o; }
    LDS_WAIT(); asm volatile("" ::: "memory");
}
__device__ __forceinline__ int rel_bucket(int d) {
    if (d < 16) return d;
    int b = 16;
    b += (d >= 19); b += (d >= 21); b += (d >= 24); b += (d >= 27); b += (d >= 31); b += (d >= 35); b += (d >= 40); b += (d >= 46);
    b += (d >= 52); b += (d >= 59); b += (d >= 67); b += (d >= 77); b += (d >= 87); b += (d >= 99); b += (d >= 113);
    return b;
}
__device__ __forceinline__ void phase_prologue(const Ctx& C) {
    float* scr = (float*)(C.lds + C.wave * 16384);
    const int gw = C.bid * NWAVES + C.wave, NGW = C.G * NWAVES;
    constexpr int I_IN = (DM / 64) * (DIN / 32), I_OUT = (DM / 64) * (DM / 32);
    constexpr int NITEMS = DEPTH * (I_IN + I_OUT);
    for (int it = gw; it < NITEMS; it += NGW) {
        const int l = it / (I_IN + I_OUT); int r = it % (I_IN + I_OUT);
        if (r < I_IN) p0_transpose_item(C.w_in + (size_t)l * DM * DIN, C.norm_g + l * DM, DM, DIN, (bf16*)(C.ws + WS_WIN) + (size_t)l * DIN * DM, scr, r, C.lane);
        else p0_transpose_item(C.w_out + (size_t)l * DM * DM, nullptr, DM, DM, (bf16*)(C.ws + WS_WOUT) + (size_t)l * DM * DM, scr, r - I_IN, C.lane);
    }
    { float* km = (float*)(C.ws + WS_KMEAN); for (int e = C.bid * 512 + C.tid; e < DEPTH * NBH * NBLK * 64; e += C.G * 512) km[e] = 0.f; }
    { bf16* wst = (bf16*)(C.ws + WS_WST); const int gt = C.bid * 512 + C.tid, NT = C.G * 512;
      for (int e = gt; e < DEPTH * 8 * 128 * 128; e += NT) { const int s = e & 127, t = (e >> 7) & 127; wst[e] = (s <= t) ? (bf16)f2bf(C.sgu_w[e]) : (bf16)0; } }
    if (C.bid == 0) { float* bt = (float*)(C.ws + WS_BT); for (int e = C.tid; e < 8 * 128; e += 512) { const int h = e >> 7, d = e & 127; bt[e] = C.rel_bias[rel_bucket(d) * 8 + h] * LOG2E; } }
    { bf16* xb = (bf16*)(C.ws + WS_XB); float* rowss = (float*)(C.ws + WS_ROWSS);
      for (int m = gw; m < MROWS; m += NGW) {
        const f32x4* xr = (const f32x4*)(C.x + (size_t)m * DM) + C.lane;
        f32x4 v[4]; float s = 0.f;
#pragma unroll
        for (int j = 0; j < 4; ++j) { v[j] = xr[64 * j]; s += (v[j].x * v[j].x + v[j].y * v[j].y) + (v[j].z * v[j].z + v[j].w * v[j].w); }
        s = wave_sum(s);
        unsigned long long* o8 = (unsigned long long*)(xb + (size_t)m * DM) + C.lane;
#pragma unroll
        for (int j = 0; j < 4; ++j) o8[64 * j] = (unsigned long long)pk2(v[j].x, v[j].y) | ((unsigned long long)pk2(v[j].z, v[j].w) << 32);
        if (C.lane < 16) rowss[(size_t)m * 16 + C.lane] = (C.lane == 0) ? s : 0.f;
      } }
}

__device__ __forceinline__ void phase_kmean(const Ctx& C) {
    const bf16* K = (const bf16*)(C.ws + WS_PROJ) + (size_t)T_K * SUBSTRIDE;
    float* km = (float*)(C.ws + WS_KMEAN);
    float* red = (float*)C.lds;
    const int cgp = C.tid & 63, rg = C.tid >> 6;
    for (int u = C.bid; u < BATCH * NBLK; u += C.G) {
        const int b = u / NBLK, n = u % NBLK;
        float s[8];
#pragma unroll
        for (int e = 0; e < 8; ++e) s[e] = 0.f;
        for (int r = rg; r < 256; r += 8) {
            const v4u v = *(const v4u*)(K + ((size_t)(b * SEQ + n * 256 + r)) * 512 + cgp * 8);
            s[0] += bflo(v.x); s[1] += bfhi(v.x); s[2] += bflo(v.y); s[3] += bfhi(v.y); s[4] += bflo(v.z); s[5] += bfhi(v.z); s[6] += bflo(v.w); s[7] += bfhi(v.w);
        }
#pragma unroll
        for (int e = 0; e < 8; ++e) red[rg * 512 + cgp * 8 + e] = s[e];
        __syncthreads();
        { const int col = C.tid; float t = 0.f;
#pragma unroll
          for (int r = 0; r < 8; ++r) t += red[r * 512 + col];
          km[((size_t)((b * NH + (col >> 6)) * NBLK + n)) * 64 + (col & 63)] = t * (1.0f / 256.0f); }
        __syncthreads();
    }
}

typedef short bf16x8 __attribute__((ext_vector_type(8)));
typedef short bf16x4s __attribute__((ext_vector_type(4)));
typedef float f32x16 __attribute__((ext_vector_type(16)));
__device__ __forceinline__ int crow(int r, int hi) { return (r & 3) + 8 * (r >> 2) + 4 * hi; }
__device__ __forceinline__ unsigned cvtpk(float lo, float hi) { unsigned r; asm volatile("v_cvt_pk_bf16_f32 %0, %1, %2" : "=v"(r) : "v"(lo), "v"(hi)); return r; }
__device__ __forceinline__ void phase_gate(const Ctx& C, int layer) {
    const bf16* Q = (const bf16*)(C.ws + WS_PROJ) + (size_t)T_Q * SUBSTRIDE;
    const float* KM = (const float*)(C.ws + WS_KMEAN) + (size_t)layer * NBH * NBLK * 64;
    int* SEL = (int*)(C.ws + WS_SEL); int* LOFF = (int*)(C.ws + WS_LOFF); unsigned short* LIST = (unsigned short*)(C.ws + WS_LIST);
    int* cnt = (int*)(C.lds);
    int* offs = (int*)(C.lds + 256);
    const int lane = C.lane, ql = lane & 31, hi = lane >> 5;
    for (int u = C.bid; u < NBH * NBLK; u += C.G) {
        const int bh = u >> 6, i = u & 63, b = bh >> 3, h = bh & 7;
        const int q = C.wave * 32 + ql, pos = i * 256 + q;
        if (i == 0) { if (CHECK_ATTN && hi == 0) { int* sp = SEL + ((size_t)bh * SEQ + pos) * 4; sp[0] = -1; sp[1] = -1; sp[2] = -1; sp[3] = -1; } continue; }
        if (C.tid < 64) cnt[C.tid] = 0;
        bf16x8 qf[4];
        { const bf16* qrow = Q + ((size_t)(b * SEQ + pos)) * 512 + h * 64 + hi * 8;
#pragma unroll
          for (int ks = 0; ks < 4; ++ks) qf[ks] = *(const bf16x8*)(qrow + ks * 16); }
        float b0 = -INFINITY, b1 = -INFINITY, b2 = -INFINITY; int i0 = -1, i1 = -1, i2 = -1;
#define TOP3_INS(v, idx) do { const float v_ = (v); const int x_ = (idx); if (v_ > b0) { b2 = b1; i2 = i1; b1 = b0; i1 = i0; b0 = v_; i0 = x_; } else if (v_ > b1) { b2 = b1; i2 = i1; b1 = v_; i1 = x_; } else if (v_ > b2) { b2 = v_; i2 = x_; } } while (0)
        const int ntile = (i + 31) >> 5;
        for (int nt = 0; nt < ntile; ++nt) {
            f32x16 p = {};
            const float* kr = KM + ((size_t)bh * NBLK + 32 * nt + ql) * 64 + hi * 8;
#pragma unroll
            for (int ks = 0; ks < 4; ++ks) {
                const f32x4 k0 = *(const f32x4*)(kr + ks * 16), k1 = *(const f32x4*)(kr + ks * 16 + 4);
                const v4u kw = (v4u){cvtpk(k0[0], k0[1]), cvtpk(k0[2], k0[3]), cvtpk(k1[0], k1[1]), cvtpk(k1[2], k1[3])};
                p = __builtin_amdgcn_mfma_f32_32x32x16_bf16(__builtin_bit_cast(bf16x8, kw), qf[ks], p, 0, 0, 0);
            }
#pragma unroll
            for (int r = 0; r < 16; ++r) { const int n = 32 * nt + crow(r, hi); if (n < i) TOP3_INS(p[r], n); }
        }
        { const float c0 = __shfl_xor(b0, 32), c1 = __shfl_xor(b1, 32), c2 = __shfl_xor(b2, 32);
          const int j0 = __shfl_xor(i0, 32), j1 = __shfl_xor(i1, 32), j2 = __shfl_xor(i2, 32);
          if (j0 >= 0) TOP3_INS(c0, j0);
          if (j1 >= 0) TOP3_INS(c1, j1);
          if (j2 >= 0) TOP3_INS(c2, j2); }
#undef TOP3_INS
        __syncthreads();
        int p0 = 0, p1 = 0, p2 = 0;
        if (hi == 0) {
            if (CHECK_ATTN) { int* sp = SEL + ((size_t)bh * SEQ + pos) * 4; sp[0] = i0; sp[1] = i1; sp[2] = i2; sp[3] = -1; }
            p0 = atomicAdd(&cnt[i0], 1);
            if (i1 >= 0) p1 = atomicAdd(&cnt[i1], 1);
            if (i2 >= 0) p2 = atomicAdd(&cnt[i2], 1);
        }
        __syncthreads();
        if (C.tid == 0) { int a = 0; for (int n = 0; n < 64; ++n) { offs[n] = a; a += cnt[n]; } offs[64] = a; }
        __syncthreads();
        if (hi == 0) {
            unsigned short* lp = LIST + (size_t)u * 768;
            lp[offs[i0] + p0] = (unsigned short)(q | (0 << 8));
            if (i1 >= 0) lp[offs[i1] + p1] = (unsigned short)(q | (1 << 8));
            if (i2 >= 0) lp[offs[i2] + p2] = (unsigned short)(q | (2 << 8));
        }
        if (C.tid < 65) LOFF[(size_t)u * 80 + C.tid] = offs[C.tid];
        __syncthreads();
    }
}

__device__ __forceinline__ void phase_sgu_simple(const Ctx& C, int layer) {
    const bf16* U = (const bf16*)(C.ws + WS_PROJ) + (size_t)T_U * SUBSTRIDE;
    const bf16* V = (const bf16*)(C.ws + WS_PROJ) + (size_t)T_V * SUBSTRIDE;
    const bf16* ZA = (const bf16*)(C.ws + WS_PROJ) + (size_t)T_ZA * SUBSTRIDE;
    bf16* MIX = (bf16*)(C.ws + WS_MIX);
    const float* lng = C.ln_g + layer * 512; const float* lnb = C.ln_b + layer * 512;
    const float* Wl = C.sgu_w + (size_t)layer * 8 * 128 * 128; const float* bl = C.sgu_b + layer * 8 * 128;
    bf16* vh = (bf16*)C.lds;
    for (int u = C.bid; u < MROWS / 128; u += C.G) {
        const size_t row0 = (size_t)u * 128;
        for (int r = 0; r < 16; ++r) {
            const int t = C.wave * 16 + r;
            const v4u v = *(const v4u*)(V + (row0 + t) * 512 + C.lane * 8);
            float f[8] = {bflo(v.x), bfhi(v.x), bflo(v.y), bfhi(v.y), bflo(v.z), bfhi(v.z), bflo(v.w), bfhi(v.w)};
            float s = 0.f;
#pragma unroll
            for (int e = 0; e < 8; ++e) s += f[e];
            const float mean = wave_sum(s) * (1.0f / 512.0f);
            float s2 = 0.f;
#pragma unroll
            for (int e = 0; e < 8; ++e) { f[e] -= mean; s2 += f[e] * f[e]; }
            const float rstd = 1.0f / sqrtf(wave_sum(s2) * (1.0f / 512.0f) + LN_EPS);
            v4u o;
            float g8[8], b8[8];
#pragma unroll
            for (int e = 0; e < 8; ++e) { g8[e] = lng[C.lane * 8 + e]; b8[e] = lnb[C.lane * 8 + e]; }
            o.x = pk2(f[0] * rstd * g8[0] + b8[0], f[1] * rstd * g8[1] + b8[1]); o.y = pk2(f[2] * rstd * g8[2] + b8[2], f[3] * rstd * g8[3] + b8[3]);
            o.z = pk2(f[4] * rstd * g8[4] + b8[4], f[5] * rstd * g8[5] + b8[5]); o.w = pk2(f[6] * rstd * g8[6] + b8[6], f[7] * rstd * g8[7] + b8[7]);
            *(v4u*)(vh + t * 512 + C.lane * 8) = o;
        }
        __syncthreads();
        { const int c = C.tid, g = c >> 6;
          const float* Wg = Wl + (size_t)g * 128 * 128;
          for (int t = 0; t < 128; ++t) {
              float acc = 0.f;
              for (int s = 0; s <= t; ++s) acc += Wg[t * 128 + s] * __uint_as_float((unsigned)vh[s * 512 + c] << 16);
              acc += bl[g * 128 + t];
              const float uu = __uint_as_float((unsigned)U[(row0 + t) * 512 + c] << 16), zz = __uint_as_float((unsigned)ZA[(row0 + t) * 512 + c] << 16);
              MIX[(row0 + t) * 1024 + c] = (bf16)f2bf(uu * acc * zz);
          } }
        __syncthreads();
    }
}

__device__ __forceinline__ void phase_attn_simple(const Ctx& C, bf16* MIX) {
    const bf16* Q = (const bf16*)(C.ws + WS_PROJ) + (size_t)T_Q * SUBSTRIDE;
    const bf16* K = (const bf16*)(C.ws + WS_PROJ) + (size_t)T_K * SUBSTRIDE;
    const bf16* VV = (const bf16*)(C.ws + WS_PROJ) + (size_t)T_VV * SUBSTRIDE;
    const bf16* ZB = (const bf16*)(C.ws + WS_PROJ) + (size_t)T_ZB * SUBSTRIDE;
    const int* SEL = (const int*)(C.ws + WS_SEL); const float* BT = (const float*)(C.ws + WS_BT);
    const int gt = C.bid * 512 + C.tid, NT = C.G * 512;
    for (int item = gt; item < NBH * SEQ; item += NT) {
        const int bh = item >> 14, pos = item & (SEQ - 1), b = bh >> 3, h = bh & 7, own = pos >> 8;
        const size_t rowq = (size_t)(b * SEQ + pos);
        float qv[64], o[64];
        { const v4u* qp = (const v4u*)(Q + rowq * 512 + h * 64);
#pragma unroll
          for (int c = 0; c < 8; ++c) { const v4u v = qp[c]; qv[8 * c + 0] = bflo(v.x); qv[8 * c + 1] = bfhi(v.x); qv[8 * c + 2] = bflo(v.y); qv[8 * c + 3] = bfhi(v.y);
              qv[8 * c + 4] = bflo(v.z); qv[8 * c + 5] = bfhi(v.z); qv[8 * c + 6] = bflo(v.w); qv[8 * c + 7] = bfhi(v.w); } }
#pragma unroll
        for (int d = 0; d < 64; ++d) o[d] = 0.f;
        float m = -INFINITY, l = 0.f;
        const float* bt = BT + h * 128;
        for (int slot = 0; slot < 4; ++slot) {
            int blk, klim;
            if (slot == 0) { blk = own; klim = (pos & 255) + 1; } else { blk = SEL[(size_t)item * 4 + slot - 1]; klim = 256; if (blk < 0) klim = 0; }
            for (int kl = 0; kl < klim; ++kl) {
                const int kpos = blk * 256 + kl;
                const v4u* kp = (const v4u*)(K + ((size_t)(b * SEQ + kpos)) * 512 + h * 64);
                float a0 = 0.f, a1 = 0.f;
#pragma unroll
                for (int c = 0; c < 8; ++c) { const v4u v = kp[c];
                    a0 += qv[8 * c + 0] * bflo(v.x) + qv[8 * c + 2] * bflo(v.y) + qv[8 * c + 4] * bflo(v.z) + qv[8 * c + 6] * bflo(v.w);
                    a1 += qv[8 * c + 1] * bfhi(v.x) + qv[8 * c + 3] * bfhi(v.y) + qv[8 * c + 5] * bfhi(v.z) + qv[8 * c + 7] * bfhi(v.w); }
                int dd = pos - kpos; dd = dd > 127 ? 127 : dd;
                const float s = (a0 + a1) + bt[dd];
                if (s > m) { const float al = __builtin_amdgcn_exp2f(m - s); l *= al;
#pragma unroll
                    for (int d = 0; d < 64; ++d) o[d] *= al;
                    m = s; }
                const float p = __builtin_amdgcn_exp2f(s - m);
                l += p;
                const v4u* vp = (const v4u*)(VV + ((size_t)(b * SEQ + kpos)) * 512 + h * 64);
#pragma unroll
                for (int c = 0; c < 8; ++c) { const v4u v = vp[c];
                    o[8 * c + 0] += p * bflo(v.x); o[8 * c + 1] += p * bfhi(v.x); o[8 * c + 2] += p * bflo(v.y); o[8 * c + 3] += p * bfhi(v.y);
                    o[8 * c + 4] += p * bflo(v.z); o[8 * c + 5] += p * bfhi(v.z); o[8 * c + 6] += p * bflo(v.w); o[8 * c + 7] += p * bfhi(v.w); }
            }
        }
        const float rl = 1.0f / l;
        const v4u* zp = (const v4u*)(ZB + rowq * 512 + h * 64);
        v4u* op = (v4u*)(MIX + rowq * 1024 + 512 + h * 64);
#pragma unroll
        for (int c = 0; c < 8; ++c) { const v4u z = zp[c]; v4u w;
            w.x = pk2(o[8 * c + 0] * rl * bflo(z.x), o[8 * c + 1] * rl * bfhi(z.x)); w.y = pk2(o[8 * c + 2] * rl * bflo(z.y), o[8 * c + 3] * rl * bfhi(z.y));
            w.z = pk2(o[8 * c + 4] * rl * bflo(z.z), o[8 * c + 5] * rl * bfhi(z.z)); w.w = pk2(o[8 * c + 6] * rl * bflo(z.w), o[8 * c + 7] * rl * bfhi(z.w));
            op[c] = w; }
    }
}

constexpr int AT_KS = 0, AT_KPITCH = 144;
constexpr int AT_VT = 36864, AT_VPITCH = 520;
constexpr int AT_DT = AT_VT + 64 * AT_VPITCH;
constexpr int AT_ENT = AT_DT + 512, AT_CAP = 4096;
constexpr int AT_PRE = AT_ENT + AT_CAP * 4;
constexpr int AT_OST = AT_PRE + 1024;
constexpr int AT_MISC = AT_OST + 8 * 4096;
constexpr int AT_NSEL_A = 60 * NBH, AT_NOWN = NBLK * NBH, AT_NUNITS = 63 * NBH + AT_NOWN;

template <bool OWN>
__device__ __forceinline__ void attn_tile(const Ctx& C, unsigned char* lds, int b, int h, int bh, int e0, int cnt, int nkt2) {
    const bf16* Q = (const bf16*)(C.ws + WS_PROJ) + (size_t)T_Q * SUBSTRIDE;
    bf16* PO = (bf16*)C.out; float* PL = (float*)(C.ws + WS_PL);
    const unsigned* ENT = (const unsigned*)(lds + AT_ENT);
    const float* DT = (const float*)(lds + AT_DT);
    const int lane = C.lane, q = lane & 31, hi = lane >> 5;
    const unsigned ent = ENT[(e0 + q < cnt) ? (e0 + q) : e0];
    const int pos = ent & 16383, qoff = (ent >> 16) & 1023;
    const bf16* qrow = Q + ((size_t)(b * SEQ + pos)) * 512 + h * 64 + hi * 8;
    bf16x8 qf[4];
#pragma unroll
    for (int ks = 0; ks < 4; ++ks) qf[ks] = *(const bf16x8*)(qrow + ks * 16);
    f32x16 o0 = {}, o1 = {};
    float l = 0.f;
    const bool anybias = OWN ? true : (__any(qoff < 112) != 0);
    const unsigned char* kbase = lds + AT_KS + q * AT_KPITCH + hi * 16;
    const unsigned char* vbase = lds + AT_VT + q * AT_VPITCH + hi * 8;
    for (int kt2 = 0; kt2 < nkt2; ++kt2) {
        f32x16 p0 = {}, p1 = {};
#pragma unroll
        for (int ks = 0; ks < 4; ++ks) {
            const bf16x8 k0 = *(const bf16x8*)(kbase + (64 * kt2) * AT_KPITCH + ks * 32);
            const bf16x8 k1 = *(const bf16x8*)(kbase + (64 * kt2 + 32) * AT_KPITCH + ks * 32);
            p0 = __builtin_amdgcn_mfma_f32_32x32x16_bf16(k0, qf[ks], p0, 0, 0, 0);
            p1 = __builtin_amdgcn_mfma_f32_32x32x16_bf16(k1, qf[ks], p1, 0, 0, 0);
        }
        if (anybias && (OWN || kt2 >= 2)) {
            const int dq = (OWN ? 0 : 256) + qoff - 64 * kt2;
#pragma unroll
            for (int r = 0; r < 16; ++r) {
                const int d0 = dq - crow(r, hi), d1 = d0 - 32;
                const float b0 = DT[d0 < 0 ? 0 : (d0 > 127 ? 127 : d0)], b1 = DT[d1 < 0 ? 0 : (d1 > 127 ? 127 : d1)];
                p0[r] = (OWN && d0 < 0) ? -INFINITY : p0[r] + b0;
                p1[r] = (OWN && d1 < 0) ? -INFINITY : p1[r] + b1;
            }
        }
#pragma unroll
        for (int r = 0; r < 16; ++r) { p0[r] = __builtin_amdgcn_exp2f(p0[r]); p1[r] = __builtin_amdgcn_exp2f(p1[r]); }
        float sa = 0.f, sb = 0.f;
#pragma unroll
        for (int r = 0; r < 16; ++r) { sa += p0[r]; sb += p1[r]; }
        l += sa + sb;
        v4u pa[4];
#pragma unroll
        for (int s = 0; s < 2; ++s) {
            pa[s] = (v4u){cvtpk(p0[8 * s + 0], p0[8 * s + 1]), cvtpk(p0[8 * s + 2], p0[8 * s + 3]), cvtpk(p0[8 * s + 4], p0[8 * s + 5]), cvtpk(p0[8 * s + 6], p0[8 * s + 7])};
            pa[2 + s] = (v4u){cvtpk(p1[8 * s + 0], p1[8 * s + 1]), cvtpk(p1[8 * s + 2], p1[8 * s + 3]), cvtpk(p1[8 * s + 4], p1[8 * s + 5]), cvtpk(p1[8 * s + 6], p1[8 * s + 7])};
        }
#pragma unroll
        for (int s = 0; s < 4; ++s) {
            const unsigned char* vp = vbase + (64 * kt2 + 16 * s) * 2;
            const bf16x4s a0 = *(const bf16x4s*)(vp), a1 = *(const bf16x4s*)(vp + 16);
            const bf16x4s c0 = *(const bf16x4s*)(vp + 32 * AT_VPITCH), c1 = *(const bf16x4s*)(vp + 32 * AT_VPITCH + 16);
            const bf16x8 vb0 = (bf16x8){a0[0], a0[1], a0[2], a0[3], a1[0], a1[1], a1[2], a1[3]};
            const bf16x8 vb1 = (bf16x8){c0[0], c0[1], c0[2], c0[3], c1[0], c1[1], c1[2], c1[3]};
            const bf16x8 paf = __builtin_bit_cast(bf16x8, pa[s]);
            o0 = __builtin_amdgcn_mfma_f32_32x32x16_bf16(paf, vb0, o0, 0, 0, 0);
            o1 = __builtin_amdgcn_mfma_f32_32x32x16_bf16(paf, vb1, o1, 0, 0, 0);
        }
    }
    l += __shfl_xor(l, 32);
    bf16* stg = (bf16*)(lds + AT_OST + C.wave * 4096);
#pragma unroll
    for (int r = 0; r < 16; ++r) { const int orow = crow(r, hi); stg[orow * 64 + q] = (bf16)f2bf(o0[r]); stg[orow * 64 + 32 + q] = (bf16)f2bf(o1[r]); }
    LDS_WAIT(); asm volatile("" ::: "memory");
#pragma unroll
    for (int it = 0; it < 4; ++it) {
        const int row = it * 8 + (lane >> 3), ch = lane & 7;
        if (e0 + row < cnt) {
            const unsigned er = ENT[e0 + row];
            const int pr = er & 16383, jr = (er >> 14) & 3;
            *(v4u*)(PO + (((size_t)bh * SEQ + pr) * 4 + jr) * 64 + ch * 8) = *(const v4u*)(stg + row * 64 + ch * 8);
        }
    }
    if (hi == 0 && e0 + q < cnt) PL[((size_t)bh * SEQ + pos) * 4 + ((ent >> 14) & 3)] = l;
    LDS_WAIT(); asm volatile("" ::: "memory");
}

__device__ __forceinline__ void phase_attn(const Ctx& C, int layer) {
    unsigned char* lds = C.lds;
    const bf16* K = (const bf16*)(C.ws + WS_PROJ) + (size_t)T_K * SUBSTRIDE;
    const bf16* VV = (const bf16*)(C.ws + WS_PROJ) + (size_t)T_VV * SUBSTRIDE;
    const int* LOFF = (const int*)(C.ws + WS_LOFF); const unsigned short* LIST = (const unsigned short*)(C.ws + WS_LIST);
    const float* BT = (const float*)(C.ws + WS_BT);
    unsigned* ctr = (unsigned*)(C.ws + WS_CTL) + 64 + 64 * layer;
    unsigned* ENT = (unsigned*)(lds + AT_ENT);
    int* PRE = (int*)(lds + AT_PRE); int* LO = PRE + 68;
    volatile unsigned* MISC = (volatile unsigned*)(lds + AT_MISC);
    const int tid = C.tid;
    for (;;) {
        if (tid == 0) MISC[0] = atomicAdd(ctr, 1u);
        __syncthreads();
        const int u = (int)MISC[0];
        if (u >= AT_NUNITS) break;
        bool own; int bh, n;
        if (u < AT_NSEL_A) { own = false; n = u >> 4; bh = u & 15; }
        else if (u < AT_NSEL_A + AT_NOWN) { own = true; const int k = u - AT_NSEL_A; n = 63 - (k >> 4); bh = k & 15; }
        else { own = false; const int k = u - AT_NSEL_A - AT_NOWN; n = 60 + (k >> 4); bh = k & 15; }
        const int b = bh >> 3, h = bh & 7;
        { const bf16* Kg = K + ((size_t)(b * SEQ + n * 256)) * 512 + h * 64;
          const bf16* Vg = VV + ((size_t)(b * SEQ + n * 256)) * 512 + h * 64;
#pragma unroll
          for (int it = 0; it < 4; ++it) { const int idx = tid + 512 * it, row = idx >> 3, ch = idx & 7;
              *(v4u*)(lds + AT_KS + row * AT_KPITCH + ch * 16) = *(const v4u*)(Kg + (size_t)row * 512 + ch * 8); }
#pragma unroll
          for (int it = 0; it < 4; ++it) { const int idx = tid + 512 * it, ch = idx >> 8, kv = idx & 255;
              const v4u v = *(const v4u*)(Vg + (size_t)kv * 512 + ch * 8);
              unsigned short* vt = (unsigned short*)(lds + AT_VT + (8 * ch) * AT_VPITCH + kv * 2);
              vt[0 * (AT_VPITCH / 2)] = (unsigned short)(v.x & 0xffff); vt[1 * (AT_VPITCH / 2)] = (unsigned short)(v.x >> 16);
              vt[2 * (AT_VPITCH / 2)] = (unsigned short)(v.y & 0xffff); vt[3 * (AT_VPITCH / 2)] = (unsigned short)(v.y >> 16);
              vt[4 * (AT_VPITCH / 2)] = (unsigned short)(v.z & 0xffff); vt[5 * (AT_VPITCH / 2)] = (unsigned short)(v.z >> 16);
              vt[6 * (AT_VPITCH / 2)] = (unsigned short)(v.w & 0xffff); vt[7 * (AT_VPITCH / 2)] = (unsigned short)(v.w >> 16); }
          if (tid < 128) ((float*)(lds + AT_DT))[tid] = BT[h * 128 + tid] - BT[h * 128 + 127]; }
        int total;
        if (own) total = 256;
        else {
            if (tid < 64) {
                const int i = n + 1 + tid; int c = 0, lo = 0;
                if (i < NBLK) { const int* lp = LOFF + ((size_t)(bh * NBLK + i)) * 80 + n; lo = lp[0]; c = lp[1] - lo; }
                int inc = c;
#pragma unroll
                for (int o = 1; o < 64; o <<= 1) { const int t = __shfl_up(inc, o); if (tid >= o) inc += t; }
                PRE[tid + 1] = inc; LO[tid] = lo; if (tid == 0) PRE[0] = 0;
            }
            __syncthreads();
            total = PRE[63 - n];
        }
        for (int base = 0; base < total; base += AT_CAP) {
            const int cnt = (total - base < AT_CAP) ? (total - base) : AT_CAP;
            if (own) { if (tid < 256) ENT[tid] = (unsigned)(n * 256 + tid) | (3u << 14) | ((unsigned)tid << 16); }
            else {
                for (int ii = C.wave; ii < 63 - n; ii += 8) {
                    const int i = n + 1 + ii, s0 = PRE[ii], s1 = PRE[ii + 1];
                    const int lo = s0 > base ? s0 : base, hi_ = s1 < base + cnt ? s1 : base + cnt;
                    const unsigned short* lp = LIST + ((size_t)(bh * NBLK + i)) * 768 + LO[ii];
                    for (int e = lo + C.lane; e < hi_; e += 64) {
                        const unsigned val = lp[e - s0]; const unsigned ql = val & 255u, j = val >> 8;
                        ENT[e - base] = (unsigned)(i * 256 + ql) | (j << 14) | ((ii == 0 ? ql : 1023u) << 16);
                    }
                }
            }
            __syncthreads();
            const int ntiles = (cnt + 31) >> 5;
            for (int tile = C.wave; tile < ntiles; tile += 8) {
                if (own) attn_tile<true>(C, lds, b, h, bh, tile * 32, cnt, (tile >> 1) + 1);
                else attn_tile<false>(C, lds, b, h, bh, tile * 32, cnt, 4);
            }
            __syncthreads();
        }
        __syncthreads();
    }
}

__device__ __forceinline__ void phase_combine(const Ctx& C) {
    const bf16* PO = (const bf16*)C.out; const float* PL = (const float*)(C.ws + WS_PL);
    const bf16* ZB = (const bf16*)(C.ws + WS_PROJ) + (size_t)T_ZB * SUBSTRIDE;
    bf16* MIX = (bf16*)(C.ws + WS_MIX);
    const int gt = C.bid * 512 + C.tid, NT = C.G * 512;
    for (int idx = gt; idx < MROWS * 64; idx += NT) {
        const int ch = idx & 7, h = (idx >> 3) & 7, row = idx >> 6, b = row >> 14, pos = row & (SEQ - 1), i = pos >> 8;
        const size_t pb = ((size_t)(b * NH + h) * SEQ + pos) * 4;
        const f32x4 lv = *(const f32x4*)(PL + pb);
        float L = lv[3];
        float acc[8];
        { const v4u v = *(const v4u*)(PO + (pb + 3) * 64 + ch * 8);
          acc[0] = bflo(v.x); acc[1] = bfhi(v.x); acc[2] = bflo(v.y); acc[3] = bfhi(v.y); acc[4] = bflo(v.z); acc[5] = bfhi(v.z); acc[6] = bflo(v.w); acc[7] = bfhi(v.w); }
#pragma unroll
        for (int j = 0; j < 3; ++j) if (j < i) {
            const v4u v = *(const v4u*)(PO + (pb + j) * 64 + ch * 8);
            L += lv[j];
            acc[0] += bflo(v.x); acc[1] += bfhi(v.x); acc[2] += bflo(v.y); acc[3] += bfhi(v.y); acc[4] += bflo(v.z); acc[5] += bfhi(v.z); acc[6] += bflo(v.w); acc[7] += bfhi(v.w);
        }
        const float rl = 1.0f / L;
        const v4u z = *(const v4u*)(ZB + (size_t)row * 512 + h * 64 + ch * 8);
        v4u w;
        w.x = pk2(acc[0] * rl * bflo(z.x), acc[1] * rl * bfhi(z.x)); w.y = pk2(acc[2] * rl * bflo(z.y), acc[3] * rl * bfhi(z.y));
        w.z = pk2(acc[4] * rl * bflo(z.z), acc[5] * rl * bfhi(z.z)); w.w = pk2(acc[6] * rl * bflo(z.w), acc[7] * rl * bfhi(z.w));
        *(v4u*)(MIX + (size_t)row * 1024 + 512 + h * 64 + ch * 8) = w;
    }
}

constexpr int SG_VPITCH = 272, SG_MPITCH = 144, SG_WREG = 128 * SG_MPITCH;
constexpr int SG_STATS = 8 * SG_WREG;
constexpr int SG_MR = SG_STATS + 8192;
constexpr int SG_LN = SG_MR + 1024;
__device__ __forceinline__ void phase_sgu(const Ctx& C, int layer) {
    typedef float f32x2v __attribute__((ext_vector_type(2)));
    unsigned char* lds = C.lds;
    const bf16* U = (const bf16*)(C.ws + WS_PROJ) + (size_t)T_U * SUBSTRIDE;
    const bf16* V = (const bf16*)(C.ws + WS_PROJ) + (size_t)T_V * SUBSTRIDE;
    const bf16* ZA = (const bf16*)(C.ws + WS_PROJ) + (size_t)T_ZA * SUBSTRIDE;
    bf16* MIX = (bf16*)(C.ws + WS_MIX);
    const int g = C.wave; int lane = C.lane;
    const float* lng = C.ln_g + layer * 512 + g * 64; const float* lnb = C.ln_b + layer * 512 + g * 64;
    const bf16* Wg = (const bf16*)(C.ws + WS_WST) + ((size_t)(layer * 8 + g)) * 128 * 128;
    const float* bg = C.sgu_b + (layer * 8 + g) * 128;
    unsigned char* myreg = lds + g * SG_WREG;
    f32x2v* stats = (f32x2v*)(lds + SG_STATS); f32x2v* mr = (f32x2v*)(lds + SG_MR);
    float* lnl = (float*)(lds + SG_LN + g * 512);
    lnl[lane] = lng[lane]; lnl[64 + lane] = lnb[lane];
    for (int u = C.bid; u < MROWS / 128; u += C.G) {
        const size_t row0 = (size_t)u * 128;
        asm volatile("" : "+v"(lane));
        v4u xv[2][8];
#pragma unroll
        for (int rr = 0; rr < 2; ++rr) {
            const v4u* vp = (const v4u*)(V + (row0 + lane + 64 * rr) * 512 + g * 64);
#pragma unroll
            for (int c = 0; c < 8; ++c) xv[rr][c] = vp[c];
        }
        bf16x8 wf[4][8];
        { const bf16* wa = Wg + (size_t)(lane & 31) * 128 + (lane >> 5) * 8;
#pragma unroll
          for (int tt = 0; tt < 4; ++tt)
#pragma unroll
              for (int ks = 0; ks < 8; ++ks) if (tt >= (ks >> 1)) wf[tt][ks] = *(const bf16x8*)(wa + (size_t)tt * 32 * 128 + ks * 16); }
#pragma unroll
        for (int rr = 0; rr < 2; ++rr) {
            float s1 = 0.f, s2 = 0.f;
#pragma unroll
            for (int c = 0; c < 8; ++c) { const v4u v = xv[rr][c];
                const float f0 = bflo(v.x), f1 = bfhi(v.x), f2 = bflo(v.y), f3 = bfhi(v.y), f4 = bflo(v.z), f5 = bfhi(v.z), f6 = bflo(v.w), f7 = bfhi(v.w);
                s1 += ((f0 + f1) + (f2 + f3)) + ((f4 + f5) + (f6 + f7));
                s2 += ((f0 * f0 + f1 * f1) + (f2 * f2 + f3 * f3)) + ((f4 * f4 + f5 * f5) + (f6 * f6 + f7 * f7)); }
            stats[g * 128 + lane + 64 * rr] = (f32x2v){s1, s2};
        }
        __syncthreads();
        if (C.tid < 128) {
            float s1 = 0.f, s2 = 0.f;
#pragma unroll
            for (int w = 0; w < 8; ++w) { const f32x2v t = stats[w * 128 + C.tid]; s1 += t.x; s2 += t.y; }
            const float mean = s1 * (1.0f / 512.0f), var = s2 * (1.0f / 512.0f) - mean * mean;
            mr[C.tid] = (f32x2v){mean, 1.0f / sqrtf(var + LN_EPS)};
        }
        __syncthreads();
#pragma unroll
        for (int c = 0; c < 8; ++c) asm volatile("" : "+v"(xv[0][c]), "+v"(xv[1][c]));
        { const f32x2v m0 = mr[lane], m1 = mr[lane + 64];
          unsigned short* vt = (unsigned short*)(myreg + lane * 2);
#pragma unroll
          for (int c = 0; c < 8; ++c) {
              const v4u v0 = xv[0][c], v1 = xv[1][c];
              const float f0[8] = {bflo(v0.x), bfhi(v0.x), bflo(v0.y), bfhi(v0.y), bflo(v0.z), bfhi(v0.z), bflo(v0.w), bfhi(v0.w)};
              const float f1[8] = {bflo(v1.x), bfhi(v1.x), bflo(v1.y), bfhi(v1.y), bflo(v1.z), bfhi(v1.z), bflo(v1.w), bfhi(v1.w)};
#pragma unroll
              for (int e = 0; e < 8; ++e) { const int d = 8 * c + e; const float gg = lnl[d], bbv = lnl[64 + d];
                  vt[d * (SG_VPITCH / 2)] = (unsigned short)f2bf((f0[e] - m0.x) * m0.y * gg + bbv);
                  vt[d * (SG_VPITCH / 2) + 64] = (unsigned short)f2bf((f1[e] - m1.x) * m1.y * gg + bbv); }
              asm volatile("" ::: "memory");
          } }
        LDS_WAIT(); asm volatile("" ::: "memory");
        { const int q = lane & 31, hi = lane >> 5;
          unsigned pk[2][4][8];
#pragma unroll
          for (int dt = 0; dt < 2; ++dt) {
              const unsigned char* bb = myreg + (32 * dt + q) * SG_VPITCH + hi * 16;
              f32x16 acc[4];
#pragma unroll
              for (int tt = 0; tt < 4; ++tt) acc[tt] = (f32x16){};
#pragma unroll
              for (int ks = 0; ks < 8; ++ks) {
                  const bf16x8 b0 = *(const bf16x8*)(bb + ks * 32);
#pragma unroll
                  for (int tt = 0; tt < 4; ++tt) if (tt >= (ks >> 1)) acc[tt] = __builtin_amdgcn_mfma_f32_32x32x16_bf16(wf[tt][ks], b0, acc[tt], 0, 0, 0);
              }
#pragma unroll
              for (int tt = 0; tt < 4; ++tt)
#pragma unroll
                  for (int rp = 0; rp < 8; ++rp) pk[dt][tt][rp] = cvtpk(acc[tt][2 * rp], acc[tt][2 * rp + 1]);
          }
          LDS_WAIT(); asm volatile("" ::: "memory");
          unsigned char* mxb = myreg + (4 * hi) * SG_MPITCH + q * 2;
#pragma unroll
          for (int dt = 0; dt < 2; ++dt)
#pragma unroll
              for (int tt = 0; tt < 4; ++tt)
#pragma unroll
                  for (int r = 0; r < 16; ++r)
                      *(unsigned short*)(mxb + (32 * tt + (r & 3) + 8 * (r >> 2)) * SG_MPITCH + 64 * dt) = (unsigned short)((r & 1) ? (pk[dt][tt][r >> 1] >> 16) : (pk[dt][tt][r >> 1] & 0xffffu));
        }
        LDS_WAIT(); asm volatile("" ::: "memory");
        { const int ch = lane & 7, r8 = lane >> 3;
#pragma unroll 8
          for (int it = 0; it < 16; ++it) {
              const int t = it * 8 + r8;
              const v4u mv = *(const v4u*)(myreg + t * SG_MPITCH + ch * 16);
              const v4u uv = *(const v4u*)(U + (row0 + t) * 512 + g * 64 + ch * 8), zv = *(const v4u*)(ZA + (row0 + t) * 512 + g * 64 + ch * 8);
              const float bt = bg[t];
              v4u o;
              o.x = pk2(bflo(uv.x) * (bflo(mv.x) + bt) * bflo(zv.x), bfhi(uv.x) * (bfhi(mv.x) + bt) * bfhi(zv.x));
              o.y = pk2(bflo(uv.y) * (bflo(mv.y) + bt) * bflo(zv.y), bfhi(uv.y) * (bfhi(mv.y) + bt) * bfhi(zv.y));
              o.z = pk2(bflo(uv.z) * (bflo(mv.z) + bt) * bflo(zv.z), bfhi(uv.z) * (bfhi(mv.z) + bt) * bfhi(zv.z));
              o.w = pk2(bflo(uv.w) * (bflo(mv.w) + bt) * bflo(zv.w), bfhi(uv.w) * (bfhi(mv.w) + bt) * bfhi(zv.w));
              *(v4u*)(MIX + (row0 + t) * 1024 + g * 64 + ch * 8) = o;
          } }
        __syncthreads();
    }
}

__device__ __forceinline__ void phase_final(const Ctx& C) {
    const float* rowss = (const float*)(C.ws + WS_ROWSS);
    const float chk = CHECK_ATTN ? __uint_as_float(((const unsigned*)(C.ws + WS_CTL))[32]) : 0.f;
    const int gw = C.bid * NWAVES + C.wave, NGW = C.G * NWAVES;
    f32x4 g[4];
#pragma unroll
    for (int j = 0; j < 4; ++j) g[j] = ((const f32x4*)C.final_g)[64 * j + C.lane];
    for (int m = gw; m < MROWS; m += NGW) {
        float ss = (C.lane < 16) ? rowss[(size_t)m * 16 + C.lane] : 0.f;
        ss = wave_sum(ss);
        float rs = 1.0f / sqrtf(ss * (1.0f / 1024.0f) + NORM_EPS);
        f32x4* xr = (f32x4*)(C.out + (size_t)m * DM) + C.lane;
#pragma unroll
        for (int j = 0; j < 4; ++j) { f32x4 v = xr[64 * j]; v = v * rs * g[j]; if (CHECK_ATTN && m == 0 && j == 0 && C.lane == 0) v.x = chk * 1e6f; xr[64 * j] = v; }
    }
}

#define GAS __attribute__((address_space(1)))
typedef GAS unsigned gu32;
#define RLX_AGENT __ATOMIC_RELAXED, __HIP_MEMORY_SCOPE_AGENT
constexpr int CW_BAR = 4096;
constexpr int LDS_BARST = LDS_BYTES - 64;
#define XB_TMO      128
#define XB_XCNT(j)  (256  + 64 * (j))
#define XB_XSUB(j)  (1280 + 64 * (j))
#define XB_XGEN(j)  (2304 + 64 * (j))
#define XB_TOP      3328
#define XB_TOPGEN   3392
#define XCD_BAR_WORDS 3456
#define XB_SPIN_CAP (1u << 18)

__device__ __forceinline__ unsigned xb_ld(unsigned* p)              { return __hip_atomic_load(p, __ATOMIC_RELAXED, __HIP_MEMORY_SCOPE_AGENT); }
__device__ __forceinline__ unsigned xb_add(unsigned* p, unsigned v) { return __hip_atomic_fetch_add(p, v, __ATOMIC_RELAXED, __HIP_MEMORY_SCOPE_AGENT); }
__device__ __forceinline__ unsigned xb_xcc_id() { return (unsigned)__builtin_amdgcn_s_getreg((3 << 11) | 20) & 0xFu; }
#define XB_SPIN(cond, bar) do { unsigned _sp = 0; while (cond) { __builtin_amdgcn_s_sleep(1); \
    if ((++_sp & 255u) == 0u) { if (xb_ld(&(bar)[XB_TMO])) break; if (_sp > XB_SPIN_CAP) { atomicAdd(&(bar)[XB_TMO], 1u); break; } } } } while (0)

struct XcdBarrier {
    unsigned* bar; unsigned x;
    volatile LAS unsigned* st;
};

__device__ __forceinline__ XcdBarrier xcd_barrier_post(unsigned* bar, volatile LAS unsigned* st) {
    XcdBarrier b; b.bar = bar; b.x = xb_xcc_id(); b.st = st;
    if (threadIdx.x == 0) (void)xb_add(&bar[XB_XCNT(b.x)], 1u);
    return b;
}
__device__ __forceinline__ void xcd_barrier_complete(unsigned* bar, unsigned x, unsigned& nloc, unsigned& nx) {
    const unsigned G = gridDim.x * gridDim.y * gridDim.z;
    unsigned sum, cnt, mine, sp = 0u;
    for (;;) {
        sum = 0u; cnt = 0u; mine = 0u;
#pragma unroll
        for (unsigned j = 0; j < 16; ++j) { const unsigned c = xb_ld(&bar[XB_XCNT(j)]); sum += c; cnt += (c > 0u) ? 1u : 0u; mine = (j == x) ? c : mine; }
        if (sum == G) break;
        __builtin_amdgcn_s_sleep(1);
        if ((++sp & 255u) == 0u) { if (xb_ld(&bar[XB_TMO])) break; if (sp > XB_SPIN_CAP) { atomicAdd(&bar[XB_TMO], 1u); break; } }
    }
    nloc = mine > 0u ? mine : 1u; nx = cnt > 0u ? cnt : 1u;
}

__device__ __forceinline__ void xcd_barrier(const XcdBarrier& b) {
    asm volatile("s_waitcnt vmcnt(0)" ::: "memory");
    __syncthreads();
    if (threadIdx.x == 0) {
        unsigned* bar = b.bar;
        __builtin_amdgcn_s_waitcnt(0);
        unsigned nloc = b.st[0], nx = b.st[1];
        if (nloc == 0u) { xcd_barrier_complete(bar, b.x, nloc, nx); b.st[0] = nloc; b.st[1] = nx; }
        const unsigned old = xb_add(&bar[XB_XSUB(b.x)], 1u);
        const unsigned gen = old / nloc;
        if (old + 1u == (gen + 1u) * nloc) {
            __builtin_amdgcn_fence(__ATOMIC_RELEASE, "agent");
            asm volatile("s_waitcnt vmcnt(0)" ::: "memory");
            const unsigned og = xb_add(&bar[XB_TOP], 1u);
            const unsigned tg = og / nx;
            if (og + 1u == (tg + 1u) * nx) xb_add(&bar[XB_TOPGEN], 1u);
            else XB_SPIN(xb_ld(&bar[XB_TOPGEN]) == tg, bar);
            __builtin_amdgcn_fence(__ATOMIC_ACQUIRE, "agent");
            xb_add(&bar[XB_XGEN(b.x)], 1u);
            asm volatile("s_waitcnt vmcnt(0)" ::: "memory");
        } else {
            XB_SPIN(xb_ld(&bar[XB_XGEN(b.x)]) == gen, bar);
            __builtin_amdgcn_fence(__ATOMIC_ACQUIRE, "agent");
            asm volatile("s_waitcnt vmcnt(0)" ::: "memory");
        }
    }
    __syncthreads();
}

#ifndef ATTN_OPT
#define ATTN_OPT 1
#endif
template <int ST> __device__ __forceinline__ void run_stage(const Args& args, unsigned char* lds, int Lr) {
    const int L = Lr & 15, rep = Lr >> 4;
    Ctx C;
    { int t = threadIdx.x; asm volatile("" : "+v"(t)); C.tid = t; }
    C.lds = lds; C.lane = C.tid & 63; C.wave = __builtin_amdgcn_readfirstlane(C.tid >> 6); C.G = gridDim.x; C.bid = blockIdx.x;
    C.x = args.in[0]; C.norm_g = args.in[1]; C.w_in = args.in[2]; C.ln_g = args.in[3]; C.ln_b = args.in[4]; C.sgu_w = args.in[5]; C.sgu_b = args.in[6];
    C.w_out = args.in[7]; C.rel_bias = args.in[8]; C.final_g = args.in[9]; C.out = args.out; C.ws = args.ws;
    asm volatile("" : "+s"(C.ws), "+s"(C.out), "+s"(C.x), "+s"(C.sgu_b), "+s"(C.ln_g), "+s"(C.ln_b));
    if constexpr (ST == 0) phase_prologue(C);
    else if constexpr (ST == 1) {
        pg8::Gemm g{(const pg8::bf16_t*)(C.ws + WS_XB), (const pg8::bf16_t*)(C.ws + WS_WIN) + (size_t)L * DIN * DM, MROWS, DIN, DM};
        pg8::StaticOrder S; S.init(MROWS, DIN, C.G, C.bid);
        pg8::EpiProj E{(pg8::bf16_t*)(C.ws + WS_PROJ), SUBSTRIDE, (const float*)(C.ws + WS_ROWSS), (float*)(C.ws + WS_KMEAN) + (size_t)L * NBH * NBLK * 64};
        pg8::gemm_phase<pg8::EpiProj, pg8::StaticOrder, true, true>((PG8_LAS unsigned char*)lds, g, S, E, C.tid);
    } else if constexpr (ST == 2) phase_kmean(C);
    else if constexpr (ST == 3) { phase_gate(C, L); if (SGU_OPT) phase_sgu(C, L); else phase_sgu_simple(C, L); }
    else if constexpr (ST == 4) { if (ATTN_OPT) phase_attn(C, L + 2 * rep); else phase_attn_simple(C, (bf16*)(C.ws + WS_MIX)); }
    else if constexpr (ST == 5) { if (ATTN_OPT) phase_combine(C); }
    else if constexpr (ST == 6) {
        pg8::Gemm g{(const pg8::bf16_t*)(C.ws + WS_MIX), (const pg8::bf16_t*)(C.ws + WS_WOUT) + (size_t)L * DM * DM, MROWS, DM, DM};
        pg8::StaticOrder S; S.init(MROWS, DM, C.G, C.bid);
        if (L == 0) { pg8::EpiRes<false> E{C.x, C.out, (pg8::bf16_t*)(C.ws + WS_XB), (float*)(C.ws + WS_ROWSS)};
            pg8::gemm_phase<pg8::EpiRes<false>, pg8::StaticOrder, true, true>((PG8_LAS unsigned char*)lds, g, S, E, C.tid); }
        else { pg8::EpiRes<true> E{C.x, C.out, (pg8::bf16_t*)(C.ws + WS_XB), (float*)(C.ws + WS_ROWSS)};
            pg8::gemm_phase<pg8::EpiRes<true>, pg8::StaticOrder, true, true>((PG8_LAS unsigned char*)lds, g, S, E, C.tid); }
    } else if constexpr (ST == 7) phase_final(C);
    else if constexpr (ST == 8) phase_attn_simple(C, (bf16*)(C.ws + 104 * MiB));
    else if constexpr (ST == 9) {
        const bf16* A = (const bf16*)(C.ws + WS_MIX); const bf16* B = (const bf16*)(C.ws + 104 * MiB); unsigned* flag = (unsigned*)(C.ws + WS_CTL) + 32;
        float md = 0.f;
        for (size_t idx = (size_t)C.bid * 512 + C.tid; idx < (size_t)MROWS * 512; idx += (size_t)C.G * 512) {
            const size_t row = idx >> 9, col = 512 + (idx & 511);
            const float a = __uint_as_float((unsigned)A[row * 1024 + col] << 16), r = __uint_as_float((unsigned)B[row * 1024 + col] << 16);
            float sc = fabsf(r);
#pragma unroll
            for (int o = 1; o < 64; o <<= 1) sc = fmaxf(sc, __shfl_xor(sc, o));
            const float d = fabsf(a - r) / (0.02f + sc);
            md = (d > md || !(d == d)) ? (d == d ? d : 1e6f) : md;
        }
        atomicMax(flag, __float_as_uint(md));
    }
}
template <int SEL> __global__ void __launch_bounds__(NWAVES * 64, 2) fwd(Args args) {
    extern __shared__ __attribute__((aligned(16))) unsigned char lds[];
    if constexpr (SEL >= 0) run_stage<SEL>(args, lds, args.layer);
    else {
        if (args.pad == 0x7fffffff) cg::this_grid().sync();
        volatile LAS unsigned* bst = (volatile LAS unsigned*)((LAS unsigned char*)lds + LDS_BARST);
        if (threadIdx.x == 0) { bst[0] = 0u; bst[1] = 0u; }
        __syncthreads();
        XcdBarrier bar = xcd_barrier_post((unsigned*)(args.ws + WS_CTL) + CW_BAR, bst);
#define GRID_SYNC() do { XcdBarrier b2_ = bar; asm volatile("" : "+s"(b2_.bar), "+s"(b2_.x)); xcd_barrier(b2_); } while (0)
#define RUN(k, L) do { run_stage<k>(args, lds, L); GRID_SYNC(); if (REPEAT_MASK & (1 << k)) { run_stage<k>(args, lds, L + 16); GRID_SYNC(); } } while (0)
        RUN(0, 0);
        for (int L = 0; L < DEPTH; ++L) {
            RUN(1, L); RUN(3, L); RUN(4, L);
            if (ATTN_OPT) RUN(5, L);
            RUN(6, L);
        }
        run_stage<7>(args, lds, 0);
    }
}

#ifndef MK_N_LAUNCHES
#define MK_N_LAUNCHES 1
#endif
template <int SEL> static void launch_stage(int grid, Args a, int layer, hipStream_t stream) {
    static bool attr = false;
    if (!attr) { (void)hipFuncSetAttribute((const void*)fwd<SEL>, hipFuncAttributeMaxDynamicSharedMemorySize, LDS_BYTES); attr = true; }
    a.layer = layer;
    hipLaunchKernelGGL(fwd<SEL>, dim3(grid), dim3(NWAVES * 64), LDS_BYTES, stream, a);
}
extern "C" void kernel_launch(void* const* d_in, const int* in_sizes, int n_in, void* d_out, int out_size, void* d_ws, size_t ws_size, hipStream_t stream) {
    static int grid = 0;
    if (grid == 0) {
        if (n_in != 10 || out_size != MROWS * DM || ws_size < WS_END) { fprintf(stderr, "kernel_launch: unexpected shapes (n_in %d out %d ws %zu)\n", n_in, out_size, ws_size); grid = -1; return; }
        int dev = 0, cus = 0;
        (void)hipGetDevice(&dev); (void)hipDeviceGetAttribute(&cus, hipDeviceAttributeMultiprocessorCount, dev);
        grid = cus;
#if MK_N_LAUNCHES == 1
        int per_cu = 0;
        if (hipFuncSetAttribute((const void*)fwd<-1>, hipFuncAttributeMaxDynamicSharedMemorySize, LDS_BYTES) != hipSuccess) { fprintf(stderr, "kernel_launch: hipFuncSetAttribute failed\n"); grid = -1; return; }
        if (hipOccupancyMaxActiveBlocksPerMultiprocessor(&per_cu, (const void*)fwd<-1>, NWAVES * 64, LDS_BYTES) != hipSuccess || per_cu < 1) { fprintf(stderr, "kernel_launch: occupancy query says %d\n", per_cu); grid = -1; return; }
        (void)hipGetLastError();
#endif
    }
    if (grid < 0) return;
    (void)hipMemsetAsync((char*)d_ws + WS_CTL, 0, CTL_ZERO_BYTES, stream);
    Args a{};
    for (int i = 0; i < 10; ++i) a.in[i] = (const float*)d_in[i];
    a.out = (float*)d_out; a.ws = (unsigned char*)d_ws;
#if MK_N_LAUNCHES == 1
    void* kargs[] = {&a};
    hipError_t e = hipLaunchCooperativeKernel((const void*)fwd<-1>, dim3(grid), dim3(NWAVES * 64), kargs, LDS_BYTES, stream);
    if (e != hipSuccess) fprintf(stderr, "kernel_launch: cooperative launch failed: %s\n", hipGetErrorString(e));
#else
    launch_stage<0>(grid, a, 0, stream);
    for (int L = 0; L < DEPTH; ++L) {
        launch_stage<1>(grid, a, L, stream); launch_stage<3>(grid, a, L, stream);
        launch_stage<4>(grid, a, L, stream); launch_stage<5>(grid, a, L, stream);
        if (CHECK_ATTN && L == 0) { launch_stage<8>(grid, a, L, stream); launch_stage<9>(grid, a, L, stream); }
        launch_stage<6>(grid, a, L, stream);
    }
    launch_stage<7>(grid, a, 0, stream);
#endif
}
```

```cpp
#include <hip/hip_runtime.h>
#include <hip/hip_cooperative_groups.h>
#include <cstdio>
#include <cstdint>
namespace cg = cooperative_groups;

constexpr int BATCH = 2, SEQ = 16384, DM = 1024, MROWS = BATCH * SEQ, DIN = 3584, DSUB = 512;
constexpr int NH = 8, DH = 64, NBLK = SEQ / 256, NBH = BATCH * NH, DEPTH = 2;
constexpr float NORM_EPS = 1e-6f, LN_EPS = 1e-5f;
constexpr float LOG2E = 1.4426950408889634f;
#ifndef CHECK_ATTN
#define CHECK_ATTN 0
#endif
constexpr float QSCALE = 0.125f * LOG2E;
namespace pg8 {
#define PG8_LAS __attribute__((address_space(3)))
typedef unsigned short bf16_t;
typedef short bf16x8 __attribute__((ext_vector_type(8)));
typedef float f32x4 __attribute__((ext_vector_type(4)));
typedef unsigned u32x4 __attribute__((ext_vector_type(4)));
constexpr int BM = 256, BK = 64, HALF = 128, HTB = HALF * BK * 2  , STAGE_BYTES = 8 * HTB, NXCD = 8, WGM = 8;

__host__ __device__ __forceinline__ int lds_byte(int r, int c) { const int st = (r >> 4) * 2 + (c >> 5), rr = r & 15, cc = c & 31, ob = rr * 64 + cc * 2; return st * 1024 + (ob ^ (((ob >> 9) & 1) << 5)); }
__host__ __device__ __forceinline__ void stage_rc(int b, int& R, int& C) { const int st = b / 1024, sb = b % 1024, swz = sb ^ (((sb >> 9) & 1) << 5); R = (st >> 1) * 16 + swz / 64; C = (st & 1) * 32 + (swz % 64) / 2; }
__host__ __device__ __forceinline__ int perm32(int rho) { const int n = rho >> 4, i = rho & 15; return 8 * (i >> 2) + 4 * n + (i & 3); }

struct Unit { int pm, pn; };
struct Gemm { const bf16_t* A; const bf16_t* Bt; int M, N, K; };

struct StaticOrder {
    int nM, nN, nwg, G, c;
    __host__ __device__ void init(int M, int N, int G_, int c_) { nM = M / BM; nN = N / BM; nwg = nM * nN; G = G_; c = c_; }
    __host__ __device__ bool next(int i, Unit& u) const {
        const long L = (long)i * G + c; if (L >= nwg) return false;
        int wgid = (int)L; { const int q = nwg / NXCD, r = nwg % NXCD, xcd = wgid % NXCD, off = wgid / NXCD; wgid = (xcd < r ? xcd * (q + 1) : r * (q + 1) + (xcd - r) * q) + off; }
        const int nig = WGM * nN, gid = wgid / nig, fm = gid * WGM, gsz = (nM - fm) < WGM ? (nM - fm) : WGM;
        u.pm = fm + ((wgid % nig) % gsz); u.pn = (wgid % nig) / gsz; return true;
    }
    __device__ __forceinline__ void a_ready(const Unit&) const {}
    __device__ __forceinline__ void done(const Unit&) const {}
};

__device__ __forceinline__ unsigned cvt_pk_bf16(float lo, float hi) { unsigned r; asm volatile("v_cvt_pk_bf16_f32 %0, %1, %2" : "=v"(r) : "v"(lo), "v"(hi)); return r; }
typedef float f32x2 __attribute__((ext_vector_type(2)));
typedef float f32x2 __attribute__((ext_vector_type(2)));
__device__ __forceinline__ float act_gelu(float x) {
    const float u = x * (1.0f + 0.044715f * x * x);
    const float e = __builtin_amdgcn_exp2f(u * (-2.0f * 0.7978845608028654f * 1.4426950408889634f));
    return x * __builtin_amdgcn_rcpf(1.0f + e);
}
__device__ __forceinline__ float act_silu(float x) {
    const float e = __builtin_amdgcn_exp2f(x * (-1.4426950408889634f));
    return x * __builtin_amdgcn_rcpf(1.0f + e);
}
struct EpiProj {
    static constexpr bool PERM = true, AFTER_DRAIN = false;
    bf16_t* P; size_t sub_stride; const float* rstd_lds; int pm0, pm1, pm2, pm3; float* kmean;
    __device__ __forceinline__ void operator()(const f32x4 (&acc)[2][2][4][2], const Unit& u, int wr, int wc, int fr, int fq) const {
        const int t = u.pn >> 1;
        bf16_t* base = P + (size_t)t * sub_stride;
        const int col0 = (u.pn & 1) * 256 + wc * 32 + 8 * fq;
        const int row0 = u.pm * BM + wr * 64 + fr;
        const int slot = (u.pm == pm0) ? 0 : (u.pm == pm1) ? 1 : (u.pm == pm2) ? 2 : 3;
        const float* rt = rstd_lds + slot * 256 + wr * 64 + fr;
        const float qs = (t == 3) ? (0.125f * 1.4426950408889634f) : 1.0f;
        float ks[2][8];
#pragma unroll
        for (int bj = 0; bj < 2; ++bj)
#pragma unroll
            for (int e = 0; e < 8; ++e) ks[bj][e] = 0.f;
#pragma unroll
        for (int ai = 0; ai < 2; ++ai)
#pragma unroll
            for (int m = 0; m < 4; ++m) {
                const int row = row0 + ai * HALF + m * 16;
                const float rs = rt[ai * HALF + m * 16] * qs;
                bf16_t* rowp = base + (size_t)row * 512 + col0;
#pragma unroll
                for (int bj = 0; bj < 2; ++bj) {
                    const f32x4 v0 = acc[ai][bj][m][0] * rs, v1 = acc[ai][bj][m][1] * rs;
                    if (t == 4) {
#pragma unroll
                        for (int e = 0; e < 4; ++e) { ks[bj][e] += v0[e]; ks[bj][4 + e] += v1[e]; }
                    }
                    u32x4 w; w.x = cvt_pk_bf16(v0[0], v0[1]); w.y = cvt_pk_bf16(v0[2], v0[3]); w.z = cvt_pk_bf16(v1[0], v1[1]); w.w = cvt_pk_bf16(v1[2], v1[3]);
                    *(u32x4*)(rowp + bj * HALF) = w;
                }
            }
        if (t == 4) {
            const int b = u.pm >> 6, n = u.pm & 63;
#pragma unroll
            for (int bj = 0; bj < 2; ++bj)
#pragma unroll
                for (int e = 0; e < 8; ++e) {
                    float v = ks[bj][e];
                    v += __shfl_xor(v, 1); v += __shfl_xor(v, 2); v += __shfl_xor(v, 4); v += __shfl_xor(v, 8);
                    if (fr == 0) { const int col = col0 + bj * HALF + e; atomicAdd(kmean + ((size_t)((b * 8 + (col >> 6)) * 64 + n)) * 64 + (col & 63), v * (1.0f / 256.0f)); }
                }
        }
    }
};
#define PG8_GAS __attribute__((address_space(1)))
struct EpiRes {
    static constexpr bool PERM = false, AFTER_DRAIN = false;
    bf16_t* xb; float* rowss;
    __device__ __forceinline__ void operator()(const f32x4 (&acc)[2][2][4][2], const Unit& u, int wr, int wc, int fr, int fq) const {
        typedef unsigned u32x2v __attribute__((ext_vector_type(2)));
        const int col0 = u.pn * BM + wc * 32 + 4 * fq;
        PG8_GAS bf16_t* xbg = (PG8_GAS bf16_t*)xb; PG8_GAS float* rsg = (PG8_GAS float*)rowss;
        const size_t offb = (size_t)(u.pm * BM + wr * 64 + fr) * 1024 + col0;
        u32x2v rr[2][4][2][2];
#pragma unroll
        for (int ai = 0; ai < 2; ++ai)
#pragma unroll
            for (int m = 0; m < 4; ++m)
#pragma unroll
                for (int bj = 0; bj < 2; ++bj)
#pragma unroll
                    for (int n = 0; n < 2; ++n) rr[ai][m][bj][n] = *(const PG8_GAS u32x2v*)(xbg + offb + (size_t)(ai * HALF + m * 16) * 1024 + bj * HALF + n * 16);
#pragma unroll
        for (int ai = 0; ai < 2; ++ai)
#pragma unroll
            for (int m = 0; m < 4; ++m) {
                const int row = u.pm * BM + ai * HALF + wr * 64 + m * 16 + fr;
                float ss = 0.f;
#pragma unroll
                for (int bj = 0; bj < 2; ++bj)
#pragma unroll
                    for (int n = 0; n < 2; ++n) {
                        const u32x2v w0 = rr[ai][m][bj][n];
                        const f32x4 r = (f32x4){__uint_as_float(w0.x << 16), __uint_as_float(w0.x & 0xffff0000u), __uint_as_float(w0.y << 16), __uint_as_float(w0.y & 0xffff0000u)};
                        const f32x4 o = r + acc[ai][bj][m][n];
                        ss += (o[0] * o[0] + o[1] * o[1]) + (o[2] * o[2] + o[3] * o[3]);
                        u32x2v w; w.x = cvt_pk_bf16(o[0], o[1]); w.y = cvt_pk_bf16(o[2], o[3]);
                        *(PG8_GAS u32x2v*)(xbg + offb + (size_t)(ai * HALF + m * 16) * 1024 + bj * HALF + n * 16) = w;
                    }
                ss += __shfl_xor(ss, 16); ss += __shfl_xor(ss, 32);
                if (fq == 0) rsg[(size_t)row * 16 + u.pn * 4 + wc] = ss;
            }
    }
};
struct EpiFinal {
    static constexpr bool PERM = false, AFTER_DRAIN = false;
    const bf16_t* xb; float* out; const float* fg; float* slots; unsigned* cnt;
    __device__ __forceinline__ void operator()(f32x4 (&acc)[2][2][4][2], const Unit& u, int wr, int wc, int fr, int fq) const {
        typedef unsigned u32x2v __attribute__((ext_vector_type(2)));
        const int col0 = u.pn * BM + wc * 32 + 4 * fq;
        const PG8_GAS bf16_t* xbg = (const PG8_GAS bf16_t*)xb; PG8_GAS float* outg = (PG8_GAS float*)out; const PG8_GAS float* slg = (const PG8_GAS float*)slots;
        const size_t offb = (size_t)(u.pm * BM + wr * 64 + fr) * 1024 + col0;
        u32x2v rr[2][4][2][2];
#pragma unroll
        for (int ai = 0; ai < 2; ++ai)
#pragma unroll
            for (int m = 0; m < 4; ++m)
#pragma unroll
                for (int bj = 0; bj < 2; ++bj)
#pragma unroll
                    for (int n = 0; n < 2; ++n) rr[ai][m][bj][n] = *(const PG8_GAS u32x2v*)(xbg + offb + (size_t)(ai * HALF + m * 16) * 1024 + bj * HALF + n * 16);
#pragma unroll
        for (int ai = 0; ai < 2; ++ai)
#pragma unroll
            for (int m = 0; m < 4; ++m) {
                const int row = u.pm * BM + ai * HALF + wr * 64 + m * 16 + fr;
                float ss = 0.f;
#pragma unroll
                for (int bj = 0; bj < 2; ++bj)
#pragma unroll
                    for (int n = 0; n < 2; ++n) {
                        const u32x2v w = rr[ai][m][bj][n];
                        const f32x4 r = (f32x4){__uint_as_float(w.x << 16), __uint_as_float(w.x & 0xffff0000u), __uint_as_float(w.y << 16), __uint_as_float(w.y & 0xffff0000u)};
                        const f32x4 o = r + acc[ai][bj][m][n];
                        acc[ai][bj][m][n] = o;
                        ss += (o[0] * o[0] + o[1] * o[1]) + (o[2] * o[2] + o[3] * o[3]);
                    }
                ss += __shfl_xor(ss, 16); ss += __shfl_xor(ss, 32);
                if (fq == 0) __hip_atomic_store(slots + (size_t)row * 16 + u.pn * 4 + wc, ss, __ATOMIC_RELAXED, __HIP_MEMORY_SCOPE_AGENT);
            }
        asm volatile("s_waitcnt vmcnt(0)" ::: "memory");
        unsigned* pc = cnt + 64 * u.pm;
        if (fr == 0 && fq == 0) __hip_atomic_fetch_add(pc, 1u, __ATOMIC_RELAXED, __HIP_MEMORY_SCOPE_AGENT);
        f32x4 g4[2][2];
#pragma unroll
        for (int bj = 0; bj < 2; ++bj)
#pragma unroll
            for (int n = 0; n < 2; ++n) g4[bj][n] = *(const PG8_GAS f32x4*)((const PG8_GAS float*)fg + col0 + bj * HALF + n * 16);
        for (unsigned spins = 0; spins < (1u << 22); ++spins) {
            if (__hip_atomic_load(pc, __ATOMIC_RELAXED, __HIP_MEMORY_SCOPE_AGENT) >= 32u) break;
            __builtin_amdgcn_s_sleep(2);
        }
        __builtin_amdgcn_fence(__ATOMIC_ACQUIRE, "agent");
        asm volatile("s_waitcnt vmcnt(0)" ::: "memory");
#pragma unroll
        for (int ai = 0; ai < 2; ++ai) {
            f32x4 sl[4][4];
#pragma unroll
            for (int m = 0; m < 4; ++m)
#pragma unroll
                for (int k = 0; k < 4; ++k) sl[m][k] = *(const PG8_GAS f32x4*)(slg + (size_t)(u.pm * BM + ai * HALF + wr * 64 + m * 16 + fr) * 16 + k * 4);
#pragma unroll
            for (int m = 0; m < 4; ++m) {
                const f32x4 s0 = sl[m][0], s1 = sl[m][1], s2 = sl[m][2], s3 = sl[m][3];
                const float tot = ((s0[0] + s0[1]) + (s0[2] + s0[3])) + ((s1[0] + s1[1]) + (s1[2] + s1[3])) + ((s2[0] + s2[1]) + (s2[2] + s2[3])) + ((s3[0] + s3[1]) + (s3[2] + s3[3]));
                const float rs = 1.0f / sqrtf(tot * (1.0f / 1024.0f) + 1e-6f);
#pragma unroll
                for (int bj = 0; bj < 2; ++bj)
#pragma unroll
                    for (int n = 0; n < 2; ++n) *(PG8_GAS f32x4*)(outg + offb + (size_t)(ai * HALF + m * 16) * 1024 + bj * HALF + n * 16) = acc[ai][bj][m][n] * rs * g4[bj][n];
            }
        }
    }
};
template <class Epi, class Sched, bool ALIGN_EPI = false, bool SP2 = false>
__device__ __forceinline__ void gemm_phase(PG8_LAS unsigned char* lds, const Gemm g, const Sched& S, const Epi& E, const int tid) {
    const int wid = __builtin_amdgcn_readfirstlane(tid >> 6), lane = tid & 63, wr = wid >> 2, wc = wid & 3, fr = lane & 15, fq = lane >> 4;
    const int K = g.K, nt = K / BK;
    unsigned voffA[2], voffB[2];
#pragma unroll
    for (int i = 0; i < 2; ++i) { int R, C; stage_rc(tid * 16 + i * 8192, R, C); const int Rb = Epi::PERM ? ((R & ~31) + perm32(R & 31)) : R;
        voffA[i] = (unsigned)(R * K + C) * 2u; voffB[i] = (unsigned)(Rb * K + C) * 2u; }
    const size_t kstep = (size_t)(BK * 2);
    const size_t hstep = (size_t)HALF * K * 2;
    const size_t tstep = 2 * hstep;
    const unsigned ldsw = (unsigned)wid * 1024u;
    const int aoff = lds_byte(wr * 64 + fr, fq * 8), boff = lds_byte(wc * 32 + fr, fq * 8);
#define PG8_SA(b, h) (((b) * 2 + (h)) * HTB)
#define PG8_SB(b, h) ((4 + (b) * 2 + (h)) * HTB)
#define PG8_STAGE(bufoff, gbase, voff) do { _Pragma("unroll") for (int _i = 0; _i < 2; ++_i) \
        __builtin_amdgcn_global_load_lds((const unsigned*)((const char*)(gbase) + (voff)[_i]), (PG8_LAS unsigned*)(lds + (bufoff) + ldsw + _i * 8192), 16, 0, 0); } while (0)
#define PG8_LDA(dst, b, h) do { _Pragma("unroll") for (int m = 0; m < 4; ++m) _Pragma("unroll") for (int k = 0; k < 2; ++k) dst[m][k] = *(const PG8_LAS bf16x8*)(lds + PG8_SA(b, h) + aoff + m * 2048 + k * 1024); } while (0)
#define PG8_LDB(dst, b, h) do { _Pragma("unroll") for (int n = 0; n < 2; ++n) _Pragma("unroll") for (int k = 0; k < 2; ++k) dst[n][k] = *(const PG8_LAS bf16x8*)(lds + PG8_SB(b, h) + boff + n * 2048 + k * 1024); } while (0)
#define PG8_MMA(ai, bj, At, Bt) do { __builtin_amdgcn_s_setprio(1); _Pragma("unroll") for (int m = 0; m < 4; ++m) _Pragma("unroll") for (int n = 0; n < 2; ++n) _Pragma("unroll") for (int k = 0; k < 2; ++k) \
        acc[ai][bj][m][n] = __builtin_amdgcn_mfma_f32_16x16x32_bf16(Bt[n][k], At[m][k], acc[ai][bj][m][n], 0, 0, 0); __builtin_amdgcn_s_setprio(0); } while (0)
#define PG8_WAIT_V(n) asm volatile("s_waitcnt vmcnt(" #n ")" ::: "memory")
#define PG8_WAIT_L(n) asm volatile("s_waitcnt lgkmcnt(" #n ")" ::: "memory")
#define PG8_BAR __builtin_amdgcn_s_barrier()
#define PG8_SCHED __builtin_amdgcn_sched_barrier(0)
    Unit cur, nxt; int ui = 0;
    if (!S.next(0, cur)) return;
    f32x4 acc[2][2][4][2];
#pragma unroll
    for (int a = 0; a < 2; ++a)
#pragma unroll
        for (int b = 0; b < 2; ++b)
#pragma unroll
            for (int m = 0; m < 4; ++m)
#pragma unroll
                for (int n = 0; n < 2; ++n) acc[a][b][m][n] = (f32x4){0.f, 0.f, 0.f, 0.f};
    bf16x8 At[4][2], B0[2][2], B1[2][2];
    const char* cA = (const char*)g.A + (size_t)cur.pm * tstep; const char* cB = (const char*)g.Bt + (size_t)cur.pn * tstep;
    S.a_ready(cur);
    if constexpr (SP2) {
        PG8_STAGE(PG8_SB(0, 0), cB, voffB); PG8_STAGE(PG8_SB(0, 1), cB + hstep, voffB); PG8_STAGE(PG8_SA(0, 0), cA, voffA); PG8_STAGE(PG8_SA(0, 1), cA + hstep, voffA);
        if (wr == 1) PG8_BAR;
        PG8_WAIT_V(2); PG8_BAR;
        PG8_STAGE(PG8_SB(1, 0), cB + kstep, voffB); PG8_STAGE(PG8_SA(1, 0), cA + kstep, voffA); PG8_STAGE(PG8_SB(1, 1), cB + hstep + kstep, voffB);
        PG8_WAIT_V(6); PG8_BAR;
    } else {
        PG8_STAGE(PG8_SB(0, 0), cB, voffB); PG8_STAGE(PG8_SA(0, 0), cA, voffA); PG8_STAGE(PG8_SB(0, 1), cB + hstep, voffB); PG8_STAGE(PG8_SA(0, 1), cA + hstep, voffA);
        if (wr == 1) PG8_BAR;
        PG8_WAIT_V(4); PG8_BAR;
        PG8_STAGE(PG8_SB(1, 0), cB + kstep, voffB); PG8_STAGE(PG8_SA(1, 0), cA + kstep, voffA); PG8_STAGE(PG8_SB(1, 1), cB + hstep + kstep, voffB);
        PG8_WAIT_V(6); PG8_BAR;
    }
    for (;;) {
        const bool has_next = S.next(ui + 1, nxt);
        const char* nA = has_next ? (const char*)g.A + (size_t)nxt.pm * tstep : cA; const char* nB = has_next ? (const char*)g.Bt + (size_t)nxt.pn * tstep : cB;
        for (int t = 0; t < nt; t += 2) {
            const bool last = (t == nt - 2);
            const char* a1 = cA + (size_t)(t + 1) * kstep;
            const char* a2 = last ? nA : cA + (size_t)(t + 2) * kstep; const char* b2 = last ? nB : cB + (size_t)(t + 2) * kstep;
            const char* a3 = a2 + kstep; const char* b3 = b2 + kstep;
            if (last && has_next) S.a_ready(nxt);
            if constexpr (SP2) {
            PG8_LDB(B0, 0, 0); PG8_LDB(B1, 0, 1); PG8_SCHED; PG8_LDA(At, 0, 0); PG8_STAGE(PG8_SA(1, 1), a1 + hstep, voffA);
            PG8_WAIT_V(8); PG8_WAIT_L(0); PG8_BAR; PG8_MMA(0, 0, At, B0); PG8_MMA(0, 1, At, B1); PG8_BAR; PG8_SCHED;
            PG8_LDA(At, 0, 1); PG8_STAGE(PG8_SB(0, 0), b2, voffB); PG8_STAGE(PG8_SB(0, 1), b2 + hstep, voffB); PG8_STAGE(PG8_SA(0, 0), a2, voffA);
            PG8_WAIT_V(8); PG8_WAIT_L(0); PG8_BAR; PG8_MMA(1, 0, At, B0); PG8_MMA(1, 1, At, B1); PG8_BAR; PG8_SCHED;
            PG8_LDB(B0, 1, 0); PG8_LDB(B1, 1, 1); PG8_SCHED; PG8_LDA(At, 1, 0); PG8_STAGE(PG8_SA(0, 1), a2 + hstep, voffA);
            PG8_WAIT_V(8); PG8_WAIT_L(0); PG8_BAR; PG8_MMA(0, 0, At, B0); PG8_MMA(0, 1, At, B1); PG8_BAR; PG8_SCHED;
            PG8_LDA(At, 1, 1); PG8_STAGE(PG8_SB(1, 0), b3, voffB); PG8_STAGE(PG8_SB(1, 1), b3 + hstep, voffB); PG8_STAGE(PG8_SA(1, 0), a3, voffA);
            PG8_WAIT_V(8); PG8_WAIT_L(0); PG8_BAR; PG8_MMA(1, 0, At, B0); PG8_MMA(1, 1, At, B1); PG8_BAR; PG8_SCHED;
            } else {
            PG8_LDB(B0, 0, 0); PG8_SCHED; PG8_LDA(At, 0, 0); PG8_STAGE(PG8_SA(1, 1), a1 + hstep, voffA);
            PG8_WAIT_L(8); PG8_BAR; PG8_WAIT_L(0); PG8_MMA(0, 0, At, B0); PG8_BAR; PG8_SCHED;
            PG8_LDB(B1, 0, 1); PG8_STAGE(PG8_SB(0, 0), b2, voffB);
            PG8_BAR; PG8_WAIT_L(0); PG8_MMA(0, 1, At, B1); PG8_BAR;
            PG8_LDA(At, 0, 1); PG8_STAGE(PG8_SA(0, 0), a2, voffA);
            PG8_BAR; PG8_WAIT_L(0); PG8_MMA(1, 0, At, B0); PG8_BAR; PG8_SCHED;
            PG8_STAGE(PG8_SB(0, 1), b2 + hstep, voffB);
            PG8_WAIT_V(6); PG8_BAR; PG8_MMA(1, 1, At, B1); PG8_BAR;
            PG8_LDB(B0, 1, 0); PG8_SCHED; PG8_LDA(At, 1, 0); PG8_STAGE(PG8_SA(0, 1), a2 + hstep, voffA);
            PG8_WAIT_L(8); PG8_BAR; PG8_WAIT_L(0); PG8_MMA(0, 0, At, B0); PG8_BAR; PG8_SCHED;
            PG8_LDB(B1, 1, 1); PG8_STAGE(PG8_SB(1, 0), b3, voffB);
            PG8_BAR; PG8_WAIT_L(0); PG8_MMA(0, 1, At, B1); PG8_BAR;
            PG8_LDA(At, 1, 1); PG8_STAGE(PG8_SA(1, 0), a3, voffA);
            PG8_BAR; PG8_WAIT_L(0); PG8_MMA(1, 0, At, B0); PG8_BAR; PG8_SCHED;
            PG8_STAGE(PG8_SB(1, 1), b3 + hstep, voffB);
            PG8_WAIT_V(6); PG8_BAR; PG8_MMA(1, 1, At, B1); PG8_BAR;
            }
        }
        if constexpr (ALIGN_EPI) { if (wr == 0) PG8_BAR; }
        if constexpr (!Epi::AFTER_DRAIN) { int ln_; asm volatile("v_mbcnt_lo_u32_b32 %0, -1, 0\n\tv_mbcnt_hi_u32_b32 %0, -1, %0" : "=v"(ln_)); E(acc, cur, wr, wc, ln_ & 15, ln_ >> 4); S.done(cur); }
        if (!has_next) break;
#pragma unroll
        for (int a = 0; a < 2; ++a)
#pragma unroll
            for (int b = 0; b < 2; ++b)
#pragma unroll
                for (int m = 0; m < 4; ++m)
#pragma unroll
                    for (int n = 0; n < 2; ++n) acc[a][b][m][n] = (f32x4){0.f, 0.f, 0.f, 0.f};
        cur = nxt; cA = nA; cB = nB; ++ui;
        if constexpr (ALIGN_EPI) { if (wr == 1) PG8_BAR; }
    }
    PG8_WAIT_V(0);
    if constexpr (!ALIGN_EPI) { if (wr == 0) PG8_BAR; }
    PG8_BAR;
    if constexpr (Epi::AFTER_DRAIN) { E.fused(acc, cur, wr, wc, fr, fq, lds, wid, lane); S.done(cur); }
#undef PG8_SA
#undef PG8_SB
#undef PG8_STAGE
#undef PG8_LDA
#undef PG8_LDB
#undef PG8_MMA
#undef PG8_WAIT_V
#undef PG8_WAIT_L
#undef PG8_BAR
#undef PG8_SCHED
}
}

constexpr size_t MiB = 1u << 20;
constexpr size_t WS_CTL = 0, CTL_ZERO_BYTES = 1 * MiB;
constexpr size_t WS_WIN = 2 * MiB;
constexpr size_t WS_WOUT = 16 * MiB;
constexpr size_t WS_WST = 20 * MiB;
constexpr size_t WS_BT = 21 * MiB;
constexpr size_t WS_KMEAN = 22 * MiB;
constexpr size_t WS_LOFF = 23 * MiB;
constexpr size_t WS_ROWSS = 24 * MiB;
constexpr size_t WS_PL = 26 * MiB;
constexpr size_t WS_LIST = 30 * MiB;
constexpr size_t WS_SEL = 32 * MiB;
constexpr size_t WS_XB = 40 * MiB;
constexpr size_t WS_PROJ = 168 * MiB;
constexpr size_t WS_MIX = 392 * MiB;
constexpr size_t WS_END = 456 * MiB;
constexpr size_t SUBSTRIDE = (size_t)MROWS * 512;
enum { T_U = 0, T_V = 1, T_ZA = 2, T_Q = 3, T_K = 4, T_VV = 5, T_ZB = 6 };

constexpr int NWAVES = 8;
constexpr int LDS_BYTES = 160 * 1024;
constexpr int RING_BYTES = 131072;

#define LAS __attribute__((address_space(3)))
typedef unsigned short bf16;
typedef unsigned v4u __attribute__((ext_vector_type(4)));
typedef float f32x4 __attribute__((ext_vector_type(4)));
#define LDS_WAIT() asm volatile("s_waitcnt lgkmcnt(0)" ::: "memory")
__device__ __forceinline__ unsigned f2bf(float f) { unsigned u = __builtin_bit_cast(unsigned, f); return (u + 0x7fffu + ((u >> 16) & 1u)) >> 16; }
__device__ __forceinline__ unsigned pk2(float lo, float hi) { return f2bf(lo) | (f2bf(hi) << 16); }
__device__ __forceinline__ float bflo(unsigned w) { return __uint_as_float(w << 16); }
__device__ __forceinline__ float bfhi(unsigned w) { return __uint_as_float(w & 0xffff0000u); }
__device__ __forceinline__ float wave_sum(float v) {
#pragma unroll
    for (int o = 1; o < 64; o <<= 1) v += __shfl_xor(v, o);
    return v;
}

__device__ __forceinline__ int lane_now() { int l; asm volatile("v_mbcnt_lo_u32_b32 %0, -1, 0\n\tv_mbcnt_hi_u32_b32 %0, -1, %0" : "=v"(l)); return l; }
struct Args { const float* in[10]; float* out; unsigned char* ws; int layer, pad; };

struct Ctx {
    unsigned char* lds;
    int tid, lane, wave, G, bid;
    const float *x, *norm_g, *w_in, *ln_g, *ln_b, *sgu_w, *sgu_b, *w_out, *rel_bias, *final_g;
    float* out; unsigned char* ws;
};

__device__ __forceinline__ void p0_transpose_item(const float* W, const float* gs, int K, int N, bf16* WT, float* scr, int item, int lane) {
    const int nblk = N / 32, kb = item / nblk, nb = item % nblk, k0 = 64 * kb, n0 = 32 * nb;
#pragma unroll 8
    for (int i = 0; i < 32; ++i) { const int kk = 2 * i + (lane >> 5); const float sc = gs ? gs[k0 + kk] : 1.0f; scr[kk * 33 + (lane & 31)] = W[(size_t)(k0 + kk) * N + n0 + (lane & 31)] * sc; }
    LDS_WAIT(); asm volatile("" ::: "memory");
    const int c = lane & 7;
#pragma unroll
    for (int j = 0; j < 4; ++j) { const int n = (lane >> 3) + 8 * j; const float* s = scr + (8 * c) * 33 + n;
        v4u o; o.x = pk2(s[0 * 33], s[1 * 33]); o.y = pk2(s[2 * 33], s[3 * 33]); o.z = pk2(s[4 * 33], s[5 * 33]); o.w = pk2(s[6 * 33], s[7 * 33]);
        *(v4u*)(WT + (size_t)(n0 + n) * K + k0 + 8 * c) = o; }
    LDS_WAIT(); asm volatile("" ::: "memory");
}
__device__ __forceinline__ int rel_bucket(int d) {
    if (d < 16) return d;
    int b = 16;
    b += (d >= 19); b += (d >= 21); b += (d >= 24); b += (d >= 27); b += (d >= 31); b += (d >= 35); b += (d >= 40); b += (d >= 46);
    b += (d >= 52); b += (d >= 59); b += (d >= 67); b += (d >= 77); b += (d >= 87); b += (d >= 99); b += (d >= 113);
    return b;
}
__device__ __forceinline__ void phase_prologue(const Ctx& C) {
    float* scr = (float*)(C.lds + C.wave * 16384);
    const int gw = C.bid * NWAVES + C.wave, NGW = C.G * NWAVES;
    constexpr int I_IN = (DM / 64) * (DIN / 32), I_OUT = (DM / 64) * (DM / 32);
    constexpr int NITEMS = DEPTH * (I_IN + I_OUT);
    for (int it = gw; it < NITEMS; it += NGW) {
        const int l = it / (I_IN + I_OUT); int r = it % (I_IN + I_OUT);
        if (r < I_IN) p0_transpose_item(C.w_in + (size_t)l * DM * DIN, C.norm_g + l * DM, DM, DIN, (bf16*)(C.ws + WS_WIN) + (size_t)l * DIN * DM, scr, r, C.lane);
        else p0_transpose_item(C.w_out + (size_t)l * DM * DM, nullptr, DM, DM, (bf16*)(C.ws + WS_WOUT) + (size_t)l * DM * DM, scr, r - I_IN, C.lane);
    }
    { float* km = (float*)(C.ws + WS_KMEAN); for (int e = C.bid * 512 + C.tid; e < DEPTH * NBH * NBLK * 64; e += C.G * 512) km[e] = 0.f; }
    { bf16* wst = (bf16*)(C.ws + WS_WST); const int gt = C.bid * 512 + C.tid, NT = C.G * 512;
      for (int e = gt; e < DEPTH * 8 * 128 * 128; e += NT) { const int s = e & 127, t = (e >> 7) & 127; wst[e] = (s <= t) ? (bf16)f2bf(C.sgu_w[e]) : (bf16)0; } }
    if (C.bid == 0) { float* bt = (float*)(C.ws + WS_BT); for (int e = C.tid; e < 8 * 128; e += 512) { const int h = e >> 7, d = e & 127; bt[e] = C.rel_bias[rel_bucket(d) * 8 + h] * LOG2E; } }
    { bf16* xb = (bf16*)(C.ws + WS_XB); float* rowss = (float*)(C.ws + WS_ROWSS);
      constexpr int UN = 4;
      for (int m0 = gw; m0 < MROWS; m0 += NGW * UN) {
        f32x4 v[UN][4];
#pragma unroll
        for (int k = 0; k < UN; ++k) { const f32x4* xr = (const f32x4*)(C.x + (size_t)(m0 + k * NGW) * DM) + C.lane;
#pragma unroll
            for (int j = 0; j < 4; ++j) v[k][j] = xr[64 * j]; }
#pragma unroll
        for (int k = 0; k < UN; ++k) { const int m = m0 + k * NGW;
            float s = 0.f;
#pragma unroll
            for (int j = 0; j < 4; ++j) s += (v[k][j].x * v[k][j].x + v[k][j].y * v[k][j].y) + (v[k][j].z * v[k][j].z + v[k][j].w * v[k][j].w);
            s = wave_sum(s);
            unsigned long long* o8 = (unsigned long long*)(xb + (size_t)m * DM) + C.lane;
#pragma unroll
            for (int j = 0; j < 4; ++j) o8[64 * j] = (unsigned long long)pk2(v[k][j].x, v[k][j].y) | ((unsigned long long)pk2(v[k][j].z, v[k][j].w) << 32);
            if (C.lane < 16) rowss[(size_t)m * 16 + C.lane] = (C.lane == 0) ? s : 0.f; }
      } }
}

typedef short bf16x8 __attribute__((ext_vector_type(8)));
typedef short bf16x4s __attribute__((ext_vector_type(4)));
typedef float f32x16 __attribute__((ext_vector_type(16)));
__device__ __forceinline__ int crow(int r, int hi) { return (r & 3) + 8 * (r >> 2) + 4 * hi; }
__device__ __forceinline__ unsigned cvtpk(float lo, float hi) { unsigned r; asm volatile("v_cvt_pk_bf16_f32 %0, %1, %2" : "=v"(r) : "v"(lo), "v"(hi)); return r; }
__device__ __forceinline__ void phase_gate(const Ctx& C, int layer) {
    const bf16* Q = (const bf16*)(C.ws + WS_PROJ) + (size_t)T_Q * SUBSTRIDE;
    const float* KM = (const float*)(C.ws + WS_KMEAN) + (size_t)layer * NBH * NBLK * 64;
    int* SEL = (int*)(C.ws + WS_SEL); int* LOFF = (int*)(C.ws + WS_LOFF); unsigned short* LIST = (unsigned short*)(C.ws + WS_LIST);
    int* cnt = (int*)(C.lds);
    int* offs = (int*)(C.lds + 256);
    const int lane = C.lane, ql = lane & 31, hi = lane >> 5;
    if (C.tid < 64) cnt[C.tid] = 0;
    __syncthreads();
    bf16x8 qf[4]; f32x4 kr[2][4][2];
#define GATE_LOAD(uu) do { const int bh_ = (uu) / 63, i_ = (uu) % 63 + 1, b_ = bh_ >> 3, h_ = bh_ & 7; \
        const bf16* qrow_ = Q + ((size_t)(b_ * SEQ + i_ * 256 + C.wave * 32 + ql)) * 512 + h_ * 64 + hi * 8; \
        _Pragma("unroll") for (int ks = 0; ks < 4; ++ks) qf[ks] = *(const bf16x8*)(qrow_ + ks * 16); \
        _Pragma("unroll") for (int nt = 0; nt < 2; ++nt) { const float* kp_ = KM + ((size_t)bh_ * NBLK + 32 * nt + ql) * 64 + hi * 8; \
            _Pragma("unroll") for (int ks = 0; ks < 4; ++ks) { kr[nt][ks][0] = *(const f32x4*)(kp_ + ks * 16); kr[nt][ks][1] = *(const f32x4*)(kp_ + ks * 16 + 4); } } } while (0)
    int u = C.bid;
    if (u < NBH * 63) GATE_LOAD(u);
    for (; u < NBH * 63; u += C.G) {
        const int bh = u / 63, i = u % 63 + 1;
        const int q = C.wave * 32 + ql, pos = i * 256 + q;
        float b0 = -INFINITY, b1 = -INFINITY, b2 = -INFINITY; int i0 = -1, i1 = -1, i2 = -1;
#define TOP3_INS(v, idx) do { const float v_ = (v); const int x_ = (idx); if (v_ > b0) { b2 = b1; i2 = i1; b1 = b0; i1 = i0; b0 = v_; i0 = x_; } else if (v_ > b1) { b2 = b1; i2 = i1; b1 = v_; i1 = x_; } else if (v_ > b2) { b2 = v_; i2 = x_; } } while (0)
#pragma unroll
        for (int nt = 0; nt < 2; ++nt) {
            f32x16 p = {};
#pragma unroll
            for (int ks = 0; ks < 4; ++ks) {
                const f32x4 k0 = kr[nt][ks][0], k1 = kr[nt][ks][1];
                const v4u kw = (v4u){cvtpk(k0[0], k0[1]), cvtpk(k0[2], k0[3]), cvtpk(k1[0], k1[1]), cvtpk(k1[2], k1[3])};
                p = __builtin_amdgcn_mfma_f32_32x32x16_bf16(__builtin_bit_cast(bf16x8, kw), qf[ks], p, 0, 0, 0);
            }
#pragma unroll
            for (int r = 0; r < 16; ++r) { const int n = 32 * nt + crow(r, hi); if (n < i) TOP3_INS(p[r], n); }
        }
        if (u + C.G < NBH * 63) GATE_LOAD(u + C.G);
        { const float c0 = __shfl_xor(b0, 32), c1 = __shfl_xor(b1, 32), c2 = __shfl_xor(b2, 32);
          const int j0 = __shfl_xor(i0, 32), j1 = __shfl_xor(i1, 32), j2 = __shfl_xor(i2, 32);
          if (j0 >= 0) TOP3_INS(c0, j0);
          if (j1 >= 0) TOP3_INS(c1, j1);
          if (j2 >= 0) TOP3_INS(c2, j2); }
#undef TOP3_INS
        int p0 = 0, p1 = 0, p2 = 0;
        if (hi == 0) {
            if (CHECK_ATTN) { int* sp = SEL + ((size_t)bh * SEQ + pos) * 4; sp[0] = i0; sp[1] = i1; sp[2] = i2; sp[3] = -1; }
            p0 = atomicAdd(&cnt[i0], 1);
            if (i1 >= 0) p1 = atomicAdd(&cnt[i1], 1);
            if (i2 >= 0) p2 = atomicAdd(&cnt[i2], 1);
        }
        __syncthreads();
        if (C.tid < 64) {
            const int c = cnt[C.tid]; cnt[C.tid] = 0;
            int inc = c;
#pragma unroll
            for (int o = 1; o < 64; o <<= 1) { const int t = __shfl_up(inc, o); if (C.tid >= o) inc += t; }
            offs[C.tid + 1] = inc; if (C.tid == 0) offs[0] = 0;
            LOFF[(size_t)(bh * NBLK + i) * 80 + C.tid + 1] = inc; if (C.tid == 0) LOFF[(size_t)(bh * NBLK + i) * 80] = 0;
        }
        __syncthreads();
        if (hi == 0) {
            unsigned short* lp = LIST + (size_t)(bh * NBLK + i) * 768;
            lp[offs[i0] + p0] = (unsigned short)(q | (0 << 8));
            if (i1 >= 0) lp[offs[i1] + p1] = (unsigned short)(q | (1 << 8));
            if (i2 >= 0) lp[offs[i2] + p2] = (unsigned short)(q | (2 << 8));
        }
    }
#undef GATE_LOAD
    if (CHECK_ATTN) { for (int e = C.bid * 512 + C.tid; e < NBH * 256; e += C.G * 512) { const int bh = e >> 8, qq = e & 255; int* sp = SEL + ((size_t)bh * SEQ + qq) * 4; sp[0] = -1; sp[1] = -1; sp[2] = -1; sp[3] = -1; } }
    __syncthreads();
}

__device__ __forceinline__ void phase_attn_simple(const Ctx& C, bf16* MIX) {
    const bf16* Q = (const bf16*)(C.ws + WS_PROJ) + (size_t)T_Q * SUBSTRIDE;
    const bf16* K = (const bf16*)(C.ws + WS_PROJ) + (size_t)T_K * SUBSTRIDE;
    const bf16* VV = (const bf16*)(C.ws + WS_PROJ) + (size_t)T_VV * SUBSTRIDE;
    const bf16* ZB = (const bf16*)(C.ws + WS_PROJ) + (size_t)T_ZB * SUBSTRIDE;
    const int* SEL = (const int*)(C.ws + WS_SEL); const float* BT = (const float*)(C.ws + WS_BT);
    const int gt = C.bid * 512 + C.tid, NT = C.G * 512;
    for (int item = gt; item < NBH * SEQ; item += NT) {
        const int bh = item >> 14, pos = item & (SEQ - 1), b = bh >> 3, h = bh & 7, own = pos >> 8;
        const size_t rowq = (size_t)(b * SEQ + pos);
        float qv[64], o[64];
        { const v4u* qp = (const v4u*)(Q + rowq * 512 + h * 64);
#pragma unroll
          for (int c = 0; c < 8; ++c) { const v4u v = qp[c]; qv[8 * c + 0] = bflo(v.x); qv[8 * c + 1] = bfhi(v.x); qv[8 * c + 2] = bflo(v.y); qv[8 * c + 3] = bfhi(v.y);
              qv[8 * c + 4] = bflo(v.z); qv[8 * c + 5] = bfhi(v.z); qv[8 * c + 6] = bflo(v.w); qv[8 * c + 7] = bfhi(v.w); } }
#pragma unroll
        for (int d = 0; d < 64; ++d) o[d] = 0.f;
        float m = -INFINITY, l = 0.f;
        const float* bt = BT + h * 128;
        for (int slot = 0; slot < 4; ++slot) {
            int blk, klim;
            if (slot == 0) { blk = own; klim = (pos & 255) + 1; } else { blk = SEL[(size_t)item * 4 + slot - 1]; klim = 256; if (blk < 0) klim = 0; }
            for (int kl = 0; kl < klim; ++kl) {
                const int kpos = blk * 256 + kl;
                const v4u* kp = (const v4u*)(K + ((size_t)(b * SEQ + kpos)) * 512 + h * 64);
                float a0 = 0.f, a1 = 0.f;
#pragma unroll
                for (int c = 0; c < 8; ++c) { const v4u v = kp[c];
                    a0 += qv[8 * c + 0] * bflo(v.x) + qv[8 * c + 2] * bflo(v.y) + qv[8 * c + 4] * bflo(v.z) + qv[8 * c + 6] * bflo(v.w);
                    a1 += qv[8 * c + 1] * bfhi(v.x) + qv[8 * c + 3] * bfhi(v.y) + qv[8 * c + 5] * bfhi(v.z) + qv[8 * c + 7] * bfhi(v.w); }
                int dd = pos - kpos; dd = dd > 127 ? 127 : dd;
                const float s = (a0 + a1) + bt[dd];
                if (s > m) { const float al = __builtin_amdgcn_exp2f(m - s); l *= al;
#pragma unroll
                    for (int d = 0; d < 64; ++d) o[d] *= al;
                    m = s; }
                const float p = __builtin_amdgcn_exp2f(s - m);
                l += p;
                const v4u* vp = (const v4u*)(VV + ((size_t)(b * SEQ + kpos)) * 512 + h * 64);
#pragma unroll
                for (int c = 0; c < 8; ++c) { const v4u v = vp[c];
                    o[8 * c + 0] += p * bflo(v.x); o[8 * c + 1] += p * bfhi(v.x); o[8 * c + 2] += p * bflo(v.y); o[8 * c + 3] += p * bfhi(v.y);
                    o[8 * c + 4] += p * bflo(v.z); o[8 * c + 5] += p * bfhi(v.z); o[8 * c + 6] += p * bflo(v.w); o[8 * c + 7] += p * bfhi(v.w); }
            }
        }
        const float rl = 1.0f / l;
        const v4u* zp = (const v4u*)(ZB + rowq * 512 + h * 64);
        v4u* op = (v4u*)(MIX + rowq * 1024 + 512 + h * 64);
#pragma unroll
        for (int c = 0; c < 8; ++c) { const v4u z = zp[c]; v4u w;
            w.x = pk2(o[8 * c + 0] * rl * pg8::act_silu(bflo(z.x)), o[8 * c + 1] * rl * pg8::act_silu(bfhi(z.x))); w.y = pk2(o[8 * c + 2] * rl * pg8::act_silu(bflo(z.y)), o[8 * c + 3] * rl * pg8::act_silu(bfhi(z.y)));
            w.z = pk2(o[8 * c + 4] * rl * pg8::act_silu(bflo(z.z)), o[8 * c + 5] * rl * pg8::act_silu(bfhi(z.z))); w.w = pk2(o[8 * c + 6] * rl * pg8::act_silu(bflo(z.w)), o[8 * c + 7] * rl * pg8::act_silu(bfhi(z.w)));
            op[c] = w; }
    }
}

constexpr int AT_KS = 0, AT_KPITCH = 144;
constexpr int AT_VT = 36864, AT_VPITCH = 528;
constexpr int AT_DT = AT_VT + 64 * AT_VPITCH;
constexpr int AT_ENT = AT_DT + 4096, AT_CAP = 4096;
constexpr int AT_PRE = AT_ENT + AT_CAP * 4;
constexpr int AT_OST = AT_PRE + 1024;
constexpr int AT_MISC = AT_OST + 8 * 4096;
constexpr int AT_NUNITS = NBLK * NBH;

struct QTile { unsigned ent; bf16x8 qf[4]; };
__device__ __forceinline__ void attn_load_q(QTile& T, const Ctx& C, const unsigned char* lds, int b, int h, int e0, int cnt) {
    const bf16* Q = (const bf16*)(C.ws + WS_PROJ) + (size_t)T_Q * SUBSTRIDE;
    const unsigned* ENT = (const unsigned*)(lds + AT_ENT);
    const int q = C.lane & 31, hi = C.lane >> 5;
    T.ent = ENT[(e0 + q < cnt) ? (e0 + q) : e0];
    const bf16* qrow = Q + ((size_t)(b * SEQ + (int)(T.ent & 16383u))) * 512 + h * 64 + hi * 8;
#pragma unroll
    for (int ks = 0; ks < 4; ++ks) T.qf[ks] = *(const bf16x8*)(qrow + ks * 16);
}
__device__ __forceinline__ void attn_tile(const Ctx& C, unsigned char* lds, const QTile& T, int bh, int e0, int cnt, int nkt2, const bool OWN) {
    bf16* PO = (bf16*)C.out; float* PL = (float*)(C.ws + WS_PL);
    const unsigned* ENT = (const unsigned*)(lds + AT_ENT);
    const int lane = C.lane, q = lane & 31, hi = lane >> 5;
    const unsigned ent = T.ent;
    const int pos = ent & 16383, qoff = (ent >> 16) & 1023;
    f32x16 o0 = {}, o1 = {};
    float l = 0.f;
    const bool anybias = OWN ? true : (__any(qoff < 112) != 0);
    const unsigned char* kbase = lds + AT_KS + q * AT_KPITCH + hi * 16;
    const unsigned char* vbase = lds + AT_VT + q * AT_VPITCH + hi * 16;
    const float* et0 = (const float*)(lds + AT_DT) + (256 + (OWN ? 0 : 256) + qoff - 4 * hi);
    bf16x8 kf[8];
#pragma unroll
    for (int ks = 0; ks < 4; ++ks) { kf[2 * ks] = *(const bf16x8*)(kbase + ks * 32); kf[2 * ks + 1] = *(const bf16x8*)(kbase + 32 * AT_KPITCH + ks * 32); }
    for (int kt2 = 0; kt2 < nkt2; ++kt2) {
        f32x16 p0 = {}, p1 = {};
        __builtin_amdgcn_s_setprio(1);
#pragma unroll
        for (int ks = 0; ks < 4; ++ks) {
            p0 = __builtin_amdgcn_mfma_f32_32x32x16_bf16(kf[2 * ks], T.qf[ks], p0, 0, 0, 0);
            p1 = __builtin_amdgcn_mfma_f32_32x32x16_bf16(kf[2 * ks + 1], T.qf[ks], p1, 0, 0, 0);
        }
        __builtin_amdgcn_s_setprio(0);
        bf16x8 vf[8];
#pragma unroll
        for (int s = 0; s < 4; ++s) { vf[2 * s] = *(const bf16x8*)(vbase + (64 * kt2 + 16 * s) * 2); vf[2 * s + 1] = *(const bf16x8*)(vbase + 32 * AT_VPITCH + (64 * kt2 + 16 * s) * 2); }
        if (anybias && (OWN || kt2 >= 2)) {
            const float* et = et0 - 64 * kt2 - 63;
#pragma unroll
            for (int r = 0; r < 16; ++r) { p0[r] += et[63 - ((r & 3) + 8 * (r >> 2))]; p1[r] += et[31 - ((r & 3) + 8 * (r >> 2))]; }
        }
#pragma unroll
        for (int r = 0; r < 16; ++r) { p0[r] = __builtin_amdgcn_exp2f(p0[r]); p1[r] = __builtin_amdgcn_exp2f(p1[r]); }
        float sa = 0.f, sb = 0.f;
#pragma unroll
        for (int r = 0; r < 16; ++r) { sa += p0[r]; sb += p1[r]; }
        l += sa + sb;
        v4u pa[4];
#pragma unroll
        for (int s = 0; s < 2; ++s) {
            pa[s] = (v4u){cvtpk(p0[8 * s + 0], p0[8 * s + 1]), cvtpk(p0[8 * s + 2], p0[8 * s + 3]), cvtpk(p0[8 * s + 4], p0[8 * s + 5]), cvtpk(p0[8 * s + 6], p0[8 * s + 7])};
            pa[2 + s] = (v4u){cvtpk(p1[8 * s + 0], p1[8 * s + 1]), cvtpk(p1[8 * s + 2], p1[8 * s + 3]), cvtpk(p1[8 * s + 4], p1[8 * s + 5]), cvtpk(p1[8 * s + 6], p1[8 * s + 7])};
        }
        if (kt2 + 1 < nkt2) {
#pragma unroll
            for (int ks = 0; ks < 4; ++ks) { kf[2 * ks] = *(const bf16x8*)(kbase + (64 * kt2 + 64) * AT_KPITCH + ks * 32); kf[2 * ks + 1] = *(const bf16x8*)(kbase + (64 * kt2 + 96) * AT_KPITCH + ks * 32); }
        }
        __builtin_amdgcn_s_setprio(1);
#pragma unroll
        for (int s = 0; s < 4; ++s) {
            const bf16x8 paf = __builtin_bit_cast(bf16x8, pa[s]);
            o0 = __builtin_amdgcn_mfma_f32_32x32x16_bf16(paf, vf[2 * s], o0, 0, 0, 0);
            o1 = __builtin_amdgcn_mfma_f32_32x32x16_bf16(paf, vf[2 * s + 1], o1, 0, 0, 0);
        }
        __builtin_amdgcn_s_setprio(0);
    }
    l += __shfl_xor(l, 32);
    bf16* stg = (bf16*)(lds + AT_OST + C.wave * 4096);
#pragma unroll
    for (int r = 0; r < 16; ++r) { const int orow = crow(r, hi); stg[orow * 64 + q] = (bf16)f2bf(o0[r]); stg[orow * 64 + 32 + q] = (bf16)f2bf(o1[r]); }
    LDS_WAIT(); asm volatile("" ::: "memory");
#pragma unroll
    for (int it = 0; it < 4; ++it) {
        const int row = it * 8 + (lane >> 3), ch = lane & 7;
        if (e0 + row < cnt) {
            const unsigned er = ENT[e0 + row];
            const int pr = er & 16383, jr = (er >> 14) & 3;
            *(v4u*)(PO + (((size_t)bh * SEQ + pr) * 4 + jr) * 64 + ch * 8) = *(const v4u*)(stg + row * 64 + ch * 8);
        }
    }
    if (hi == 0 && e0 + q < cnt) PL[((size_t)bh * SEQ + pos) * 4 + ((ent >> 14) & 3)] = l;
    LDS_WAIT(); asm volatile("" ::: "memory");
}

__device__ __forceinline__ void phase_attn(const Ctx& C, int layer) {
    unsigned char* lds = C.lds;
    const bf16* K = (const bf16*)(C.ws + WS_PROJ) + (size_t)T_K * SUBSTRIDE;
    const bf16* VV = (const bf16*)(C.ws + WS_PROJ) + (size_t)T_VV * SUBSTRIDE;
    const int* LOFF = (const int*)(C.ws + WS_LOFF); const unsigned short* LIST = (const unsigned short*)(C.ws + WS_LIST);
    const float* BT = (const float*)(C.ws + WS_BT);
    unsigned* ctr = (unsigned*)(C.ws + WS_CTL) + 64 + 64 * layer;
    unsigned* ENT = (unsigned*)(lds + AT_ENT);
    int* PRE = (int*)(lds + AT_PRE); int* LO = PRE + 68;
    volatile unsigned* MISC = (volatile unsigned*)(lds + AT_MISC);
    int tid = C.tid;
    v4u kpre[4], vpre[4]; int lpre0 = 0, lpre1 = 0;
#define AT_LOADKV(uu) do { const int bh_ = (uu) & 15, n_ = (uu) >> 4; \
        const bf16* Kg = K + ((size_t)((bh_ >> 3) * SEQ + n_ * 256)) * 512 + (bh_ & 7) * 64; const bf16* Vg = VV + ((size_t)((bh_ >> 3) * SEQ + n_ * 256)) * 512 + (bh_ & 7) * 64; \
        _Pragma("unroll") for (int it = 0; it < 4; ++it) { const int idx = tid + 512 * it; kpre[it] = *(const v4u*)(Kg + (size_t)(idx >> 3) * 512 + (idx & 7) * 8); \
            vpre[it] = *(const v4u*)(Vg + (size_t)(idx >> 3) * 512 + (idx & 7) * 8); } \
        lpre0 = 0; lpre1 = 0; if (tid < 64 && n_ + 1 + tid < NBLK) { const int* lp_ = LOFF + ((size_t)(bh_ * NBLK + n_ + 1 + tid)) * 80 + n_; lpre0 = lp_[0]; lpre1 = lp_[1]; } } while (0)
    if (tid == 0) MISC[0] = atomicAdd(ctr, 1u);
    __syncthreads();
    int u = (int)MISC[0];
    if (u < AT_NUNITS) AT_LOADKV(u);
    while (u < AT_NUNITS) {
        asm volatile("" : "+v"(tid));
        Ctx Cu = C; Cu.tid = tid; Cu.lane = tid & 63;
        const int bh = u & 15, n = u >> 4, b = bh >> 3, h = bh & 7;
        if (tid == 0) MISC[1] = atomicAdd(ctr, 1u);
#pragma unroll
        for (int it = 0; it < 4; ++it) { const int idx = tid + 512 * it;
            *(v4u*)(lds + AT_KS + (idx >> 3) * AT_KPITCH + (idx & 7) * 16) = kpre[it];
            const v4u v = vpre[it];
            const int kv_ = idx >> 3, kvp_ = (kv_ & ~12) | ((kv_ & 4) << 1) | ((kv_ & 8) >> 1);
            unsigned short* vt = (unsigned short*)(lds + AT_VT + (8 * (idx & 7)) * AT_VPITCH + kvp_ * 2);
            vt[0 * (AT_VPITCH / 2)] = (unsigned short)(v.x & 0xffff); vt[1 * (AT_VPITCH / 2)] = (unsigned short)(v.x >> 16);
            vt[2 * (AT_VPITCH / 2)] = (unsigned short)(v.y & 0xffff); vt[3 * (AT_VPITCH / 2)] = (unsigned short)(v.y >> 16);
            vt[4 * (AT_VPITCH / 2)] = (unsigned short)(v.z & 0xffff); vt[5 * (AT_VPITCH / 2)] = (unsigned short)(v.z >> 16);
            vt[6 * (AT_VPITCH / 2)] = (unsigned short)(v.w & 0xffff); vt[7 * (AT_VPITCH / 2)] = (unsigned short)(v.w >> 16); }
        { float* et_ = (float*)(lds + AT_DT);
#pragma unroll
          for (int k_ = 0; k_ < 2; ++k_) { const int j_ = tid + 512 * k_, d_ = j_ - 256; et_[j_] = d_ < 0 ? -INFINITY : (d_ < 128 ? BT[h * 128 + d_] - BT[h * 128 + 127] : 0.f); } }
        if (tid < 64) {
            const int lo = lpre0; int inc = lpre1 - lpre0;
#pragma unroll
            for (int o = 1; o < 64; o <<= 1) { const int t = __shfl_up(inc, o); if (tid >= o) inc += t; }
            PRE[tid + 1] = inc; LO[tid] = lo; if (tid == 0) PRE[0] = 0;
        }
        __syncthreads();
        const int total = 256 + PRE[63 - n];
        const int unext = (int)MISC[1];
        if (unext < AT_NUNITS) AT_LOADKV(unext);
        for (int base = 0; base < total; base += AT_CAP) {
            const int cnt = (total - base < AT_CAP) ? (total - base) : AT_CAP;
            if (base == 0 && tid < 256) ENT[tid] = (unsigned)(n * 256 + tid) | (3u << 14) | ((unsigned)tid << 16);
            { const int e_lo = base > 256 ? base : 256, e_hi = base + cnt;
#pragma unroll 4
              for (int e = e_lo + tid; e < e_hi; e += 512) {
                  const int es = e - 256; int a = 0, z = 63 - n;
#pragma unroll
                  for (int it = 0; it < 6; ++it) { const int mid = (a + z) >> 1; const bool up = (z - a > 1) && (PRE[mid] <= es); const bool dn = (z - a > 1) && !up; a = up ? mid : a; z = dn ? mid : z; }
                  const int ii = a, i = n + 1 + ii;
                  const unsigned val = LIST[((size_t)(bh * NBLK + i)) * 768 + LO[ii] + (es - PRE[ii])]; const unsigned ql = val & 255u, j = val >> 8;
                  ENT[e - base] = (unsigned)(i * 256 + ql) | (j << 14) | ((ii == 0 ? ql : 400u) << 16);
              } }
            __syncthreads();
            const int ntiles = (cnt + 31) >> 5;
            const int nown = (base == 0) ? 8 : 0;
            for (int tile = C.wave; tile < ntiles; tile += 8) {
                QTile Tc;
                attn_load_q(Tc, Cu, lds, b, h, tile * 32, cnt);
                { const bool own_ = tile < nown; attn_tile(Cu, lds, Tc, bh, tile * 32, cnt, own_ ? (tile >> 1) + 1 : 4, own_); }
            }
            __syncthreads();
        }
        u = unext;
    }
#undef AT_LOADKV
}

__device__ __forceinline__ void phase_combine(const Ctx& C) {
    const bf16* PO = (const bf16*)C.out; const float* PL = (const float*)(C.ws + WS_PL);
    const bf16* ZB = (const bf16*)(C.ws + WS_PROJ) + (size_t)T_ZB * SUBSTRIDE;
    bf16* MIX = (bf16*)(C.ws + WS_MIX);
    const int gt = C.bid * 512 + C.tid, NT = C.G * 512;
    constexpr int UN = 4;
    for (int idx0 = gt; idx0 < MROWS * 64; idx0 += NT * UN) {
        f32x4 lv[UN]; v4u pv[UN][4]; v4u zv[UN];
#pragma unroll
        for (int k = 0; k < UN; ++k) {
            const int idx = idx0 + k * NT;
            const int ch = idx & 7, h = (idx >> 3) & 7, row = idx >> 6, b = row >> 14, pos = row & (SEQ - 1), i = pos >> 8;
            const size_t pb = ((size_t)(b * NH + h) * SEQ + pos) * 4;
            lv[k] = *(const f32x4*)(PL + pb);
#pragma unroll
            for (int j = 0; j < 4; ++j) pv[k][j] = (j == 3 || j < i) ? *(const v4u*)(PO + (pb + j) * 64 + ch * 8) : (v4u){0u, 0u, 0u, 0u};
            zv[k] = *(const v4u*)(ZB + (size_t)row * 512 + h * 64 + ch * 8);
        }
#pragma unroll
        for (int k = 0; k < UN; ++k) {
            const int idx = idx0 + k * NT;
            const int ch = idx & 7, h = (idx >> 3) & 7, row = idx >> 6, pos = row & (SEQ - 1), i = pos >> 8;
            float L = lv[k][3];
#pragma unroll
            for (int j = 0; j < 3; ++j) L += (j < i) ? lv[k][j] : 0.f;
            float acc[8];
#pragma unroll
            for (int e = 0; e < 8; ++e) acc[e] = 0.f;
#pragma unroll
            for (int j = 0; j < 4; ++j) { const v4u v = pv[k][j];
                acc[0] += bflo(v.x); acc[1] += bfhi(v.x); acc[2] += bflo(v.y); acc[3] += bfhi(v.y); acc[4] += bflo(v.z); acc[5] += bfhi(v.z); acc[6] += bflo(v.w); acc[7] += bfhi(v.w); }
            const float rl = 1.0f / L;
            const v4u z = zv[k];
            v4u w;
            w.x = pk2(acc[0] * rl * pg8::act_silu(bflo(z.x)), acc[1] * rl * pg8::act_silu(bfhi(z.x))); w.y = pk2(acc[2] * rl * pg8::act_silu(bflo(z.y)), acc[3] * rl * pg8::act_silu(bfhi(z.y)));
            w.z = pk2(acc[4] * rl * pg8::act_silu(bflo(z.z)), acc[5] * rl * pg8::act_silu(bfhi(z.z))); w.w = pk2(acc[6] * rl * pg8::act_silu(bflo(z.w)), acc[7] * rl * pg8::act_silu(bfhi(z.w)));
            *(v4u*)(MIX + (size_t)row * 1024 + 512 + h * 64 + ch * 8) = w;
        }
    }
}

constexpr int SG_VPITCH = 272, SG_MPITCH = 144, SG_WREG = 128 * SG_MPITCH;
constexpr int SG_STATS = 8 * SG_WREG;
constexpr int SG_MR = SG_STATS + 8192;
constexpr int SG_LN = SG_MR + 1024;
__device__ __forceinline__ void phase_sgu(const Ctx& C, int layer) {
    typedef float f32x2v __attribute__((ext_vector_type(2)));
    unsigned char* lds = C.lds;
    const bf16* U = (const bf16*)(C.ws + WS_PROJ) + (size_t)T_U * SUBSTRIDE;
    const bf16* V = (const bf16*)(C.ws + WS_PROJ) + (size_t)T_V * SUBSTRIDE;
    const bf16* ZA = (const bf16*)(C.ws + WS_PROJ) + (size_t)T_ZA * SUBSTRIDE;
    bf16* MIX = (bf16*)(C.ws + WS_MIX);
    const int g = C.wave; int lane = C.lane;
    const float* lng = C.ln_g + layer * 512 + g * 64; const float* lnb = C.ln_b + layer * 512 + g * 64;
    const bf16* Wg = (const bf16*)(C.ws + WS_WST) + ((size_t)(layer * 8 + g)) * 128 * 128;
    const float* bg = C.sgu_b + (layer * 8 + g) * 128;
    unsigned char* myreg = lds + g * SG_WREG;
    f32x2v* stats = (f32x2v*)(lds + SG_STATS); f32x2v* mr = (f32x2v*)(lds + SG_MR);
    float* lnl = (float*)(lds + SG_LN + g * 512);
    lnl[lane] = lng[lane]; lnl[64 + lane] = lnb[lane];
    for (int u = C.bid; u < MROWS / 128; u += C.G) {
        const size_t row0 = (size_t)u * 128;
        asm volatile("" : "+v"(lane));
        v4u xv[2][8];
#pragma unroll
        for (int rr = 0; rr < 2; ++rr) {
            const v4u* vp = (const v4u*)(V + (row0 + lane + 64 * rr) * 512 + g * 64);
#pragma unroll
            for (int c = 0; c < 8; ++c) xv[rr][c] = vp[c];
        }
#pragma unroll
        for (int rr = 0; rr < 2; ++rr) {
            float s1 = 0.f, s2 = 0.f;
#pragma unroll
            for (int c = 0; c < 8; ++c) { v4u v = xv[rr][c];
                v.x = pk2(pg8::act_gelu(bflo(v.x)), pg8::act_gelu(bfhi(v.x))); v.y = pk2(pg8::act_gelu(bflo(v.y)), pg8::act_gelu(bfhi(v.y)));
                v.z = pk2(pg8::act_gelu(bflo(v.z)), pg8::act_gelu(bfhi(v.z))); v.w = pk2(pg8::act_gelu(bflo(v.w)), pg8::act_gelu(bfhi(v.w))); xv[rr][c] = v;
                const float f0 = bflo(v.x), f1 = bfhi(v.x), f2 = bflo(v.y), f3 = bfhi(v.y), f4 = bflo(v.z), f5 = bfhi(v.z), f6 = bflo(v.w), f7 = bfhi(v.w);
                s1 += ((f0 + f1) + (f2 + f3)) + ((f4 + f5) + (f6 + f7));
                s2 += ((f0 * f0 + f1 * f1) + (f2 * f2 + f3 * f3)) + ((f4 * f4 + f5 * f5) + (f6 * f6 + f7 * f7)); }
            stats[g * 128 + lane + 64 * rr] = (f32x2v){s1, s2};
        }
        bf16x8 wf[4][8];
        { const bf16* wa = Wg + (size_t)(lane & 31) * 128 + (lane >> 5) * 8;
#pragma unroll
          for (int tt = 0; tt < 4; ++tt)
#pragma unroll
              for (int ks = 0; ks < 8; ++ks) if (tt >= (ks >> 1)) wf[tt][ks] = *(const bf16x8*)(wa + (size_t)tt * 32 * 128 + ks * 16); }
        __syncthreads();
        if (C.tid < 128) {
            float s1 = 0.f, s2 = 0.f;
#pragma unroll
            for (int w = 0; w < 8; ++w) { const f32x2v t = stats[w * 128 + C.tid]; s1 += t.x; s2 += t.y; }
            const float mean = s1 * (1.0f / 512.0f), var = s2 * (1.0f / 512.0f) - mean * mean;
            mr[C.tid] = (f32x2v){mean, 1.0f / sqrtf(var + LN_EPS)};
        }
        __syncthreads();
#pragma unroll
        for (int c = 0; c < 8; ++c) asm volatile("" : "+v"(xv[0][c]), "+v"(xv[1][c]));
        { const f32x2v m0 = mr[lane], m1 = mr[lane + 64];
          unsigned short* vt = (unsigned short*)(myreg + lane * 2);
#pragma unroll
          for (int c = 0; c < 8; ++c) {
              const v4u v0 = xv[0][c], v1 = xv[1][c];
              const float f0[8] = {bflo(v0.x), bfhi(v0.x), bflo(v0.y), bfhi(v0.y), bflo(v0.z), bfhi(v0.z), bflo(v0.w), bfhi(v0.w)};
              const float f1[8] = {bflo(v1.x), bfhi(v1.x), bflo(v1.y), bfhi(v1.y), bflo(v1.z), bfhi(v1.z), bflo(v1.w), bfhi(v1.w)};
#pragma unroll
              for (int e = 0; e < 8; ++e) { const int d = 8 * c + e; const float gg = lnl[d], bbv = lnl[64 + d];
                  vt[d * (SG_VPITCH / 2)] = (unsigned short)f2bf((f0[e] - m0.x) * m0.y * gg + bbv);
                  vt[d * (SG_VPITCH / 2) + 64] = (unsigned short)f2bf((f1[e] - m1.x) * m1.y * gg + bbv); }
              asm volatile("" ::: "memory");
          } }
        LDS_WAIT(); asm volatile("" ::: "memory");
        { const int q = lane & 31, hi = lane >> 5;
          unsigned pk[2][4][8];
#pragma unroll
          for (int dt = 0; dt < 2; ++dt) {
              const unsigned char* bb = myreg + (32 * dt + q) * SG_VPITCH + hi * 16;
              f32x16 acc[4];
#pragma unroll
              for (int tt = 0; tt < 4; ++tt) acc[tt] = (f32x16){};
#pragma unroll
              for (int ks = 0; ks < 8; ++ks) {
                  const bf16x8 b0 = *(const bf16x8*)(bb + ks * 32);
#pragma unroll
                  for (int tt = 0; tt < 4; ++tt) if (tt >= (ks >> 1)) acc[tt] = __builtin_amdgcn_mfma_f32_32x32x16_bf16(wf[tt][ks], b0, acc[tt], 0, 0, 0);
              }
#pragma unroll
              for (int tt = 0; tt < 4; ++tt)
#pragma unroll
                  for (int rp = 0; rp < 8; ++rp) pk[dt][tt][rp] = cvtpk(acc[tt][2 * rp], acc[tt][2 * rp + 1]);
          }
          LDS_WAIT(); asm volatile("" ::: "memory");
          unsigned char* mxb = myreg + (4 * hi) * SG_MPITCH + q * 2;
#pragma unroll
          for (int dt = 0; dt < 2; ++dt)
#pragma unroll
              for (int tt = 0; tt < 4; ++tt)
#pragma unroll
                  for (int r = 0; r < 16; ++r)
                      *(unsigned short*)(mxb + (32 * tt + (r & 3) + 8 * (r >> 2)) * SG_MPITCH + 64 * dt) = (unsigned short)((r & 1) ? (pk[dt][tt][r >> 1] >> 16) : (pk[dt][tt][r >> 1] & 0xffffu));
        }
        LDS_WAIT(); asm volatile("" ::: "memory");
        { const int ch = lane & 7, r8 = lane >> 3;
#pragma unroll 4
          for (int it = 0; it < 16; ++it) {
              const int t = it * 8 + r8;
              const v4u mv = *(const v4u*)(myreg + t * SG_MPITCH + ch * 16);
              const v4u uv = *(const v4u*)(U + (row0 + t) * 512 + g * 64 + ch * 8), zv = *(const v4u*)(ZA + (row0 + t) * 512 + g * 64 + ch * 8);
              const float bt = bg[t];
              v4u o;
#define SGU_Y(uw, mw, zw) pk2(pg8::act_gelu(bflo(uw)) * (bflo(mw) + bt) * pg8::act_silu(bflo(zw)), pg8::act_gelu(bfhi(uw)) * (bfhi(mw) + bt) * pg8::act_silu(bfhi(zw)))
              o.x = SGU_Y(uv.x, mv.x, zv.x); o.y = SGU_Y(uv.y, mv.y, zv.y); o.z = SGU_Y(uv.z, mv.z, zv.z); o.w = SGU_Y(uv.w, mv.w, zv.w);
#undef SGU_Y
              *(v4u*)(MIX + (row0 + t) * 1024 + g * 64 + ch * 8) = o;
          } }
        __syncthreads();
    }
}

__device__ __forceinline__ void phase_check_inject(const Ctx& C) {
    if (C.bid == 0 && C.tid == 0) C.out[0] = __uint_as_float(((const unsigned*)(C.ws + WS_CTL))[32]) * 1e6f;
}

#define GAS __attribute__((address_space(1)))
typedef GAS unsigned gu32;
#define RLX_AGENT __ATOMIC_RELAXED, __HIP_MEMORY_SCOPE_AGENT
constexpr int CW_BAR = 4096;
constexpr int LDS_BARST = LDS_BYTES - 64;
#define XB_TMO      128
#define XB_XCNT(j)  (256  + 64 * (j))
#define XB_XSUB(j)  (1280 + 64 * (j))
#define XB_XGEN(j)  (2304 + 64 * (j))
#define XB_TOP      3328
#define XB_TOPGEN   3392
#define XCD_BAR_WORDS 3456
#define XB_SPIN_CAP (1u << 18)

__device__ __forceinline__ unsigned xb_ld(unsigned* p)              { return __hip_atomic_load(p, __ATOMIC_RELAXED, __HIP_MEMORY_SCOPE_AGENT); }
__device__ __forceinline__ unsigned xb_add(unsigned* p, unsigned v) { return __hip_atomic_fetch_add(p, v, __ATOMIC_RELAXED, __HIP_MEMORY_SCOPE_AGENT); }
__device__ __forceinline__ unsigned xb_xcc_id() { return (unsigned)__builtin_amdgcn_s_getreg((3 << 11) | 20) & 0xFu; }
#define XB_SPIN(cond, bar) do { unsigned _sp = 0; while (cond) { __builtin_amdgcn_s_sleep(1); \
    if ((++_sp & 255u) == 0u) { if (xb_ld(&(bar)[XB_TMO])) break; if (_sp > XB_SPIN_CAP) { atomicAdd(&(bar)[XB_TMO], 1u); break; } } } } while (0)

struct XcdBarrier {
    unsigned* bar; unsigned x;
    volatile LAS unsigned* st;
};

__device__ __forceinline__ XcdBarrier xcd_barrier_post(unsigned* bar, volatile LAS unsigned* st) {
    XcdBarrier b; b.bar = bar; b.x = xb_xcc_id(); b.st = st;
    if (threadIdx.x == 0) (void)xb_add(&bar[XB_XCNT(b.x)], 1u);
    return b;
}
__device__ __forceinline__ void xcd_barrier_complete(unsigned* bar, unsigned x, unsigned& nloc, unsigned& nx) {
    const unsigned G = gridDim.x * gridDim.y * gridDim.z;
    unsigned sum, cnt, mine, sp = 0u;
    for (;;) {
        sum = 0u; cnt = 0u; mine = 0u;
#pragma unroll
        for (unsigned j = 0; j < 16; ++j) { const unsigned c = xb_ld(&bar[XB_XCNT(j)]); sum += c; cnt += (c > 0u) ? 1u : 0u; mine = (j == x) ? c : mine; }
        if (sum == G) break;
        __builtin_amdgcn_s_sleep(1);
        if ((++sp & 255u) == 0u) { if (xb_ld(&bar[XB_TMO])) break; if (sp > XB_SPIN_CAP) { atomicAdd(&bar[XB_TMO], 1u); break; } }
    }
    nloc = mine > 0u ? mine : 1u; nx = cnt > 0u ? cnt : 1u;
}

__device__ __forceinline__ void xcd_barrier(const XcdBarrier& b, const bool leader_thread) {
    asm volatile("s_waitcnt vmcnt(0)" ::: "memory");
    __syncthreads();
    if (leader_thread) {
        unsigned* bar = b.bar;
        __builtin_amdgcn_s_waitcnt(0);
        unsigned nloc = b.st[0], nx = b.st[1];
        if (nloc == 0u) { xcd_barrier_complete(bar, b.x, nloc, nx); b.st[0] = nloc; b.st[1] = nx; }
        const unsigned old = xb_add(&bar[XB_XSUB(b.x)], 1u);
        const unsigned gen = old / nloc;
        if (old + 1u == (gen + 1u) * nloc) {
            __builtin_amdgcn_fence(__ATOMIC_RELEASE, "agent");
            asm volatile("s_waitcnt vmcnt(0)" ::: "memory");
            const unsigned og = xb_add(&bar[XB_TOP], 1u);
            const unsigned tg = og / nx;
            if (og + 1u == (tg + 1u) * nx) xb_add(&bar[XB_TOPGEN], 1u);
            else XB_SPIN(xb_ld(&bar[XB_TOPGEN]) == tg, bar);
            __builtin_amdgcn_fence(__ATOMIC_ACQUIRE, "agent");
            xb_add(&bar[XB_XGEN(b.x)], 1u);
            asm volatile("s_waitcnt vmcnt(0)" ::: "memory");
        } else {
            XB_SPIN(xb_ld(&bar[XB_XGEN(b.x)]) == gen, bar);
            __builtin_amdgcn_fence(__ATOMIC_ACQUIRE, "agent");
            asm volatile("s_waitcnt vmcnt(0)" ::: "memory");
        }
    }
    __syncthreads();
}

template <int ST> __device__ __forceinline__ void run_stage(const Args& args, unsigned char* lds, int Lr, int wave_s) {
    const int L = Lr;
    Ctx C;
    { int t = wave_s * 64 + lane_now(); C.tid = t; }
    C.lds = lds; C.lane = C.tid & 63; C.wave = __builtin_amdgcn_readfirstlane(C.tid >> 6); C.G = gridDim.x; C.bid = blockIdx.x;
    C.x = args.in[0]; C.norm_g = args.in[1]; C.w_in = args.in[2]; C.ln_g = args.in[3]; C.ln_b = args.in[4]; C.sgu_w = args.in[5]; C.sgu_b = args.in[6];
    C.w_out = args.in[7]; C.rel_bias = args.in[8]; C.final_g = args.in[9]; C.out = args.out; C.ws = args.ws;
    asm volatile("" : "+s"(C.ws), "+s"(C.out), "+s"(C.x), "+s"(C.sgu_b), "+s"(C.ln_g), "+s"(C.ln_b));
    if constexpr (ST == 0) phase_prologue(C);
    else if constexpr (ST == 1) {
        pg8::Gemm g{(const pg8::bf16_t*)(C.ws + WS_XB), (const pg8::bf16_t*)(C.ws + WS_WIN) + (size_t)L * DIN * DM, MROWS, DIN, DM};
        pg8::StaticOrder S; S.init(MROWS, DIN, C.G, C.bid);
        int pmA = -1, pmB = -1, pmC = -1, pmD = -1;
        { pg8::Unit uu;
          for (int i = 0; S.next(i, uu); ++i) { const int pmu = uu.pm;
              if (pmu == pmA || pmu == pmB || pmu == pmC || pmu == pmD) continue;
              if (pmA < 0) pmA = pmu; else if (pmB < 0) pmB = pmu; else if (pmC < 0) pmC = pmu; else if (pmD < 0) pmD = pmu; } }
        float* rtab = (float*)(lds + RING_BYTES);
        { const float* rowss = (const float*)(C.ws + WS_ROWSS);
#pragma unroll
          for (int k = 0; k < 2; ++k) { const int e = C.tid + 512 * k, sl = e >> 8, pmk = sl == 0 ? pmA : sl == 1 ? pmB : sl == 2 ? pmC : pmD;
              if (pmk >= 0) { const f32x4* rp = (const f32x4*)(rowss + ((size_t)pmk * 256 + (e & 255)) * 16); const f32x4 s0 = rp[0], s1 = rp[1], s2 = rp[2], s3 = rp[3];
                  const float ss = ((s0[0] + s0[1]) + (s0[2] + s0[3])) + ((s1[0] + s1[1]) + (s1[2] + s1[3])) + ((s2[0] + s2[1]) + (s2[2] + s2[3])) + ((s3[0] + s3[1]) + (s3[2] + s3[3]));
                  rtab[e] = 1.0f / sqrtf(ss * (1.0f / 1024.0f) + NORM_EPS); } }
          __syncthreads(); }
        pg8::EpiProj E{(pg8::bf16_t*)(C.ws + WS_PROJ), SUBSTRIDE, rtab, pmA, pmB, pmC, pmD, (float*)(C.ws + WS_KMEAN) + (size_t)L * NBH * NBLK * 64};
        pg8::gemm_phase<pg8::EpiProj, pg8::StaticOrder, true, true>((PG8_LAS unsigned char*)lds, g, S, E, C.tid);
    }
    else if constexpr (ST == 3) { phase_gate(C, L); phase_sgu(C, L); }
    else if constexpr (ST == 4) phase_attn(C, L);
    else if constexpr (ST == 5) phase_combine(C);
    else if constexpr (ST == 6) {
        pg8::Gemm g{(const pg8::bf16_t*)(C.ws + WS_MIX), (const pg8::bf16_t*)(C.ws + WS_WOUT) + (size_t)L * DM * DM, MROWS, DM, DM};
        pg8::StaticOrder S; S.init(MROWS, DM, C.G, C.bid);
        if (L == 0) { pg8::EpiRes E{(pg8::bf16_t*)(C.ws + WS_XB), (float*)(C.ws + WS_ROWSS)};
            pg8::gemm_phase<pg8::EpiRes, pg8::StaticOrder, true, true>((PG8_LAS unsigned char*)lds, g, S, E, C.tid); }
        else { pg8::EpiFinal E{(const pg8::bf16_t*)(C.ws + WS_XB), C.out, C.final_g, (float*)(C.ws + WS_ROWSS), (unsigned*)(C.ws + WS_CTL) + 8192};
            pg8::gemm_phase<pg8::EpiFinal, pg8::StaticOrder, true, true>((PG8_LAS unsigned char*)lds, g, S, E, C.tid); }
    } else if constexpr (ST == 7) phase_check_inject(C);
    else if constexpr (ST == 8) phase_attn_simple(C, (bf16*)(C.ws + 104 * MiB));
    else if constexpr (ST == 9) {
        const bf16* A = (const bf16*)(C.ws + WS_MIX); const bf16* B = (const bf16*)(C.ws + 104 * MiB); unsigned* flag = (unsigned*)(C.ws + WS_CTL) + 32;
        float md = 0.f;
        for (size_t idx = (size_t)C.bid * 512 + C.tid; idx < (size_t)MROWS * 512; idx += (size_t)C.G * 512) {
            const size_t row = idx >> 9, col = 512 + (idx & 511);
            const float a = __uint_as_float((unsigned)A[row * 1024 + col] << 16), r = __uint_as_float((unsigned)B[row * 1024 + col] << 16);
            float sc = fabsf(r);
#pragma unroll
            for (int o = 1; o < 64; o <<= 1) sc = fmaxf(sc, __shfl_xor(sc, o));
            const float d = fabsf(a - r) / (0.02f + sc);
            md = (d > md || !(d == d)) ? (d == d ? d : 1e6f) : md;
        }
        atomicMax(flag, __float_as_uint(md));
    }
}
template <int SEL> __global__ void __launch_bounds__(NWAVES * 64, 2) fwd(Args args) {
    extern __shared__ __attribute__((aligned(16))) unsigned char lds[];
    const int wave_s = __builtin_amdgcn_readfirstlane((int)threadIdx.x >> 6);
    if constexpr (SEL >= 0) run_stage<SEL>(args, lds, args.layer, wave_s);
    else {
        if (args.pad == 0x7fffffff) cg::this_grid().sync();
        volatile LAS unsigned* bst = (volatile LAS unsigned*)((LAS unsigned char*)lds + LDS_BARST);
        if (threadIdx.x == 0) { bst[0] = 0u; bst[1] = 0u; }
        __syncthreads();
        XcdBarrier bar = xcd_barrier_post((unsigned*)(args.ws + WS_CTL) + CW_BAR, bst);
#define GRID_SYNC() do { XcdBarrier b2_ = bar; asm volatile("" : "+s"(b2_.bar), "+s"(b2_.x)); xcd_barrier(b2_, wave_s == 0 && lane_now() == 0); } while (0)
#define RUN(k, L) do { run_stage<k>(args, lds, L, wave_s); GRID_SYNC(); } while (0)
        RUN(0, 0);
        for (int L = 0; L < DEPTH; ++L) {
            RUN(1, L); RUN(3, L); RUN(4, L); RUN(5, L);
            if (L == DEPTH - 1) run_stage<6>(args, lds, L, wave_s); else RUN(6, L);
        }
    }
}

#ifndef MK_N_LAUNCHES
#define MK_N_LAUNCHES 1
#endif
template <int SEL> static void launch_stage(int grid, Args a, int layer, hipStream_t stream) {
    static bool attr = false;
    if (!attr) { (void)hipFuncSetAttribute((const void*)fwd<SEL>, hipFuncAttributeMaxDynamicSharedMemorySize, LDS_BYTES); attr = true; }
    a.layer = layer;
    hipLaunchKernelGGL(fwd<SEL>, dim3(grid), dim3(NWAVES * 64), LDS_BYTES, stream, a);
}
extern "C" void kernel_launch(void* const* d_in, const int* in_sizes, int n_in, void* d_out, int out_size, void* d_ws, size_t ws_size, hipStream_t stream) {
    static int grid = 0;
    if (grid == 0) {
        if (n_in != 10 || out_size != MROWS * DM || ws_size < WS_END) { fprintf(stderr, "kernel_launch: unexpected shapes (n_in %d out %d ws %zu)\n", n_in, out_size, ws_size); grid = -1; return; }
        int dev = 0, cus = 0;
        (void)hipGetDevice(&dev); (void)hipDeviceGetAttribute(&cus, hipDeviceAttributeMultiprocessorCount, dev);
        grid = cus;
#if MK_N_LAUNCHES == 1
        int per_cu = 0;
        if (hipFuncSetAttribute((const void*)fwd<-1>, hipFuncAttributeMaxDynamicSharedMemorySize, LDS_BYTES) != hipSuccess) { fprintf(stderr, "kernel_launch: hipFuncSetAttribute failed\n"); grid = -1; return; }
        if (hipOccupancyMaxActiveBlocksPerMultiprocessor(&per_cu, (const void*)fwd<-1>, NWAVES * 64, LDS_BYTES) != hipSuccess || per_cu < 1) { fprintf(stderr, "kernel_launch: occupancy query says %d\n", per_cu); grid = -1; return; }
        (void)hipGetLastError();
#endif
    }
    if (grid < 0) return;
    (void)hipMemsetAsync((char*)d_ws + WS_CTL, 0, CTL_ZERO_BYTES, stream);
    Args a{};
    for (int i = 0; i < 10; ++i) a.in[i] = (const float*)d_in[i];
    a.out = (float*)d_out; a.ws = (unsigned char*)d_ws;
#if MK_N_LAUNCHES == 1
    void* kargs[] = {&a};
    hipError_t e = hipLaunchCooperativeKernel((const void*)fwd<-1>, dim3(grid), dim3(NWAVES * 64), kargs, LDS_BYTES, stream);
    if (e != hipSuccess) fprintf(stderr, "kernel_launch: cooperative launch failed: %s\n", hipGetErrorString(e));
#else
    launch_stage<0>(grid, a, 0, stream);
    for (int L = 0; L < DEPTH; ++L) {
        launch_stage<1>(grid, a, L, stream); launch_stage<3>(grid, a, L, stream);
        launch_stage<4>(grid, a, L, stream); launch_stage<5>(grid, a, L, stream);
        if (CHECK_ATTN && L == 0) { launch_stage<8>(grid, a, L, stream); launch_stage<9>(grid, a, L, stream); }
        launch_stage<6>(grid, a, L, stream);
    }
    if (CHECK_ATTN) launch_stage<7>(grid, a, 0, stream);
#endif
}
```

```cpp
#include <hip/hip_runtime.h>
#include <hip/hip_cooperative_groups.h>
#include <cstdio>
#include <cstdint>
namespace cg = cooperative_groups;

constexpr int BATCH = 2, SEQ = 16384, DM = 1024, MROWS = BATCH * SEQ, DIN = 3584, DSUB = 512;
constexpr int NH = 8, DH = 64, NBLK = SEQ / 256, NBH = BATCH * NH, DEPTH = 2;
constexpr float NORM_EPS = 1e-6f, LN_EPS = 1e-5f;
constexpr float LOG2E = 1.4426950408889634f;
#ifndef CHECK_ATTN
#define CHECK_ATTN 0
#endif
constexpr float QSCALE = 0.125f * LOG2E;
namespace pg8 {
#define PG8_LAS __attribute__((address_space(3)))
typedef unsigned short bf16_t;
typedef short bf16x8 __attribute__((ext_vector_type(8)));
typedef float f32x4 __attribute__((ext_vector_type(4)));
typedef unsigned u32x4 __attribute__((ext_vector_type(4)));
constexpr int BM = 256, BK = 64, HALF = 128, HTB = HALF * BK * 2  , STAGE_BYTES = 8 * HTB, NXCD = 8, WGM = 8;

__host__ __device__ __forceinline__ int lds_byte(int r, int c) { const int st = (r >> 4) * 2 + (c >> 5), rr = r & 15, cc = c & 31, ob = rr * 64 + cc * 2; return st * 1024 + (ob ^ (((ob >> 9) & 1) << 5)); }
__host__ __device__ __forceinline__ void stage_rc(int b, int& R, int& C) { const int st = b / 1024, sb = b % 1024, swz = sb ^ (((sb >> 9) & 1) << 5); R = (st >> 1) * 16 + swz / 64; C = (st & 1) * 32 + (swz % 64) / 2; }
__host__ __device__ __forceinline__ int perm32(int rho) { const int n = rho >> 4, i = rho & 15; return 8 * (i >> 2) + 4 * n + (i & 3); }

struct Unit { int pm, pn; };
struct Gemm { const bf16_t* A; const bf16_t* Bt; int M, N, K; };

struct StaticOrder {
    int nM, nN, nwg, G, c;
    __host__ __device__ void init(int M, int N, int G_, int c_) { nM = M / BM; nN = N / BM; nwg = nM * nN; G = G_; c = c_; }
    __host__ __device__ bool next(int i, Unit& u) const {
        const long L = (long)i * G + c; if (L >= nwg) return false;
        int wgid = (int)L; { const int q = nwg / NXCD, r = nwg % NXCD, xcd = wgid % NXCD, off = wgid / NXCD; wgid = (xcd < r ? xcd * (q + 1) : r * (q + 1) + (xcd - r) * q) + off; }
        const int nig = WGM * nN, gid = wgid / nig, fm = gid * WGM, gsz = (nM - fm) < WGM ? (nM - fm) : WGM;
        u.pm = fm + ((wgid % nig) % gsz); u.pn = (wgid % nig) / gsz; return true;
    }
    __device__ __forceinline__ void a_ready(const Unit&) const {}
    __device__ __forceinline__ void done(const Unit&) const {}
};

__device__ __forceinline__ unsigned cvt_pk_bf16(float lo, float hi) { unsigned r; asm volatile("v_cvt_pk_bf16_f32 %0, %1, %2" : "=v"(r) : "v"(lo), "v"(hi)); return r; }
typedef float f32x2 __attribute__((ext_vector_type(2)));
typedef float f32x2 __attribute__((ext_vector_type(2)));
__device__ __forceinline__ float act_gelu(float x) {
    const float u = x * (1.0f + 0.044715f * x * x);
    const float e = __builtin_amdgcn_exp2f(u * (-2.0f * 0.7978845608028654f * 1.4426950408889634f));
    return x * __builtin_amdgcn_rcpf(1.0f + e);
}
__device__ __forceinline__ float act_silu(float x) {
    const float e = __builtin_amdgcn_exp2f(x * (-1.4426950408889634f));
    return x * __builtin_amdgcn_rcpf(1.0f + e);
}
struct EpiProj {
    static constexpr bool PERM = true, AFTER_DRAIN = false;
    bf16_t* P; size_t sub_stride; const float* rstd_lds; int pm0, pm1, pm2, pm3; float* kmean;
    __device__ __forceinline__ void operator()(const f32x4 (&acc)[2][2][4][2], const Unit& u, int wr, int wc, int fr, int fq) const {
        const int t = u.pn >> 1;
        bf16_t* base = P + (size_t)t * sub_stride;
        const int col0 = (u.pn & 1) * 256 + wc * 32 + 8 * fq;
        const int row0 = u.pm * BM + wr * 64 + fr;
        const int slot = (u.pm == pm0) ? 0 : (u.pm == pm1) ? 1 : (u.pm == pm2) ? 2 : 3;
        const float* rt = rstd_lds + slot * 256 + wr * 64 + fr;
        const float qs = (t == 3) ? (0.125f * 1.4426950408889634f) : 1.0f;
        float ks[2][8];
#pragma unroll
        for (int bj = 0; bj < 2; ++bj)
#pragma unroll
            for (int e = 0; e < 8; ++e) ks[bj][e] = 0.f;
#pragma unroll
        for (int ai = 0; ai < 2; ++ai)
#pragma unroll
            for (int m = 0; m < 4; ++m) {
                const int row = row0 + ai * HALF + m * 16;
                const float rs = rt[ai * HALF + m * 16] * qs;
                bf16_t* rowp = base + (size_t)row * 512 + col0;
#pragma unroll
                for (int bj = 0; bj < 2; ++bj) {
                    const f32x4 v0 = acc[ai][bj][m][0] * rs, v1 = acc[ai][bj][m][1] * rs;
                    if (t == 4) {
#pragma unroll
                        for (int e = 0; e < 4; ++e) { ks[bj][e] += v0[e]; ks[bj][4 + e] += v1[e]; }
                    }
                    u32x4 w; w.x = cvt_pk_bf16(v0[0], v0[1]); w.y = cvt_pk_bf16(v0[2], v0[3]); w.z = cvt_pk_bf16(v1[0], v1[1]); w.w = cvt_pk_bf16(v1[2], v1[3]);
                    *(u32x4*)(rowp + bj * HALF) = w;
                }
            }
        if (t == 4) {
            const int b = u.pm >> 6, n = u.pm & 63;
#pragma unroll
            for (int bj = 0; bj < 2; ++bj)
#pragma unroll
                for (int e = 0; e < 8; ++e) {
                    float v = ks[bj][e];
                    v += __shfl_xor(v, 1); v += __shfl_xor(v, 2); v += __shfl_xor(v, 4); v += __shfl_xor(v, 8);
                    if (fr == 0) { const int col = col0 + bj * HALF + e; atomicAdd(kmean + ((size_t)((b * 8 + (col >> 6)) * 64 + n)) * 64 + (col & 63), v * (1.0f / 256.0f)); }
                }
        }
    }
};
#define PG8_GAS __attribute__((address_space(1)))
struct EpiRes {
    static constexpr bool PERM = false, AFTER_DRAIN = false;
    bf16_t* xb; float* rowss;
    __device__ __forceinline__ void operator()(const f32x4 (&acc)[2][2][4][2], const Unit& u, int wr, int wc, int fr, int fq) const {
        typedef unsigned u32x2v __attribute__((ext_vector_type(2)));
        const int col0 = u.pn * BM + wc * 32 + 4 * fq;
        PG8_GAS bf16_t* xbg = (PG8_GAS bf16_t*)xb; PG8_GAS float* rsg = (PG8_GAS float*)rowss;
        const size_t offb = (size_t)(u.pm * BM + wr * 64 + fr) * 1024 + col0;
        u32x2v rr[2][4][2][2];
#pragma unroll
        for (int ai = 0; ai < 2; ++ai)
#pragma unroll
            for (int m = 0; m < 4; ++m)
#pragma unroll
                for (int bj = 0; bj < 2; ++bj)
#pragma unroll
                    for (int n = 0; n < 2; ++n) rr[ai][m][bj][n] = *(const PG8_GAS u32x2v*)(xbg + offb + (size_t)(ai * HALF + m * 16) * 1024 + bj * HALF + n * 16);
#pragma unroll
        for (int ai = 0; ai < 2; ++ai)
#pragma unroll
            for (int m = 0; m < 4; ++m) {
                const int row = u.pm * BM + ai * HALF + wr * 64 + m * 16 + fr;
                float ss = 0.f;
#pragma unroll
                for (int bj = 0; bj < 2; ++bj)
#pragma unroll
                    for (int n = 0; n < 2; ++n) {
                        const u32x2v w0 = rr[ai][m][bj][n];
                        const f32x4 r = (f32x4){__uint_as_float(w0.x << 16), __uint_as_float(w0.x & 0xffff0000u), __uint_as_float(w0.y << 16), __uint_as_float(w0.y & 0xffff0000u)};
                        const f32x4 o = r + acc[ai][bj][m][n];
                        ss += (o[0] * o[0] + o[1] * o[1]) + (o[2] * o[2] + o[3] * o[3]);
                        u32x2v w; w.x = cvt_pk_bf16(o[0], o[1]); w.y = cvt_pk_bf16(o[2], o[3]);
                        *(PG8_GAS u32x2v*)(xbg + offb + (size_t)(ai * HALF + m * 16) * 1024 + bj * HALF + n * 16) = w;
                    }
                ss += __shfl_xor(ss, 16); ss += __shfl_xor(ss, 32);
                if (fq == 0) rsg[(size_t)row * 16 + u.pn * 4 + wc] = ss;
            }
    }
};
struct EpiFinal {
    static constexpr bool PERM = false, AFTER_DRAIN = false;
    const bf16_t* xb; float* out; const float* fg; float* slots; unsigned* cnt;
    __device__ __forceinline__ void operator()(f32x4 (&acc)[2][2][4][2], const Unit& u, int wr, int wc, int fr, int fq) const {
        typedef unsigned u32x2v __attribute__((ext_vector_type(2)));
        const int col0 = u.pn * BM + wc * 32 + 4 * fq;
        const PG8_GAS bf16_t* xbg = (const PG8_GAS bf16_t*)xb; PG8_GAS float* outg = (PG8_GAS float*)out; const PG8_GAS float* slg = (const PG8_GAS float*)slots;
        const size_t offb = (size_t)(u.pm * BM + wr * 64 + fr) * 1024 + col0;
        u32x2v rr[2][4][2][2];
#pragma unroll
        for (int ai = 0; ai < 2; ++ai)
#pragma unroll
            for (int m = 0; m < 4; ++m)
#pragma unroll
                for (int bj = 0; bj < 2; ++bj)
#pragma unroll
                    for (int n = 0; n < 2; ++n) rr[ai][m][bj][n] = *(const PG8_GAS u32x2v*)(xbg + offb + (size_t)(ai * HALF + m * 16) * 1024 + bj * HALF + n * 16);
#pragma unroll
        for (int ai = 0; ai < 2; ++ai)
#pragma unroll
            for (int m = 0; m < 4; ++m) {
                const int row = u.pm * BM + ai * HALF + wr * 64 + m * 16 + fr;
                float ss = 0.f;
#pragma unroll
                for (int bj = 0; bj < 2; ++bj)
#pragma unroll
                    for (int n = 0; n < 2; ++n) {
                        const u32x2v w = rr[ai][m][bj][n];
                        const f32x4 r = (f32x4){__uint_as_float(w.x << 16), __uint_as_float(w.x & 0xffff0000u), __uint_as_float(w.y << 16), __uint_as_float(w.y & 0xffff0000u)};
                        const f32x4 o = r + acc[ai][bj][m][n];
                        acc[ai][bj][m][n] = o;
                        ss += (o[0] * o[0] + o[1] * o[1]) + (o[2] * o[2] + o[3] * o[3]);
                    }
                ss += __shfl_xor(ss, 16); ss += __shfl_xor(ss, 32);
                if (fq == 0) __hip_atomic_store(slots + (size_t)row * 16 + u.pn * 4 + wc, ss, __ATOMIC_RELAXED, __HIP_MEMORY_SCOPE_AGENT);
            }
        asm volatile("s_waitcnt vmcnt(0)" ::: "memory");
        unsigned* pc = cnt + 64 * u.pm;
        if (fr == 0 && fq == 0) __hip_atomic_fetch_add(pc, 1u, __ATOMIC_RELAXED, __HIP_MEMORY_SCOPE_AGENT);
        f32x4 g4[2][2];
#pragma unroll
        for (int bj = 0; bj < 2; ++bj)
#pragma unroll
            for (int n = 0; n < 2; ++n) g4[bj][n] = *(const PG8_GAS f32x4*)((const PG8_GAS float*)fg + col0 + bj * HALF + n * 16);
        for (unsigned spins = 0; spins < (1u << 22); ++spins) {
            if (__hip_atomic_load(pc, __ATOMIC_RELAXED, __HIP_MEMORY_SCOPE_AGENT) >= 32u) break;
            __builtin_amdgcn_s_sleep(2);
        }
        __builtin_amdgcn_fence(__ATOMIC_ACQUIRE, "agent");
        asm volatile("s_waitcnt vmcnt(0)" ::: "memory");
#pragma unroll
        for (int ai = 0; ai < 2; ++ai) {
            f32x4 sl[4][4];
#pragma unroll
            for (int m = 0; m < 4; ++m)
#pragma unroll
                for (int k = 0; k < 4; ++k) sl[m][k] = *(const PG8_GAS f32x4*)(slg + (size_t)(u.pm * BM + ai * HALF + wr * 64 + m * 16 + fr) * 16 + k * 4);
#pragma unroll
            for (int m = 0; m < 4; ++m) {
                const f32x4 s0 = sl[m][0], s1 = sl[m][1], s2 = sl[m][2], s3 = sl[m][3];
                const float tot = ((s0[0] + s0[1]) + (s0[2] + s0[3])) + ((s1[0] + s1[1]) + (s1[2] + s1[3])) + ((s2[0] + s2[1]) + (s2[2] + s2[3])) + ((s3[0] + s3[1]) + (s3[2] + s3[3]));
                const float rs = 1.0f / sqrtf(tot * (1.0f / 1024.0f) + 1e-6f);
#pragma unroll
                for (int bj = 0; bj < 2; ++bj)
#pragma unroll
                    for (int n = 0; n < 2; ++n) *(PG8_GAS f32x4*)(outg + offb + (size_t)(ai * HALF + m * 16) * 1024 + bj * HALF + n * 16) = acc[ai][bj][m][n] * rs * g4[bj][n];
            }
        }
    }
};
template <class Epi, class Sched, bool ALIGN_EPI = false, bool SP2 = false>
__device__ __forceinline__ void gemm_phase(PG8_LAS unsigned char* lds, const Gemm g, const Sched& S, const Epi& E, const int tid) {
    const int wid = __builtin_amdgcn_readfirstlane(tid >> 6), lane = tid & 63, wr = wid >> 2, wc = wid & 3, fr = lane & 15, fq = lane >> 4;
    const int K = g.K, nt = K / BK;
    unsigned voffA[2], voffB[2];
#pragma unroll
    for (int i = 0; i < 2; ++i) { int R, C; stage_rc(tid * 16 + i * 8192, R, C); const int Rb = Epi::PERM ? ((R & ~31) + perm32(R & 31)) : R;
        voffA[i] = (unsigned)(R * K + C) * 2u; voffB[i] = (unsigned)(Rb * K + C) * 2u; }
    const size_t kstep = (size_t)(BK * 2);
    const size_t hstep = (size_t)HALF * K * 2;
    const size_t tstep = 2 * hstep;
    const unsigned ldsw = (unsigned)wid * 1024u;
    const int aoff = lds_byte(wr * 64 + fr, fq * 8), boff = lds_byte(wc * 32 + fr, fq * 8);
#define PG8_SA(b, h) (((b) * 2 + (h)) * HTB)
#define PG8_SB(b, h) ((4 + (b) * 2 + (h)) * HTB)
#define PG8_STAGE(bufoff, gbase, voff) do { _Pragma("unroll") for (int _i = 0; _i < 2; ++_i) \
        __builtin_amdgcn_global_load_lds((const unsigned*)((const char*)(gbase) + (voff)[_i]), (PG8_LAS unsigned*)(lds + (bufoff) + ldsw + _i * 8192), 16, 0, 0); } while (0)
#define PG8_LDA(dst, b, h) do { _Pragma("unroll") for (int m = 0; m < 4; ++m) _Pragma("unroll") for (int k = 0; k < 2; ++k) dst[m][k] = *(const PG8_LAS bf16x8*)(lds + PG8_SA(b, h) + aoff + m * 2048 + k * 1024); } while (0)
#define PG8_LDB(dst, b, h) do { _Pragma("unroll") for (int n = 0; n < 2; ++n) _Pragma("unroll") for (int k = 0; k < 2; ++k) dst[n][k] = *(const PG8_LAS bf16x8*)(lds + PG8_SB(b, h) + boff + n * 2048 + k * 1024); } while (0)
#define PG8_MMA(ai, bj, At, Bt) do { __builtin_amdgcn_s_setprio(1); _Pragma("unroll") for (int m = 0; m < 4; ++m) _Pragma("unroll") for (int n = 0; n < 2; ++n) _Pragma("unroll") for (int k = 0; k < 2; ++k) \
        acc[ai][bj][m][n] = __builtin_amdgcn_mfma_f32_16x16x32_bf16(Bt[n][k], At[m][k], acc[ai][bj][m][n], 0, 0, 0); __builtin_amdgcn_s_setprio(0); } while (0)
#define PG8_WAIT_V(n) asm volatile("s_waitcnt vmcnt(" #n ")" ::: "memory")
#define PG8_WAIT_L(n) asm volatile("s_waitcnt lgkmcnt(" #n ")" ::: "memory")
#define PG8_BAR __builtin_amdgcn_s_barrier()
#define PG8_SCHED __builtin_amdgcn_sched_barrier(0)
    Unit cur, nxt; int ui = 0;
    if (!S.next(0, cur)) return;
    f32x4 acc[2][2][4][2];
#pragma unroll
    for (int a = 0; a < 2; ++a)
#pragma unroll
        for (int b = 0; b < 2; ++b)
#pragma unroll
            for (int m = 0; m < 4; ++m)
#pragma unroll
                for (int n = 0; n < 2; ++n) acc[a][b][m][n] = (f32x4){0.f, 0.f, 0.f, 0.f};
    bf16x8 At[4][2], B0[2][2], B1[2][2];
    const char* cA = (const char*)g.A + (size_t)cur.pm * tstep; const char* cB = (const char*)g.Bt + (size_t)cur.pn * tstep;
    S.a_ready(cur);
    if constexpr (SP2) {
        PG8_STAGE(PG8_SB(0, 0), cB, voffB); PG8_STAGE(PG8_SB(0, 1), cB + hstep, voffB); PG8_STAGE(PG8_SA(0, 0), cA, voffA); PG8_STAGE(PG8_SA(0, 1), cA + hstep, voffA);
        if (wr == 1) PG8_BAR;
        PG8_WAIT_V(2); PG8_BAR;
        PG8_STAGE(PG8_SB(1, 0), cB + kstep, voffB); PG8_STAGE(PG8_SA(1, 0), cA + kstep, voffA); PG8_STAGE(PG8_SB(1, 1), cB + hstep + kstep, voffB);
        PG8_WAIT_V(6); PG8_BAR;
    } else {
        PG8_STAGE(PG8_SB(0, 0), cB, voffB); PG8_STAGE(PG8_SA(0, 0), cA, voffA); PG8_STAGE(PG8_SB(0, 1), cB + hstep, voffB); PG8_STAGE(PG8_SA(0, 1), cA + hstep, voffA);
        if (wr == 1) PG8_BAR;
        PG8_WAIT_V(4); PG8_BAR;
        PG8_STAGE(PG8_SB(1, 0), cB + kstep, voffB); PG8_STAGE(PG8_SA(1, 0), cA + kstep, voffA); PG8_STAGE(PG8_SB(1, 1), cB + hstep + kstep, voffB);
        PG8_WAIT_V(6); PG8_BAR;
    }
    for (;;) {
        const bool has_next = S.next(ui + 1, nxt);
        const char* nA = has_next ? (const char*)g.A + (size_t)nxt.pm * tstep : cA; const char* nB = has_next ? (const char*)g.Bt + (size_t)nxt.pn * tstep : cB;
        for (int t = 0; t < nt; t += 2) {
            const bool last = (t == nt - 2);
            const char* a1 = cA + (size_t)(t + 1) * kstep;
            const char* a2 = last ? nA : cA + (size_t)(t + 2) * kstep; const char* b2 = last ? nB : cB + (size_t)(t + 2) * kstep;
            const char* a3 = a2 + kstep; const char* b3 = b2 + kstep;
            if (last && has_next) S.a_ready(nxt);
            if constexpr (SP2) {
            PG8_LDB(B0, 0, 0); PG8_LDB(B1, 0, 1); PG8_SCHED; PG8_LDA(At, 0, 0); PG8_STAGE(PG8_SA(1, 1), a1 + hstep, voffA);
            PG8_WAIT_V(8); PG8_WAIT_L(0); PG8_BAR; PG8_MMA(0, 0, At, B0); PG8_MMA(0, 1, At, B1); PG8_BAR; PG8_SCHED;
            PG8_LDA(At, 0, 1); PG8_STAGE(PG8_SB(0, 0), b2, voffB); PG8_STAGE(PG8_SB(0, 1), b2 + hstep, voffB); PG8_STAGE(PG8_SA(0, 0), a2, voffA);
            PG8_WAIT_V(8); PG8_WAIT_L(0); PG8_BAR; PG8_MMA(1, 0, At, B0); PG8_MMA(1, 1, At, B1); PG8_BAR; PG8_SCHED;
            PG8_LDB(B0, 1, 0); PG8_LDB(B1, 1, 1); PG8_SCHED; PG8_LDA(At, 1, 0); PG8_STAGE(PG8_SA(0, 1), a2 + hstep, voffA);
            PG8_WAIT_V(8); PG8_WAIT_L(0); PG8_BAR; PG8_MMA(0, 0, At, B0); PG8_MMA(0, 1, At, B1); PG8_BAR; PG8_SCHED;
            PG8_LDA(At, 1, 1); PG8_STAGE(PG8_SB(1, 0), b3, voffB); PG8_STAGE(PG8_SB(1, 1), b3 + hstep, voffB); PG8_STAGE(PG8_SA(1, 0), a3, voffA);
            PG8_WAIT_V(8); PG8_WAIT_L(0); PG8_BAR; PG8_MMA(1, 0, At, B0); PG8_MMA(1, 1, At, B1); PG8_BAR; PG8_SCHED;
            } else {
            PG8_LDB(B0, 0, 0); PG8_SCHED; PG8_LDA(At, 0, 0); PG8_STAGE(PG8_SA(1, 1), a1 + hstep, voffA);
            PG8_WAIT_L(8); PG8_BAR; PG8_WAIT_L(0); PG8_MMA(0, 0, At, B0); PG8_BAR; PG8_SCHED;
            PG8_LDB(B1, 0, 1); PG8_STAGE(PG8_SB(0, 0), b2, voffB);
            PG8_BAR; PG8_WAIT_L(0); PG8_MMA(0, 1, At, B1); PG8_BAR;
            PG8_LDA(At, 0, 1); PG8_STAGE(PG8_SA(0, 0), a2, voffA);
            PG8_BAR; PG8_WAIT_L(0); PG8_MMA(1, 0, At, B0); PG8_BAR; PG8_SCHED;
            PG8_STAGE(PG8_SB(0, 1), b2 + hstep, voffB);
            PG8_WAIT_V(6); PG8_BAR; PG8_MMA(1, 1, At, B1); PG8_BAR;
            PG8_LDB(B0, 1, 0); PG8_SCHED; PG8_LDA(At, 1, 0); PG8_STAGE(PG8_SA(0, 1), a2 + hstep, voffA);
            PG8_WAIT_L(8); PG8_BAR; PG8_WAIT_L(0); PG8_MMA(0, 0, At, B0); PG8_BAR; PG8_SCHED;
            PG8_LDB(B1, 1, 1); PG8_STAGE(PG8_SB(1, 0), b3, voffB);
            PG8_BAR; PG8_WAIT_L(0); PG8_MMA(0, 1, At, B1); PG8_BAR;
            PG8_LDA(At, 1, 1); PG8_STAGE(PG8_SA(1, 0), a3, voffA);
            PG8_BAR; PG8_WAIT_L(0); PG8_MMA(1, 0, At, B0); PG8_BAR; PG8_SCHED;
            PG8_STAGE(PG8_SB(1, 1), b3 + hstep, voffB);
            PG8_WAIT_V(6); PG8_BAR; PG8_MMA(1, 1, At, B1); PG8_BAR;
            }
        }
        if constexpr (ALIGN_EPI) { if (wr == 0) PG8_BAR; }
        if constexpr (!Epi::AFTER_DRAIN) { int ln_; asm volatile("v_mbcnt_lo_u32_b32 %0, -1, 0\n\tv_mbcnt_hi_u32_b32 %0, -1, %0" : "=v"(ln_)); E(acc, cur, wr, wc, ln_ & 15, ln_ >> 4); S.done(cur); }
        if (!has_next) break;
#pragma unroll
        for (int a = 0; a < 2; ++a)
#pragma unroll
            for (int b = 0; b < 2; ++b)
#pragma unroll
                for (int m = 0; m < 4; ++m)
#pragma unroll
                    for (int n = 0; n < 2; ++n) acc[a][b][m][n] = (f32x4){0.f, 0.f, 0.f, 0.f};
        cur = nxt; cA = nA; cB = nB; ++ui;
        if constexpr (ALIGN_EPI) { if (wr == 1) PG8_BAR; }
    }
    PG8_WAIT_V(0);
    if constexpr (!ALIGN_EPI) { if (wr == 0) PG8_BAR; }
    PG8_BAR;
    if constexpr (Epi::AFTER_DRAIN) { E.fused(acc, cur, wr, wc, fr, fq, lds, wid, lane); S.done(cur); }
#undef PG8_SA
#undef PG8_SB
#undef PG8_STAGE
#undef PG8_LDA
#undef PG8_LDB
#undef PG8_MMA
#undef PG8_WAIT_V
#undef PG8_WAIT_L
#undef PG8_BAR
#undef PG8_SCHED
}
}

constexpr size_t MiB = 1u << 20;
constexpr size_t WS_CTL = 0, CTL_ZERO_BYTES = 1 * MiB;
constexpr size_t WS_WIN = 2 * MiB;
constexpr size_t WS_WOUT = 16 * MiB;
constexpr size_t WS_WST = 20 * MiB;
constexpr size_t WS_BT = 21 * MiB;
constexpr size_t WS_KMEAN = 22 * MiB;
constexpr size_t WS_LOFF = 23 * MiB;
constexpr size_t WS_ROWSS = 24 * MiB;
constexpr size_t WS_PL = 26 * MiB;
constexpr size_t WS_LIST = 30 * MiB;
constexpr size_t WS_SEL = 32 * MiB;
constexpr size_t WS_XB = 40 * MiB;
constexpr size_t WS_PROJ = 168 * MiB;
constexpr size_t WS_MIX = 392 * MiB;
constexpr size_t WS_END = 456 * MiB;
constexpr size_t SUBSTRIDE = (size_t)MROWS * 512;
enum { T_U = 0, T_V = 1, T_ZA = 2, T_Q = 3, T_K = 4, T_VV = 5, T_ZB = 6 };

constexpr int NWAVES = 8;
constexpr int LDS_BYTES = 160 * 1024;
constexpr int RING_BYTES = 131072;

#define LAS __attribute__((address_space(3)))
typedef unsigned short bf16;
typedef unsigned v4u __attribute__((ext_vector_type(4)));
typedef float f32x4 __attribute__((ext_vector_type(4)));
#define LDS_WAIT() asm volatile("s_waitcnt lgkmcnt(0)" ::: "memory")
__device__ __forceinline__ unsigned f2bf(float f) { unsigned u = __builtin_bit_cast(unsigned, f); return (u + 0x7fffu + ((u >> 16) & 1u)) >> 16; }
__device__ __forceinline__ unsigned pk2(float lo, float hi) { return f2bf(lo) | (f2bf(hi) << 16); }
__device__ __forceinline__ float bflo(unsigned w) { return __uint_as_float(w << 16); }
__device__ __forceinline__ float bfhi(unsigned w) { return __uint_as_float(w & 0xffff0000u); }
__device__ __forceinline__ float wave_sum(float v) {
#pragma unroll
    for (int o = 1; o < 64; o <<= 1) v += __shfl_xor(v, o);
    return v;
}

__device__ __forceinline__ int lane_now() { int l; asm volatile("v_mbcnt_lo_u32_b32 %0, -1, 0\n\tv_mbcnt_hi_u32_b32 %0, -1, %0" : "=v"(l)); return l; }
struct Args { const float* in[10]; float* out; unsigned char* ws; int layer, pad; };

struct Ctx {
    unsigned char* lds;
    int tid, lane, wave, G, bid;
    const float *x, *norm_g, *w_in, *ln_g, *ln_b, *sgu_w, *sgu_b, *w_out, *rel_bias, *final_g;
    float* out; unsigned char* ws;
};

__device__ __forceinline__ void p0_transpose_item(const float* W, const float* gs, int K, int N, bf16* WT, float* scr, int item, int lane) {
    const int nblk = N / 32, kb = item / nblk, nb = item % nblk, k0 = 64 * kb, n0 = 32 * nb;
#pragma unroll 8
    for (int i = 0; i < 32; ++i) { const int kk = 2 * i + (lane >> 5); const float sc = gs ? gs[k0 + kk] : 1.0f; scr[kk * 33 + (lane & 31)] = W[(size_t)(k0 + kk) * N + n0 + (lane & 31)] * sc; }
    LDS_WAIT(); asm volatile("" ::: "memory");
    const int c = lane & 7;
#pragma unroll
    for (int j = 0; j < 4; ++j) { const int n = (lane >> 3) + 8 * j; const float* s = scr + (8 * c) * 33 + n;
        v4u o; o.x = pk2(s[0 * 33], s[1 * 33]); o.y = pk2(s[2 * 33], s[3 * 33]); o.z = pk2(s[4 * 33], s[5 * 33]); o.w = pk2(s[6 * 33], s[7 * 33]);
        *(v4u*)(WT + (size_t)(n0 + n) * K + k0 + 8 * c) = o; }
    LDS_WAIT(); asm volatile("" ::: "memory");
}
__device__ __forceinline__ int rel_bucket(int d) {
    if (d < 16) return d;
    int b = 16;
    b += (d >= 19); b += (d >= 21); b += (d >= 24); b += (d >= 27); b += (d >= 31); b += (d >= 35); b += (d >= 40); b += (d >= 46);
    b += (d >= 52); b += (d >= 59); b += (d >= 67); b += (d >= 77); b += (d >= 87); b += (d >= 99); b += (d >= 113);
    return b;
}
__device__ __forceinline__ void phase_prologue(const Ctx& C) {
    float* scr = (float*)(C.lds + C.wave * 16384);
    const int gw = C.bid * NWAVES + C.wave, NGW = C.G * NWAVES;
    constexpr int I_IN = (DM / 64) * (DIN / 32), I_OUT = (DM / 64) * (DM / 32);
    constexpr int NITEMS = DEPTH * (I_IN + I_OUT);
    for (int it = gw; it < NITEMS; it += NGW) {
        const int l = it / (I_IN + I_OUT); int r = it % (I_IN + I_OUT);
        if (r < I_IN) p0_transpose_item(C.w_in + (size_t)l * DM * DIN, C.norm_g + l * DM, DM, DIN, (bf16*)(C.ws + WS_WIN) + (size_t)l * DIN * DM, scr, r, C.lane);
        else p0_transpose_item(C.w_out + (size_t)l * DM * DM, nullptr, DM, DM, (bf16*)(C.ws + WS_WOUT) + (size_t)l * DM * DM, scr, r - I_IN, C.lane);
    }
    { float* km = (float*)(C.ws + WS_KMEAN); for (int e = C.bid * 512 + C.tid; e < DEPTH * NBH * NBLK * 64; e += C.G * 512) km[e] = 0.f; }
    { bf16* wst = (bf16*)(C.ws + WS_WST); const int gt = C.bid * 512 + C.tid, NT = C.G * 512;
      for (int e = gt; e < DEPTH * 8 * 128 * 128; e += NT) { const int s = e & 127, t = (e >> 7) & 127; wst[e] = (s <= t) ? (bf16)f2bf(C.sgu_w[e]) : (bf16)0; } }
    if (C.bid == 0) { float* bt = (float*)(C.ws + WS_BT); for (int e = C.tid; e < 8 * 128; e += 512) { const int h = e >> 7, d = e & 127; bt[e] = C.rel_bias[rel_bucket(d) * 8 + h] * LOG2E; } }
    { bf16* xb = (bf16*)(C.ws + WS_XB); float* rowss = (float*)(C.ws + WS_ROWSS);
      constexpr int UN = 4;
      for (int m0 = gw; m0 < MROWS; m0 += NGW * UN) {
        f32x4 v[UN][4];
#pragma unroll
        for (int k = 0; k < UN; ++k) { const f32x4* xr = (const f32x4*)(C.x + (size_t)(m0 + k * NGW) * DM) + C.lane;
#pragma unroll
            for (int j = 0; j < 4; ++j) v[k][j] = xr[64 * j]; }
#pragma unroll
        for (int k = 0; k < UN; ++k) { const int m = m0 + k * NGW;
            float s = 0.f;
#pragma unroll
            for (int j = 0; j < 4; ++j) s += (v[k][j].x * v[k][j].x + v[k][j].y * v[k][j].y) + (v[k][j].z * v[k][j].z + v[k][j].w * v[k][j].w);
            s = wave_sum(s);
            unsigned long long* o8 = (unsigned long long*)(xb + (size_t)m * DM) + C.lane;
#pragma unroll
            for (int j = 0; j < 4; ++j) o8[64 * j] = (unsigned long long)pk2(v[k][j].x, v[k][j].y) | ((unsigned long long)pk2(v[k][j].z, v[k][j].w) << 32);
            if (C.lane < 16) rowss[(size_t)m * 16 + C.lane] = (C.lane == 0) ? s : 0.f; }
      } }
}

typedef short bf16x8 __attribute__((ext_vector_type(8)));
typedef short bf16x4s __attribute__((ext_vector_type(4)));
typedef float f32x16 __attribute__((ext_vector_type(16)));
__device__ __forceinline__ int crow(int r, int hi) { return (r & 3) + 8 * (r >> 2) + 4 * hi; }
__device__ __forceinline__ unsigned cvtpk(float lo, float hi) { unsigned r; asm volatile("v_cvt_pk_bf16_f32 %0, %1, %2" : "=v"(r) : "v"(lo), "v"(hi)); return r; }
__device__ __forceinline__ void phase_gate(const Ctx& C, int layer) {
    const bf16* Q = (const bf16*)(C.ws + WS_PROJ) + (size_t)T_Q * SUBSTRIDE;
    const float* KM = (const float*)(C.ws + WS_KMEAN) + (size_t)layer * NBH * NBLK * 64;
    int* SEL = (int*)(C.ws + WS_SEL); int* LOFF = (int*)(C.ws + WS_LOFF); unsigned short* LIST = (unsigned short*)(C.ws + WS_LIST);
    int* cnt = (int*)(C.lds);
    int* offs = (int*)(C.lds + 256);
    unsigned char* kml = C.lds + 1024;
    const int lane = C.lane, ql = lane & 31, hi = lane >> 5;
    bf16x8 qfN[4]; f32x4 kmr[2];
#define GATE_LOAD(uu) do { const int bh_ = (uu) / 63, i_ = (uu) % 63 + 1, b_ = bh_ >> 3, h_ = bh_ & 7; \
        const bf16* qrow_ = Q + ((size_t)(b_ * SEQ + i_ * 256 + C.wave * 32 + ql)) * 512 + h_ * 64 + hi * 8; \
        _Pragma("unroll") for (int ks = 0; ks < 4; ++ks) qfN[ks] = *(const bf16x8*)(qrow_ + ks * 16); \
        const float* kp_ = KM + (size_t)bh_ * NBLK * 64 + C.tid * 8; kmr[0] = *(const f32x4*)kp_; kmr[1] = *(const f32x4*)(kp_ + 4); } while (0)
#define GATE_KML() do { *(v4u*)(kml + (C.tid >> 3) * 144 + (C.tid & 7) * 16) = (v4u){cvtpk(kmr[0][0], kmr[0][1]), cvtpk(kmr[0][2], kmr[0][3]), cvtpk(kmr[1][0], kmr[1][1]), cvtpk(kmr[1][2], kmr[1][3])}; } while (0)
    int u = C.bid;
    if (C.tid < 64) cnt[C.tid] = 0;
    if (u < NBH * 63) { GATE_LOAD(u); GATE_KML(); }
    __syncthreads();
    for (; u < NBH * 63; u += C.G) {
        const int bh = u / 63, i = u % 63 + 1;
        const int q = C.wave * 32 + ql, pos = i * 256 + q;
        bf16x8 qf[4];
#pragma unroll
        for (int ks = 0; ks < 4; ++ks) qf[ks] = qfN[ks];
        const bool more = u + C.G < NBH * 63;
        if (more) GATE_LOAD(u + C.G);
        float b0 = -INFINITY, b1 = -INFINITY, b2 = -INFINITY; int i0 = -1, i1 = -1, i2 = -1;
#define TOP3_INS(v, idx) do { const float v_ = (v); const int x_ = (idx); if (v_ > b0) { b2 = b1; i2 = i1; b1 = b0; i1 = i0; b0 = v_; i0 = x_; } else if (v_ > b1) { b2 = b1; i2 = i1; b1 = v_; i1 = x_; } else if (v_ > b2) { b2 = v_; i2 = x_; } } while (0)
#pragma unroll
        for (int nt = 0; nt < 2; ++nt) {
            f32x16 p = {};
#pragma unroll
            for (int ks = 0; ks < 4; ++ks) {
                const bf16x8 kw = *(const bf16x8*)(kml + (32 * nt + ql) * 144 + ks * 32 + hi * 16);
                p = __builtin_amdgcn_mfma_f32_32x32x16_bf16(kw, qf[ks], p, 0, 0, 0);
            }
#pragma unroll
            for (int r = 0; r < 16; ++r) { const int n = 32 * nt + crow(r, hi); if (n < i) TOP3_INS(p[r], n); }
        }
        { const float c0 = __shfl_xor(b0, 32), c1 = __shfl_xor(b1, 32), c2 = __shfl_xor(b2, 32);
          const int j0 = __shfl_xor(i0, 32), j1 = __shfl_xor(i1, 32), j2 = __shfl_xor(i2, 32);
          if (j0 >= 0) TOP3_INS(c0, j0);
          if (j1 >= 0) TOP3_INS(c1, j1);
          if (j2 >= 0) TOP3_INS(c2, j2); }
#undef TOP3_INS
        int p0 = 0, p1 = 0, p2 = 0;
        if (hi == 0) {
            if (CHECK_ATTN) { int* sp = SEL + ((size_t)bh * SEQ + pos) * 4; sp[0] = i0; sp[1] = i1; sp[2] = i2; sp[3] = -1; }
            p0 = atomicAdd(&cnt[i0], 1);
            if (i1 >= 0) p1 = atomicAdd(&cnt[i1], 1);
            if (i2 >= 0) p2 = atomicAdd(&cnt[i2], 1);
        }
        __syncthreads();
        if (C.tid < 64) {
            const int c = cnt[C.tid]; cnt[C.tid] = 0;
            int inc = c;
#pragma unroll
            for (int o = 1; o < 64; o <<= 1) { const int t = __shfl_up(inc, o); if (C.tid >= o) inc += t; }
            offs[C.tid + 1] = inc; if (C.tid == 0) offs[0] = 0;
            LOFF[(size_t)(bh * NBLK + i) * 80 + C.tid + 1] = inc; if (C.tid == 0) LOFF[(size_t)(bh * NBLK + i) * 80] = 0;
        }
        if (more) GATE_KML();
        __syncthreads();
        if (hi == 0) {
            unsigned short* lp = LIST + (size_t)(bh * NBLK + i) * 768;
            lp[offs[i0] + p0] = (unsigned short)(q | (0 << 8));
            if (i1 >= 0) lp[offs[i1] + p1] = (unsigned short)(q | (1 << 8));
            if (i2 >= 0) lp[offs[i2] + p2] = (unsigned short)(q | (2 << 8));
        }
    }
#undef GATE_LOAD
#undef GATE_KML
    if (CHECK_ATTN) { for (int e = C.bid * 512 + C.tid; e < NBH * 256; e += C.G * 512) { const int bh = e >> 8, qq = e & 255; int* sp = SEL + ((size_t)bh * SEQ + qq) * 4; sp[0] = -1; sp[1] = -1; sp[2] = -1; sp[3] = -1; } }
    __syncthreads();
}

__device__ __forceinline__ void phase_attn_simple(const Ctx& C, bf16* MIX) {
    const bf16* Q = (const bf16*)(C.ws + WS_PROJ) + (size_t)T_Q * SUBSTRIDE;
    const bf16* K = (const bf16*)(C.ws + WS_PROJ) + (size_t)T_K * SUBSTRIDE;
    const bf16* VV = (const bf16*)(C.ws + WS_PROJ) + (size_t)T_VV * SUBSTRIDE;
    const bf16* ZB = (const bf16*)(C.ws + WS_PROJ) + (size_t)T_ZB * SUBSTRIDE;
    const int* SEL = (const int*)(C.ws + WS_SEL); const float* BT = (const float*)(C.ws + WS_BT);
    const int gt = C.bid * 512 + C.tid, NT = C.G * 512;
    for (int item = gt; item < NBH * SEQ; item += NT) {
        const int bh = item >> 14, pos = item & (SEQ - 1), b = bh >> 3, h = bh & 7, own = pos >> 8;
        const size_t rowq = (size_t)(b * SEQ + pos);
        float qv[64], o[64];
        { const v4u* qp = (const v4u*)(Q + rowq * 512 + h * 64);
#pragma unroll
          for (int c = 0; c < 8; ++c) { const v4u v = qp[c]; qv[8 * c + 0] = bflo(v.x); qv[8 * c + 1] = bfhi(v.x); qv[8 * c + 2] = bflo(v.y); qv[8 * c + 3] = bfhi(v.y);
              qv[8 * c + 4] = bflo(v.z); qv[8 * c + 5] = bfhi(v.z); qv[8 * c + 6] = bflo(v.w); qv[8 * c + 7] = bfhi(v.w); } }
#pragma unroll
        for (int d = 0; d < 64; ++d) o[d] = 0.f;
        float m = -INFINITY, l = 0.f;
        const float* bt = BT + h * 128;
        for (int slot = 0; slot < 4; ++slot) {
            int blk, klim;
            if (slot == 0) { blk = own; klim = (pos & 255) + 1; } else { blk = SEL[(size_t)item * 4 + slot - 1]; klim = 256; if (blk < 0) klim = 0; }
            for (int kl = 0; kl < klim; ++kl) {
                const int kpos = blk * 256 + kl;
                const v4u* kp = (const v4u*)(K + ((size_t)(b * SEQ + kpos)) * 512 + h * 64);
                float a0 = 0.f, a1 = 0.f;
#pragma unroll
                for (int c = 0; c < 8; ++c) { const v4u v = kp[c];
                    a0 += qv[8 * c + 0] * bflo(v.x) + qv[8 * c + 2] * bflo(v.y) + qv[8 * c + 4] * bflo(v.z) + qv[8 * c + 6] * bflo(v.w);
                    a1 += qv[8 * c + 1] * bfhi(v.x) + qv[8 * c + 3] * bfhi(v.y) + qv[8 * c + 5] * bfhi(v.z) + qv[8 * c + 7] * bfhi(v.w); }
                int dd = pos - kpos; dd = dd > 127 ? 127 : dd;
                const float s = (a0 + a1) + bt[dd];
                if (s > m) { const float al = __builtin_amdgcn_exp2f(m - s); l *= al;
#pragma unroll
                    for (int d = 0; d < 64; ++d) o[d] *= al;
                    m = s; }
                const float p = __builtin_amdgcn_exp2f(s - m);
                l += p;
                const v4u* vp = (const v4u*)(VV + ((size_t)(b * SEQ + kpos)) * 512 + h * 64);
#pragma unroll
                for (int c = 0; c < 8; ++c) { const v4u v = vp[c];
                    o[8 * c + 0] += p * bflo(v.x); o[8 * c + 1] += p * bfhi(v.x); o[8 * c + 2] += p * bflo(v.y); o[8 * c + 3] += p * bfhi(v.y);
                    o[8 * c + 4] += p * bflo(v.z); o[8 * c + 5] += p * bfhi(v.z); o[8 * c + 6] += p * bflo(v.w); o[8 * c + 7] += p * bfhi(v.w); }
            }
        }
        const float rl = 1.0f / l;
        const v4u* zp = (const v4u*)(ZB + rowq * 512 + h * 64);
        v4u* op = (v4u*)(MIX + rowq * 1024 + 512 + h * 64);
#pragma unroll
        for (int c = 0; c < 8; ++c) { const v4u z = zp[c]; v4u w;
            w.x = pk2(o[8 * c + 0] * rl * pg8::act_silu(bflo(z.x)), o[8 * c + 1] * rl * pg8::act_silu(bfhi(z.x))); w.y = pk2(o[8 * c + 2] * rl * pg8::act_silu(bflo(z.y)), o[8 * c + 3] * rl * pg8::act_silu(bfhi(z.y)));
            w.z = pk2(o[8 * c + 4] * rl * pg8::act_silu(bflo(z.z)), o[8 * c + 5] * rl * pg8::act_silu(bfhi(z.z))); w.w = pk2(o[8 * c + 6] * rl * pg8::act_silu(bflo(z.w)), o[8 * c + 7] * rl * pg8::act_silu(bfhi(z.w)));
            op[c] = w; }
    }
}

constexpr int AT_KS = 0, AT_KPITCH = 144;
constexpr int AT_VT = 36864, AT_VPITCH = 528;
constexpr int AT_DT = AT_VT + 64 * AT_VPITCH;
constexpr int AT_ENT = AT_DT + 4096, AT_CAP = 4096;
constexpr int AT_PRE = AT_ENT + AT_CAP * 4;
constexpr int AT_OST = AT_PRE + 1024;
constexpr int AT_MISC = AT_OST + 8 * 4096;
constexpr int AT_NUNITS = NBLK * NBH;

struct QTile { unsigned ent; bf16x8 qf[4]; };
__device__ __forceinline__ void attn_load_q(QTile& T, const Ctx& C, const unsigned char* lds, int b, int h, int e0, int cnt) {
    const bf16* Q = (const bf16*)(C.ws + WS_PROJ) + (size_t)T_Q * SUBSTRIDE;
    const unsigned* ENT = (const unsigned*)(lds + AT_ENT);
    const int q = C.lane & 31, hi = C.lane >> 5;
    T.ent = ENT[(e0 + q < cnt) ? (e0 + q) : e0];
    const bf16* qrow = Q + ((size_t)(b * SEQ + (int)(T.ent & 16383u))) * 512 + h * 64 + hi * 8;
#pragma unroll
    for (int ks = 0; ks < 4; ++ks) T.qf[ks] = *(const bf16x8*)(qrow + ks * 16);
}
__device__ __forceinline__ void attn_tile(const Ctx& C, unsigned char* lds, const QTile& T, int bh, int e0, int cnt, int nkt2, const bool OWN) {
    bf16* PO = (bf16*)C.out; float* PL = (float*)(C.ws + WS_PL);
    const unsigned* ENT = (const unsigned*)(lds + AT_ENT);
    const int lane = C.lane, q = lane & 31, hi = lane >> 5;
    const unsigned ent = T.ent;
    const int pos = ent & 16383, qoff = (ent >> 16) & 1023;
    f32x16 o0 = {}, o1 = {};
    float l = 0.f;
    const bool anybias = OWN ? true : (__any(qoff < 112) != 0);
    const unsigned char* kbase = lds + AT_KS + q * AT_KPITCH + hi * 16;
    const unsigned char* vbase = lds + AT_VT + q * AT_VPITCH + hi * 16;
    const float* et0 = (const float*)(lds + AT_DT) + (256 + (OWN ? 0 : 256) + qoff - 4 * hi);
    bf16x8 kf[8];
#pragma unroll
    for (int ks = 0; ks < 4; ++ks) { kf[2 * ks] = *(const bf16x8*)(kbase + ks * 32); kf[2 * ks + 1] = *(const bf16x8*)(kbase + 32 * AT_KPITCH + ks * 32); }
    for (int kt2 = 0; kt2 < nkt2; ++kt2) {
        f32x16 p0 = {}, p1 = {};
        __builtin_amdgcn_s_setprio(1);
#pragma unroll
        for (int ks = 0; ks < 4; ++ks) {
            p0 = __builtin_amdgcn_mfma_f32_32x32x16_bf16(kf[2 * ks], T.qf[ks], p0, 0, 0, 0);
            p1 = __builtin_amdgcn_mfma_f32_32x32x16_bf16(kf[2 * ks + 1], T.qf[ks], p1, 0, 0, 0);
        }
        __builtin_amdgcn_s_setprio(0);
        bf16x8 vf[8];
#pragma unroll
        for (int s = 0; s < 4; ++s) { vf[2 * s] = *(const bf16x8*)(vbase + (64 * kt2 + 16 * s) * 2); vf[2 * s + 1] = *(const bf16x8*)(vbase + 32 * AT_VPITCH + (64 * kt2 + 16 * s) * 2); }
        if (anybias && (OWN || kt2 >= 2)) {
            const float* et = et0 - 64 * kt2 - 63;
#pragma unroll
            for (int r = 0; r < 16; ++r) { p0[r] += et[63 - ((r & 3) + 8 * (r >> 2))]; p1[r] += et[31 - ((r & 3) + 8 * (r >> 2))]; }
        }
#pragma unroll
        for (int r = 0; r < 16; ++r) { p0[r] = __builtin_amdgcn_exp2f(p0[r]); p1[r] = __builtin_amdgcn_exp2f(p1[r]); }
        float sa = 0.f, sb = 0.f;
#pragma unroll
        for (int r = 0; r < 16; ++r) { sa += p0[r]; sb += p1[r]; }
        l += sa + sb;
        v4u pa[4];
#pragma unroll
        for (int s = 0; s < 2; ++s) {
            pa[s] = (v4u){cvtpk(p0[8 * s + 0], p0[8 * s + 1]), cvtpk(p0[8 * s + 2], p0[8 * s + 3]), cvtpk(p0[8 * s + 4], p0[8 * s + 5]), cvtpk(p0[8 * s + 6], p0[8 * s + 7])};
            pa[2 + s] = (v4u){cvtpk(p1[8 * s + 0], p1[8 * s + 1]), cvtpk(p1[8 * s + 2], p1[8 * s + 3]), cvtpk(p1[8 * s + 4], p1[8 * s + 5]), cvtpk(p1[8 * s + 6], p1[8 * s + 7])};
        }
        if (kt2 + 1 < nkt2) {
#pragma unroll
            for (int ks = 0; ks < 4; ++ks) { kf[2 * ks] = *(const bf16x8*)(kbase + (64 * kt2 + 64) * AT_KPITCH + ks * 32); kf[2 * ks + 1] = *(const bf16x8*)(kbase + (64 * kt2 + 96) * AT_KPITCH + ks * 32); }
        }
        __builtin_amdgcn_s_setprio(1);
#pragma unroll
        for (int s = 0; s < 4; ++s) {
            const bf16x8 paf = __builtin_bit_cast(bf16x8, pa[s]);
            o0 = __builtin_amdgcn_mfma_f32_32x32x16_bf16(paf, vf[2 * s], o0, 0, 0, 0);
            o1 = __builtin_amdgcn_mfma_f32_32x32x16_bf16(paf, vf[2 * s + 1], o1, 0, 0, 0);
        }
        __builtin_amdgcn_s_setprio(0);
    }
    l += __shfl_xor(l, 32);
    bf16* stg = (bf16*)(lds + AT_OST + C.wave * 4096);
#pragma unroll
    for (int r = 0; r < 16; ++r) { const int orow = crow(r, hi); stg[orow * 64 + q] = (bf16)f2bf(o0[r]); stg[orow * 64 + 32 + q] = (bf16)f2bf(o1[r]); }
    LDS_WAIT(); asm volatile("" ::: "memory");
#pragma unroll
    for (int it = 0; it < 4; ++it) {
        const int row = it * 8 + (lane >> 3), ch = lane & 7;
        if (e0 + row < cnt) {
            const unsigned er = ENT[e0 + row];
            const int pr = er & 16383, jr = (er >> 14) & 3;
            *(v4u*)(PO + (((size_t)bh * SEQ + pr) * 4 + jr) * 64 + ch * 8) = *(const v4u*)(stg + row * 64 + ch * 8);
        }
    }
    if (hi == 0 && e0 + q < cnt) PL[((size_t)bh * SEQ + pos) * 4 + ((ent >> 14) & 3)] = l;
    LDS_WAIT(); asm volatile("" ::: "memory");
}

__device__ __forceinline__ void phase_attn(const Ctx& C, int layer) {
    unsigned char* lds = C.lds;
    const bf16* K = (const bf16*)(C.ws + WS_PROJ) + (size_t)T_K * SUBSTRIDE;
    const bf16* VV = (const bf16*)(C.ws + WS_PROJ) + (size_t)T_VV * SUBSTRIDE;
    const int* LOFF = (const int*)(C.ws + WS_LOFF); const unsigned short* LIST = (const unsigned short*)(C.ws + WS_LIST);
    const float* BT = (const float*)(C.ws + WS_BT);
    const int qg = C.bid & 7;
    unsigned* ctr = (unsigned*)(C.ws + WS_CTL) + 64 + 64 * layer;
    int qstep = 0;
    unsigned* ENT = (unsigned*)(lds + AT_ENT);
    int* PRE = (int*)(lds + AT_PRE); int* LO = PRE + 68;
    volatile unsigned* MISC = (volatile unsigned*)(lds + AT_MISC);
    int tid = C.tid;
    v4u kpre[4], vpre[4]; int lpre0 = 0, lpre1 = 0;
#define AT_LOADKV(uu) do { const int bh_ = (uu) & 15, n_ = (uu) >> 4; \
        const bf16* Kg = K + ((size_t)((bh_ >> 3) * SEQ + n_ * 256)) * 512 + (bh_ & 7) * 64; const bf16* Vg = VV + ((size_t)((bh_ >> 3) * SEQ + n_ * 256)) * 512 + (bh_ & 7) * 64; \
        _Pragma("unroll") for (int it = 0; it < 4; ++it) { const int idx = tid + 512 * it; kpre[it] = *(const v4u*)(Kg + (size_t)(idx >> 3) * 512 + (idx & 7) * 8); \
            vpre[it] = *(const v4u*)(Vg + (size_t)(idx >> 3) * 512 + (idx & 7) * 8); } \
        lpre0 = 0; lpre1 = 0; if (tid < 64 && n_ + 1 + tid < NBLK) { const int* lp_ = LOFF + ((size_t)(bh_ * NBLK + n_ + 1 + tid)) * 80 + n_; lpre0 = lp_[0]; lpre1 = lp_[1]; } } while (0)
#define AT_FETCH() ({ unsigned r_ = (unsigned)AT_NUNITS; while (qstep < 8) { const int g_ = (qg + qstep) & 7; const unsigned k_ = atomicAdd(ctr + 4 * g_, 1u); \
        if (k_ < 2u * NBLK) { r_ = (k_ >> 1) * 16 + 2 * g_ + (k_ & 1); break; } ++qstep; } r_; })
    if (tid == 0) MISC[0] = AT_FETCH();
    __syncthreads();
    int u = (int)MISC[0];
    if (u < AT_NUNITS) AT_LOADKV(u);
    while (u < AT_NUNITS) {
        asm volatile("" : "+v"(tid));
        Ctx Cu = C; Cu.tid = tid; Cu.lane = tid & 63;
        const int bh = u & 15, n = u >> 4, b = bh >> 3, h = bh & 7;
        if (tid == 0) MISC[1] = AT_FETCH();
#pragma unroll
        for (int it = 0; it < 4; ++it) { const int idx = tid + 512 * it;
            *(v4u*)(lds + AT_KS + (idx >> 3) * AT_KPITCH + (idx & 7) * 16) = kpre[it];
            const v4u v = vpre[it];
            const int kv_ = idx >> 3, kvp_ = (kv_ & ~12) | ((kv_ & 4) << 1) | ((kv_ & 8) >> 1);
            unsigned short* vt = (unsigned short*)(lds + AT_VT + (8 * (idx & 7)) * AT_VPITCH + kvp_ * 2);
            vt[0 * (AT_VPITCH / 2)] = (unsigned short)(v.x & 0xffff); vt[1 * (AT_VPITCH / 2)] = (unsigned short)(v.x >> 16);
            vt[2 * (AT_VPITCH / 2)] = (unsigned short)(v.y & 0xffff); vt[3 * (AT_VPITCH / 2)] = (unsigned short)(v.y >> 16);
            vt[4 * (AT_VPITCH / 2)] = (unsigned short)(v.z & 0xffff); vt[5 * (AT_VPITCH / 2)] = (unsigned short)(v.z >> 16);
            vt[6 * (AT_VPITCH / 2)] = (unsigned short)(v.w & 0xffff); vt[7 * (AT_VPITCH / 2)] = (unsigned short)(v.w >> 16); }
        { float* et_ = (float*)(lds + AT_DT);
#pragma unroll
          for (int k_ = 0; k_ < 2; ++k_) { const int j_ = tid + 512 * k_, d_ = j_ - 256; et_[j_] = d_ < 0 ? -INFINITY : (d_ < 128 ? BT[h * 128 + d_] - BT[h * 128 + 127] : 0.f); } }
        if (tid < 64) {
            const int lo = lpre0; int inc = lpre1 - lpre0;
#pragma unroll
            for (int o = 1; o < 64; o <<= 1) { const int t = __shfl_up(inc, o); if (tid >= o) inc += t; }
            PRE[tid + 1] = inc; LO[tid] = lo; if (tid == 0) PRE[0] = 0;
        }
        __syncthreads();
        const int total = 256 + PRE[63 - n];
        const int unext = (int)MISC[1];
        if (unext < AT_NUNITS) AT_LOADKV(unext);
        for (int base = 0; base < total; base += AT_CAP) {
            const int cnt = (total - base < AT_CAP) ? (total - base) : AT_CAP;
            if (base == 0 && tid < 256) ENT[tid] = (unsigned)(n * 256 + tid) | (3u << 14) | ((unsigned)tid << 16);
            { const int e_lo = base > 256 ? base : 256, e_hi = base + cnt;
#pragma unroll 4
              for (int e = e_lo + tid; e < e_hi; e += 512) {
                  const int es = e - 256; int a = 0, z = 63 - n;
#pragma unroll
                  for (int it = 0; it < 6; ++it) { const int mid = (a + z) >> 1; const bool up = (z - a > 1) && (PRE[mid] <= es); const bool dn = (z - a > 1) && !up; a = up ? mid : a; z = dn ? mid : z; }
                  const int ii = a, i = n + 1 + ii;
                  const unsigned val = LIST[((size_t)(bh * NBLK + i)) * 768 + LO[ii] + (es - PRE[ii])]; const unsigned ql = val & 255u, j = val >> 8;
                  ENT[e - base] = (unsigned)(i * 256 + ql) | (j << 14) | ((ii == 0 ? ql : 400u) << 16);
              } }
            __syncthreads();
            const int ntiles = (cnt + 31) >> 5;
            const int nown = (base == 0) ? 8 : 0;
            for (int tile = C.wave; tile < ntiles; tile += 8) {
                QTile Tc;
                attn_load_q(Tc, Cu, lds, b, h, tile * 32, cnt);
                { const bool own_ = tile < nown; attn_tile(Cu, lds, Tc, bh, tile * 32, cnt, own_ ? (tile >> 1) + 1 : 4, own_); }
            }
            __syncthreads();
        }
        u = unext;
    }
#undef AT_LOADKV
#undef AT_FETCH
}

__device__ __forceinline__ void phase_combine(const Ctx& C) {
    const bf16* PO = (const bf16*)C.out; const float* PL = (const float*)(C.ws + WS_PL);
    const bf16* ZB = (const bf16*)(C.ws + WS_PROJ) + (size_t)T_ZB * SUBSTRIDE;
    bf16* MIX = (bf16*)(C.ws + WS_MIX);
    const int gt = C.bid * 512 + C.tid, NT = C.G * 512;
    constexpr int UN = 4;
    for (int idx0 = gt; idx0 < MROWS * 64; idx0 += NT * UN) {
        f32x4 lv[UN]; v4u pv[UN][4]; v4u zv[UN];
#pragma unroll
        for (int k = 0; k < UN; ++k) {
            const int idx = idx0 + k * NT;
            const int ch = idx & 7, h = (idx >> 3) & 7, row = idx >> 6, b = row >> 14, pos = row & (SEQ - 1), i = pos >> 8;
            const size_t pb = ((size_t)(b * NH + h) * SEQ + pos) * 4;
            lv[k] = *(const f32x4*)(PL + pb);
#pragma unroll
            for (int j = 0; j < 4; ++j) pv[k][j] = (j == 3 || j < i) ? *(const v4u*)(PO + (pb + j) * 64 + ch * 8) : (v4u){0u, 0u, 0u, 0u};
            zv[k] = *(const v4u*)(ZB + (size_t)row * 512 + h * 64 + ch * 8);
        }
#pragma unroll
        for (int k = 0; k < UN; ++k) {
            const int idx = idx0 + k * NT;
            const int ch = idx & 7, h = (idx >> 3) & 7, row = idx >> 6, pos = row & (SEQ - 1), i = pos >> 8;
            float L = lv[k][3];
#pragma unroll
            for (int j = 0; j < 3; ++j) L += (j < i) ? lv[k][j] : 0.f;
            float acc[8];
#pragma unroll
            for (int e = 0; e < 8; ++e) acc[e] = 0.f;
#pragma unroll
            for (int j = 0; j < 4; ++j) { const v4u v = pv[k][j];
                acc[0] += bflo(v.x); acc[1] += bfhi(v.x); acc[2] += bflo(v.y); acc[3] += bfhi(v.y); acc[4] += bflo(v.z); acc[5] += bfhi(v.z); acc[6] += bflo(v.w); acc[7] += bfhi(v.w); }
            const float rl = 1.0f / L;
            const v4u z = zv[k];
            v4u w;
            w.x = pk2(acc[0] * rl * pg8::act_silu(bflo(z.x)), acc[1] * rl * pg8::act_silu(bfhi(z.x))); w.y = pk2(acc[2] * rl * pg8::act_silu(bflo(z.y)), acc[3] * rl * pg8::act_silu(bfhi(z.y)));
            w.z = pk2(acc[4] * rl * pg8::act_silu(bflo(z.z)), acc[5] * rl * pg8::act_silu(bfhi(z.z))); w.w = pk2(acc[6] * rl * pg8::act_silu(bflo(z.w)), acc[7] * rl * pg8::act_silu(bfhi(z.w)));
            *(v4u*)(MIX + (size_t)row * 1024 + 512 + h * 64 + ch * 8) = w;
        }
    }
}

constexpr int SG_VPITCH = 272, SG_MPITCH = 144, SG_WREG = 128 * SG_MPITCH;
constexpr int SG_STATS = 8 * SG_WREG;
constexpr int SG_MR = SG_STATS + 8192;
constexpr int SG_LN = SG_MR + 1024;
__device__ __forceinline__ void phase_sgu(const Ctx& C, int layer) {
    typedef float f32x2v __attribute__((ext_vector_type(2)));
    unsigned char* lds = C.lds;
    const bf16* U = (const bf16*)(C.ws + WS_PROJ) + (size_t)T_U * SUBSTRIDE;
    const bf16* V = (const bf16*)(C.ws + WS_PROJ) + (size_t)T_V * SUBSTRIDE;
    const bf16* ZA = (const bf16*)(C.ws + WS_PROJ) + (size_t)T_ZA * SUBSTRIDE;
    bf16* MIX = (bf16*)(C.ws + WS_MIX);
    const int g = C.wave; int lane = C.lane;
    const float* lng = C.ln_g + layer * 512 + g * 64; const float* lnb = C.ln_b + layer * 512 + g * 64;
    const bf16* Wg = (const bf16*)(C.ws + WS_WST) + ((size_t)(layer * 8 + g)) * 128 * 128;
    const float* bg = C.sgu_b + (layer * 8 + g) * 128;
    unsigned char* myreg = lds + g * SG_WREG;
    f32x2v* stats = (f32x2v*)(lds + SG_STATS); f32x2v* mr = (f32x2v*)(lds + SG_MR);
    float* lnl = (float*)(lds + SG_LN + g * 512);
    lnl[lane] = lng[lane]; lnl[64 + lane] = lnb[lane];
    for (int u = C.bid; u < MROWS / 128; u += C.G) {
        const size_t row0 = (size_t)u * 128;
        asm volatile("" : "+v"(lane));
        v4u xv[2][8];
#pragma unroll
        for (int rr = 0; rr < 2; ++rr) {
            const v4u* vp = (const v4u*)(V + (row0 + lane + 64 * rr) * 512 + g * 64);
#pragma unroll
            for (int c = 0; c < 8; ++c) xv[rr][c] = vp[c];
        }
#pragma unroll
        for (int rr = 0; rr < 2; ++rr) {
            float s1 = 0.f, s2 = 0.f;
#pragma unroll
            for (int c = 0; c < 8; ++c) { v4u v = xv[rr][c];
                v.x = pk2(pg8::act_gelu(bflo(v.x)), pg8::act_gelu(bfhi(v.x))); v.y = pk2(pg8::act_gelu(bflo(v.y)), pg8::act_gelu(bfhi(v.y)));
                v.z = pk2(pg8::act_gelu(bflo(v.z)), pg8::act_gelu(bfhi(v.z))); v.w = pk2(pg8::act_gelu(bflo(v.w)), pg8::act_gelu(bfhi(v.w))); xv[rr][c] = v;
                const float f0 = bflo(v.x), f1 = bfhi(v.x), f2 = bflo(v.y), f3 = bfhi(v.y), f4 = bflo(v.z), f5 = bfhi(v.z), f6 = bflo(v.w), f7 = bfhi(v.w);
                s1 += ((f0 + f1) + (f2 + f3)) + ((f4 + f5) + (f6 + f7));
                s2 += ((f0 * f0 + f1 * f1) + (f2 * f2 + f3 * f3)) + ((f4 * f4 + f5 * f5) + (f6 * f6 + f7 * f7)); }
            stats[g * 128 + lane + 64 * rr] = (f32x2v){s1, s2};
        }
        bf16x8 wf[4][8];
        { const bf16* wa = Wg + (size_t)(lane & 31) * 128 + (lane >> 5) * 8;
#pragma unroll
          for (int tt = 0; tt < 4; ++tt)
#pragma unroll
              for (int ks = 0; ks < 8; ++ks) if (tt >= (ks >> 1)) wf[tt][ks] = *(const bf16x8*)(wa + (size_t)tt * 32 * 128 + ks * 16); }
        __syncthreads();
        if (C.tid < 128) {
            float s1 = 0.f, s2 = 0.f;
#pragma unroll
            for (int w = 0; w < 8; ++w) { const f32x2v t = stats[w * 128 + C.tid]; s1 += t.x; s2 += t.y; }
            const float mean = s1 * (1.0f / 512.0f), var = s2 * (1.0f / 512.0f) - mean * mean;
            mr[C.tid] = (f32x2v){mean, 1.0f / sqrtf(var + LN_EPS)};
        }
        __syncthreads();
#pragma unroll
        for (int c = 0; c < 8; ++c) asm volatile("" : "+v"(xv[0][c]), "+v"(xv[1][c]));
        { const f32x2v m0 = mr[lane], m1 = mr[lane + 64];
          unsigned short* vt = (unsigned short*)(myreg + lane * 2);
#pragma unroll
          for (int c = 0; c < 8; ++c) {
              const v4u v0 = xv[0][c], v1 = xv[1][c];
              const float f0[8] = {bflo(v0.x), bfhi(v0.x), bflo(v0.y), bfhi(v0.y), bflo(v0.z), bfhi(v0.z), bflo(v0.w), bfhi(v0.w)};
              const float f1[8] = {bflo(v1.x), bfhi(v1.x), bflo(v1.y), bfhi(v1.y), bflo(v1.z), bfhi(v1.z), bflo(v1.w), bfhi(v1.w)};
#pragma unroll
              for (int e = 0; e < 8; ++e) { const int d = 8 * c + e; const float gg = lnl[d], bbv = lnl[64 + d];
                  vt[d * (SG_VPITCH / 2)] = (unsigned short)f2bf((f0[e] - m0.x) * m0.y * gg + bbv);
                  vt[d * (SG_VPITCH / 2) + 64] = (unsigned short)f2bf((f1[e] - m1.x) * m1.y * gg + bbv); }
              asm volatile("" ::: "memory");
          } }
        LDS_WAIT(); asm volatile("" ::: "memory");
        { const int q = lane & 31, hi = lane >> 5;
          unsigned pk[2][4][8];
#pragma unroll
          for (int dt = 0; dt < 2; ++dt) {
              const unsigned char* bb = myreg + (32 * dt + q) * SG_VPITCH + hi * 16;
              f32x16 acc[4];
#pragma unroll
              for (int tt = 0; tt < 4; ++tt) acc[tt] = (f32x16){};
#pragma unroll
              for (int ks = 0; ks < 8; ++ks) {
                  const bf16x8 b0 = *(const bf16x8*)(bb + ks * 32);
#pragma unroll
                  for (int tt = 0; tt < 4; ++tt) if (tt >= (ks >> 1)) acc[tt] = __builtin_amdgcn_mfma_f32_32x32x16_bf16(wf[tt][ks], b0, acc[tt], 0, 0, 0);
              }
#pragma unroll
              for (int tt = 0; tt < 4; ++tt)
#pragma unroll
                  for (int rp = 0; rp < 8; ++rp) pk[dt][tt][rp] = cvtpk(acc[tt][2 * rp], acc[tt][2 * rp + 1]);
          }
          LDS_WAIT(); asm volatile("" ::: "memory");
          unsigned char* mxb = myreg + (4 * hi) * SG_MPITCH + q * 2;
#pragma unroll
          for (int dt = 0; dt < 2; ++dt)
#pragma unroll
              for (int tt = 0; tt < 4; ++tt)
#pragma unroll
                  for (int r = 0; r < 16; ++r)
                      *(unsigned short*)(mxb + (32 * tt + (r & 3) + 8 * (r >> 2)) * SG_MPITCH + 64 * dt) = (unsigned short)((r & 1) ? (pk[dt][tt][r >> 1] >> 16) : (pk[dt][tt][r >> 1] & 0xffffu));
        }
        LDS_WAIT(); asm volatile("" ::: "memory");
        { const int ch = lane & 7, r8 = lane >> 3;
#pragma unroll 4
          for (int it = 0; it < 16; ++it) {
              const int t = it * 8 + r8;
              const v4u mv = *(const v4u*)(myreg + t * SG_MPITCH + ch * 16);
              const v4u uv = *(const v4u*)(U + (row0 + t) * 512 + g * 64 + ch * 8), zv = *(const v4u*)(ZA + (row0 + t) * 512 + g * 64 + ch * 8);
              const float bt = bg[t];
              v4u o;
#define SGU_Y(uw, mw, zw) pk2(pg8::act_gelu(bflo(uw)) * (bflo(mw) + bt) * pg8::act_silu(bflo(zw)), pg8::act_gelu(bfhi(uw)) * (bfhi(mw) + bt) * pg8::act_silu(bfhi(zw)))
              o.x = SGU_Y(uv.x, mv.x, zv.x); o.y = SGU_Y(uv.y, mv.y, zv.y); o.z = SGU_Y(uv.z, mv.z, zv.z); o.w = SGU_Y(uv.w, mv.w, zv.w);
#undef SGU_Y
              *(v4u*)(MIX + (row0 + t) * 1024 + g * 64 + ch * 8) = o;
          } }
        __syncthreads();
    }
}

__device__ __forceinline__ void phase_check_inject(const Ctx& C) {
    if (C.bid == 0 && C.tid == 0) C.out[0] = __uint_as_float(((const unsigned*)(C.ws + WS_CTL))[32]) * 1e6f;
}

#define GAS __attribute__((address_space(1)))
typedef GAS unsigned gu32;
#define RLX_AGENT __ATOMIC_RELAXED, __HIP_MEMORY_SCOPE_AGENT
constexpr int CW_BAR = 4096;
constexpr int LDS_BARST = LDS_BYTES - 64;
#define XB_TMO      128
#define XB_XCNT(j)  (256  + 64 * (j))
#define XB_XSUB(j)  (1280 + 64 * (j))
#define XB_XGEN(j)  (2304 + 64 * (j))
#define XB_TOP      3328
#define XB_TOPGEN   3392
#define XCD_BAR_WORDS 3456
#define XB_SPIN_CAP (1u << 18)

__device__ __forceinline__ unsigned xb_ld(unsigned* p)              { return __hip_atomic_load(p, __ATOMIC_RELAXED, __HIP_MEMORY_SCOPE_AGENT); }
__device__ __forceinline__ unsigned xb_add(unsigned* p, unsigned v) { return __hip_atomic_fetch_add(p, v, __ATOMIC_RELAXED, __HIP_MEMORY_SCOPE_AGENT); }
__device__ __forceinline__ unsigned xb_xcc_id() { return (unsigned)__builtin_amdgcn_s_getreg((3 << 11) | 20) & 0xFu; }
#define XB_SPIN(cond, bar) do { unsigned _sp = 0; while (cond) { __builtin_amdgcn_s_sleep(1); \
    if ((++_sp & 255u) == 0u) { if (xb_ld(&(bar)[XB_TMO])) break; if (_sp > XB_SPIN_CAP) { atomicAdd(&(bar)[XB_TMO], 1u); break; } } } } while (0)

struct XcdBarrier {
    unsigned* bar; unsigned x;
    volatile LAS unsigned* st;
};

__device__ __forceinline__ XcdBarrier xcd_barrier_post(unsigned* bar, volatile LAS unsigned* st) {
    XcdBarrier b; b.bar = bar; b.x = xb_xcc_id(); b.st = st;
    if (threadIdx.x == 0) (void)xb_add(&bar[XB_XCNT(b.x)], 1u);
    return b;
}
__device__ __forceinline__ void xcd_barrier_complete(unsigned* bar, unsigned x, unsigned& nloc, unsigned& nx) {
    const unsigned G = gridDim.x * gridDim.y * gridDim.z;
    unsigned sum, cnt, mine, sp = 0u;
    for (;;) {
        sum = 0u; cnt = 0u; mine = 0u;
#pragma unroll
        for (unsigned j = 0; j < 16; ++j) { const unsigned c = xb_ld(&bar[XB_XCNT(j)]); sum += c; cnt += (c > 0u) ? 1u : 0u; mine = (j == x) ? c : mine; }
        if (sum == G) break;
        __builtin_amdgcn_s_sleep(1);
        if ((++sp & 255u) == 0u) { if (xb_ld(&bar[XB_TMO])) break; if (sp > XB_SPIN_CAP) { atomicAdd(&bar[XB_TMO], 1u); break; } }
    }
    nloc = mine > 0u ? mine : 1u; nx = cnt > 0u ? cnt : 1u;
}

__device__ __forceinline__ void xcd_barrier(const XcdBarrier& b, const bool leader_thread) {
    asm volatile("s_waitcnt vmcnt(0)" ::: "memory");
    __syncthreads();
    if (leader_thread) {
        unsigned* bar = b.bar;
        __builtin_amdgcn_s_waitcnt(0);
        unsigned nloc = b.st[0], nx = b.st[1];
        if (nloc == 0u) { xcd_barrier_complete(bar, b.x, nloc, nx); b.st[0] = nloc; b.st[1] = nx; }
        const unsigned old = xb_add(&bar[XB_XSUB(b.x)], 1u);
        const unsigned gen = old / nloc;
        if (old + 1u == (gen + 1u) * nloc) {
            __builtin_amdgcn_fence(__ATOMIC_RELEASE, "agent");
            asm volatile("s_waitcnt vmcnt(0)" ::: "memory");
            const unsigned og = xb_add(&bar[XB_TOP], 1u);
            const unsigned tg = og / nx;
            if (og + 1u == (tg + 1u) * nx) xb_add(&bar[XB_TOPGEN], 1u);
            else XB_SPIN(xb_ld(&bar[XB_TOPGEN]) == tg, bar);
            __builtin_amdgcn_fence(__ATOMIC_ACQUIRE, "agent");
            xb_add(&bar[XB_XGEN(b.x)], 1u);
            asm volatile("s_waitcnt vmcnt(0)" ::: "memory");
        } else {
            XB_SPIN(xb_ld(&bar[XB_XGEN(b.x)]) == gen, bar);
            __builtin_amdgcn_fence(__ATOMIC_ACQUIRE, "agent");
            asm volatile("s_waitcnt vmcnt(0)" ::: "memory");
        }
    }
    __syncthreads();
}

template <int ST> __device__ __forceinline__ void run_stage(const Args& args, unsigned char* lds, int Lr, int wave_s) {
    const int L = Lr;
    Ctx C;
    { int t = wave_s * 64 + lane_now(); C.tid = t; }
    C.lds = lds; C.lane = C.tid & 63; C.wave = __builtin_amdgcn_readfirstlane(C.tid >> 6); C.G = gridDim.x; C.bid = blockIdx.x;
    C.x = args.in[0]; C.norm_g = args.in[1]; C.w_in = args.in[2]; C.ln_g = args.in[3]; C.ln_b = args.in[4]; C.sgu_w = args.in[5]; C.sgu_b = args.in[6];
    C.w_out = args.in[7]; C.rel_bias = args.in[8]; C.final_g = args.in[9]; C.out = args.out; C.ws = args.ws;
    asm volatile("" : "+s"(C.ws), "+s"(C.out), "+s"(C.x), "+s"(C.sgu_b), "+s"(C.ln_g), "+s"(C.ln_b));
    if constexpr (ST == 0) phase_prologue(C);
    else if constexpr (ST == 1) {
        pg8::Gemm g{(const pg8::bf16_t*)(C.ws + WS_XB), (const pg8::bf16_t*)(C.ws + WS_WIN) + (size_t)L * DIN * DM, MROWS, DIN, DM};
        pg8::StaticOrder S; S.init(MROWS, DIN, C.G, C.bid);
        int pmA = -1, pmB = -1, pmC = -1, pmD = -1;
        { pg8::Unit uu;
          for (int i = 0; S.next(i, uu); ++i) { const int pmu = uu.pm;
              if (pmu == pmA || pmu == pmB || pmu == pmC || pmu == pmD) continue;
              if (pmA < 0) pmA = pmu; else if (pmB < 0) pmB = pmu; else if (pmC < 0) pmC = pmu; else if (pmD < 0) pmD = pmu; } }
        float* rtab = (float*)(lds + RING_BYTES);
        { const float* rowss = (const float*)(C.ws + WS_ROWSS);
#pragma unroll
          for (int k = 0; k < 2; ++k) { const int e = C.tid + 512 * k, sl = e >> 8, pmk = sl == 0 ? pmA : sl == 1 ? pmB : sl == 2 ? pmC : pmD;
              if (pmk >= 0) { const f32x4* rp = (const f32x4*)(rowss + ((size_t)pmk * 256 + (e & 255)) * 16); const f32x4 s0 = rp[0], s1 = rp[1], s2 = rp[2], s3 = rp[3];
                  const float ss = ((s0[0] + s0[1]) + (s0[2] + s0[3])) + ((s1[0] + s1[1]) + (s1[2] + s1[3])) + ((s2[0] + s2[1]) + (s2[2] + s2[3])) + ((s3[0] + s3[1]) + (s3[2] + s3[3]));
                  rtab[e] = 1.0f / sqrtf(ss * (1.0f / 1024.0f) + NORM_EPS); } }
          __syncthreads(); }
        pg8::EpiProj E{(pg8::bf16_t*)(C.ws + WS_PROJ), SUBSTRIDE, rtab, pmA, pmB, pmC, pmD, (float*)(C.ws + WS_KMEAN) + (size_t)L * NBH * NBLK * 64};
        pg8::gemm_phase<pg8::EpiProj, pg8::StaticOrder, true, true>((PG8_LAS unsigned char*)lds, g, S, E, C.tid);
    }
    else if constexpr (ST == 3) { phase_gate(C, L); phase_sgu(C, L); }
    else if constexpr (ST == 4) phase_attn(C, L);
    else if constexpr (ST == 5) phase_combine(C);
    else if constexpr (ST == 6) {
        pg8::Gemm g{(const pg8::bf16_t*)(C.ws + WS_MIX), (const pg8::bf16_t*)(C.ws + WS_WOUT) + (size_t)L * DM * DM, MROWS, DM, DM};
        pg8::StaticOrder S; S.init(MROWS, DM, C.G, C.bid);
        if (L == 0) { pg8::EpiRes E{(pg8::bf16_t*)(C.ws + WS_XB), (float*)(C.ws + WS_ROWSS)};
            pg8::gemm_phase<pg8::EpiRes, pg8::StaticOrder, true, true>((PG8_LAS unsigned char*)lds, g, S, E, C.tid); }
        else { pg8::EpiFinal E{(const pg8::bf16_t*)(C.ws + WS_XB), C.out, C.final_g, (float*)(C.ws + WS_ROWSS), (unsigned*)(C.ws + WS_CTL) + 8192};
            pg8::gemm_phase<pg8::EpiFinal, pg8::StaticOrder, true, true>((PG8_LAS unsigned char*)lds, g, S, E, C.tid); }
    } else if constexpr (ST == 7) phase_check_inject(C);
    else if constexpr (ST == 8) phase_attn_simple(C, (bf16*)(C.ws + 104 * MiB));
    else if constexpr (ST == 9) {
        const bf16* A = (const bf16*)(C.ws + WS_MIX); const bf16* B = (const bf16*)(C.ws + 104 * MiB); unsigned* flag = (unsigned*)(C.ws + WS_CTL) + 32;
        float md = 0.f;
        for (size_t idx = (size_t)C.bid * 512 + C.tid; idx < (size_t)MROWS * 512; idx += (size_t)C.G * 512) {
            const size_t row = idx >> 9, col = 512 + (idx & 511);
            const float a = __uint_as_float((unsigned)A[row * 1024 + col] << 16), r = __uint_as_float((unsigned)B[row * 1024 + col] << 16);
            float sc = fabsf(r);
#pragma unroll
            for (int o = 1; o < 64; o <<= 1) sc = fmaxf(sc, __shfl_xor(sc, o));
            const float d = fabsf(a - r) / (0.02f + sc);
            md = (d > md || !(d == d)) ? (d == d ? d : 1e6f) : md;
        }
        atomicMax(flag, __float_as_uint(md));
    }
}
template <int SEL> __global__ void __launch_bounds__(NWAVES * 64, 2) fwd(Args args) {
    extern __shared__ __attribute__((aligned(16))) unsigned char lds[];
    const int wave_s = __builtin_amdgcn_readfirstlane((int)threadIdx.x >> 6);
    if constexpr (SEL >= 0) run_stage<SEL>(args, lds, args.layer, wave_s);
    else {
        if (args.pad == 0x7fffffff) cg::this_grid().sync();
        volatile LAS unsigned* bst = (volatile LAS unsigned*)((LAS unsigned char*)lds + LDS_BARST);
        if (threadIdx.x == 0) { bst[0] = 0u; bst[1] = 0u; }
        __syncthreads();
        XcdBarrier bar = xcd_barrier_post((unsigned*)(args.ws + WS_CTL) + CW_BAR, bst);
#define GRID_SYNC() do { XcdBarrier b2_ = bar; asm volatile("" : "+s"(b2_.bar), "+s"(b2_.x)); xcd_barrier(b2_, wave_s == 0 && lane_now() == 0); } while (0)
#define RUN(k, L) do { run_stage<k>(args, lds, L, wave_s); GRID_SYNC(); } while (0)
        RUN(0, 0);
        for (int L = 0; L < DEPTH; ++L) {
            RUN(1, L); RUN(3, L); RUN(4, L); RUN(5, L);
            if (L == DEPTH - 1) run_stage<6>(args, lds, L, wave_s); else RUN(6, L);
        }
    }
}

#ifndef MK_N_LAUNCHES
#define MK_N_LAUNCHES 1
#endif
template <int SEL> static void launch_stage(int grid, Args a, int layer, hipStream_t stream) {
    static bool attr = false;
    if (!attr) { (void)hipFuncSetAttribute((const void*)fwd<SEL>, hipFuncAttributeMaxDynamicSharedMemorySize, LDS_BYTES); attr = true; }
    a.layer = layer;
    hipLaunchKernelGGL(fwd<SEL>, dim3(grid), dim3(NWAVES * 64), LDS_BYTES, stream, a);
}
extern "C" void kernel_launch(void* const* d_in, const int* in_sizes, int n_in, void* d_out, int out_size, void* d_ws, size_t ws_size, hipStream_t stream) {
    static int grid = 0;
    if (grid == 0) {
        if (n_in != 10 || out_size != MROWS * DM || ws_size < WS_END) { fprintf(stderr, "kernel_launch: unexpected shapes (n_in %d out %d ws %zu)\n", n_in, out_size, ws_size); grid = -1; return; }
        int dev = 0, cus = 0;
        (void)hipGetDevice(&dev); (void)hipDeviceGetAttribute(&cus, hipDeviceAttributeMultiprocessorCount, dev);
        grid = cus;
#if MK_N_LAUNCHES == 1
        int per_cu = 0;
        if (hipFuncSetAttribute((const void*)fwd<-1>, hipFuncAttributeMaxDynamicSharedMemorySize, LDS_BYTES) != hipSuccess) { fprintf(stderr, "kernel_launch: hipFuncSetAttribute failed\n"); grid = -1; return; }
        if (hipOccupancyMaxActiveBlocksPerMultiprocessor(&per_cu, (const void*)fwd<-1>, NWAVES * 64, LDS_BYTES) != hipSuccess || per_cu < 1) { fprintf(stderr, "kernel_launch: occupancy query says %d\n", per_cu); grid = -1; return; }
        (void)hipGetLastError();
#endif
    }
    if (grid < 0) return;
    (void)hipMemsetAsync((char*)d_ws + WS_CTL, 0, CTL_ZERO_BYTES, stream);
    Args a{};
    for (int i = 0; i < 10; ++i) a.in[i] = (const float*)d_in[i];
    a.out = (float*)d_out; a.ws = (unsigned char*)d_ws;
#if MK_N_LAUNCHES == 1
    void* kargs[] = {&a};
    hipError_t e = hipLaunchCooperativeKernel((const void*)fwd<-1>, dim3(grid), dim3(NWAVES * 64), kargs, LDS_BYTES, stream);
    if (e != hipSuccess) fprintf(stderr, "kernel_launch: cooperative launch failed: %s\n", hipGetErrorString(e));
#else
    launch_stage<0>(grid, a, 0, stream);
    for (int L = 0; L < DEPTH; ++L) {
        launch_stage<1>(grid, a, L, stream); launch_stage<3>(grid, a, L, stream);
        launch_stage<4>(grid, a, L, stream); launch_stage<5>(grid, a, L, stream);
        if (CHECK_ATTN && L == 0) { launch_stage<8>(grid, a, L, stream); launch_stage<9>(grid, a, L, stream); }
        launch_stage<6>(grid, a, L, stream);
    }
    if (CHECK_ATTN) launch_stage<7>(grid, a, 0, stream);
#endif
}
```

```cpp
#include <hip/hip_runtime.h>
#include <hip/hip_cooperative_groups.h>
#include <cstdio>
#include <cstdint>
namespace cg = cooperative_groups;

constexpr int BATCH = 2, SEQ = 16384, DM = 1024, MROWS = BATCH * SEQ, DIN = 3584, DSUB = 512;
constexpr int NH = 8, DH = 64, NBLK = SEQ / 256, NBH = BATCH * NH, DEPTH = 2;
constexpr float NORM_EPS = 1e-6f, LN_EPS = 1e-5f;
constexpr float LOG2E = 1.4426950408889634f;
#ifndef CHECK_ATTN
#define CHECK_ATTN 0
#endif
constexpr float QSCALE = 0.125f * LOG2E;
namespace pg8 {
#define PG8_LAS __attribute__((address_space(3)))
typedef unsigned short bf16_t;
typedef short bf16x8 __attribute__((ext_vector_type(8)));
typedef float f32x4 __attribute__((ext_vector_type(4)));
typedef unsigned u32x4 __attribute__((ext_vector_type(4)));
constexpr int BM = 256, BK = 64, HALF = 128, HTB = HALF * BK * 2  , STAGE_BYTES = 8 * HTB, NXCD = 8, WGM = 8;

__host__ __device__ __forceinline__ int lds_byte(int r, int c) { const int st = (r >> 4) * 2 + (c >> 5), rr = r & 15, cc = c & 31, ob = rr * 64 + cc * 2; return st * 1024 + (ob ^ (((ob >> 9) & 1) << 5)); }
__host__ __device__ __forceinline__ void stage_rc(int b, int& R, int& C) { const int st = b / 1024, sb = b % 1024, swz = sb ^ (((sb >> 9) & 1) << 5); R = (st >> 1) * 16 + swz / 64; C = (st & 1) * 32 + (swz % 64) / 2; }
__host__ __device__ __forceinline__ int perm32(int rho) { const int n = rho >> 4, i = rho & 15; return 8 * (i >> 2) + 4 * n + (i & 3); }

struct Unit { int pm, pn; };
struct Gemm { const bf16_t* A; const bf16_t* Bt; int M, N, K; };

struct StaticOrder {
    int nM, nN, nwg, G, c;
    __host__ __device__ void init(int M, int N, int G_, int c_) { nM = M / BM; nN = N / BM; nwg = nM * nN; G = G_; c = c_; }
    __host__ __device__ bool next(int i, Unit& u) const {
        const long L = (long)i * G + c; if (L >= nwg) return false;
        int wgid = (int)L; { const int q = nwg / NXCD, r = nwg % NXCD, xcd = wgid % NXCD, off = wgid / NXCD; wgid = (xcd < r ? xcd * (q + 1) : r * (q + 1) + (xcd - r) * q) + off; }
        const int nig = WGM * nN, gid = wgid / nig, fm = gid * WGM, gsz = (nM - fm) < WGM ? (nM - fm) : WGM;
        u.pm = fm + ((wgid % nig) % gsz); u.pn = (wgid % nig) / gsz; return true;
    }
    __device__ __forceinline__ void a_ready(const Unit&) const {}
    __device__ __forceinline__ void done(const Unit&) const {}
};

__device__ __forceinline__ unsigned cvt_pk_bf16(float lo, float hi) { unsigned r; asm volatile("v_cvt_pk_bf16_f32 %0, %1, %2" : "=v"(r) : "v"(lo), "v"(hi)); return r; }
typedef float f32x2 __attribute__((ext_vector_type(2)));
typedef float f32x2 __attribute__((ext_vector_type(2)));
__device__ __forceinline__ float act_gelu(float x) {
    const float u = x * (1.0f + 0.044715f * x * x);
    const float e = __builtin_amdgcn_exp2f(u * (-2.0f * 0.7978845608028654f * 1.4426950408889634f));
    return x * __builtin_amdgcn_rcpf(1.0f + e);
}
__device__ __forceinline__ float act_silu(float x) {
    const float e = __builtin_amdgcn_exp2f(x * (-1.4426950408889634f));
    return x * __builtin_amdgcn_rcpf(1.0f + e);
}
struct EpiProj {
    static constexpr bool PERM = true, AFTER_DRAIN = false;
    bf16_t* P; size_t sub_stride; const float* rstd_lds; int pm0, pm1, pm2, pm3; float* kmean;
    __device__ __forceinline__ void operator()(const f32x4 (&acc)[2][2][4][2], const Unit& u, int wr, int wc, int fr, int fq) const {
        const int t = u.pn >> 1;
        bf16_t* base = P + (size_t)t * sub_stride;
        const int col0 = (u.pn & 1) * 256 + wc * 32 + 8 * fq;
        const int row0 = u.pm * BM + wr * 64 + fr;
        const int slot = (u.pm == pm0) ? 0 : (u.pm == pm1) ? 1 : (u.pm == pm2) ? 2 : 3;
        const float* rt = rstd_lds + slot * 256 + wr * 64 + fr;
        const float qs = (t == 3) ? (0.125f * 1.4426950408889634f) : 1.0f;
        float ks[2][8];
#pragma unroll
        for (int bj = 0; bj < 2; ++bj)
#pragma unroll
            for (int e = 0; e < 8; ++e) ks[bj][e] = 0.f;
#pragma unroll
        for (int ai = 0; ai < 2; ++ai)
#pragma unroll
            for (int m = 0; m < 4; ++m) {
                const int row = row0 + ai * HALF + m * 16;
                const float rs = rt[ai * HALF + m * 16] * qs;
                bf16_t* rowp = base + (size_t)row * 512 + col0;
#pragma unroll
                for (int bj = 0; bj < 2; ++bj) {
                    const f32x4 v0 = acc[ai][bj][m][0] * rs, v1 = acc[ai][bj][m][1] * rs;
                    if (t == 4) {
#pragma unroll
                        for (int e = 0; e < 4; ++e) { ks[bj][e] += v0[e]; ks[bj][4 + e] += v1[e]; }
                    }
                    u32x4 w; w.x = cvt_pk_bf16(v0[0], v0[1]); w.y = cvt_pk_bf16(v0[2], v0[3]); w.z = cvt_pk_bf16(v1[0], v1[1]); w.w = cvt_pk_bf16(v1[2], v1[3]);
                    *(u32x4*)(rowp + bj * HALF) = w;
                }
            }
        if (t == 4) {
            const int b = u.pm >> 6, n = u.pm & 63;
#pragma unroll
            for (int bj = 0; bj < 2; ++bj)
#pragma unroll
                for (int e = 0; e < 8; ++e) {
                    float v = ks[bj][e];
                    v += __shfl_xor(v, 1); v += __shfl_xor(v, 2); v += __shfl_xor(v, 4); v += __shfl_xor(v, 8);
                    if (fr == 0) { const int col = col0 + bj * HALF + e; atomicAdd(kmean + ((size_t)((b * 8 + (col >> 6)) * 64 + n)) * 64 + (col & 63), v * (1.0f / 256.0f)); }
                }
        }
    }
};
#define PG8_GAS __attribute__((address_space(1)))
struct EpiRes {
    static constexpr bool PERM = false, AFTER_DRAIN = false;
    bf16_t* xb; float* rowss;
    __device__ __forceinline__ void operator()(const f32x4 (&acc)[2][2][4][2], const Unit& u, int wr, int wc, int fr, int fq) const {
        typedef unsigned u32x2v __attribute__((ext_vector_type(2)));
        const int col0 = u.pn * BM + wc * 32 + 4 * fq;
        PG8_GAS bf16_t* xbg = (PG8_GAS bf16_t*)xb; PG8_GAS float* rsg = (PG8_GAS float*)rowss;
        const size_t offb = (size_t)(u.pm * BM + wr * 64 + fr) * 1024 + col0;
        u32x2v rr[2][4][2][2];
#pragma unroll
        for (int ai = 0; ai < 2; ++ai)
#pragma unroll
            for (int m = 0; m < 4; ++m)
#pragma unroll
                for (int bj = 0; bj < 2; ++bj)
#pragma unroll
                    for (int n = 0; n < 2; ++n) rr[ai][m][bj][n] = *(const PG8_GAS u32x2v*)(xbg + offb + (size_t)(ai * HALF + m * 16) * 1024 + bj * HALF + n * 16);
#pragma unroll
        for (int ai = 0; ai < 2; ++ai)
#pragma unroll
            for (int m = 0; m < 4; ++m) {
                const int row = u.pm * BM + ai * HALF + wr * 64 + m * 16 + fr;
                float ss = 0.f;
#pragma unroll
                for (int bj = 0; bj < 2; ++bj)
#pragma unroll
                    for (int n = 0; n < 2; ++n) {
                        const u32x2v w0 = rr[ai][m][bj][n];
                        const f32x4 r = (f32x4){__uint_as_float(w0.x << 16), __uint_as_float(w0.x & 0xffff0000u), __uint_as_float(w0.y << 16), __uint_as_float(w0.y & 0xffff0000u)};
                        const f32x4 o = r + acc[ai][bj][m][n];
                        ss += (o[0] * o[0] + o[1] * o[1]) + (o[2] * o[2] + o[3] * o[3]);
                        u32x2v w; w.x = cvt_pk_bf16(o[0], o[1]); w.y = cvt_pk_bf16(o[2], o[3]);
                        *(PG8_GAS u32x2v*)(xbg + offb + (size_t)(ai * HALF + m * 16) * 1024 + bj * HALF + n * 16) = w;
                    }
                ss += __shfl_xor(ss, 16); ss += __shfl_xor(ss, 32);
                if (fq == 0) rsg[(size_t)row * 16 + u.pn * 4 + wc] = ss;
            }
    }
};
struct EpiFinal {
    static constexpr bool PERM = false, AFTER_DRAIN = false;
    const bf16_t* xb; float* out; const float* fg; float* slots; unsigned* cnt;
    __device__ __forceinline__ void operator()(f32x4 (&acc)[2][2][4][2], const Unit& u, int wr, int wc, int fr, int fq) const {
        typedef unsigned u32x2v __attribute__((ext_vector_type(2)));
        const int col0 = u.pn * BM + wc * 32 + 4 * fq;
        const PG8_GAS bf16_t* xbg = (const PG8_GAS bf16_t*)xb; PG8_GAS float* outg = (PG8_GAS float*)out; const PG8_GAS float* slg = (const PG8_GAS float*)slots;
        const size_t offb = (size_t)(u.pm * BM + wr * 64 + fr) * 1024 + col0;
        u32x2v rr[2][4][2][2];
#pragma unroll
        for (int ai = 0; ai < 2; ++ai)
#pragma unroll
            for (int m = 0; m < 4; ++m)
#pragma unroll
                for (int bj = 0; bj < 2; ++bj)
#pragma unroll
                    for (int n = 0; n < 2; ++n) rr[ai][m][bj][n] = *(const PG8_GAS u32x2v*)(xbg + offb + (size_t)(ai * HALF + m * 16) * 1024 + bj * HALF + n * 16);
#pragma unroll
        for (int ai = 0; ai < 2; ++ai)
#pragma unroll
            for (int m = 0; m < 4; ++m) {
                const int row = u.pm * BM + ai * HALF + wr * 64 + m * 16 + fr;
                float ss = 0.f;
#pragma unroll
                for (int bj = 0; bj < 2; ++bj)
#pragma unroll
                    for (int n = 0; n < 2; ++n) {
                        const u32x2v w = rr[ai][m][bj][n];
                        const f32x4 r = (f32x4){__uint_as_float(w.x << 16), __uint_as_float(w.x & 0xffff0000u), __uint_as_float(w.y << 16), __uint_as_float(w.y & 0xffff0000u)};
                        const f32x4 o = r + acc[ai][bj][m][n];
                        acc[ai][bj][m][n] = o;
                        ss += (o[0] * o[0] + o[1] * o[1]) + (o[2] * o[2] + o[3] * o[3]);
                    }
                ss += __shfl_xor(ss, 16); ss += __shfl_xor(ss, 32);
                if (fq == 0) __hip_atomic_store(slots + (size_t)row * 16 + u.pn * 4 + wc, ss, __ATOMIC_RELAXED, __HIP_MEMORY_SCOPE_AGENT);
            }
        asm volatile("s_waitcnt vmcnt(0)" ::: "memory");
        unsigned* pc = cnt + 64 * u.pm;
        if (fr == 0 && fq == 0) __hip_atomic_fetch_add(pc, 1u, __ATOMIC_RELAXED, __HIP_MEMORY_SCOPE_AGENT);
        f32x4 g4[2][2];
#pragma unroll
        for (int bj = 0; bj < 2; ++bj)
#pragma unroll
            for (int n = 0; n < 2; ++n) g4[bj][n] = *(const PG8_GAS f32x4*)((const PG8_GAS float*)fg + col0 + bj * HALF + n * 16);
        for (unsigned spins = 0; spins < (1u << 22); ++spins) {
            if (__hip_atomic_load(pc, __ATOMIC_RELAXED, __HIP_MEMORY_SCOPE_AGENT) >= 32u) break;
            __builtin_amdgcn_s_sleep(2);
        }
        __builtin_amdgcn_fence(__ATOMIC_ACQUIRE, "agent");
        asm volatile("s_waitcnt vmcnt(0)" ::: "memory");
#pragma unroll
        for (int ai = 0; ai < 2; ++ai) {
            f32x4 sl[4][4];
#pragma unroll
            for (int m = 0; m < 4; ++m)
#pragma unroll
                for (int k = 0; k < 4; ++k) sl[m][k] = *(const PG8_GAS f32x4*)(slg + (size_t)(u.pm * BM + ai * HALF + wr * 64 + m * 16 + fr) * 16 + k * 4);
#pragma unroll
            for (int m = 0; m < 4; ++m) {
                const f32x4 s0 = sl[m][0], s1 = sl[m][1], s2 = sl[m][2], s3 = sl[m][3];
                const float tot = ((s0[0] + s0[1]) + (s0[2] + s0[3])) + ((s1[0] + s1[1]) + (s1[2] + s1[3])) + ((s2[0] + s2[1]) + (s2[2] + s2[3])) + ((s3[0] + s3[1]) + (s3[2] + s3[3]));
                const float rs = 1.0f / sqrtf(tot * (1.0f / 1024.0f) + 1e-6f);
#pragma unroll
                for (int bj = 0; bj < 2; ++bj)
#pragma unroll
                    for (int n = 0; n < 2; ++n) *(PG8_GAS f32x4*)(outg + offb + (size_t)(ai * HALF + m * 16) * 1024 + bj * HALF + n * 16) = acc[ai][bj][m][n] * rs * g4[bj][n];
            }
        }
    }
};
template <class Epi, class Sched, bool ALIGN_EPI = false, bool SP2 = false>
__device__ __forceinline__ void gemm_phase(PG8_LAS unsigned char* lds, const Gemm g, const Sched& S, const Epi& E, const int tid) {
    const int wid = __builtin_amdgcn_readfirstlane(tid >> 6), lane = tid & 63, wr = wid >> 2, wc = wid & 3, fr = lane & 15, fq = lane >> 4;
    const int K = g.K, nt = K / BK;
    unsigned voffA[2], voffB[2];
#pragma unroll
    for (int i = 0; i < 2; ++i) { int R, C; stage_rc(tid * 16 + i * 8192, R, C); const int Rb = Epi::PERM ? ((R & ~31) + perm32(R & 31)) : R;
        voffA[i] = (unsigned)(R * K + C) * 2u; voffB[i] = (unsigned)(Rb * K + C) * 2u; }
    const size_t kstep = (size_t)(BK * 2);
    const size_t hstep = (size_t)HALF * K * 2;
    const size_t tstep = 2 * hstep;
    const unsigned ldsw = (unsigned)wid * 1024u;
    const int aoff = lds_byte(wr * 64 + fr, fq * 8), boff = lds_byte(wc * 32 + fr, fq * 8);
#define PG8_SA(b, h) (((b) * 2 + (h)) * HTB)
#define PG8_SB(b, h) ((4 + (b) * 2 + (h)) * HTB)
#define PG8_STAGE(bufoff, gbase, voff) do { _Pragma("unroll") for (int _i = 0; _i < 2; ++_i) \
        __builtin_amdgcn_global_load_lds((const unsigned*)((const char*)(gbase) + (voff)[_i]), (PG8_LAS unsigned*)(lds + (bufoff) + ldsw + _i * 8192), 16, 0, 0); } while (0)
#define PG8_LDA(dst, b, h) do { _Pragma("unroll") for (int m = 0; m < 4; ++m) _Pragma("unroll") for (int k = 0; k < 2; ++k) dst[m][k] = *(const PG8_LAS bf16x8*)(lds + PG8_SA(b, h) + aoff + m * 2048 + k * 1024); } while (0)
#define PG8_LDB(dst, b, h) do { _Pragma("unroll") for (int n = 0; n < 2; ++n) _Pragma("unroll") for (int k = 0; k < 2; ++k) dst[n][k] = *(const PG8_LAS bf16x8*)(lds + PG8_SB(b, h) + boff + n * 2048 + k * 1024); } while (0)
#define PG8_MMA(ai, bj, At, Bt) do { __builtin_amdgcn_s_setprio(1); _Pragma("unroll") for (int m = 0; m < 4; ++m) _Pragma("unroll") for (int n = 0; n < 2; ++n) _Pragma("unroll") for (int k = 0; k < 2; ++k) \
        acc[ai][bj][m][n] = __builtin_amdgcn_mfma_f32_16x16x32_bf16(Bt[n][k], At[m][k], acc[ai][bj][m][n], 0, 0, 0); __builtin_amdgcn_s_setprio(0); } while (0)
#define PG8_WAIT_V(n) asm volatile("s_waitcnt vmcnt(" #n ")" ::: "memory")
#define PG8_WAIT_L(n) asm volatile("s_waitcnt lgkmcnt(" #n ")" ::: "memory")
#define PG8_BAR __builtin_amdgcn_s_barrier()
#define PG8_SCHED __builtin_amdgcn_sched_barrier(0)
    Unit cur, nxt; int ui = 0;
    if (!S.next(0, cur)) return;
    f32x4 acc[2][2][4][2];
#pragma unroll
    for (int a = 0; a < 2; ++a)
#pragma unroll
        for (int b = 0; b < 2; ++b)
#pragma unroll
            for (int m = 0; m < 4; ++m)
#pragma unroll
                for (int n = 0; n < 2; ++n) acc[a][b][m][n] = (f32x4){0.f, 0.f, 0.f, 0.f};
    bf16x8 At[4][2], B0[2][2], B1[2][2];
    const char* cA = (const char*)g.A + (size_t)cur.pm * tstep; const char* cB = (const char*)g.Bt + (size_t)cur.pn * tstep;
    S.a_ready(cur);
    if constexpr (SP2) {
        PG8_STAGE(PG8_SB(0, 0), cB, voffB); PG8_STAGE(PG8_SB(0, 1), cB + hstep, voffB); PG8_STAGE(PG8_SA(0, 0), cA, voffA); PG8_STAGE(PG8_SA(0, 1), cA + hstep, voffA);
        if (wr == 1) PG8_BAR;
        PG8_WAIT_V(2); PG8_BAR;
        PG8_STAGE(PG8_SB(1, 0), cB + kstep, voffB); PG8_STAGE(PG8_SA(1, 0), cA + kstep, voffA); PG8_STAGE(PG8_SB(1, 1), cB + hstep + kstep, voffB);
        PG8_WAIT_V(6); PG8_BAR;
    } else {
        PG8_STAGE(PG8_SB(0, 0), cB, voffB); PG8_STAGE(PG8_SA(0, 0), cA, voffA); PG8_STAGE(PG8_SB(0, 1), cB + hstep, voffB); PG8_STAGE(PG8_SA(0, 1), cA + hstep, voffA);
        if (wr == 1) PG8_BAR;
        PG8_WAIT_V(4); PG8_BAR;
        PG8_STAGE(PG8_SB(1, 0), cB + kstep, voffB); PG8_STAGE(PG8_SA(1, 0), cA + kstep, voffA); PG8_STAGE(PG8_SB(1, 1), cB + hstep + kstep, voffB);
        PG8_WAIT_V(6); PG8_BAR;
    }
    for (;;) {
        const bool has_next = S.next(ui + 1, nxt);
        const char* nA = has_next ? (const char*)g.A + (size_t)nxt.pm * tstep : cA; const char* nB = has_next ? (const char*)g.Bt + (size_t)nxt.pn * tstep : cB;
        for (int t = 0; t < nt; t += 2) {
            const bool last = (t == nt - 2);
            const char* a1 = cA + (size_t)(t + 1) * kstep;
            const char* a2 = last ? nA : cA + (size_t)(t + 2) * kstep; const char* b2 = last ? nB : cB + (size_t)(t + 2) * kstep;
            const char* a3 = a2 + kstep; const char* b3 = b2 + kstep;
            if (last && has_next) S.a_ready(nxt);
            if constexpr (SP2) {
            PG8_LDB(B0, 0, 0); PG8_LDB(B1, 0, 1); PG8_SCHED; PG8_LDA(At, 0, 0); PG8_STAGE(PG8_SA(1, 1), a1 + hstep, voffA);
            PG8_WAIT_V(8); PG8_WAIT_L(0); PG8_BAR; PG8_MMA(0, 0, At, B0); PG8_MMA(0, 1, At, B1); PG8_BAR; PG8_SCHED;
            PG8_LDA(At, 0, 1); PG8_STAGE(PG8_SB(0, 0), b2, voffB); PG8_STAGE(PG8_SB(0, 1), b2 + hstep, voffB); PG8_STAGE(PG8_SA(0, 0), a2, voffA);
            PG8_WAIT_V(8); PG8_WAIT_L(0); PG8_BAR; PG8_MMA(1, 0, At, B0); PG8_MMA(1, 1, At, B1); PG8_BAR; PG8_SCHED;
            PG8_LDB(B0, 1, 0); PG8_LDB(B1, 1, 1); PG8_SCHED; PG8_LDA(At, 1, 0); PG8_STAGE(PG8_SA(0, 1), a2 + hstep, voffA);
            PG8_WAIT_V(8); PG8_WAIT_L(0); PG8_BAR; PG8_MMA(0, 0, At, B0); PG8_MMA(0, 1, At, B1); PG8_BAR; PG8_SCHED;
            PG8_LDA(At, 1, 1); PG8_STAGE(PG8_SB(1, 0), b3, voffB); PG8_STAGE(PG8_SB(1, 1), b3 + hstep, voffB); PG8_STAGE(PG8_SA(1, 0), a3, voffA);
            PG8_WAIT_V(8); PG8_WAIT_L(0); PG8_BAR; PG8_MMA(1, 0, At, B0); PG8_MMA(1, 1, At, B1); PG8_BAR; PG8_SCHED;
            } else {
            PG8_LDB(B0, 0, 0); PG8_SCHED; PG8_LDA(At, 0, 0); PG8_STAGE(PG8_SA(1, 1), a1 + hstep, voffA);
            PG8_WAIT_L(8); PG8_BAR; PG8_WAIT_L(0); PG8_MMA(0, 0, At, B0); PG8_BAR; PG8_SCHED;
            PG8_LDB(B1, 0, 1); PG8_STAGE(PG8_SB(0, 0), b2, voffB);
            PG8_BAR; PG8_WAIT_L(0); PG8_MMA(0, 1, At, B1); PG8_BAR;
            PG8_LDA(At, 0, 1); PG8_STAGE(PG8_SA(0, 0), a2, voffA);
            PG8_BAR; PG8_WAIT_L(0); PG8_MMA(1, 0, At, B0); PG8_BAR; PG8_SCHED;
            PG8_STAGE(PG8_SB(0, 1), b2 + hstep, voffB);
            PG8_WAIT_V(6); PG8_BAR; PG8_MMA(1, 1, At, B1); PG8_BAR;
            PG8_LDB(B0, 1, 0); PG8_SCHED; PG8_LDA(At, 1, 0); PG8_STAGE(PG8_SA(0, 1), a2 + hstep, voffA);
            PG8_WAIT_L(8); PG8_BAR; PG8_WAIT_L(0); PG8_MMA(0, 0, At, B0); PG8_BAR; PG8_SCHED;
            PG8_LDB(B1, 1, 1); PG8_STAGE(PG8_SB(1, 0), b3, voffB);
            PG8_BAR; PG8_WAIT_L(0); PG8_MMA(0, 1, At, B1); PG8_BAR;
            PG8_LDA(At, 1, 1); PG8_STAGE(PG8_SA(1, 0), a3, voffA);
            PG8_BAR; PG8_WAIT_L(0); PG8_MMA(1, 0, At, B0); PG8_BAR; PG8_SCHED;
            PG8_STAGE(PG8_SB(1, 1), b3 + hstep, voffB);
            PG8_WAIT_V(6); PG8_BAR; PG8_MMA(1, 1, At, B1); PG8_BAR;
            }
        }
        if constexpr (ALIGN_EPI) { if (wr == 0) PG8_BAR; }
        if constexpr (!Epi::AFTER_DRAIN) { int ln_; asm volatile("v_mbcnt_lo_u32_b32 %0, -1, 0\n\tv_mbcnt_hi_u32_b32 %0, -1, %0" : "=v"(ln_)); E(acc, cur, wr, wc, ln_ & 15, ln_ >> 4); S.done(cur); }
        if (!has_next) break;
#pragma unroll
        for (int a = 0; a < 2; ++a)
#pragma unroll
            for (int b = 0; b < 2; ++b)
#pragma unroll
                for (int m = 0; m < 4; ++m)
#pragma unroll
                    for (int n = 0; n < 2; ++n) acc[a][b][m][n] = (f32x4){0.f, 0.f, 0.f, 0.f};
        cur = nxt; cA = nA; cB = nB; ++ui;
        if constexpr (ALIGN_EPI) { if (wr == 1) PG8_BAR; }
    }
    PG8_WAIT_V(0);
    if constexpr (!ALIGN_EPI) { if (wr == 0) PG8_BAR; }
    PG8_BAR;
    if constexpr (Epi::AFTER_DRAIN) { E.fused(acc, cur, wr, wc, fr, fq, lds, wid, lane); S.done(cur); }
#undef PG8_SA
#undef PG8_SB
#undef PG8_STAGE
#undef PG8_LDA
#undef PG8_LDB
#undef PG8_MMA
#undef PG8_WAIT_V
#undef PG8_WAIT_L
#undef PG8_BAR
#undef PG8_SCHED
}
}

constexpr size_t MiB = 1u << 20;
constexpr size_t WS_CTL = 0, CTL_ZERO_BYTES = 1 * MiB;
constexpr size_t WS_WIN = 2 * MiB;
constexpr size_t WS_WOUT = 16 * MiB;
constexpr size_t WS_WST = 20 * MiB;
constexpr size_t WS_BT = 21 * MiB;
constexpr size_t WS_KMEAN = 22 * MiB;
constexpr size_t WS_LOFF = 23 * MiB;
constexpr size_t WS_ROWSS = 24 * MiB;
constexpr size_t WS_PL = 26 * MiB;
constexpr size_t WS_LIST = 30 * MiB;
constexpr size_t WS_SEL = 32 * MiB;
constexpr size_t WS_XB = 40 * MiB;
constexpr size_t WS_PROJ = 168 * MiB;
constexpr size_t WS_MIX = 392 * MiB;
constexpr size_t WS_END = 456 * MiB;
constexpr size_t SUBSTRIDE = (size_t)MROWS * 512;
enum { T_U = 0, T_V = 1, T_ZA = 2, T_Q = 3, T_K = 4, T_VV = 5, T_ZB = 6 };

constexpr int NWAVES = 8;
constexpr int LDS_BYTES = 160 * 1024;
constexpr int RING_BYTES = 131072;

#define LAS __attribute__((address_space(3)))
typedef unsigned short bf16;
typedef unsigned v4u __attribute__((ext_vector_type(4)));
typedef float f32x4 __attribute__((ext_vector_type(4)));
#define LDS_WAIT() asm volatile("s_waitcnt lgkmcnt(0)" ::: "memory")
__device__ __forceinline__ unsigned f2bf(float f) { unsigned u = __builtin_bit_cast(unsigned, f); return (u + 0x7fffu + ((u >> 16) & 1u)) >> 16; }
__device__ __forceinline__ unsigned pk2(float lo, float hi) { return f2bf(lo) | (f2bf(hi) << 16); }
__device__ __forceinline__ float bflo(unsigned w) { return __uint_as_float(w << 16); }
__device__ __forceinline__ float bfhi(unsigned w) { return __uint_as_float(w & 0xffff0000u); }
__device__ __forceinline__ float wave_sum(float v) {
#pragma unroll
    for (int o = 1; o < 64; o <<= 1) v += __shfl_xor(v, o);
    return v;
}

__device__ __forceinline__ int lane_now() { int l; asm volatile("v_mbcnt_lo_u32_b32 %0, -1, 0\n\tv_mbcnt_hi_u32_b32 %0, -1, %0" : "=v"(l)); return l; }
struct Args { const float* in[10]; float* out; unsigned char* ws; int layer, pad; };

struct Ctx {
    unsigned char* lds;
    int tid, lane, wave, G, bid;
    const float *x, *norm_g, *w_in, *ln_g, *ln_b, *sgu_w, *sgu_b, *w_out, *rel_bias, *final_g;
    float* out; unsigned char* ws;
};

__device__ __forceinline__ void p0_transpose_item(const float* W, const float* gs, int K, int N, bf16* WT, float* scr, int item, int lane) {
    const int nblk = N / 32, kb = item / nblk, nb = item % nblk, k0 = 64 * kb, n0 = 32 * nb;
    float wv[32];
#pragma unroll
    for (int i = 0; i < 32; ++i) wv[i] = W[(size_t)(k0 + 2 * i + (lane >> 5)) * N + n0 + (lane & 31)];
#pragma unroll
    for (int i = 0; i < 32; ++i) { const int kk = 2 * i + (lane >> 5); const float sc = gs ? gs[k0 + kk] : 1.0f; scr[kk * 33 + (lane & 31)] = wv[i] * sc; }
    LDS_WAIT(); asm volatile("" ::: "memory");
    const int c = lane & 7;
#pragma unroll
    for (int j = 0; j < 4; ++j) { const int n = (lane >> 3) + 8 * j; const float* s = scr + (8 * c) * 33 + n;
        v4u o; o.x = pk2(s[0 * 33], s[1 * 33]); o.y = pk2(s[2 * 33], s[3 * 33]); o.z = pk2(s[4 * 33], s[5 * 33]); o.w = pk2(s[6 * 33], s[7 * 33]);
        *(v4u*)(WT + (size_t)(n0 + n) * K + k0 + 8 * c) = o; }
    LDS_WAIT(); asm volatile("" ::: "memory");
}
__device__ __forceinline__ int rel_bucket(int d) {
    if (d < 16) return d;
    int b = 16;
    b += (d >= 19); b += (d >= 21); b += (d >= 24); b += (d >= 27); b += (d >= 31); b += (d >= 35); b += (d >= 40); b += (d >= 46);
    b += (d >= 52); b += (d >= 59); b += (d >= 67); b += (d >= 77); b += (d >= 87); b += (d >= 99); b += (d >= 113);
    return b;
}
__device__ __forceinline__ void phase_prologue(const Ctx& C) {
    float* scr = (float*)(C.lds + C.wave * 16384);
    const int gw = C.bid * NWAVES + C.wave, NGW = C.G * NWAVES;
    constexpr int I_IN = (DM / 64) * (DIN / 32), I_OUT = (DM / 64) * (DM / 32);
    constexpr int NITEMS = DEPTH * (I_IN + I_OUT);
    for (int it = gw; it < NITEMS; it += NGW) {
        const int l = it / (I_IN + I_OUT); int r = it % (I_IN + I_OUT);
        if (r < I_IN) p0_transpose_item(C.w_in + (size_t)l * DM * DIN, C.norm_g + l * DM, DM, DIN, (bf16*)(C.ws + WS_WIN) + (size_t)l * DIN * DM, scr, r, C.lane);
        else p0_transpose_item(C.w_out + (size_t)l * DM * DM, nullptr, DM, DM, (bf16*)(C.ws + WS_WOUT) + (size_t)l * DM * DM, scr, r - I_IN, C.lane);
    }
    { float* km = (float*)(C.ws + WS_KMEAN); for (int e = C.bid * 512 + C.tid; e < DEPTH * NBH * NBLK * 64; e += C.G * 512) km[e] = 0.f; }
    { bf16* wst = (bf16*)(C.ws + WS_WST); const int gt = C.bid * 512 + C.tid, NT = C.G * 512;
      for (int e = gt; e < DEPTH * 8 * 128 * 128; e += NT) { const int s = e & 127, t = (e >> 7) & 127; wst[e] = (s <= t) ? (bf16)f2bf(C.sgu_w[e]) : (bf16)0; } }
    if (C.bid == 0) { float* bt = (float*)(C.ws + WS_BT); for (int e = C.tid; e < 8 * 128; e += 512) { const int h = e >> 7, d = e & 127; bt[e] = C.rel_bias[rel_bucket(d) * 8 + h] * LOG2E; } }
    { bf16* xb = (bf16*)(C.ws + WS_XB); float* rowss = (float*)(C.ws + WS_ROWSS);
      constexpr int UN = 4;
      for (int m0 = gw; m0 < MROWS; m0 += NGW * UN) {
        f32x4 v[UN][4];
#pragma unroll
        for (int k = 0; k < UN; ++k) { const f32x4* xr = (const f32x4*)(C.x + (size_t)(m0 + k * NGW) * DM) + C.lane;
#pragma unroll
            for (int j = 0; j < 4; ++j) v[k][j] = xr[64 * j]; }
#pragma unroll
        for (int k = 0; k < UN; ++k) { const int m = m0 + k * NGW;
            float s = 0.f;
#pragma unroll
            for (int j = 0; j < 4; ++j) s += (v[k][j].x * v[k][j].x + v[k][j].y * v[k][j].y) + (v[k][j].z * v[k][j].z + v[k][j].w * v[k][j].w);
            s = wave_sum(s);
            unsigned long long* o8 = (unsigned long long*)(xb + (size_t)m * DM) + C.lane;
#pragma unroll
            for (int j = 0; j < 4; ++j) o8[64 * j] = (unsigned long long)pk2(v[k][j].x, v[k][j].y) | ((unsigned long long)pk2(v[k][j].z, v[k][j].w) << 32);
            if (C.lane < 16) rowss[(size_t)m * 16 + C.lane] = (C.lane == 0) ? s : 0.f; }
      } }
}

typedef short bf16x8 __attribute__((ext_vector_type(8)));
typedef short bf16x4s __attribute__((ext_vector_type(4)));
typedef float f32x16 __attribute__((ext_vector_type(16)));
__device__ __forceinline__ int crow(int r, int hi) { return (r & 3) + 8 * (r >> 2) + 4 * hi; }
__device__ __forceinline__ unsigned cvtpk(float lo, float hi) { unsigned r; asm volatile("v_cvt_pk_bf16_f32 %0, %1, %2" : "=v"(r) : "v"(lo), "v"(hi)); return r; }
__device__ __forceinline__ void phase_gate(const Ctx& C, int layer) {
    const bf16* Q = (const bf16*)(C.ws + WS_PROJ) + (size_t)T_Q * SUBSTRIDE;
    const float* KM = (const float*)(C.ws + WS_KMEAN) + (size_t)layer * NBH * NBLK * 64;
    int* SEL = (int*)(C.ws + WS_SEL); int* LOFF = (int*)(C.ws + WS_LOFF); unsigned short* LIST = (unsigned short*)(C.ws + WS_LIST);
    int* cnt = (int*)(C.lds);
    int* offs = (int*)(C.lds + 256);
    unsigned char* kml = C.lds + 1024;
    const int lane = C.lane, ql = lane & 31, hi = lane >> 5;
    bf16x8 qfN[4]; f32x4 kmr[2];
#define GATE_LOAD(uu) do { const int bh_ = (uu) / 63, i_ = (uu) % 63 + 1, b_ = bh_ >> 3, h_ = bh_ & 7; \
        const bf16* qrow_ = Q + ((size_t)(b_ * SEQ + i_ * 256 + C.wave * 32 + ql)) * 512 + h_ * 64 + hi * 8; \
        _Pragma("unroll") for (int ks = 0; ks < 4; ++ks) qfN[ks] = *(const bf16x8*)(qrow_ + ks * 16); \
        const float* kp_ = KM + (size_t)bh_ * NBLK * 64 + C.tid * 8; kmr[0] = *(const f32x4*)kp_; kmr[1] = *(const f32x4*)(kp_ + 4); } while (0)
#define GATE_KML() do { *(v4u*)(kml + (C.tid >> 3) * 144 + (C.tid & 7) * 16) = (v4u){cvtpk(kmr[0][0], kmr[0][1]), cvtpk(kmr[0][2], kmr[0][3]), cvtpk(kmr[1][0], kmr[1][1]), cvtpk(kmr[1][2], kmr[1][3])}; } while (0)
    int u = C.bid;
    if (C.tid < 64) cnt[C.tid] = 0;
    if (u < NBH * 63) { GATE_LOAD(u); GATE_KML(); }
    __syncthreads();
    for (; u < NBH * 63; u += C.G) {
        const int bh = u / 63, i = u % 63 + 1;
        const int q = C.wave * 32 + ql, pos = i * 256 + q;
        bf16x8 qf[4];
#pragma unroll
        for (int ks = 0; ks < 4; ++ks) qf[ks] = qfN[ks];
        const bool more = u + C.G < NBH * 63;
        if (more) GATE_LOAD(u + C.G);
        float b0 = -INFINITY, b1 = -INFINITY, b2 = -INFINITY; int i0 = -1, i1 = -1, i2 = -1;
#define TOP3_INS(v, idx) do { const float v_ = (v); const int x_ = (idx); if (v_ > b0) { b2 = b1; i2 = i1; b1 = b0; i1 = i0; b0 = v_; i0 = x_; } else if (v_ > b1) { b2 = b1; i2 = i1; b1 = v_; i1 = x_; } else if (v_ > b2) { b2 = v_; i2 = x_; } } while (0)
#pragma unroll
        for (int nt = 0; nt < 2; ++nt) {
            f32x16 p = {};
#pragma unroll
            for (int ks = 0; ks < 4; ++ks) {
                const bf16x8 kw = *(const bf16x8*)(kml + (32 * nt + ql) * 144 + ks * 32 + hi * 16);
                p = __builtin_amdgcn_mfma_f32_32x32x16_bf16(kw, qf[ks], p, 0, 0, 0);
            }
#pragma unroll
            for (int r = 0; r < 16; ++r) { const int n = 32 * nt + crow(r, hi); if (n < i) TOP3_INS(p[r], n); }
        }
        { const float c0 = __shfl_xor(b0, 32), c1 = __shfl_xor(b1, 32), c2 = __shfl_xor(b2, 32);
          const int j0 = __shfl_xor(i0, 32), j1 = __shfl_xor(i1, 32), j2 = __shfl_xor(i2, 32);
          if (j0 >= 0) TOP3_INS(c0, j0);
          if (j1 >= 0) TOP3_INS(c1, j1);
          if (j2 >= 0) TOP3_INS(c2, j2); }
#undef TOP3_INS
        int p0 = 0, p1 = 0, p2 = 0;
        if (hi == 0) {
            if (CHECK_ATTN) { int* sp = SEL + ((size_t)bh * SEQ + pos) * 4; sp[0] = i0; sp[1] = i1; sp[2] = i2; sp[3] = -1; }
            p0 = atomicAdd(&cnt[i0], 1);
            if (i1 >= 0) p1 = atomicAdd(&cnt[i1], 1);
            if (i2 >= 0) p2 = atomicAdd(&cnt[i2], 1);
        }
        __syncthreads();
        if (C.tid < 64) {
            const int c = cnt[C.tid]; cnt[C.tid] = 0;
            int inc = c;
#pragma unroll
            for (int o = 1; o < 64; o <<= 1) { const int t = __shfl_up(inc, o); if (C.tid >= o) inc += t; }
            offs[C.tid + 1] = inc; if (C.tid == 0) offs[0] = 0;
            LOFF[(size_t)(bh * NBLK + i) * 80 + C.tid + 1] = inc; if (C.tid == 0) LOFF[(size_t)(bh * NBLK + i) * 80] = 0;
        }
        if (more) GATE_KML();
        __syncthreads();
        if (hi == 0) {
            unsigned short* lp = LIST + (size_t)(bh * NBLK + i) * 768;
            lp[offs[i0] + p0] = (unsigned short)(q | (0 << 8));
            if (i1 >= 0) lp[offs[i1] + p1] = (unsigned short)(q | (1 << 8));
            if (i2 >= 0) lp[offs[i2] + p2] = (unsigned short)(q | (2 << 8));
        }
    }
#undef GATE_LOAD
#undef GATE_KML
    if (CHECK_ATTN) { for (int e = C.bid * 512 + C.tid; e < NBH * 256; e += C.G * 512) { const int bh = e >> 8, qq = e & 255; int* sp = SEL + ((size_t)bh * SEQ + qq) * 4; sp[0] = -1; sp[1] = -1; sp[2] = -1; sp[3] = -1; } }
    __syncthreads();
}

__device__ __forceinline__ void phase_attn_simple(const Ctx& C, bf16* MIX) {
    const bf16* Q = (const bf16*)(C.ws + WS_PROJ) + (size_t)T_Q * SUBSTRIDE;
    const bf16* K = (const bf16*)(C.ws + WS_PROJ) + (size_t)T_K * SUBSTRIDE;
    const bf16* VV = (const bf16*)(C.ws + WS_PROJ) + (size_t)T_VV * SUBSTRIDE;
    const bf16* ZB = (const bf16*)(C.ws + WS_PROJ) + (size_t)T_ZB * SUBSTRIDE;
    const int* SEL = (const int*)(C.ws + WS_SEL); const float* BT = (const float*)(C.ws + WS_BT);
    const int gt = C.bid * 512 + C.tid, NT = C.G * 512;
    for (int item = gt; item < NBH * SEQ; item += NT) {
        const int bh = item >> 14, pos = item & (SEQ - 1), b = bh >> 3, h = bh & 7, own = pos >> 8;
        const size_t rowq = (size_t)(b * SEQ + pos);
        float qv[64], o[64];
        { const v4u* qp = (const v4u*)(Q + rowq * 512 + h * 64);
#pragma unroll
          for (int c = 0; c < 8; ++c) { const v4u v = qp[c]; qv[8 * c + 0] = bflo(v.x); qv[8 * c + 1] = bfhi(v.x); qv[8 * c + 2] = bflo(v.y); qv[8 * c + 3] = bfhi(v.y);
              qv[8 * c + 4] = bflo(v.z); qv[8 * c + 5] = bfhi(v.z); qv[8 * c + 6] = bflo(v.w); qv[8 * c + 7] = bfhi(v.w); } }
#pragma unroll
        for (int d = 0; d < 64; ++d) o[d] = 0.f;
        float m = -INFINITY, l = 0.f;
        const float* bt = BT + h * 128;
        for (int slot = 0; slot < 4; ++slot) {
            int blk, klim;
            if (slot == 0) { blk = own; klim = (pos & 255) + 1; } else { blk = SEL[(size_t)item * 4 + slot - 1]; klim = 256; if (blk < 0) klim = 0; }
            for (int kl = 0; kl < klim; ++kl) {
                const int kpos = blk * 256 + kl;
                const v4u* kp = (const v4u*)(K + ((size_t)(b * SEQ + kpos)) * 512 + h * 64);
                float a0 = 0.f, a1 = 0.f;
#pragma unroll
                for (int c = 0; c < 8; ++c) { const v4u v = kp[c];
                    a0 += qv[8 * c + 0] * bflo(v.x) + qv[8 * c + 2] * bflo(v.y) + qv[8 * c + 4] * bflo(v.z) + qv[8 * c + 6] * bflo(v.w);
                    a1 += qv[8 * c + 1] * bfhi(v.x) + qv[8 * c + 3] * bfhi(v.y) + qv[8 * c + 5] * bfhi(v.z) + qv[8 * c + 7] * bfhi(v.w); }
                int dd = pos - kpos; dd = dd > 127 ? 127 : dd;
                const float s = (a0 + a1) + bt[dd];
                if (s > m) { const float al = __builtin_amdgcn_exp2f(m - s); l *= al;
#pragma unroll
                    for (int d = 0; d < 64; ++d) o[d] *= al;
                    m = s; }
                const float p = __builtin_amdgcn_exp2f(s - m);
                l += p;
                const v4u* vp = (const v4u*)(VV + ((size_t)(b * SEQ + kpos)) * 512 + h * 64);
#pragma unroll
                for (int c = 0; c < 8; ++c) { const v4u v = vp[c];
                    o[8 * c + 0] += p * bflo(v.x); o[8 * c + 1] += p * bfhi(v.x); o[8 * c + 2] += p * bflo(v.y); o[8 * c + 3] += p * bfhi(v.y);
                    o[8 * c + 4] += p * bflo(v.z); o[8 * c + 5] += p * bfhi(v.z); o[8 * c + 6] += p * bflo(v.w); o[8 * c + 7] += p * bfhi(v.w); }
            }
        }
        const float rl = 1.0f / l;
        const v4u* zp = (const v4u*)(ZB + rowq * 512 + h * 64);
        v4u* op = (v4u*)(MIX + rowq * 1024 + 512 + h * 64);
#pragma unroll
        for (int c = 0; c < 8; ++c) { const v4u z = zp[c]; v4u w;
            w.x = pk2(o[8 * c + 0] * rl * pg8::act_silu(bflo(z.x)), o[8 * c + 1] * rl * pg8::act_silu(bfhi(z.x))); w.y = pk2(o[8 * c + 2] * rl * pg8::act_silu(bflo(z.y)), o[8 * c + 3] * rl * pg8::act_silu(bfhi(z.y)));
            w.z = pk2(o[8 * c + 4] * rl * pg8::act_silu(bflo(z.z)), o[8 * c + 5] * rl * pg8::act_silu(bfhi(z.z))); w.w = pk2(o[8 * c + 6] * rl * pg8::act_silu(bflo(z.w)), o[8 * c + 7] * rl * pg8::act_silu(bfhi(z.w)));
            op[c] = w; }
    }
}

constexpr int AT_KS = 0, AT_KPITCH = 144;
constexpr int AT_VT = 36864, AT_VPITCH = 528;
constexpr int AT_DT = AT_VT + 64 * AT_VPITCH;
constexpr int AT_ENT = AT_DT + 4096, AT_CAP = 4096;
constexpr int AT_PRE = AT_ENT + AT_CAP * 4;
constexpr int AT_OST = AT_PRE + 1024;
constexpr int AT_MISC = AT_OST + 8 * 4096;
constexpr int AT_NUNITS = NBLK * NBH;

struct QTile { unsigned ent; bf16x8 qf[4]; };
__device__ __forceinline__ void attn_load_q(QTile& T, const Ctx& C, const unsigned char* lds, int b, int h, int e0, int cnt) {
    const bf16* Q = (const bf16*)(C.ws + WS_PROJ) + (size_t)T_Q * SUBSTRIDE;
    const unsigned* ENT = (const unsigned*)(lds + AT_ENT);
    const int q = C.lane & 31, hi = C.lane >> 5;
    T.ent = ENT[(e0 + q < cnt) ? (e0 + q) : e0];
    const bf16* qrow = Q + ((size_t)(b * SEQ + (int)(T.ent & 16383u))) * 512 + h * 64 + hi * 8;
#pragma unroll
    for (int ks = 0; ks < 4; ++ks) T.qf[ks] = *(const bf16x8*)(qrow + ks * 16);
}
__device__ __forceinline__ void attn_tile(const Ctx& C, unsigned char* lds, const QTile& T, int bh, int e0, int cnt, int nkt2, const bool OWN) {
    bf16* PO = (bf16*)C.out; float* PL = (float*)(C.ws + WS_PL);
    const unsigned* ENT = (const unsigned*)(lds + AT_ENT);
    const int lane = C.lane, q = lane & 31, hi = lane >> 5;
    const unsigned ent = T.ent;
    const int pos = ent & 16383, qoff = (ent >> 16) & 1023;
    f32x16 o0 = {}, o1 = {};
    float l = 0.f;
    const bool anybias = OWN ? true : (__any(qoff < 112) != 0);
    const unsigned char* kbase = lds + AT_KS + q * AT_KPITCH + hi * 16;
    const unsigned char* vbase = lds + AT_VT + q * AT_VPITCH + hi * 16;
    const float* et0 = (const float*)(lds + AT_DT) + (256 + (OWN ? 0 : 256) + qoff - 4 * hi);
    bf16x8 kf[8];
#pragma unroll
    for (int ks = 0; ks < 4; ++ks) { kf[2 * ks] = *(const bf16x8*)(kbase + ks * 32); kf[2 * ks + 1] = *(const bf16x8*)(kbase + 32 * AT_KPITCH + ks * 32); }
    for (int kt2 = 0; kt2 < nkt2; ++kt2) {
        f32x16 p0 = {}, p1 = {};
        __builtin_amdgcn_s_setprio(1);
#pragma unroll
        for (int ks = 0; ks < 4; ++ks) {
            p0 = __builtin_amdgcn_mfma_f32_32x32x16_bf16(kf[2 * ks], T.qf[ks], p0, 0, 0, 0);
            p1 = __builtin_amdgcn_mfma_f32_32x32x16_bf16(kf[2 * ks + 1], T.qf[ks], p1, 0, 0, 0);
        }
        __builtin_amdgcn_s_setprio(0);
        bf16x8 vf[8];
#pragma unroll
        for (int s = 0; s < 4; ++s) { vf[2 * s] = *(const bf16x8*)(vbase + (64 * kt2 + 16 * s) * 2); vf[2 * s + 1] = *(const bf16x8*)(vbase + 32 * AT_VPITCH + (64 * kt2 + 16 * s) * 2); }
        if (anybias && (OWN || kt2 >= 2)) {
            const float* et = et0 - 64 * kt2 - 63;
#pragma unroll
            for (int r = 0; r < 16; ++r) { p0[r] += et[63 - ((r & 3) + 8 * (r >> 2))]; p1[r] += et[31 - ((r & 3) + 8 * (r >> 2))]; }
        }
#pragma unroll
        for (int r = 0; r < 16; ++r) { p0[r] = __builtin_amdgcn_exp2f(p0[r]); p1[r] = __builtin_amdgcn_exp2f(p1[r]); }
        float sa = 0.f, sb = 0.f;
#pragma unroll
        for (int r = 0; r < 16; ++r) { sa += p0[r]; sb += p1[r]; }
        l += sa + sb;
        v4u pa[4];
#pragma unroll
        for (int s = 0; s < 2; ++s) {
            pa[s] = (v4u){cvtpk(p0[8 * s + 0], p0[8 * s + 1]), cvtpk(p0[8 * s + 2], p0[8 * s + 3]), cvtpk(p0[8 * s + 4], p0[8 * s + 5]), cvtpk(p0[8 * s + 6], p0[8 * s + 7])};
            pa[2 + s] = (v4u){cvtpk(p1[8 * s + 0], p1[8 * s + 1]), cvtpk(p1[8 * s + 2], p1[8 * s + 3]), cvtpk(p1[8 * s + 4], p1[8 * s + 5]), cvtpk(p1[8 * s + 6], p1[8 * s + 7])};
        }
        if (kt2 + 1 < nkt2) {
#pragma unroll
            for (int ks = 0; ks < 4; ++ks) { kf[2 * ks] = *(const bf16x8*)(kbase + (64 * kt2 + 64) * AT_KPITCH + ks * 32); kf[2 * ks + 1] = *(const bf16x8*)(kbase + (64 * kt2 + 96) * AT_KPITCH + ks * 32); }
        }
        __builtin_amdgcn_s_setprio(1);
#pragma unroll
        for (int s = 0; s < 4; ++s) {
            const bf16x8 paf = __builtin_bit_cast(bf16x8, pa[s]);
            o0 = __builtin_amdgcn_mfma_f32_32x32x16_bf16(paf, vf[2 * s], o0, 0, 0, 0);
            o1 = __builtin_amdgcn_mfma_f32_32x32x16_bf16(paf, vf[2 * s + 1], o1, 0, 0, 0);
        }
        __builtin_amdgcn_s_setprio(0);
    }
    l += __shfl_xor(l, 32);
    bf16* stg = (bf16*)(lds + AT_OST + C.wave * 4096);
#pragma unroll
    for (int r = 0; r < 16; ++r) { const int orow = crow(r, hi); stg[orow * 64 + q] = (bf16)f2bf(o0[r]); stg[orow * 64 + 32 + q] = (bf16)f2bf(o1[r]); }
    LDS_WAIT(); asm volatile("" ::: "memory");
#pragma unroll
    for (int it = 0; it < 4; ++it) {
        const int row = it * 8 + (lane >> 3), ch = lane & 7;
        if (e0 + row < cnt) {
            const unsigned er = ENT[e0 + row];
            const int pr = er & 16383, jr = (er >> 14) & 3;
            *(v4u*)(PO + (((size_t)bh * SEQ + pr) * 4 + jr) * 64 + ch * 8) = *(const v4u*)(stg + row * 64 + ch * 8);
        }
    }
    if (hi == 0 && e0 + q < cnt) PL[((size_t)bh * SEQ + pos) * 4 + ((ent >> 14) & 3)] = l;
    LDS_WAIT(); asm volatile("" ::: "memory");
}

__device__ __forceinline__ void phase_attn(const Ctx& C, int layer) {
    unsigned char* lds = C.lds;
    const bf16* K = (const bf16*)(C.ws + WS_PROJ) + (size_t)T_K * SUBSTRIDE;
    const bf16* VV = (const bf16*)(C.ws + WS_PROJ) + (size_t)T_VV * SUBSTRIDE;
    const int* LOFF = (const int*)(C.ws + WS_LOFF); const unsigned short* LIST = (const unsigned short*)(C.ws + WS_LIST);
    const float* BT = (const float*)(C.ws + WS_BT);
    const int qg = C.bid & 7;
    unsigned* ctr = (unsigned*)(C.ws + WS_CTL) + 64 + 64 * layer;
    int qstep = 0;
    unsigned* ENT = (unsigned*)(lds + AT_ENT);
    int* PRE = (int*)(lds + AT_PRE); int* LO = PRE + 68;
    volatile unsigned* MISC = (volatile unsigned*)(lds + AT_MISC);
    int tid = C.tid;
    v4u kpre[4], vpre[4]; int lpre0 = 0, lpre1 = 0;
#define AT_LOADKV(uu) do { const int bh_ = (uu) & 15, n_ = (uu) >> 4; \
        const bf16* Kg = K + ((size_t)((bh_ >> 3) * SEQ + n_ * 256)) * 512 + (bh_ & 7) * 64; const bf16* Vg = VV + ((size_t)((bh_ >> 3) * SEQ + n_ * 256)) * 512 + (bh_ & 7) * 64; \
        _Pragma("unroll") for (int it = 0; it < 4; ++it) { const int idx = tid + 512 * it; kpre[it] = *(const v4u*)(Kg + (size_t)(idx >> 3) * 512 + (idx & 7) * 8); \
            vpre[it] = *(const v4u*)(Vg + (size_t)(idx >> 3) * 512 + (idx & 7) * 8); } \
        lpre0 = 0; lpre1 = 0; if (tid < 64 && n_ + 1 + tid < NBLK) { const int* lp_ = LOFF + ((size_t)(bh_ * NBLK + n_ + 1 + tid)) * 80 + n_; lpre0 = lp_[0]; lpre1 = lp_[1]; } } while (0)
#define AT_FETCH() ({ unsigned r_ = (unsigned)AT_NUNITS; while (qstep < 8) { const int g_ = (qg + qstep) & 7; const unsigned k_ = atomicAdd(ctr + 4 * g_, 1u); \
        if (k_ < 2u * NBLK) { r_ = (k_ >> 1) * 16 + 2 * g_ + (k_ & 1); break; } ++qstep; } r_; })
    if (tid == 0) MISC[0] = AT_FETCH();
    __syncthreads();
    int u = (int)MISC[0];
    if (u < AT_NUNITS) AT_LOADKV(u);
    while (u < AT_NUNITS) {
        asm volatile("" : "+v"(tid));
        Ctx Cu = C; Cu.tid = tid; Cu.lane = tid & 63;
        const int bh = u & 15, n = u >> 4, b = bh >> 3, h = bh & 7;
        if (tid == 0) MISC[1] = AT_FETCH();
#pragma unroll
        for (int it = 0; it < 4; ++it) { const int idx = tid + 512 * it;
            *(v4u*)(lds + AT_KS + (idx >> 3) * AT_KPITCH + (idx & 7) * 16) = kpre[it];
            const v4u v = vpre[it];
            const int kv_ = idx >> 3, kvp_ = (kv_ & ~12) | ((kv_ & 4) << 1) | ((kv_ & 8) >> 1);
            unsigned short* vt = (unsigned short*)(lds + AT_VT + (8 * (idx & 7)) * AT_VPITCH + kvp_ * 2);
            vt[0 * (AT_VPITCH / 2)] = (unsigned short)(v.x & 0xffff); vt[1 * (AT_VPITCH / 2)] = (unsigned short)(v.x >> 16);
            vt[2 * (AT_VPITCH / 2)] = (unsigned short)(v.y & 0xffff); vt[3 * (AT_VPITCH / 2)] = (unsigned short)(v.y >> 16);
            vt[4 * (AT_VPITCH / 2)] = (unsigned short)(v.z & 0xffff); vt[5 * (AT_VPITCH / 2)] = (unsigned short)(v.z >> 16);
            vt[6 * (AT_VPITCH / 2)] = (unsigned short)(v.w & 0xffff); vt[7 * (AT_VPITCH / 2)] = (unsigned short)(v.w >> 16); }
        { float* et_ = (float*)(lds + AT_DT);
#pragma unroll
          for (int k_ = 0; k_ < 2; ++k_) { const int j_ = tid + 512 * k_, d_ = j_ - 256; et_[j_] = d_ < 0 ? -INFINITY : (d_ < 128 ? BT[h * 128 + d_] - BT[h * 128 + 127] : 0.f); } }
        if (tid < 64) {
            const int lo = lpre0; int inc = lpre1 - lpre0;
#pragma unroll
            for (int o = 1; o < 64; o <<= 1) { const int t = __shfl_up(inc, o); if (tid >= o) inc += t; }
            PRE[tid + 1] = inc; LO[tid] = lo; if (tid == 0) PRE[0] = 0;
        }
        __syncthreads();
        const int total = 256 + PRE[63 - n];
        const int unext = (int)MISC[1];
        if (unext < AT_NUNITS) AT_LOADKV(unext);
        for (int base = 0; base < total; base += AT_CAP) {
            const int cnt = (total - base < AT_CAP) ? (total - base) : AT_CAP;
            if (base == 0 && tid < 256) ENT[tid] = (unsigned)(n * 256 + tid) | (3u << 14) | ((unsigned)tid << 16);
            { const int e_lo = base > 256 ? base : 256, e_hi = base + cnt;
#pragma unroll 4
              for (int e = e_lo + tid; e < e_hi; e += 512) {
                  const int es = e - 256; int a = 0, z = 63 - n;
#pragma unroll
                  for (int it = 0; it < 6; ++it) { const int mid = (a + z) >> 1; const bool up = (z - a > 1) && (PRE[mid] <= es); const bool dn = (z - a > 1) && !up; a = up ? mid : a; z = dn ? mid : z; }
                  const int ii = a, i = n + 1 + ii;
                  const unsigned val = LIST[((size_t)(bh * NBLK + i)) * 768 + LO[ii] + (es - PRE[ii])]; const unsigned ql = val & 255u, j = val >> 8;
                  ENT[e - base] = (unsigned)(i * 256 + ql) | (j << 14) | ((ii == 0 ? ql : 400u) << 16);
              } }
            __syncthreads();
            const int ntiles = (cnt + 31) >> 5;
            const int nown = (base == 0) ? 8 : 0;
            for (int tile = C.wave; tile < ntiles; tile += 8) {
                QTile Tc;
                attn_load_q(Tc, Cu, lds, b, h, tile * 32, cnt);
                { const bool own_ = tile < nown; attn_tile(Cu, lds, Tc, bh, tile * 32, cnt, own_ ? (tile >> 1) + 1 : 4, own_); }
            }
            __syncthreads();
        }
        u = unext;
    }
#undef AT_LOADKV
#undef AT_FETCH
}

__device__ __forceinline__ void phase_combine(const Ctx& C) {
    const bf16* PO = (const bf16*)C.out; const float* PL = (const float*)(C.ws + WS_PL);
    const bf16* ZB = (const bf16*)(C.ws + WS_PROJ) + (size_t)T_ZB * SUBSTRIDE;
    bf16* MIX = (bf16*)(C.ws + WS_MIX);
    const int gt = C.bid * 512 + C.tid, NT = C.G * 512;
    constexpr int UN = 4;
    for (int idx0 = gt; idx0 < MROWS * 64; idx0 += NT * UN) {
        f32x4 lv[UN]; v4u pv[UN][4]; v4u zv[UN];
#pragma unroll
        for (int k = 0; k < UN; ++k) {
            const int idx = idx0 + k * NT;
            const int ch = idx & 7, h = (idx >> 3) & 7, row = idx >> 6, b = row >> 14, pos = row & (SEQ - 1), i = pos >> 8;
            const size_t pb = ((size_t)(b * NH + h) * SEQ + pos) * 4;
            lv[k] = *(const f32x4*)(PL + pb);
#pragma unroll
            for (int j = 0; j < 4; ++j) pv[k][j] = (j == 3 || j < i) ? *(const v4u*)(PO + (pb + j) * 64 + ch * 8) : (v4u){0u, 0u, 0u, 0u};
            zv[k] = *(const v4u*)(ZB + (size_t)row * 512 + h * 64 + ch * 8);
        }
#pragma unroll
        for (int k = 0; k < UN; ++k) {
            const int idx = idx0 + k * NT;
            const int ch = idx & 7, h = (idx >> 3) & 7, row = idx >> 6, pos = row & (SEQ - 1), i = pos >> 8;
            float L = lv[k][3];
#pragma unroll
            for (int j = 0; j < 3; ++j) L += (j < i) ? lv[k][j] : 0.f;
            float acc[8];
#pragma unroll
            for (int e = 0; e < 8; ++e) acc[e] = 0.f;
#pragma unroll
            for (int j = 0; j < 4; ++j) { const v4u v = pv[k][j];
                acc[0] += bflo(v.x); acc[1] += bfhi(v.x); acc[2] += bflo(v.y); acc[3] += bfhi(v.y); acc[4] += bflo(v.z); acc[5] += bfhi(v.z); acc[6] += bflo(v.w); acc[7] += bfhi(v.w); }
            const float rl = 1.0f / L;
            const v4u z = zv[k];
            v4u w;
            w.x = pk2(acc[0] * rl * pg8::act_silu(bflo(z.x)), acc[1] * rl * pg8::act_silu(bfhi(z.x))); w.y = pk2(acc[2] * rl * pg8::act_silu(bflo(z.y)), acc[3] * rl * pg8::act_silu(bfhi(z.y)));
            w.z = pk2(acc[4] * rl * pg8::act_silu(bflo(z.z)), acc[5] * rl * pg8::act_silu(bfhi(z.z))); w.w = pk2(acc[6] * rl * pg8::act_silu(bflo(z.w)), acc[7] * rl * pg8::act_silu(bfhi(z.w)));
            *(v4u*)(MIX + (size_t)row * 1024 + 512 + h * 64 + ch * 8) = w;
        }
    }
}

constexpr int SG_VPITCH = 272, SG_MPITCH = 144, SG_WREG = 128 * SG_MPITCH;
constexpr int SG_STATS = 8 * SG_WREG;
constexpr int SG_MR = SG_STATS + 8192;
constexpr int SG_LN = SG_MR + 1024;
__device__ __forceinline__ void phase_sgu(const Ctx& C, int layer) {
    typedef float f32x2v __attribute__((ext_vector_type(2)));
    unsigned char* lds = C.lds;
    const bf16* U = (const bf16*)(C.ws + WS_PROJ) + (size_t)T_U * SUBSTRIDE;
    const bf16* V = (const bf16*)(C.ws + WS_PROJ) + (size_t)T_V * SUBSTRIDE;
    const bf16* ZA = (const bf16*)(C.ws + WS_PROJ) + (size_t)T_ZA * SUBSTRIDE;
    bf16* MIX = (bf16*)(C.ws + WS_MIX);
    const int g = C.wave; int lane = C.lane;
    const float* lng = C.ln_g + layer * 512 + g * 64; const float* lnb = C.ln_b + layer * 512 + g * 64;
    const bf16* Wg = (const bf16*)(C.ws + WS_WST) + ((size_t)(layer * 8 + g)) * 128 * 128;
    const float* bg = C.sgu_b + (layer * 8 + g) * 128;
    unsigned char* myreg = lds + g * SG_WREG;
    f32x2v* stats = (f32x2v*)(lds + SG_STATS); f32x2v* mr = (f32x2v*)(lds + SG_MR);
    float* lnl = (float*)(lds + SG_LN + g * 512);
    lnl[lane] = lng[lane]; lnl[64 + lane] = lnb[lane];
    for (int u = C.bid; u < MROWS / 128; u += C.G) {
        const size_t row0 = (size_t)u * 128;
        asm volatile("" : "+v"(lane));
        v4u xv[2][8];
#pragma unroll
        for (int rr = 0; rr < 2; ++rr) {
            const v4u* vp = (const v4u*)(V + (row0 + lane + 64 * rr) * 512 + g * 64);
#pragma unroll
            for (int c = 0; c < 8; ++c) xv[rr][c] = vp[c];
        }
#pragma unroll
        for (int rr = 0; rr < 2; ++rr) {
            float s1 = 0.f, s2 = 0.f;
#pragma unroll
            for (int c = 0; c < 8; ++c) { v4u v = xv[rr][c];
                v.x = pk2(pg8::act_gelu(bflo(v.x)), pg8::act_gelu(bfhi(v.x))); v.y = pk2(pg8::act_gelu(bflo(v.y)), pg8::act_gelu(bfhi(v.y)));
                v.z = pk2(pg8::act_gelu(bflo(v.z)), pg8::act_gelu(bfhi(v.z))); v.w = pk2(pg8::act_gelu(bflo(v.w)), pg8::act_gelu(bfhi(v.w))); xv[rr][c] = v;
                const float f0 = bflo(v.x), f1 = bfhi(v.x), f2 = bflo(v.y), f3 = bfhi(v.y), f4 = bflo(v.z), f5 = bfhi(v.z), f6 = bflo(v.w), f7 = bfhi(v.w);
                s1 += ((f0 + f1) + (f2 + f3)) + ((f4 + f5) + (f6 + f7));
                s2 += ((f0 * f0 + f1 * f1) + (f2 * f2 + f3 * f3)) + ((f4 * f4 + f5 * f5) + (f6 * f6 + f7 * f7)); }
            stats[g * 128 + lane + 64 * rr] = (f32x2v){s1, s2};
        }
        bf16x8 wf[4][8];
        { const bf16* wa = Wg + (size_t)(lane & 31) * 128 + (lane >> 5) * 8;
#pragma unroll
          for (int tt = 0; tt < 4; ++tt)
#pragma unroll
              for (int ks = 0; ks < 8; ++ks) if (tt >= (ks >> 1)) wf[tt][ks] = *(const bf16x8*)(wa + (size_t)tt * 32 * 128 + ks * 16); }
        __syncthreads();
        if (C.tid < 128) {
            float s1 = 0.f, s2 = 0.f;
#pragma unroll
            for (int w = 0; w < 8; ++w) { const f32x2v t = stats[w * 128 + C.tid]; s1 += t.x; s2 += t.y; }
            const float mean = s1 * (1.0f / 512.0f), var = s2 * (1.0f / 512.0f) - mean * mean;
            mr[C.tid] = (f32x2v){mean, 1.0f / sqrtf(var + LN_EPS)};
        }
        __syncthreads();
#pragma unroll
        for (int c = 0; c < 8; ++c) asm volatile("" : "+v"(xv[0][c]), "+v"(xv[1][c]));
        { const f32x2v m0 = mr[lane], m1 = mr[lane + 64];
          unsigned short* vt = (unsigned short*)(myreg + lane * 2);
#pragma unroll
          for (int c = 0; c < 8; ++c) {
              const v4u v0 = xv[0][c], v1 = xv[1][c];
              const float f0[8] = {bflo(v0.x), bfhi(v0.x), bflo(v0.y), bfhi(v0.y), bflo(v0.z), bfhi(v0.z), bflo(v0.w), bfhi(v0.w)};
              const float f1[8] = {bflo(v1.x), bfhi(v1.x), bflo(v1.y), bfhi(v1.y), bflo(v1.z), bfhi(v1.z), bflo(v1.w), bfhi(v1.w)};
#pragma unroll
              for (int e = 0; e < 8; ++e) { const int d = 8 * c + e; const float gg = lnl[d], bbv = lnl[64 + d];
                  vt[d * (SG_VPITCH / 2)] = (unsigned short)f2bf((f0[e] - m0.x) * m0.y * gg + bbv);
                  vt[d * (SG_VPITCH / 2) + 64] = (unsigned short)f2bf((f1[e] - m1.x) * m1.y * gg + bbv); }
              asm volatile("" ::: "memory");
          } }
        LDS_WAIT(); asm volatile("" ::: "memory");
        { const int q = lane & 31, hi = lane >> 5;
          unsigned pk[2][4][8];
#pragma unroll
          for (int dt = 0; dt < 2; ++dt) {
              const unsigned char* bb = myreg + (32 * dt + q) * SG_VPITCH + hi * 16;
              f32x16 acc[4];
#pragma unroll
              for (int tt = 0; tt < 4; ++tt) acc[tt] = (f32x16){};
#pragma unroll
              for (int ks = 0; ks < 8; ++ks) {
                  const bf16x8 b0 = *(const bf16x8*)(bb + ks * 32);
#pragma unroll
                  for (int tt = 0; tt < 4; ++tt) if (tt >= (ks >> 1)) acc[tt] = __builtin_amdgcn_mfma_f32_32x32x16_bf16(wf[tt][ks], b0, acc[tt], 0, 0, 0);
              }
#pragma unroll
              for (int tt = 0; tt < 4; ++tt)
#pragma unroll
                  for (int rp = 0; rp < 8; ++rp) pk[dt][tt][rp] = cvtpk(acc[tt][2 * rp], acc[tt][2 * rp + 1]);
          }
          LDS_WAIT(); asm volatile("" ::: "memory");
          unsigned char* mxb = myreg + (4 * hi) * SG_MPITCH + q * 2;
#pragma unroll
          for (int dt = 0; dt < 2; ++dt)
#pragma unroll
              for (int tt = 0; tt < 4; ++tt)
#pragma unroll
                  for (int r = 0; r < 16; ++r)
                      *(unsigned short*)(mxb + (32 * tt + (r & 3) + 8 * (r >> 2)) * SG_MPITCH + 64 * dt) = (unsigned short)((r & 1) ? (pk[dt][tt][r >> 1] >> 16) : (pk[dt][tt][r >> 1] & 0xffffu));
        }
        LDS_WAIT(); asm volatile("" ::: "memory");
        { const int ch = lane & 7, r8 = lane >> 3;
#pragma unroll 4
          for (int it = 0; it < 16; ++it) {
              const int t = it * 8 + r8;
              const v4u mv = *(const v4u*)(myreg + t * SG_MPITCH + ch * 16);
              const v4u uv = *(const v4u*)(U + (row0 + t) * 512 + g * 64 + ch * 8), zv = *(const v4u*)(ZA + (row0 + t) * 512 + g * 64 + ch * 8);
              const float bt = bg[t];
              v4u o;
#define SGU_Y(uw, mw, zw) pk2(pg8::act_gelu(bflo(uw)) * (bflo(mw) + bt) * pg8::act_silu(bflo(zw)), pg8::act_gelu(bfhi(uw)) * (bfhi(mw) + bt) * pg8::act_silu(bfhi(zw)))
              o.x = SGU_Y(uv.x, mv.x, zv.x); o.y = SGU_Y(uv.y, mv.y, zv.y); o.z = SGU_Y(uv.z, mv.z, zv.z); o.w = SGU_Y(uv.w, mv.w, zv.w);
#undef SGU_Y
              *(v4u*)(MIX + (row0 + t) * 1024 + g * 64 + ch * 8) = o;
          } }
        __syncthreads();
    }
}

__device__ __forceinline__ void phase_check_inject(const Ctx& C) {
    if (C.bid == 0 && C.tid == 0) C.out[0] = __uint_as_float(((const unsigned*)(C.ws + WS_CTL))[32]) * 1e6f;
}

#define GAS __attribute__((address_space(1)))
typedef GAS unsigned gu32;
#define RLX_AGENT __ATOMIC_RELAXED, __HIP_MEMORY_SCOPE_AGENT
constexpr int CW_BAR = 4096;
constexpr int LDS_BARST = LDS_BYTES - 64;
#define XB_TMO      128
#define XB_XCNT(j)  (256  + 64 * (j))
#define XB_XSUB(j)  (1280 + 64 * (j))
#define XB_XGEN(j)  (2304 + 64 * (j))
#define XB_TOP      3328
#define XB_TOPGEN   3392
#define XCD_BAR_WORDS 3456
#define XB_SPIN_CAP (1u << 18)

__device__ __forceinline__ unsigned xb_ld(unsigned* p)              { return __hip_atomic_load(p, __ATOMIC_RELAXED, __HIP_MEMORY_SCOPE_AGENT); }
__device__ __forceinline__ unsigned xb_add(unsigned* p, unsigned v) { return __hip_atomic_fetch_add(p, v, __ATOMIC_RELAXED, __HIP_MEMORY_SCOPE_AGENT); }
__device__ __forceinline__ unsigned xb_xcc_id() { return (unsigned)__builtin_amdgcn_s_getreg((3 << 11) | 20) & 0xFu; }
#define XB_SPIN(cond, bar) do { unsigned _sp = 0; while (cond) { __builtin_amdgcn_s_sleep(1); \
    if ((++_sp & 255u) == 0u) { if (xb_ld(&(bar)[XB_TMO])) break; if (_sp > XB_SPIN_CAP) { atomicAdd(&(bar)[XB_TMO], 1u); break; } } } } while (0)

struct XcdBarrier {
    unsigned* bar; unsigned x;
    volatile LAS unsigned* st;
};

__device__ __forceinline__ XcdBarrier xcd_barrier_post(unsigned* bar, volatile LAS unsigned* st) {
    XcdBarrier b; b.bar = bar; b.x = xb_xcc_id(); b.st = st;
    if (threadIdx.x == 0) (void)xb_add(&bar[XB_XCNT(b.x)], 1u);
    return b;
}
__device__ __forceinline__ void xcd_barrier_complete(unsigned* bar, unsigned x, unsigned& nloc, unsigned& nx) {
    const unsigned G = gridDim.x * gridDim.y * gridDim.z;
    unsigned sum, cnt, mine, sp = 0u;
    for (;;) {
        sum = 0u; cnt = 0u; mine = 0u;
#pragma unroll
        for (unsigned j = 0; j < 16; ++j) { const unsigned c = xb_ld(&bar[XB_XCNT(j)]); sum += c; cnt += (c > 0u) ? 1u : 0u; mine = (j == x) ? c : mine; }
        if (sum == G) break;
        __builtin_amdgcn_s_sleep(1);
        if ((++sp & 255u) == 0u) { if (xb_ld(&bar[XB_TMO])) break; if (sp > XB_SPIN_CAP) { atomicAdd(&bar[XB_TMO], 1u); break; } }
    }
    nloc = mine > 0u ? mine : 1u; nx = cnt > 0u ? cnt : 1u;
}

__device__ __forceinline__ void xcd_barrier(const XcdBarrier& b, const bool leader_thread) {
    asm volatile("s_waitcnt vmcnt(0)" ::: "memory");
    __syncthreads();
    if (leader_thread) {
        unsigned* bar = b.bar;
        __builtin_amdgcn_s_waitcnt(0);
        unsigned nloc = b.st[0], nx = b.st[1];
        if (nloc == 0u) { xcd_barrier_complete(bar, b.x, nloc, nx); b.st[0] = nloc; b.st[1] = nx; }
        const unsigned old = xb_add(&bar[XB_XSUB(b.x)], 1u);
        const unsigned gen = old / nloc;
        if (old + 1u == (gen + 1u) * nloc) {
            __builtin_amdgcn_fence(__ATOMIC_RELEASE, "agent");
            asm volatile("s_waitcnt vmcnt(0)" ::: "memory");
            const unsigned og = xb_add(&bar[XB_TOP], 1u);
            const unsigned tg = og / nx;
            if (og + 1u == (tg + 1u) * nx) xb_add(&bar[XB_TOPGEN], 1u);
            else XB_SPIN(xb_ld(&bar[XB_TOPGEN]) == tg, bar);
            __builtin_amdgcn_fence(__ATOMIC_ACQUIRE, "agent");
            xb_add(&bar[XB_XGEN(b.x)], 1u);
            asm volatile("s_waitcnt vmcnt(0)" ::: "memory");
        } else {
            XB_SPIN(xb_ld(&bar[XB_XGEN(b.x)]) == gen, bar);
            __builtin_amdgcn_fence(__ATOMIC_ACQUIRE, "agent");
            asm volatile("s_waitcnt vmcnt(0)" ::: "memory");
        }
    }
    __syncthreads();
}

template <int ST> __device__ __forceinline__ void run_stage(const Args& args, unsigned char* lds, int Lr, int wave_s) {
    const int L = Lr;
    Ctx C;
    { int t = wave_s * 64 + lane_now(); C.tid = t; }
    C.lds = lds; C.lane = C.tid & 63; C.wave = __builtin_amdgcn_readfirstlane(C.tid >> 6); C.G = gridDim.x; C.bid = blockIdx.x;
    C.x = args.in[0]; C.norm_g = args.in[1]; C.w_in = args.in[2]; C.ln_g = args.in[3]; C.ln_b = args.in[4]; C.sgu_w = args.in[5]; C.sgu_b = args.in[6];
    C.w_out = args.in[7]; C.rel_bias = args.in[8]; C.final_g = args.in[9]; C.out = args.out; C.ws = args.ws;
    asm volatile("" : "+s"(C.ws), "+s"(C.out), "+s"(C.x), "+s"(C.sgu_b), "+s"(C.ln_g), "+s"(C.ln_b));
    if constexpr (ST == 0) phase_prologue(C);
    else if constexpr (ST == 1) {
        pg8::Gemm g{(const pg8::bf16_t*)(C.ws + WS_XB), (const pg8::bf16_t*)(C.ws + WS_WIN) + (size_t)L * DIN * DM, MROWS, DIN, DM};
        pg8::StaticOrder S; S.init(MROWS, DIN, C.G, C.bid);
        int pmA = -1, pmB = -1, pmC = -1, pmD = -1;
        { pg8::Unit uu;
          for (int i = 0; S.next(i, uu); ++i) { const int pmu = uu.pm;
              if (pmu == pmA || pmu == pmB || pmu == pmC || pmu == pmD) continue;
              if (pmA < 0) pmA = pmu; else if (pmB < 0) pmB = pmu; else if (pmC < 0) pmC = pmu; else if (pmD < 0) pmD = pmu; } }
        float* rtab = (float*)(lds + RING_BYTES);
        { const float* rowss = (const float*)(C.ws + WS_ROWSS);
#pragma unroll
          for (int k = 0; k < 2; ++k) { const int e = C.tid + 512 * k, sl = e >> 8, pmk = sl == 0 ? pmA : sl == 1 ? pmB : sl == 2 ? pmC : pmD;
              if (pmk >= 0) { const f32x4* rp = (const f32x4*)(rowss + ((size_t)pmk * 256 + (e & 255)) * 16); const f32x4 s0 = rp[0], s1 = rp[1], s2 = rp[2], s3 = rp[3];
                  const float ss = ((s0[0] + s0[1]) + (s0[2] + s0[3])) + ((s1[0] + s1[1]) + (s1[2] + s1[3])) + ((s2[0] + s2[1]) + (s2[2] + s2[3])) + ((s3[0] + s3[1]) + (s3[2] + s3[3]));
                  rtab[e] = 1.0f / sqrtf(ss * (1.0f / 1024.0f) + NORM_EPS); } }
          __syncthreads(); }
        pg8::EpiProj E{(pg8::bf16_t*)(C.ws + WS_PROJ), SUBSTRIDE, rtab, pmA, pmB, pmC, pmD, (float*)(C.ws + WS_KMEAN) + (size_t)L * NBH * NBLK * 64};
        pg8::gemm_phase<pg8::EpiProj, pg8::StaticOrder, true, true>((PG8_LAS unsigned char*)lds, g, S, E, C.tid);
    }
    else if constexpr (ST == 3) { phase_gate(C, L); phase_sgu(C, L); }
    else if constexpr (ST == 4) phase_attn(C, L);
    else if constexpr (ST == 5) phase_combine(C);
    else if constexpr (ST == 6) {
        pg8::Gemm g{(const pg8::bf16_t*)(C.ws + WS_MIX), (const pg8::bf16_t*)(C.ws + WS_WOUT) + (size_t)L * DM * DM, MROWS, DM, DM};
        pg8::StaticOrder S; S.init(MROWS, DM, C.G, C.bid);
        if (L == 0) { pg8::EpiRes E{(pg8::bf16_t*)(C.ws + WS_XB), (float*)(C.ws + WS_ROWSS)};
            pg8::gemm_phase<pg8::EpiRes, pg8::StaticOrder, true, true>((PG8_LAS unsigned char*)lds, g, S, E, C.tid); }
        else { pg8::EpiFinal E{(const pg8::bf16_t*)(C.ws + WS_XB), C.out, C.final_g, (float*)(C.ws + WS_ROWSS), (unsigned*)(C.ws + WS_CTL) + 8192};
            pg8::gemm_phase<pg8::EpiFinal, pg8::StaticOrder, true, true>((PG8_LAS unsigned char*)lds, g, S, E, C.tid); }
    } else if constexpr (ST == 7) phase_check_inject(C);
    else if constexpr (ST == 8) phase_attn_simple(C, (bf16*)(C.ws + 104 * MiB));
    else if constexpr (ST == 9) {
        const bf16* A = (const bf16*)(C.ws + WS_MIX); const bf16* B = (const bf16*)(C.ws + 104 * MiB); unsigned* flag = (unsigned*)(C.ws + WS_CTL) + 32;
        float md = 0.f;
        for (size_t idx = (size_t)C.bid * 512 + C.tid; idx < (size_t)MROWS * 512; idx += (size_t)C.G * 512) {
            const size_t row = idx >> 9, col = 512 + (idx & 511);
            const float a = __uint_as_float((unsigned)A[row * 1024 + col] << 16), r = __uint_as_float((unsigned)B[row * 1024 + col] << 16);
            float sc = fabsf(r);
#pragma unroll
            for (int o = 1; o < 64; o <<= 1) sc = fmaxf(sc, __shfl_xor(sc, o));
            const float d = fabsf(a - r) / (0.02f + sc);
            md = (d > md || !(d == d)) ? (d == d ? d : 1e6f) : md;
        }
        atomicMax(flag, __float_as_uint(md));
    }
}
template <int SEL> __global__ void __launch_bounds__(NWAVES * 64, 2) fwd(Args args) {
    extern __shared__ __attribute__((aligned(16))) unsigned char lds[];
    const int wave_s = __builtin_amdgcn_readfirstlane((int)threadIdx.x >> 6);
    if constexpr (SEL >= 0) run_stage<SEL>(args, lds, args.layer, wave_s);
    else {
        if (args.pad == 0x7fffffff) cg::this_grid().sync();
        volatile LAS unsigned* bst = (volatile LAS unsigned*)((LAS unsigned char*)lds + LDS_BARST);
        if (threadIdx.x == 0) { bst[0] = 0u; bst[1] = 0u; }
        __syncthreads();
        XcdBarrier bar = xcd_barrier_post((unsigned*)(args.ws + WS_CTL) + CW_BAR, bst);
#define GRID_SYNC() do { XcdBarrier b2_ = bar; asm volatile("" : "+s"(b2_.bar), "+s"(b2_.x)); xcd_barrier(b2_, wave_s == 0 && lane_now() == 0); } while (0)
#define RUN(k, L) do { run_stage<k>(args, lds, L, wave_s); GRID_SYNC(); } while (0)
        RUN(0, 0);
        for (int L = 0; L < DEPTH; ++L) {
            RUN(1, L); RUN(3, L); RUN(4, L); RUN(5, L);
            if (L == DEPTH - 1) run_stage<6>(args, lds, L, wave_s); else RUN(6, L);
        }
    }
}

#ifndef MK_N_LAUNCHES
#define MK_N_LAUNCHES 1
#endif
template <int SEL> static void launch_stage(int grid, Args a, int layer, hipStream_t stream) {
    static bool attr = false;
    if (!attr) { (void)hipFuncSetAttribute((const void*)fwd<SEL>, hipFuncAttributeMaxDynamicSharedMemorySize, LDS_BYTES); attr = true; }
    a.layer = layer;
    hipLaunchKernelGGL(fwd<SEL>, dim3(grid), dim3(NWAVES * 64), LDS_BYTES, stream, a);
}
extern "C" void kernel_launch(void* const* d_in, const int* in_sizes, int n_in, void* d_out, int out_size, void* d_ws, size_t ws_size, hipStream_t stream) {
    static int grid = 0;
    if (grid == 0) {
        if (n_in != 10 || out_size != MROWS * DM || ws_size < WS_END) { fprintf(stderr, "kernel_launch: unexpected shapes (n_in %d out %d ws %zu)\n", n_in, out_size, ws_size); grid = -1; return; }
        int dev = 0, cus = 0;
        (void)hipGetDevice(&dev); (void)hipDeviceGetAttribute(&cus, hipDeviceAttributeMultiprocessorCount, dev);
        grid = cus;
#if MK_N_LAUNCHES == 1
        int per_cu = 0;
        if (hipFuncSetAttribute((const void*)fwd<-1>, hipFuncAttributeMaxDynamicSharedMemorySize, LDS_BYTES) != hipSuccess) { fprintf(stderr, "kernel_launch: hipFuncSetAttribute failed\n"); grid = -1; return; }
        if (hipOccupancyMaxActiveBlocksPerMultiprocessor(&per_cu, (const void*)fwd<-1>, NWAVES * 64, LDS_BYTES) != hipSuccess || per_cu < 1) { fprintf(stderr, "kernel_launch: occupancy query says %d\n", per_cu); grid = -1; return; }
        (void)hipGetLastError();
#endif
    }
    if (grid < 0) return;
    (void)hipMemsetAsync((char*)d_ws + WS_CTL, 0, CTL_ZERO_BYTES, stream);
    Args a{};
    for (int i = 0; i < 10; ++i) a.in[i] = (const float*)d_in[i];
    a.out = (float*)d_out; a.ws = (unsigned char*)d_ws;
#if MK_N_LAUNCHES == 1
    void* kargs[] = {&a};
    hipError_t e = hipLaunchCooperativeKernel((const void*)fwd<-1>, dim3(grid), dim3(NWAVES * 64), kargs, LDS_BYTES, stream);
    if (e != hipSuccess) fprintf(stderr, "kernel_launch: cooperative launch failed: %s\n", hipGetErrorString(e));
#else
    launch_stage<0>(grid, a, 0, stream);
    for (int L = 0; L < DEPTH; ++L) {
        launch_stage<1>(grid, a, L, stream); launch_stage<3>(grid, a, L, stream);
        launch_stage<4>(grid, a, L, stream); launch_stage<5>(grid, a, L, stream);
        if (CHECK_ATTN && L == 0) { launch_stage<8>(grid, a, L, stream); launch_stage<9>(grid, a, L, stream); }
        launch_stage<6>(grid, a, L, stream);
    }
    if (CHECK_ATTN) launch_stage<7>(grid, a, 0, stream);
#endif
}
```

```cpp
#include <hip/hip_runtime.h>
#include <hip/hip_cooperative_groups.h>
#include <cstdio>
#include <cstdint>
namespace cg = cooperative_groups;

constexpr int BATCH = 2, SEQ = 16384, DM = 1024, MROWS = BATCH * SEQ, DIN = 3584, DSUB = 512;
constexpr int NH = 8, DH = 64, NBLK = SEQ / 256, NBH = BATCH * NH, DEPTH = 2;
constexpr float NORM_EPS = 1e-6f, LN_EPS = 1e-5f;
constexpr float LOG2E = 1.4426950408889634f;
#ifndef CHECK_ATTN
#define CHECK_ATTN 0
#endif
constexpr float QSCALE = 0.125f * LOG2E;
namespace pg8 {
#define PG8_LAS __attribute__((address_space(3)))
typedef unsigned short bf16_t;
typedef short bf16x8 __attribute__((ext_vector_type(8)));
typedef float f32x4 __attribute__((ext_vector_type(4)));
typedef unsigned u32x4 __attribute__((ext_vector_type(4)));
constexpr int BM = 256, BK = 64, HALF = 128, HTB = HALF * BK * 2  , STAGE_BYTES = 8 * HTB, NXCD = 8, WGM = 8;

__host__ __device__ __forceinline__ int lds_byte(int r, int c) { const int st = (r >> 4) * 2 + (c >> 5), rr = r & 15, cc = c & 31, ob = rr * 64 + cc * 2; return st * 1024 + (ob ^ (((ob >> 9) & 1) << 5)); }
__host__ __device__ __forceinline__ void stage_rc(int b, int& R, int& C) { const int st = b / 1024, sb = b % 1024, swz = sb ^ (((sb >> 9) & 1) << 5); R = (st >> 1) * 16 + swz / 64; C = (st & 1) * 32 + (swz % 64) / 2; }
__host__ __device__ __forceinline__ int perm32(int rho) { const int n = rho >> 4, i = rho & 15; return 8 * (i >> 2) + 4 * n + (i & 3); }

struct Unit { int pm, pn; };
struct Gemm { const bf16_t* A; const bf16_t* Bt; int M, N, K; };

struct StaticOrder {
    int nM, nN, nwg, G, c;
    __host__ __device__ void init(int M, int N, int G_, int c_) { nM = M / BM; nN = N / BM; nwg = nM * nN; G = G_; c = c_; }
    __host__ __device__ bool next(int i, Unit& u) const {
        const long L = (long)i * G + c; if (L >= nwg) return false;
        int wgid = (int)L; { const int q = nwg / NXCD, r = nwg % NXCD, xcd = wgid % NXCD, off = wgid / NXCD; wgid = (xcd < r ? xcd * (q + 1) : r * (q + 1) + (xcd - r) * q) + off; }
        const int nig = WGM * nN, gid = wgid / nig, fm = gid * WGM, gsz = (nM - fm) < WGM ? (nM - fm) : WGM;
        u.pm = fm + ((wgid % nig) % gsz); u.pn = (wgid % nig) / gsz; return true;
    }
    __device__ __forceinline__ void a_ready(const Unit&) const {}
    __device__ __forceinline__ void done(const Unit&) const {}
};

__device__ __forceinline__ unsigned cvt_pk_bf16(float lo, float hi) { unsigned r; asm volatile("v_cvt_pk_bf16_f32 %0, %1, %2" : "=v"(r) : "v"(lo), "v"(hi)); return r; }
typedef float f32x2 __attribute__((ext_vector_type(2)));
typedef float f32x2 __attribute__((ext_vector_type(2)));
__device__ __forceinline__ float act_gelu(float x) {
    const float u = x * (1.0f + 0.044715f * x * x);
    const float e = __builtin_amdgcn_exp2f(u * (-2.0f * 0.7978845608028654f * 1.4426950408889634f));
    return x * __builtin_amdgcn_rcpf(1.0f + e);
}
__device__ __forceinline__ float act_silu(float x) {
    const float e = __builtin_amdgcn_exp2f(x * (-1.4426950408889634f));
    return x * __builtin_amdgcn_rcpf(1.0f + e);
}
struct EpiProj {
    static constexpr bool PERM = true, AFTER_DRAIN = false;
    bf16_t* P; size_t sub_stride; const float* rstd_lds; int pm0, pm1, pm2, pm3; float* kmean;
    __device__ __forceinline__ void operator()(const f32x4 (&acc)[2][2][4][2], const Unit& u, int wr, int wc, int fr, int fq) const {
        const int t = u.pn >> 1;
        bf16_t* base = P + (size_t)t * sub_stride;
        const int col0 = (u.pn & 1) * 256 + wc * 32 + 8 * fq;
        const int row0 = u.pm * BM + wr * 64 + fr;
        const int slot = (u.pm == pm0) ? 0 : (u.pm == pm1) ? 1 : (u.pm == pm2) ? 2 : 3;
        const float* rt = rstd_lds + slot * 256 + wr * 64 + fr;
        const float qs = (t == 3) ? (0.125f * 1.4426950408889634f) : 1.0f;
        float ks[2][8];
#pragma unroll
        for (int bj = 0; bj < 2; ++bj)
#pragma unroll
            for (int e = 0; e < 8; ++e) ks[bj][e] = 0.f;
#pragma unroll
        for (int ai = 0; ai < 2; ++ai)
#pragma unroll
            for (int m = 0; m < 4; ++m) {
                const int row = row0 + ai * HALF + m * 16;
                const float rs = rt[ai * HALF + m * 16] * qs;
                bf16_t* rowp = base + (size_t)row * 512 + col0;
#pragma unroll
                for (int bj = 0; bj < 2; ++bj) {
                    const f32x4 v0 = acc[ai][bj][m][0] * rs, v1 = acc[ai][bj][m][1] * rs;
                    if (t == 4) {
#pragma unroll
                        for (int e = 0; e < 4; ++e) { ks[bj][e] += v0[e]; ks[bj][4 + e] += v1[e]; }
                    }
                    u32x4 w; w.x = cvt_pk_bf16(v0[0], v0[1]); w.y = cvt_pk_bf16(v0[2], v0[3]); w.z = cvt_pk_bf16(v1[0], v1[1]); w.w = cvt_pk_bf16(v1[2], v1[3]);
                    *(u32x4*)(rowp + bj * HALF) = w;
                }
            }
        if (t == 4) {
            const int b = u.pm >> 6, n = u.pm & 63;
#pragma unroll
            for (int bj = 0; bj < 2; ++bj)
#pragma unroll
                for (int e = 0; e < 8; ++e) {
                    float v = ks[bj][e];
                    v += __shfl_xor(v, 1); v += __shfl_xor(v, 2); v += __shfl_xor(v, 4); v += __shfl_xor(v, 8);
                    if (fr == 0) { const int col = col0 + bj * HALF + e; atomicAdd(kmean + ((size_t)((b * 8 + (col >> 6)) * 64 + n)) * 64 + (col & 63), v * (1.0f / 256.0f)); }
                }
        }
    }
};
#define PG8_GAS __attribute__((address_space(1)))
struct EpiRes {
    static constexpr bool PERM = false, AFTER_DRAIN = false;
    bf16_t* xb; float* rowss;
    __device__ __forceinline__ void operator()(const f32x4 (&acc)[2][2][4][2], const Unit& u, int wr, int wc, int fr, int fq) const {
        typedef unsigned u32x2v __attribute__((ext_vector_type(2)));
        const int col0 = u.pn * BM + wc * 32 + 4 * fq;
        PG8_GAS bf16_t* xbg = (PG8_GAS bf16_t*)xb; PG8_GAS float* rsg = (PG8_GAS float*)rowss;
        const size_t offb = (size_t)(u.pm * BM + wr * 64 + fr) * 1024 + col0;
        u32x2v rr[2][4][2][2];
#pragma unroll
        for (int ai = 0; ai < 2; ++ai)
#pragma unroll
            for (int m = 0; m < 4; ++m)
#pragma unroll
                for (int bj = 0; bj < 2; ++bj)
#pragma unroll
                    for (int n = 0; n < 2; ++n) rr[ai][m][bj][n] = *(const PG8_GAS u32x2v*)(xbg + offb + (size_t)(ai * HALF + m * 16) * 1024 + bj * HALF + n * 16);
#pragma unroll
        for (int ai = 0; ai < 2; ++ai)
#pragma unroll
            for (int m = 0; m < 4; ++m) {
                const int row = u.pm * BM + ai * HALF + wr * 64 + m * 16 + fr;
                float ss = 0.f;
#pragma unroll
                for (int bj = 0; bj < 2; ++bj)
#pragma unroll
                    for (int n = 0; n < 2; ++n) {
                        const u32x2v w0 = rr[ai][m][bj][n];
                        const f32x4 r = (f32x4){__uint_as_float(w0.x << 16), __uint_as_float(w0.x & 0xffff0000u), __uint_as_float(w0.y << 16), __uint_as_float(w0.y & 0xffff0000u)};
                        const f32x4 o = r + acc[ai][bj][m][n];
                        ss += (o[0] * o[0] + o[1] * o[1]) + (o[2] * o[2] + o[3] * o[3]);
                        u32x2v w; w.x = cvt_pk_bf16(o[0], o[1]); w.y = cvt_pk_bf16(o[2], o[3]);
                        *(PG8_GAS u32x2v*)(xbg + offb + (size_t)(ai * HALF + m * 16) * 1024 + bj * HALF + n * 16) = w;
                    }
                ss += __shfl_xor(ss, 16); ss += __shfl_xor(ss, 32);
                if (fq == 0) rsg[(size_t)row * 16 + u.pn * 4 + wc] = ss;
            }
    }
};
struct EpiFinal {
    static constexpr bool PERM = false, AFTER_DRAIN = false;
    const bf16_t* xb; float* out; const float* fg; float* slots; unsigned* cnt;
    __device__ __forceinline__ void operator()(f32x4 (&acc)[2][2][4][2], const Unit& u, int wr, int wc, int fr, int fq) const {
        typedef unsigned u32x2v __attribute__((ext_vector_type(2)));
        const int col0 = u.pn * BM + wc * 32 + 4 * fq;
        const PG8_GAS bf16_t* xbg = (const PG8_GAS bf16_t*)xb; PG8_GAS float* outg = (PG8_GAS float*)out; const PG8_GAS float* slg = (const PG8_GAS float*)slots;
        const size_t offb = (size_t)(u.pm * BM + wr * 64 + fr) * 1024 + col0;
        u32x2v rr[2][4][2][2];
#pragma unroll
        for (int ai = 0; ai < 2; ++ai)
#pragma unroll
            for (int m = 0; m < 4; ++m)
#pragma unroll
                for (int bj = 0; bj < 2; ++bj)
#pragma unroll
                    for (int n = 0; n < 2; ++n) rr[ai][m][bj][n] = *(const PG8_GAS u32x2v*)(xbg + offb + (size_t)(ai * HALF + m * 16) * 1024 + bj * HALF + n * 16);
#pragma unroll
        for (int ai = 0; ai < 2; ++ai)
#pragma unroll
            for (int m = 0; m < 4; ++m) {
                const int row = u.pm * BM + ai * HALF + wr * 64 + m * 16 + fr;
                float ss = 0.f;
#pragma unroll
                for (int bj = 0; bj < 2; ++bj)
#pragma unroll
                    for (int n = 0; n < 2; ++n) {
                        const u32x2v w = rr[ai][m][bj][n];
                        const f32x4 r = (f32x4){__uint_as_float(w.x << 16), __uint_as_float(w.x & 0xffff0000u), __uint_as_float(w.y << 16), __uint_as_float(w.y & 0xffff0000u)};
                        const f32x4 o = r + acc[ai][bj][m][n];
                        acc[ai][bj][m][n] = o;
                        ss += (o[0] * o[0] + o[1] * o[1]) + (o[2] * o[2] + o[3] * o[3]);
                    }
                ss += __shfl_xor(ss, 16); ss += __shfl_xor(ss, 32);
                if (fq == 0) __hip_atomic_store(slots + (size_t)row * 16 + u.pn * 4 + wc, ss, __ATOMIC_RELAXED, __HIP_MEMORY_SCOPE_AGENT);
            }
        asm volatile("s_waitcnt vmcnt(0)" ::: "memory");
        unsigned* pc = cnt + 64 * u.pm;
        if (fr == 0 && fq == 0) __hip_atomic_fetch_add(pc, 1u, __ATOMIC_RELAXED, __HIP_MEMORY_SCOPE_AGENT);
        f32x4 g4[2][2];
#pragma unroll
        for (int bj = 0; bj < 2; ++bj)
#pragma unroll
            for (int n = 0; n < 2; ++n) g4[bj][n] = *(const PG8_GAS f32x4*)((const PG8_GAS float*)fg + col0 + bj * HALF + n * 16);
        for (unsigned spins = 0; spins < (1u << 22); ++spins) {
            if (__hip_atomic_load(pc, __ATOMIC_RELAXED, __HIP_MEMORY_SCOPE_AGENT) >= 32u) break;
            __builtin_amdgcn_s_sleep(2);
        }
        __builtin_amdgcn_fence(__ATOMIC_ACQUIRE, "agent");
        asm volatile("s_waitcnt vmcnt(0)" ::: "memory");
#pragma unroll
        for (int ai = 0; ai < 2; ++ai) {
            f32x4 sl[4][4];
#pragma unroll
            for (int m = 0; m < 4; ++m)
#pragma unroll
                for (int k = 0; k < 4; ++k) sl[m][k] = *(const PG8_GAS f32x4*)(slg + (size_t)(u.pm * BM + ai * HALF + wr * 64 + m * 16 + fr) * 16 + k * 4);
#pragma unroll
            for (int m = 0; m < 4; ++m) {
                const f32x4 s0 = sl[m][0], s1 = sl[m][1], s2 = sl[m][2], s3 = sl[m][3];
                const float tot = ((s0[0] + s0[1]) + (s0[2] + s0[3])) + ((s1[0] + s1[1]) + (s1[2] + s1[3])) + ((s2[0] + s2[1]) + (s2[2] + s2[3])) + ((s3[0] + s3[1]) + (s3[2] + s3[3]));
                const float rs = 1.0f / sqrtf(tot * (1.0f / 1024.0f) + 1e-6f);
#pragma unroll
                for (int bj = 0; bj < 2; ++bj)
#pragma unroll
                    for (int n = 0; n < 2; ++n) *(PG8_GAS f32x4*)(outg + offb + (size_t)(ai * HALF + m * 16) * 1024 + bj * HALF + n * 16) = acc[ai][bj][m][n] * rs * g4[bj][n];
            }
        }
    }
};
template <class Epi, class Sched, bool ALIGN_EPI = false, bool SP2 = false>
__device__ __forceinline__ void gemm_phase(PG8_LAS unsigned char* lds, const Gemm g, const Sched& S, const Epi& E, const int tid) {
    const int wid = __builtin_amdgcn_readfirstlane(tid >> 6), lane = tid & 63, wr = wid >> 2, wc = wid & 3, fr = lane & 15, fq = lane >> 4;
    const int K = g.K, nt = K / BK;
    unsigned voffA[2], voffB[2];
#pragma unroll
    for (int i = 0; i < 2; ++i) { int R, C; stage_rc(tid * 16 + i * 8192, R, C); const int Rb = Epi::PERM ? ((R & ~31) + perm32(R & 31)) : R;
        voffA[i] = (unsigned)(R * K + C) * 2u; voffB[i] = (unsigned)(Rb * K + C) * 2u; }
    const size_t kstep = (size_t)(BK * 2);
    const size_t hstep = (size_t)HALF * K * 2;
    const size_t tstep = 2 * hstep;
    const unsigned ldsw = (unsigned)wid * 1024u;
    const int aoff = lds_byte(wr * 64 + fr, fq * 8), boff = lds_byte(wc * 32 + fr, fq * 8);
#define PG8_SA(b, h) (((b) * 2 + (h)) * HTB)
#define PG8_SB(b, h) ((4 + (b) * 2 + (h)) * HTB)
#define PG8_STAGE(bufoff, gbase, voff) do { _Pragma("unroll") for (int _i = 0; _i < 2; ++_i) \
        __builtin_amdgcn_global_load_lds((const unsigned*)((const char*)(gbase) + (voff)[_i]), (PG8_LAS unsigned*)(lds + (bufoff) + ldsw + _i * 8192), 16, 0, 0); } while (0)
#define PG8_LDA(dst, b, h) do { _Pragma("unroll") for (int m = 0; m < 4; ++m) _Pragma("unroll") for (int k = 0; k < 2; ++k) dst[m][k] = *(const PG8_LAS bf16x8*)(lds + PG8_SA(b, h) + aoff + m * 2048 + k * 1024); } while (0)
#define PG8_LDB(dst, b, h) do { _Pragma("unroll") for (int n = 0; n < 2; ++n) _Pragma("unroll") for (int k = 0; k < 2; ++k) dst[n][k] = *(const PG8_LAS bf16x8*)(lds + PG8_SB(b, h) + boff + n * 2048 + k * 1024); } while (0)
#define PG8_MMA(ai, bj, At, Bt) do { __builtin_amdgcn_s_setprio(1); _Pragma("unroll") for (int m = 0; m < 4; ++m) _Pragma("unroll") for (int n = 0; n < 2; ++n) _Pragma("unroll") for (int k = 0; k < 2; ++k) \
        acc[ai][bj][m][n] = __builtin_amdgcn_mfma_f32_16x16x32_bf16(Bt[n][k], At[m][k], acc[ai][bj][m][n], 0, 0, 0); __builtin_amdgcn_s_setprio(0); } while (0)
#define PG8_WAIT_V(n) asm volatile("s_waitcnt vmcnt(" #n ")" ::: "memory")
#define PG8_WAIT_L(n) asm volatile("s_waitcnt lgkmcnt(" #n ")" ::: "memory")
#define PG8_BAR __builtin_amdgcn_s_barrier()
#define PG8_SCHED __builtin_amdgcn_sched_barrier(0)
    Unit cur, nxt; int ui = 0;
    if (!S.next(0, cur)) return;
    f32x4 acc[2][2][4][2];
#pragma unroll
    for (int a = 0; a < 2; ++a)
#pragma unroll
        for (int b = 0; b < 2; ++b)
#pragma unroll
            for (int m = 0; m < 4; ++m)
#pragma unroll
                for (int n = 0; n < 2; ++n) acc[a][b][m][n] = (f32x4){0.f, 0.f, 0.f, 0.f};
    bf16x8 At[4][2], B0[2][2], B1[2][2];
    const char* cA = (const char*)g.A + (size_t)cur.pm * tstep; const char* cB = (const char*)g.Bt + (size_t)cur.pn * tstep;
    S.a_ready(cur);
    if constexpr (SP2) {
        PG8_STAGE(PG8_SB(0, 0), cB, voffB); PG8_STAGE(PG8_SB(0, 1), cB + hstep, voffB); PG8_STAGE(PG8_SA(0, 0), cA, voffA); PG8_STAGE(PG8_SA(0, 1), cA + hstep, voffA);
        if (wr == 1) PG8_BAR;
        PG8_WAIT_V(2); PG8_BAR;
        PG8_STAGE(PG8_SB(1, 0), cB + kstep, voffB); PG8_STAGE(PG8_SA(1, 0), cA + kstep, voffA); PG8_STAGE(PG8_SB(1, 1), cB + hstep + kstep, voffB);
        PG8_WAIT_V(6); PG8_BAR;
    } else {
        PG8_STAGE(PG8_SB(0, 0), cB, voffB); PG8_STAGE(PG8_SA(0, 0), cA, voffA); PG8_STAGE(PG8_SB(0, 1), cB + hstep, voffB); PG8_STAGE(PG8_SA(0, 1), cA + hstep, voffA);
        if (wr == 1) PG8_BAR;
        PG8_WAIT_V(4); PG8_BAR;
        PG8_STAGE(PG8_SB(1, 0), cB + kstep, voffB); PG8_STAGE(PG8_SA(1, 0), cA + kstep, voffA); PG8_STAGE(PG8_SB(1, 1), cB + hstep + kstep, voffB);
        PG8_WAIT_V(6); PG8_BAR;
    }
    for (;;) {
        const bool has_next = S.next(ui + 1, nxt);
        const char* nA = has_next ? (const char*)g.A + (size_t)nxt.pm * tstep : cA; const char* nB = has_next ? (const char*)g.Bt + (size_t)nxt.pn * tstep : cB;
        for (int t = 0; t < nt; t += 2) {
            const bool last = (t == nt - 2);
            const char* a1 = cA + (size_t)(t + 1) * kstep;
            const char* a2 = last ? nA : cA + (size_t)(t + 2) * kstep; const char* b2 = last ? nB : cB + (size_t)(t + 2) * kstep;
            const char* a3 = a2 + kstep; const char* b3 = b2 + kstep;
            if (last && has_next) S.a_ready(nxt);
            if constexpr (SP2) {
            PG8_LDB(B0, 0, 0); PG8_LDB(B1, 0, 1); PG8_SCHED; PG8_LDA(At, 0, 0); PG8_STAGE(PG8_SA(1, 1), a1 + hstep, voffA);
            PG8_WAIT_V(8); PG8_WAIT_L(0); PG8_BAR; PG8_MMA(0, 0, At, B0); PG8_MMA(0, 1, At, B1); PG8_BAR; PG8_SCHED;
            PG8_LDA(At, 0, 1); PG8_STAGE(PG8_SB(0, 0), b2, voffB); PG8_STAGE(PG8_SB(0, 1), b2 + hstep, voffB); PG8_STAGE(PG8_SA(0, 0), a2, voffA);
            PG8_WAIT_V(8); PG8_WAIT_L(0); PG8_BAR; PG8_MMA(1, 0, At, B0); PG8_MMA(1, 1, At, B1); PG8_BAR; PG8_SCHED;
            PG8_LDB(B0, 1, 0); PG8_LDB(B1, 1, 1); PG8_SCHED; PG8_LDA(At, 1, 0); PG8_STAGE(PG8_SA(0, 1), a2 + hstep, voffA);
            PG8_WAIT_V(8); PG8_WAIT_L(0); PG8_BAR; PG8_MMA(0, 0, At, B0); PG8_MMA(0, 1, At, B1); PG8_BAR; PG8_SCHED;
            PG8_LDA(At, 1, 1); PG8_STAGE(PG8_SB(1, 0), b3, voffB); PG8_STAGE(PG8_SB(1, 1), b3 + hstep, voffB); PG8_STAGE(PG8_SA(1, 0), a3, voffA);
            PG8_WAIT_V(8); PG8_WAIT_L(0); PG8_BAR; PG8_MMA(1, 0, At, B0); PG8_MMA(1, 1, At, B1); PG8_BAR; PG8_SCHED;
            } else {
            PG8_LDB(B0, 0, 0); PG8_SCHED; PG8_LDA(At, 0, 0); PG8_STAGE(PG8_SA(1, 1), a1 + hstep, voffA);
            PG8_WAIT_L(8); PG8_BAR; PG8_WAIT_L(0); PG8_MMA(0, 0, At, B0); PG8_BAR; PG8_SCHED;
            PG8_LDB(B1, 0, 1); PG8_STAGE(PG8_SB(0, 0), b2, voffB);
            PG8_BAR; PG8_WAIT_L(0); PG8_MMA(0, 1, At, B1); PG8_BAR;
            PG8_LDA(At, 0, 1); PG8_STAGE(PG8_SA(0, 0), a2, voffA);
            PG8_BAR; PG8_WAIT_L(0); PG8_MMA(1, 0, At, B0); PG8_BAR; PG8_SCHED;
            PG8_STAGE(PG8_SB(0, 1), b2 + hstep, voffB);
            PG8_WAIT_V(6); PG8_BAR; PG8_MMA(1, 1, At, B1); PG8_BAR;
            PG8_LDB(B0, 1, 0); PG8_SCHED; PG8_LDA(At, 1, 0); PG8_STAGE(PG8_SA(0, 1), a2 + hstep, voffA);
            PG8_WAIT_L(8); PG8_BAR; PG8_WAIT_L(0); PG8_MMA(0, 0, At, B0); PG8_BAR; PG8_SCHED;
            PG8_LDB(B1, 1, 1); PG8_STAGE(PG8_SB(1, 0), b3, voffB);
            PG8_BAR; PG8_WAIT_L(0); PG8_MMA(0, 1, At, B1); PG8_BAR;
            PG8_LDA(At, 1, 1); PG8_STAGE(PG8_SA(1, 0), a3, voffA);
            PG8_BAR; PG8_WAIT_L(0); PG8_MMA(1, 0, At, B0); PG8_BAR; PG8_SCHED;
            PG8_STAGE(PG8_SB(1, 1), b3 + hstep, voffB);
            PG8_WAIT_V(6); PG8_BAR; PG8_MMA(1, 1, At, B1); PG8_BAR;
            }
        }
        if constexpr (ALIGN_EPI) { if (wr == 0) PG8_BAR; }
        if constexpr (!Epi::AFTER_DRAIN) { int ln_; asm volatile("v_mbcnt_lo_u32_b32 %0, -1, 0\n\tv_mbcnt_hi_u32_b32 %0, -1, %0" : "=v"(ln_)); E(acc, cur, wr, wc, ln_ & 15, ln_ >> 4); S.done(cur); }
        if (!has_next) break;
#pragma unroll
        for (int a = 0; a < 2; ++a)
#pragma unroll
            for (int b = 0; b < 2; ++b)
#pragma unroll
                for (int m = 0; m < 4; ++m)
#pragma unroll
                    for (int n = 0; n < 2; ++n) acc[a][b][m][n] = (f32x4){0.f, 0.f, 0.f, 0.f};
        cur = nxt; cA = nA; cB = nB; ++ui;
        if constexpr (ALIGN_EPI) { if (wr == 1) PG8_BAR; }
    }
    PG8_WAIT_V(0);
    if constexpr (!ALIGN_EPI) { if (wr == 0) PG8_BAR; }
    PG8_BAR;
    if constexpr (Epi::AFTER_DRAIN) { E.fused(acc, cur, wr, wc, fr, fq, lds, wid, lane); S.done(cur); }
#undef PG8_SA
#undef PG8_SB
#undef PG8_STAGE
#undef PG8_LDA
#undef PG8_LDB
#undef PG8_MMA
#undef PG8_WAIT_V
#undef PG8_WAIT_L
#undef PG8_BAR
#undef PG8_SCHED
}
}

constexpr size_t MiB = 1u << 20;
constexpr size_t WS_CTL = 0, CTL_ZERO_BYTES = 1 * MiB;
constexpr size_t WS_WIN = 2 * MiB;
constexpr size_t WS_WOUT = 16 * MiB;
constexpr size_t WS_WST = 20 * MiB;
constexpr size_t WS_BT = 21 * MiB;
constexpr size_t WS_KMEAN = 22 * MiB;
constexpr size_t WS_LOFF = 23 * MiB;
constexpr size_t WS_ROWSS = 24 * MiB;
constexpr size_t WS_PL = 26 * MiB;
constexpr size_t WS_LIST = 30 * MiB;
constexpr size_t WS_SEL = 32 * MiB;
constexpr size_t WS_XB = 40 * MiB;
constexpr size_t WS_PROJ = 168 * MiB;
constexpr size_t WS_MIX = 392 * MiB;
constexpr size_t WS_END = 456 * MiB;
constexpr size_t SUBSTRIDE = (size_t)MROWS * 512;
enum { T_U = 0, T_V = 1, T_ZA = 2, T_Q = 3, T_K = 4, T_VV = 5, T_ZB = 6 };

constexpr int NWAVES = 8;
constexpr int LDS_BYTES = 160 * 1024;
constexpr int RING_BYTES = 131072;

#define LAS __attribute__((address_space(3)))
typedef unsigned short bf16;
typedef unsigned v4u __attribute__((ext_vector_type(4)));
typedef float f32x4 __attribute__((ext_vector_type(4)));
#define LDS_WAIT() asm volatile("s_waitcnt lgkmcnt(0)" ::: "memory")
__device__ __forceinline__ unsigned f2bf(float f) { unsigned u = __builtin_bit_cast(unsigned, f); return (u + 0x7fffu + ((u >> 16) & 1u)) >> 16; }
__device__ __forceinline__ unsigned pk2(float lo, float hi) { return f2bf(lo) | (f2bf(hi) << 16); }
__device__ __forceinline__ float bflo(unsigned w) { return __uint_as_float(w << 16); }
__device__ __forceinline__ float bfhi(unsigned w) { return __uint_as_float(w & 0xffff0000u); }
__device__ __forceinline__ float wave_sum(float v) {
#pragma unroll
    for (int o = 1; o < 64; o <<= 1) v += __shfl_xor(v, o);
    return v;
}

__device__ __forceinline__ int lane_now() { int l; asm volatile("v_mbcnt_lo_u32_b32 %0, -1, 0\n\tv_mbcnt_hi_u32_b32 %0, -1, %0" : "=v"(l)); return l; }
struct Args { const float* in[10]; float* out; unsigned char* ws; int layer, pad; };

struct Ctx {
    unsigned char* lds;
    int tid, lane, wave, G, bid;
    const float *x, *norm_g, *w_in, *ln_g, *ln_b, *sgu_w, *sgu_b, *w_out, *rel_bias, *final_g;
    float* out; unsigned char* ws;
};

__device__ __forceinline__ void p0_transpose_item(const float* W, const float* gs, int K, int N, bf16* WT, float* scr, int item, int lane) {
    const int nblk = N / 32, kb = item / nblk, nb = item % nblk, k0 = 64 * kb, n0 = 32 * nb;
    float wv[32];
#pragma unroll
    for (int i = 0; i < 32; ++i) wv[i] = W[(size_t)(k0 + 2 * i + (lane >> 5)) * N + n0 + (lane & 31)];
#pragma unroll
    for (int i = 0; i < 32; ++i) { const int kk = 2 * i + (lane >> 5); const float sc = gs ? gs[k0 + kk] : 1.0f; scr[kk * 33 + (lane & 31)] = wv[i] * sc; }
    LDS_WAIT(); asm volatile("" ::: "memory");
    const int c = lane & 7;
#pragma unroll
    for (int j = 0; j < 4; ++j) { const int n = (lane >> 3) + 8 * j; const float* s = scr + (8 * c) * 33 + n;
        v4u o; o.x = pk2(s[0 * 33], s[1 * 33]); o.y = pk2(s[2 * 33], s[3 * 33]); o.z = pk2(s[4 * 33], s[5 * 33]); o.w = pk2(s[6 * 33], s[7 * 33]);
        *(v4u*)(WT + (size_t)(n0 + n) * K + k0 + 8 * c) = o; }
    LDS_WAIT(); asm volatile("" ::: "memory");
}
__device__ __forceinline__ int rel_bucket(int d) {
    if (d < 16) return d;
    int b = 16;
    b += (d >= 19); b += (d >= 21); b += (d >= 24); b += (d >= 27); b += (d >= 31); b += (d >= 35); b += (d >= 40); b += (d >= 46);
    b += (d >= 52); b += (d >= 59); b += (d >= 67); b += (d >= 77); b += (d >= 87); b += (d >= 99); b += (d >= 113);
    return b;
}
__device__ __forceinline__ void phase_prologue(const Ctx& C) {
    float* scr = (float*)(C.lds + C.wave * 16384);
    const int gw = C.bid * NWAVES + C.wave, NGW = C.G * NWAVES;
    constexpr int I_IN = (DM / 64) * (DIN / 32), I_OUT = (DM / 64) * (DM / 32);
    constexpr int NITEMS = DEPTH * (I_IN + I_OUT);
    for (int it = gw; it < NITEMS; it += NGW) {
        const int l = it / (I_IN + I_OUT); int r = it % (I_IN + I_OUT);
        if (r < I_IN) p0_transpose_item(C.w_in + (size_t)l * DM * DIN, C.norm_g + l * DM, DM, DIN, (bf16*)(C.ws + WS_WIN) + (size_t)l * DIN * DM, scr, r, C.lane);
        else p0_transpose_item(C.w_out + (size_t)l * DM * DM, nullptr, DM, DM, (bf16*)(C.ws + WS_WOUT) + (size_t)l * DM * DM, scr, r - I_IN, C.lane);
    }
    { float* km = (float*)(C.ws + WS_KMEAN); for (int e = C.bid * 512 + C.tid; e < DEPTH * NBH * NBLK * 64; e += C.G * 512) km[e] = 0.f; }
    { bf16* wst = (bf16*)(C.ws + WS_WST); const int gt = C.bid * 512 + C.tid, NT = C.G * 512;
      for (int e = gt; e < DEPTH * 8 * 128 * 128; e += NT) { const int s = e & 127, t = (e >> 7) & 127; wst[e] = (s <= t) ? (bf16)f2bf(C.sgu_w[e]) : (bf16)0; } }
    if (C.bid == 0) { float* bt = (float*)(C.ws + WS_BT); for (int e = C.tid; e < 8 * 128; e += 512) { const int h = e >> 7, d = e & 127; bt[e] = C.rel_bias[rel_bucket(d) * 8 + h] * LOG2E; } }
    { bf16* xb = (bf16*)(C.ws + WS_XB); float* rowss = (float*)(C.ws + WS_ROWSS);
      constexpr int UN = 4;
      for (int m0 = gw; m0 < MROWS; m0 += NGW * UN) {
        f32x4 v[UN][4];
#pragma unroll
        for (int k = 0; k < UN; ++k) { const f32x4* xr = (const f32x4*)(C.x + (size_t)(m0 + k * NGW) * DM) + C.lane;
#pragma unroll
            for (int j = 0; j < 4; ++j) v[k][j] = xr[64 * j]; }
#pragma unroll
        for (int k = 0; k < UN; ++k) { const int m = m0 + k * NGW;
            float s = 0.f;
#pragma unroll
            for (int j = 0; j < 4; ++j) s += (v[k][j].x * v[k][j].x + v[k][j].y * v[k][j].y) + (v[k][j].z * v[k][j].z + v[k][j].w * v[k][j].w);
            s = wave_sum(s);
            unsigned long long* o8 = (unsigned long long*)(xb + (size_t)m * DM) + C.lane;
#pragma unroll
            for (int j = 0; j < 4; ++j) o8[64 * j] = (unsigned long long)pk2(v[k][j].x, v[k][j].y) | ((unsigned long long)pk2(v[k][j].z, v[k][j].w) << 32);
            if (C.lane < 16) rowss[(size_t)m * 16 + C.lane] = (C.lane == 0) ? s : 0.f; }
      } }
}

typedef short bf16x8 __attribute__((ext_vector_type(8)));
typedef short bf16x4s __attribute__((ext_vector_type(4)));
typedef float f32x16 __attribute__((ext_vector_type(16)));
__device__ __forceinline__ int crow(int r, int hi) { return (r & 3) + 8 * (r >> 2) + 4 * hi; }
__device__ __forceinline__ unsigned cvtpk(float lo, float hi) { unsigned r; asm volatile("v_cvt_pk_bf16_f32 %0, %1, %2" : "=v"(r) : "v"(lo), "v"(hi)); return r; }
__device__ __forceinline__ void phase_gate(const Ctx& C, int layer) {
    const bf16* Q = (const bf16*)(C.ws + WS_PROJ) + (size_t)T_Q * SUBSTRIDE;
    const float* KM = (const float*)(C.ws + WS_KMEAN) + (size_t)layer * NBH * NBLK * 64;
    int* SEL = (int*)(C.ws + WS_SEL); int* LOFF = (int*)(C.ws + WS_LOFF); unsigned short* LIST = (unsigned short*)(C.ws + WS_LIST);
    int* cnt = (int*)(C.lds);
    int* offs = (int*)(C.lds + 256);
    unsigned char* kml = C.lds + 1024;
    const int lane = C.lane, ql = lane & 31, hi = lane >> 5;
    bf16x8 qfN[4]; f32x4 kmr[2];
#define GATE_LOAD(uu) do { const int bh_ = (uu) / 63, i_ = (uu) % 63 + 1, b_ = bh_ >> 3, h_ = bh_ & 7; \
        const bf16* qrow_ = Q + ((size_t)(b_ * SEQ + i_ * 256 + C.wave * 32 + ql)) * 512 + h_ * 64 + hi * 8; \
        _Pragma("unroll") for (int ks = 0; ks < 4; ++ks) qfN[ks] = *(const bf16x8*)(qrow_ + ks * 16); \
        const float* kp_ = KM + (size_t)bh_ * NBLK * 64 + C.tid * 8; kmr[0] = *(const f32x4*)kp_; kmr[1] = *(const f32x4*)(kp_ + 4); } while (0)
#define GATE_KML() do { *(v4u*)(kml + (C.tid >> 3) * 144 + (C.tid & 7) * 16) = (v4u){cvtpk(kmr[0][0], kmr[0][1]), cvtpk(kmr[0][2], kmr[0][3]), cvtpk(kmr[1][0], kmr[1][1]), cvtpk(kmr[1][2], kmr[1][3])}; } while (0)
    int u = C.bid;
    if (C.tid < 64) cnt[C.tid] = 0;
    if (u < NBH * 63) { GATE_LOAD(u); GATE_KML(); }
    __syncthreads();
    for (; u < NBH * 63; u += C.G) {
        const int bh = u / 63, i = u % 63 + 1;
        const int q = C.wave * 32 + ql, pos = i * 256 + q;
        bf16x8 qf[4];
#pragma unroll
        for (int ks = 0; ks < 4; ++ks) qf[ks] = qfN[ks];
        const bool more = u + C.G < NBH * 63;
        if (more) GATE_LOAD(u + C.G);
        float b0 = -INFINITY, b1 = -INFINITY, b2 = -INFINITY; int i0 = -1, i1 = -1, i2 = -1;
#define TOP3_INS(v, idx) do { const float v_ = (v); const int x_ = (idx); if (v_ > b0) { b2 = b1; i2 = i1; b1 = b0; i1 = i0; b0 = v_; i0 = x_; } else if (v_ > b1) { b2 = b1; i2 = i1; b1 = v_; i1 = x_; } else if (v_ > b2) { b2 = v_; i2 = x_; } } while (0)
#pragma unroll
        for (int nt = 0; nt < 2; ++nt) {
            f32x16 p = {};
#pragma unroll
            for (int ks = 0; ks < 4; ++ks) {
                const bf16x8 kw = *(const bf16x8*)(kml + (32 * nt + ql) * 144 + ks * 32 + hi * 16);
                p = __builtin_amdgcn_mfma_f32_32x32x16_bf16(kw, qf[ks], p, 0, 0, 0);
            }
#pragma unroll
            for (int r = 0; r < 16; ++r) { const int n = 32 * nt + crow(r, hi); if (n < i) TOP3_INS(p[r], n); }
        }
        { const float c0 = __shfl_xor(b0, 32), c1 = __shfl_xor(b1, 32), c2 = __shfl_xor(b2, 32);
          const int j0 = __shfl_xor(i0, 32), j1 = __shfl_xor(i1, 32), j2 = __shfl_xor(i2, 32);
          if (j0 >= 0) TOP3_INS(c0, j0);
          if (j1 >= 0) TOP3_INS(c1, j1);
          if (j2 >= 0) TOP3_INS(c2, j2); }
#undef TOP3_INS
        int p0 = 0, p1 = 0, p2 = 0;
        if (hi == 0) {
            if (CHECK_ATTN) { int* sp = SEL + ((size_t)bh * SEQ + pos) * 4; sp[0] = i0; sp[1] = i1; sp[2] = i2; sp[3] = -1; }
            p0 = atomicAdd(&cnt[i0], 1);
            if (i1 >= 0) p1 = atomicAdd(&cnt[i1], 1);
            if (i2 >= 0) p2 = atomicAdd(&cnt[i2], 1);
        }
        __syncthreads();
        if (C.tid < 64) {
            const int c = cnt[C.tid]; cnt[C.tid] = 0;
            int inc = c;
#pragma unroll
            for (int o = 1; o < 64; o <<= 1) { const int t = __shfl_up(inc, o); if (C.tid >= o) inc += t; }
            offs[C.tid + 1] = inc; if (C.tid == 0) offs[0] = 0;
            LOFF[(size_t)(bh * NBLK + i) * 80 + C.tid + 1] = inc; if (C.tid == 0) LOFF[(size_t)(bh * NBLK + i) * 80] = 0;
        }
        if (more) GATE_KML();
        __syncthreads();
        if (hi == 0) {
            unsigned short* lp = LIST + (size_t)(bh * NBLK + i) * 768;
            lp[offs[i0] + p0] = (unsigned short)(q | (0 << 8));
            if (i1 >= 0) lp[offs[i1] + p1] = (unsigned short)(q | (1 << 8));
            if (i2 >= 0) lp[offs[i2] + p2] = (unsigned short)(q | (2 << 8));
        }
    }
#undef GATE_LOAD
#undef GATE_KML
    if (CHECK_ATTN) { for (int e = C.bid * 512 + C.tid; e < NBH * 256; e += C.G * 512) { const int bh = e >> 8, qq = e & 255; int* sp = SEL + ((size_t)bh * SEQ + qq) * 4; sp[0] = -1; sp[1] = -1; sp[2] = -1; sp[3] = -1; } }
    __syncthreads();
}

__device__ __forceinline__ void phase_attn_simple(const Ctx& C, bf16* MIX) {
    const bf16* Q = (const bf16*)(C.ws + WS_PROJ) + (size_t)T_Q * SUBSTRIDE;
    const bf16* K = (const bf16*)(C.ws + WS_PROJ) + (size_t)T_K * SUBSTRIDE;
    const bf16* VV = (const bf16*)(C.ws + WS_PROJ) + (size_t)T_VV * SUBSTRIDE;
    const bf16* ZB = (const bf16*)(C.ws + WS_PROJ) + (size_t)T_ZB * SUBSTRIDE;
    const int* SEL = (const int*)(C.ws + WS_SEL); const float* BT = (const float*)(C.ws + WS_BT);
    const int gt = C.bid * 512 + C.tid, NT = C.G * 512;
    for (int item = gt; item < NBH * SEQ; item += NT) {
        const int bh = item >> 14, pos = item & (SEQ - 1), b = bh >> 3, h = bh & 7, own = pos >> 8;
        const size_t rowq = (size_t)(b * SEQ + pos);
        float qv[64], o[64];
        { const v4u* qp = (const v4u*)(Q + rowq * 512 + h * 64);
#pragma unroll
          for (int c = 0; c < 8; ++c) { const v4u v = qp[c]; qv[8 * c + 0] = bflo(v.x); qv[8 * c + 1] = bfhi(v.x); qv[8 * c + 2] = bflo(v.y); qv[8 * c + 3] = bfhi(v.y);
              qv[8 * c + 4] = bflo(v.z); qv[8 * c + 5] = bfhi(v.z); qv[8 * c + 6] = bflo(v.w); qv[8 * c + 7] = bfhi(v.w); } }
#pragma unroll
        for (int d = 0; d < 64; ++d) o[d] = 0.f;
        float m = -INFINITY, l = 0.f;
        const float* bt = BT + h * 128;
        for (int slot = 0; slot < 4; ++slot) {
            int blk, klim;
            if (slot == 0) { blk = own; klim = (pos & 255) + 1; } else { blk = SEL[(size_t)item * 4 + slot - 1]; klim = 256; if (blk < 0) klim = 0; }
            for (int kl = 0; kl < klim; ++kl) {
                const int kpos = blk * 256 + kl;
                const v4u* kp = (const v4u*)(K + ((size_t)(b * SEQ + kpos)) * 512 + h * 64);
                float a0 = 0.f, a1 = 0.f;
#pragma unroll
                for (int c = 0; c < 8; ++c) { const v4u v = kp[c];
                    a0 += qv[8 * c + 0] * bflo(v.x) + qv[8 * c + 2] * bflo(v.y) + qv[8 * c + 4] * bflo(v.z) + qv[8 * c + 6] * bflo(v.w);
                    a1 += qv[8 * c + 1] * bfhi(v.x) + qv[8 * c + 3] * bfhi(v.y) + qv[8 * c + 5] * bfhi(v.z) + qv[8 * c + 7] * bfhi(v.w); }
                int dd = pos - kpos; dd = dd > 127 ? 127 : dd;
                const float s = (a0 + a1) + bt[dd];
                if (s > m) { const float al = __builtin_amdgcn_exp2f(m - s); l *= al;
#pragma unroll
                    for (int d = 0; d < 64; ++d) o[d] *= al;
                    m = s; }
                const float p = __builtin_amdgcn_exp2f(s - m);
                l += p;
                const v4u* vp = (const v4u*)(VV + ((size_t)(b * SEQ + kpos)) * 512 + h * 64);
#pragma unroll
                for (int c = 0; c < 8; ++c) { const v4u v = vp[c];
                    o[8 * c + 0] += p * bflo(v.x); o[8 * c + 1] += p * bfhi(v.x); o[8 * c + 2] += p * bflo(v.y); o[8 * c + 3] += p * bfhi(v.y);
                    o[8 * c + 4] += p * bflo(v.z); o[8 * c + 5] += p * bfhi(v.z); o[8 * c + 6] += p * bflo(v.w); o[8 * c + 7] += p * bfhi(v.w); }
            }
        }
        const float rl = 1.0f / l;
        const v4u* zp = (const v4u*)(ZB + rowq * 512 + h * 64);
        v4u* op = (v4u*)(MIX + rowq * 1024 + 512 + h * 64);
#pragma unroll
        for (int c = 0; c < 8; ++c) { const v4u z = zp[c]; v4u w;
            w.x = pk2(o[8 * c + 0] * rl * pg8::act_silu(bflo(z.x)), o[8 * c + 1] * rl * pg8::act_silu(bfhi(z.x))); w.y = pk2(o[8 * c + 2] * rl * pg8::act_silu(bflo(z.y)), o[8 * c + 3] * rl * pg8::act_silu(bfhi(z.y)));
            w.z = pk2(o[8 * c + 4] * rl * pg8::act_silu(bflo(z.z)), o[8 * c + 5] * rl * pg8::act_silu(bfhi(z.z))); w.w = pk2(o[8 * c + 6] * rl * pg8::act_silu(bflo(z.w)), o[8 * c + 7] * rl * pg8::act_silu(bfhi(z.w)));
            op[c] = w; }
    }
}

constexpr int AT_KS = 0, AT_KPITCH = 144;
constexpr int AT_VT = 36864, AT_VPITCH = 528;
constexpr int AT_DT = AT_VT + 64 * AT_VPITCH;
constexpr int AT_ENT = AT_DT + 4096, AT_CAP = 4096;
constexpr int AT_PRE = AT_ENT + AT_CAP * 4;
constexpr int AT_OST = AT_PRE + 1024;
constexpr int AT_MISC = AT_OST + 8 * 4096;
constexpr int AT_NUNITS = NBLK * NBH;

struct QTile { unsigned ent; bf16x8 qf[4]; };
__device__ __forceinline__ void attn_load_q(QTile& T, const Ctx& C, const unsigned char* lds, int b, int h, int e0, int cnt) {
    const bf16* Q = (const bf16*)(C.ws + WS_PROJ) + (size_t)T_Q * SUBSTRIDE;
    const unsigned* ENT = (const unsigned*)(lds + AT_ENT);
    const int q = C.lane & 31, hi = C.lane >> 5;
    T.ent = ENT[(e0 + q < cnt) ? (e0 + q) : e0];
    const bf16* qrow = Q + ((size_t)(b * SEQ + (int)(T.ent & 16383u))) * 512 + h * 64 + hi * 8;
#pragma unroll
    for (int ks = 0; ks < 4; ++ks) T.qf[ks] = *(const bf16x8*)(qrow + ks * 16);
}
__device__ __forceinline__ void attn_tile(const Ctx& C, unsigned char* lds, const QTile& T, int bh, int e0, int cnt, int nkt2, const bool OWN) {
    bf16* PO = (bf16*)C.out; float* PL = (float*)(C.ws + WS_PL);
    const unsigned* ENT = (const unsigned*)(lds + AT_ENT);
    const int lane = C.lane, q = lane & 31, hi = lane >> 5;
    const unsigned ent = T.ent;
    const int pos = ent & 16383, qoff = (ent >> 16) & 1023;
    f32x16 o0 = {}, o1 = {};
    float l = 0.f;
    const bool anybias = OWN ? true : (__any(qoff < 112) != 0);
    const unsigned char* kbase = lds + AT_KS + q * AT_KPITCH + hi * 16;
    const unsigned char* vbase = lds + AT_VT + q * AT_VPITCH + hi * 16;
    const float* et0 = (const float*)(lds + AT_DT) + (256 + (OWN ? 0 : 256) + qoff - 4 * hi);
    bf16x8 kf[8];
#pragma unroll
    for (int ks = 0; ks < 4; ++ks) { kf[2 * ks] = *(const bf16x8*)(kbase + ks * 32); kf[2 * ks + 1] = *(const bf16x8*)(kbase + 32 * AT_KPITCH + ks * 32); }
    for (int kt2 = 0; kt2 < nkt2; ++kt2) {
        f32x16 p0 = {}, p1 = {};
        __builtin_amdgcn_s_setprio(1);
#pragma unroll
        for (int ks = 0; ks < 4; ++ks) {
            p0 = __builtin_amdgcn_mfma_f32_32x32x16_bf16(kf[2 * ks], T.qf[ks], p0, 0, 0, 0);
            p1 = __builtin_amdgcn_mfma_f32_32x32x16_bf16(kf[2 * ks + 1], T.qf[ks], p1, 0, 0, 0);
        }
        __builtin_amdgcn_s_setprio(0);
        bf16x8 vf[8];
#pragma unroll
        for (int s = 0; s < 4; ++s) { vf[2 * s] = *(const bf16x8*)(vbase + (64 * kt2 + 16 * s) * 2); vf[2 * s + 1] = *(const bf16x8*)(vbase + 32 * AT_VPITCH + (64 * kt2 + 16 * s) * 2); }
        if (anybias && (OWN || kt2 >= 2)) {
            const float* et = et0 - 64 * kt2 - 63;
#pragma unroll
            for (int r = 0; r < 16; ++r) { p0[r] += et[63 - ((r & 3) + 8 * (r >> 2))]; p1[r] += et[31 - ((r & 3) + 8 * (r >> 2))]; }
        }
#pragma unroll
        for (int r = 0; r < 16; ++r) { p0[r] = __builtin_amdgcn_exp2f(p0[r]); p1[r] = __builtin_amdgcn_exp2f(p1[r]); }
        float sa = 0.f, sb = 0.f;
#pragma unroll
        for (int r = 0; r < 16; ++r) { sa += p0[r]; sb += p1[r]; }
        l += sa + sb;
        v4u pa[4];
#pragma unroll
        for (int s = 0; s < 2; ++s) {
            pa[s] = (v4u){cvtpk(p0[8 * s + 0], p0[8 * s + 1]), cvtpk(p0[8 * s + 2], p0[8 * s + 3]), cvtpk(p0[8 * s + 4], p0[8 * s + 5]), cvtpk(p0[8 * s + 6], p0[8 * s + 7])};
            pa[2 + s] = (v4u){cvtpk(p1[8 * s + 0], p1[8 * s + 1]), cvtpk(p1[8 * s + 2], p1[8 * s + 3]), cvtpk(p1[8 * s + 4], p1[8 * s + 5]), cvtpk(p1[8 * s + 6], p1[8 * s + 7])};
        }
        if (kt2 + 1 < nkt2) {
#pragma unroll
            for (int ks = 0; ks < 4; ++ks) { kf[2 * ks] = *(const bf16x8*)(kbase + (64 * kt2 + 64) * AT_KPITCH + ks * 32); kf[2 * ks + 1] = *(const bf16x8*)(kbase + (64 * kt2 + 96) * AT_KPITCH + ks * 32); }
        }
        __builtin_amdgcn_s_setprio(1);
#pragma unroll
        for (int s = 0; s < 4; ++s) {
            const bf16x8 paf = __builtin_bit_cast(bf16x8, pa[s]);
            o0 = __builtin_amdgcn_mfma_f32_32x32x16_bf16(paf, vf[2 * s], o0, 0, 0, 0);
            o1 = __builtin_amdgcn_mfma_f32_32x32x16_bf16(paf, vf[2 * s + 1], o1, 0, 0, 0);
        }
        __builtin_amdgcn_s_setprio(0);
    }
    l += __shfl_xor(l, 32);
    bf16* stg = (bf16*)(lds + AT_OST + C.wave * 4096);
#pragma unroll
    for (int r = 0; r < 16; ++r) { const int orow = crow(r, hi); stg[orow * 64 + q] = (bf16)f2bf(o0[r]); stg[orow * 64 + 32 + q] = (bf16)f2bf(o1[r]); }
    LDS_WAIT(); asm volatile("" ::: "memory");
#pragma unroll
    for (int it = 0; it < 4; ++it) {
        const int row = it * 8 + (lane >> 3), ch = lane & 7;
        if (e0 + row < cnt) {
            const unsigned er = ENT[e0 + row];
            const int pr = er & 16383, jr = (er >> 14) & 3;
            *(v4u*)(PO + (((size_t)bh * SEQ + pr) * 4 + jr) * 64 + ch * 8) = *(const v4u*)(stg + row * 64 + ch * 8);
        }
    }
    if (hi == 0 && e0 + q < cnt) PL[((size_t)bh * SEQ + pos) * 4 + ((ent >> 14) & 3)] = l;
    LDS_WAIT(); asm volatile("" ::: "memory");
}

__device__ __forceinline__ void phase_attn(const Ctx& C, int layer) {
    unsigned char* lds = C.lds;
    const bf16* K = (const bf16*)(C.ws + WS_PROJ) + (size_t)T_K * SUBSTRIDE;
    const bf16* VV = (const bf16*)(C.ws + WS_PROJ) + (size_t)T_VV * SUBSTRIDE;
    const int* LOFF = (const int*)(C.ws + WS_LOFF); const unsigned short* LIST = (const unsigned short*)(C.ws + WS_LIST);
    const float* BT = (const float*)(C.ws + WS_BT);
    const int qg = C.bid & 7;
    unsigned* ctr = (unsigned*)(C.ws + WS_CTL) + 64 + 64 * layer;
    int qstep = 0;
    unsigned* ENT = (unsigned*)(lds + AT_ENT);
    int* PRE = (int*)(lds + AT_PRE); int* LO = PRE + 68;
    volatile unsigned* MISC = (volatile unsigned*)(lds + AT_MISC);
    int tid = C.tid;
    v4u kpre[4], vpre[4]; int lpre0 = 0, lpre1 = 0;
#define AT_LOADKV(uu) do { const int bh_ = (uu) & 15, n_ = (uu) >> 4; \
        const bf16* Kg = K + ((size_t)((bh_ >> 3) * SEQ + n_ * 256)) * 512 + (bh_ & 7) * 64; const bf16* Vg = VV + ((size_t)((bh_ >> 3) * SEQ + n_ * 256)) * 512 + (bh_ & 7) * 64; \
        _Pragma("unroll") for (int it = 0; it < 4; ++it) { const int idx = tid + 512 * it; kpre[it] = *(const v4u*)(Kg + (size_t)(idx >> 3) * 512 + (idx & 7) * 8); \
            vpre[it] = *(const v4u*)(Vg + (size_t)(idx >> 3) * 512 + (idx & 7) * 8); } \
        lpre0 = 0; lpre1 = 0; if (tid < 64 && n_ + 1 + tid < NBLK) { const int* lp_ = LOFF + ((size_t)(bh_ * NBLK + n_ + 1 + tid)) * 80 + n_; lpre0 = lp_[0]; lpre1 = lp_[1]; } } while (0)
#define AT_FETCH() ({ unsigned r_ = (unsigned)AT_NUNITS; while (qstep < 8) { const int g_ = (qg + qstep) & 7; const unsigned k_ = atomicAdd(ctr + 4 * g_, 1u); \
        if (k_ < 2u * NBLK) { r_ = (k_ >> 1) * 16 + 2 * g_ + (k_ & 1); break; } ++qstep; } r_; })
    if (tid == 0) MISC[0] = AT_FETCH();
    __syncthreads();
    int u = (int)MISC[0];
    if (u < AT_NUNITS) AT_LOADKV(u);
    while (u < AT_NUNITS) {
        asm volatile("" : "+v"(tid));
        Ctx Cu = C; Cu.tid = tid; Cu.lane = tid & 63;
        const int bh = u & 15, n = u >> 4, b = bh >> 3, h = bh & 7;
        if (tid == 0) MISC[1] = AT_FETCH();
#pragma unroll
        for (int it = 0; it < 4; ++it) { const int idx = tid + 512 * it;
            *(v4u*)(lds + AT_KS + (idx >> 3) * AT_KPITCH + (idx & 7) * 16) = kpre[it];
            const v4u v = vpre[it];
            const int kv_ = idx >> 3, kvp_ = (kv_ & ~12) | ((kv_ & 4) << 1) | ((kv_ & 8) >> 1);
            unsigned short* vt = (unsigned short*)(lds + AT_VT + (8 * (idx & 7)) * AT_VPITCH + kvp_ * 2);
            vt[0 * (AT_VPITCH / 2)] = (unsigned short)(v.x & 0xffff); vt[1 * (AT_VPITCH / 2)] = (unsigned short)(v.x >> 16);
            vt[2 * (AT_VPITCH / 2)] = (unsigned short)(v.y & 0xffff); vt[3 * (AT_VPITCH / 2)] = (unsigned short)(v.y >> 16);
            vt[4 * (AT_VPITCH / 2)] = (unsigned short)(v.z & 0xffff); vt[5 * (AT_VPITCH / 2)] = (unsigned short)(v.z >> 16);
            vt[6 * (AT_VPITCH / 2)] = (unsigned short)(v.w & 0xffff); vt[7 * (AT_VPITCH / 2)] = (unsigned short)(v.w >> 16); }
        { float* et_ = (float*)(lds + AT_DT);
#pragma unroll
          for (int k_ = 0; k_ < 2; ++k_) { const int j_ = tid + 512 * k_, d_ = j_ - 256; et_[j_] = d_ < 0 ? -INFINITY : (d_ < 128 ? BT[h * 128 + d_] - BT[h * 128 + 127] : 0.f); } }
        if (tid < 64) {
            const int lo = lpre0; int inc = lpre1 - lpre0;
#pragma unroll
            for (int o = 1; o < 64; o <<= 1) { const int t = __shfl_up(inc, o); if (tid >= o) inc += t; }
            PRE[tid + 1] = inc; LO[tid] = lo; if (tid == 0) PRE[0] = 0;
        }
        __syncthreads();
        const int total = 256 + PRE[63 - n];
        const int unext = (int)MISC[1];
        if (unext < AT_NUNITS) AT_LOADKV(unext);
        for (int base = 0; base < total; base += AT_CAP) {
            const int cnt = (total - base < AT_CAP) ? (total - base) : AT_CAP;
            if (base == 0 && tid < 256) ENT[tid] = (unsigned)(n * 256 + tid) | (3u << 14) | ((unsigned)tid << 16);
            { const int e_lo = base > 256 ? base : 256, e_hi = base + cnt;
#pragma unroll 4
              for (int e = e_lo + tid; e < e_hi; e += 512) {
                  const int es = e - 256; int a = 0, z = 63 - n;
#pragma unroll
                  for (int it = 0; it < 6; ++it) { const int mid = (a + z) >> 1; const bool up = (z - a > 1) && (PRE[mid] <= es); const bool dn = (z - a > 1) && !up; a = up ? mid : a; z = dn ? mid : z; }
                  const int ii = a, i = n + 1 + ii;
                  const unsigned val = LIST[((size_t)(bh * NBLK + i)) * 768 + LO[ii] + (es - PRE[ii])]; const unsigned ql = val & 255u, j = val >> 8;
                  ENT[e - base] = (unsigned)(i * 256 + ql) | (j << 14) | ((ii == 0 ? ql : 400u) << 16);
              } }
            __syncthreads();
            const int ntiles = (cnt + 31) >> 5;
            const int nown = (base == 0) ? 8 : 0;
            for (int tile = C.wave; tile < ntiles; tile += 8) {
                QTile Tc;
                attn_load_q(Tc, Cu, lds, b, h, tile * 32, cnt);
                { const bool own_ = tile < nown; attn_tile(Cu, lds, Tc, bh, tile * 32, cnt, own_ ? (tile >> 1) + 1 : 4, own_); }
            }
            __syncthreads();
        }
        u = unext;
    }
#undef AT_LOADKV
#undef AT_FETCH
}

__device__ __forceinline__ void phase_combine(const Ctx& C) {
    const bf16* PO = (const bf16*)C.out; const float* PL = (const float*)(C.ws + WS_PL);
    const bf16* ZB = (const bf16*)(C.ws + WS_PROJ) + (size_t)T_ZB * SUBSTRIDE;
    bf16* MIX = (bf16*)(C.ws + WS_MIX);
    const int gt = C.bid * 512 + C.tid, NT = C.G * 512;
    constexpr int UN = 4;
    for (int idx0 = gt; idx0 < MROWS * 64; idx0 += NT * UN) {
        f32x4 lv[UN]; v4u pv[UN][4]; v4u zv[UN];
#pragma unroll
        for (int k = 0; k < UN; ++k) {
            const int idx = idx0 + k * NT;
            const int ch = idx & 7, h = (idx >> 3) & 7, row = idx >> 6, b = row >> 14, pos = row & (SEQ - 1), i = pos >> 8;
            const size_t pb = ((size_t)(b * NH + h) * SEQ + pos) * 4;
            lv[k] = *(const f32x4*)(PL + pb);
#pragma unroll
            for (int j = 0; j < 4; ++j) pv[k][j] = (j == 3 || j < i) ? *(const v4u*)(PO + (pb + j) * 64 + ch * 8) : (v4u){0u, 0u, 0u, 0u};
            zv[k] = *(const v4u*)(ZB + (size_t)row * 512 + h * 64 + ch * 8);
        }
#pragma unroll
        for (int k = 0; k < UN; ++k) {
            const int idx = idx0 + k * NT;
            const int ch = idx & 7, h = (idx >> 3) & 7, row = idx >> 6, pos = row & (SEQ - 1), i = pos >> 8;
            float L = lv[k][3];
#pragma unroll
            for (int j = 0; j < 3; ++j) L += (j < i) ? lv[k][j] : 0.f;
            float acc[8];
#pragma unroll
            for (int e = 0; e < 8; ++e) acc[e] = 0.f;
#pragma unroll
            for (int j = 0; j < 4; ++j) { const v4u v = pv[k][j];
                acc[0] += bflo(v.x); acc[1] += bfhi(v.x); acc[2] += bflo(v.y); acc[3] += bfhi(v.y); acc[4] += bflo(v.z); acc[5] += bfhi(v.z); acc[6] += bflo(v.w); acc[7] += bfhi(v.w); }
            const float rl = 1.0f / L;
            const v4u z = zv[k];
            v4u w;
            w.x = pk2(acc[0] * rl * pg8::act_silu(bflo(z.x)), acc[1] * rl * pg8::act_silu(bfhi(z.x))); w.y = pk2(acc[2] * rl * pg8::act_silu(bflo(z.y)), acc[3] * rl * pg8::act_silu(bfhi(z.y)));
            w.z = pk2(acc[4] * rl * pg8::act_silu(bflo(z.z)), acc[5] * rl * pg8::act_silu(bfhi(z.z))); w.w = pk2(acc[6] * rl * pg8::act_silu(bflo(z.w)), acc[7] * rl * pg8::act_silu(bfhi(z.w)));
            *(v4u*)(MIX + (size_t)row * 1024 + 512 + h * 64 + ch * 8) = w;
        }
    }
}

constexpr int SG_VPITCH = 272, SG_MPITCH = 144, SG_WREG = 128 * SG_MPITCH;
constexpr int SG_STATS = 8 * SG_WREG;
constexpr int SG_MR = SG_STATS + 8192;
constexpr int SG_LN = SG_MR + 1024;
__device__ __forceinline__ void phase_sgu(const Ctx& C, int layer) {
    typedef float f32x2v __attribute__((ext_vector_type(2)));
    unsigned char* lds = C.lds;
    const bf16* U = (const bf16*)(C.ws + WS_PROJ) + (size_t)T_U * SUBSTRIDE;
    const bf16* V = (const bf16*)(C.ws + WS_PROJ) + (size_t)T_V * SUBSTRIDE;
    const bf16* ZA = (const bf16*)(C.ws + WS_PROJ) + (size_t)T_ZA * SUBSTRIDE;
    bf16* MIX = (bf16*)(C.ws + WS_MIX);
    const int g = C.wave; int lane = C.lane;
    const float* lng = C.ln_g + layer * 512 + g * 64; const float* lnb = C.ln_b + layer * 512 + g * 64;
    const bf16* Wg = (const bf16*)(C.ws + WS_WST) + ((size_t)(layer * 8 + g)) * 128 * 128;
    const float* bg = C.sgu_b + (layer * 8 + g) * 128;
    unsigned char* myreg = lds + g * SG_WREG;
    f32x2v* stats = (f32x2v*)(lds + SG_STATS); f32x2v* mr = (f32x2v*)(lds + SG_MR);
    float* lnl = (float*)(lds + SG_LN + g * 512);
    lnl[lane] = lng[lane]; lnl[64 + lane] = lnb[lane];
    for (int u = C.bid; u < MROWS / 128; u += C.G) {
        const size_t row0 = (size_t)u * 128;
        asm volatile("" : "+v"(lane));
        v4u xv[2][8];
#pragma unroll
        for (int rr = 0; rr < 2; ++rr) {
            const v4u* vp = (const v4u*)(V + (row0 + lane + 64 * rr) * 512 + g * 64);
#pragma unroll
            for (int c = 0; c < 8; ++c) xv[rr][c] = vp[c];
        }
#pragma unroll
        for (int rr = 0; rr < 2; ++rr) {
            float s1 = 0.f, s2 = 0.f;
#pragma unroll
            for (int c = 0; c < 8; ++c) { v4u v = xv[rr][c];
                v.x = pk2(pg8::act_gelu(bflo(v.x)), pg8::act_gelu(bfhi(v.x))); v.y = pk2(pg8::act_gelu(bflo(v.y)), pg8::act_gelu(bfhi(v.y)));
                v.z = pk2(pg8::act_gelu(bflo(v.z)), pg8::act_gelu(bfhi(v.z))); v.w = pk2(pg8::act_gelu(bflo(v.w)), pg8::act_gelu(bfhi(v.w))); xv[rr][c] = v;
                const float f0 = bflo(v.x), f1 = bfhi(v.x), f2 = bflo(v.y), f3 = bfhi(v.y), f4 = bflo(v.z), f5 = bfhi(v.z), f6 = bflo(v.w), f7 = bfhi(v.w);
                s1 += ((f0 + f1) + (f2 + f3)) + ((f4 + f5) + (f6 + f7));
                s2 += ((f0 * f0 + f1 * f1) + (f2 * f2 + f3 * f3)) + ((f4 * f4 + f5 * f5) + (f6 * f6 + f7 * f7)); }
            stats[g * 128 + lane + 64 * rr] = (f32x2v){s1, s2};
        }
        bf16x8 wf[4][8];
        { const bf16* wa = Wg + (size_t)(lane & 31) * 128 + (lane >> 5) * 8;
#pragma unroll
          for (int tt = 0; tt < 4; ++tt)
#pragma unroll
              for (int ks = 0; ks < 8; ++ks) if (tt >= (ks >> 1)) wf[tt][ks] = *(const bf16x8*)(wa + (size_t)tt * 32 * 128 + ks * 16); }
        __syncthreads();
        if (C.tid < 128) {
            float s1 = 0.f, s2 = 0.f;
#pragma unroll
            for (int w = 0; w < 8; ++w) { const f32x2v t = stats[w * 128 + C.tid]; s1 += t.x; s2 += t.y; }
            const float mean = s1 * (1.0f / 512.0f), var = s2 * (1.0f / 512.0f) - mean * mean;
            mr[C.tid] = (f32x2v){mean, 1.0f / sqrtf(var + LN_EPS)};
        }
        __syncthreads();
#pragma unroll
        for (int c = 0; c < 8; ++c) asm volatile("" : "+v"(xv[0][c]), "+v"(xv[1][c]));
        { const f32x2v m0 = mr[lane], m1 = mr[lane + 64];
          unsigned short* vt = (unsigned short*)(myreg + lane * 2);
#pragma unroll
          for (int c = 0; c < 8; ++c) {
              const v4u v0 = xv[0][c], v1 = xv[1][c];
              const float f0[8] = {bflo(v0.x), bfhi(v0.x), bflo(v0.y), bfhi(v0.y), bflo(v0.z), bfhi(v0.z), bflo(v0.w), bfhi(v0.w)};
              const float f1[8] = {bflo(v1.x), bfhi(v1.x), bflo(v1.y), bfhi(v1.y), bflo(v1.z), bfhi(v1.z), bflo(v1.w), bfhi(v1.w)};
#pragma unroll
              for (int e = 0; e < 8; ++e) { const int d = 8 * c + e; const float gg = lnl[d], bbv = lnl[64 + d];
                  vt[d * (SG_VPITCH / 2)] = (unsigned short)f2bf((f0[e] - m0.x) * m0.y * gg + bbv);
                  vt[d * (SG_VPITCH / 2) + 64] = (unsigned short)f2bf((f1[e] - m1.x) * m1.y * gg + bbv); }
              asm volatile("" ::: "memory");
          } }
        LDS_WAIT(); asm volatile("" ::: "memory");
        { const int q = lane & 31, hi = lane >> 5;
          unsigned pk[2][4][8];
#pragma unroll
          for (int dt = 0; dt < 2; ++dt) {
              const unsigned char* bb = myreg + (32 * dt + q) * SG_VPITCH + hi * 16;
              f32x16 acc[4];
#pragma unroll
              for (int tt = 0; tt < 4; ++tt) acc[tt] = (f32x16){};
#pragma unroll
              for (int ks = 0; ks < 8; ++ks) {
                  const bf16x8 b0 = *(const bf16x8*)(bb + ks * 32);
#pragma unroll
                  for (int tt = 0; tt < 4; ++tt) if (tt >= (ks >> 1)) acc[tt] = __builtin_amdgcn_mfma_f32_32x32x16_bf16(wf[tt][ks], b0, acc[tt], 0, 0, 0);
              }
#pragma unroll
              for (int tt = 0; tt < 4; ++tt)
#pragma unroll
                  for (int rp = 0; rp < 8; ++rp) pk[dt][tt][rp] = cvtpk(acc[tt][2 * rp], acc[tt][2 * rp + 1]);
          }
          LDS_WAIT(); asm volatile("" ::: "memory");
          unsigned char* mxb = myreg + (4 * hi) * SG_MPITCH + q * 2;
#pragma unroll
          for (int dt = 0; dt < 2; ++dt)
#pragma unroll
              for (int tt = 0; tt < 4; ++tt)
#pragma unroll
                  for (int r = 0; r < 16; ++r)
                      *(unsigned short*)(mxb + (32 * tt + (r & 3) + 8 * (r >> 2)) * SG_MPITCH + 64 * dt) = (unsigned short)((r & 1) ? (pk[dt][tt][r >> 1] >> 16) : (pk[dt][tt][r >> 1] & 0xffffu));
        }
        LDS_WAIT(); asm volatile("" ::: "memory");
        { const int ch = lane & 7, r8 = lane >> 3;
#pragma unroll 4
          for (int it = 0; it < 16; ++it) {
              const int t = it * 8 + r8;
              const v4u mv = *(const v4u*)(myreg + t * SG_MPITCH + ch * 16);
              const v4u uv = *(const v4u*)(U + (row0 + t) * 512 + g * 64 + ch * 8), zv = *(const v4u*)(ZA + (row0 + t) * 512 + g * 64 + ch * 8);
              const float bt = bg[t];
              v4u o;
#define SGU_Y(uw, mw, zw) pk2(pg8::act_gelu(bflo(uw)) * (bflo(mw) + bt) * pg8::act_silu(bflo(zw)), pg8::act_gelu(bfhi(uw)) * (bfhi(mw) + bt) * pg8::act_silu(bfhi(zw)))
              o.x = SGU_Y(uv.x, mv.x, zv.x); o.y = SGU_Y(uv.y, mv.y, zv.y); o.z = SGU_Y(uv.z, mv.z, zv.z); o.w = SGU_Y(uv.w, mv.w, zv.w);
#undef SGU_Y
              *(v4u*)(MIX + (row0 + t) * 1024 + g * 64 + ch * 8) = o;
          } }
        __syncthreads();
    }
}

__device__ __forceinline__ void phase_check_inject(const Ctx& C) {
    if (C.bid == 0 && C.tid == 0) C.out[0] = __uint_as_float(((const unsigned*)(C.ws + WS_CTL))[32]) * 1e6f;
}

#define GAS __attribute__((address_space(1)))
typedef GAS unsigned gu32;
#define RLX_AGENT __ATOMIC_RELAXED, __HIP_MEMORY_SCOPE_AGENT
constexpr int CW_BAR = 4096;
constexpr int LDS_BARST = LDS_BYTES - 64;
#define XB_TMO      128
#define XB_XCNT(j)  (256  + 64 * (j))
#define XB_XSUB(j)  (1280 + 64 * (j))
#define XB_XGEN(j)  (2304 + 64 * (j))
#define XB_TOP      3328
#define XB_TOPGEN   3392
#define XCD_BAR_WORDS 3456
#define XB_SPIN_CAP (1u << 18)

__device__ __forceinline__ unsigned xb_ld(unsigned* p)              { return __hip_atomic_load(p, __ATOMIC_RELAXED, __HIP_MEMORY_SCOPE_AGENT); }
__device__ __forceinline__ unsigned xb_add(unsigned* p, unsigned v) { return __hip_atomic_fetch_add(p, v, __ATOMIC_RELAXED, __HIP_MEMORY_SCOPE_AGENT); }
__device__ __forceinline__ unsigned xb_xcc_id() { return (unsigned)__builtin_amdgcn_s_getreg((3 << 11) | 20) & 0xFu; }
#define XB_SPIN(cond, bar) do { unsigned _sp = 0; while (cond) { __builtin_amdgcn_s_sleep(1); \
    if ((++_sp & 255u) == 0u) { if (xb_ld(&(bar)[XB_TMO])) break; if (_sp > XB_SPIN_CAP) { atomicAdd(&(bar)[XB_TMO], 1u); break; } } } } while (0)

struct XcdBarrier {
    unsigned* bar; unsigned x;
    volatile LAS unsigned* st;
};

__device__ __forceinline__ XcdBarrier xcd_barrier_post(unsigned* bar, volatile LAS unsigned* st) {
    XcdBarrier b; b.bar = bar; b.x = xb_xcc_id(); b.st = st;
    if (threadIdx.x == 0) (void)xb_add(&bar[XB_XCNT(b.x)], 1u);
    return b;
}
__device__ __forceinline__ void xcd_barrier_complete(unsigned* bar, unsigned x, unsigned& nloc, unsigned& nx) {
    const unsigned G = gridDim.x * gridDim.y * gridDim.z;
    unsigned sum, cnt, mine, sp = 0u;
    for (;;) {
        sum = 0u; cnt = 0u; mine = 0u;
#pragma unroll
        for (unsigned j = 0; j < 16; ++j) { const unsigned c = xb_ld(&bar[XB_XCNT(j)]); sum += c; cnt += (c > 0u) ? 1u : 0u; mine = (j == x) ? c : mine; }
        if (sum == G) break;
        __builtin_amdgcn_s_sleep(1);
        if ((++sp & 255u) == 0u) { if (xb_ld(&bar[XB_TMO])) break; if (sp > XB_SPIN_CAP) { atomicAdd(&bar[XB_TMO], 1u); break; } }
    }
    nloc = mine > 0u ? mine : 1u; nx = cnt > 0u ? cnt : 1u;
}

__device__ __forceinline__ void xcd_barrier(const XcdBarrier& b, const bool leader_thread) {
    asm volatile("s_waitcnt vmcnt(0)" ::: "memory");
    __syncthreads();
    if (leader_thread) {
        unsigned* bar = b.bar;
        __builtin_amdgcn_s_waitcnt(0);
        unsigned nloc = b.st[0], nx = b.st[1];
        if (nloc == 0u) { xcd_barrier_complete(bar, b.x, nloc, nx); b.st[0] = nloc; b.st[1] = nx; }
        const unsigned old = xb_add(&bar[XB_XSUB(b.x)], 1u);
        const unsigned gen = old / nloc;
        if (old + 1u == (gen + 1u) * nloc) {
            __builtin_amdgcn_fence(__ATOMIC_RELEASE, "agent");
            asm volatile("s_waitcnt vmcnt(0)" ::: "memory");
            const unsigned og = xb_add(&bar[XB_TOP], 1u);
            const unsigned tg = og / nx;
            if (og + 1u == (tg + 1u) * nx) xb_add(&bar[XB_TOPGEN], 1u);
            else XB_SPIN(xb_ld(&bar[XB_TOPGEN]) == tg, bar);
            __builtin_amdgcn_fence(__ATOMIC_ACQUIRE, "agent");
            xb_add(&bar[XB_XGEN(b.x)], 1u);
            asm volatile("s_waitcnt vmcnt(0)" ::: "memory");
        } else {
            XB_SPIN(xb_ld(&bar[XB_XGEN(b.x)]) == gen, bar);
            __builtin_amdgcn_fence(__ATOMIC_ACQUIRE, "agent");
            asm volatile("s_waitcnt vmcnt(0)" ::: "memory");
        }
    }
    __syncthreads();
}

template <int ST> __device__ __forceinline__ void run_stage(const Args& args, unsigned char* lds, int Lr, int wave_s) {
    const int L = Lr;
    Ctx C;
    { int t = wave_s * 64 + lane_now(); C.tid = t; }
    C.lds = lds; C.lane = C.tid & 63; C.wave = __builtin_amdgcn_readfirstlane(C.tid >> 6); C.G = gridDim.x; C.bid = blockIdx.x;
    C.x = args.in[0]; C.norm_g = args.in[1]; C.w_in = args.in[2]; C.ln_g = args.in[3]; C.ln_b = args.in[4]; C.sgu_w = args.in[5]; C.sgu_b = args.in[6];
    C.w_out = args.in[7]; C.rel_bias = args.in[8]; C.final_g = args.in[9]; C.out = args.out; C.ws = args.ws;
    asm volatile("" : "+s"(C.ws), "+s"(C.out), "+s"(C.x), "+s"(C.sgu_b), "+s"(C.ln_g), "+s"(C.ln_b));
    if constexpr (ST == 0) phase_prologue(C);
    else if constexpr (ST == 1) {
        pg8::Gemm g{(const pg8::bf16_t*)(C.ws + WS_XB), (const pg8::bf16_t*)(C.ws + WS_WIN) + (size_t)L * DIN * DM, MROWS, DIN, DM};
        pg8::StaticOrder S; S.init(MROWS, DIN, C.G, C.bid);
        int pmA = -1, pmB = -1, pmC = -1, pmD = -1;
        { pg8::Unit uu;
          for (int i = 0; S.next(i, uu); ++i) { const int pmu = uu.pm;
              if (pmu == pmA || pmu == pmB || pmu == pmC || pmu == pmD) continue;
              if (pmA < 0) pmA = pmu; else if (pmB < 0) pmB = pmu; else if (pmC < 0) pmC = pmu; else if (pmD < 0) pmD = pmu; } }
        float* rtab = (float*)(lds + RING_BYTES);
        { const float* rowss = (const float*)(C.ws + WS_ROWSS);
#pragma unroll
          for (int k = 0; k < 2; ++k) { const int e = C.tid + 512 * k, sl = e >> 8, pmk = sl == 0 ? pmA : sl == 1 ? pmB : sl == 2 ? pmC : pmD;
              if (pmk >= 0) { const f32x4* rp = (const f32x4*)(rowss + ((size_t)pmk * 256 + (e & 255)) * 16); const f32x4 s0 = rp[0], s1 = rp[1], s2 = rp[2], s3 = rp[3];
                  const float ss = ((s0[0] + s0[1]) + (s0[2] + s0[3])) + ((s1[0] + s1[1]) + (s1[2] + s1[3])) + ((s2[0] + s2[1]) + (s2[2] + s2[3])) + ((s3[0] + s3[1]) + (s3[2] + s3[3]));
                  rtab[e] = 1.0f / sqrtf(ss * (1.0f / 1024.0f) + NORM_EPS); } }
          __syncthreads(); }
        pg8::EpiProj E{(pg8::bf16_t*)(C.ws + WS_PROJ), SUBSTRIDE, rtab, pmA, pmB, pmC, pmD, (float*)(C.ws + WS_KMEAN) + (size_t)L * NBH * NBLK * 64};
        pg8::gemm_phase<pg8::EpiProj, pg8::StaticOrder, true, true>((PG8_LAS unsigned char*)lds, g, S, E, C.tid);
    }
    else if constexpr (ST == 3) { phase_gate(C, L); phase_sgu(C, L); }
    else if constexpr (ST == 4) phase_attn(C, L);
    else if constexpr (ST == 5) phase_combine(C);
    else if constexpr (ST == 6) {
        pg8::Gemm g{(const pg8::bf16_t*)(C.ws + WS_MIX), (const pg8::bf16_t*)(C.ws + WS_WOUT) + (size_t)L * DM * DM, MROWS, DM, DM};
        pg8::StaticOrder S; S.init(MROWS, DM, C.G, C.bid);
        if (L == 0) { pg8::EpiRes E{(pg8::bf16_t*)(C.ws + WS_XB), (float*)(C.ws + WS_ROWSS)};
            pg8::gemm_phase<pg8::EpiRes, pg8::StaticOrder, true, true>((PG8_LAS unsigned char*)lds, g, S, E, C.tid); }
        else { pg8::EpiFinal E{(const pg8::bf16_t*)(C.ws + WS_XB), C.out, C.final_g, (float*)(C.ws + WS_ROWSS), (unsigned*)(C.ws + WS_CTL) + 8192};
            pg8::gemm_phase<pg8::EpiFinal, pg8::StaticOrder, true, true>((PG8_LAS unsigned char*)lds, g, S, E, C.tid); }
    } else if constexpr (ST == 7) phase_check_inject(C);
    else if constexpr (ST == 8) phase_attn_simple(C, (bf16*)(C.ws + 104 * MiB));
    else if constexpr (ST == 9) {
        const bf16* A = (const bf16*)(C.ws + WS_MIX); const bf16* B = (const bf16*)(C.ws + 104 * MiB); unsigned* flag = (unsigned*)(C.ws + WS_CTL) + 32;
        float md = 0.f;
        for (size_t idx = (size_t)C.bid * 512 + C.tid; idx < (size_t)MROWS * 512; idx += (size_t)C.G * 512) {
            const size_t row = idx >> 9, col = 512 + (idx & 511);
            const float a = __uint_as_float((unsigned)A[row * 1024 + col] << 16), r = __uint_as_float((unsigned)B[row * 1024 + col] << 16);
            float sc = fabsf(r);
#pragma unroll
            for (int o = 1; o < 64; o <<= 1) sc = fmaxf(sc, __shfl_xor(sc, o));
            const float d = fabsf(a - r) / (0.02f + sc);
            md = (d > md || !(d == d)) ? (d == d ? d : 1e6f) : md;
        }
        atomicMax(flag, __float_as_uint(md));
    }
}
template <int SEL> __global__ void __launch_bounds__(NWAVES * 64, 2) fwd(Args args) {
    extern __shared__ __attribute__((aligned(16))) unsigned char lds[];
    const int wave_s = __builtin_amdgcn_readfirstlane((int)threadIdx.x >> 6);
    if constexpr (SEL >= 0) run_stage<SEL>(args, lds, args.layer, wave_s);
    else {
        if (args.pad == 0x7fffffff) cg::this_grid().sync();
        volatile LAS unsigned* bst = (volatile LAS unsigned*)((LAS unsigned char*)lds + LDS_BARST);
        if (threadIdx.x == 0) { bst[0] = 0u; bst[1] = 0u; }
        __syncthreads();
        XcdBarrier bar = xcd_barrier_post((unsigned*)(args.ws + WS_CTL) + CW_BAR, bst);
#define GRID_SYNC() do { XcdBarrier b2_ = bar; asm volatile("" : "+s"(b2_.bar), "+s"(b2_.x)); xcd_barrier(b2_, wave_s == 0 && lane_now() == 0); } while (0)
#define RUN(k, L) do { run_stage<k>(args, lds, L, wave_s); GRID_SYNC(); } while (0)
        RUN(0, 0);
        for (int L = 0; L < DEPTH; ++L) {
            RUN(1, L); RUN(3, L); RUN(4, L); RUN(5, L);
            if (L == DEPTH - 1) run_stage<6>(args, lds, L, wave_s); else RUN(6, L);
        }
    }
}

#ifndef MK_N_LAUNCHES
#define MK_N_LAUNCHES 1
#endif
template <int SEL> static void launch_stage(int grid, Args a, int layer, hipStream_t stream) {
    static bool attr = false;
    if (!attr) { (void)hipFuncSetAttribute((const void*)fwd<SEL>, hipFuncAttributeMaxDynamicSharedMemorySize, LDS_BYTES); attr = true; }
    a.layer = layer;
    hipLaunchKernelGGL(fwd<SEL>, dim3(grid), dim3(NWAVES * 64), LDS_BYTES, stream, a);
}
extern "C" void kernel_launch(void* const* d_in, const int* in_sizes, int n_in, void* d_out, int out_size, void* d_ws, size_t ws_size, hipStream_t stream) {
    static int grid = 0;
    if (grid == 0) {
        if (n_in != 10 || out_size != MROWS * DM || ws_size < WS_END) { fprintf(stderr, "kernel_launch: unexpected shapes (n_in %d out %d ws %zu)\n", n_in, out_size, ws_size); grid = -1; return; }
        int dev = 0, cus = 0;
        (void)hipGetDevice(&dev); (void)hipDeviceGetAttribute(&cus, hipDeviceAttributeMultiprocessorCount, dev);
        grid = cus;
        if (grid != 256) fprintf(stderr, "kernel_launch: %d CUs: the fused final-norm epilogue pairs the four column tiles of a row panel inside one round of a 256-workgroup grid\n", grid);
#if MK_N_LAUNCHES == 1
        int per_cu = 0;
        if (hipFuncSetAttribute((const void*)fwd<-1>, hipFuncAttributeMaxDynamicSharedMemorySize, LDS_BYTES) != hipSuccess) { fprintf(stderr, "kernel_launch: hipFuncSetAttribute failed\n"); grid = -1; return; }
        if (hipOccupancyMaxActiveBlocksPerMultiprocessor(&per_cu, (const void*)fwd<-1>, NWAVES * 64, LDS_BYTES) != hipSuccess || per_cu < 1) { fprintf(stderr, "kernel_launch: occupancy query says %d\n", per_cu); grid = -1; return; }
        (void)hipGetLastError();
#endif
    }
    if (grid < 0) return;
    (void)hipMemsetAsync((char*)d_ws + WS_CTL, 0, CTL_ZERO_BYTES, stream);
    Args a{};
    for (int i = 0; i < 10; ++i) a.in[i] = (const float*)d_in[i];
    a.out = (float*)d_out; a.ws = (unsigned char*)d_ws;
#if MK_N_LAUNCHES == 1
    void* kargs[] = {&a};
    hipError_t e = hipLaunchCooperativeKernel((const void*)fwd<-1>, dim3(grid), dim3(NWAVES * 64), kargs, LDS_BYTES, stream);
    if (e != hipSuccess) fprintf(stderr, "kernel_launch: cooperative launch failed: %s\n", hipGetErrorString(e));
#else
    launch_stage<0>(grid, a, 0, stream);
    for (int L = 0; L < DEPTH; ++L) {
        launch_stage<1>(grid, a, L, stream); launch_stage<3>(grid, a, L, stream);
        launch_stage<4>(grid, a, L, stream); launch_stage<5>(grid, a, L, stream);
        if (CHECK_ATTN && L == 0) { launch_stage<8>(grid, a, L, stream); launch_stage<9>(grid, a, L, stream); }
        launch_stage<6>(grid, a, L, stream);
    }
    if (CHECK_ATTN) launch_stage<7>(grid, a, 0, stream);
#endif
}
```

```cpp
#include <hip/hip_runtime.h>
#include <hip/hip_cooperative_groups.h>
#include <cstdio>
#include <cstdint>
namespace cg = cooperative_groups;

constexpr int BATCH = 2, SEQ = 16384, DM = 1024, MROWS = BATCH * SEQ, DIN = 3584, DSUB = 512;
constexpr int NH = 8, DH = 64, NBLK = SEQ / 256, NBH = BATCH * NH, DEPTH = 2;
constexpr float NORM_EPS = 1e-6f, LN_EPS = 1e-5f;
constexpr float LOG2E = 1.4426950408889634f;
#ifndef CHECK_ATTN
#define CHECK_ATTN 0
#endif
constexpr float QSCALE = 0.125f * LOG2E;
namespace pg8 {
#define PG8_LAS __attribute__((address_space(3)))
typedef unsigned short bf16_t;
typedef short bf16x8 __attribute__((ext_vector_type(8)));
typedef float f32x4 __attribute__((ext_vector_type(4)));
typedef unsigned u32x4 __attribute__((ext_vector_type(4)));
constexpr int BM = 256, BK = 64, HALF = 128, HTB = HALF * BK * 2  , STAGE_BYTES = 8 * HTB, NXCD = 8, WGM = 8;

__host__ __device__ __forceinline__ int lds_byte(int r, int c) { const int st = (r >> 4) * 2 + (c >> 5), rr = r & 15, cc = c & 31, ob = rr * 64 + cc * 2; return st * 1024 + (ob ^ (((ob >> 9) & 1) << 5)); }
__host__ __device__ __forceinline__ void stage_rc(int b, int& R, int& C) { const int st = b / 1024, sb = b % 1024, swz = sb ^ (((sb >> 9) & 1) << 5); R = (st >> 1) * 16 + swz / 64; C = (st & 1) * 32 + (swz % 64) / 2; }
__host__ __device__ __forceinline__ int perm32(int rho) { const int n = rho >> 4, i = rho & 15; return 8 * (i >> 2) + 4 * n + (i & 3); }

struct Unit { int pm, pn; };
struct Gemm { const bf16_t* A; const bf16_t* Bt; int M, N, K; };

struct StaticOrder {
    int nM, nN, nwg, G, c;
    __host__ __device__ void init(int M, int N, int G_, int c_) { nM = M / BM; nN = N / BM; nwg = nM * nN; G = G_; c = c_; }
    __host__ __device__ bool next(int i, Unit& u) const {
        const long L = (long)i * G + c; if (L >= nwg) return false;
        int wgid = (int)L; { const int q = nwg / NXCD, r = nwg % NXCD, xcd = wgid % NXCD, off = wgid / NXCD; wgid = (xcd < r ? xcd * (q + 1) : r * (q + 1) + (xcd - r) * q) + off; }
        const int nig = WGM * nN, gid = wgid / nig, fm = gid * WGM, gsz = (nM - fm) < WGM ? (nM - fm) : WGM;
        u.pm = fm + ((wgid % nig) % gsz); u.pn = (wgid % nig) / gsz; return true;
    }
    __device__ __forceinline__ void a_ready(const Unit&) const {}
    __device__ __forceinline__ void done(const Unit&) const {}
};

__device__ __forceinline__ unsigned cvt_pk_bf16(float lo, float hi) { unsigned r; asm volatile("v_cvt_pk_bf16_f32 %0, %1, %2" : "=v"(r) : "v"(lo), "v"(hi)); return r; }
typedef float f32x2 __attribute__((ext_vector_type(2)));
typedef float f32x2 __attribute__((ext_vector_type(2)));
__device__ __forceinline__ float act_gelu(float x) {
    const float u = x * (1.0f + 0.044715f * x * x);
    const float e = __builtin_amdgcn_exp2f(u * (-2.0f * 0.7978845608028654f * 1.4426950408889634f));
    return x * __builtin_amdgcn_rcpf(1.0f + e);
}
__device__ __forceinline__ float act_silu(float x) {
    const float e = __builtin_amdgcn_exp2f(x * (-1.4426950408889634f));
    return x * __builtin_amdgcn_rcpf(1.0f + e);
}
struct EpiProj {
    static constexpr bool PERM = true, AFTER_DRAIN = false;
    bf16_t* P; size_t sub_stride; const float* rstd_lds; int pm0, pm1, pm2, pm3; float* kmean;
    __device__ __forceinline__ void operator()(const f32x4 (&acc)[2][2][4][2], const Unit& u, int wr, int wc, int fr, int fq) const {
        const int t = u.pn >> 1;
        bf16_t* base = P + (size_t)t * sub_stride;
        const int col0 = (u.pn & 1) * 256 + wc * 32 + 8 * fq;
        const int row0 = u.pm * BM + wr * 64 + fr;
        const int slot = (u.pm == pm0) ? 0 : (u.pm == pm1) ? 1 : (u.pm == pm2) ? 2 : 3;
        const float* rt = rstd_lds + slot * 256 + wr * 64 + fr;
        const float qs = (t == 3) ? (0.125f * 1.4426950408889634f) : 1.0f;
        float ks[2][8];
#pragma unroll
        for (int bj = 0; bj < 2; ++bj)
#pragma unroll
            for (int e = 0; e < 8; ++e) ks[bj][e] = 0.f;
#pragma unroll
        for (int ai = 0; ai < 2; ++ai)
#pragma unroll
            for (int m = 0; m < 4; ++m) {
                const int row = row0 + ai * HALF + m * 16;
                const float rs = rt[ai * HALF + m * 16] * qs;
                bf16_t* rowp = base + (size_t)row * 512 + col0;
#pragma unroll
                for (int bj = 0; bj < 2; ++bj) {
                    const f32x4 v0 = acc[ai][bj][m][0] * rs, v1 = acc[ai][bj][m][1] * rs;
                    if (t == 4) {
#pragma unroll
                        for (int e = 0; e < 4; ++e) { ks[bj][e] += v0[e]; ks[bj][4 + e] += v1[e]; }
                    }
                    u32x4 w; w.x = cvt_pk_bf16(v0[0], v0[1]); w.y = cvt_pk_bf16(v0[2], v0[3]); w.z = cvt_pk_bf16(v1[0], v1[1]); w.w = cvt_pk_bf16(v1[2], v1[3]);
                    *(u32x4*)(rowp + bj * HALF) = w;
                }
            }
        if (t == 4) {
            const int b = u.pm >> 6, n = u.pm & 63;
#pragma unroll
            for (int bj = 0; bj < 2; ++bj)
#pragma unroll
                for (int e = 0; e < 8; ++e) {
                    float v = ks[bj][e];
                    v += __shfl_xor(v, 1); v += __shfl_xor(v, 2); v += __shfl_xor(v, 4); v += __shfl_xor(v, 8);
                    if (fr == 0) { const int col = col0 + bj * HALF + e; atomicAdd(kmean + ((size_t)((b * 8 + (col >> 6)) * 64 + n)) * 64 + (col & 63), v * (1.0f / 256.0f)); }
                }
        }
    }
};
#define PG8_GAS __attribute__((address_space(1)))
struct EpiRes {
    static constexpr bool PERM = false, AFTER_DRAIN = false;
    bf16_t* xb; float* rowss;
    __device__ __forceinline__ void operator()(const f32x4 (&acc)[2][2][4][2], const Unit& u, int wr, int wc, int fr, int fq) const {
        typedef unsigned u32x2v __attribute__((ext_vector_type(2)));
        const int col0 = u.pn * BM + wc * 32 + 4 * fq;
        PG8_GAS bf16_t* xbg = (PG8_GAS bf16_t*)xb; PG8_GAS float* rsg = (PG8_GAS float*)rowss;
        const size_t offb = (size_t)(u.pm * BM + wr * 64 + fr) * 1024 + col0;
        u32x2v rr[2][4][2][2];
#pragma unroll
        for (int ai = 0; ai < 2; ++ai)
#pragma unroll
            for (int m = 0; m < 4; ++m)
#pragma unroll
                for (int bj = 0; bj < 2; ++bj)
#pragma unroll
                    for (int n = 0; n < 2; ++n) rr[ai][m][bj][n] = *(const PG8_GAS u32x2v*)(xbg + offb + (size_t)(ai * HALF + m * 16) * 1024 + bj * HALF + n * 16);
#pragma unroll
        for (int ai = 0; ai < 2; ++ai)
#pragma unroll
            for (int m = 0; m < 4; ++m) {
                const int row = u.pm * BM + ai * HALF + wr * 64 + m * 16 + fr;
                float ss = 0.f;
#pragma unroll
                for (int bj = 0; bj < 2; ++bj)
#pragma unroll
                    for (int n = 0; n < 2; ++n) {
                        const u32x2v w0 = rr[ai][m][bj][n];
                        const f32x4 r = (f32x4){__uint_as_float(w0.x << 16), __uint_as_float(w0.x & 0xffff0000u), __uint_as_float(w0.y << 16), __uint_as_float(w0.y & 0xffff0000u)};
                        const f32x4 o = r + acc[ai][bj][m][n];
                        ss += (o[0] * o[0] + o[1] * o[1]) + (o[2] * o[2] + o[3] * o[3]);
                        u32x2v w; w.x = cvt_pk_bf16(o[0], o[1]); w.y = cvt_pk_bf16(o[2], o[3]);
                        *(PG8_GAS u32x2v*)(xbg + offb + (size_t)(ai * HALF + m * 16) * 1024 + bj * HALF + n * 16) = w;
                    }
                ss += __shfl_xor(ss, 16); ss += __shfl_xor(ss, 32);
                if (fq == 0) rsg[(size_t)row * 16 + u.pn * 4 + wc] = ss;
            }
    }
};
struct EpiFinal {
    static constexpr bool PERM = false, AFTER_DRAIN = false;
    const bf16_t* xb; float* out; const float* fg; float* slots; unsigned* cnt;
    __device__ __forceinline__ void operator()(f32x4 (&acc)[2][2][4][2], const Unit& u, int wr, int wc, int fr, int fq) const {
        typedef unsigned u32x2v __attribute__((ext_vector_type(2)));
        const int col0 = u.pn * BM + wc * 32 + 4 * fq;
        const PG8_GAS bf16_t* xbg = (const PG8_GAS bf16_t*)xb; PG8_GAS float* outg = (PG8_GAS float*)out; const PG8_GAS float* slg = (const PG8_GAS float*)slots;
        const size_t offb = (size_t)(u.pm * BM + wr * 64 + fr) * 1024 + col0;
        u32x2v rr[2][4][2][2];
#pragma unroll
        for (int ai = 0; ai < 2; ++ai)
#pragma unroll
            for (int m = 0; m < 4; ++m)
#pragma unroll
                for (int bj = 0; bj < 2; ++bj)
#pragma unroll
                    for (int n = 0; n < 2; ++n) rr[ai][m][bj][n] = *(const PG8_GAS u32x2v*)(xbg + offb + (size_t)(ai * HALF + m * 16) * 1024 + bj * HALF + n * 16);
#pragma unroll
        for (int ai = 0; ai < 2; ++ai)
#pragma unroll
            for (int m = 0; m < 4; ++m) {
                const int row = u.pm * BM + ai * HALF + wr * 64 + m * 16 + fr;
                float ss = 0.f;
#pragma unroll
                for (int bj = 0; bj < 2; ++bj)
#pragma unroll
                    for (int n = 0; n < 2; ++n) {
                        const u32x2v w = rr[ai][m][bj][n];
                        const f32x4 r = (f32x4){__uint_as_float(w.x << 16), __uint_as_float(w.x & 0xffff0000u), __uint_as_float(w.y << 16), __uint_as_float(w.y & 0xffff0000u)};
                        const f32x4 o = r + acc[ai][bj][m][n];
                        acc[ai][bj][m][n] = o;
                        ss += (o[0] * o[0] + o[1] * o[1]) + (o[2] * o[2] + o[3] * o[3]);
                    }
                ss += __shfl_xor(ss, 16); ss += __shfl_xor(ss, 32);
                if (fq == 0) __hip_atomic_store(slots + (size_t)row * 16 + u.pn * 4 + wc, ss, __ATOMIC_RELAXED, __HIP_MEMORY_SCOPE_AGENT);
            }
        asm volatile("s_waitcnt vmcnt(0)" ::: "memory");
        unsigned* pc = cnt + 64 * u.pm;
        if (fr == 0 && fq == 0) __hip_atomic_fetch_add(pc, 1u, __ATOMIC_RELAXED, __HIP_MEMORY_SCOPE_AGENT);
        f32x4 g4[2][2];
#pragma unroll
        for (int bj = 0; bj < 2; ++bj)
#pragma unroll
            for (int n = 0; n < 2; ++n) g4[bj][n] = *(const PG8_GAS f32x4*)((const PG8_GAS float*)fg + col0 + bj * HALF + n * 16);
        for (unsigned spins = 0; spins < (1u << 22); ++spins) {
            if (__hip_atomic_load(pc, __ATOMIC_RELAXED, __HIP_MEMORY_SCOPE_AGENT) >= 32u) break;
            __builtin_amdgcn_s_sleep(2);
        }
        __builtin_amdgcn_fence(__ATOMIC_ACQUIRE, "agent");
        asm volatile("s_waitcnt vmcnt(0)" ::: "memory");
#pragma unroll
        for (int ai = 0; ai < 2; ++ai) {
            f32x4 sl[4][4];
#pragma unroll
            for (int m = 0; m < 4; ++m)
#pragma unroll
                for (int k = 0; k < 4; ++k) sl[m][k] = *(const PG8_GAS f32x4*)(slg + (size_t)(u.pm * BM + ai * HALF + wr * 64 + m * 16 + fr) * 16 + k * 4);
#pragma unroll
            for (int m = 0; m < 4; ++m) {
                const f32x4 s0 = sl[m][0], s1 = sl[m][1], s2 = sl[m][2], s3 = sl[m][3];
                const float tot = ((s0[0] + s0[1]) + (s0[2] + s0[3])) + ((s1[0] + s1[1]) + (s1[2] + s1[3])) + ((s2[0] + s2[1]) + (s2[2] + s2[3])) + ((s3[0] + s3[1]) + (s3[2] + s3[3]));
                const float rs = 1.0f / sqrtf(tot * (1.0f / 1024.0f) + 1e-6f);
#pragma unroll
                for (int bj = 0; bj < 2; ++bj)
#pragma unroll
                    for (int n = 0; n < 2; ++n) *(PG8_GAS f32x4*)(outg + offb + (size_t)(ai * HALF + m * 16) * 1024 + bj * HALF + n * 16) = acc[ai][bj][m][n] * rs * g4[bj][n];
            }
        }
    }
};
template <class Epi, class Sched, bool ALIGN_EPI = false, bool SP2 = false>
__device__ __forceinline__ void gemm_phase(PG8_LAS unsigned char* lds, const Gemm g, const Sched& S, const Epi& E, const int tid) {
    const int wid = __builtin_amdgcn_readfirstlane(tid >> 6), lane = tid & 63, wr = wid >> 2, wc = wid & 3, fr = lane & 15, fq = lane >> 4;
    const int K = g.K, nt = K / BK;
    unsigned voffA[2], voffB[2];
#pragma unroll
    for (int i = 0; i < 2; ++i) { int R, C; stage_rc(tid * 16 + i * 8192, R, C); const int Rb = Epi::PERM ? ((R & ~31) + perm32(R & 31)) : R;
        voffA[i] = (unsigned)(R * K + C) * 2u; voffB[i] = (unsigned)(Rb * K + C) * 2u; }
    const size_t kstep = (size_t)(BK * 2);
    const size_t hstep = (size_t)HALF * K * 2;
    const size_t tstep = 2 * hstep;
    const unsigned ldsw = (unsigned)wid * 1024u;
    const int aoff = lds_byte(wr * 64 + fr, fq * 8), boff = lds_byte(wc * 32 + fr, fq * 8);
#define PG8_SA(b, h) (((b) * 2 + (h)) * HTB)
#define PG8_SB(b, h) ((4 + (b) * 2 + (h)) * HTB)
#define PG8_STAGE(bufoff, gbase, voff) do { _Pragma("unroll") for (int _i = 0; _i < 2; ++_i) \
        __builtin_amdgcn_global_load_lds((const unsigned*)((const char*)(gbase) + (voff)[_i]), (PG8_LAS unsigned*)(lds + (bufoff) + ldsw + _i * 8192), 16, 0, 0); } while (0)
#define PG8_LDA(dst, b, h) do { _Pragma("unroll") for (int m = 0; m < 4; ++m) _Pragma("unroll") for (int k = 0; k < 2; ++k) dst[m][k] = *(const PG8_LAS bf16x8*)(lds + PG8_SA(b, h) + aoff + m * 2048 + k * 1024); } while (0)
#define PG8_LDB(dst, b, h) do { _Pragma("unroll") for (int n = 0; n < 2; ++n) _Pragma("unroll") for (int k = 0; k < 2; ++k) dst[n][k] = *(const PG8_LAS bf16x8*)(lds + PG8_SB(b, h) + boff + n * 2048 + k * 1024); } while (0)
#define PG8_MMA(ai, bj, At, Bt) do { __builtin_amdgcn_s_setprio(1); _Pragma("unroll") for (int m = 0; m < 4; ++m) _Pragma("unroll") for (int n = 0; n < 2; ++n) _Pragma("unroll") for (int k = 0; k < 2; ++k) \
        acc[ai][bj][m][n] = __builtin_amdgcn_mfma_f32_16x16x32_bf16(Bt[n][k], At[m][k], acc[ai][bj][m][n], 0, 0, 0); __builtin_amdgcn_s_setprio(0); } while (0)
#define PG8_WAIT_V(n) asm volatile("s_waitcnt vmcnt(" #n ")" ::: "memory")
#define PG8_WAIT_L(n) asm volatile("s_waitcnt lgkmcnt(" #n ")" ::: "memory")
#define PG8_BAR __builtin_amdgcn_s_barrier()
#define PG8_SCHED __builtin_amdgcn_sched_barrier(0)
    Unit cur, nxt; int ui = 0;
    if (!S.next(0, cur)) return;
    f32x4 acc[2][2][4][2];
#pragma unroll
    for (int a = 0; a < 2; ++a)
#pragma unroll
        for (int b = 0; b < 2; ++b)
#pragma unroll
            for (int m = 0; m < 4; ++m)
#pragma unroll
                for (int n = 0; n < 2; ++n) acc[a][b][m][n] = (f32x4){0.f, 0.f, 0.f, 0.f};
    bf16x8 At[4][2], B0[2][2], B1[2][2];
    const char* cA = (const char*)g.A + (size_t)cur.pm * tstep; const char* cB = (const char*)g.Bt + (size_t)cur.pn * tstep;
    S.a_ready(cur);
    if constexpr (SP2) {
        PG8_STAGE(PG8_SB(0, 0), cB, voffB); PG8_STAGE(PG8_SB(0, 1), cB + hstep, voffB); PG8_STAGE(PG8_SA(0, 0), cA, voffA); PG8_STAGE(PG8_SA(0, 1), cA + hstep, voffA);
        if (wr == 1) PG8_BAR;
        PG8_WAIT_V(2); PG8_BAR;
        PG8_STAGE(PG8_SB(1, 0), cB + kstep, voffB); PG8_STAGE(PG8_SA(1, 0), cA + kstep, voffA); PG8_STAGE(PG8_SB(1, 1), cB + hstep + kstep, voffB);
        PG8_WAIT_V(6); PG8_BAR;
    } else {
        PG8_STAGE(PG8_SB(0, 0), cB, voffB); PG8_STAGE(PG8_SA(0, 0), cA, voffA); PG8_STAGE(PG8_SB(0, 1), cB + hstep, voffB); PG8_STAGE(PG8_SA(0, 1), cA + hstep, voffA);
        if (wr == 1) PG8_BAR;
        PG8_WAIT_V(4); PG8_BAR;
        PG8_STAGE(PG8_SB(1, 0), cB + kstep, voffB); PG8_STAGE(PG8_SA(1, 0), cA + kstep, voffA); PG8_STAGE(PG8_SB(1, 1), cB + hstep + kstep, voffB);
        PG8_WAIT_V(6); PG8_BAR;
    }
    for (;;) {
        const bool has_next = S.next(ui + 1, nxt);
        const char* nA = has_next ? (const char*)g.A + (size_t)nxt.pm * tstep : cA; const char* nB = has_next ? (const char*)g.Bt + (size_t)nxt.pn * tstep : cB;
        for (int t = 0; t < nt; t += 2) {
            const bool last = (t == nt - 2);
            const char* a1 = cA + (size_t)(t + 1) * kstep;
            const char* a2 = last ? nA : cA + (size_t)(t + 2) * kstep; const char* b2 = last ? nB : cB + (size_t)(t + 2) * kstep;
            const char* a3 = a2 + kstep; const char* b3 = b2 + kstep;
            if (last && has_next) S.a_ready(nxt);
            if constexpr (SP2) {
            PG8_LDB(B0, 0, 0); PG8_LDB(B1, 0, 1); PG8_SCHED; PG8_LDA(At, 0, 0); PG8_STAGE(PG8_SA(1, 1), a1 + hstep, voffA);
            PG8_WAIT_V(8); PG8_WAIT_L(0); PG8_BAR; PG8_MMA(0, 0, At, B0); PG8_MMA(0, 1, At, B1); PG8_BAR; PG8_SCHED;
            PG8_LDA(At, 0, 1); PG8_STAGE(PG8_SB(0, 0), b2, voffB); PG8_STAGE(PG8_SB(0, 1), b2 + hstep, voffB); PG8_STAGE(PG8_SA(0, 0), a2, voffA);
            PG8_WAIT_V(8); PG8_WAIT_L(0); PG8_BAR; PG8_MMA(1, 0, At, B0); PG8_MMA(1, 1, At, B1); PG8_BAR; PG8_SCHED;
            PG8_LDB(B0, 1, 0); PG8_LDB(B1, 1, 1); PG8_SCHED; PG8_LDA(At, 1, 0); PG8_STAGE(PG8_SA(0, 1), a2 + hstep, voffA);
            PG8_WAIT_V(8); PG8_WAIT_L(0); PG8_BAR; PG8_MMA(0, 0, At, B0); PG8_MMA(0, 1, At, B1); PG8_BAR; PG8_SCHED;
            PG8_LDA(At, 1, 1); PG8_STAGE(PG8_SB(1, 0), b3, voffB); PG8_STAGE(PG8_SB(1, 1), b3 + hstep, voffB); PG8_STAGE(PG8_SA(1, 0), a3, voffA);
            PG8_WAIT_V(8); PG8_WAIT_L(0); PG8_BAR; PG8_MMA(1, 0, At, B0); PG8_MMA(1, 1, At, B1); PG8_BAR; PG8_SCHED;
            } else {
            PG8_LDB(B0, 0, 0); PG8_SCHED; PG8_LDA(At, 0, 0); PG8_STAGE(PG8_SA(1, 1), a1 + hstep, voffA);
            PG8_WAIT_L(8); PG8_BAR; PG8_WAIT_L(0); PG8_MMA(0, 0, At, B0); PG8_BAR; PG8_SCHED;
            PG8_LDB(B1, 0, 1); PG8_STAGE(PG8_SB(0, 0), b2, voffB);
            PG8_BAR; PG8_WAIT_L(0); PG8_MMA(0, 1, At, B1); PG8_BAR;
            PG8_LDA(At, 0, 1); PG8_STAGE(PG8_SA(0, 0), a2, voffA);
            PG8_BAR; PG8_WAIT_L(0); PG8_MMA(1, 0, At, B0); PG8_BAR; PG8_SCHED;
            PG8_STAGE(PG8_SB(0, 1), b2 + hstep, voffB);
            PG8_WAIT_V(6); PG8_BAR; PG8_MMA(1, 1, At, B1); PG8_BAR;
            PG8_LDB(B0, 1, 0); PG8_SCHED; PG8_LDA(At, 1, 0); PG8_STAGE(PG8_SA(0, 1), a2 + hstep, voffA);
            PG8_WAIT_L(8); PG8_BAR; PG8_WAIT_L(0); PG8_MMA(0, 0, At, B0); PG8_BAR; PG8_SCHED;
            PG8_LDB(B1, 1, 1); PG8_STAGE(PG8_SB(1, 0), b3, voffB);
            PG8_BAR; PG8_WAIT_L(0); PG8_MMA(0, 1, At, B1); PG8_BAR;
            PG8_LDA(At, 1, 1); PG8_STAGE(PG8_SA(1, 0), a3, voffA);
            PG8_BAR; PG8_WAIT_L(0); PG8_MMA(1, 0, At, B0); PG8_BAR; PG8_SCHED;
            PG8_STAGE(PG8_SB(1, 1), b3 + hstep, voffB);
            PG8_WAIT_V(6); PG8_BAR; PG8_MMA(1, 1, At, B1); PG8_BAR;
            }
        }
        if constexpr (ALIGN_EPI) { if (wr == 0) PG8_BAR; }
        if constexpr (!Epi::AFTER_DRAIN) { int ln_; asm volatile("v_mbcnt_lo_u32_b32 %0, -1, 0\n\tv_mbcnt_hi_u32_b32 %0, -1, %0" : "=v"(ln_)); E(acc, cur, wr, wc, ln_ & 15, ln_ >> 4); S.done(cur); }
        if (!has_next) break;
#pragma unroll
        for (int a = 0; a < 2; ++a)
#pragma unroll
            for (int b = 0; b < 2; ++b)
#pragma unroll
                for (int m = 0; m < 4; ++m)
#pragma unroll
                    for (int n = 0; n < 2; ++n) acc[a][b][m][n] = (f32x4){0.f, 0.f, 0.f, 0.f};
        cur = nxt; cA = nA; cB = nB; ++ui;
        if constexpr (ALIGN_EPI) { if (wr == 1) PG8_BAR; }
    }
    PG8_WAIT_V(0);
    if constexpr (!ALIGN_EPI) { if (wr == 0) PG8_BAR; }
    PG8_BAR;
    if constexpr (Epi::AFTER_DRAIN) { E.fused(acc, cur, wr, wc, fr, fq, lds, wid, lane); S.done(cur); }
#undef PG8_SA
#undef PG8_SB
#undef PG8_STAGE
#undef PG8_LDA
#undef PG8_LDB
#undef PG8_MMA
#undef PG8_WAIT_V
#undef PG8_WAIT_L
#undef PG8_BAR
#undef PG8_SCHED
}
}

constexpr size_t MiB = 1u << 20;
constexpr size_t WS_CTL = 0, CTL_ZERO_BYTES = 1 * MiB;
constexpr size_t WS_WIN = 2 * MiB;
constexpr size_t WS_WOUT = 16 * MiB;
constexpr size_t WS_WST = 20 * MiB;
constexpr size_t WS_BT = 21 * MiB;
constexpr size_t WS_KMEAN = 22 * MiB;
constexpr size_t WS_LOFF = 23 * MiB;
constexpr size_t WS_ROWSS = 24 * MiB;
constexpr size_t WS_PL = 26 * MiB;
constexpr size_t WS_LIST = 30 * MiB;
constexpr size_t WS_SEL = 32 * MiB;
constexpr size_t WS_XB = 40 * MiB;
constexpr size_t WS_PROJ = 168 * MiB;
constexpr size_t WS_MIX = 392 * MiB;
constexpr size_t WS_END = 456 * MiB;
constexpr size_t SUBSTRIDE = (size_t)MROWS * 512;
enum { T_U = 0, T_V = 1, T_ZA = 2, T_Q = 3, T_K = 4, T_VV = 5, T_ZB = 6 };

constexpr int NWAVES = 8;
constexpr int LDS_BYTES = 160 * 1024;
constexpr int RING_BYTES = 131072;

#define LAS __attribute__((address_space(3)))
typedef unsigned short bf16;
typedef unsigned v4u __attribute__((ext_vector_type(4)));
typedef float f32x4 __attribute__((ext_vector_type(4)));
#define LDS_WAIT() asm volatile("s_waitcnt lgkmcnt(0)" ::: "memory")
__device__ __forceinline__ unsigned f2bf(float f) { unsigned u = __builtin_bit_cast(unsigned, f); return (u + 0x7fffu + ((u >> 16) & 1u)) >> 16; }
__device__ __forceinline__ unsigned pk2(float lo, float hi) { return f2bf(lo) | (f2bf(hi) << 16); }
__device__ __forceinline__ unsigned pk4_fp8(float a, float b, float c, float d) { int w = __builtin_amdgcn_cvt_pk_fp8_f32(a, b, 0, false); w = __builtin_amdgcn_cvt_pk_fp8_f32(c, d, w, true); return (unsigned)w; }
__device__ __forceinline__ float bflo(unsigned w) { return __uint_as_float(w << 16); }
__device__ __forceinline__ float bfhi(unsigned w) { return __uint_as_float(w & 0xffff0000u); }
__device__ __forceinline__ float wave_sum(float v) {
#pragma unroll
    for (int o = 1; o < 64; o <<= 1) v += __shfl_xor(v, o);
    return v;
}

__device__ __forceinline__ int lane_now() { int l; asm volatile("v_mbcnt_lo_u32_b32 %0, -1, 0\n\tv_mbcnt_hi_u32_b32 %0, -1, %0" : "=v"(l)); return l; }
struct Args { const float* in[10]; float* out; unsigned char* ws; int layer, pad; };

struct Ctx {
    unsigned char* lds;
    int tid, lane, wave, G, bid;
    const float *x, *norm_g, *w_in, *ln_g, *ln_b, *sgu_w, *sgu_b, *w_out, *rel_bias, *final_g;
    float* out; unsigned char* ws;
};

__device__ __forceinline__ void p0_transpose_item(const float* W, const float* gs, int K, int N, bf16* WT, float* scr, int item, int lane) {
    const int nblk = N / 32, kb = item / nblk, nb = item % nblk, k0 = 64 * kb, n0 = 32 * nb;
    float wv[32];
#pragma unroll
    for (int i = 0; i < 32; ++i) wv[i] = W[(size_t)(k0 + 2 * i + (lane >> 5)) * N + n0 + (lane & 31)];
#pragma unroll
    for (int i = 0; i < 32; ++i) { const int kk = 2 * i + (lane >> 5); const float sc = gs ? gs[k0 + kk] : 1.0f; scr[kk * 33 + (lane & 31)] = wv[i] * sc; }
    LDS_WAIT(); asm volatile("" ::: "memory");
    const int c = lane & 7;
#pragma unroll
    for (int j = 0; j < 4; ++j) { const int n = (lane >> 3) + 8 * j; const float* s = scr + (8 * c) * 33 + n;
        v4u o; o.x = pk2(s[0 * 33], s[1 * 33]); o.y = pk2(s[2 * 33], s[3 * 33]); o.z = pk2(s[4 * 33], s[5 * 33]); o.w = pk2(s[6 * 33], s[7 * 33]);
        *(v4u*)(WT + (size_t)(n0 + n) * K + k0 + 8 * c) = o; }
    LDS_WAIT(); asm volatile("" ::: "memory");
}
__device__ __forceinline__ int rel_bucket(int d) {
    if (d < 16) return d;
    int b = 16;
    b += (d >= 19); b += (d >= 21); b += (d >= 24); b += (d >= 27); b += (d >= 31); b += (d >= 35); b += (d >= 40); b += (d >= 46);
    b += (d >= 52); b += (d >= 59); b += (d >= 67); b += (d >= 77); b += (d >= 87); b += (d >= 99); b += (d >= 113);
    return b;
}
__device__ __forceinline__ void phase_prologue(const Ctx& C) {
    float* scr = (float*)(C.lds + C.wave * 16384);
    const int gw = C.bid * NWAVES + C.wave, NGW = C.G * NWAVES;
    constexpr int I_IN = (DM / 64) * (DIN / 32), I_OUT = (DM / 64) * (DM / 32);
    constexpr int NITEMS = DEPTH * (I_IN + I_OUT);
    for (int it = gw; it < NITEMS; it += NGW) {
        const int l = it / (I_IN + I_OUT); int r = it % (I_IN + I_OUT);
        if (r < I_IN) p0_transpose_item(C.w_in + (size_t)l * DM * DIN, C.norm_g + l * DM, DM, DIN, (bf16*)(C.ws + WS_WIN) + (size_t)l * DIN * DM, scr, r, C.lane);
        else p0_transpose_item(C.w_out + (size_t)l * DM * DM, nullptr, DM, DM, (bf16*)(C.ws + WS_WOUT) + (size_t)l * DM * DM, scr, r - I_IN, C.lane);
    }
    { float* km = (float*)(C.ws + WS_KMEAN); for (int e = C.bid * 512 + C.tid; e < DEPTH * NBH * NBLK * 64; e += C.G * 512) km[e] = 0.f; }
    { bf16* wst = (bf16*)(C.ws + WS_WST); const int gt = C.bid * 512 + C.tid, NT = C.G * 512;
      for (int e = gt; e < DEPTH * 8 * 128 * 128; e += NT) { const int s = e & 127, t = (e >> 7) & 127; wst[e] = (s <= t) ? (bf16)f2bf(C.sgu_w[e]) : (bf16)0; } }
    if (C.bid == 0) { float* bt = (float*)(C.ws + WS_BT); for (int e = C.tid; e < 8 * 128; e += 512) { const int h = e >> 7, d = e & 127; bt[e] = C.rel_bias[rel_bucket(d) * 8 + h] * LOG2E; } }
    { bf16* xb = (bf16*)(C.ws + WS_XB); float* rowss = (float*)(C.ws + WS_ROWSS);
      constexpr int UN = 4;
      for (int m0 = gw; m0 < MROWS; m0 += NGW * UN) {
        f32x4 v[UN][4];
#pragma unroll
        for (int k = 0; k < UN; ++k) { const f32x4* xr = (const f32x4*)(C.x + (size_t)(m0 + k * NGW) * DM) + C.lane;
#pragma unroll
            for (int j = 0; j < 4; ++j) v[k][j] = xr[64 * j]; }
#pragma unroll
        for (int k = 0; k < UN; ++k) { const int m = m0 + k * NGW;
            float s = 0.f;
#pragma unroll
            for (int j = 0; j < 4; ++j) s += (v[k][j].x * v[k][j].x + v[k][j].y * v[k][j].y) + (v[k][j].z * v[k][j].z + v[k][j].w * v[k][j].w);
            s = wave_sum(s);
            unsigned long long* o8 = (unsigned long long*)(xb + (size_t)m * DM) + C.lane;
#pragma unroll
            for (int j = 0; j < 4; ++j) o8[64 * j] = (unsigned long long)pk2(v[k][j].x, v[k][j].y) | ((unsigned long long)pk2(v[k][j].z, v[k][j].w) << 32);
            if (C.lane < 16) rowss[(size_t)m * 16 + C.lane] = (C.lane == 0) ? s : 0.f; }
      } }
}

typedef short bf16x8 __attribute__((ext_vector_type(8)));
typedef short bf16x4s __attribute__((ext_vector_type(4)));
typedef float f32x16 __attribute__((ext_vector_type(16)));
typedef int v8i_t __attribute__((ext_vector_type(8)));
__device__ __forceinline__ int at_vpos(int kv) { return (kv & ~63) + 32 * ((kv >> 2) & 1) + 16 * ((kv >> 5) & 1) + (kv & 3) + 4 * ((kv >> 3) & 3); }
__device__ __forceinline__ int crow(int r, int hi) { return (r & 3) + 8 * (r >> 2) + 4 * hi; }
__device__ __forceinline__ unsigned cvtpk(float lo, float hi) { unsigned r; asm volatile("v_cvt_pk_bf16_f32 %0, %1, %2" : "=v"(r) : "v"(lo), "v"(hi)); return r; }
__device__ __forceinline__ void phase_gate(const Ctx& C, int layer) {
    const bf16* Q = (const bf16*)(C.ws + WS_PROJ) + (size_t)T_Q * SUBSTRIDE;
    const float* KM = (const float*)(C.ws + WS_KMEAN) + (size_t)layer * NBH * NBLK * 64;
    int* SEL = (int*)(C.ws + WS_SEL); int* LOFF = (int*)(C.ws + WS_LOFF); unsigned short* LIST = (unsigned short*)(C.ws + WS_LIST);
    int* cnt = (int*)(C.lds);
    int* offs = (int*)(C.lds + 256);
    unsigned char* kml = C.lds + 1024;
    const int lane = C.lane, ql = lane & 31, hi = lane >> 5;
    bf16x8 qfN[4]; f32x4 kmr[2];
#define GATE_LOAD(uu) do { const int bh_ = (uu) / 63, i_ = (uu) % 63 + 1, b_ = bh_ >> 3, h_ = bh_ & 7; \
        const bf16* qrow_ = Q + ((size_t)(b_ * SEQ + i_ * 256 + C.wave * 32 + ql)) * 512 + h_ * 64 + hi * 8; \
        _Pragma("unroll") for (int ks = 0; ks < 4; ++ks) qfN[ks] = *(const bf16x8*)(qrow_ + ks * 16); \
        const float* kp_ = KM + (size_t)bh_ * NBLK * 64 + C.tid * 8; kmr[0] = *(const f32x4*)kp_; kmr[1] = *(const f32x4*)(kp_ + 4); } while (0)
#define GATE_KML() do { *(v4u*)(kml + (C.tid >> 3) * 144 + (C.tid & 7) * 16) = (v4u){cvtpk(kmr[0][0], kmr[0][1]), cvtpk(kmr[0][2], kmr[0][3]), cvtpk(kmr[1][0], kmr[1][1]), cvtpk(kmr[1][2], kmr[1][3])}; } while (0)
    int u = C.bid;
    if (C.tid < 64) cnt[C.tid] = 0;
    if (u < NBH * 63) { GATE_LOAD(u); GATE_KML(); }
    __syncthreads();
    for (; u < NBH * 63; u += C.G) {
        const int bh = u / 63, i = u % 63 + 1;
        const int q = C.wave * 32 + ql, pos = i * 256 + q;
        bf16x8 qf[4];
#pragma unroll
        for (int ks = 0; ks < 4; ++ks) qf[ks] = qfN[ks];
        const bool more = u + C.G < NBH * 63;
        if (more) GATE_LOAD(u + C.G);
        float b0 = -INFINITY, b1 = -INFINITY, b2 = -INFINITY; int i0 = -1, i1 = -1, i2 = -1;
#define TOP3_INS(v, idx) do { const float v_ = (v); const int x_ = (idx); if (v_ > b0) { b2 = b1; i2 = i1; b1 = b0; i1 = i0; b0 = v_; i0 = x_; } else if (v_ > b1) { b2 = b1; i2 = i1; b1 = v_; i1 = x_; } else if (v_ > b2) { b2 = v_; i2 = x_; } } while (0)
#pragma unroll
        for (int nt = 0; nt < 2; ++nt) {
            f32x16 p = {};
#pragma unroll
            for (int ks = 0; ks < 4; ++ks) {
                const bf16x8 kw = *(const bf16x8*)(kml + (32 * nt + ql) * 144 + ks * 32 + hi * 16);
                p = __builtin_amdgcn_mfma_f32_32x32x16_bf16(kw, qf[ks], p, 0, 0, 0);
            }
#pragma unroll
            for (int r = 0; r < 16; ++r) { const int n = 32 * nt + crow(r, hi); if (n < i) TOP3_INS(p[r], n); }
        }
        { const float c0 = __shfl_xor(b0, 32), c1 = __shfl_xor(b1, 32), c2 = __shfl_xor(b2, 32);
          const int j0 = __shfl_xor(i0, 32), j1 = __shfl_xor(i1, 32), j2 = __shfl_xor(i2, 32);
          if (j0 >= 0) TOP3_INS(c0, j0);
          if (j1 >= 0) TOP3_INS(c1, j1);
          if (j2 >= 0) TOP3_INS(c2, j2); }
#undef TOP3_INS
        int p0 = 0, p1 = 0, p2 = 0;
        if (hi == 0) {
            if (CHECK_ATTN) { int* sp = SEL + ((size_t)bh * SEQ + pos) * 4; sp[0] = i0; sp[1] = i1; sp[2] = i2; sp[3] = -1; }
            p0 = atomicAdd(&cnt[i0], 1);
            if (i1 >= 0) p1 = atomicAdd(&cnt[i1], 1);
            if (i2 >= 0) p2 = atomicAdd(&cnt[i2], 1);
        }
        __syncthreads();
        if (C.tid < 64) {
            const int c = cnt[C.tid]; cnt[C.tid] = 0;
            int inc = c;
#pragma unroll
            for (int o = 1; o < 64; o <<= 1) { const int t = __shfl_up(inc, o); if (C.tid >= o) inc += t; }
            offs[C.tid + 1] = inc; if (C.tid == 0) offs[0] = 0;
            LOFF[(size_t)(bh * NBLK + i) * 80 + C.tid + 1] = inc; if (C.tid == 0) LOFF[(size_t)(bh * NBLK + i) * 80] = 0;
        }
        if (more) GATE_KML();
        __syncthreads();
        if (hi == 0) {
            unsigned short* lp = LIST + (size_t)(bh * NBLK + i) * 768;
            lp[offs[i0] + p0] = (unsigned short)(q | (0 << 8));
            if (i1 >= 0) lp[offs[i1] + p1] = (unsigned short)(q | (1 << 8));
            if (i2 >= 0) lp[offs[i2] + p2] = (unsigned short)(q | (2 << 8));
        }
    }
#undef GATE_LOAD
#undef GATE_KML
    if (CHECK_ATTN) { for (int e = C.bid * 512 + C.tid; e < NBH * 256; e += C.G * 512) { const int bh = e >> 8, qq = e & 255; int* sp = SEL + ((size_t)bh * SEQ + qq) * 4; sp[0] = -1; sp[1] = -1; sp[2] = -1; sp[3] = -1; } }
    __syncthreads();
}

__device__ __forceinline__ void phase_attn_simple(const Ctx& C, bf16* MIX) {
    const bf16* Q = (const bf16*)(C.ws + WS_PROJ) + (size_t)T_Q * SUBSTRIDE;
    const bf16* K = (const bf16*)(C.ws + WS_PROJ) + (size_t)T_K * SUBSTRIDE;
    const bf16* VV = (const bf16*)(C.ws + WS_PROJ) + (size_t)T_VV * SUBSTRIDE;
    const bf16* ZB = (const bf16*)(C.ws + WS_PROJ) + (size_t)T_ZB * SUBSTRIDE;
    const int* SEL = (const int*)(C.ws + WS_SEL); const float* BT = (const float*)(C.ws + WS_BT);
    const int gt = C.bid * 512 + C.tid, NT = C.G * 512;
    for (int item = gt; item < NBH * SEQ; item += NT) {
        const int bh = item >> 14, pos = item & (SEQ - 1), b = bh >> 3, h = bh & 7, own = pos >> 8;
        const size_t rowq = (size_t)(b * SEQ + pos);
        float qv[64], o[64];
        { const v4u* qp = (const v4u*)(Q + rowq * 512 + h * 64);
#pragma unroll
          for (int c = 0; c < 8; ++c) { const v4u v = qp[c]; qv[8 * c + 0] = bflo(v.x); qv[8 * c + 1] = bfhi(v.x); qv[8 * c + 2] = bflo(v.y); qv[8 * c + 3] = bfhi(v.y);
              qv[8 * c + 4] = bflo(v.z); qv[8 * c + 5] = bfhi(v.z); qv[8 * c + 6] = bflo(v.w); qv[8 * c + 7] = bfhi(v.w); } }
#pragma unroll
        for (int d = 0; d < 64; ++d) o[d] = 0.f;
        float m = -INFINITY, l = 0.f;
        const float* bt = BT + h * 128;
        for (int slot = 0; slot < 4; ++slot) {
            int blk, klim;
            if (slot == 0) { blk = own; klim = (pos & 255) + 1; } else { blk = SEL[(size_t)item * 4 + slot - 1]; klim = 256; if (blk < 0) klim = 0; }
            for (int kl = 0; kl < klim; ++kl) {
                const int kpos = blk * 256 + kl;
                const v4u* kp = (const v4u*)(K + ((size_t)(b * SEQ + kpos)) * 512 + h * 64);
                float a0 = 0.f, a1 = 0.f;
#pragma unroll
                for (int c = 0; c < 8; ++c) { const v4u v = kp[c];
                    a0 += qv[8 * c + 0] * bflo(v.x) + qv[8 * c + 2] * bflo(v.y) + qv[8 * c + 4] * bflo(v.z) + qv[8 * c + 6] * bflo(v.w);
                    a1 += qv[8 * c + 1] * bfhi(v.x) + qv[8 * c + 3] * bfhi(v.y) + qv[8 * c + 5] * bfhi(v.z) + qv[8 * c + 7] * bfhi(v.w); }
                int dd = pos - kpos; dd = dd > 127 ? 127 : dd;
                const float s = (a0 + a1) + bt[dd];
                if (s > m) { const float al = __builtin_amdgcn_exp2f(m - s); l *= al;
#pragma unroll
                    for (int d = 0; d < 64; ++d) o[d] *= al;
                    m = s; }
                const float p = __builtin_amdgcn_exp2f(s - m);
                l += p;
                const v4u* vp = (const v4u*)(VV + ((size_t)(b * SEQ + kpos)) * 512 + h * 64);
#pragma unroll
                for (int c = 0; c < 8; ++c) { const v4u v = vp[c];
                    o[8 * c + 0] += p * bflo(v.x); o[8 * c + 1] += p * bfhi(v.x); o[8 * c + 2] += p * bflo(v.y); o[8 * c + 3] += p * bfhi(v.y);
                    o[8 * c + 4] += p * bflo(v.z); o[8 * c + 5] += p * bfhi(v.z); o[8 * c + 6] += p * bflo(v.w); o[8 * c + 7] += p * bfhi(v.w); }
            }
        }
        const float rl = 1.0f / l;
        const v4u* zp = (const v4u*)(ZB + rowq * 512 + h * 64);
        v4u* op = (v4u*)(MIX + rowq * 1024 + 512 + h * 64);
#pragma unroll
        for (int c = 0; c < 8; ++c) { const v4u z = zp[c]; v4u w;
            w.x = pk2(o[8 * c + 0] * rl * pg8::act_silu(bflo(z.x)), o[8 * c + 1] * rl * pg8::act_silu(bfhi(z.x))); w.y = pk2(o[8 * c + 2] * rl * pg8::act_silu(bflo(z.y)), o[8 * c + 3] * rl * pg8::act_silu(bfhi(z.y)));
            w.z = pk2(o[8 * c + 4] * rl * pg8::act_silu(bflo(z.z)), o[8 * c + 5] * rl * pg8::act_silu(bfhi(z.z))); w.w = pk2(o[8 * c + 6] * rl * pg8::act_silu(bflo(z.w)), o[8 * c + 7] * rl * pg8::act_silu(bfhi(z.w)));
            op[c] = w; }
    }
}

constexpr int AT_KS = 0, AT_KPITCH = 144;
constexpr int AT_VT = 36864, AT_VPITCH = 272;
constexpr int AT_DT = AT_VT + 64 * AT_VPITCH;
constexpr int AT_ENT = AT_DT + 4096, AT_CAP = 4096;
constexpr int AT_PRE = AT_ENT + AT_CAP * 4;
constexpr int AT_OST = AT_PRE + 1024;
constexpr int AT_MISC = AT_OST + 8 * 4096;
constexpr int AT_NUNITS = NBLK * NBH;

typedef int v4i_t __attribute__((ext_vector_type(4)));
struct QTile { unsigned ent; v4i_t qf[4]; };
__device__ __forceinline__ void attn_issue_q(QTile& T, const Ctx& C, const unsigned char* lds, int b, int h, int e0, int cnt) {
    const bf16* Q = (const bf16*)(C.ws + WS_PROJ) + (size_t)T_Q * SUBSTRIDE;
    const unsigned* ENT = (const unsigned*)(lds + AT_ENT);
    const int q = C.lane & 31, hi = C.lane >> 5;
    T.ent = ENT[(e0 + q < cnt) ? (e0 + q) : e0];
    const bf16* qrow = Q + ((size_t)(b * SEQ + (int)(T.ent & 16383u))) * 512 + h * 64 + hi * 8;
    asm volatile("global_load_dwordx4 %0, %4, off\n\tglobal_load_dwordx4 %1, %4, off offset:32\n\tglobal_load_dwordx4 %2, %4, off offset:64\n\tglobal_load_dwordx4 %3, %4, off offset:96"
                 : "=&v"(T.qf[0]), "=&v"(T.qf[1]), "=&v"(T.qf[2]), "=&v"(T.qf[3]) : "v"(qrow));
}
__device__ __forceinline__ void attn_wait_q(QTile& T) { asm volatile("s_waitcnt vmcnt(0)" : "+v"(T.qf[0]), "+v"(T.qf[1]), "+v"(T.qf[2]), "+v"(T.qf[3])); }
__device__ __forceinline__ void attn_tile(const Ctx& C, unsigned char* lds, const QTile& T, QTile& Tn, int bh, int e0, int cnt, int nkt2, const bool OWN) {
    bf16* PO = (bf16*)C.out; float* PL = (float*)(C.ws + WS_PL);
    const unsigned* ENT = (const unsigned*)(lds + AT_ENT);
    const int lane = C.lane, q = lane & 31, hi = lane >> 5;
    const unsigned ent = T.ent;
    const int pos = ent & 16383, qoff = (ent >> 16) & 1023;
    f32x16 o0 = {}, o1 = {};
    float l = 0.f;
    const bool anybias = OWN ? true : (__any(qoff < 112) != 0);
    const unsigned char* kbase = lds + AT_KS + q * AT_KPITCH + hi * 16;
    const unsigned char* vbase = lds + AT_VT + q * AT_VPITCH + hi * 32;
    const float* et0 = (const float*)(lds + AT_DT) + (256 + (OWN ? 0 : 256) + qoff - 4 * hi);
    bf16x8 kf[8];
#pragma unroll
    for (int ks = 0; ks < 4; ++ks) { kf[2 * ks] = *(const bf16x8*)(kbase + ks * 32); kf[2 * ks + 1] = *(const bf16x8*)(kbase + 32 * AT_KPITCH + ks * 32); }
    for (int kt2 = 0; kt2 < nkt2; ++kt2) {
        f32x16 p0 = {}, p1 = {};
        __builtin_amdgcn_s_setprio(1);
#pragma unroll
        for (int ks = 0; ks < 4; ++ks) {
            p0 = __builtin_amdgcn_mfma_f32_32x32x16_bf16(kf[2 * ks], __builtin_bit_cast(bf16x8, T.qf[ks]), p0, 0, 0, 0);
            p1 = __builtin_amdgcn_mfma_f32_32x32x16_bf16(kf[2 * ks + 1], __builtin_bit_cast(bf16x8, T.qf[ks]), p1, 0, 0, 0);
        }
        __builtin_amdgcn_s_setprio(0);
        v8i_t vb0, vb1;
        { typedef int v4i_t __attribute__((ext_vector_type(4)));
          const v4i_t a0 = *(const v4i_t*)(vbase + 64 * kt2), a1 = *(const v4i_t*)(vbase + 64 * kt2 + 16);
          const v4i_t c0 = *(const v4i_t*)(vbase + 32 * AT_VPITCH + 64 * kt2), c1 = *(const v4i_t*)(vbase + 32 * AT_VPITCH + 64 * kt2 + 16);
          vb0 = __builtin_shufflevector(a0, a1, 0, 1, 2, 3, 4, 5, 6, 7); vb1 = __builtin_shufflevector(c0, c1, 0, 1, 2, 3, 4, 5, 6, 7); }
        if (anybias && (OWN || kt2 >= 2)) {
            const float* et = et0 - 64 * kt2 - 63;
#pragma unroll
            for (int r = 0; r < 16; ++r) { p0[r] += et[63 - ((r & 3) + 8 * (r >> 2))]; p1[r] += et[31 - ((r & 3) + 8 * (r >> 2))]; }
        }
#pragma unroll
        for (int r = 0; r < 16; ++r) { p0[r] = __builtin_amdgcn_exp2f(p0[r]); p1[r] = __builtin_amdgcn_exp2f(p1[r]); }
        float sa = 0.f, sb = 0.f;
#pragma unroll
        for (int r = 0; r < 16; ++r) { sa += p0[r]; sb += p1[r]; }
        l += sa + sb;
        v8i_t pa8;
        { typedef short v2s_t __attribute__((ext_vector_type(2)));
#pragma unroll
          for (int i = 0; i < 4; ++i) {
              v2s_t w = {0, 0};
              w = __builtin_amdgcn_cvt_scalef32_pk_fp8_f32(w, p0[4 * i], p0[4 * i + 1], 16.0f, false); w = __builtin_amdgcn_cvt_scalef32_pk_fp8_f32(w, p0[4 * i + 2], p0[4 * i + 3], 16.0f, true);
              pa8[i] = __builtin_bit_cast(int, w);
              v2s_t z = {0, 0};
              z = __builtin_amdgcn_cvt_scalef32_pk_fp8_f32(z, p1[4 * i], p1[4 * i + 1], 16.0f, false); z = __builtin_amdgcn_cvt_scalef32_pk_fp8_f32(z, p1[4 * i + 2], p1[4 * i + 3], 16.0f, true);
              pa8[4 + i] = __builtin_bit_cast(int, z);
          } }
        if (kt2 + 1 < nkt2) {
#pragma unroll
            for (int ks = 0; ks < 4; ++ks) { kf[2 * ks] = *(const bf16x8*)(kbase + (64 * kt2 + 64) * AT_KPITCH + ks * 32); kf[2 * ks + 1] = *(const bf16x8*)(kbase + (64 * kt2 + 96) * AT_KPITCH + ks * 32); }
        }
        __builtin_amdgcn_s_setprio(1);
        o0 = __builtin_amdgcn_mfma_scale_f32_32x32x64_f8f6f4(vb0, pa8, o0, 0, 0, 0, 0x7f7f7f7f, 0, (int)0x83838383);
        o1 = __builtin_amdgcn_mfma_scale_f32_32x32x64_f8f6f4(vb1, pa8, o1, 0, 0, 0, 0x7f7f7f7f, 0, (int)0x83838383);
        __builtin_amdgcn_s_setprio(0);
    }
    l += __shfl_xor(l, 32);
    attn_wait_q(Tn);
    if (e0 + q < cnt) PL[((size_t)bh * SEQ + pos) * 4 + ((ent >> 14) & 3)] = l;
    { bf16* prow = PO + (((size_t)bh * SEQ + pos) * 4 + ((ent >> 14) & 3)) * 64 + hi * 8;
      const bool live = e0 + q < cnt;
#pragma unroll
      for (int j = 0; j < 2; ++j) {
          unsigned a0 = pg8::cvt_pk_bf16(o0[8 * j], o0[8 * j + 1]), a1 = pg8::cvt_pk_bf16(o0[8 * j + 2], o0[8 * j + 3]), b0 = pg8::cvt_pk_bf16(o0[8 * j + 4], o0[8 * j + 5]), b1 = pg8::cvt_pk_bf16(o0[8 * j + 6], o0[8 * j + 7]);
          { auto r0 = __builtin_amdgcn_permlane32_swap(a0, b0, false, false); a0 = r0[0]; b0 = r0[1]; auto r1 = __builtin_amdgcn_permlane32_swap(a1, b1, false, false); a1 = r1[0]; b1 = r1[1]; }
          unsigned c0 = pg8::cvt_pk_bf16(o1[8 * j], o1[8 * j + 1]), c1 = pg8::cvt_pk_bf16(o1[8 * j + 2], o1[8 * j + 3]), d0 = pg8::cvt_pk_bf16(o1[8 * j + 4], o1[8 * j + 5]), d1 = pg8::cvt_pk_bf16(o1[8 * j + 6], o1[8 * j + 7]);
          { auto r0 = __builtin_amdgcn_permlane32_swap(c0, d0, false, false); c0 = r0[0]; d0 = r0[1]; auto r1 = __builtin_amdgcn_permlane32_swap(c1, d1, false, false); c1 = r1[0]; d1 = r1[1]; }
          if (live) { *(v4u*)(prow + 16 * j) = (v4u){a0, a1, b0, b1}; *(v4u*)(prow + 32 + 16 * j) = (v4u){c0, c1, d0, d1}; }
      } }
}

__device__ __forceinline__ void phase_attn(const Ctx& C, int layer) {
    unsigned char* lds = C.lds;
    const bf16* K = (const bf16*)(C.ws + WS_PROJ) + (size_t)T_K * SUBSTRIDE;
    const bf16* VV = (const bf16*)(C.ws + WS_PROJ) + (size_t)T_VV * SUBSTRIDE;
    const int* LOFF = (const int*)(C.ws + WS_LOFF); const unsigned short* LIST = (const unsigned short*)(C.ws + WS_LIST);
    const float* BT = (const float*)(C.ws + WS_BT);
    const int qg = C.bid & 7;
    unsigned* ctr = (unsigned*)(C.ws + WS_CTL) + 64 + 64 * layer;
    int qstep = 0;
    unsigned* ENT = (unsigned*)(lds + AT_ENT);
    int* PRE = (int*)(lds + AT_PRE); int* LO = PRE + 68;
    volatile unsigned* MISC = (volatile unsigned*)(lds + AT_MISC);
    int tid = C.tid;
    v4u kpre[4], vpre[4]; int lpre0 = 0, lpre1 = 0;
#define AT_LOADKV(uu) do { const int bh_ = (uu) & 15, n_ = (uu) >> 4; \
        const bf16* Kg = K + ((size_t)((bh_ >> 3) * SEQ + n_ * 256)) * 512 + (bh_ & 7) * 64; const bf16* Vg = VV + ((size_t)((bh_ >> 3) * SEQ + n_ * 256)) * 512 + (bh_ & 7) * 64; \
        _Pragma("unroll") for (int it = 0; it < 4; ++it) { const int idx = tid + 512 * it; kpre[it] = *(const v4u*)(Kg + (size_t)(idx >> 3) * 512 + (idx & 7) * 8); \
            vpre[it] = *(const v4u*)(Vg + (size_t)(idx >> 3) * 512 + (idx & 7) * 8); } \
        lpre0 = 0; lpre1 = 0; if (tid < 64 && n_ + 1 + tid < NBLK) { const int* lp_ = LOFF + ((size_t)(bh_ * NBLK + n_ + 1 + tid)) * 80 + n_; lpre0 = lp_[0]; lpre1 = lp_[1]; } } while (0)
#define AT_FETCH() ({ unsigned r_ = (unsigned)AT_NUNITS; while (qstep < 8) { const int g_ = (qg + qstep) & 7; const unsigned k_ = atomicAdd(ctr + 4 * g_, 1u); \
        if (k_ < 2u * NBLK) { r_ = (k_ >> 1) * 16 + 2 * g_ + (k_ & 1); break; } ++qstep; } r_; })
    if (tid == 0) MISC[0] = AT_FETCH();
    __syncthreads();
    int u = (int)MISC[0];
    if (u < AT_NUNITS) AT_LOADKV(u);
    while (u < AT_NUNITS) {
        asm volatile("" : "+v"(tid));
        Ctx Cu = C; Cu.tid = tid; Cu.lane = tid & 63;
        const int bh = u & 15, n = u >> 4, b = bh >> 3, h = bh & 7;
        if (tid == 0) MISC[1] = AT_FETCH();
#pragma unroll
        for (int it = 0; it < 4; ++it) { const int idx = tid + 512 * it;
            *(v4u*)(lds + AT_KS + (idx >> 3) * AT_KPITCH + (idx & 7) * 16) = kpre[it];
            const v4u v = vpre[it];
            unsigned char* vt = lds + AT_VT + (8 * (idx & 7)) * AT_VPITCH + at_vpos(idx >> 3);
            const unsigned w01 = pk4_fp8(bflo(v.x), bfhi(v.x), bflo(v.y), bfhi(v.y)), w23 = pk4_fp8(bflo(v.z), bfhi(v.z), bflo(v.w), bfhi(v.w));
            vt[0 * AT_VPITCH] = (unsigned char)(w01); vt[1 * AT_VPITCH] = (unsigned char)(w01 >> 8); vt[2 * AT_VPITCH] = (unsigned char)(w01 >> 16); vt[3 * AT_VPITCH] = (unsigned char)(w01 >> 24);
            vt[4 * AT_VPITCH] = (unsigned char)(w23); vt[5 * AT_VPITCH] = (unsigned char)(w23 >> 8); vt[6 * AT_VPITCH] = (unsigned char)(w23 >> 16); vt[7 * AT_VPITCH] = (unsigned char)(w23 >> 24); }
        { float* et_ = (float*)(lds + AT_DT);
#pragma unroll
          for (int k_ = 0; k_ < 2; ++k_) { const int j_ = tid + 512 * k_, d_ = j_ - 256; et_[j_] = d_ < 0 ? -INFINITY : (d_ < 128 ? BT[h * 128 + d_] - BT[h * 128 + 127] : 0.f); } }
        if (tid < 64) {
            const int lo = lpre0; int inc = lpre1 - lpre0;
#pragma unroll
            for (int o = 1; o < 64; o <<= 1) { const int t = __shfl_up(inc, o); if (tid >= o) inc += t; }
            PRE[tid + 1] = inc; LO[tid] = lo; if (tid == 0) PRE[0] = 0;
        }
        __syncthreads();
        const int total = 256 + PRE[63 - n];
        const int unext = (int)MISC[1];
        if (unext < AT_NUNITS) AT_LOADKV(unext);
        for (int base = 0; base < total; base += AT_CAP) {
            const int cnt = (total - base < AT_CAP) ? (total - base) : AT_CAP;
            if (base == 0 && tid < 256) ENT[tid] = (unsigned)(n * 256 + tid) | (3u << 14) | ((unsigned)tid << 16);
            { const int e_lo = base > 256 ? base : 256, e_hi = base + cnt;
#pragma unroll 4
              for (int e = e_lo + tid; e < e_hi; e += 512) {
                  const int es = e - 256; int a = 0, z = 63 - n;
#pragma unroll
                  for (int it = 0; it < 6; ++it) { const int mid = (a + z) >> 1; const bool up = (z - a > 1) && (PRE[mid] <= es); const bool dn = (z - a > 1) && !up; a = up ? mid : a; z = dn ? mid : z; }
                  const int ii = a, i = n + 1 + ii;
                  const unsigned val = LIST[((size_t)(bh * NBLK + i)) * 768 + LO[ii] + (es - PRE[ii])]; const unsigned ql = val & 255u, j = val >> 8;
                  ENT[e - base] = (unsigned)(i * 256 + ql) | (j << 14) | ((ii == 0 ? ql : 400u) << 16);
              } }
            if (tid == 0) MISC[2] = 0u;
            __syncthreads();
            const int ntiles = (cnt + 31) >> 5;
            const int nown = (base == 0) ? 8 : 0;
#define AT_TICKET() ({ int tk_ = 0; if (Cu.lane == 0) tk_ = (int)atomicAdd((unsigned*)(lds + AT_MISC + 8), 1u); __builtin_amdgcn_readfirstlane(tk_); })
#define AT_TILEOF(tk_) (((tk_) < ntiles - nown) ? nown + (tk_) : (ntiles - 1 - (tk_)))
            { int tk = AT_TICKET();
              if (tk < ntiles) {
                  int tile = AT_TILEOF(tk);
                  QTile Tc; attn_issue_q(Tc, Cu, lds, b, h, tile * 32, cnt); attn_wait_q(Tc);
                  for (;;) {
                      const int tkn = AT_TICKET(); const bool more = tkn < ntiles; const int tilen = more ? AT_TILEOF(tkn) : 0;
                      QTile Tn; attn_issue_q(Tn, Cu, lds, b, h, tilen * 32, cnt);
                      { const bool own_ = tile < nown; attn_tile(Cu, lds, Tc, Tn, bh, tile * 32, cnt, own_ ? (tile >> 1) + 1 : 4, own_); }
                      if (!more) break;
                      Tc = Tn; tile = tilen;
                  }
              } }
#undef AT_TICKET
#undef AT_TILEOF
            __syncthreads();
        }
        u = unext;
    }
#undef AT_LOADKV
#undef AT_FETCH
}

__device__ __forceinline__ void phase_combine(const Ctx& C) {
    const bf16* PO = (const bf16*)C.out; const float* PL = (const float*)(C.ws + WS_PL);
    const bf16* ZB = (const bf16*)(C.ws + WS_PROJ) + (size_t)T_ZB * SUBSTRIDE;
    bf16* MIX = (bf16*)(C.ws + WS_MIX);
    const int gt = C.bid * 512 + C.tid, NT = C.G * 512;
    constexpr int UN = 4;
    for (int idx0 = gt; idx0 < MROWS * 64; idx0 += NT * UN) {
        f32x4 lv[UN]; v4u pv[UN][4]; v4u zv[UN];
#pragma unroll
        for (int k = 0; k < UN; ++k) {
            const int idx = idx0 + k * NT;
            const int ch = idx & 7, h = (idx >> 3) & 7, row = idx >> 6, b = row >> 14, pos = row & (SEQ - 1), i = pos >> 8;
            const size_t pb = ((size_t)(b * NH + h) * SEQ + pos) * 4;
            lv[k] = *(const f32x4*)(PL + pb);
#pragma unroll
            for (int j = 0; j < 4; ++j) pv[k][j] = (j == 3 || j < i) ? *(const v4u*)(PO + (pb + j) * 64 + ch * 8) : (v4u){0u, 0u, 0u, 0u};
            zv[k] = *(const v4u*)(ZB + (size_t)row * 512 + h * 64 + ch * 8);
        }
#pragma unroll
        for (int k = 0; k < UN; ++k) {
            const int idx = idx0 + k * NT;
            const int ch = idx & 7, h = (idx >> 3) & 7, row = idx >> 6, pos = row & (SEQ - 1), i = pos >> 8;
            float L = lv[k][3];
#pragma unroll
            for (int j = 0; j < 3; ++j) L += (j < i) ? lv[k][j] : 0.f;
            float acc[8];
#pragma unroll
            for (int e = 0; e < 8; ++e) acc[e] = 0.f;
#pragma unroll
            for (int j = 0; j < 4; ++j) { const v4u v = pv[k][j];
                acc[0] += bflo(v.x); acc[1] += bfhi(v.x); acc[2] += bflo(v.y); acc[3] += bfhi(v.y); acc[4] += bflo(v.z); acc[5] += bfhi(v.z); acc[6] += bflo(v.w); acc[7] += bfhi(v.w); }
            const float rl = 1.0f / L;
            const v4u z = zv[k];
            v4u w;
            w.x = pk2(acc[0] * rl * pg8::act_silu(bflo(z.x)), acc[1] * rl * pg8::act_silu(bfhi(z.x))); w.y = pk2(acc[2] * rl * pg8::act_silu(bflo(z.y)), acc[3] * rl * pg8::act_silu(bfhi(z.y)));
            w.z = pk2(acc[4] * rl * pg8::act_silu(bflo(z.z)), acc[5] * rl * pg8::act_silu(bfhi(z.z))); w.w = pk2(acc[6] * rl * pg8::act_silu(bflo(z.w)), acc[7] * rl * pg8::act_silu(bfhi(z.w)));
            *(v4u*)(MIX + (size_t)row * 1024 + 512 + h * 64 + ch * 8) = w;
        }
    }
}

constexpr int SG_VPITCH = 272, SG_MPITCH = 144, SG_WREG = 128 * SG_MPITCH;
constexpr int SG_STATS = 8 * SG_WREG;
constexpr int SG_MR = SG_STATS + 8192;
constexpr int SG_LN = SG_MR + 1024;
__device__ __forceinline__ void phase_sgu(const Ctx& C, int layer) {
    typedef float f32x2v __attribute__((ext_vector_type(2)));
    unsigned char* lds = C.lds;
    const bf16* U = (const bf16*)(C.ws + WS_PROJ) + (size_t)T_U * SUBSTRIDE;
    const bf16* V = (const bf16*)(C.ws + WS_PROJ) + (size_t)T_V * SUBSTRIDE;
    const bf16* ZA = (const bf16*)(C.ws + WS_PROJ) + (size_t)T_ZA * SUBSTRIDE;
    bf16* MIX = (bf16*)(C.ws + WS_MIX);
    const int g = C.wave; int lane = C.lane;
    const float* lng = C.ln_g + layer * 512 + g * 64; const float* lnb = C.ln_b + layer * 512 + g * 64;
    const bf16* Wg = (const bf16*)(C.ws + WS_WST) + ((size_t)(layer * 8 + g)) * 128 * 128;
    const float* bg = C.sgu_b + (layer * 8 + g) * 128;
    unsigned char* myreg = lds + g * SG_WREG;
    f32x2v* stats = (f32x2v*)(lds + SG_STATS); f32x2v* mr = (f32x2v*)(lds + SG_MR);
    float* lnl = (float*)(lds + SG_LN + g * 512);
    lnl[lane] = lng[lane]; lnl[64 + lane] = lnb[lane];
    for (int u = C.bid; u < MROWS / 128; u += C.G) {
        const size_t row0 = (size_t)u * 128;
        asm volatile("" : "+v"(lane));
        v4u xv[2][8];
#pragma unroll
        for (int rr = 0; rr < 2; ++rr) {
            const v4u* vp = (const v4u*)(V + (row0 + lane + 64 * rr) * 512 + g * 64);
#pragma unroll
            for (int c = 0; c < 8; ++c) xv[rr][c] = vp[c];
        }
#pragma unroll
        for (int rr = 0; rr < 2; ++rr) {
            float s1 = 0.f, s2 = 0.f;
#pragma unroll
            for (int c = 0; c < 8; ++c) { v4u v = xv[rr][c];
                v.x = pk2(pg8::act_gelu(bflo(v.x)), pg8::act_gelu(bfhi(v.x))); v.y = pk2(pg8::act_gelu(bflo(v.y)), pg8::act_gelu(bfhi(v.y)));
                v.z = pk2(pg8::act_gelu(bflo(v.z)), pg8::act_gelu(bfhi(v.z))); v.w = pk2(pg8::act_gelu(bflo(v.w)), pg8::act_gelu(bfhi(v.w))); xv[rr][c] = v;
                const float f0 = bflo(v.x), f1 = bfhi(v.x), f2 = bflo(v.y), f3 = bfhi(v.y), f4 = bflo(v.z), f5 = bfhi(v.z), f6 = bflo(v.w), f7 = bfhi(v.w);
                s1 += ((f0 + f1) + (f2 + f3)) + ((f4 + f5) + (f6 + f7));
                s2 += ((f0 * f0 + f1 * f1) + (f2 * f2 + f3 * f3)) + ((f4 * f4 + f5 * f5) + (f6 * f6 + f7 * f7)); }
            stats[g * 128 + lane + 64 * rr] = (f32x2v){s1, s2};
        }
        bf16x8 wf[4][8];
        { const bf16* wa = Wg + (size_t)(lane & 31) * 128 + (lane >> 5) * 8;
#pragma unroll
          for (int tt = 0; tt < 4; ++tt)
#pragma unroll
              for (int ks = 0; ks < 8; ++ks) if (tt >= (ks >> 1)) wf[tt][ks] = *(const bf16x8*)(wa + (size_t)tt * 32 * 128 + ks * 16); }
        __syncthreads();
        if (C.tid < 128) {
            float s1 = 0.f, s2 = 0.f;
#pragma unroll
            for (int w = 0; w < 8; ++w) { const f32x2v t = stats[w * 128 + C.tid]; s1 += t.x; s2 += t.y; }
            const float mean = s1 * (1.0f / 512.0f), var = s2 * (1.0f / 512.0f) - mean * mean;
            mr[C.tid] = (f32x2v){mean, 1.0f / sqrtf(var + LN_EPS)};
        }
        __syncthreads();
#pragma unroll
        for (int c = 0; c < 8; ++c) asm volatile("" : "+v"(xv[0][c]), "+v"(xv[1][c]));
        { const f32x2v m0 = mr[lane], m1 = mr[lane + 64];
          unsigned short* vt = (unsigned short*)(myreg + lane * 2);
#pragma unroll
          for (int c = 0; c < 8; ++c) {
              const v4u v0 = xv[0][c], v1 = xv[1][c];
              const float f0[8] = {bflo(v0.x), bfhi(v0.x), bflo(v0.y), bfhi(v0.y), bflo(v0.z), bfhi(v0.z), bflo(v0.w), bfhi(v0.w)};
              const float f1[8] = {bflo(v1.x), bfhi(v1.x), bflo(v1.y), bfhi(v1.y), bflo(v1.z), bfhi(v1.z), bflo(v1.w), bfhi(v1.w)};
#pragma unroll
              for (int e = 0; e < 8; ++e) { const int d = 8 * c + e; const float gg = lnl[d], bbv = lnl[64 + d];
                  vt[d * (SG_VPITCH / 2)] = (unsigned short)f2bf((f0[e] - m0.x) * m0.y * gg + bbv);
                  vt[d * (SG_VPITCH / 2) + 64] = (unsigned short)f2bf((f1[e] - m1.x) * m1.y * gg + bbv); }
              asm volatile("" ::: "memory");
          } }
        LDS_WAIT(); asm volatile("" ::: "memory");
        { const int q = lane & 31, hi = lane >> 5;
          unsigned pk[2][4][8];
#pragma unroll
          for (int dt = 0; dt < 2; ++dt) {
              const unsigned char* bb = myreg + (32 * dt + q) * SG_VPITCH + hi * 16;
              f32x16 acc[4];
#pragma unroll
              for (int tt = 0; tt < 4; ++tt) acc[tt] = (f32x16){};
#pragma unroll
              for (int ks = 0; ks < 8; ++ks) {
                  const bf16x8 b0 = *(const bf16x8*)(bb + ks * 32);
#pragma unroll
                  for (int tt = 0; tt < 4; ++tt) if (tt >= (ks >> 1)) acc[tt] = __builtin_amdgcn_mfma_f32_32x32x16_bf16(wf[tt][ks], b0, acc[tt], 0, 0, 0);
              }
#pragma unroll
              for (int tt = 0; tt < 4; ++tt)
#pragma unroll
                  for (int rp = 0; rp < 8; ++rp) pk[dt][tt][rp] = cvtpk(acc[tt][2 * rp], acc[tt][2 * rp + 1]);
          }
          LDS_WAIT(); asm volatile("" ::: "memory");
          unsigned char* mxb = myreg + (4 * hi) * SG_MPITCH + q * 2;
#pragma unroll
          for (int dt = 0; dt < 2; ++dt)
#pragma unroll
              for (int tt = 0; tt < 4; ++tt)
#pragma unroll
                  for (int r = 0; r < 16; ++r)
                      *(unsigned short*)(mxb + (32 * tt + (r & 3) + 8 * (r >> 2)) * SG_MPITCH + 64 * dt) = (unsigned short)((r & 1) ? (pk[dt][tt][r >> 1] >> 16) : (pk[dt][tt][r >> 1] & 0xffffu));
        }
        LDS_WAIT(); asm volatile("" ::: "memory");
        { const int ch = lane & 7, r8 = lane >> 3;
#pragma unroll 4
          for (int it = 0; it < 16; ++it) {
              const int t = it * 8 + r8;
              const v4u mv = *(const v4u*)(myreg + t * SG_MPITCH + ch * 16);
              const v4u uv = *(const v4u*)(U + (row0 + t) * 512 + g * 64 + ch * 8), zv = *(const v4u*)(ZA + (row0 + t) * 512 + g * 64 + ch * 8);
              const float bt = bg[t];
              v4u o;
#define SGU_Y(uw, mw, zw) pk2(pg8::act_gelu(bflo(uw)) * (bflo(mw) + bt) * pg8::act_silu(bflo(zw)), pg8::act_gelu(bfhi(uw)) * (bfhi(mw) + bt) * pg8::act_silu(bfhi(zw)))
              o.x = SGU_Y(uv.x, mv.x, zv.x); o.y = SGU_Y(uv.y, mv.y, zv.y); o.z = SGU_Y(uv.z, mv.z, zv.z); o.w = SGU_Y(uv.w, mv.w, zv.w);
#undef SGU_Y
              *(v4u*)(MIX + (row0 + t) * 1024 + g * 64 + ch * 8) = o;
          } }
        __syncthreads();
    }
}

__device__ __forceinline__ void phase_check_inject(const Ctx& C) {
    if (C.bid == 0 && C.tid == 0) C.out[0] = __uint_as_float(((const unsigned*)(C.ws + WS_CTL))[32]) * 1e6f;
}

#define GAS __attribute__((address_space(1)))
typedef GAS unsigned gu32;
#define RLX_AGENT __ATOMIC_RELAXED, __HIP_MEMORY_SCOPE_AGENT
constexpr int CW_BAR = 4096;
constexpr int LDS_BARST = LDS_BYTES - 64;
#define XB_TMO      128
#define XB_XCNT(j)  (256  + 64 * (j))
#define XB_XSUB(j)  (1280 + 64 * (j))
#define XB_XGEN(j)  (2304 + 64 * (j))
#define XB_TOP      3328
#define XB_TOPGEN   3392
#define XCD_BAR_WORDS 3456
#define XB_SPIN_CAP (1u << 18)

__device__ __forceinline__ unsigned xb_ld(unsigned* p)              { return __hip_atomic_load(p, __ATOMIC_RELAXED, __HIP_MEMORY_SCOPE_AGENT); }
__device__ __forceinline__ unsigned xb_add(unsigned* p, unsigned v) { return __hip_atomic_fetch_add(p, v, __ATOMIC_RELAXED, __HIP_MEMORY_SCOPE_AGENT); }
__device__ __forceinline__ unsigned xb_xcc_id() { return (unsigned)__builtin_amdgcn_s_getreg((3 << 11) | 20) & 0xFu; }
#define XB_SPIN(cond, bar) do { unsigned _sp = 0; while (cond) { __builtin_amdgcn_s_sleep(1); \
    if ((++_sp & 255u) == 0u) { if (xb_ld(&(bar)[XB_TMO])) break; if (_sp > XB_SPIN_CAP) { atomicAdd(&(bar)[XB_TMO], 1u); break; } } } } while (0)

struct XcdBarrier {
    unsigned* bar; unsigned x;
    volatile LAS unsigned* st;
};

__device__ __forceinline__ XcdBarrier xcd_barrier_post(unsigned* bar, volatile LAS unsigned* st) {
    XcdBarrier b; b.bar = bar; b.x = xb_xcc_id(); b.st = st;
    if (threadIdx.x == 0) (void)xb_add(&bar[XB_XCNT(b.x)], 1u);
    return b;
}
__device__ __forceinline__ void xcd_barrier_complete(unsigned* bar, unsigned x, unsigned& nloc, unsigned& nx) {
    const unsigned G = gridDim.x * gridDim.y * gridDim.z;
    unsigned sum, cnt, mine, sp = 0u;
    for (;;) {
        sum = 0u; cnt = 0u; mine = 0u;
#pragma unroll
        for (unsigned j = 0; j < 16; ++j) { const unsigned c = xb_ld(&bar[XB_XCNT(j)]); sum += c; cnt += (c > 0u) ? 1u : 0u; mine = (j == x) ? c : mine; }
        if (sum == G) break;
        __builtin_amdgcn_s_sleep(1);
        if ((++sp & 255u) == 0u) { if (xb_ld(&bar[XB_TMO])) break; if (sp > XB_SPIN_CAP) { atomicAdd(&bar[XB_TMO], 1u); break; } }
    }
    nloc = mine > 0u ? mine : 1u; nx = cnt > 0u ? cnt : 1u;
}

__device__ __forceinline__ void xcd_barrier(const XcdBarrier& b, const bool leader_thread) {
    asm volatile("s_waitcnt vmcnt(0)" ::: "memory");
    __syncthreads();
    if (leader_thread) {
        unsigned* bar = b.bar;
        __builtin_amdgcn_s_waitcnt(0);
        unsigned nloc = b.st[0], nx = b.st[1];
        if (nloc == 0u) { xcd_barrier_complete(bar, b.x, nloc, nx); b.st[0] = nloc; b.st[1] = nx; }
        const unsigned old = xb_add(&bar[XB_XSUB(b.x)], 1u);
        const unsigned gen = old / nloc;
        if (old + 1u == (gen + 1u) * nloc) {
            __builtin_amdgcn_fence(__ATOMIC_RELEASE, "agent");
            asm volatile("s_waitcnt vmcnt(0)" ::: "memory");
            const unsigned og = xb_add(&bar[XB_TOP], 1u);
            const unsigned tg = og / nx;
            if (og + 1u == (tg + 1u) * nx) xb_add(&bar[XB_TOPGEN], 1u);
            else XB_SPIN(xb_ld(&bar[XB_TOPGEN]) == tg, bar);
            __builtin_amdgcn_fence(__ATOMIC_ACQUIRE, "agent");
            xb_add(&bar[XB_XGEN(b.x)], 1u);
            asm volatile("s_waitcnt vmcnt(0)" ::: "memory");
        } else {
            XB_SPIN(xb_ld(&bar[XB_XGEN(b.x)]) == gen, bar);
            __builtin_amdgcn_fence(__ATOMIC_ACQUIRE, "agent");
            asm volatile("s_waitcnt vmcnt(0)" ::: "memory");
        }
    }
    __syncthreads();
}

template <int ST> __device__ __forceinline__ void run_stage(const Args& args, unsigned char* lds, int Lr, int wave_s) {
    const int L = Lr;
    Ctx C;
    { int t = wave_s * 64 + lane_now(); C.tid = t; }
    C.lds = lds; C.lane = C.tid & 63; C.wave = __builtin_amdgcn_readfirstlane(C.tid >> 6); C.G = gridDim.x; C.bid = blockIdx.x;
    C.x = args.in[0]; C.norm_g = args.in[1]; C.w_in = args.in[2]; C.ln_g = args.in[3]; C.ln_b = args.in[4]; C.sgu_w = args.in[5]; C.sgu_b = args.in[6];
    C.w_out = args.in[7]; C.rel_bias = args.in[8]; C.final_g = args.in[9]; C.out = args.out; C.ws = args.ws;
    asm volatile("" : "+s"(C.ws), "+s"(C.out), "+s"(C.x), "+s"(C.sgu_b), "+s"(C.ln_g), "+s"(C.ln_b));
    if constexpr (ST == 0) phase_prologue(C);
    else if constexpr (ST == 1) {
        pg8::Gemm g{(const pg8::bf16_t*)(C.ws + WS_XB), (const pg8::bf16_t*)(C.ws + WS_WIN) + (size_t)L * DIN * DM, MROWS, DIN, DM};
        pg8::StaticOrder S; S.init(MROWS, DIN, C.G, C.bid);
        int pmA = -1, pmB = -1, pmC = -1, pmD = -1;
        { pg8::Unit uu;
          for (int i = 0; S.next(i, uu); ++i) { const int pmu = uu.pm;
              if (pmu == pmA || pmu == pmB || pmu == pmC || pmu == pmD) continue;
              if (pmA < 0) pmA = pmu; else if (pmB < 0) pmB = pmu; else if (pmC < 0) pmC = pmu; else if (pmD < 0) pmD = pmu; } }
        float* rtab = (float*)(lds + RING_BYTES);
        { const float* rowss = (const float*)(C.ws + WS_ROWSS);
#pragma unroll
          for (int k = 0; k < 2; ++k) { const int e = C.tid + 512 * k, sl = e >> 8, pmk = sl == 0 ? pmA : sl == 1 ? pmB : sl == 2 ? pmC : pmD;
              if (pmk >= 0) { const f32x4* rp = (const f32x4*)(rowss + ((size_t)pmk * 256 + (e & 255)) * 16); const f32x4 s0 = rp[0], s1 = rp[1], s2 = rp[2], s3 = rp[3];
                  const float ss = ((s0[0] + s0[1]) + (s0[2] + s0[3])) + ((s1[0] + s1[1]) + (s1[2] + s1[3])) + ((s2[0] + s2[1]) + (s2[2] + s2[3])) + ((s3[0] + s3[1]) + (s3[2] + s3[3]));
                  rtab[e] = 1.0f / sqrtf(ss * (1.0f / 1024.0f) + NORM_EPS); } }
          __syncthreads(); }
        pg8::EpiProj E{(pg8::bf16_t*)(C.ws + WS_PROJ), SUBSTRIDE, rtab, pmA, pmB, pmC, pmD, (float*)(C.ws + WS_KMEAN) + (size_t)L * NBH * NBLK * 64};
        pg8::gemm_phase<pg8::EpiProj, pg8::StaticOrder, true, true>((PG8_LAS unsigned char*)lds, g, S, E, C.tid);
    }
    else if constexpr (ST == 3) { phase_gate(C, L); phase_sgu(C, L); }
    else if constexpr (ST == 4) phase_attn(C, L);
    else if constexpr (ST == 5) phase_combine(C);
    else if constexpr (ST == 6) {
        pg8::Gemm g{(const pg8::bf16_t*)(C.ws + WS_MIX), (const pg8::bf16_t*)(C.ws + WS_WOUT) + (size_t)L * DM * DM, MROWS, DM, DM};
        pg8::StaticOrder S; S.init(MROWS, DM, C.G, C.bid);
        if (L == 0) { pg8::EpiRes E{(pg8::bf16_t*)(C.ws + WS_XB), (float*)(C.ws + WS_ROWSS)};
            pg8::gemm_phase<pg8::EpiRes, pg8::StaticOrder, true, true>((PG8_LAS unsigned char*)lds, g, S, E, C.tid); }
        else { pg8::EpiFinal E{(const pg8::bf16_t*)(C.ws + WS_XB), C.out, C.final_g, (float*)(C.ws + WS_ROWSS), (unsigned*)(C.ws + WS_CTL) + 8192};
            pg8::gemm_phase<pg8::EpiFinal, pg8::StaticOrder, true, true>((PG8_LAS unsigned char*)lds, g, S, E, C.tid); }
    } else if constexpr (ST == 7) phase_check_inject(C);
    else if constexpr (ST == 8) phase_attn_simple(C, (bf16*)(C.ws + 104 * MiB));
    else if constexpr (ST == 9) {
        const bf16* A = (const bf16*)(C.ws + WS_MIX); const bf16* B = (const bf16*)(C.ws + 104 * MiB); unsigned* flag = (unsigned*)(C.ws + WS_CTL) + 32;
        float md = 0.f;
        for (size_t idx = (size_t)C.bid * 512 + C.tid; idx < (size_t)MROWS * 512; idx += (size_t)C.G * 512) {
            const size_t row = idx >> 9, col = 512 + (idx & 511);
            const float a = __uint_as_float((unsigned)A[row * 1024 + col] << 16), r = __uint_as_float((unsigned)B[row * 1024 + col] << 16);
            float sc = fabsf(r);
#pragma unroll
            for (int o = 1; o < 64; o <<= 1) sc = fmaxf(sc, __shfl_xor(sc, o));
            const float d = fabsf(a - r) / (0.02f + sc);
            md = (d > md || !(d == d)) ? (d == d ? d : 1e6f) : md;
        }
        atomicMax(flag, __float_as_uint(md));
    }
}
template <int SEL> __global__ void __launch_bounds__(NWAVES * 64, 2) fwd(Args args) {
    extern __shared__ __attribute__((aligned(16))) unsigned char lds[];
    const int wave_s = __builtin_amdgcn_readfirstlane((int)threadIdx.x >> 6);
    if constexpr (SEL >= 0) run_stage<SEL>(args, lds, args.layer, wave_s);
    else {
        if (args.pad == 0x7fffffff) cg::this_grid().sync();
        volatile LAS unsigned* bst = (volatile LAS unsigned*)((LAS unsigned char*)lds + LDS_BARST);
        if (threadIdx.x == 0) { bst[0] = 0u; bst[1] = 0u; }
        __syncthreads();
        XcdBarrier bar = xcd_barrier_post((unsigned*)(args.ws + WS_CTL) + CW_BAR, bst);
#define GRID_SYNC() do { XcdBarrier b2_ = bar; asm volatile("" : "+s"(b2_.bar), "+s"(b2_.x)); xcd_barrier(b2_, wave_s == 0 && lane_now() == 0); } while (0)
#define RUN(k, L) do { run_stage<k>(args, lds, L, wave_s); GRID_SYNC(); } while (0)
        RUN(0, 0);
        for (int L = 0; L < DEPTH; ++L) {
            RUN(1, L); RUN(3, L); RUN(4, L); RUN(5, L);
            if (L == DEPTH - 1) run_stage<6>(args, lds, L, wave_s); else RUN(6, L);
        }
    }
}

#ifndef MK_N_LAUNCHES
#define MK_N_LAUNCHES 1
#endif
template <int SEL> static void launch_stage(int grid, Args a, int layer, hipStream_t stream) {
    static bool attr = false;
    if (!attr) { (void)hipFuncSetAttribute((const void*)fwd<SEL>, hipFuncAttributeMaxDynamicSharedMemorySize, LDS_BYTES); attr = true; }
    a.layer = layer;
    hipLaunchKernelGGL(fwd<SEL>, dim3(grid), dim3(NWAVES * 64), LDS_BYTES, stream, a);
}
extern "C" void kernel_launch(void* const* d_in, const int* in_sizes, int n_in, void* d_out, int out_size, void* d_ws, size_t ws_size, hipStream_t stream) {
    static int grid = 0;
    if (grid == 0) {
        if (n_in != 10 || out_size != MROWS * DM || ws_size < WS_END) { fprintf(stderr, "kernel_launch: unexpected shapes (n_in %d out %d ws %zu)\n", n_in, out_size, ws_size); grid = -1; return; }
        int dev = 0, cus = 0;
        (void)hipGetDevice(&dev); (void)hipDeviceGetAttribute(&cus, hipDeviceAttributeMultiprocessorCount, dev);
        grid = cus;
        if (grid != 256) fprintf(stderr, "kernel_launch: %d CUs: the fused final-norm epilogue pairs the four column tiles of a row panel inside one round of a 256-workgroup grid\n", grid);
#if MK_N_LAUNCHES == 1
        int per_cu = 0;
        if (hipFuncSetAttribute((const void*)fwd<-1>, hipFuncAttributeMaxDynamicSharedMemorySize, LDS_BYTES) != hipSuccess) { fprintf(stderr, "kernel_launch: hipFuncSetAttribute failed\n"); grid = -1; return; }
        if (hipOccupancyMaxActiveBlocksPerMultiprocessor(&per_cu, (const void*)fwd<-1>, NWAVES * 64, LDS_BYTES) != hipSuccess || per_cu < 1) { fprintf(stderr, "kernel_launch: occupancy query says %d\n", per_cu); grid = -1; return; }
        (void)hipGetLastError();
#endif
    }
    if (grid < 0) return;
    (void)hipMemsetAsync((char*)d_ws + WS_CTL, 0, CTL_ZERO_BYTES, stream);
    Args a{};
    for (int i = 0; i < 10; ++i) a.in[i] = (const float*)d_in[i];
    a.out = (float*)d_out; a.ws = (unsigned char*)d_ws;
#if MK_N_LAUNCHES == 1
    void* kargs[] = {&a};
    hipError_t e = hipLaunchCooperativeKernel((const void*)fwd<-1>, dim3(grid), dim3(NWAVES * 64), kargs, LDS_BYTES, stream);
    if (e != hipSuccess) fprintf(stderr, "kernel_launch: cooperative launch failed: %s\n", hipGetErrorString(e));
#else
    launch_stage<0>(grid, a, 0, stream);
    for (int L = 0; L < DEPTH; ++L) {
        launch_stage<1>(grid, a, L, stream); launch_stage<3>(grid, a, L, stream);
        launch_stage<4>(grid, a, L, stream); launch_stage<5>(grid, a, L, stream);
        if (CHECK_ATTN && L == 0) { launch_stage<8>(grid, a, L, stream); launch_stage<9>(grid, a, L, stream); }
        launch_stage<6>(grid, a, L, stream);
    }
    if (CHECK_ATTN) launch_stage<7>(grid, a, 0, stream);
#endif
}
```

```cpp
#include <hip/hip_runtime.h>
#include <hip/hip_cooperative_groups.h>
#include <cstdio>
#include <cstdint>
namespace cg = cooperative_groups;

constexpr int BATCH = 2, SEQ = 16384, DM = 1024, MROWS = BATCH * SEQ, DIN = 3584, DSUB = 512;
constexpr int NH = 8, DH = 64, NBLK = SEQ / 256, NBH = BATCH * NH, DEPTH = 2;
constexpr float NORM_EPS = 1e-6f, LN_EPS = 1e-5f;
constexpr float LOG2E = 1.4426950408889634f;
#ifndef CHECK_ATTN
#define CHECK_ATTN 0
#endif
constexpr float QSCALE = 0.125f * LOG2E;
namespace pg8 {
#define PG8_LAS __attribute__((address_space(3)))
typedef unsigned short bf16_t;
typedef short bf16x8 __attribute__((ext_vector_type(8)));
typedef float f32x4 __attribute__((ext_vector_type(4)));
typedef unsigned u32x4 __attribute__((ext_vector_type(4)));
constexpr int BM = 256, BK = 64, HALF = 128, HTB = HALF * BK * 2  , STAGE_BYTES = 8 * HTB, NXCD = 8, WGM = 8;

__host__ __device__ __forceinline__ int lds_byte(int r, int c) { const int st = (r >> 4) * 2 + (c >> 5), rr = r & 15, cc = c & 31, ob = rr * 64 + cc * 2; return st * 1024 + (ob ^ (((ob >> 9) & 1) << 5)); }
__host__ __device__ __forceinline__ void stage_rc(int b, int& R, int& C) { const int st = b / 1024, sb = b % 1024, swz = sb ^ (((sb >> 9) & 1) << 5); R = (st >> 1) * 16 + swz / 64; C = (st & 1) * 32 + (swz % 64) / 2; }
__host__ __device__ __forceinline__ int perm32(int rho) { const int n = rho >> 4, i = rho & 15; return 8 * (i >> 2) + 4 * n + (i & 3); }

struct Unit { int pm, pn; };
struct Gemm { const bf16_t* A; const bf16_t* Bt; int M, N, K; };

struct StaticOrder {
    int nM, nN, nwg, G, c;
    __host__ __device__ void init(int M, int N, int G_, int c_) { nM = M / BM; nN = N / BM; nwg = nM * nN; G = G_; c = c_; }
    __host__ __device__ bool next(int i, Unit& u) const {
        const long L = (long)i * G + c; if (L >= nwg) return false;
        int wgid = (int)L; { const int q = nwg / NXCD, r = nwg % NXCD, xcd = wgid % NXCD, off = wgid / NXCD; wgid = (xcd < r ? xcd * (q + 1) : r * (q + 1) + (xcd - r) * q) + off; }
        const int nig = WGM * nN, gid = wgid / nig, fm = gid * WGM, gsz = (nM - fm) < WGM ? (nM - fm) : WGM;
        u.pm = fm + ((wgid % nig) % gsz); u.pn = (wgid % nig) / gsz; return true;
    }
    __device__ __forceinline__ void a_ready(const Unit&) const {}
    __device__ __forceinline__ void done(const Unit&) const {}
};

__device__ __forceinline__ unsigned cvt_pk_bf16(float lo, float hi) { unsigned r; asm volatile("v_cvt_pk_bf16_f32 %0, %1, %2" : "=v"(r) : "v"(lo), "v"(hi)); return r; }
typedef float f32x2 __attribute__((ext_vector_type(2)));
typedef float f32x2 __attribute__((ext_vector_type(2)));
__device__ __forceinline__ float act_gelu(float x) {
    const float u = x * (1.0f + 0.044715f * x * x);
    const float e = __builtin_amdgcn_exp2f(u * (-2.0f * 0.7978845608028654f * 1.4426950408889634f));
    return x * __builtin_amdgcn_rcpf(1.0f + e);
}
__device__ __forceinline__ float act_silu(float x) {
    const float e = __builtin_amdgcn_exp2f(x * (-1.4426950408889634f));
    return x * __builtin_amdgcn_rcpf(1.0f + e);
}
struct EpiProj {
    static constexpr bool PERM = true, AFTER_DRAIN = false;
    bf16_t* P; size_t sub_stride; const float* rstd_lds; int pm0, pm1, pm2, pm3; float* kmean;
    __device__ __forceinline__ void operator()(const f32x4 (&acc)[2][2][4][2], const Unit& u, int wr, int wc, int fr, int fq) const {
        const int t = u.pn >> 1;
        bf16_t* base = P + (size_t)t * sub_stride;
        const int col0 = (u.pn & 1) * 256 + wc * 32 + 8 * fq;
        const int row0 = u.pm * BM + wr * 64 + fr;
        const int slot = (u.pm == pm0) ? 0 : (u.pm == pm1) ? 1 : (u.pm == pm2) ? 2 : 3;
        const float* rt = rstd_lds + slot * 256 + wr * 64 + fr;
        const float qs = (t == 3) ? (0.125f * 1.4426950408889634f) : 1.0f;
        float ks[2][8];
#pragma unroll
        for (int bj = 0; bj < 2; ++bj)
#pragma unroll
            for (int e = 0; e < 8; ++e) ks[bj][e] = 0.f;
#pragma unroll
        for (int ai = 0; ai < 2; ++ai)
#pragma unroll
            for (int m = 0; m < 4; ++m) {
                const int row = row0 + ai * HALF + m * 16;
                const float rs = rt[ai * HALF + m * 16] * qs;
                bf16_t* rowp = base + (size_t)row * 512 + col0;
#pragma unroll
                for (int bj = 0; bj < 2; ++bj) {
                    const f32x4 v0 = acc[ai][bj][m][0] * rs, v1 = acc[ai][bj][m][1] * rs;
                    if (t == 4) {
#pragma unroll
                        for (int e = 0; e < 4; ++e) { ks[bj][e] += v0[e]; ks[bj][4 + e] += v1[e]; }
                    }
                    u32x4 w; w.x = cvt_pk_bf16(v0[0], v0[1]); w.y = cvt_pk_bf16(v0[2], v0[3]); w.z = cvt_pk_bf16(v1[0], v1[1]); w.w = cvt_pk_bf16(v1[2], v1[3]);
                    *(u32x4*)(rowp + bj * HALF) = w;
                }
            }
        if (t == 4) {
            const int b = u.pm >> 6, n = u.pm & 63;
#pragma unroll
            for (int bj = 0; bj < 2; ++bj)
#pragma unroll
                for (int e = 0; e < 8; ++e) {
                    float v = ks[bj][e];
                    v += __shfl_xor(v, 1); v += __shfl_xor(v, 2); v += __shfl_xor(v, 4); v += __shfl_xor(v, 8);
                    if (fr == 0) { const int col = col0 + bj * HALF + e; atomicAdd(kmean + ((size_t)((b * 8 + (col >> 6)) * 64 + n)) * 64 + (col & 63), v * (1.0f / 256.0f)); }
                }
        }
    }
};
#define PG8_GAS __attribute__((address_space(1)))
struct EpiRes {
    static constexpr bool PERM = true, AFTER_DRAIN = false;
    bf16_t* xb; float* rowss;
    __device__ __forceinline__ void operator()(const f32x4 (&acc)[2][2][4][2], const Unit& u, int wr, int wc, int fr, int fq) const {
        const int col0 = u.pn * BM + wc * 32 + 8 * fq;
        PG8_GAS bf16_t* xbg = (PG8_GAS bf16_t*)xb; PG8_GAS float* rsg = (PG8_GAS float*)rowss;
        const unsigned ob = (unsigned)((u.pm * BM + wr * 64 + fr) * 1024 + col0) * 2u;
        u32x4 rr[2][4][2];
#pragma unroll
        for (int ai = 0; ai < 2; ++ai)
#pragma unroll
            for (int m = 0; m < 4; ++m)
#pragma unroll
                for (int bj = 0; bj < 2; ++bj) rr[ai][m][bj] = *(const PG8_GAS u32x4*)((const PG8_GAS char*)xbg + (ob + (unsigned)(((ai * HALF + m * 16) * 1024 + bj * HALF) * 2)));
#pragma unroll
        for (int ai = 0; ai < 2; ++ai)
#pragma unroll
            for (int m = 0; m < 4; ++m) {
                const int row = u.pm * BM + ai * HALF + wr * 64 + m * 16 + fr;
                float ss = 0.f;
#pragma unroll
                for (int bj = 0; bj < 2; ++bj) {
                    const u32x4 w0 = rr[ai][m][bj];
                    const f32x4 r0 = (f32x4){__uint_as_float(w0.x << 16), __uint_as_float(w0.x & 0xffff0000u), __uint_as_float(w0.y << 16), __uint_as_float(w0.y & 0xffff0000u)};
                    const f32x4 r1 = (f32x4){__uint_as_float(w0.z << 16), __uint_as_float(w0.z & 0xffff0000u), __uint_as_float(w0.w << 16), __uint_as_float(w0.w & 0xffff0000u)};
                    const f32x4 o0 = r0 + acc[ai][bj][m][0], o1 = r1 + acc[ai][bj][m][1];
                    ss += ((o0[0] * o0[0] + o0[1] * o0[1]) + (o0[2] * o0[2] + o0[3] * o0[3])) + ((o1[0] * o1[0] + o1[1] * o1[1]) + (o1[2] * o1[2] + o1[3] * o1[3]));
                    u32x4 w; w.x = cvt_pk_bf16(o0[0], o0[1]); w.y = cvt_pk_bf16(o0[2], o0[3]); w.z = cvt_pk_bf16(o1[0], o1[1]); w.w = cvt_pk_bf16(o1[2], o1[3]);
                    *(PG8_GAS u32x4*)((PG8_GAS char*)xbg + (ob + (unsigned)(((ai * HALF + m * 16) * 1024 + bj * HALF) * 2))) = w;
                }
                ss += __shfl_xor(ss, 16); ss += __shfl_xor(ss, 32);
                if (fq == 0) rsg[(size_t)row * 16 + u.pn * 4 + wc] = ss;
            }
    }
};
struct EpiFinal {
    static constexpr bool PERM = true, AFTER_DRAIN = false;
    const bf16_t* xb; float* out; const float* fg; float* slots; unsigned* cnt;
    __device__ __forceinline__ void operator()(f32x4 (&acc)[2][2][4][2], const Unit& u, int wr, int wc, int fr, int fq) const {
        const int col0 = u.pn * BM + wc * 32 + 8 * fq;
        const PG8_GAS bf16_t* xbg = (const PG8_GAS bf16_t*)xb; PG8_GAS float* outg = (PG8_GAS float*)out; const PG8_GAS float* slg = (const PG8_GAS float*)slots;
        const unsigned ob = (unsigned)((u.pm * BM + wr * 64 + fr) * 1024 + col0) * 2u;
        u32x4 rr[2][4][2];
#pragma unroll
        for (int ai = 0; ai < 2; ++ai)
#pragma unroll
            for (int m = 0; m < 4; ++m)
#pragma unroll
                for (int bj = 0; bj < 2; ++bj) rr[ai][m][bj] = *(const PG8_GAS u32x4*)((const PG8_GAS char*)xbg + (ob + (unsigned)(((ai * HALF + m * 16) * 1024 + bj * HALF) * 2)));
#pragma unroll
        for (int ai = 0; ai < 2; ++ai)
#pragma unroll
            for (int m = 0; m < 4; ++m) {
                const int row = u.pm * BM + ai * HALF + wr * 64 + m * 16 + fr;
                float ss = 0.f;
#pragma unroll
                for (int bj = 0; bj < 2; ++bj) {
                    const u32x4 w = rr[ai][m][bj];
                    const f32x4 r0 = (f32x4){__uint_as_float(w.x << 16), __uint_as_float(w.x & 0xffff0000u), __uint_as_float(w.y << 16), __uint_as_float(w.y & 0xffff0000u)};
                    const f32x4 r1 = (f32x4){__uint_as_float(w.z << 16), __uint_as_float(w.z & 0xffff0000u), __uint_as_float(w.w << 16), __uint_as_float(w.w & 0xffff0000u)};
                    const f32x4 o0 = r0 + acc[ai][bj][m][0], o1 = r1 + acc[ai][bj][m][1];
                    acc[ai][bj][m][0] = o0; acc[ai][bj][m][1] = o1;
                    ss += ((o0[0] * o0[0] + o0[1] * o0[1]) + (o0[2] * o0[2] + o0[3] * o0[3])) + ((o1[0] * o1[0] + o1[1] * o1[1]) + (o1[2] * o1[2] + o1[3] * o1[3]));
                }
                ss += __shfl_xor(ss, 16); ss += __shfl_xor(ss, 32);
                if (fq == 0) __hip_atomic_store(slots + (size_t)row * 16 + u.pn * 4 + wc, ss, __ATOMIC_RELAXED, __HIP_MEMORY_SCOPE_AGENT);
            }
        asm volatile("s_waitcnt vmcnt(0)" ::: "memory");
        unsigned* pc = cnt + 64 * u.pm;
        if (fr == 0 && fq == 0) __hip_atomic_fetch_add(pc, 1u, __ATOMIC_RELAXED, __HIP_MEMORY_SCOPE_AGENT);
        f32x4 g4[2][2];
#pragma unroll
        for (int bj = 0; bj < 2; ++bj)
#pragma unroll
            for (int n = 0; n < 2; ++n) g4[bj][n] = *(const PG8_GAS f32x4*)((const PG8_GAS float*)fg + col0 + bj * HALF + n * 4);
        for (unsigned spins = 0; spins < (1u << 22); ++spins) {
            if (__hip_atomic_load(pc, __ATOMIC_RELAXED, __HIP_MEMORY_SCOPE_AGENT) >= 32u) break;
            __builtin_amdgcn_s_sleep(2);
        }
        __builtin_amdgcn_fence(__ATOMIC_ACQUIRE, "agent");
        asm volatile("s_waitcnt vmcnt(0)" ::: "memory");
#pragma unroll
        for (int ai = 0; ai < 2; ++ai) {
            f32x4 sl[4][4];
#pragma unroll
            for (int m = 0; m < 4; ++m)
#pragma unroll
                for (int k = 0; k < 4; ++k) sl[m][k] = *(const PG8_GAS f32x4*)(slg + (size_t)(u.pm * BM + ai * HALF + wr * 64 + m * 16 + fr) * 16 + k * 4);
#pragma unroll
            for (int m = 0; m < 4; ++m) {
                const f32x4 s0 = sl[m][0], s1 = sl[m][1], s2 = sl[m][2], s3 = sl[m][3];
                const float tot = ((s0[0] + s0[1]) + (s0[2] + s0[3])) + ((s1[0] + s1[1]) + (s1[2] + s1[3])) + ((s2[0] + s2[1]) + (s2[2] + s2[3])) + ((s3[0] + s3[1]) + (s3[2] + s3[3]));
                const float rs = 1.0f / sqrtf(tot * (1.0f / 1024.0f) + 1e-6f);
#pragma unroll
                for (int bj = 0; bj < 2; ++bj)
#pragma unroll
                    for (int n = 0; n < 2; ++n) *(PG8_GAS f32x4*)((PG8_GAS char*)outg + (2u * ob + (unsigned)(((ai * HALF + m * 16) * 1024 + bj * HALF + n * 4) * 4))) = acc[ai][bj][m][n] * rs * g4[bj][n];
            }
        }
    }
};
template <class Epi, class Sched, bool ALIGN_EPI = false, bool SP2 = false>
__device__ __forceinline__ void gemm_phase(PG8_LAS unsigned char* lds, const Gemm g, const Sched& S, const Epi& E, const int tid) {
    const int wid = __builtin_amdgcn_readfirstlane(tid >> 6), lane = tid & 63, wr = wid >> 2, wc = wid & 3, fr = lane & 15, fq = lane >> 4;
    const int K = g.K, nt = K / BK;
    unsigned voffA[2], voffB[2];
#pragma unroll
    for (int i = 0; i < 2; ++i) { int R, C; stage_rc(tid * 16 + i * 8192, R, C); const int Rb = Epi::PERM ? ((R & ~31) + perm32(R & 31)) : R;
        voffA[i] = (unsigned)(R * K + C) * 2u; voffB[i] = (unsigned)(Rb * K + C) * 2u; }
    const size_t kstep = (size_t)(BK * 2);
    const size_t hstep = (size_t)HALF * K * 2;
    const size_t tstep = 2 * hstep;
    const unsigned ldsw = (unsigned)wid * 1024u;
    const int aoff = lds_byte(wr * 64 + fr, fq * 8), boff = lds_byte(wc * 32 + fr, fq * 8);
#define PG8_SA(b, h) (((b) * 2 + (h)) * HTB)
#define PG8_SB(b, h) ((4 + (b) * 2 + (h)) * HTB)
#define PG8_STAGE(bufoff, gbase, voff) do { _Pragma("unroll") for (int _i = 0; _i < 2; ++_i) \
        __builtin_amdgcn_global_load_lds((const unsigned*)((const char*)(gbase) + (voff)[_i]), (PG8_LAS unsigned*)(lds + (bufoff) + ldsw + _i * 8192), 16, 0, 0); } while (0)
#define PG8_LDA(dst, b, h) do { _Pragma("unroll") for (int m = 0; m < 4; ++m) _Pragma("unroll") for (int k = 0; k < 2; ++k) dst[m][k] = *(const PG8_LAS bf16x8*)(lds + PG8_SA(b, h) + aoff + m * 2048 + k * 1024); } while (0)
#define PG8_LDB(dst, b, h) do { _Pragma("unroll") for (int n = 0; n < 2; ++n) _Pragma("unroll") for (int k = 0; k < 2; ++k) dst[n][k] = *(const PG8_LAS bf16x8*)(lds + PG8_SB(b, h) + boff + n * 2048 + k * 1024); } while (0)
#define PG8_MMA(ai, bj, At, Bt) do { __builtin_amdgcn_s_setprio(1); _Pragma("unroll") for (int m = 0; m < 4; ++m) _Pragma("unroll") for (int n = 0; n < 2; ++n) _Pragma("unroll") for (int k = 0; k < 2; ++k) \
        acc[ai][bj][m][n] = __builtin_amdgcn_mfma_f32_16x16x32_bf16(Bt[n][k], At[m][k], acc[ai][bj][m][n], 0, 0, 0); __builtin_amdgcn_s_setprio(0); } while (0)
#define PG8_WAIT_V(n) asm volatile("s_waitcnt vmcnt(" #n ")" ::: "memory")
#define PG8_WAIT_L(n) asm volatile("s_waitcnt lgkmcnt(" #n ")" ::: "memory")
#define PG8_BAR __builtin_amdgcn_s_barrier()
#define PG8_SCHED __builtin_amdgcn_sched_barrier(0)
    Unit cur, nxt; int ui = 0;
    if (!S.next(0, cur)) return;
    f32x4 acc[2][2][4][2];
#pragma unroll
    for (int a = 0; a < 2; ++a)
#pragma unroll
        for (int b = 0; b < 2; ++b)
#pragma unroll
            for (int m = 0; m < 4; ++m)
#pragma unroll
                for (int n = 0; n < 2; ++n) acc[a][b][m][n] = (f32x4){0.f, 0.f, 0.f, 0.f};
    bf16x8 At[4][2], B0[2][2], B1[2][2];
    const char* cA = (const char*)g.A + (size_t)cur.pm * tstep; const char* cB = (const char*)g.Bt + (size_t)cur.pn * tstep;
    S.a_ready(cur);
    if constexpr (SP2) {
        PG8_STAGE(PG8_SB(0, 0), cB, voffB); PG8_STAGE(PG8_SB(0, 1), cB + hstep, voffB); PG8_STAGE(PG8_SA(0, 0), cA, voffA); PG8_STAGE(PG8_SA(0, 1), cA + hstep, voffA);
        if (wr == 1) PG8_BAR;
        PG8_WAIT_V(2); PG8_BAR;
        PG8_STAGE(PG8_SB(1, 0), cB + kstep, voffB); PG8_STAGE(PG8_SA(1, 0), cA + kstep, voffA); PG8_STAGE(PG8_SB(1, 1), cB + hstep + kstep, voffB);
        PG8_WAIT_V(6); PG8_BAR;
    } else {
        PG8_STAGE(PG8_SB(0, 0), cB, voffB); PG8_STAGE(PG8_SA(0, 0), cA, voffA); PG8_STAGE(PG8_SB(0, 1), cB + hstep, voffB); PG8_STAGE(PG8_SA(0, 1), cA + hstep, voffA);
        if (wr == 1) PG8_BAR;
        PG8_WAIT_V(4); PG8_BAR;
        PG8_STAGE(PG8_SB(1, 0), cB + kstep, voffB); PG8_STAGE(PG8_SA(1, 0), cA + kstep, voffA); PG8_STAGE(PG8_SB(1, 1), cB + hstep + kstep, voffB);
        PG8_WAIT_V(6); PG8_BAR;
    }
    for (;;) {
        const bool has_next = S.next(ui + 1, nxt);
        const char* nA = has_next ? (const char*)g.A + (size_t)nxt.pm * tstep : cA; const char* nB = has_next ? (const char*)g.Bt + (size_t)nxt.pn * tstep : cB;
        for (int t = 0; t < nt; t += 2) {
            const bool last = (t == nt - 2);
            const char* a1 = cA + (size_t)(t + 1) * kstep;
            const char* a2 = last ? nA : cA + (size_t)(t + 2) * kstep; const char* b2 = last ? nB : cB + (size_t)(t + 2) * kstep;
            const char* a3 = a2 + kstep; const char* b3 = b2 + kstep;
            if (last && has_next) S.a_ready(nxt);
            if constexpr (SP2) {
            PG8_LDB(B0, 0, 0); PG8_LDB(B1, 0, 1); PG8_SCHED; PG8_LDA(At, 0, 0); PG8_STAGE(PG8_SA(1, 1), a1 + hstep, voffA);
            PG8_WAIT_V(8); PG8_WAIT_L(0); PG8_BAR; PG8_MMA(0, 0, At, B0); PG8_MMA(0, 1, At, B1); PG8_BAR; PG8_SCHED;
            PG8_LDA(At, 0, 1); PG8_STAGE(PG8_SB(0, 0), b2, voffB); PG8_STAGE(PG8_SB(0, 1), b2 + hstep, voffB); PG8_STAGE(PG8_SA(0, 0), a2, voffA);
            PG8_WAIT_V(8); PG8_WAIT_L(0); PG8_BAR; PG8_MMA(1, 0, At, B0); PG8_MMA(1, 1, At, B1); PG8_BAR; PG8_SCHED;
            PG8_LDB(B0, 1, 0); PG8_LDB(B1, 1, 1); PG8_SCHED; PG8_LDA(At, 1, 0); PG8_STAGE(PG8_SA(0, 1), a2 + hstep, voffA);
            PG8_WAIT_V(8); PG8_WAIT_L(0); PG8_BAR; PG8_MMA(0, 0, At, B0); PG8_MMA(0, 1, At, B1); PG8_BAR; PG8_SCHED;
            PG8_LDA(At, 1, 1); PG8_STAGE(PG8_SB(1, 0), b3, voffB); PG8_STAGE(PG8_SB(1, 1), b3 + hstep, voffB); PG8_STAGE(PG8_SA(1, 0), a3, voffA);
            PG8_WAIT_V(8); PG8_WAIT_L(0); PG8_BAR; PG8_MMA(1, 0, At, B0); PG8_MMA(1, 1, At, B1); PG8_BAR; PG8_SCHED;
            } else {
            PG8_LDB(B0, 0, 0); PG8_SCHED; PG8_LDA(At, 0, 0); PG8_STAGE(PG8_SA(1, 1), a1 + hstep, voffA);
            PG8_WAIT_L(8); PG8_BAR; PG8_WAIT_L(0); PG8_MMA(0, 0, At, B0); PG8_BAR; PG8_SCHED;
            PG8_LDB(B1, 0, 1); PG8_STAGE(PG8_SB(0, 0), b2, voffB);
            PG8_BAR; PG8_WAIT_L(0); PG8_MMA(0, 1, At, B1); PG8_BAR;
            PG8_LDA(At, 0, 1); PG8_STAGE(PG8_SA(0, 0), a2, voffA);
            PG8_BAR; PG8_WAIT_L(0); PG8_MMA(1, 0, At, B0); PG8_BAR; PG8_SCHED;
            PG8_STAGE(PG8_SB(0, 1), b2 + hstep, voffB);
            PG8_WAIT_V(6); PG8_BAR; PG8_MMA(1, 1, At, B1); PG8_BAR;
            PG8_LDB(B0, 1, 0); PG8_SCHED; PG8_LDA(At, 1, 0); PG8_STAGE(PG8_SA(0, 1), a2 + hstep, voffA);
            PG8_WAIT_L(8); PG8_BAR; PG8_WAIT_L(0); PG8_MMA(0, 0, At, B0); PG8_BAR; PG8_SCHED;
            PG8_LDB(B1, 1, 1); PG8_STAGE(PG8_SB(1, 0), b3, voffB);
            PG8_BAR; PG8_WAIT_L(0); PG8_MMA(0, 1, At, B1); PG8_BAR;
            PG8_LDA(At, 1, 1); PG8_STAGE(PG8_SA(1, 0), a3, voffA);
            PG8_BAR; PG8_WAIT_L(0); PG8_MMA(1, 0, At, B0); PG8_BAR; PG8_SCHED;
            PG8_STAGE(PG8_SB(1, 1), b3 + hstep, voffB);
            PG8_WAIT_V(6); PG8_BAR; PG8_MMA(1, 1, At, B1); PG8_BAR;
            }
        }
        if constexpr (ALIGN_EPI) { if (wr == 0) PG8_BAR; }
        if constexpr (!Epi::AFTER_DRAIN) { int ln_; asm volatile("v_mbcnt_lo_u32_b32 %0, -1, 0\n\tv_mbcnt_hi_u32_b32 %0, -1, %0" : "=v"(ln_)); E(acc, cur, wr, wc, ln_ & 15, ln_ >> 4); S.done(cur); }
        if (!has_next) break;
#pragma unroll
        for (int a = 0; a < 2; ++a)
#pragma unroll
            for (int b = 0; b < 2; ++b)
#pragma unroll
                for (int m = 0; m < 4; ++m)
#pragma unroll
                    for (int n = 0; n < 2; ++n) acc[a][b][m][n] = (f32x4){0.f, 0.f, 0.f, 0.f};
        cur = nxt; cA = nA; cB = nB; ++ui;
        if constexpr (ALIGN_EPI) { if (wr == 1) PG8_BAR; }
    }
    PG8_WAIT_V(0);
    if constexpr (!ALIGN_EPI) { if (wr == 0) PG8_BAR; }
    PG8_BAR;
    if constexpr (Epi::AFTER_DRAIN) { E.fused(acc, cur, wr, wc, fr, fq, lds, wid, lane); S.done(cur); }
#undef PG8_SA
#undef PG8_SB
#undef PG8_STAGE
#undef PG8_LDA
#undef PG8_LDB
#undef PG8_MMA
#undef PG8_WAIT_V
#undef PG8_WAIT_L
#undef PG8_BAR
#undef PG8_SCHED
}
}

constexpr size_t MiB = 1u << 20;
constexpr size_t WS_CTL = 0, CTL_ZERO_BYTES = 1 * MiB;
constexpr size_t WS_WIN = 2 * MiB;
constexpr size_t WS_WOUT = 16 * MiB;
constexpr size_t WS_WST = 20 * MiB;
constexpr size_t WS_BT = 21 * MiB;
constexpr size_t WS_KMEAN = 22 * MiB;
constexpr size_t WS_LOFF = 23 * MiB;
constexpr size_t WS_ROWSS = 24 * MiB;
constexpr size_t WS_PL = 26 * MiB;
constexpr size_t WS_LIST = 30 * MiB;
constexpr size_t WS_SEL = 32 * MiB;
constexpr size_t WS_XB = 40 * MiB;
constexpr size_t WS_PROJ = 168 * MiB;
constexpr size_t WS_MIX = 392 * MiB;
constexpr size_t WS_END = 456 * MiB;
constexpr size_t SUBSTRIDE = (size_t)MROWS * 512;
enum { T_U = 0, T_V = 1, T_ZA = 2, T_Q = 3, T_K = 4, T_VV = 5, T_ZB = 6 };

constexpr int NWAVES = 8;
constexpr int LDS_BYTES = 160 * 1024;
constexpr int RING_BYTES = 131072;

#define LAS __attribute__((address_space(3)))
typedef unsigned short bf16;
typedef unsigned v4u __attribute__((ext_vector_type(4)));
typedef float f32x4 __attribute__((ext_vector_type(4)));
#define LDS_WAIT() asm volatile("s_waitcnt lgkmcnt(0)" ::: "memory")
__device__ __forceinline__ unsigned f2bf(float f) { unsigned u = __builtin_bit_cast(unsigned, f); return (u + 0x7fffu + ((u >> 16) & 1u)) >> 16; }
__device__ __forceinline__ unsigned pk2(float lo, float hi) { return f2bf(lo) | (f2bf(hi) << 16); }
__device__ __forceinline__ unsigned pk4_fp8(float a, float b, float c, float d) { int w = __builtin_amdgcn_cvt_pk_fp8_f32(a, b, 0, false); w = __builtin_amdgcn_cvt_pk_fp8_f32(c, d, w, true); return (unsigned)w; }
__device__ __forceinline__ float bflo(unsigned w) { return __uint_as_float(w << 16); }
__device__ __forceinline__ float bfhi(unsigned w) { return __uint_as_float(w & 0xffff0000u); }
__device__ __forceinline__ float wave_sum(float v) {
#pragma unroll
    for (int o = 1; o < 64; o <<= 1) v += __shfl_xor(v, o);
    return v;
}

__device__ __forceinline__ int lane_now() { int l; asm volatile("v_mbcnt_lo_u32_b32 %0, -1, 0\n\tv_mbcnt_hi_u32_b32 %0, -1, %0" : "=v"(l)); return l; }
struct Args { const float* in[10]; float* out; unsigned char* ws; int layer, pad; };

struct Ctx {
    unsigned char* lds;
    int tid, lane, wave, G, bid;
    const float *x, *norm_g, *w_in, *ln_g, *ln_b, *sgu_w, *sgu_b, *w_out, *rel_bias, *final_g;
    float* out; unsigned char* ws;
};

__device__ __forceinline__ void p0_transpose_item(const float* W, const float* gs, int K, int N, bf16* WT, float* scr, int item, int lane) {
    const int nblk = N / 32, kb = item / nblk, nb = item % nblk, k0 = 64 * kb, n0 = 32 * nb;
    float wv[32];
#pragma unroll
    for (int i = 0; i < 32; ++i) wv[i] = W[(size_t)(k0 + 2 * i + (lane >> 5)) * N + n0 + (lane & 31)];
#pragma unroll
    for (int i = 0; i < 32; ++i) { const int kk = 2 * i + (lane >> 5); const float sc = gs ? gs[k0 + kk] : 1.0f; scr[kk * 33 + (lane & 31)] = wv[i] * sc; }
    LDS_WAIT(); asm volatile("" ::: "memory");
    const int c = lane & 7;
#pragma unroll
    for (int j = 0; j < 4; ++j) { const int n = (lane >> 3) + 8 * j; const float* s = scr + (8 * c) * 33 + n;
        v4u o; o.x = pk2(s[0 * 33], s[1 * 33]); o.y = pk2(s[2 * 33], s[3 * 33]); o.z = pk2(s[4 * 33], s[5 * 33]); o.w = pk2(s[6 * 33], s[7 * 33]);
        *(v4u*)(WT + (size_t)(n0 + n) * K + k0 + 8 * c) = o; }
    LDS_WAIT(); asm volatile("" ::: "memory");
}
__device__ __forceinline__ int rel_bucket(int d) {
    if (d < 16) return d;
    int b = 16;
    b += (d >= 19); b += (d >= 21); b += (d >= 24); b += (d >= 27); b += (d >= 31); b += (d >= 35); b += (d >= 40); b += (d >= 46);
    b += (d >= 52); b += (d >= 59); b += (d >= 67); b += (d >= 77); b += (d >= 87); b += (d >= 99); b += (d >= 113);
    return b;
}
__device__ __forceinline__ void phase_prologue(const Ctx& C) {
    float* scr = (float*)(C.lds + C.wave * 16384);
    const int gw = C.bid * NWAVES + C.wave, NGW = C.G * NWAVES;
    constexpr int I_IN = (DM / 64) * (DIN / 32), I_OUT = (DM / 64) * (DM / 32);
    constexpr int NITEMS = DEPTH * (I_IN + I_OUT);
    for (int it = gw; it < NITEMS; it += NGW) {
        const int l = it / (I_IN + I_OUT); int r = it % (I_IN + I_OUT);
        if (r < I_IN) p0_transpose_item(C.w_in + (size_t)l * DM * DIN, C.norm_g + l * DM, DM, DIN, (bf16*)(C.ws + WS_WIN) + (size_t)l * DIN * DM, scr, r, C.lane);
        else p0_transpose_item(C.w_out + (size_t)l * DM * DM, nullptr, DM, DM, (bf16*)(C.ws + WS_WOUT) + (size_t)l * DM * DM, scr, r - I_IN, C.lane);
    }
    { float* km = (float*)(C.ws + WS_KMEAN); for (int e = C.bid * 512 + C.tid; e < DEPTH * NBH * NBLK * 64; e += C.G * 512) km[e] = 0.f; }
    { bf16* wst = (bf16*)(C.ws + WS_WST); const int gt = C.bid * 512 + C.tid, NT = C.G * 512;
      for (int e = gt; e < DEPTH * 8 * 128 * 128; e += NT) { const int s = e & 127, t = (e >> 7) & 127; wst[e] = (s <= t) ? (bf16)f2bf(C.sgu_w[e]) : (bf16)0; } }
    if (C.bid == 0) { float* bt = (float*)(C.ws + WS_BT); for (int e = C.tid; e < 8 * 128; e += 512) { const int h = e >> 7, d = e & 127; bt[e] = C.rel_bias[rel_bucket(d) * 8 + h] * LOG2E; } }
    { bf16* xb = (bf16*)(C.ws + WS_XB); float* rowss = (float*)(C.ws + WS_ROWSS);
      constexpr int UN = 4;
      for (int m0 = gw; m0 < MROWS; m0 += NGW * UN) {
        f32x4 v[UN][4];
#pragma unroll
        for (int k = 0; k < UN; ++k) { const f32x4* xr = (const f32x4*)(C.x + (size_t)(m0 + k * NGW) * DM) + C.lane;
#pragma unroll
            for (int j = 0; j < 4; ++j) v[k][j] = xr[64 * j]; }
#pragma unroll
        for (int k = 0; k < UN; ++k) { const int m = m0 + k * NGW;
            float s = 0.f;
#pragma unroll
            for (int j = 0; j < 4; ++j) s += (v[k][j].x * v[k][j].x + v[k][j].y * v[k][j].y) + (v[k][j].z * v[k][j].z + v[k][j].w * v[k][j].w);
            s = wave_sum(s);
            unsigned long long* o8 = (unsigned long long*)(xb + (size_t)m * DM) + C.lane;
#pragma unroll
            for (int j = 0; j < 4; ++j) o8[64 * j] = (unsigned long long)pk2(v[k][j].x, v[k][j].y) | ((unsigned long long)pk2(v[k][j].z, v[k][j].w) << 32);
            if (C.lane < 16) rowss[(size_t)m * 16 + C.lane] = (C.lane == 0) ? s : 0.f; }
      } }
}

typedef short bf16x8 __attribute__((ext_vector_type(8)));
typedef short bf16x4s __attribute__((ext_vector_type(4)));
typedef float f32x16 __attribute__((ext_vector_type(16)));
typedef int v8i_t __attribute__((ext_vector_type(8)));
__device__ __forceinline__ int at_vpos(int kv) { return (kv & ~63) + 32 * ((kv >> 2) & 1) + 16 * ((kv >> 5) & 1) + (kv & 3) + 4 * ((kv >> 3) & 3); }
__device__ __forceinline__ int crow(int r, int hi) { return (r & 3) + 8 * (r >> 2) + 4 * hi; }
__device__ __forceinline__ unsigned cvtpk(float lo, float hi) { unsigned r; asm volatile("v_cvt_pk_bf16_f32 %0, %1, %2" : "=v"(r) : "v"(lo), "v"(hi)); return r; }
__device__ __forceinline__ void phase_gate(const Ctx& C, int layer) {
    const bf16* Q = (const bf16*)(C.ws + WS_PROJ) + (size_t)T_Q * SUBSTRIDE;
    const float* KM = (const float*)(C.ws + WS_KMEAN) + (size_t)layer * NBH * NBLK * 64;
    int* SEL = (int*)(C.ws + WS_SEL); int* LOFF = (int*)(C.ws + WS_LOFF); unsigned short* LIST = (unsigned short*)(C.ws + WS_LIST);
    int* cnt = (int*)(C.lds);
    int* offs = (int*)(C.lds + 256);
    unsigned char* kml = C.lds + 1024;
    const int lane = C.lane, ql = lane & 31, hi = lane >> 5;
    bf16x8 qfN[4]; f32x4 kmr[2];
#define GATE_LOAD(uu) do { const int bh_ = (uu) / 63, i_ = (uu) % 63 + 1, b_ = bh_ >> 3, h_ = bh_ & 7; \
        const bf16* qrow_ = Q + ((size_t)(b_ * SEQ + i_ * 256 + C.wave * 32 + ql)) * 512 + h_ * 64 + hi * 8; \
        _Pragma("unroll") for (int ks = 0; ks < 4; ++ks) qfN[ks] = *(const bf16x8*)(qrow_ + ks * 16); \
        const float* kp_ = KM + (size_t)bh_ * NBLK * 64 + C.tid * 8; kmr[0] = *(const f32x4*)kp_; kmr[1] = *(const f32x4*)(kp_ + 4); } while (0)
#define GATE_KML() do { *(v4u*)(kml + (C.tid >> 3) * 144 + (C.tid & 7) * 16) = (v4u){cvtpk(kmr[0][0], kmr[0][1]), cvtpk(kmr[0][2], kmr[0][3]), cvtpk(kmr[1][0], kmr[1][1]), cvtpk(kmr[1][2], kmr[1][3])}; } while (0)
    int u = C.bid;
    if (C.tid < 64) cnt[C.tid] = 0;
    if (u < NBH * 63) { GATE_LOAD(u); GATE_KML(); }
    __syncthreads();
    for (; u < NBH * 63; u += C.G) {
        const int bh = u / 63, i = u % 63 + 1;
        const int q = C.wave * 32 + ql, pos = i * 256 + q;
        bf16x8 qf[4];
#pragma unroll
        for (int ks = 0; ks < 4; ++ks) qf[ks] = qfN[ks];
        const bool more = u + C.G < NBH * 63;
        if (more) GATE_LOAD(u + C.G);
        float b0 = -INFINITY, b1 = -INFINITY, b2 = -INFINITY; int i0 = -1, i1 = -1, i2 = -1;
#define TOP3_INS(v, idx) do { const float v_ = (v); const int x_ = (idx); if (v_ > b0) { b2 = b1; i2 = i1; b1 = b0; i1 = i0; b0 = v_; i0 = x_; } else if (v_ > b1) { b2 = b1; i2 = i1; b1 = v_; i1 = x_; } else if (v_ > b2) { b2 = v_; i2 = x_; } } while (0)
#pragma unroll
        for (int nt = 0; nt < 2; ++nt) {
            f32x16 p = {};
#pragma unroll
            for (int ks = 0; ks < 4; ++ks) {
                const bf16x8 kw = *(const bf16x8*)(kml + (32 * nt + ql) * 144 + ks * 32 + hi * 16);
                p = __builtin_amdgcn_mfma_f32_32x32x16_bf16(kw, qf[ks], p, 0, 0, 0);
            }
#pragma unroll
            for (int r = 0; r < 16; ++r) { const int n = 32 * nt + crow(r, hi); if (n < i) TOP3_INS(p[r], n); }
        }
        { const float c0 = __shfl_xor(b0, 32), c1 = __shfl_xor(b1, 32), c2 = __shfl_xor(b2, 32);
          const int j0 = __shfl_xor(i0, 32), j1 = __shfl_xor(i1, 32), j2 = __shfl_xor(i2, 32);
          if (j0 >= 0) TOP3_INS(c0, j0);
          if (j1 >= 0) TOP3_INS(c1, j1);
          if (j2 >= 0) TOP3_INS(c2, j2); }
#undef TOP3_INS
        int p0 = 0, p1 = 0, p2 = 0;
        if (hi == 0) {
            if (CHECK_ATTN) { int* sp = SEL + ((size_t)bh * SEQ + pos) * 4; sp[0] = i0; sp[1] = i1; sp[2] = i2; sp[3] = -1; }
            p0 = atomicAdd(&cnt[i0], 1);
            if (i1 >= 0) p1 = atomicAdd(&cnt[i1], 1);
            if (i2 >= 0) p2 = atomicAdd(&cnt[i2], 1);
        }
        __syncthreads();
        if (C.tid < 64) {
            const int c = cnt[C.tid]; cnt[C.tid] = 0;
            int inc = c;
#pragma unroll
            for (int o = 1; o < 64; o <<= 1) { const int t = __shfl_up(inc, o); if (C.tid >= o) inc += t; }
            offs[C.tid + 1] = inc; if (C.tid == 0) offs[0] = 0;
            LOFF[(size_t)(bh * NBLK + i) * 80 + C.tid + 1] = inc; if (C.tid == 0) LOFF[(size_t)(bh * NBLK + i) * 80] = 0;
        }
        if (more) GATE_KML();
        __syncthreads();
        if (hi == 0) {
            unsigned short* lp = LIST + (size_t)(bh * NBLK + i) * 768;
            lp[offs[i0] + p0] = (unsigned short)(q | (0 << 8));
            if (i1 >= 0) lp[offs[i1] + p1] = (unsigned short)(q | (1 << 8));
            if (i2 >= 0) lp[offs[i2] + p2] = (unsigned short)(q | (2 << 8));
        }
    }
#undef GATE_LOAD
#undef GATE_KML
    if (CHECK_ATTN) { for (int e = C.bid * 512 + C.tid; e < NBH * 256; e += C.G * 512) { const int bh = e >> 8, qq = e & 255; int* sp = SEL + ((size_t)bh * SEQ + qq) * 4; sp[0] = -1; sp[1] = -1; sp[2] = -1; sp[3] = -1; } }
    __syncthreads();
}

__device__ __forceinline__ void phase_attn_simple(const Ctx& C, bf16* MIX) {
    const bf16* Q = (const bf16*)(C.ws + WS_PROJ) + (size_t)T_Q * SUBSTRIDE;
    const bf16* K = (const bf16*)(C.ws + WS_PROJ) + (size_t)T_K * SUBSTRIDE;
    const bf16* VV = (const bf16*)(C.ws + WS_PROJ) + (size_t)T_VV * SUBSTRIDE;
    const bf16* ZB = (const bf16*)(C.ws + WS_PROJ) + (size_t)T_ZB * SUBSTRIDE;
    const int* SEL = (const int*)(C.ws + WS_SEL); const float* BT = (const float*)(C.ws + WS_BT);
    const int gt = C.bid * 512 + C.tid, NT = C.G * 512;
    for (int item = gt; item < NBH * SEQ; item += NT) {
        const int bh = item >> 14, pos = item & (SEQ - 1), b = bh >> 3, h = bh & 7, own = pos >> 8;
        const size_t rowq = (size_t)(b * SEQ + pos);
        float qv[64], o[64];
        { const v4u* qp = (const v4u*)(Q + rowq * 512 + h * 64);
#pragma unroll
          for (int c = 0; c < 8; ++c) { const v4u v = qp[c]; qv[8 * c + 0] = bflo(v.x); qv[8 * c + 1] = bfhi(v.x); qv[8 * c + 2] = bflo(v.y); qv[8 * c + 3] = bfhi(v.y);
              qv[8 * c + 4] = bflo(v.z); qv[8 * c + 5] = bfhi(v.z); qv[8 * c + 6] = bflo(v.w); qv[8 * c + 7] = bfhi(v.w); } }
#pragma unroll
        for (int d = 0; d < 64; ++d) o[d] = 0.f;
        float m = -INFINITY, l = 0.f;
        const float* bt = BT + h * 128;
        for (int slot = 0; slot < 4; ++slot) {
            int blk, klim;
            if (slot == 0) { blk = own; klim = (pos & 255) + 1; } else { blk = SEL[(size_t)item * 4 + slot - 1]; klim = 256; if (blk < 0) klim = 0; }
            for (int kl = 0; kl < klim; ++kl) {
                const int kpos = blk * 256 + kl;
                const v4u* kp = (const v4u*)(K + ((size_t)(b * SEQ + kpos)) * 512 + h * 64);
                float a0 = 0.f, a1 = 0.f;
#pragma unroll
                for (int c = 0; c < 8; ++c) { const v4u v = kp[c];
                    a0 += qv[8 * c + 0] * bflo(v.x) + qv[8 * c + 2] * bflo(v.y) + qv[8 * c + 4] * bflo(v.z) + qv[8 * c + 6] * bflo(v.w);
                    a1 += qv[8 * c + 1] * bfhi(v.x) + qv[8 * c + 3] * bfhi(v.y) + qv[8 * c + 5] * bfhi(v.z) + qv[8 * c + 7] * bfhi(v.w); }
                int dd = pos - kpos; dd = dd > 127 ? 127 : dd;
                const float s = (a0 + a1) + bt[dd];
                if (s > m) { const float al = __builtin_amdgcn_exp2f(m - s); l *= al;
#pragma unroll
                    for (int d = 0; d < 64; ++d) o[d] *= al;
                    m = s; }
                const float p = __builtin_amdgcn_exp2f(s - m);
                l += p;
                const v4u* vp = (const v4u*)(VV + ((size_t)(b * SEQ + kpos)) * 512 + h * 64);
#pragma unroll
                for (int c = 0; c < 8; ++c) { const v4u v = vp[c];
                    o[8 * c + 0] += p * bflo(v.x); o[8 * c + 1] += p * bfhi(v.x); o[8 * c + 2] += p * bflo(v.y); o[8 * c + 3] += p * bfhi(v.y);
                    o[8 * c + 4] += p * bflo(v.z); o[8 * c + 5] += p * bfhi(v.z); o[8 * c + 6] += p * bflo(v.w); o[8 * c + 7] += p * bfhi(v.w); }
            }
        }
        const float rl = 1.0f / l;
        const v4u* zp = (const v4u*)(ZB + rowq * 512 + h * 64);
        v4u* op = (v4u*)(MIX + rowq * 1024 + 512 + h * 64);
#pragma unroll
        for (int c = 0; c < 8; ++c) { const v4u z = zp[c]; v4u w;
            w.x = pk2(o[8 * c + 0] * rl * pg8::act_silu(bflo(z.x)), o[8 * c + 1] * rl * pg8::act_silu(bfhi(z.x))); w.y = pk2(o[8 * c + 2] * rl * pg8::act_silu(bflo(z.y)), o[8 * c + 3] * rl * pg8::act_silu(bfhi(z.y)));
            w.z = pk2(o[8 * c + 4] * rl * pg8::act_silu(bflo(z.z)), o[8 * c + 5] * rl * pg8::act_silu(bfhi(z.z))); w.w = pk2(o[8 * c + 6] * rl * pg8::act_silu(bflo(z.w)), o[8 * c + 7] * rl * pg8::act_silu(bfhi(z.w)));
            op[c] = w; }
    }
}

constexpr int AT_KS = 0, AT_KPITCH = 144;
constexpr int AT_VT = 36864, AT_VPITCH = 272;
constexpr int AT_DT = AT_VT + 64 * AT_VPITCH;
constexpr int AT_ENT = AT_DT + 4096, AT_CAP = 4096;
constexpr int AT_PRE = AT_ENT + AT_CAP * 4;
constexpr int AT_OST = AT_PRE + 1024;
constexpr int AT_MISC = AT_OST + 8 * 4096;
constexpr int AT_NUNITS = NBLK * NBH;

typedef int v4i_t __attribute__((ext_vector_type(4)));
#ifndef ATTN_STATIC_PRIO
#define ATTN_STATIC_PRIO 1
#endif
#if ATTN_STATIC_PRIO
#define ATTN_PRIO_UP
#define ATTN_PRIO_DN
#else
#define ATTN_PRIO_UP __builtin_amdgcn_s_setprio(1)
#define ATTN_PRIO_DN __builtin_amdgcn_s_setprio(0)
#endif
struct QTile { unsigned ent; v4i_t qf[4]; };
__device__ __forceinline__ void attn_issue_q(QTile& T, const Ctx& C, const unsigned char* lds, int b, int h, int e0, int cnt) {
    const bf16* Q = (const bf16*)(C.ws + WS_PROJ) + (size_t)T_Q * SUBSTRIDE;
    const unsigned* ENT = (const unsigned*)(lds + AT_ENT);
    const int q = C.lane & 31, hi = C.lane >> 5;
    T.ent = ENT[(e0 + q < cnt) ? (e0 + q) : e0];
    const bf16* qrow = Q + ((size_t)(b * SEQ + (int)(T.ent & 16383u))) * 512 + h * 64 + hi * 8;
    asm volatile("global_load_dwordx4 %0, %4, off\n\tglobal_load_dwordx4 %1, %4, off offset:32\n\tglobal_load_dwordx4 %2, %4, off offset:64\n\tglobal_load_dwordx4 %3, %4, off offset:96"
                 : "=&v"(T.qf[0]), "=&v"(T.qf[1]), "=&v"(T.qf[2]), "=&v"(T.qf[3]) : "v"(qrow));
}
__device__ __forceinline__ void attn_wait_q(QTile& T) { asm volatile("s_waitcnt vmcnt(0)" : "+v"(T.qf[0]), "+v"(T.qf[1]), "+v"(T.qf[2]), "+v"(T.qf[3])); }
__device__ __forceinline__ void attn_tile(const Ctx& C, unsigned char* lds, const QTile& T, QTile& Tn, int bh, int e0, int cnt, int nkt2, const bool OWN) {
    bf16* PO = (bf16*)C.out; float* PL = (float*)(C.ws + WS_PL);
    const unsigned* ENT = (const unsigned*)(lds + AT_ENT);
    const int lane = C.lane, q = lane & 31, hi = lane >> 5;
    const unsigned ent = T.ent;
    const int pos = ent & 16383, qoff = (ent >> 16) & 1023;
    f32x16 o0 = {}, o1 = {};
    float l = 0.f;
    const bool anybias = OWN ? true : (__any(qoff < 112) != 0);
    const unsigned char* kbase = lds + AT_KS + q * AT_KPITCH + hi * 16;
    const unsigned char* vbase = lds + AT_VT + q * AT_VPITCH + hi * 32;
    const float* et0 = (const float*)(lds + AT_DT) + (256 + (OWN ? 0 : 256) + qoff - 4 * hi);
    bf16x8 kf[8];
#pragma unroll
    for (int ks = 0; ks < 4; ++ks) { kf[2 * ks] = *(const bf16x8*)(kbase + ks * 32); kf[2 * ks + 1] = *(const bf16x8*)(kbase + 32 * AT_KPITCH + ks * 32); }
    for (int kt2 = 0; kt2 < nkt2; ++kt2) {
        f32x16 p0 = {}, p1 = {};
        ATTN_PRIO_UP;
#pragma unroll
        for (int ks = 0; ks < 4; ++ks) {
            p0 = __builtin_amdgcn_mfma_f32_32x32x16_bf16(kf[2 * ks], __builtin_bit_cast(bf16x8, T.qf[ks]), p0, 0, 0, 0);
            p1 = __builtin_amdgcn_mfma_f32_32x32x16_bf16(kf[2 * ks + 1], __builtin_bit_cast(bf16x8, T.qf[ks]), p1, 0, 0, 0);
        }
        ATTN_PRIO_DN;
        v8i_t vb0, vb1;
        { typedef int v4i_t __attribute__((ext_vector_type(4)));
          const v4i_t a0 = *(const v4i_t*)(vbase + 64 * kt2), a1 = *(const v4i_t*)(vbase + 64 * kt2 + 16);
          const v4i_t c0 = *(const v4i_t*)(vbase + 32 * AT_VPITCH + 64 * kt2), c1 = *(const v4i_t*)(vbase + 32 * AT_VPITCH + 64 * kt2 + 16);
          vb0 = __builtin_shufflevector(a0, a1, 0, 1, 2, 3, 4, 5, 6, 7); vb1 = __builtin_shufflevector(c0, c1, 0, 1, 2, 3, 4, 5, 6, 7); }
        if (anybias && (OWN || kt2 >= 2)) {
            const float* et = et0 - 64 * kt2 - 63;
#pragma unroll
            for (int r = 0; r < 16; ++r) { p0[r] += et[63 - ((r & 3) + 8 * (r >> 2))]; p1[r] += et[31 - ((r & 3) + 8 * (r >> 2))]; }
        }
#pragma unroll
        for (int r = 0; r < 16; ++r) { p0[r] = __builtin_amdgcn_exp2f(p0[r]); p1[r] = __builtin_amdgcn_exp2f(p1[r]); }
        float sa = 0.f, sb = 0.f;
#pragma unroll
        for (int r = 0; r < 16; ++r) { sa += p0[r]; sb += p1[r]; }
        l += sa + sb;
        v8i_t pa8;
        { typedef short v2s_t __attribute__((ext_vector_type(2)));
#pragma unroll
          for (int i = 0; i < 4; ++i) {
              v2s_t w = {0, 0};
              w = __builtin_amdgcn_cvt_scalef32_pk_fp8_f32(w, p0[4 * i], p0[4 * i + 1], 16.0f, false); w = __builtin_amdgcn_cvt_scalef32_pk_fp8_f32(w, p0[4 * i + 2], p0[4 * i + 3], 16.0f, true);
              pa8[i] = __builtin_bit_cast(int, w);
              v2s_t z = {0, 0};
              z = __builtin_amdgcn_cvt_scalef32_pk_fp8_f32(z, p1[4 * i], p1[4 * i + 1], 16.0f, false); z = __builtin_amdgcn_cvt_scalef32_pk_fp8_f32(z, p1[4 * i + 2], p1[4 * i + 3], 16.0f, true);
              pa8[4 + i] = __builtin_bit_cast(int, z);
          } }
        if (kt2 + 1 < nkt2) {
#pragma unroll
            for (int ks = 0; ks < 4; ++ks) { kf[2 * ks] = *(const bf16x8*)(kbase + (64 * kt2 + 64) * AT_KPITCH + ks * 32); kf[2 * ks + 1] = *(const bf16x8*)(kbase + (64 * kt2 + 96) * AT_KPITCH + ks * 32); }
        }
        ATTN_PRIO_UP;
        o0 = __builtin_amdgcn_mfma_scale_f32_32x32x64_f8f6f4(vb0, pa8, o0, 0, 0, 0, 0x7f7f7f7f, 0, (int)0x83838383);
        o1 = __builtin_amdgcn_mfma_scale_f32_32x32x64_f8f6f4(vb1, pa8, o1, 0, 0, 0, 0x7f7f7f7f, 0, (int)0x83838383);
        ATTN_PRIO_DN;
    }
    l += __shfl_xor(l, 32);
    attn_wait_q(Tn);
    if (e0 + q < cnt) PL[((size_t)bh * SEQ + pos) * 4 + ((ent >> 14) & 3)] = l;
    { bf16* prow = PO + (((size_t)bh * SEQ + pos) * 4 + ((ent >> 14) & 3)) * 64 + hi * 8;
      const bool live = e0 + q < cnt;
#pragma unroll
      for (int j = 0; j < 2; ++j) {
          unsigned a0 = pg8::cvt_pk_bf16(o0[8 * j], o0[8 * j + 1]), a1 = pg8::cvt_pk_bf16(o0[8 * j + 2], o0[8 * j + 3]), b0 = pg8::cvt_pk_bf16(o0[8 * j + 4], o0[8 * j + 5]), b1 = pg8::cvt_pk_bf16(o0[8 * j + 6], o0[8 * j + 7]);
          { auto r0 = __builtin_amdgcn_permlane32_swap(a0, b0, false, false); a0 = r0[0]; b0 = r0[1]; auto r1 = __builtin_amdgcn_permlane32_swap(a1, b1, false, false); a1 = r1[0]; b1 = r1[1]; }
          unsigned c0 = pg8::cvt_pk_bf16(o1[8 * j], o1[8 * j + 1]), c1 = pg8::cvt_pk_bf16(o1[8 * j + 2], o1[8 * j + 3]), d0 = pg8::cvt_pk_bf16(o1[8 * j + 4], o1[8 * j + 5]), d1 = pg8::cvt_pk_bf16(o1[8 * j + 6], o1[8 * j + 7]);
          { auto r0 = __builtin_amdgcn_permlane32_swap(c0, d0, false, false); c0 = r0[0]; d0 = r0[1]; auto r1 = __builtin_amdgcn_permlane32_swap(c1, d1, false, false); c1 = r1[0]; d1 = r1[1]; }
          if (live) { *(v4u*)(prow + 16 * j) = (v4u){a0, a1, b0, b1}; *(v4u*)(prow + 32 + 16 * j) = (v4u){c0, c1, d0, d1}; }
      } }
}

__device__ __forceinline__ void phase_attn(const Ctx& C, int layer) {
    if (ATTN_STATIC_PRIO && C.wave >= 4) __builtin_amdgcn_s_setprio(2);
    unsigned char* lds = C.lds;
    const bf16* K = (const bf16*)(C.ws + WS_PROJ) + (size_t)T_K * SUBSTRIDE;
    const bf16* VV = (const bf16*)(C.ws + WS_PROJ) + (size_t)T_VV * SUBSTRIDE;
    const int* LOFF = (const int*)(C.ws + WS_LOFF); const unsigned short* LIST = (const unsigned short*)(C.ws + WS_LIST);
    const float* BT = (const float*)(C.ws + WS_BT);
    const int qg = C.bid & 7;
    unsigned* ctr = (unsigned*)(C.ws + WS_CTL) + 64 + 64 * layer;
    int qstep = 0;
    unsigned* ENT = (unsigned*)(lds + AT_ENT);
    int* PRE = (int*)(lds + AT_PRE); int* LO = PRE + 68;
    volatile unsigned* MISC = (volatile unsigned*)(lds + AT_MISC);
    int tid = C.tid;
    v4u kpre[4], vpre[4]; int lpre0 = 0, lpre1 = 0;
#define AT_LOADKV(uu) do { const int bh_ = (uu) & 15, n_ = (uu) >> 4; \
        const bf16* Kg = K + ((size_t)((bh_ >> 3) * SEQ + n_ * 256)) * 512 + (bh_ & 7) * 64; const bf16* Vg = VV + ((size_t)((bh_ >> 3) * SEQ + n_ * 256)) * 512 + (bh_ & 7) * 64; \
        _Pragma("unroll") for (int it = 0; it < 4; ++it) { const int idx = tid + 512 * it; kpre[it] = *(const v4u*)(Kg + (size_t)(idx >> 3) * 512 + (idx & 7) * 8); \
            vpre[it] = *(const v4u*)(Vg + (size_t)(idx >> 3) * 512 + (idx & 7) * 8); } \
        lpre0 = 0; lpre1 = 0; if (tid < 64 && n_ + 1 + tid < NBLK) { const int* lp_ = LOFF + ((size_t)(bh_ * NBLK + n_ + 1 + tid)) * 80 + n_; lpre0 = lp_[0]; lpre1 = lp_[1]; } } while (0)
#define AT_FETCH() ({ unsigned r_ = (unsigned)AT_NUNITS; while (qstep < 8) { const int g_ = (qg + qstep) & 7; const unsigned k_ = atomicAdd(ctr + 4 * g_, 1u); \
        if (k_ < 2u * NBLK) { r_ = (k_ >> 1) * 16 + 2 * g_ + (k_ & 1); break; } ++qstep; } r_; })
    if (tid == 0) MISC[0] = AT_FETCH();
    __syncthreads();
    int u = (int)MISC[0];
    if (u < AT_NUNITS) AT_LOADKV(u);
    while (u < AT_NUNITS) {
        asm volatile("" : "+v"(tid));
        Ctx Cu = C; Cu.tid = tid; Cu.lane = tid & 63;
        const int bh = u & 15, n = u >> 4, b = bh >> 3, h = bh & 7;
        if (tid == 0) MISC[1] = AT_FETCH();
#pragma unroll
        for (int it = 0; it < 4; ++it) { const int idx = tid + 512 * it;
            *(v4u*)(lds + AT_KS + (idx >> 3) * AT_KPITCH + (idx & 7) * 16) = kpre[it];
            const v4u v = vpre[it];
            unsigned char* vt = lds + AT_VT + (8 * (idx & 7)) * AT_VPITCH + at_vpos(idx >> 3);
            const unsigned w01 = pk4_fp8(bflo(v.x), bfhi(v.x), bflo(v.y), bfhi(v.y)), w23 = pk4_fp8(bflo(v.z), bfhi(v.z), bflo(v.w), bfhi(v.w));
            vt[0 * AT_VPITCH] = (unsigned char)(w01); vt[1 * AT_VPITCH] = (unsigned char)(w01 >> 8); vt[2 * AT_VPITCH] = (unsigned char)(w01 >> 16); vt[3 * AT_VPITCH] = (unsigned char)(w01 >> 24);
            vt[4 * AT_VPITCH] = (unsigned char)(w23); vt[5 * AT_VPITCH] = (unsigned char)(w23 >> 8); vt[6 * AT_VPITCH] = (unsigned char)(w23 >> 16); vt[7 * AT_VPITCH] = (unsigned char)(w23 >> 24); }
        { float* et_ = (float*)(lds + AT_DT);
#pragma unroll
          for (int k_ = 0; k_ < 2; ++k_) { const int j_ = tid + 512 * k_, d_ = j_ - 256; et_[j_] = d_ < 0 ? -INFINITY : (d_ < 128 ? BT[h * 128 + d_] - BT[h * 128 + 127] : 0.f); } }
        if (tid < 64) {
            const int lo = lpre0; int inc = lpre1 - lpre0;
#pragma unroll
            for (int o = 1; o < 64; o <<= 1) { const int t = __shfl_up(inc, o); if (tid >= o) inc += t; }
            PRE[tid + 1] = inc; LO[tid] = lo; if (tid == 0) PRE[0] = 0;
        }
        __syncthreads();
        const int total = 256 + PRE[63 - n];
        const int unext = (int)MISC[1];
        if (unext < AT_NUNITS) AT_LOADKV(unext);
        for (int base = 0; base < total; base += AT_CAP) {
            const int cnt = (total - base < AT_CAP) ? (total - base) : AT_CAP;
            if (base == 0 && tid < 256) ENT[tid] = (unsigned)(n * 256 + tid) | (3u << 14) | ((unsigned)tid << 16);
            { const int e_lo = base > 256 ? base : 256, e_hi = base + cnt;
#pragma unroll 4
              for (int e = e_lo + tid; e < e_hi; e += 512) {
                  const int es = e - 256; int a = 0, z = 63 - n;
#pragma unroll
                  for (int it = 0; it < 6; ++it) { const int mid = (a + z) >> 1; const bool up = (z - a > 1) && (PRE[mid] <= es); const bool dn = (z - a > 1) && !up; a = up ? mid : a; z = dn ? mid : z; }
                  const int ii = a, i = n + 1 + ii;
                  const unsigned val = LIST[((size_t)(bh * NBLK + i)) * 768 + LO[ii] + (es - PRE[ii])]; const unsigned ql = val & 255u, j = val >> 8;
                  ENT[e - base] = (unsigned)(i * 256 + ql) | (j << 14) | ((ii == 0 ? ql : 400u) << 16);
              } }
            if (tid == 0) MISC[2] = 0u;
            __syncthreads();
            const int ntiles = (cnt + 31) >> 5;
            const int nown = (base == 0) ? 8 : 0;
#define AT_TICKET() ({ int tk_ = 0; if (Cu.lane == 0) tk_ = (int)atomicAdd((unsigned*)(lds + AT_MISC + 8), 1u); __builtin_amdgcn_readfirstlane(tk_); })
#define AT_TILEOF(tk_) (((tk_) < ntiles - nown) ? nown + (tk_) : (ntiles - 1 - (tk_)))
            { int tk = AT_TICKET();
              if (tk < ntiles) {
                  int tile = AT_TILEOF(tk);
                  QTile Tc; attn_issue_q(Tc, Cu, lds, b, h, tile * 32, cnt); attn_wait_q(Tc);
                  for (;;) {
                      const int tkn = AT_TICKET(); const bool more = tkn < ntiles; const int tilen = more ? AT_TILEOF(tkn) : 0;
                      QTile Tn; attn_issue_q(Tn, Cu, lds, b, h, tilen * 32, cnt);
                      { const bool own_ = tile < nown; attn_tile(Cu, lds, Tc, Tn, bh, tile * 32, cnt, own_ ? (tile >> 1) + 1 : 4, own_); }
                      if (!more) break;
                      Tc = Tn; tile = tilen;
                  }
              } }
#undef AT_TICKET
#undef AT_TILEOF
            __syncthreads();
        }
        u = unext;
    }
#undef AT_LOADKV
#undef AT_FETCH
    if (ATTN_STATIC_PRIO) __builtin_amdgcn_s_setprio(0);
}

__device__ __forceinline__ void phase_combine(const Ctx& C) {
    const bf16* PO = (const bf16*)C.out; const float* PL = (const float*)(C.ws + WS_PL);
    const bf16* ZB = (const bf16*)(C.ws + WS_PROJ) + (size_t)T_ZB * SUBSTRIDE;
    bf16* MIX = (bf16*)(C.ws + WS_MIX);
    const int gt = C.bid * 512 + C.tid, NT = C.G * 512;
    constexpr int UN = 4;
    for (int idx0 = gt; idx0 < MROWS * 64; idx0 += NT * UN) {
        f32x4 lv[UN]; v4u pv[UN][4]; v4u zv[UN];
#pragma unroll
        for (int k = 0; k < UN; ++k) {
            const int idx = idx0 + k * NT;
            const int ch = idx & 7, h = (idx >> 3) & 7, row = idx >> 6, b = row >> 14, pos = row & (SEQ - 1), i = pos >> 8;
            const size_t pb = ((size_t)(b * NH + h) * SEQ + pos) * 4;
            lv[k] = *(const f32x4*)(PL + pb);
#pragma unroll
            for (int j = 0; j < 4; ++j) pv[k][j] = (j == 3 || j < i) ? *(const v4u*)(PO + (pb + j) * 64 + ch * 8) : (v4u){0u, 0u, 0u, 0u};
            zv[k] = *(const v4u*)(ZB + (size_t)row * 512 + h * 64 + ch * 8);
        }
#pragma unroll
        for (int k = 0; k < UN; ++k) {
            const int idx = idx0 + k * NT;
            const int ch = idx & 7, h = (idx >> 3) & 7, row = idx >> 6, pos = row & (SEQ - 1), i = pos >> 8;
            float L = lv[k][3];
#pragma unroll
            for (int j = 0; j < 3; ++j) L += (j < i) ? lv[k][j] : 0.f;
            float acc[8];
#pragma unroll
            for (int e = 0; e < 8; ++e) acc[e] = 0.f;
#pragma unroll
            for (int j = 0; j < 4; ++j) { const v4u v = pv[k][j];
                acc[0] += bflo(v.x); acc[1] += bfhi(v.x); acc[2] += bflo(v.y); acc[3] += bfhi(v.y); acc[4] += bflo(v.z); acc[5] += bfhi(v.z); acc[6] += bflo(v.w); acc[7] += bfhi(v.w); }
            const float rl = 1.0f / L;
            const v4u z = zv[k];
            v4u w;
            w.x = pk2(acc[0] * rl * pg8::act_silu(bflo(z.x)), acc[1] * rl * pg8::act_silu(bfhi(z.x))); w.y = pk2(acc[2] * rl * pg8::act_silu(bflo(z.y)), acc[3] * rl * pg8::act_silu(bfhi(z.y)));
            w.z = pk2(acc[4] * rl * pg8::act_silu(bflo(z.z)), acc[5] * rl * pg8::act_silu(bfhi(z.z))); w.w = pk2(acc[6] * rl * pg8::act_silu(bflo(z.w)), acc[7] * rl * pg8::act_silu(bfhi(z.w)));
            *(v4u*)(MIX + (size_t)row * 1024 + 512 + h * 64 + ch * 8) = w;
        }
    }
}

constexpr int SG_VPITCH = 272, SG_MPITCH = 144, SG_WREG = 128 * SG_MPITCH;
constexpr int SG_STATS = 8 * SG_WREG;
constexpr int SG_MR = SG_STATS + 8192;
constexpr int SG_LN = SG_MR + 1024;
__device__ __forceinline__ void phase_sgu(const Ctx& C, int layer) {
    typedef float f32x2v __attribute__((ext_vector_type(2)));
    unsigned char* lds = C.lds;
    const bf16* U = (const bf16*)(C.ws + WS_PROJ) + (size_t)T_U * SUBSTRIDE;
    const bf16* V = (const bf16*)(C.ws + WS_PROJ) + (size_t)T_V * SUBSTRIDE;
    const bf16* ZA = (const bf16*)(C.ws + WS_PROJ) + (size_t)T_ZA * SUBSTRIDE;
    bf16* MIX = (bf16*)(C.ws + WS_MIX);
    const int g = C.wave; int lane = C.lane;
    const float* lng = C.ln_g + layer * 512 + g * 64; const float* lnb = C.ln_b + layer * 512 + g * 64;
    const bf16* Wg = (const bf16*)(C.ws + WS_WST) + ((size_t)(layer * 8 + g)) * 128 * 128;
    const float* bg = C.sgu_b + (layer * 8 + g) * 128;
    unsigned char* myreg = lds + g * SG_WREG;
    f32x2v* stats = (f32x2v*)(lds + SG_STATS); f32x2v* mr = (f32x2v*)(lds + SG_MR);
    float* lnl = (float*)(lds + SG_LN + g * 512);
    lnl[lane] = lng[lane]; lnl[64 + lane] = lnb[lane];
    for (int u = C.bid; u < MROWS / 128; u += C.G) {
        const size_t row0 = (size_t)u * 128;
        asm volatile("" : "+v"(lane));
        v4u xv[2][8];
#pragma unroll
        for (int rr = 0; rr < 2; ++rr) {
            const v4u* vp = (const v4u*)(V + (row0 + lane + 64 * rr) * 512 + g * 64);
#pragma unroll
            for (int c = 0; c < 8; ++c) xv[rr][c] = vp[c];
        }
#pragma unroll
        for (int rr = 0; rr < 2; ++rr) {
            float s1 = 0.f, s2 = 0.f;
#pragma unroll
            for (int c = 0; c < 8; ++c) { v4u v = xv[rr][c];
                v.x = pk2(pg8::act_gelu(bflo(v.x)), pg8::act_gelu(bfhi(v.x))); v.y = pk2(pg8::act_gelu(bflo(v.y)), pg8::act_gelu(bfhi(v.y)));
                v.z = pk2(pg8::act_gelu(bflo(v.z)), pg8::act_gelu(bfhi(v.z))); v.w = pk2(pg8::act_gelu(bflo(v.w)), pg8::act_gelu(bfhi(v.w))); xv[rr][c] = v;
                const float f0 = bflo(v.x), f1 = bfhi(v.x), f2 = bflo(v.y), f3 = bfhi(v.y), f4 = bflo(v.z), f5 = bfhi(v.z), f6 = bflo(v.w), f7 = bfhi(v.w);
                s1 += ((f0 + f1) + (f2 + f3)) + ((f4 + f5) + (f6 + f7));
                s2 += ((f0 * f0 + f1 * f1) + (f2 * f2 + f3 * f3)) + ((f4 * f4 + f5 * f5) + (f6 * f6 + f7 * f7)); }
            stats[g * 128 + lane + 64 * rr] = (f32x2v){s1, s2};
        }
        bf16x8 wf[4][8];
        { const bf16* wa = Wg + (size_t)(lane & 31) * 128 + (lane >> 5) * 8;
#pragma unroll
          for (int tt = 0; tt < 4; ++tt)
#pragma unroll
              for (int ks = 0; ks < 8; ++ks) if (tt >= (ks >> 1)) wf[tt][ks] = *(const bf16x8*)(wa + (size_t)tt * 32 * 128 + ks * 16); }
        __syncthreads();
        if (C.tid < 128) {
            float s1 = 0.f, s2 = 0.f;
#pragma unroll
            for (int w = 0; w < 8; ++w) { const f32x2v t = stats[w * 128 + C.tid]; s1 += t.x; s2 += t.y; }
            const float mean = s1 * (1.0f / 512.0f), var = s2 * (1.0f / 512.0f) - mean * mean;
            mr[C.tid] = (f32x2v){mean, 1.0f / sqrtf(var + LN_EPS)};
        }
        __syncthreads();
#pragma unroll
        for (int c = 0; c < 8; ++c) asm volatile("" : "+v"(xv[0][c]), "+v"(xv[1][c]));
        { const f32x2v m0 = mr[lane], m1 = mr[lane + 64];
          unsigned short* vt = (unsigned short*)(myreg + lane * 2);
#pragma unroll
          for (int c = 0; c < 8; ++c) {
              const v4u v0 = xv[0][c], v1 = xv[1][c];
              const float f0[8] = {bflo(v0.x), bfhi(v0.x), bflo(v0.y), bfhi(v0.y), bflo(v0.z), bfhi(v0.z), bflo(v0.w), bfhi(v0.w)};
              const float f1[8] = {bflo(v1.x), bfhi(v1.x), bflo(v1.y), bfhi(v1.y), bflo(v1.z), bfhi(v1.z), bflo(v1.w), bfhi(v1.w)};
#pragma unroll
              for (int e = 0; e < 8; ++e) { const int d = 8 * c + e; const float gg = lnl[d], bbv = lnl[64 + d];
                  vt[d * (SG_VPITCH / 2)] = (unsigned short)f2bf((f0[e] - m0.x) * m0.y * gg + bbv);
                  vt[d * (SG_VPITCH / 2) + 64] = (unsigned short)f2bf((f1[e] - m1.x) * m1.y * gg + bbv); }
              asm volatile("" ::: "memory");
          } }
        LDS_WAIT(); asm volatile("" ::: "memory");
        { const int q = lane & 31, hi = lane >> 5;
          unsigned pk[2][4][8];
#pragma unroll
          for (int dt = 0; dt < 2; ++dt) {
              const unsigned char* bb = myreg + (32 * dt + q) * SG_VPITCH + hi * 16;
              f32x16 acc[4];
#pragma unroll
              for (int tt = 0; tt < 4; ++tt) acc[tt] = (f32x16){};
#pragma unroll
              for (int ks = 0; ks < 8; ++ks) {
                  const bf16x8 b0 = *(const bf16x8*)(bb + ks * 32);
#pragma unroll
                  for (int tt = 0; tt < 4; ++tt) if (tt >= (ks >> 1)) acc[tt] = __builtin_amdgcn_mfma_f32_32x32x16_bf16(wf[tt][ks], b0, acc[tt], 0, 0, 0);
              }
#pragma unroll
              for (int tt = 0; tt < 4; ++tt)
#pragma unroll
                  for (int rp = 0; rp < 8; ++rp) pk[dt][tt][rp] = cvtpk(acc[tt][2 * rp], acc[tt][2 * rp + 1]);
          }
          LDS_WAIT(); asm volatile("" ::: "memory");
          unsigned char* mxb = myreg + (4 * hi) * SG_MPITCH + q * 2;
#pragma unroll
          for (int dt = 0; dt < 2; ++dt)
#pragma unroll
              for (int tt = 0; tt < 4; ++tt)
#pragma unroll
                  for (int r = 0; r < 16; ++r)
                      *(unsigned short*)(mxb + (32 * tt + (r & 3) + 8 * (r >> 2)) * SG_MPITCH + 64 * dt) = (unsigned short)((r & 1) ? (pk[dt][tt][r >> 1] >> 16) : (pk[dt][tt][r >> 1] & 0xffffu));
        }
        LDS_WAIT(); asm volatile("" ::: "memory");
        { const int ch = lane & 7, r8 = lane >> 3;
#pragma unroll 4
          for (int it = 0; it < 16; ++it) {
              const int t = it * 8 + r8;
              const v4u mv = *(const v4u*)(myreg + t * SG_MPITCH + ch * 16);
              const v4u uv = *(const v4u*)(U + (row0 + t) * 512 + g * 64 + ch * 8), zv = *(const v4u*)(ZA + (row0 + t) * 512 + g * 64 + ch * 8);
              const float bt = bg[t];
              v4u o;
#define SGU_Y(uw, mw, zw) pk2(pg8::act_gelu(bflo(uw)) * (bflo(mw) + bt) * pg8::act_silu(bflo(zw)), pg8::act_gelu(bfhi(uw)) * (bfhi(mw) + bt) * pg8::act_silu(bfhi(zw)))
              o.x = SGU_Y(uv.x, mv.x, zv.x); o.y = SGU_Y(uv.y, mv.y, zv.y); o.z = SGU_Y(uv.z, mv.z, zv.z); o.w = SGU_Y(uv.w, mv.w, zv.w);
#undef SGU_Y
              *(v4u*)(MIX + (row0 + t) * 1024 + g * 64 + ch * 8) = o;
          } }
        __syncthreads();
    }
}

__device__ __forceinline__ void phase_check_inject(const Ctx& C) {
    if (C.bid == 0 && C.tid == 0) C.out[0] = __uint_as_float(((const unsigned*)(C.ws + WS_CTL))[32]) * 1e6f;
}

#define GAS __attribute__((address_space(1)))
typedef GAS unsigned gu32;
#define RLX_AGENT __ATOMIC_RELAXED, __HIP_MEMORY_SCOPE_AGENT
constexpr int CW_BAR = 4096;
constexpr int LDS_BARST = LDS_BYTES - 64;
#define XB_TMO      128
#define XB_XCNT(j)  (256  + 64 * (j))
#define XB_XSUB(j)  (1280 + 64 * (j))
#define XB_XGEN(j)  (2304 + 64 * (j))
#define XB_TOP      3328
#define XB_TOPGEN   3392
#define XCD_BAR_WORDS 3456
#define XB_SPIN_CAP (1u << 18)

__device__ __forceinline__ unsigned xb_ld(unsigned* p)              { return __hip_atomic_load(p, __ATOMIC_RELAXED, __HIP_MEMORY_SCOPE_AGENT); }
__device__ __forceinline__ unsigned xb_add(unsigned* p, unsigned v) { return __hip_atomic_fetch_add(p, v, __ATOMIC_RELAXED, __HIP_MEMORY_SCOPE_AGENT); }
__device__ __forceinline__ unsigned xb_xcc_id() { return (unsigned)__builtin_amdgcn_s_getreg((3 << 11) | 20) & 0xFu; }
#define XB_SPIN(cond, bar) do { unsigned _sp = 0; while (cond) { __builtin_amdgcn_s_sleep(1); \
    if ((++_sp & 255u) == 0u) { if (xb_ld(&(bar)[XB_TMO])) break; if (_sp > XB_SPIN_CAP) { atomicAdd(&(bar)[XB_TMO], 1u); break; } } } } while (0)

struct XcdBarrier {
    unsigned* bar; unsigned x;
    volatile LAS unsigned* st;
};

__device__ __forceinline__ XcdBarrier xcd_barrier_post(unsigned* bar, volatile LAS unsigned* st) {
    XcdBarrier b; b.bar = bar; b.x = xb_xcc_id(); b.st = st;
    if (threadIdx.x == 0) (void)xb_add(&bar[XB_XCNT(b.x)], 1u);
    return b;
}
__device__ __forceinline__ void xcd_barrier_complete(unsigned* bar, unsigned x, unsigned& nloc, unsigned& nx) {
    const unsigned G = gridDim.x * gridDim.y * gridDim.z;
    unsigned sum, cnt, mine, sp = 0u;
    for (;;) {
        sum = 0u; cnt = 0u; mine = 0u;
#pragma unroll
        for (unsigned j = 0; j < 16; ++j) { const unsigned c = xb_ld(&bar[XB_XCNT(j)]); sum += c; cnt += (c > 0u) ? 1u : 0u; mine = (j == x) ? c : mine; }
        if (sum == G) break;
        __builtin_amdgcn_s_sleep(1);
        if ((++sp & 255u) == 0u) { if (xb_ld(&bar[XB_TMO])) break; if (sp > XB_SPIN_CAP) { atomicAdd(&bar[XB_TMO], 1u); break; } }
    }
    nloc = mine > 0u ? mine : 1u; nx = cnt > 0u ? cnt : 1u;
}

__device__ __forceinline__ void xcd_barrier(const XcdBarrier& b, const bool leader_thread) {
    asm volatile("s_waitcnt vmcnt(0)" ::: "memory");
    __syncthreads();
    if (leader_thread) {
        unsigned* bar = b.bar;
        __builtin_amdgcn_s_waitcnt(0);
        unsigned nloc = b.st[0], nx = b.st[1];
        if (nloc == 0u) { xcd_barrier_complete(bar, b.x, nloc, nx); b.st[0] = nloc; b.st[1] = nx; }
        const unsigned old = xb_add(&bar[XB_XSUB(b.x)], 1u);
        const unsigned gen = old / nloc;
        if (old + 1u == (gen + 1u) * nloc) {
            __builtin_amdgcn_fence(__ATOMIC_RELEASE, "agent");
            asm volatile("s_waitcnt vmcnt(0)" ::: "memory");
            const unsigned og = xb_add(&bar[XB_TOP], 1u);
            const unsigned tg = og / nx;
            if (og + 1u == (tg + 1u) * nx) xb_add(&bar[XB_TOPGEN], 1u);
            else XB_SPIN(xb_ld(&bar[XB_TOPGEN]) == tg, bar);
            __builtin_amdgcn_fence(__ATOMIC_ACQUIRE, "agent");
            xb_add(&bar[XB_XGEN(b.x)], 1u);
            asm volatile("s_waitcnt vmcnt(0)" ::: "memory");
        } else {
            XB_SPIN(xb_ld(&bar[XB_XGEN(b.x)]) == gen, bar);
            __builtin_amdgcn_fence(__ATOMIC_ACQUIRE, "agent");
            asm volatile("s_waitcnt vmcnt(0)" ::: "memory");
        }
    }
    __syncthreads();
}

template <int ST> __device__ __forceinline__ void run_stage(const Args& args, unsigned char* lds, int Lr, int wave_s) {
    const int L = Lr;
    Ctx C;
    { int t = wave_s * 64 + lane_now(); C.tid = t; }
    C.lds = lds; C.lane = C.tid & 63; C.wave = __builtin_amdgcn_readfirstlane(C.tid >> 6); C.G = gridDim.x; C.bid = blockIdx.x;
    C.x = args.in[0]; C.norm_g = args.in[1]; C.w_in = args.in[2]; C.ln_g = args.in[3]; C.ln_b = args.in[4]; C.sgu_w = args.in[5]; C.sgu_b = args.in[6];
    C.w_out = args.in[7]; C.rel_bias = args.in[8]; C.final_g = args.in[9]; C.out = args.out; C.ws = args.ws;
    asm volatile("" : "+s"(C.ws), "+s"(C.out), "+s"(C.x), "+s"(C.sgu_b), "+s"(C.ln_g), "+s"(C.ln_b));
    if constexpr (ST == 0) phase_prologue(C);
    else if constexpr (ST == 1) {
        pg8::Gemm g{(const pg8::bf16_t*)(C.ws + WS_XB), (const pg8::bf16_t*)(C.ws + WS_WIN) + (size_t)L * DIN * DM, MROWS, DIN, DM};
        pg8::StaticOrder S; S.init(MROWS, DIN, C.G, C.bid);
        int pmA = -1, pmB = -1, pmC = -1, pmD = -1;
        { pg8::Unit uu;
          for (int i = 0; S.next(i, uu); ++i) { const int pmu = uu.pm;
              if (pmu == pmA || pmu == pmB || pmu == pmC || pmu == pmD) continue;
              if (pmA < 0) pmA = pmu; else if (pmB < 0) pmB = pmu; else if (pmC < 0) pmC = pmu; else if (pmD < 0) pmD = pmu; } }
        float* rtab = (float*)(lds + RING_BYTES);
        { const float* rowss = (const float*)(C.ws + WS_ROWSS);
#pragma unroll
          for (int k = 0; k < 2; ++k) { const int e = C.tid + 512 * k, sl = e >> 8, pmk = sl == 0 ? pmA : sl == 1 ? pmB : sl == 2 ? pmC : pmD;
              if (pmk >= 0) { const f32x4* rp = (const f32x4*)(rowss + ((size_t)pmk * 256 + (e & 255)) * 16); const f32x4 s0 = rp[0], s1 = rp[1], s2 = rp[2], s3 = rp[3];
                  const float ss = ((s0[0] + s0[1]) + (s0[2] + s0[3])) + ((s1[0] + s1[1]) + (s1[2] + s1[3])) + ((s2[0] + s2[1]) + (s2[2] + s2[3])) + ((s3[0] + s3[1]) + (s3[2] + s3[3]));
                  rtab[e] = 1.0f / sqrtf(ss * (1.0f / 1024.0f) + NORM_EPS); } }
          __syncthreads(); }
        pg8::EpiProj E{(pg8::bf16_t*)(C.ws + WS_PROJ), SUBSTRIDE, rtab, pmA, pmB, pmC, pmD, (float*)(C.ws + WS_KMEAN) + (size_t)L * NBH * NBLK * 64};
        pg8::gemm_phase<pg8::EpiProj, pg8::StaticOrder, true, true>((PG8_LAS unsigned char*)lds, g, S, E, C.tid);
    }
    else if constexpr (ST == 3) { phase_gate(C, L); phase_sgu(C, L); }
    else if constexpr (ST == 4) phase_attn(C, L);
    else if constexpr (ST == 5) phase_combine(C);
    else if constexpr (ST == 6) {
        pg8::Gemm g{(const pg8::bf16_t*)(C.ws + WS_MIX), (const pg8::bf16_t*)(C.ws + WS_WOUT) + (size_t)L * DM * DM, MROWS, DM, DM};
        pg8::StaticOrder S; S.init(MROWS, DM, C.G, C.bid);
        if (L == 0) { pg8::EpiRes E{(pg8::bf16_t*)(C.ws + WS_XB), (float*)(C.ws + WS_ROWSS)};
            pg8::gemm_phase<pg8::EpiRes, pg8::StaticOrder, true, true>((PG8_LAS unsigned char*)lds, g, S, E, C.tid); }
        else { pg8::EpiFinal E{(const pg8::bf16_t*)(C.ws + WS_XB), C.out, C.final_g, (float*)(C.ws + WS_ROWSS), (unsigned*)(C.ws + WS_CTL) + 8192};
            pg8::gemm_phase<pg8::EpiFinal, pg8::StaticOrder, true, true>((PG8_LAS unsigned char*)lds, g, S, E, C.tid); }
    } else if constexpr (ST == 7) phase_check_inject(C);
    else if constexpr (ST == 8) phase_attn_simple(C, (bf16*)(C.ws + 104 * MiB));
    else if constexpr (ST == 9) {
        const bf16* A = (const bf16*)(C.ws + WS_MIX); const bf16* B = (const bf16*)(C.ws + 104 * MiB); unsigned* flag = (unsigned*)(C.ws + WS_CTL) + 32;
        float md = 0.f;
        for (size_t idx = (size_t)C.bid * 512 + C.tid; idx < (size_t)MROWS * 512; idx += (size_t)C.G * 512) {
            const size_t row = idx >> 9, col = 512 + (idx & 511);
            const float a = __uint_as_float((unsigned)A[row * 1024 + col] << 16), r = __uint_as_float((unsigned)B[row * 1024 + col] << 16);
            float sc = fabsf(r);
#pragma unroll
            for (int o = 1; o < 64; o <<= 1) sc = fmaxf(sc, __shfl_xor(sc, o));
            const float d = fabsf(a - r) / (0.02f + sc);
            md = (d > md || !(d == d)) ? (d == d ? d : 1e6f) : md;
        }
        atomicMax(flag, __float_as_uint(md));
    }
}
template <int SEL> __global__ void __launch_bounds__(NWAVES * 64, 2) fwd(Args args) {
    extern __shared__ __attribute__((aligned(16))) unsigned char lds[];
    const int wave_s = __builtin_amdgcn_readfirstlane((int)threadIdx.x >> 6);
    if constexpr (SEL >= 0) run_stage<SEL>(args, lds, args.layer, wave_s);
    else {
        if (args.pad == 0x7fffffff) cg::this_grid().sync();
        volatile LAS unsigned* bst = (volatile LAS unsigned*)((LAS unsigned char*)lds + LDS_BARST);
        if (threadIdx.x == 0) { bst[0] = 0u; bst[1] = 0u; }
        __syncthreads();
        XcdBarrier bar = xcd_barrier_post((unsigned*)(args.ws + WS_CTL) + CW_BAR, bst);
#define GRID_SYNC() do { XcdBarrier b2_ = bar; asm volatile("" : "+s"(b2_.bar), "+s"(b2_.x)); xcd_barrier(b2_, wave_s == 0 && lane_now() == 0); } while (0)
#define RUN(k, L) do { run_stage<k>(args, lds, L, wave_s); GRID_SYNC(); } while (0)
        RUN(0, 0);
        for (int L = 0; L < DEPTH; ++L) {
            RUN(1, L); RUN(3, L); RUN(4, L); RUN(5, L);
            if (L == DEPTH - 1) run_stage<6>(args, lds, L, wave_s); else RUN(6, L);
        }
    }
}

#ifndef MK_N_LAUNCHES
#define MK_N_LAUNCHES 1
#endif
template <int SEL> static void launch_stage(int grid, Args a, int layer, hipStream_t stream) {
    static bool attr = false;
    if (!attr) { (void)hipFuncSetAttribute((const void*)fwd<SEL>, hipFuncAttributeMaxDynamicSharedMemorySize, LDS_BYTES); attr = true; }
    a.layer = layer;
    hipLaunchKernelGGL(fwd<SEL>, dim3(grid), dim3(NWAVES * 64), LDS_BYTES, stream, a);
}
extern "C" void kernel_launch(void* const* d_in, const int* in_sizes, int n_in, void* d_out, int out_size, void* d_ws, size_t ws_size, hipStream_t stream) {
    static int grid = 0;
    if (grid == 0) {
        if (n_in != 10 || out_size != MROWS * DM || ws_size < WS_END) { fprintf(stderr, "kernel_launch: unexpected shapes (n_in %d out %d ws %zu)\n", n_in, out_size, ws_size); grid = -1; return; }
        int dev = 0, cus = 0;
        (void)hipGetDevice(&dev); (void)hipDeviceGetAttribute(&cus, hipDeviceAttributeMultiprocessorCount, dev);
        grid = cus;
        if (grid != 256) fprintf(stderr, "kernel_launch: %d CUs: the fused final-norm epilogue pairs the four column tiles of a row panel inside one round of a 256-workgroup grid\n", grid);
#if MK_N_LAUNCHES == 1
        int per_cu = 0;
        if (hipFuncSetAttribute((const void*)fwd<-1>, hipFuncAttributeMaxDynamicSharedMemorySize, LDS_BYTES) != hipSuccess) { fprintf(stderr, "kernel_launch: hipFuncSetAttribute failed\n"); grid = -1; return; }
        if (hipOccupancyMaxActiveBlocksPerMultiprocessor(&per_cu, (const void*)fwd<-1>, NWAVES * 64, LDS_BYTES) != hipSuccess || per_cu < 1) { fprintf(stderr, "kernel_launch: occupancy query says %d\n", per_cu); grid = -1; return; }
        (void)hipGetLastError();
#endif
    }
    if (grid < 0) return;
    (void)hipMemsetAsync((char*)d_ws + WS_CTL, 0, CTL_ZERO_BYTES, stream);
    Args a{};
    for (int i = 0; i < 10; ++i) a.in[i] = (const float*)d_in[i];
    a.out = (float*)d_out; a.ws = (unsigned char*)d_ws;
#if MK_N_LAUNCHES == 1
    void* kargs[] = {&a};
    hipError_t e = hipLaunchCooperativeKernel((const void*)fwd<-1>, dim3(grid), dim3(NWAVES * 64), kargs, LDS_BYTES, stream);
    if (e != hipSuccess) fprintf(stderr, "kernel_launch: cooperative launch failed: %s\n", hipGetErrorString(e));
#else
    launch_stage<0>(grid, a, 0, stream);
    for (int L = 0; L < DEPTH; ++L) {
        launch_stage<1>(grid, a, L, stream); launch_stage<3>(grid, a, L, stream);
        launch_stage<4>(grid, a, L, stream); launch_stage<5>(grid, a, L, stream);
        if (CHECK_ATTN && L == 0) { launch_stage<8>(grid, a, L, stream); launch_stage<9>(grid, a, L, stream); }
        launch_stage<6>(grid, a, L, stream);
    }
    if (CHECK_ATTN) launch_stage<7>(grid, a, 0, stream);
#endif
}
```

```cpp
#include <hip/hip_runtime.h>
#include <hip/hip_cooperative_groups.h>
#include <cstdio>
#include <cstdint>
namespace cg = cooperative_groups;

constexpr int BATCH = 2, SEQ = 16384, DM = 1024, MROWS = BATCH * SEQ, DIN = 3584, DSUB = 512;
constexpr int NH = 8, DH = 64, NBLK = SEQ / 256, NBH = BATCH * NH, DEPTH = 2;
constexpr float NORM_EPS = 1e-6f, LN_EPS = 1e-5f;
constexpr float LOG2E = 1.4426950408889634f;
#ifndef CHECK_ATTN
#define CHECK_ATTN 0
#endif
constexpr float QSCALE = 0.125f * LOG2E;
__device__ __forceinline__ int lx_lane() { int l; asm volatile("v_mbcnt_lo_u32_b32 %0, -1, 0\n\tv_mbcnt_hi_u32_b32 %0, -1, %0" : "=v"(l)); return l; }
__device__ __forceinline__ int lx_xor(int v, int m) { return __builtin_amdgcn_ds_bpermute((lx_lane() ^ m) << 2, v); }
__device__ __forceinline__ float lx_xor(float v, int m) { return __builtin_bit_cast(float, __builtin_amdgcn_ds_bpermute((lx_lane() ^ m) << 2, __builtin_bit_cast(int, v))); }
__device__ __forceinline__ int lx_up(int v, int d) { const int l = lx_lane(); return __builtin_amdgcn_ds_bpermute((l >= d ? l - d : l) << 2, v); }
namespace pg8 {
#define PG8_LAS __attribute__((address_space(3)))
typedef unsigned short bf16_t;
typedef short bf16x8 __attribute__((ext_vector_type(8)));
typedef float f32x4 __attribute__((ext_vector_type(4)));
typedef unsigned u32x4 __attribute__((ext_vector_type(4)));
constexpr int BM = 256, BK = 64, HALF = 128, HTB = HALF * BK * 2  , STAGE_BYTES = 8 * HTB, NXCD = 8, WGM = 8;

__host__ __device__ __forceinline__ int lds_byte(int r, int c) { const int st = (r >> 4) * 2 + (c >> 5), rr = r & 15, cc = c & 31, ob = rr * 64 + cc * 2; return st * 1024 + (ob ^ (((ob >> 9) & 1) << 5)); }
__host__ __device__ __forceinline__ void stage_rc(int b, int& R, int& C) { const int st = b / 1024, sb = b % 1024, swz = sb ^ (((sb >> 9) & 1) << 5); R = (st >> 1) * 16 + swz / 64; C = (st & 1) * 32 + (swz % 64) / 2; }
__host__ __device__ __forceinline__ int perm32(int rho) { const int n = rho >> 4, i = rho & 15; return 8 * (i >> 2) + 4 * n + (i & 3); }

struct Unit { int pm, pn; };
struct Gemm { const bf16_t* A; const bf16_t* Bt; int M, N, K; };

struct StaticOrder {
    int nM, nN, nwg, G, c;
    __host__ __device__ void init(int M, int N, int G_, int c_) { nM = M / BM; nN = N / BM; nwg = nM * nN; G = G_; c = c_; }
    __host__ __device__ bool next(int i, Unit& u) const {
        const long L = (long)i * G + c; if (L >= nwg) return false;
        int wgid = (int)L; { const int q = nwg / NXCD, r = nwg % NXCD, xcd = wgid % NXCD, off = wgid / NXCD; wgid = (xcd < r ? xcd * (q + 1) : r * (q + 1) + (xcd - r) * q) + off; }
        const int nig = WGM * nN, gid = wgid / nig, fm = gid * WGM, gsz = (nM - fm) < WGM ? (nM - fm) : WGM;
        u.pm = fm + ((wgid % nig) % gsz); u.pn = (wgid % nig) / gsz; return true;
    }
    __device__ __forceinline__ void a_ready(const Unit&) const {}
    __device__ __forceinline__ void done(const Unit&) const {}
};

__device__ __forceinline__ unsigned cvt_pk_bf16(float lo, float hi) { unsigned r; asm volatile("v_cvt_pk_bf16_f32 %0, %1, %2" : "=v"(r) : "v"(lo), "v"(hi)); return r; }
typedef float f32x2 __attribute__((ext_vector_type(2)));
typedef float f32x2 __attribute__((ext_vector_type(2)));
__device__ __forceinline__ float act_gelu(float x) {
    const float u = x * (1.0f + 0.044715f * x * x);
    const float e = __builtin_amdgcn_exp2f(u * (-2.0f * 0.7978845608028654f * 1.4426950408889634f));
    return x * __builtin_amdgcn_rcpf(1.0f + e);
}
__device__ __forceinline__ float act_silu(float x) {
    const float e = __builtin_amdgcn_exp2f(x * (-1.4426950408889634f));
    return x * __builtin_amdgcn_rcpf(1.0f + e);
}
struct EpiProj {
    static constexpr bool PERM = true, AFTER_DRAIN = false;
    bf16_t* P; size_t sub_stride; const float* rstd_lds; int pm0, pm1, pm2, pm3; float* kmean;
    __device__ __forceinline__ void operator()(const f32x4 (&acc)[2][2][4][2], const Unit& u, int wr, int wc, int fr, int fq) const {
        const int t = u.pn >> 1;
        bf16_t* base = P + (size_t)t * sub_stride;
        const int col0 = (u.pn & 1) * 256 + wc * 32 + 8 * fq;
        const int row0 = u.pm * BM + wr * 64 + fr;
        const int slot = (u.pm == pm0) ? 0 : (u.pm == pm1) ? 1 : (u.pm == pm2) ? 2 : 3;
        const float* rt = rstd_lds + slot * 256 + wr * 64 + fr;
        const float qs = (t == 3) ? (0.125f * 1.4426950408889634f) : 1.0f;
        float ks[2][8];
#pragma unroll
        for (int bj = 0; bj < 2; ++bj)
#pragma unroll
            for (int e = 0; e < 8; ++e) ks[bj][e] = 0.f;
#pragma unroll
        for (int ai = 0; ai < 2; ++ai)
#pragma unroll
            for (int m = 0; m < 4; ++m) {
                const int row = row0 + ai * HALF + m * 16;
                const float rs = rt[ai * HALF + m * 16] * qs;
                bf16_t* rowp = base + (size_t)row * 512 + col0;
#pragma unroll
                for (int bj = 0; bj < 2; ++bj) {
                    const f32x4 v0 = acc[ai][bj][m][0] * rs, v1 = acc[ai][bj][m][1] * rs;
                    if (t == 4) {
#pragma unroll
                        for (int e = 0; e < 4; ++e) { ks[bj][e] += v0[e]; ks[bj][4 + e] += v1[e]; }
                    }
                    u32x4 w; w.x = cvt_pk_bf16(v0[0], v0[1]); w.y = cvt_pk_bf16(v0[2], v0[3]); w.z = cvt_pk_bf16(v1[0], v1[1]); w.w = cvt_pk_bf16(v1[2], v1[3]);
                    *(u32x4*)(rowp + bj * HALF) = w;
                }
            }
        if (t == 4) {
            const int b = u.pm >> 6, n = u.pm & 63;
#pragma unroll
            for (int bj = 0; bj < 2; ++bj)
#pragma unroll
                for (int e = 0; e < 8; ++e) {
                    float v = ks[bj][e];
                    v += lx_xor(v, 1); v += lx_xor(v, 2); v += lx_xor(v, 4); v += lx_xor(v, 8);
                    if (fr == 0) { const int col = col0 + bj * HALF + e; atomicAdd(kmean + ((size_t)((b * 8 + (col >> 6)) * 64 + n)) * 64 + (col & 63), v * (1.0f / 256.0f)); }
                }
        }
    }
};
#define PG8_GAS __attribute__((address_space(1)))
struct EpiRes {
    static constexpr bool PERM = true, AFTER_DRAIN = false;
    bf16_t* xb; float* rowss;
    __device__ __forceinline__ void operator()(const f32x4 (&acc)[2][2][4][2], const Unit& u, int wr, int wc, int fr, int fq) const {
        const int col0 = u.pn * BM + wc * 32 + 8 * fq;
        PG8_GAS bf16_t* xbg = (PG8_GAS bf16_t*)xb; PG8_GAS float* rsg = (PG8_GAS float*)rowss;
        const unsigned ob = (unsigned)((u.pm * BM + wr * 64 + fr) * 1024 + col0) * 2u;
        u32x4 rr[2][4][2];
#pragma unroll
        for (int ai = 0; ai < 2; ++ai)
#pragma unroll
            for (int m = 0; m < 4; ++m)
#pragma unroll
                for (int bj = 0; bj < 2; ++bj) rr[ai][m][bj] = *(const PG8_GAS u32x4*)((const PG8_GAS char*)xbg + (ob + (unsigned)(((ai * HALF + m * 16) * 1024 + bj * HALF) * 2)));
#pragma unroll
        for (int ai = 0; ai < 2; ++ai)
#pragma unroll
            for (int m = 0; m < 4; ++m) {
                const int row = u.pm * BM + ai * HALF + wr * 64 + m * 16 + fr;
                float ss = 0.f;
#pragma unroll
                for (int bj = 0; bj < 2; ++bj) {
                    const u32x4 w0 = rr[ai][m][bj];
                    const f32x4 r0 = (f32x4){__uint_as_float(w0.x << 16), __uint_as_float(w0.x & 0xffff0000u), __uint_as_float(w0.y << 16), __uint_as_float(w0.y & 0xffff0000u)};
                    const f32x4 r1 = (f32x4){__uint_as_float(w0.z << 16), __uint_as_float(w0.z & 0xffff0000u), __uint_as_float(w0.w << 16), __uint_as_float(w0.w & 0xffff0000u)};
                    const f32x4 o0 = r0 + acc[ai][bj][m][0], o1 = r1 + acc[ai][bj][m][1];
                    ss += ((o0[0] * o0[0] + o0[1] * o0[1]) + (o0[2] * o0[2] + o0[3] * o0[3])) + ((o1[0] * o1[0] + o1[1] * o1[1]) + (o1[2] * o1[2] + o1[3] * o1[3]));
                    u32x4 w; w.x = cvt_pk_bf16(o0[0], o0[1]); w.y = cvt_pk_bf16(o0[2], o0[3]); w.z = cvt_pk_bf16(o1[0], o1[1]); w.w = cvt_pk_bf16(o1[2], o1[3]);
                    *(PG8_GAS u32x4*)((PG8_GAS char*)xbg + (ob + (unsigned)(((ai * HALF + m * 16) * 1024 + bj * HALF) * 2))) = w;
                }
                ss += lx_xor(ss, 16); ss += lx_xor(ss, 32);
                if (fq == 0) rsg[(size_t)row * 16 + u.pn * 4 + wc] = ss;
            }
    }
};
struct EpiFinal {
    static constexpr bool PERM = true, AFTER_DRAIN = false;
    const bf16_t* xb; float* out; const float* fg; float* slots; unsigned* cnt;
    __device__ __forceinline__ void operator()(f32x4 (&acc)[2][2][4][2], const Unit& u, int wr, int wc, int fr, int fq) const {
        const int col0 = u.pn * BM + wc * 32 + 8 * fq;
        const PG8_GAS bf16_t* xbg = (const PG8_GAS bf16_t*)xb; PG8_GAS float* outg = (PG8_GAS float*)out; const PG8_GAS float* slg = (const PG8_GAS float*)slots;
        const unsigned ob = (unsigned)((u.pm * BM + wr * 64 + fr) * 1024 + col0) * 2u;
        u32x4 rr[2][4][2];
#pragma unroll
        for (int ai = 0; ai < 2; ++ai)
#pragma unroll
            for (int m = 0; m < 4; ++m)
#pragma unroll
                for (int bj = 0; bj < 2; ++bj) rr[ai][m][bj] = *(const PG8_GAS u32x4*)((const PG8_GAS char*)xbg + (ob + (unsigned)(((ai * HALF + m * 16) * 1024 + bj * HALF) * 2)));
#pragma unroll
        for (int ai = 0; ai < 2; ++ai)
#pragma unroll
            for (int m = 0; m < 4; ++m) {
                const int row = u.pm * BM + ai * HALF + wr * 64 + m * 16 + fr;
                float ss = 0.f;
#pragma unroll
                for (int bj = 0; bj < 2; ++bj) {
                    const u32x4 w = rr[ai][m][bj];
                    const f32x4 r0 = (f32x4){__uint_as_float(w.x << 16), __uint_as_float(w.x & 0xffff0000u), __uint_as_float(w.y << 16), __uint_as_float(w.y & 0xffff0000u)};
                    const f32x4 r1 = (f32x4){__uint_as_float(w.z << 16), __uint_as_float(w.z & 0xffff0000u), __uint_as_float(w.w << 16), __uint_as_float(w.w & 0xffff0000u)};
                    const f32x4 o0 = r0 + acc[ai][bj][m][0], o1 = r1 + acc[ai][bj][m][1];
                    acc[ai][bj][m][0] = o0; acc[ai][bj][m][1] = o1;
                    ss += ((o0[0] * o0[0] + o0[1] * o0[1]) + (o0[2] * o0[2] + o0[3] * o0[3])) + ((o1[0] * o1[0] + o1[1] * o1[1]) + (o1[2] * o1[2] + o1[3] * o1[3]));
                }
                ss += lx_xor(ss, 16); ss += lx_xor(ss, 32);
                if (fq == 0) __hip_atomic_store(slots + (size_t)row * 16 + u.pn * 4 + wc, ss, __ATOMIC_RELAXED, __HIP_MEMORY_SCOPE_AGENT);
            }
        asm volatile("s_waitcnt vmcnt(0)" ::: "memory");
        unsigned* pc = cnt + 64 * u.pm;
        if (fr == 0 && fq == 0) __hip_atomic_fetch_add(pc, 1u, __ATOMIC_RELAXED, __HIP_MEMORY_SCOPE_AGENT);
        f32x4 g4[2][2];
#pragma unroll
        for (int bj = 0; bj < 2; ++bj)
#pragma unroll
            for (int n = 0; n < 2; ++n) g4[bj][n] = *(const PG8_GAS f32x4*)((const PG8_GAS float*)fg + col0 + bj * HALF + n * 4);
        for (unsigned spins = 0; spins < (1u << 22); ++spins) {
            if (__hip_atomic_load(pc, __ATOMIC_RELAXED, __HIP_MEMORY_SCOPE_AGENT) >= 32u) break;
            __builtin_amdgcn_s_sleep(2);
        }
        __builtin_amdgcn_fence(__ATOMIC_ACQUIRE, "agent");
        asm volatile("s_waitcnt vmcnt(0)" ::: "memory");
#pragma unroll
        for (int ai = 0; ai < 2; ++ai) {
            f32x4 sl[4][4];
#pragma unroll
            for (int m = 0; m < 4; ++m)
#pragma unroll
                for (int k = 0; k < 4; ++k) sl[m][k] = *(const PG8_GAS f32x4*)(slg + (size_t)(u.pm * BM + ai * HALF + wr * 64 + m * 16 + fr) * 16 + k * 4);
#pragma unroll
            for (int m = 0; m < 4; ++m) {
                const f32x4 s0 = sl[m][0], s1 = sl[m][1], s2 = sl[m][2], s3 = sl[m][3];
                const float tot = ((s0[0] + s0[1]) + (s0[2] + s0[3])) + ((s1[0] + s1[1]) + (s1[2] + s1[3])) + ((s2[0] + s2[1]) + (s2[2] + s2[3])) + ((s3[0] + s3[1]) + (s3[2] + s3[3]));
                const float rs = 1.0f / sqrtf(tot * (1.0f / 1024.0f) + 1e-6f);
#pragma unroll
                for (int bj = 0; bj < 2; ++bj)
#pragma unroll
                    for (int n = 0; n < 2; ++n) *(PG8_GAS f32x4*)((PG8_GAS char*)outg + (2u * ob + (unsigned)(((ai * HALF + m * 16) * 1024 + bj * HALF + n * 4) * 4))) = acc[ai][bj][m][n] * rs * g4[bj][n];
            }
        }
    }
};
template <class Epi, class Sched, bool ALIGN_EPI = false, bool SP2 = false>
__device__ __forceinline__ void gemm_phase(PG8_LAS unsigned char* lds, const Gemm g, const Sched& S, const Epi& E, const int tid) {
    const int wid = __builtin_amdgcn_readfirstlane(tid >> 6), lane = tid & 63, wr = wid >> 2, wc = wid & 3, fr = lane & 15, fq = lane >> 4;
    const int K = g.K, nt = K / BK;
    unsigned voffA[2], voffB[2];
#pragma unroll
    for (int i = 0; i < 2; ++i) { int R, C; stage_rc(tid * 16 + i * 8192, R, C); const int Rb = Epi::PERM ? ((R & ~31) + perm32(R & 31)) : R;
        voffA[i] = (unsigned)(R * K + C) * 2u; voffB[i] = (unsigned)(Rb * K + C) * 2u; }
    const size_t kstep = (size_t)(BK * 2);
    const size_t hstep = (size_t)HALF * K * 2;
    const size_t tstep = 2 * hstep;
    const unsigned ldsw = (unsigned)wid * 1024u;
    const int aoff = lds_byte(wr * 64 + fr, fq * 8), boff = lds_byte(wc * 32 + fr, fq * 8);
#define PG8_SA(b, h) (((b) * 2 + (h)) * HTB)
#define PG8_SB(b, h) ((4 + (b) * 2 + (h)) * HTB)
#define PG8_STAGE(bufoff, gbase, voff) do { _Pragma("unroll") for (int _i = 0; _i < 2; ++_i) \
        __builtin_amdgcn_global_load_lds((const unsigned*)((const char*)(gbase) + (voff)[_i]), (PG8_LAS unsigned*)(lds + (bufoff) + ldsw + _i * 8192), 16, 0, 0); } while (0)
#define PG8_LDA(dst, b, h) do { _Pragma("unroll") for (int m = 0; m < 4; ++m) _Pragma("unroll") for (int k = 0; k < 2; ++k) dst[m][k] = *(const PG8_LAS bf16x8*)(lds + PG8_SA(b, h) + aoff + m * 2048 + k * 1024); } while (0)
#define PG8_LDB(dst, b, h) do { _Pragma("unroll") for (int n = 0; n < 2; ++n) _Pragma("unroll") for (int k = 0; k < 2; ++k) dst[n][k] = *(const PG8_LAS bf16x8*)(lds + PG8_SB(b, h) + boff + n * 2048 + k * 1024); } while (0)
#define PG8_MMA(ai, bj, At, Bt) do { __builtin_amdgcn_s_setprio(1); _Pragma("unroll") for (int m = 0; m < 4; ++m) _Pragma("unroll") for (int n = 0; n < 2; ++n) _Pragma("unroll") for (int k = 0; k < 2; ++k) \
        acc[ai][bj][m][n] = __builtin_amdgcn_mfma_f32_16x16x32_bf16(Bt[n][k], At[m][k], acc[ai][bj][m][n], 0, 0, 0); __builtin_amdgcn_s_setprio(0); } while (0)
#define PG8_WAIT_V(n) asm volatile("s_waitcnt vmcnt(" #n ")" ::: "memory")
#define PG8_WAIT_L(n) asm volatile("s_waitcnt lgkmcnt(" #n ")" ::: "memory")
#define PG8_BAR __builtin_amdgcn_s_barrier()
#define PG8_SCHED __builtin_amdgcn_sched_barrier(0)
    Unit cur, nxt; int ui = 0;
    if (!S.next(0, cur)) return;
    f32x4 acc[2][2][4][2];
#pragma unroll
    for (int a = 0; a < 2; ++a)
#pragma unroll
        for (int b = 0; b < 2; ++b)
#pragma unroll
            for (int m = 0; m < 4; ++m)
#pragma unroll
                for (int n = 0; n < 2; ++n) acc[a][b][m][n] = (f32x4){0.f, 0.f, 0.f, 0.f};
    bf16x8 At[4][2], B0[2][2], B1[2][2];
    const char* cA = (const char*)g.A + (size_t)cur.pm * tstep; const char* cB = (const char*)g.Bt + (size_t)cur.pn * tstep;
    S.a_ready(cur);
    if constexpr (SP2) {
        PG8_STAGE(PG8_SB(0, 0), cB, voffB); PG8_STAGE(PG8_SB(0, 1), cB + hstep, voffB); PG8_STAGE(PG8_SA(0, 0), cA, voffA); PG8_STAGE(PG8_SA(0, 1), cA + hstep, voffA);
        if (wr == 1) PG8_BAR;
        PG8_WAIT_V(2); PG8_BAR;
        PG8_STAGE(PG8_SB(1, 0), cB + kstep, voffB); PG8_STAGE(PG8_SA(1, 0), cA + kstep, voffA); PG8_STAGE(PG8_SB(1, 1), cB + hstep + kstep, voffB);
        PG8_WAIT_V(6); PG8_BAR;
    } else {
        PG8_STAGE(PG8_SB(0, 0), cB, voffB); PG8_STAGE(PG8_SA(0, 0), cA, voffA); PG8_STAGE(PG8_SB(0, 1), cB + hstep, voffB); PG8_STAGE(PG8_SA(0, 1), cA + hstep, voffA);
        if (wr == 1) PG8_BAR;
        PG8_WAIT_V(4); PG8_BAR;
        PG8_STAGE(PG8_SB(1, 0), cB + kstep, voffB); PG8_STAGE(PG8_SA(1, 0), cA + kstep, voffA); PG8_STAGE(PG8_SB(1, 1), cB + hstep + kstep, voffB);
        PG8_WAIT_V(6); PG8_BAR;
    }
    for (;;) {
        const bool has_next = S.next(ui + 1, nxt);
        const char* nA = has_next ? (const char*)g.A + (size_t)nxt.pm * tstep : cA; const char* nB = has_next ? (const char*)g.Bt + (size_t)nxt.pn * tstep : cB;
        for (int t = 0; t < nt; t += 2) {
            const bool last = (t == nt - 2);
            const char* a1 = cA + (size_t)(t + 1) * kstep;
            const char* a2 = last ? nA : cA + (size_t)(t + 2) * kstep; const char* b2 = last ? nB : cB + (size_t)(t + 2) * kstep;
            const char* a3 = a2 + kstep; const char* b3 = b2 + kstep;
            if (last && has_next) S.a_ready(nxt);
            if constexpr (SP2) {
            PG8_LDB(B0, 0, 0); PG8_LDB(B1, 0, 1); PG8_SCHED; PG8_LDA(At, 0, 0); PG8_STAGE(PG8_SA(1, 1), a1 + hstep, voffA);
            PG8_WAIT_V(8); PG8_WAIT_L(0); PG8_BAR; PG8_MMA(0, 0, At, B0); PG8_MMA(0, 1, At, B1); PG8_BAR; PG8_SCHED;
            PG8_LDA(At, 0, 1); PG8_STAGE(PG8_SB(0, 0), b2, voffB); PG8_STAGE(PG8_SB(0, 1), b2 + hstep, voffB); PG8_STAGE(PG8_SA(0, 0), a2, voffA);
            PG8_WAIT_V(8); PG8_WAIT_L(0); PG8_BAR; PG8_MMA(1, 0, At, B0); PG8_MMA(1, 1, At, B1); PG8_BAR; PG8_SCHED;
            PG8_LDB(B0, 1, 0); PG8_LDB(B1, 1, 1); PG8_SCHED; PG8_LDA(At, 1, 0); PG8_STAGE(PG8_SA(0, 1), a2 + hstep, voffA);
            PG8_WAIT_V(8); PG8_WAIT_L(0); PG8_BAR; PG8_MMA(0, 0, At, B0); PG8_MMA(0, 1, At, B1); PG8_BAR; PG8_SCHED;
            PG8_LDA(At, 1, 1); PG8_STAGE(PG8_SB(1, 0), b3, voffB); PG8_STAGE(PG8_SB(1, 1), b3 + hstep, voffB); PG8_STAGE(PG8_SA(1, 0), a3, voffA);
            PG8_WAIT_V(8); PG8_WAIT_L(0); PG8_BAR; PG8_MMA(1, 0, At, B0); PG8_MMA(1, 1, At, B1); PG8_BAR; PG8_SCHED;
            } else {
            PG8_LDB(B0, 0, 0); PG8_SCHED; PG8_LDA(At, 0, 0); PG8_STAGE(PG8_SA(1, 1), a1 + hstep, voffA);
            PG8_WAIT_L(8); PG8_BAR; PG8_WAIT_L(0); PG8_MMA(0, 0, At, B0); PG8_BAR; PG8_SCHED;
            PG8_LDB(B1, 0, 1); PG8_STAGE(PG8_SB(0, 0), b2, voffB);
            PG8_BAR; PG8_WAIT_L(0); PG8_MMA(0, 1, At, B1); PG8_BAR;
            PG8_LDA(At, 0, 1); PG8_STAGE(PG8_SA(0, 0), a2, voffA);
            PG8_BAR; PG8_WAIT_L(0); PG8_MMA(1, 0, At, B0); PG8_BAR; PG8_SCHED;
            PG8_STAGE(PG8_SB(0, 1), b2 + hstep, voffB);
            PG8_WAIT_V(6); PG8_BAR; PG8_MMA(1, 1, At, B1); PG8_BAR;
            PG8_LDB(B0, 1, 0); PG8_SCHED; PG8_LDA(At, 1, 0); PG8_STAGE(PG8_SA(0, 1), a2 + hstep, voffA);
            PG8_WAIT_L(8); PG8_BAR; PG8_WAIT_L(0); PG8_MMA(0, 0, At, B0); PG8_BAR; PG8_SCHED;
            PG8_LDB(B1, 1, 1); PG8_STAGE(PG8_SB(1, 0), b3, voffB);
            PG8_BAR; PG8_WAIT_L(0); PG8_MMA(0, 1, At, B1); PG8_BAR;
            PG8_LDA(At, 1, 1); PG8_STAGE(PG8_SA(1, 0), a3, voffA);
            PG8_BAR; PG8_WAIT_L(0); PG8_MMA(1, 0, At, B0); PG8_BAR; PG8_SCHED;
            PG8_STAGE(PG8_SB(1, 1), b3 + hstep, voffB);
            PG8_WAIT_V(6); PG8_BAR; PG8_MMA(1, 1, At, B1); PG8_BAR;
            }
        }
        if constexpr (ALIGN_EPI) { if (wr == 0) PG8_BAR; }
        if constexpr (!Epi::AFTER_DRAIN) { int ln_; asm volatile("v_mbcnt_lo_u32_b32 %0, -1, 0\n\tv_mbcnt_hi_u32_b32 %0, -1, %0" : "=v"(ln_)); E(acc, cur, wr, wc, ln_ & 15, ln_ >> 4); S.done(cur); }
        if (!has_next) break;
#pragma unroll
        for (int a = 0; a < 2; ++a)
#pragma unroll
            for (int b = 0; b < 2; ++b)
#pragma unroll
                for (int m = 0; m < 4; ++m)
#pragma unroll
                    for (int n = 0; n < 2; ++n) acc[a][b][m][n] = (f32x4){0.f, 0.f, 0.f, 0.f};
        cur = nxt; cA = nA; cB = nB; ++ui;
        if constexpr (ALIGN_EPI) { if (wr == 1) PG8_BAR; }
    }
    PG8_WAIT_V(0);
    if constexpr (!ALIGN_EPI) { if (wr == 0) PG8_BAR; }
    PG8_BAR;
    if constexpr (Epi::AFTER_DRAIN) { E.fused(acc, cur, wr, wc, fr, fq, lds, wid, lane); S.done(cur); }
#undef PG8_SA
#undef PG8_SB
#undef PG8_STAGE
#undef PG8_LDA
#undef PG8_LDB
#undef PG8_MMA
#undef PG8_WAIT_V
#undef PG8_WAIT_L
#undef PG8_BAR
#undef PG8_SCHED
}
}

constexpr size_t MiB = 1u << 20;
constexpr size_t WS_CTL = 0, CTL_ZERO_BYTES = 1 * MiB;
constexpr size_t WS_WIN = 2 * MiB;
constexpr size_t WS_WOUT = 16 * MiB;
constexpr size_t WS_WST = 20 * MiB;
constexpr size_t WS_BT = 21 * MiB;
constexpr size_t WS_KMEAN = 22 * MiB;
constexpr size_t WS_LOFF = 23 * MiB;
constexpr size_t WS_ROWSS = 24 * MiB;
constexpr size_t WS_PL = 26 * MiB;
constexpr size_t WS_LIST = 30 * MiB;
constexpr size_t WS_SEL = 32 * MiB;
constexpr size_t WS_XB = 40 * MiB;
constexpr size_t WS_PROJ = 168 * MiB;
constexpr size_t WS_MIX = 392 * MiB;
constexpr size_t WS_END = 456 * MiB;
constexpr size_t SUBSTRIDE = (size_t)MROWS * 512;
enum { T_U = 0, T_V = 1, T_ZA = 2, T_Q = 3, T_K = 4, T_VV = 5, T_ZB = 6 };

constexpr int NWAVES = 8;
constexpr int LDS_BYTES = 160 * 1024;
constexpr int RING_BYTES = 131072;

#define LAS __attribute__((address_space(3)))
typedef unsigned short bf16;
typedef unsigned v4u __attribute__((ext_vector_type(4)));
typedef float f32x4 __attribute__((ext_vector_type(4)));
#define LDS_WAIT() asm volatile("s_waitcnt lgkmcnt(0)" ::: "memory")
__device__ __forceinline__ unsigned f2bf(float f) { unsigned u = __builtin_bit_cast(unsigned, f); return (u + 0x7fffu + ((u >> 16) & 1u)) >> 16; }
__device__ __forceinline__ unsigned pk2(float lo, float hi) { return f2bf(lo) | (f2bf(hi) << 16); }
__device__ __forceinline__ unsigned pk4_fp8(float a, float b, float c, float d) { int w = __builtin_amdgcn_cvt_pk_fp8_f32(a, b, 0, false); w = __builtin_amdgcn_cvt_pk_fp8_f32(c, d, w, true); return (unsigned)w; }
__device__ __forceinline__ float bflo(unsigned w) { return __uint_as_float(w << 16); }
__device__ __forceinline__ float bfhi(unsigned w) { return __uint_as_float(w & 0xffff0000u); }
__device__ __forceinline__ float wave_sum(float v) {
#pragma unroll
    for (int o = 1; o < 64; o <<= 1) v += lx_xor(v, o);
    return v;
}

__device__ __forceinline__ int lane_now() { int l; asm volatile("v_mbcnt_lo_u32_b32 %0, -1, 0\n\tv_mbcnt_hi_u32_b32 %0, -1, %0" : "=v"(l)); return l; }
struct Args { const float* in[10]; float* out; unsigned char* ws; int layer, pad; };

struct Ctx {
    unsigned char* lds;
    int tid, lane, wave, G, bid;
    const float *x, *norm_g, *w_in, *ln_g, *ln_b, *sgu_w, *sgu_b, *w_out, *rel_bias, *final_g;
    float* out; unsigned char* ws;
};

__device__ __forceinline__ void p0_transpose_item(const float* W, const float* gs, int K, int N, bf16* WT, float* scr, int item, int lane) {
    const int nblk = N / 32, kb = item / nblk, nb = item % nblk, k0 = 64 * kb, n0 = 32 * nb;
    float wv[32];
#pragma unroll
    for (int i = 0; i < 32; ++i) wv[i] = W[(size_t)(k0 + 2 * i + (lane >> 5)) * N + n0 + (lane & 31)];
#pragma unroll
    for (int i = 0; i < 32; ++i) { const int kk = 2 * i + (lane >> 5); const float sc = gs ? gs[k0 + kk] : 1.0f; scr[kk * 33 + (lane & 31)] = wv[i] * sc; }
    LDS_WAIT(); asm volatile("" ::: "memory");
    const int c = lane & 7;
#pragma unroll
    for (int j = 0; j < 4; ++j) { const int n = (lane >> 3) + 8 * j; const float* s = scr + (8 * c) * 33 + n;
        v4u o; o.x = pk2(s[0 * 33], s[1 * 33]); o.y = pk2(s[2 * 33], s[3 * 33]); o.z = pk2(s[4 * 33], s[5 * 33]); o.w = pk2(s[6 * 33], s[7 * 33]);
        *(v4u*)(WT + (size_t)(n0 + n) * K + k0 + 8 * c) = o; }
    LDS_WAIT(); asm volatile("" ::: "memory");
}
__device__ __forceinline__ int rel_bucket(int d) {
    if (d < 16) return d;
    int b = 16;
    b += (d >= 19); b += (d >= 21); b += (d >= 24); b += (d >= 27); b += (d >= 31); b += (d >= 35); b += (d >= 40); b += (d >= 46);
    b += (d >= 52); b += (d >= 59); b += (d >= 67); b += (d >= 77); b += (d >= 87); b += (d >= 99); b += (d >= 113);
    return b;
}
__device__ __forceinline__ void phase_prologue(const Ctx& C) {
    float* scr = (float*)(C.lds + C.wave * 16384);
    const int gw = C.bid * NWAVES + C.wave, NGW = C.G * NWAVES;
    constexpr int I_IN = (DM / 64) * (DIN / 32), I_OUT = (DM / 64) * (DM / 32);
    constexpr int NITEMS = DEPTH * (I_IN + I_OUT);
    for (int it = gw; it < NITEMS; it += NGW) {
        const int l = it / (I_IN + I_OUT); int r = it % (I_IN + I_OUT);
        if (r < I_IN) p0_transpose_item(C.w_in + (size_t)l * DM * DIN, C.norm_g + l * DM, DM, DIN, (bf16*)(C.ws + WS_WIN) + (size_t)l * DIN * DM, scr, r, C.lane);
        else p0_transpose_item(C.w_out + (size_t)l * DM * DM, nullptr, DM, DM, (bf16*)(C.ws + WS_WOUT) + (size_t)l * DM * DM, scr, r - I_IN, C.lane);
    }
    { float* km = (float*)(C.ws + WS_KMEAN); for (int e = C.bid * 512 + C.tid; e < DEPTH * NBH * NBLK * 64; e += C.G * 512) km[e] = 0.f; }
    { bf16* wst = (bf16*)(C.ws + WS_WST); const int gt = C.bid * 512 + C.tid, NT = C.G * 512;
      for (int e = gt; e < DEPTH * 8 * 128 * 128; e += NT) { const int s = e & 127, t = (e >> 7) & 127; wst[e] = (s <= t) ? (bf16)f2bf(C.sgu_w[e]) : (bf16)0; } }
    if (C.bid == 0) { float* bt = (float*)(C.ws + WS_BT); for (int e = C.tid; e < 8 * 128; e += 512) { const int h = e >> 7, d = e & 127; bt[e] = C.rel_bias[rel_bucket(d) * 8 + h] * LOG2E; } }
    { bf16* xb = (bf16*)(C.ws + WS_XB); float* rowss = (float*)(C.ws + WS_ROWSS);
      constexpr int UN = 4;
      for (int m0 = gw; m0 < MROWS; m0 += NGW * UN) {
        f32x4 v[UN][4];
#pragma unroll
        for (int k = 0; k < UN; ++k) { const f32x4* xr = (const f32x4*)(C.x + (size_t)(m0 + k * NGW) * DM) + C.lane;
#pragma unroll
            for (int j = 0; j < 4; ++j) v[k][j] = xr[64 * j]; }
#pragma unroll
        for (int k = 0; k < UN; ++k) { const int m = m0 + k * NGW;
            float s = 0.f;
#pragma unroll
            for (int j = 0; j < 4; ++j) s += (v[k][j].x * v[k][j].x + v[k][j].y * v[k][j].y) + (v[k][j].z * v[k][j].z + v[k][j].w * v[k][j].w);
            s = wave_sum(s);
            unsigned long long* o8 = (unsigned long long*)(xb + (size_t)m * DM) + C.lane;
#pragma unroll
            for (int j = 0; j < 4; ++j) o8[64 * j] = (unsigned long long)pk2(v[k][j].x, v[k][j].y) | ((unsigned long long)pk2(v[k][j].z, v[k][j].w) << 32);
            if (C.lane < 16) rowss[(size_t)m * 16 + C.lane] = (C.lane == 0) ? s : 0.f; }
      } }
}

typedef short bf16x8 __attribute__((ext_vector_type(8)));
typedef short bf16x4s __attribute__((ext_vector_type(4)));
typedef float f32x16 __attribute__((ext_vector_type(16)));
typedef int v8i_t __attribute__((ext_vector_type(8)));
__device__ __forceinline__ int at_vpos(int kv) { return (kv & ~63) + 32 * ((kv >> 2) & 1) + 16 * ((kv >> 5) & 1) + (kv & 3) + 4 * ((kv >> 3) & 3); }
__device__ __forceinline__ int crow(int r, int hi) { return (r & 3) + 8 * (r >> 2) + 4 * hi; }
__device__ __forceinline__ unsigned cvtpk(float lo, float hi) { unsigned r; asm volatile("v_cvt_pk_bf16_f32 %0, %1, %2" : "=v"(r) : "v"(lo), "v"(hi)); return r; }
__device__ __forceinline__ void phase_gate(const Ctx& C, int layer) {
    const bf16* Q = (const bf16*)(C.ws + WS_PROJ) + (size_t)T_Q * SUBSTRIDE;
    const float* KM = (const float*)(C.ws + WS_KMEAN) + (size_t)layer * NBH * NBLK * 64;
    int* SEL = (int*)(C.ws + WS_SEL); int* LOFF = (int*)(C.ws + WS_LOFF); unsigned short* LIST = (unsigned short*)(C.ws + WS_LIST);
    int* cnt = (int*)(C.lds);
    int* offs = (int*)(C.lds + 256);
    unsigned char* kml = C.lds + 1024;
    const int lane = C.lane, ql = lane & 31, hi = lane >> 5;
    bf16x8 qfN[4]; f32x4 kmr[2];
#define GATE_LOAD(uu) do { const int bh_ = (uu) / 63, i_ = (uu) % 63 + 1, b_ = bh_ >> 3, h_ = bh_ & 7; \
        const bf16* qrow_ = Q + ((size_t)(b_ * SEQ + i_ * 256 + C.wave * 32 + ql)) * 512 + h_ * 64 + hi * 8; \
        _Pragma("unroll") for (int ks = 0; ks < 4; ++ks) qfN[ks] = *(const bf16x8*)(qrow_ + ks * 16); \
        const float* kp_ = KM + (size_t)bh_ * NBLK * 64 + C.tid * 8; kmr[0] = *(const f32x4*)kp_; kmr[1] = *(const f32x4*)(kp_ + 4); } while (0)
#define GATE_KML() do { *(v4u*)(kml + (C.tid >> 3) * 144 + (C.tid & 7) * 16) = (v4u){cvtpk(kmr[0][0], kmr[0][1]), cvtpk(kmr[0][2], kmr[0][3]), cvtpk(kmr[1][0], kmr[1][1]), cvtpk(kmr[1][2], kmr[1][3])}; } while (0)
    int u = C.bid;
    if (C.tid < 64) cnt[C.tid] = 0;
    if (u < NBH * 63) { GATE_LOAD(u); GATE_KML(); }
    __syncthreads();
    for (; u < NBH * 63; u += C.G) {
        const int bh = u / 63, i = u % 63 + 1;
        const int q = C.wave * 32 + ql, pos = i * 256 + q;
        bf16x8 qf[4];
#pragma unroll
        for (int ks = 0; ks < 4; ++ks) qf[ks] = qfN[ks];
        const bool more = u + C.G < NBH * 63;
        if (more) GATE_LOAD(u + C.G);
        float b0 = -INFINITY, b1 = -INFINITY, b2 = -INFINITY; int i0 = -1, i1 = -1, i2 = -1;
#define TOP3_INS(v, idx) do { const float v_ = (v); const int x_ = (idx); if (v_ > b0) { b2 = b1; i2 = i1; b1 = b0; i1 = i0; b0 = v_; i0 = x_; } else if (v_ > b1) { b2 = b1; i2 = i1; b1 = v_; i1 = x_; } else if (v_ > b2) { b2 = v_; i2 = x_; } } while (0)
#pragma unroll
        for (int nt = 0; nt < 2; ++nt) {
            f32x16 p = {};
#pragma unroll
            for (int ks = 0; ks < 4; ++ks) {
                const bf16x8 kw = *(const bf16x8*)(kml + (32 * nt + ql) * 144 + ks * 32 + hi * 16);
                p = __builtin_amdgcn_mfma_f32_32x32x16_bf16(kw, qf[ks], p, 0, 0, 0);
            }
#pragma unroll
            for (int r = 0; r < 16; ++r) { const int n = 32 * nt + crow(r, hi); if (n < i) TOP3_INS(p[r], n); }
        }
        { const float c0 = lx_xor(b0, 32), c1 = lx_xor(b1, 32), c2 = lx_xor(b2, 32);
          const int j0 = lx_xor(i0, 32), j1 = lx_xor(i1, 32), j2 = lx_xor(i2, 32);
          if (j0 >= 0) TOP3_INS(c0, j0);
          if (j1 >= 0) TOP3_INS(c1, j1);
          if (j2 >= 0) TOP3_INS(c2, j2); }
#undef TOP3_INS
        int p0 = 0, p1 = 0, p2 = 0;
        if (hi == 0) {
            if (CHECK_ATTN) { int* sp = SEL + ((size_t)bh * SEQ + pos) * 4; sp[0] = i0; sp[1] = i1; sp[2] = i2; sp[3] = -1; }
            p0 = atomicAdd(&cnt[i0], 1);
            if (i1 >= 0) p1 = atomicAdd(&cnt[i1], 1);
            if (i2 >= 0) p2 = atomicAdd(&cnt[i2], 1);
        }
        __syncthreads();
        if (C.tid < 64) {
            const int c = cnt[C.tid]; cnt[C.tid] = 0;
            int inc = c;
#pragma unroll
            for (int o = 1; o < 64; o <<= 1) { const int t = lx_up(inc, o); if (C.tid >= o) inc += t; }
            offs[C.tid + 1] = inc; if (C.tid == 0) offs[0] = 0;
            LOFF[(size_t)(bh * NBLK + i) * 80 + C.tid + 1] = inc; if (C.tid == 0) LOFF[(size_t)(bh * NBLK + i) * 80] = 0;
        }
        if (more) GATE_KML();
        __syncthreads();
        if (hi == 0) {
            unsigned short* lp = LIST + (size_t)(bh * NBLK + i) * 768;
            lp[offs[i0] + p0] = (unsigned short)(q | (0 << 8));
            if (i1 >= 0) lp[offs[i1] + p1] = (unsigned short)(q | (1 << 8));
            if (i2 >= 0) lp[offs[i2] + p2] = (unsigned short)(q | (2 << 8));
        }
    }
#undef GATE_LOAD
#undef GATE_KML
    if (CHECK_ATTN) { for (int e = C.bid * 512 + C.tid; e < NBH * 256; e += C.G * 512) { const int bh = e >> 8, qq = e & 255; int* sp = SEL + ((size_t)bh * SEQ + qq) * 4; sp[0] = -1; sp[1] = -1; sp[2] = -1; sp[3] = -1; } }
    __syncthreads();
}

__device__ __forceinline__ void phase_attn_simple(const Ctx& C, bf16* MIX) {
    const bf16* Q = (const bf16*)(C.ws + WS_PROJ) + (size_t)T_Q * SUBSTRIDE;
    const bf16* K = (const bf16*)(C.ws + WS_PROJ) + (size_t)T_K * SUBSTRIDE;
    const bf16* VV = (const bf16*)(C.ws + WS_PROJ) + (size_t)T_VV * SUBSTRIDE;
    const bf16* ZB = (const bf16*)(C.ws + WS_PROJ) + (size_t)T_ZB * SUBSTRIDE;
    const int* SEL = (const int*)(C.ws + WS_SEL); const float* BT = (const float*)(C.ws + WS_BT);
    const int gt = C.bid * 512 + C.tid, NT = C.G * 512;
    for (int item = gt; item < NBH * SEQ; item += NT) {
        const int bh = item >> 14, pos = item & (SEQ - 1), b = bh >> 3, h = bh & 7, own = pos >> 8;
        const size_t rowq = (size_t)(b * SEQ + pos);
        float qv[64], o[64];
        { const v4u* qp = (const v4u*)(Q + rowq * 512 + h * 64);
#pragma unroll
          for (int c = 0; c < 8; ++c) { const v4u v = qp[c]; qv[8 * c + 0] = bflo(v.x); qv[8 * c + 1] = bfhi(v.x); qv[8 * c + 2] = bflo(v.y); qv[8 * c + 3] = bfhi(v.y);
              qv[8 * c + 4] = bflo(v.z); qv[8 * c + 5] = bfhi(v.z); qv[8 * c + 6] = bflo(v.w); qv[8 * c + 7] = bfhi(v.w); } }
#pragma unroll
        for (int d = 0; d < 64; ++d) o[d] = 0.f;
        float m = -INFINITY, l = 0.f;
        const float* bt = BT + h * 128;
        for (int slot = 0; slot < 4; ++slot) {
            int blk, klim;
            if (slot == 0) { blk = own; klim = (pos & 255) + 1; } else { blk = SEL[(size_t)item * 4 + slot - 1]; klim = 256; if (blk < 0) klim = 0; }
            for (int kl = 0; kl < klim; ++kl) {
                const int kpos = blk * 256 + kl;
                const v4u* kp = (const v4u*)(K + ((size_t)(b * SEQ + kpos)) * 512 + h * 64);
                float a0 = 0.f, a1 = 0.f;
#pragma unroll
                for (int c = 0; c < 8; ++c) { const v4u v = kp[c];
                    a0 += qv[8 * c + 0] * bflo(v.x) + qv[8 * c + 2] * bflo(v.y) + qv[8 * c + 4] * bflo(v.z) + qv[8 * c + 6] * bflo(v.w);
                    a1 += qv[8 * c + 1] * bfhi(v.x) + qv[8 * c + 3] * bfhi(v.y) + qv[8 * c + 5] * bfhi(v.z) + qv[8 * c + 7] * bfhi(v.w); }
                int dd = pos - kpos; dd = dd > 127 ? 127 : dd;
                const float s = (a0 + a1) + bt[dd];
                if (s > m) { const float al = __builtin_amdgcn_exp2f(m - s); l *= al;
#pragma unroll
                    for (int d = 0; d < 64; ++d) o[d] *= al;
                    m = s; }
                const float p = __builtin_amdgcn_exp2f(s - m);
                l += p;
                const v4u* vp = (const v4u*)(VV + ((size_t)(b * SEQ + kpos)) * 512 + h * 64);
#pragma unroll
                for (int c = 0; c < 8; ++c) { const v4u v = vp[c];
                    o[8 * c + 0] += p * bflo(v.x); o[8 * c + 1] += p * bfhi(v.x); o[8 * c + 2] += p * bflo(v.y); o[8 * c + 3] += p * bfhi(v.y);
                    o[8 * c + 4] += p * bflo(v.z); o[8 * c + 5] += p * bfhi(v.z); o[8 * c + 6] += p * bflo(v.w); o[8 * c + 7] += p * bfhi(v.w); }
            }
        }
        const float rl = 1.0f / l;
        const v4u* zp = (const v4u*)(ZB + rowq * 512 + h * 64);
        v4u* op = (v4u*)(MIX + rowq * 1024 + 512 + h * 64);
#pragma unroll
        for (int c = 0; c < 8; ++c) { const v4u z = zp[c]; v4u w;
            w.x = pk2(o[8 * c + 0] * rl * pg8::act_silu(bflo(z.x)), o[8 * c + 1] * rl * pg8::act_silu(bfhi(z.x))); w.y = pk2(o[8 * c + 2] * rl * pg8::act_silu(bflo(z.y)), o[8 * c + 3] * rl * pg8::act_silu(bfhi(z.y)));
            w.z = pk2(o[8 * c + 4] * rl * pg8::act_silu(bflo(z.z)), o[8 * c + 5] * rl * pg8::act_silu(bfhi(z.z))); w.w = pk2(o[8 * c + 6] * rl * pg8::act_silu(bflo(z.w)), o[8 * c + 7] * rl * pg8::act_silu(bfhi(z.w)));
            op[c] = w; }
    }
}

constexpr int AT_KS = 0, AT_KPITCH = 144;
constexpr int AT_VT = 36864, AT_VPITCH = 272;
constexpr int AT_DT = AT_VT + 64 * AT_VPITCH;
constexpr int AT_ENT = AT_DT + 4096, AT_CAP = 4096;
constexpr int AT_PRE = AT_ENT + AT_CAP * 4;
constexpr int AT_OST = AT_PRE + 1024;
constexpr int AT_MISC = AT_OST + 8 * 4096;
constexpr int AT_NUNITS = NBLK * NBH;

typedef int v4i_t __attribute__((ext_vector_type(4)));
#ifndef ATTN_STATIC_PRIO
#define ATTN_STATIC_PRIO 1
#endif
#if ATTN_STATIC_PRIO
#define ATTN_PRIO_UP
#define ATTN_PRIO_DN
#else
#define ATTN_PRIO_UP __builtin_amdgcn_s_setprio(1)
#define ATTN_PRIO_DN __builtin_amdgcn_s_setprio(0)
#endif
struct QTile { unsigned ent; v4i_t qf[4]; };
__device__ __forceinline__ void attn_issue_q(QTile& T, const Ctx& C, const unsigned char* lds, int b, int h, int e0, int cnt) {
    const bf16* Q = (const bf16*)(C.ws + WS_PROJ) + (size_t)T_Q * SUBSTRIDE;
    const unsigned* ENT = (const unsigned*)(lds + AT_ENT);
    const int q = C.lane & 31, hi = C.lane >> 5;
    T.ent = ENT[(e0 + q < cnt) ? (e0 + q) : e0];
    const bf16* qrow = Q + ((size_t)(b * SEQ + (int)(T.ent & 16383u))) * 512 + h * 64 + hi * 8;
    asm volatile("global_load_dwordx4 %0, %4, off\n\tglobal_load_dwordx4 %1, %4, off offset:32\n\tglobal_load_dwordx4 %2, %4, off offset:64\n\tglobal_load_dwordx4 %3, %4, off offset:96"
                 : "=&v"(T.qf[0]), "=&v"(T.qf[1]), "=&v"(T.qf[2]), "=&v"(T.qf[3]) : "v"(qrow));
}
__device__ __forceinline__ void attn_wait_q(QTile& T) { asm volatile("s_waitcnt vmcnt(0)" : "+v"(T.qf[0]), "+v"(T.qf[1]), "+v"(T.qf[2]), "+v"(T.qf[3])); }
__device__ __forceinline__ void attn_tile(const Ctx& C, unsigned char* lds, const QTile& T, QTile& Tn, int bh, int e0, int cnt, int nkt2, const bool OWN) {
    bf16* PO = (bf16*)C.out; float* PL = (float*)(C.ws + WS_PL);
    const unsigned* ENT = (const unsigned*)(lds + AT_ENT);
    const int lane = C.lane, q = lane & 31, hi = lane >> 5;
    const unsigned ent = T.ent;
    const int pos = ent & 16383, qoff = (ent >> 16) & 1023;
    f32x16 o0 = {}, o1 = {}, ol = {};
    v8i_t pa8 = {};
    asm volatile("" : "+v"(pa8));
    const bool anybias = OWN ? true : (__any(qoff < 112) != 0);
    const unsigned char* kbase = lds + AT_KS + q * AT_KPITCH + hi * 16;
    const unsigned char* vbase = lds + AT_VT + q * AT_VPITCH + hi * 32;
    const float* et0 = (const float*)(lds + AT_DT) + (1023 - (256 + (OWN ? 0 : 256) + qoff - 4 * hi));
    bf16x8 kf[8];
#pragma unroll
    for (int ks = 0; ks < 4; ++ks) { kf[2 * ks] = *(const bf16x8*)(kbase + ks * 32); kf[2 * ks + 1] = *(const bf16x8*)(kbase + 32 * AT_KPITCH + ks * 32); }
    for (int kt2 = 0; kt2 < nkt2; ++kt2) {
        f32x16 p0, p1;
        if (anybias && (OWN || kt2 >= 2)) {
            const float* et = et0 + 64 * kt2;
#pragma unroll
            for (int r = 0; r < 16; ++r) { p0[r] = et[(r & 3) + 8 * (r >> 2)]; p1[r] = et[32 + (r & 3) + 8 * (r >> 2)]; }
#pragma unroll
            for (int ks = 0; ks < 4; ++ks) {
                p0 = __builtin_amdgcn_mfma_f32_32x32x16_bf16(kf[2 * ks], __builtin_bit_cast(bf16x8, T.qf[ks]), p0, 0, 0, 0);
                p1 = __builtin_amdgcn_mfma_f32_32x32x16_bf16(kf[2 * ks + 1], __builtin_bit_cast(bf16x8, T.qf[ks]), p1, 0, 0, 0);
            }
        } else {
            p0 = (f32x16){}; p1 = (f32x16){};
#pragma unroll
            for (int ks = 0; ks < 4; ++ks) {
                p0 = __builtin_amdgcn_mfma_f32_32x32x16_bf16(kf[2 * ks], __builtin_bit_cast(bf16x8, T.qf[ks]), p0, 0, 0, 0);
                p1 = __builtin_amdgcn_mfma_f32_32x32x16_bf16(kf[2 * ks + 1], __builtin_bit_cast(bf16x8, T.qf[ks]), p1, 0, 0, 0);
            }
        }
        v8i_t vb0, vb1;
        { typedef int v4i_t __attribute__((ext_vector_type(4)));
          const v4i_t a0 = *(const v4i_t*)(vbase + 64 * kt2), a1 = *(const v4i_t*)(vbase + 64 * kt2 + 16);
          const v4i_t c0 = *(const v4i_t*)(vbase + 32 * AT_VPITCH + 64 * kt2), c1 = *(const v4i_t*)(vbase + 32 * AT_VPITCH + 64 * kt2 + 16);
          vb0 = __builtin_shufflevector(a0, a1, 0, 1, 2, 3, 4, 5, 6, 7); vb1 = __builtin_shufflevector(c0, c1, 0, 1, 2, 3, 4, 5, 6, 7); }
#pragma unroll
        for (int r = 0; r < 16; ++r) { p0[r] = __builtin_amdgcn_exp2f(p0[r]); p1[r] = __builtin_amdgcn_exp2f(p1[r]); }
        { typedef short v2s_t __attribute__((ext_vector_type(2)));
#pragma unroll
          for (int i = 0; i < 4; ++i) {
              v2s_t w = __builtin_bit_cast(v2s_t, pa8[i]);
              w = __builtin_amdgcn_cvt_scalef32_pk_fp8_f32(w, p0[4 * i], p0[4 * i + 1], 16.0f, false); w = __builtin_amdgcn_cvt_scalef32_pk_fp8_f32(w, p0[4 * i + 2], p0[4 * i + 3], 16.0f, true);
              pa8[i] = __builtin_bit_cast(int, w);
              v2s_t z = __builtin_bit_cast(v2s_t, pa8[4 + i]);
              z = __builtin_amdgcn_cvt_scalef32_pk_fp8_f32(z, p1[4 * i], p1[4 * i + 1], 16.0f, false); z = __builtin_amdgcn_cvt_scalef32_pk_fp8_f32(z, p1[4 * i + 2], p1[4 * i + 3], 16.0f, true);
              pa8[4 + i] = __builtin_bit_cast(int, z);
          } }
        if (kt2 + 1 < nkt2) {
#pragma unroll
            for (int ks = 0; ks < 4; ++ks) { kf[2 * ks] = *(const bf16x8*)(kbase + (64 * kt2 + 64) * AT_KPITCH + ks * 32); kf[2 * ks + 1] = *(const bf16x8*)(kbase + (64 * kt2 + 96) * AT_KPITCH + ks * 32); }
        }
        ATTN_PRIO_UP;
        o0 = __builtin_amdgcn_mfma_scale_f32_32x32x64_f8f6f4(vb0, pa8, o0, 0, 0, 0, 0x7f7f7f7f, 0, (int)0x83838383);
        o1 = __builtin_amdgcn_mfma_scale_f32_32x32x64_f8f6f4(vb1, pa8, o1, 0, 0, 0, 0x7f7f7f7f, 0, (int)0x83838383);
        v8i_t ones8;
#pragma unroll
        for (int i = 0; i < 8; ++i) { int c_; asm volatile("v_mov_b32 %0, 0x38383838" : "=v"(c_)); ones8[i] = c_; }
        ol = __builtin_amdgcn_mfma_scale_f32_32x32x64_f8f6f4(ones8, pa8, ol, 0, 0, 0, 0x7f7f7f7f, 0, (int)0x83838383);
        ATTN_PRIO_DN;
    }
    const float l = ol[0];
    attn_wait_q(Tn);
    if (e0 + q < cnt) PL[((size_t)bh * SEQ + pos) * 4 + ((ent >> 14) & 3)] = l;
    { bf16* prow = PO + (((size_t)bh * SEQ + pos) * 4 + ((ent >> 14) & 3)) * 64 + hi * 8;
      const bool live = e0 + q < cnt;
#pragma unroll
      for (int j = 0; j < 2; ++j) {
          unsigned a0 = pg8::cvt_pk_bf16(o0[8 * j], o0[8 * j + 1]), a1 = pg8::cvt_pk_bf16(o0[8 * j + 2], o0[8 * j + 3]), b0 = pg8::cvt_pk_bf16(o0[8 * j + 4], o0[8 * j + 5]), b1 = pg8::cvt_pk_bf16(o0[8 * j + 6], o0[8 * j + 7]);
          { auto r0 = __builtin_amdgcn_permlane32_swap(a0, b0, false, false); a0 = r0[0]; b0 = r0[1]; auto r1 = __builtin_amdgcn_permlane32_swap(a1, b1, false, false); a1 = r1[0]; b1 = r1[1]; }
          unsigned c0 = pg8::cvt_pk_bf16(o1[8 * j], o1[8 * j + 1]), c1 = pg8::cvt_pk_bf16(o1[8 * j + 2], o1[8 * j + 3]), d0 = pg8::cvt_pk_bf16(o1[8 * j + 4], o1[8 * j + 5]), d1 = pg8::cvt_pk_bf16(o1[8 * j + 6], o1[8 * j + 7]);
          { auto r0 = __builtin_amdgcn_permlane32_swap(c0, d0, false, false); c0 = r0[0]; d0 = r0[1]; auto r1 = __builtin_amdgcn_permlane32_swap(c1, d1, false, false); c1 = r1[0]; d1 = r1[1]; }
          if (live) { *(v4u*)(prow + 16 * j) = (v4u){a0, a1, b0, b1}; *(v4u*)(prow + 32 + 16 * j) = (v4u){c0, c1, d0, d1}; }
      } }
}

__device__ __forceinline__ void phase_attn(const Ctx& C, int layer) {
    if (ATTN_STATIC_PRIO && C.wave >= 4) __builtin_amdgcn_s_setprio(2);
    unsigned char* lds = C.lds;
    const bf16* K = (const bf16*)(C.ws + WS_PROJ) + (size_t)T_K * SUBSTRIDE;
    const bf16* VV = (const bf16*)(C.ws + WS_PROJ) + (size_t)T_VV * SUBSTRIDE;
    const int* LOFF = (const int*)(C.ws + WS_LOFF); const unsigned short* LIST = (const unsigned short*)(C.ws + WS_LIST);
    const float* BT = (const float*)(C.ws + WS_BT);
    const int qg = C.bid & 7;
    unsigned* ctr = (unsigned*)(C.ws + WS_CTL) + 64 + 64 * layer;
    int qstep = 0;
    unsigned* ENT = (unsigned*)(lds + AT_ENT);
    int* PRE = (int*)(lds + AT_PRE); int* LO = PRE + 68;
    volatile unsigned* MISC = (volatile unsigned*)(lds + AT_MISC);
    int tid = C.tid;
    v4u kpre[4], vpre[4]; int lpre0 = 0, lpre1 = 0;
#define AT_LOADKV(uu) do { const int bh_ = (uu) & 15, n_ = (uu) >> 4; \
        const bf16* Kg = K + ((size_t)((bh_ >> 3) * SEQ + n_ * 256)) * 512 + (bh_ & 7) * 64; const bf16* Vg = VV + ((size_t)((bh_ >> 3) * SEQ + n_ * 256)) * 512 + (bh_ & 7) * 64; \
        _Pragma("unroll") for (int it = 0; it < 4; ++it) { const int idx = tid + 512 * it; kpre[it] = *(const v4u*)(Kg + (size_t)(idx >> 3) * 512 + (idx & 7) * 8); \
            vpre[it] = *(const v4u*)(Vg + (size_t)(idx >> 3) * 512 + (idx & 7) * 8); } \
        lpre0 = 0; lpre1 = 0; if (tid < 64 && n_ + 1 + tid < NBLK) { const int* lp_ = LOFF + ((size_t)(bh_ * NBLK + n_ + 1 + tid)) * 80 + n_; lpre0 = lp_[0]; lpre1 = lp_[1]; } } while (0)
#define AT_FETCH() ({ unsigned r_ = (unsigned)AT_NUNITS; while (qstep < 8) { const int g_ = (qg + qstep) & 7; const unsigned k_ = atomicAdd(ctr + 4 * g_, 1u); \
        if (k_ < 2u * NBLK) { r_ = (k_ >> 1) * 16 + 2 * g_ + (k_ & 1); break; } ++qstep; } r_; })
    if (tid == 0) MISC[0] = AT_FETCH();
    __syncthreads();
    int u = (int)MISC[0];
    if (u < AT_NUNITS) AT_LOADKV(u);
    while (u < AT_NUNITS) {
        asm volatile("" : "+v"(tid));
        Ctx Cu = C; Cu.tid = tid; Cu.lane = tid & 63;
        const int bh = u & 15, n = u >> 4, b = bh >> 3, h = bh & 7;
        if (tid == 0) MISC[1] = AT_FETCH();
#pragma unroll
        for (int it = 0; it < 4; ++it) { const int idx = tid + 512 * it;
            *(v4u*)(lds + AT_KS + (idx >> 3) * AT_KPITCH + (idx & 7) * 16) = kpre[it];
            const v4u v = vpre[it];
            unsigned char* vt = lds + AT_VT + (8 * (idx & 7)) * AT_VPITCH + at_vpos(idx >> 3);
            const unsigned w01 = pk4_fp8(bflo(v.x), bfhi(v.x), bflo(v.y), bfhi(v.y)), w23 = pk4_fp8(bflo(v.z), bfhi(v.z), bflo(v.w), bfhi(v.w));
            vt[0 * AT_VPITCH] = (unsigned char)(w01); vt[1 * AT_VPITCH] = (unsigned char)(w01 >> 8); vt[2 * AT_VPITCH] = (unsigned char)(w01 >> 16); vt[3 * AT_VPITCH] = (unsigned char)(w01 >> 24);
            vt[4 * AT_VPITCH] = (unsigned char)(w23); vt[5 * AT_VPITCH] = (unsigned char)(w23 >> 8); vt[6 * AT_VPITCH] = (unsigned char)(w23 >> 16); vt[7 * AT_VPITCH] = (unsigned char)(w23 >> 24); }
        { float* et_ = (float*)(lds + AT_DT);
#pragma unroll
          for (int k_ = 0; k_ < 2; ++k_) { const int j_ = tid + 512 * k_, d_ = j_ - 256; et_[1023 - j_] = d_ < 0 ? -INFINITY : (d_ < 128 ? BT[h * 128 + d_] - BT[h * 128 + 127] : 0.f);     } }
        if (tid < 64) {
            const int lo = lpre0; int inc = lpre1 - lpre0;
#pragma unroll
            for (int o = 1; o < 64; o <<= 1) { const int t = lx_up(inc, o); if (tid >= o) inc += t; }
            PRE[tid + 1] = inc; LO[tid] = lo; if (tid == 0) PRE[0] = 0;
        }
        __syncthreads();
        const int total = 256 + PRE[63 - n];
        const int unext = (int)MISC[1];
        if (unext < AT_NUNITS) AT_LOADKV(unext);
        for (int base = 0; base < total; base += AT_CAP) {
            const int cnt = (total - base < AT_CAP) ? (total - base) : AT_CAP;
            if (base == 0 && tid < 256) ENT[tid] = (unsigned)(n * 256 + tid) | (3u << 14) | ((unsigned)tid << 16);
            { const int e_lo = base > 256 ? base : 256, e_hi = base + cnt;
#pragma unroll 4
              for (int e = e_lo + tid; e < e_hi; e += 512) {
                  const int es = e - 256; int a = 0, z = 63 - n;
#pragma unroll
                  for (int it = 0; it < 6; ++it) { const int mid = (a + z) >> 1; const bool up = (z - a > 1) && (PRE[mid] <= es); const bool dn = (z - a > 1) && !up; a = up ? mid : a; z = dn ? mid : z; }
                  const int ii = a, i = n + 1 + ii;
                  const unsigned val = LIST[((size_t)(bh * NBLK + i)) * 768 + LO[ii] + (es - PRE[ii])]; const unsigned ql = val & 255u, j = val >> 8;
                  ENT[e - base] = (unsigned)(i * 256 + ql) | (j << 14) | ((ii == 0 ? ql : 400u) << 16);
              } }
            if (tid == 0) MISC[2] = 0u;
            __syncthreads();
            const int ntiles = (cnt + 31) >> 5;
            const int nown = (base == 0) ? 8 : 0;
#define AT_TICKET() ({ int tk_ = 0; if (Cu.lane == 0) tk_ = (int)atomicAdd((unsigned*)(lds + AT_MISC + 8), 1u); __builtin_amdgcn_readfirstlane(tk_); })
#define AT_TILEOF(tk_) (((tk_) < ntiles - nown) ? nown + (tk_) : (ntiles - 1 - (tk_)))
            { int tk = AT_TICKET();
              if (tk < ntiles) {
                  int tile = AT_TILEOF(tk);
                  QTile Tc; attn_issue_q(Tc, Cu, lds, b, h, tile * 32, cnt); attn_wait_q(Tc);
                  for (;;) {
                      const int tkn = AT_TICKET(); const bool more = tkn < ntiles; const int tilen = more ? AT_TILEOF(tkn) : 0;
                      QTile Tn; attn_issue_q(Tn, Cu, lds, b, h, tilen * 32, cnt);
                      { const bool own_ = tile < nown; attn_tile(Cu, lds, Tc, Tn, bh, tile * 32, cnt, own_ ? (tile >> 1) + 1 : 4, own_); }
                      if (!more) break;
                      Tc = Tn; tile = tilen;
                  }
              } }
#undef AT_TICKET
#undef AT_TILEOF
            __syncthreads();
        }
        u = unext;
    }
#undef AT_LOADKV
#undef AT_FETCH
    if (ATTN_STATIC_PRIO) __builtin_amdgcn_s_setprio(0);
}

__device__ __forceinline__ void phase_combine(const Ctx& C) {
    const bf16* PO = (const bf16*)C.out; const float* PL = (const float*)(C.ws + WS_PL);
    const bf16* ZB = (const bf16*)(C.ws + WS_PROJ) + (size_t)T_ZB * SUBSTRIDE;
    bf16* MIX = (bf16*)(C.ws + WS_MIX);
    const int gt = C.bid * 512 + C.tid, NT = C.G * 512;
    constexpr int UN = 4;
    for (int idx0 = gt; idx0 < MROWS * 64; idx0 += NT * UN) {
        f32x4 lv[UN]; v4u pv[UN][4]; v4u zv[UN];
#pragma unroll
        for (int k = 0; k < UN; ++k) {
            const int idx = idx0 + k * NT;
            const int ch = idx & 7, h = (idx >> 3) & 7, row = idx >> 6, b = row >> 14, pos = row & (SEQ - 1), i = pos >> 8;
            const size_t pb = ((size_t)(b * NH + h) * SEQ + pos) * 4;
            lv[k] = *(const f32x4*)(PL + pb);
#pragma unroll
            for (int j = 0; j < 4; ++j) pv[k][j] = (j == 3 || j < i) ? *(const v4u*)(PO + (pb + j) * 64 + ch * 8) : (v4u){0u, 0u, 0u, 0u};
            zv[k] = *(const v4u*)(ZB + (size_t)row * 512 + h * 64 + ch * 8);
        }
#pragma unroll
        for (int k = 0; k < UN; ++k) {
            const int idx = idx0 + k * NT;
            const int ch = idx & 7, h = (idx >> 3) & 7, row = idx >> 6, pos = row & (SEQ - 1), i = pos >> 8;
            float L = lv[k][3];
#pragma unroll
            for (int j = 0; j < 3; ++j) L += (j < i) ? lv[k][j] : 0.f;
            float acc[8];
#pragma unroll
            for (int e = 0; e < 8; ++e) acc[e] = 0.f;
#pragma unroll
            for (int j = 0; j < 4; ++j) { const v4u v = pv[k][j];
                acc[0] += bflo(v.x); acc[1] += bfhi(v.x); acc[2] += bflo(v.y); acc[3] += bfhi(v.y); acc[4] += bflo(v.z); acc[5] += bfhi(v.z); acc[6] += bflo(v.w); acc[7] += bfhi(v.w); }
            const float rl = 1.0f / L;
            const v4u z = zv[k];
            v4u w;
            w.x = pk2(acc[0] * rl * pg8::act_silu(bflo(z.x)), acc[1] * rl * pg8::act_silu(bfhi(z.x))); w.y = pk2(acc[2] * rl * pg8::act_silu(bflo(z.y)), acc[3] * rl * pg8::act_silu(bfhi(z.y)));
            w.z = pk2(acc[4] * rl * pg8::act_silu(bflo(z.z)), acc[5] * rl * pg8::act_silu(bfhi(z.z))); w.w = pk2(acc[6] * rl * pg8::act_silu(bflo(z.w)), acc[7] * rl * pg8::act_silu(bfhi(z.w)));
            *(v4u*)(MIX + (size_t)row * 1024 + 512 + h * 64 + ch * 8) = w;
        }
    }
}

constexpr int SG_VPITCH = 272, SG_MPITCH = 144, SG_WREG = 128 * SG_MPITCH;
constexpr int SG_STATS = 8 * SG_WREG;
constexpr int SG_MR = SG_STATS + 8192;
constexpr int SG_LN = SG_MR + 1024;
__device__ __forceinline__ void phase_sgu(const Ctx& C, int layer) {
    typedef float f32x2v __attribute__((ext_vector_type(2)));
    unsigned char* lds = C.lds;
    const bf16* U = (const bf16*)(C.ws + WS_PROJ) + (size_t)T_U * SUBSTRIDE;
    const bf16* V = (const bf16*)(C.ws + WS_PROJ) + (size_t)T_V * SUBSTRIDE;
    const bf16* ZA = (const bf16*)(C.ws + WS_PROJ) + (size_t)T_ZA * SUBSTRIDE;
    bf16* MIX = (bf16*)(C.ws + WS_MIX);
    const int g = C.wave; int lane = C.lane;
    const float* lng = C.ln_g + layer * 512 + g * 64; const float* lnb = C.ln_b + layer * 512 + g * 64;
    const bf16* Wg = (const bf16*)(C.ws + WS_WST) + ((size_t)(layer * 8 + g)) * 128 * 128;
    const float* bg = C.sgu_b + (layer * 8 + g) * 128;
    unsigned char* myreg = lds + g * SG_WREG;
    f32x2v* stats = (f32x2v*)(lds + SG_STATS); f32x2v* mr = (f32x2v*)(lds + SG_MR);
    float* lnl = (float*)(lds + SG_LN + g * 512);
    lnl[lane] = lng[lane]; lnl[64 + lane] = lnb[lane];
    for (int u = C.bid; u < MROWS / 128; u += C.G) {
        const size_t row0 = (size_t)u * 128;
        asm volatile("" : "+v"(lane));
        v4u xv[2][8];
#pragma unroll
        for (int rr = 0; rr < 2; ++rr) {
            const v4u* vp = (const v4u*)(V + (row0 + lane + 64 * rr) * 512 + g * 64);
#pragma unroll
            for (int c = 0; c < 8; ++c) xv[rr][c] = vp[c];
        }
#pragma unroll
        for (int rr = 0; rr < 2; ++rr) {
            float s1 = 0.f, s2 = 0.f;
#pragma unroll
            for (int c = 0; c < 8; ++c) { v4u v = xv[rr][c];
                v.x = pk2(pg8::act_gelu(bflo(v.x)), pg8::act_gelu(bfhi(v.x))); v.y = pk2(pg8::act_gelu(bflo(v.y)), pg8::act_gelu(bfhi(v.y)));
                v.z = pk2(pg8::act_gelu(bflo(v.z)), pg8::act_gelu(bfhi(v.z))); v.w = pk2(pg8::act_gelu(bflo(v.w)), pg8::act_gelu(bfhi(v.w))); xv[rr][c] = v;
                const float f0 = bflo(v.x), f1 = bfhi(v.x), f2 = bflo(v.y), f3 = bfhi(v.y), f4 = bflo(v.z), f5 = bfhi(v.z), f6 = bflo(v.w), f7 = bfhi(v.w);
                s1 += ((f0 + f1) + (f2 + f3)) + ((f4 + f5) + (f6 + f7));
                s2 += ((f0 * f0 + f1 * f1) + (f2 * f2 + f3 * f3)) + ((f4 * f4 + f5 * f5) + (f6 * f6 + f7 * f7)); }
            stats[g * 128 + lane + 64 * rr] = (f32x2v){s1, s2};
        }
        bf16x8 wf[4][8];
        { const bf16* wa = Wg + (size_t)(lane & 31) * 128 + (lane >> 5) * 8;
#pragma unroll
          for (int tt = 0; tt < 4; ++tt)
#pragma unroll
              for (int ks = 0; ks < 8; ++ks) if (tt >= (ks >> 1)) wf[tt][ks] = *(const bf16x8*)(wa + (size_t)tt * 32 * 128 + ks * 16); }
        __syncthreads();
        if (C.tid < 128) {
            float s1 = 0.f, s2 = 0.f;
#pragma unroll
            for (int w = 0; w < 8; ++w) { const f32x2v t = stats[w * 128 + C.tid]; s1 += t.x; s2 += t.y; }
            const float mean = s1 * (1.0f / 512.0f), var = s2 * (1.0f / 512.0f) - mean * mean;
            mr[C.tid] = (f32x2v){mean, 1.0f / sqrtf(var + LN_EPS)};
        }
        __syncthreads();
#pragma unroll
        for (int c = 0; c < 8; ++c) asm volatile("" : "+v"(xv[0][c]), "+v"(xv[1][c]));
        { const f32x2v m0 = mr[lane], m1 = mr[lane + 64];
          unsigned short* vt = (unsigned short*)(myreg + lane * 2);
#pragma unroll
          for (int c = 0; c < 8; ++c) {
              const v4u v0 = xv[0][c], v1 = xv[1][c];
              const float f0[8] = {bflo(v0.x), bfhi(v0.x), bflo(v0.y), bfhi(v0.y), bflo(v0.z), bfhi(v0.z), bflo(v0.w), bfhi(v0.w)};
              const float f1[8] = {bflo(v1.x), bfhi(v1.x), bflo(v1.y), bfhi(v1.y), bflo(v1.z), bfhi(v1.z), bflo(v1.w), bfhi(v1.w)};
#pragma unroll
              for (int e = 0; e < 8; ++e) { const int d = 8 * c + e; const float gg = lnl[d], bbv = lnl[64 + d];
                  vt[d * (SG_VPITCH / 2)] = (unsigned short)f2bf((f0[e] - m0.x) * m0.y * gg + bbv);
                  vt[d * (SG_VPITCH / 2) + 64] = (unsigned short)f2bf((f1[e] - m1.x) * m1.y * gg + bbv); }
              asm volatile("" ::: "memory");
          } }
        LDS_WAIT(); asm volatile("" ::: "memory");
        { const int q = lane & 31, hi = lane >> 5;
          unsigned pk[2][4][8];
#pragma unroll
          for (int dt = 0; dt < 2; ++dt) {
              const unsigned char* bb = myreg + (32 * dt + q) * SG_VPITCH + hi * 16;
              f32x16 acc[4];
#pragma unroll
              for (int tt = 0; tt < 4; ++tt) acc[tt] = (f32x16){};
#pragma unroll
              for (int ks = 0; ks < 8; ++ks) {
                  const bf16x8 b0 = *(const bf16x8*)(bb + ks * 32);
#pragma unroll
                  for (int tt = 0; tt < 4; ++tt) if (tt >= (ks >> 1)) acc[tt] = __builtin_amdgcn_mfma_f32_32x32x16_bf16(wf[tt][ks], b0, acc[tt], 0, 0, 0);
              }
#pragma unroll
              for (int tt = 0; tt < 4; ++tt)
#pragma unroll
                  for (int rp = 0; rp < 8; ++rp) pk[dt][tt][rp] = cvtpk(acc[tt][2 * rp], acc[tt][2 * rp + 1]);
          }
          LDS_WAIT(); asm volatile("" ::: "memory");
          unsigned char* mxb = myreg + (4 * hi) * SG_MPITCH + q * 2;
#pragma unroll
          for (int dt = 0; dt < 2; ++dt)
#pragma unroll
              for (int tt = 0; tt < 4; ++tt)
#pragma unroll
                  for (int r = 0; r < 16; ++r)
                      *(unsigned short*)(mxb + (32 * tt + (r & 3) + 8 * (r >> 2)) * SG_MPITCH + 64 * dt) = (unsigned short)((r & 1) ? (pk[dt][tt][r >> 1] >> 16) : (pk[dt][tt][r >> 1] & 0xffffu));
        }
        LDS_WAIT(); asm volatile("" ::: "memory");
        { const int ch = lane & 7, r8 = lane >> 3;
#pragma unroll 4
          for (int it = 0; it < 16; ++it) {
              const int t = it * 8 + r8;
              const v4u mv = *(const v4u*)(myreg + t * SG_MPITCH + ch * 16);
              const v4u uv = *(const v4u*)(U + (row0 + t) * 512 + g * 64 + ch * 8), zv = *(const v4u*)(ZA + (row0 + t) * 512 + g * 64 + ch * 8);
              const float bt = bg[t];
              v4u o;
#define SGU_Y(uw, mw, zw) pk2(pg8::act_gelu(bflo(uw)) * (bflo(mw) + bt) * pg8::act_silu(bflo(zw)), pg8::act_gelu(bfhi(uw)) * (bfhi(mw) + bt) * pg8::act_silu(bfhi(zw)))
              o.x = SGU_Y(uv.x, mv.x, zv.x); o.y = SGU_Y(uv.y, mv.y, zv.y); o.z = SGU_Y(uv.z, mv.z, zv.z); o.w = SGU_Y(uv.w, mv.w, zv.w);
#undef SGU_Y
              *(v4u*)(MIX + (row0 + t) * 1024 + g * 64 + ch * 8) = o;
          } }
        __syncthreads();
    }
}

__device__ __forceinline__ void phase_check_inject(const Ctx& C) {
    if (C.bid == 0 && C.tid == 0) C.out[0] = __uint_as_float(((const unsigned*)(C.ws + WS_CTL))[32]) * 1e6f;
}

#define GAS __attribute__((address_space(1)))
typedef GAS unsigned gu32;
#define RLX_AGENT __ATOMIC_RELAXED, __HIP_MEMORY_SCOPE_AGENT
constexpr int CW_BAR = 4096;
constexpr int LDS_BARST = LDS_BYTES - 64;
#define XB_TMO      128
#define XB_XCNT(j)  (256  + 64 * (j))
#define XB_XSUB(j)  (1280 + 64 * (j))
#define XB_XGEN(j)  (2304 + 64 * (j))
#define XB_TOP      3328
#define XB_TOPGEN   3392
#define XCD_BAR_WORDS 3456
#define XB_SPIN_CAP (1u << 18)

__device__ __forceinline__ unsigned xb_ld(unsigned* p)              { return __hip_atomic_load(p, __ATOMIC_RELAXED, __HIP_MEMORY_SCOPE_AGENT); }
__device__ __forceinline__ unsigned xb_add(unsigned* p, unsigned v) { return __hip_atomic_fetch_add(p, v, __ATOMIC_RELAXED, __HIP_MEMORY_SCOPE_AGENT); }
__device__ __forceinline__ unsigned xb_xcc_id() { return (unsigned)__builtin_amdgcn_s_getreg((3 << 11) | 20) & 0xFu; }
#define XB_SPIN(cond, bar) do { unsigned _sp = 0; while (cond) { __builtin_amdgcn_s_sleep(1); \
    if ((++_sp & 255u) == 0u) { if (xb_ld(&(bar)[XB_TMO])) break; if (_sp > XB_SPIN_CAP) { atomicAdd(&(bar)[XB_TMO], 1u); break; } } } } while (0)

struct XcdBarrier {
    unsigned* bar; unsigned x;
    volatile LAS unsigned* st;
};

__device__ __forceinline__ XcdBarrier xcd_barrier_post(unsigned* bar, volatile LAS unsigned* st) {
    XcdBarrier b; b.bar = bar; b.x = xb_xcc_id(); b.st = st;
    if (threadIdx.x == 0) (void)xb_add(&bar[XB_XCNT(b.x)], 1u);
    return b;
}
__device__ __forceinline__ void xcd_barrier_complete(unsigned* bar, unsigned x, unsigned& nloc, unsigned& nx) {
    const unsigned G = gridDim.x * gridDim.y * gridDim.z;
    unsigned sum, cnt, mine, sp = 0u;
    for (;;) {
        sum = 0u; cnt = 0u; mine = 0u;
#pragma unroll
        for (unsigned j = 0; j < 16; ++j) { const unsigned c = xb_ld(&bar[XB_XCNT(j)]); sum += c; cnt += (c > 0u) ? 1u : 0u; mine = (j == x) ? c : mine; }
        if (sum == G) break;
        __builtin_amdgcn_s_sleep(1);
        if ((++sp & 255u) == 0u) { if (xb_ld(&bar[XB_TMO])) break; if (sp > XB_SPIN_CAP) { atomicAdd(&bar[XB_TMO], 1u); break; } }
    }
    nloc = mine > 0u ? mine : 1u; nx = cnt > 0u ? cnt : 1u;
}

__device__ __forceinline__ void xcd_barrier(const XcdBarrier& b, const bool leader_thread) {
    asm volatile("s_waitcnt vmcnt(0)" ::: "memory");
    __syncthreads();
    if (leader_thread) {
        unsigned* bar = b.bar;
        __builtin_amdgcn_s_waitcnt(0);
        unsigned nloc = b.st[0], nx = b.st[1];
        if (nloc == 0u) { xcd_barrier_complete(bar, b.x, nloc, nx); b.st[0] = nloc; b.st[1] = nx; }
        const unsigned old = xb_add(&bar[XB_XSUB(b.x)], 1u);
        const unsigned gen = old / nloc;
        if (old + 1u == (gen + 1u) * nloc) {
            __builtin_amdgcn_fence(__ATOMIC_RELEASE, "agent");
            asm volatile("s_waitcnt vmcnt(0)" ::: "memory");
            const unsigned og = xb_add(&bar[XB_TOP], 1u);
            const unsigned tg = og / nx;
            if (og + 1u == (tg + 1u) * nx) xb_add(&bar[XB_TOPGEN], 1u);
            else XB_SPIN(xb_ld(&bar[XB_TOPGEN]) == tg, bar);
            __builtin_amdgcn_fence(__ATOMIC_ACQUIRE, "agent");
            xb_add(&bar[XB_XGEN(b.x)], 1u);
            asm volatile("s_waitcnt vmcnt(0)" ::: "memory");
        } else {
            XB_SPIN(xb_ld(&bar[XB_XGEN(b.x)]) == gen, bar);
            __builtin_amdgcn_fence(__ATOMIC_ACQUIRE, "agent");
            asm volatile("s_waitcnt vmcnt(0)" ::: "memory");
        }
    }
    __syncthreads();
}

template <int ST> __device__ __forceinline__ void run_stage(const Args& args, unsigned char* lds, int Lr, int wave_s) {
    const int L = Lr;
    Ctx C;
    { int t = wave_s * 64 + lane_now(); C.tid = t; }
    C.lds = lds; C.lane = C.tid & 63; C.wave = __builtin_amdgcn_readfirstlane(C.tid >> 6); C.G = gridDim.x; C.bid = blockIdx.x;
    C.x = args.in[0]; C.norm_g = args.in[1]; C.w_in = args.in[2]; C.ln_g = args.in[3]; C.ln_b = args.in[4]; C.sgu_w = args.in[5]; C.sgu_b = args.in[6];
    C.w_out = args.in[7]; C.rel_bias = args.in[8]; C.final_g = args.in[9]; C.out = args.out; C.ws = args.ws;
    asm volatile("" : "+s"(C.ws), "+s"(C.out), "+s"(C.x), "+s"(C.sgu_b), "+s"(C.ln_g), "+s"(C.ln_b));
    if constexpr (ST == 0) phase_prologue(C);
    else if constexpr (ST == 1) {
        pg8::Gemm g{(const pg8::bf16_t*)(C.ws + WS_XB), (const pg8::bf16_t*)(C.ws + WS_WIN) + (size_t)L * DIN * DM, MROWS, DIN, DM};
        pg8::StaticOrder S; S.init(MROWS, DIN, C.G, C.bid);
        int pmA = -1, pmB = -1, pmC = -1, pmD = -1;
        { pg8::Unit uu;
          for (int i = 0; S.next(i, uu); ++i) { const int pmu = uu.pm;
              if (pmu == pmA || pmu == pmB || pmu == pmC || pmu == pmD) continue;
              if (pmA < 0) pmA = pmu; else if (pmB < 0) pmB = pmu; else if (pmC < 0) pmC = pmu; else if (pmD < 0) pmD = pmu; } }
        float* rtab = (float*)(lds + RING_BYTES);
        { const float* rowss = (const float*)(C.ws + WS_ROWSS);
#pragma unroll
          for (int k = 0; k < 2; ++k) { const int e = C.tid + 512 * k, sl = e >> 8, pmk = sl == 0 ? pmA : sl == 1 ? pmB : sl == 2 ? pmC : pmD;
              if (pmk >= 0) { const f32x4* rp = (const f32x4*)(rowss + ((size_t)pmk * 256 + (e & 255)) * 16); const f32x4 s0 = rp[0], s1 = rp[1], s2 = rp[2], s3 = rp[3];
                  const float ss = ((s0[0] + s0[1]) + (s0[2] + s0[3])) + ((s1[0] + s1[1]) + (s1[2] + s1[3])) + ((s2[0] + s2[1]) + (s2[2] + s2[3])) + ((s3[0] + s3[1]) + (s3[2] + s3[3]));
                  rtab[e] = 1.0f / sqrtf(ss * (1.0f / 1024.0f) + NORM_EPS); } }
          __syncthreads(); }
        pg8::EpiProj E{(pg8::bf16_t*)(C.ws + WS_PROJ), SUBSTRIDE, rtab, pmA, pmB, pmC, pmD, (float*)(C.ws + WS_KMEAN) + (size_t)L * NBH * NBLK * 64};
        pg8::gemm_phase<pg8::EpiProj, pg8::StaticOrder, true, true>((PG8_LAS unsigned char*)lds, g, S, E, C.tid);
    }
    else if constexpr (ST == 3) { phase_gate(C, L); phase_sgu(C, L); }
    else if constexpr (ST == 4) phase_attn(C, L);
    else if constexpr (ST == 5) phase_combine(C);
    else if constexpr (ST == 6) {
        pg8::Gemm g{(const pg8::bf16_t*)(C.ws + WS_MIX), (const pg8::bf16_t*)(C.ws + WS_WOUT) + (size_t)L * DM * DM, MROWS, DM, DM};
        pg8::StaticOrder S; S.init(MROWS, DM, C.G, C.bid);
        if (L == 0) { pg8::EpiRes E{(pg8::bf16_t*)(C.ws + WS_XB), (float*)(C.ws + WS_ROWSS)};
            pg8::gemm_phase<pg8::EpiRes, pg8::StaticOrder, true, true>((PG8_LAS unsigned char*)lds, g, S, E, C.tid); }
        else { pg8::EpiFinal E{(const pg8::bf16_t*)(C.ws + WS_XB), C.out, C.final_g, (float*)(C.ws + WS_ROWSS), (unsigned*)(C.ws + WS_CTL) + 8192};
            pg8::gemm_phase<pg8::EpiFinal, pg8::StaticOrder, true, true>((PG8_LAS unsigned char*)lds, g, S, E, C.tid); }
    } else if constexpr (ST == 7) phase_check_inject(C);
    else if constexpr (ST == 8) phase_attn_simple(C, (bf16*)(C.ws + 104 * MiB));
    else if constexpr (ST == 9) {
        const bf16* A = (const bf16*)(C.ws + WS_MIX); const bf16* B = (const bf16*)(C.ws + 104 * MiB); unsigned* flag = (unsigned*)(C.ws + WS_CTL) + 32;
        float md = 0.f;
        for (size_t idx = (size_t)C.bid * 512 + C.tid; idx < (size_t)MROWS * 512; idx += (size_t)C.G * 512) {
            const size_t row = idx >> 9, col = 512 + (idx & 511);
            const float a = __uint_as_float((unsigned)A[row * 1024 + col] << 16), r = __uint_as_float((unsigned)B[row * 1024 + col] << 16);
            float sc = fabsf(r);
#pragma unroll
            for (int o = 1; o < 64; o <<= 1) sc = fmaxf(sc, lx_xor(sc, o));
            const float d = fabsf(a - r) / (0.02f + sc);
            md = (d > md || !(d == d)) ? (d == d ? d : 1e6f) : md;
        }
        atomicMax(flag, __float_as_uint(md));
    }
}
template <int SEL> __global__ void __launch_bounds__(NWAVES * 64, 2) fwd(Args args) {
    extern __shared__ __attribute__((aligned(16))) unsigned char lds[];
    const int wave_s = __builtin_amdgcn_readfirstlane((int)threadIdx.x >> 6);
    if constexpr (SEL >= 0) run_stage<SEL>(args, lds, args.layer, wave_s);
    else {
        if (args.pad == 0x7fffffff) cg::this_grid().sync();
        volatile LAS unsigned* bst = (volatile LAS unsigned*)((LAS unsigned char*)lds + LDS_BARST);
        if (threadIdx.x == 0) { bst[0] = 0u; bst[1] = 0u; }
        __syncthreads();
        XcdBarrier bar = xcd_barrier_post((unsigned*)(args.ws + WS_CTL) + CW_BAR, bst);
#define GRID_SYNC() do { XcdBarrier b2_ = bar; asm volatile("" : "+s"(b2_.bar), "+s"(b2_.x)); xcd_barrier(b2_, wave_s == 0 && lane_now() == 0); } while (0)
#define RUN(k, L) do { run_stage<k>(args, lds, L, wave_s); GRID_SYNC(); } while (0)
        RUN(0, 0);
        for (int L = 0; L < DEPTH; ++L) {
            RUN(1, L); RUN(3, L); RUN(4, L); RUN(5, L);
            if (L == DEPTH - 1) run_stage<6>(args, lds, L, wave_s); else RUN(6, L);
        }
    }
}

#ifndef MK_N_LAUNCHES
#define MK_N_LAUNCHES 1
#endif
template <int SEL> static void launch_stage(int grid, Args a, int layer, hipStream_t stream) {
    static bool attr = false;
    if (!attr) { (void)hipFuncSetAttribute((const void*)fwd<SEL>, hipFuncAttributeMaxDynamicSharedMemorySize, LDS_BYTES); attr = true; }
    a.layer = layer;
    hipLaunchKernelGGL(fwd<SEL>, dim3(grid), dim3(NWAVES * 64), LDS_BYTES, stream, a);
}
extern "C" void kernel_launch(void* const* d_in, const int* in_sizes, int n_in, void* d_out, int out_size, void* d_ws, size_t ws_size, hipStream_t stream) {
    static int grid = 0;
    if (grid == 0) {
        if (n_in != 10 || out_size != MROWS * DM || ws_size < WS_END) { fprintf(stderr, "kernel_launch: unexpected shapes (n_in %d out %d ws %zu)\n", n_in, out_size, ws_size); grid = -1; return; }
        int dev = 0, cus = 0;
        (void)hipGetDevice(&dev); (void)hipDeviceGetAttribute(&cus, hipDeviceAttributeMultiprocessorCount, dev);
        grid = cus;
        if (grid != 256) fprintf(stderr, "kernel_launch: %d CUs: the fused final-norm epilogue pairs the four column tiles of a row panel inside one round of a 256-workgroup grid\n", grid);
#if MK_N_LAUNCHES == 1
        int per_cu = 0;
        if (hipFuncSetAttribute((const void*)fwd<-1>, hipFuncAttributeMaxDynamicSharedMemorySize, LDS_BYTES) != hipSuccess) { fprintf(stderr, "kernel_launch: hipFuncSetAttribute failed\n"); grid = -1; return; }
        if (hipOccupancyMaxActiveBlocksPerMultiprocessor(&per_cu, (const void*)fwd<-1>, NWAVES * 64, LDS_BYTES) != hipSuccess || per_cu < 1) { fprintf(stderr, "kernel_launch: occupancy query says %d\n", per_cu); grid = -1; return; }
        (void)hipGetLastError();
#endif
    }
    if (grid < 0) return;
    (void)hipMemsetAsync((char*)d_ws + WS_CTL, 0, CTL_ZERO_BYTES, stream);
    Args a{};
    for (int i = 0; i < 10; ++i) a.in[i] = (const float*)d_in[i];
    a.out = (float*)d_out; a.ws = (unsigned char*)d_ws;
#if MK_N_LAUNCHES == 1
    void* kargs[] = {&a};
    hipError_t e = hipLaunchCooperativeKernel((const void*)fwd<-1>, dim3(grid), dim3(NWAVES * 64), kargs, LDS_BYTES, stream);
    if (e != hipSuccess) fprintf(stderr, "kernel_launch: cooperative launch failed: %s\n", hipGetErrorString(e));
#else
    launch_stage<0>(grid, a, 0, stream);
    for (int L = 0; L < DEPTH; ++L) {
        launch_stage<1>(grid, a, L, stream); launch_stage<3>(grid, a, L, stream);
        launch_stage<4>(grid, a, L, stream); launch_stage<5>(grid, a, L, stream);
        if (CHECK_ATTN && L == 0) { launch_stage<8>(grid, a, L, stream); launch_stage<9>(grid, a, L, stream); }
        launch_stage<6>(grid, a, L, stream);
    }
    if (CHECK_ATTN) launch_stage<7>(grid, a, 0, stream);
#endif
}
```

```cpp
#include <hip/hip_runtime.h>
#include <hip/hip_cooperative_groups.h>
#include <cstdio>
#include <cstdint>
namespace cg = cooperative_groups;

constexpr int BATCH = 2, SEQ = 16384, DM = 1024, MROWS = BATCH * SEQ, DIN = 3584, DSUB = 512;
constexpr int NH = 8, DH = 64, NBLK = SEQ / 256, NBH = BATCH * NH, DEPTH = 2;
constexpr float NORM_EPS = 1e-6f, LN_EPS = 1e-5f;
constexpr float LOG2E = 1.4426950408889634f;
#ifndef CHECK_ATTN
#define CHECK_ATTN 0
#endif
constexpr float QSCALE = 0.125f * LOG2E;
__device__ __forceinline__ int lx_lane() { int l; asm volatile("v_mbcnt_lo_u32_b32 %0, -1, 0\n\tv_mbcnt_hi_u32_b32 %0, -1, %0" : "=v"(l)); return l; }
__device__ __forceinline__ int lx_xor(int v, int m) { return __builtin_amdgcn_ds_bpermute((lx_lane() ^ m) << 2, v); }
__device__ __forceinline__ float lx_xor(float v, int m) { return __builtin_bit_cast(float, __builtin_amdgcn_ds_bpermute((lx_lane() ^ m) << 2, __builtin_bit_cast(int, v))); }
__device__ __forceinline__ int lx_up(int v, int d) { const int l = lx_lane(); return __builtin_amdgcn_ds_bpermute((l >= d ? l - d : l) << 2, v); }
namespace pg8 {
#define PG8_LAS __attribute__((address_space(3)))
typedef unsigned short bf16_t;
typedef short bf16x8 __attribute__((ext_vector_type(8)));
typedef float f32x4 __attribute__((ext_vector_type(4)));
typedef unsigned u32x4 __attribute__((ext_vector_type(4)));
typedef int pg8_v8i __attribute__((ext_vector_type(8)));
typedef int pg8_v4i __attribute__((ext_vector_type(4)));
constexpr int BM = 256, BK = 64, HALF = 128, HTB = HALF * BK * 2  , STAGE_BYTES = 8 * HTB, NXCD = 8, WGM = 8;

__host__ __device__ __forceinline__ int lds_byte(int r, int c) { const int st = (r >> 4) * 2 + (c >> 5), rr = r & 15, cc = c & 31, ob = rr * 64 + cc * 2; return st * 1024 + (ob ^ (((ob >> 9) & 1) << 5)); }
__host__ __device__ __forceinline__ void stage_rc(int b, int& R, int& C) { const int st = b / 1024, sb = b % 1024, swz = sb ^ (((sb >> 9) & 1) << 5); R = (st >> 1) * 16 + swz / 64; C = (st & 1) * 32 + (swz % 64) / 2; }
__host__ __device__ __forceinline__ int perm32(int rho) { const int n = rho >> 4, i = rho & 15; return 8 * (i >> 2) + 4 * n + (i & 3); }

struct Unit { int pm, pn; };
struct Gemm { const bf16_t* A; const bf16_t* Bt; int M, N, K; int kext = 0; };

struct StaticOrder {
    int nM, nN, nwg, G, c;
    __host__ __device__ void init(int M, int N, int G_, int c_) { nM = M / BM; nN = N / BM; nwg = nM * nN; G = G_; c = c_; }
    __host__ __device__ bool next(int i, Unit& u) const {
        const long L = (long)i * G + c; if (L >= nwg) return false;
        int wgid = (int)L; { const int q = nwg / NXCD, r = nwg % NXCD, xcd = wgid % NXCD, off = wgid / NXCD; wgid = (xcd < r ? xcd * (q + 1) : r * (q + 1) + (xcd - r) * q) + off; }
        const int nig = WGM * nN, gid = wgid / nig, fm = gid * WGM, gsz = (nM - fm) < WGM ? (nM - fm) : WGM;
        u.pm = fm + ((wgid % nig) % gsz); u.pn = (wgid % nig) / gsz; return true;
    }
    __device__ __forceinline__ void a_ready(const Unit&) const {}
    __device__ __forceinline__ void done(const Unit&) const {}
};

__device__ __forceinline__ unsigned cvt_pk_bf16(float lo, float hi) { unsigned r; asm volatile("v_cvt_pk_bf16_f32 %0, %1, %2" : "=v"(r) : "v"(lo), "v"(hi)); return r; }
typedef float f32x2 __attribute__((ext_vector_type(2)));
typedef float f32x2 __attribute__((ext_vector_type(2)));
__device__ __forceinline__ float act_gelu(float x) {
    const float u = x * (1.0f + 0.044715f * x * x);
    const float e = __builtin_amdgcn_exp2f(u * (-2.0f * 0.7978845608028654f * 1.4426950408889634f));
    return x * __builtin_amdgcn_rcpf(1.0f + e);
}
__device__ __forceinline__ float act_silu(float x) {
    const float e = __builtin_amdgcn_exp2f(x * (-1.4426950408889634f));
    return x * __builtin_amdgcn_rcpf(1.0f + e);
}
struct EpiProj {
    static constexpr bool PERM = true, AFTER_DRAIN = false;
    bf16_t* P; size_t sub_stride; const float* rstd_lds; int pm0, pm1, pm2, pm3; float* kmean; int pn_base, pn_hole; float oscale;
    __device__ __forceinline__ void operator()(const f32x4 (&acc)[2][2][4][2], const Unit& u, int wr, int wc, int fr, int fq) const {
        const int pnn = u.pn + pn_base + (u.pn >= pn_hole ? 2 : 0), t = pnn >> 1;
        bf16_t* base = P + (size_t)t * sub_stride;
        const int col0 = (pnn & 1) * 256 + wc * 32 + 8 * fq;
        const int row0 = u.pm * BM + wr * 64 + fr;
        const int slot = (u.pm == pm0) ? 0 : (u.pm == pm1) ? 1 : (u.pm == pm2) ? 2 : 3;
        const float* rt = rstd_lds + slot * 256 + wr * 64 + fr;
        const float qs = ((t == 3) ? (0.125f * 1.4426950408889634f) : 1.0f) * oscale;
        float ks[2][8];
#pragma unroll
        for (int bj = 0; bj < 2; ++bj)
#pragma unroll
            for (int e = 0; e < 8; ++e) ks[bj][e] = 0.f;
#pragma unroll
        for (int ai = 0; ai < 2; ++ai)
#pragma unroll
            for (int m = 0; m < 4; ++m) {
                const int row = row0 + ai * HALF + m * 16;
                const float rs = rt[ai * HALF + m * 16] * qs;
                bf16_t* rowp = base + (size_t)row * 512 + col0;
#pragma unroll
                for (int bj = 0; bj < 2; ++bj) {
                    const f32x4 v0 = acc[ai][bj][m][0] * rs, v1 = acc[ai][bj][m][1] * rs;
                    if (t == 4) {
#pragma unroll
                        for (int e = 0; e < 4; ++e) { ks[bj][e] += v0[e]; ks[bj][4 + e] += v1[e]; }
                    }
                    u32x4 w; w.x = cvt_pk_bf16(v0[0], v0[1]); w.y = cvt_pk_bf16(v0[2], v0[3]); w.z = cvt_pk_bf16(v1[0], v1[1]); w.w = cvt_pk_bf16(v1[2], v1[3]);
                    *(u32x4*)(rowp + bj * HALF) = w;
                }
            }
        if (t == 4) {
            const int b = u.pm >> 6, n = u.pm & 63;
#pragma unroll
            for (int bj = 0; bj < 2; ++bj)
#pragma unroll
                for (int e = 0; e < 8; ++e) {
                    float v = ks[bj][e];
                    v += lx_xor(v, 1); v += lx_xor(v, 2); v += lx_xor(v, 4); v += lx_xor(v, 8);
                    if (fr == 0) { const int col = col0 + bj * HALF + e; atomicAdd(kmean + ((size_t)((b * 8 + (col >> 6)) * 64 + n)) * 64 + (col & 63), v * (1.0f / 256.0f)); }
                }
        }
    }
};
#define PG8_GAS __attribute__((address_space(1)))
struct EpiRes {
    static constexpr bool PERM = true, AFTER_DRAIN = false;
    bf16_t* xb; float* rowss; unsigned char* xb8;
    __device__ __forceinline__ void operator()(const f32x4 (&acc)[2][2][4][2], const Unit& u, int wr, int wc, int fr, int fq) const {
        const int col0 = u.pn * BM + wc * 32 + 8 * fq;
        PG8_GAS bf16_t* xbg = (PG8_GAS bf16_t*)xb; PG8_GAS float* rsg = (PG8_GAS float*)rowss;
        const unsigned ob = (unsigned)((u.pm * BM + wr * 64 + fr) * 1024 + col0) * 2u;
        u32x4 rr[2][4][2];
#pragma unroll
        for (int ai = 0; ai < 2; ++ai)
#pragma unroll
            for (int m = 0; m < 4; ++m)
#pragma unroll
                for (int bj = 0; bj < 2; ++bj) rr[ai][m][bj] = *(const PG8_GAS u32x4*)((const PG8_GAS char*)xbg + (ob + (unsigned)(((ai * HALF + m * 16) * 1024 + bj * HALF) * 2)));
#pragma unroll
        for (int ai = 0; ai < 2; ++ai)
#pragma unroll
            for (int m = 0; m < 4; ++m) {
                const int row = u.pm * BM + ai * HALF + wr * 64 + m * 16 + fr;
                float ss = 0.f; int w8[2][2];
#pragma unroll
                for (int bj = 0; bj < 2; ++bj) {
                    const u32x4 w0 = rr[ai][m][bj];
                    const f32x4 r0 = (f32x4){__uint_as_float(w0.x << 16), __uint_as_float(w0.x & 0xffff0000u), __uint_as_float(w0.y << 16), __uint_as_float(w0.y & 0xffff0000u)};
                    const f32x4 r1 = (f32x4){__uint_as_float(w0.z << 16), __uint_as_float(w0.z & 0xffff0000u), __uint_as_float(w0.w << 16), __uint_as_float(w0.w & 0xffff0000u)};
                    const f32x4 o0 = r0 + acc[ai][bj][m][0], o1 = r1 + acc[ai][bj][m][1];
                    ss += ((o0[0] * o0[0] + o0[1] * o0[1]) + (o0[2] * o0[2] + o0[3] * o0[3])) + ((o1[0] * o1[0] + o1[1] * o1[1]) + (o1[2] * o1[2] + o1[3] * o1[3]));
                    u32x4 w; w.x = cvt_pk_bf16(o0[0], o0[1]); w.y = cvt_pk_bf16(o0[2], o0[3]); w.z = cvt_pk_bf16(o1[0], o1[1]); w.w = cvt_pk_bf16(o1[2], o1[3]);
                    *(PG8_GAS u32x4*)((PG8_GAS char*)xbg + (ob + (unsigned)(((ai * HALF + m * 16) * 1024 + bj * HALF) * 2))) = w;
                    w8[bj][0] = __builtin_amdgcn_cvt_pk_fp8_f32(o0[0], o0[1], 0, false); w8[bj][0] = __builtin_amdgcn_cvt_pk_fp8_f32(o0[2], o0[3], w8[bj][0], true);
                    w8[bj][1] = __builtin_amdgcn_cvt_pk_fp8_f32(o1[0], o1[1], 0, false); w8[bj][1] = __builtin_amdgcn_cvt_pk_fp8_f32(o1[2], o1[3], w8[bj][1], true);
                }
                { auto r0 = __builtin_amdgcn_permlane16_swap((unsigned)w8[0][0], (unsigned)w8[1][0], false, false); auto r1 = __builtin_amdgcn_permlane16_swap((unsigned)w8[0][1], (unsigned)w8[1][1], false, false);
                  const unsigned o8 = (ob - (unsigned)col0) + (unsigned)((ai * HALF + m * 16) * 2048) + ((fq & 1) ? (unsigned)(HALF - 8) : 0u);
                  *(PG8_GAS u32x4*)((PG8_GAS unsigned char*)xb8 + o8) = (u32x4){r0[0], r1[0], r0[1], r1[1]}; }
                ss += lx_xor(ss, 16); ss += lx_xor(ss, 32);
                if (fq == 0) rsg[(size_t)row * 16 + u.pn * 4 + wc] = ss;
            }
    }
};
struct EpiFinal {
    static constexpr bool PERM = true, AFTER_DRAIN = false;
    const bf16_t* xb; float* out; const float* fg; float* slots; unsigned* cnt;
    __device__ __forceinline__ void operator()(f32x4 (&acc)[2][2][4][2], const Unit& u, int wr, int wc, int fr, int fq) const {
        const int col0 = u.pn * BM + wc * 32 + 8 * fq;
        const PG8_GAS bf16_t* xbg = (const PG8_GAS bf16_t*)xb; PG8_GAS float* outg = (PG8_GAS float*)out; const PG8_GAS float* slg = (const PG8_GAS float*)slots;
        const unsigned ob = (unsigned)((u.pm * BM + wr * 64 + fr) * 1024 + col0) * 2u;
        u32x4 rr[2][4][2];
#pragma unroll
        for (int ai = 0; ai < 2; ++ai)
#pragma unroll
            for (int m = 0; m < 4; ++m)
#pragma unroll
                for (int bj = 0; bj < 2; ++bj) rr[ai][m][bj] = *(const PG8_GAS u32x4*)((const PG8_GAS char*)xbg + (ob + (unsigned)(((ai * HALF + m * 16) * 1024 + bj * HALF) * 2)));
#pragma unroll
        for (int ai = 0; ai < 2; ++ai)
#pragma unroll
            for (int m = 0; m < 4; ++m) {
                const int row = u.pm * BM + ai * HALF + wr * 64 + m * 16 + fr;
                float ss = 0.f;
#pragma unroll
                for (int bj = 0; bj < 2; ++bj) {
                    const u32x4 w = rr[ai][m][bj];
                    const f32x4 r0 = (f32x4){__uint_as_float(w.x << 16), __uint_as_float(w.x & 0xffff0000u), __uint_as_float(w.y << 16), __uint_as_float(w.y & 0xffff0000u)};
                    const f32x4 r1 = (f32x4){__uint_as_float(w.z << 16), __uint_as_float(w.z & 0xffff0000u), __uint_as_float(w.w << 16), __uint_as_float(w.w & 0xffff0000u)};
                    const f32x4 o0 = r0 + acc[ai][bj][m][0], o1 = r1 + acc[ai][bj][m][1];
                    acc[ai][bj][m][0] = o0; acc[ai][bj][m][1] = o1;
                    ss += ((o0[0] * o0[0] + o0[1] * o0[1]) + (o0[2] * o0[2] + o0[3] * o0[3])) + ((o1[0] * o1[0] + o1[1] * o1[1]) + (o1[2] * o1[2] + o1[3] * o1[3]));
                }
                ss += lx_xor(ss, 16); ss += lx_xor(ss, 32);
                if (fq == 0) __hip_atomic_store(slots + (size_t)row * 16 + u.pn * 4 + wc, ss, __ATOMIC_RELAXED, __HIP_MEMORY_SCOPE_AGENT);
            }
        asm volatile("s_waitcnt vmcnt(0)" ::: "memory");
        unsigned* pc = cnt + 64 * u.pm;
        if (fr == 0 && fq == 0) __hip_atomic_fetch_add(pc, 1u, __ATOMIC_RELAXED, __HIP_MEMORY_SCOPE_AGENT);
        f32x4 g4[2][2];
#pragma unroll
        for (int bj = 0; bj < 2; ++bj)
#pragma unroll
            for (int n = 0; n < 2; ++n) g4[bj][n] = *(const PG8_GAS f32x4*)((const PG8_GAS float*)fg + col0 + bj * HALF + n * 4);
        for (unsigned spins = 0; spins < (1u << 22); ++spins) {
            if (__hip_atomic_load(pc, __ATOMIC_RELAXED, __HIP_MEMORY_SCOPE_AGENT) >= 32u) break;
            __builtin_amdgcn_s_sleep(2);
        }
        __builtin_amdgcn_fence(__ATOMIC_ACQUIRE, "agent");
        asm volatile("s_waitcnt vmcnt(0)" ::: "memory");
#pragma unroll
        for (int ai = 0; ai < 2; ++ai) {
            f32x4 sl[4][4];
#pragma unroll
            for (int m = 0; m < 4; ++m)
#pragma unroll
                for (int k = 0; k < 4; ++k) sl[m][k] = *(const PG8_GAS f32x4*)(slg + (size_t)(u.pm * BM + ai * HALF + wr * 64 + m * 16 + fr) * 16 + k * 4);
#pragma unroll
            for (int m = 0; m < 4; ++m) {
                const f32x4 s0 = sl[m][0], s1 = sl[m][1], s2 = sl[m][2], s3 = sl[m][3];
                const float tot = ((s0[0] + s0[1]) + (s0[2] + s0[3])) + ((s1[0] + s1[1]) + (s1[2] + s1[3])) + ((s2[0] + s2[1]) + (s2[2] + s2[3])) + ((s3[0] + s3[1]) + (s3[2] + s3[3]));
                const float rs = 1.0f / sqrtf(tot * (1.0f / 1024.0f) + 1e-6f);
#pragma unroll
                for (int bj = 0; bj < 2; ++bj)
#pragma unroll
                    for (int n = 0; n < 2; ++n) *(PG8_GAS f32x4*)((PG8_GAS char*)outg + (2u * ob + (unsigned)(((ai * HALF + m * 16) * 1024 + bj * HALF + n * 4) * 4))) = acc[ai][bj][m][n] * rs * g4[bj][n];
            }
        }
    }
};
template <class Epi, class Sched, bool ALIGN_EPI = false, bool SP2 = false, bool FP8 = false, bool CHAIN_IN = false, bool CHAIN_OUT = false>
__device__ __forceinline__ void gemm_phase(PG8_LAS unsigned char* lds, const Gemm g, const Sched& S, const Epi& E, const int tid, const char* chainA = nullptr, const char* chainB = nullptr) {
    static_assert(!(CHAIN_IN || CHAIN_OUT) || (SP2 && ALIGN_EPI), "chaining is written for the SP2 + ALIGN_EPI form");
    const int wid = __builtin_amdgcn_readfirstlane(tid >> 6), lane = tid & 63, wr = wid >> 2, wc = wid & 3, fr = lane & 15, fq = lane >> 4;
    const int K = g.K, nt = (g.kext ? g.kext : K) / BK;
    unsigned voffA[2], voffB[2];
#pragma unroll
    for (int i = 0; i < 2; ++i) { int R, C; stage_rc(tid * 16 + i * 8192, R, C); const int Rb = Epi::PERM ? ((R & ~31) + perm32(R & 31)) : R;
        voffA[i] = (unsigned)(R * K + C) * 2u; voffB[i] = (unsigned)(Rb * K + C) * 2u; }
    const size_t kstep = (size_t)(BK * 2);
    const size_t hstep = (size_t)HALF * K * 2;
    const size_t tstep = 2 * hstep;
    const unsigned ldsbase = (unsigned)(size_t)lds;
    const unsigned ldsw = (unsigned)wid * 1024u;
    const int aoff = lds_byte(wr * 64 + fr, fq * 8), boff = lds_byte(wc * 32 + fr, fq * 8);
#define PG8_SA(b, h) (((b) * 2 + (h)) * HTB)
#define PG8_SB(b, h) ((4 + (b) * 2 + (h)) * HTB)
#define PG8_GLDS(gbase_, voff_, ldsdst_) do { unsigned keep_; \
        asm volatile("s_mov_b32 %0, m0\n\ts_mov_b32 m0, %3\n\ts_nop 0\n\tglobal_load_lds_dwordx4 %1, %2\n\ts_mov_b32 m0, %0" : "=&s"(keep_) : "v"(voff_), "s"(gbase_), "s"(ldsdst_)); } while (0)
#define PG8_STAGE(bufoff, gbase, voff) do { _Pragma("unroll") for (int _i = 0; _i < 2; ++_i) { \
        if constexpr (FP8) PG8_GLDS((const char*)(gbase), (voff)[_i], (unsigned)__builtin_amdgcn_readfirstlane((int)(ldsbase + (unsigned)(bufoff) + ldsw + (unsigned)(_i * 8192)))); \
        else __builtin_amdgcn_global_load_lds((const unsigned*)((const char*)(gbase) + (voff)[_i]), (PG8_LAS unsigned*)(lds + (bufoff) + ldsw + _i * 8192), 16, 0, 0); } } while (0)
#define PG8_LD32(base_) __builtin_shufflevector(*(const PG8_LAS pg8_v4i*)(base_), *(const PG8_LAS pg8_v4i*)((base_) + 1024), 0, 1, 2, 3, 4, 5, 6, 7)
#define PG8_LDA(dst, b, h) do { if constexpr (FP8) { _Pragma("unroll") for (int m = 0; m < 4; ++m) dst##8[m] = PG8_LD32(lds + PG8_SA(b, h) + aoff + m * 2048); } \
        else { _Pragma("unroll") for (int m = 0; m < 4; ++m) _Pragma("unroll") for (int k = 0; k < 2; ++k) dst[m][k] = *(const PG8_LAS bf16x8*)(lds + PG8_SA(b, h) + aoff + m * 2048 + k * 1024); } } while (0)
#define PG8_LDB(dst, b, h) do { if constexpr (FP8) { _Pragma("unroll") for (int n = 0; n < 2; ++n) dst##8[n] = PG8_LD32(lds + PG8_SB(b, h) + boff + n * 2048); } \
        else { _Pragma("unroll") for (int n = 0; n < 2; ++n) _Pragma("unroll") for (int k = 0; k < 2; ++k) dst[n][k] = *(const PG8_LAS bf16x8*)(lds + PG8_SB(b, h) + boff + n * 2048 + k * 1024); } } while (0)
#define PG8_MMA(ai, bj, At, Bt) do { __builtin_amdgcn_s_setprio(1); \
        if constexpr (FP8) { _Pragma("unroll") for (int m = 0; m < 4; ++m) _Pragma("unroll") for (int n = 0; n < 2; ++n) \
            acc[ai][bj][m][n] = __builtin_amdgcn_mfma_scale_f32_16x16x128_f8f6f4(Bt##8[n], At##8[m], acc[ai][bj][m][n], 0, 0, 0, 0x7f7f7f7f, 0, 0x7f7f7f7f); } \
        else { _Pragma("unroll") for (int m = 0; m < 4; ++m) _Pragma("unroll") for (int n = 0; n < 2; ++n) _Pragma("unroll") for (int k = 0; k < 2; ++k) \
            acc[ai][bj][m][n] = __builtin_amdgcn_mfma_f32_16x16x32_bf16(Bt[n][k], At[m][k], acc[ai][bj][m][n], 0, 0, 0); } \
        __builtin_amdgcn_s_setprio(0); } while (0)
#define PG8_WAIT_V(n) asm volatile("s_waitcnt vmcnt(" #n ")" ::: "memory")
#define PG8_WAIT_L(n) asm volatile("s_waitcnt lgkmcnt(" #n ")" ::: "memory")
#define PG8_BAR __builtin_amdgcn_s_barrier()
#define PG8_SCHED __builtin_amdgcn_sched_barrier(0)
    Unit cur, nxt; int ui = 0;
    if (!S.next(0, cur)) return;
    f32x4 acc[2][2][4][2];
#pragma unroll
    for (int a = 0; a < 2; ++a)
#pragma unroll
        for (int b = 0; b < 2; ++b)
#pragma unroll
            for (int m = 0; m < 4; ++m)
#pragma unroll
                for (int n = 0; n < 2; ++n) acc[a][b][m][n] = (f32x4){0.f, 0.f, 0.f, 0.f};
    bf16x8 At[FP8 ? 1 : 4][2], B0[FP8 ? 1 : 2][2], B1[FP8 ? 1 : 2][2];
    pg8_v8i At8[FP8 ? 4 : 1], B08[FP8 ? 2 : 1], B18[FP8 ? 2 : 1];
    const char* cA = (const char*)g.A + (size_t)cur.pm * tstep; const char* cB = (const char*)g.Bt + (size_t)cur.pn * tstep;
    S.a_ready(cur);
    if constexpr (CHAIN_IN) { } else if constexpr (SP2) {
        PG8_STAGE(PG8_SB(0, 0), cB, voffB); PG8_STAGE(PG8_SB(0, 1), cB + hstep, voffB); PG8_STAGE(PG8_SA(0, 0), cA, voffA); PG8_STAGE(PG8_SA(0, 1), cA + hstep, voffA);
        if (wr == 1) PG8_BAR;
        PG8_WAIT_V(2); PG8_BAR;
        PG8_STAGE(PG8_SB(1, 0), cB + kstep, voffB); PG8_STAGE(PG8_SA(1, 0), cA + kstep, voffA); PG8_STAGE(PG8_SB(1, 1), cB + hstep + kstep, voffB);
        PG8_WAIT_V(6); PG8_BAR;
    } else {
        PG8_STAGE(PG8_SB(0, 0), cB, voffB); PG8_STAGE(PG8_SA(0, 0), cA, voffA); PG8_STAGE(PG8_SB(0, 1), cB + hstep, voffB); PG8_STAGE(PG8_SA(0, 1), cA + hstep, voffA);
        if (wr == 1) PG8_BAR;
        PG8_WAIT_V(4); PG8_BAR;
        PG8_STAGE(PG8_SB(1, 0), cB + kstep, voffB); PG8_STAGE(PG8_SA(1, 0), cA + kstep, voffA); PG8_STAGE(PG8_SB(1, 1), cB + hstep + kstep, voffB);
        PG8_WAIT_V(6); PG8_BAR;
    }
    for (;;) {
        const bool has_next = S.next(ui + 1, nxt);
        const char* nA = has_next ? (const char*)g.A + (size_t)nxt.pm * tstep : (CHAIN_OUT ? chainA : cA); const char* nB = has_next ? (const char*)g.Bt + (size_t)nxt.pn * tstep : (CHAIN_OUT ? chainB : cB);
#pragma unroll 1
        for (int t = 0; t < nt; t += 2) {
            const bool last = (t == nt - 2);
            const char* a1 = cA + (size_t)(t + 1) * kstep;
            const char* a2 = last ? nA : cA + (size_t)(t + 2) * kstep; const char* b2 = last ? nB : cB + (size_t)(t + 2) * kstep;
            const char* a3 = a2 + kstep; const char* b3 = b2 + kstep;
            if (last && has_next) S.a_ready(nxt);
            if constexpr (SP2) {
            PG8_LDB(B0, 0, 0); PG8_LDB(B1, 0, 1); PG8_SCHED; PG8_LDA(At, 0, 0); PG8_STAGE(PG8_SA(1, 1), a1 + hstep, voffA);
            PG8_WAIT_V(8); PG8_WAIT_L(0); PG8_BAR; PG8_MMA(0, 0, At, B0); PG8_MMA(0, 1, At, B1); PG8_BAR; PG8_SCHED;
            PG8_LDA(At, 0, 1); PG8_STAGE(PG8_SB(0, 0), b2, voffB); PG8_STAGE(PG8_SB(0, 1), b2 + hstep, voffB); PG8_STAGE(PG8_SA(0, 0), a2, voffA);
            PG8_WAIT_V(8); PG8_WAIT_L(0); PG8_BAR; PG8_MMA(1, 0, At, B0); PG8_MMA(1, 1, At, B1); PG8_BAR; PG8_SCHED;
            PG8_LDB(B0, 1, 0); PG8_LDB(B1, 1, 1); PG8_SCHED; PG8_LDA(At, 1, 0); PG8_STAGE(PG8_SA(0, 1), a2 + hstep, voffA);
            PG8_WAIT_V(8); PG8_WAIT_L(0); PG8_BAR; PG8_MMA(0, 0, At, B0); PG8_MMA(0, 1, At, B1); PG8_BAR; PG8_SCHED;
            PG8_LDA(At, 1, 1); PG8_STAGE(PG8_SB(1, 0), b3, voffB); PG8_STAGE(PG8_SB(1, 1), b3 + hstep, voffB); PG8_STAGE(PG8_SA(1, 0), a3, voffA);
            PG8_WAIT_V(8); PG8_WAIT_L(0); PG8_BAR; PG8_MMA(1, 0, At, B0); PG8_MMA(1, 1, At, B1); PG8_BAR; PG8_SCHED;
            } else {
            PG8_LDB(B0, 0, 0); PG8_SCHED; PG8_LDA(At, 0, 0); PG8_STAGE(PG8_SA(1, 1), a1 + hstep, voffA);
            PG8_WAIT_L(8); PG8_BAR; PG8_WAIT_L(0); PG8_MMA(0, 0, At, B0); PG8_BAR; PG8_SCHED;
            PG8_LDB(B1, 0, 1); PG8_STAGE(PG8_SB(0, 0), b2, voffB);
            PG8_BAR; PG8_WAIT_L(0); PG8_MMA(0, 1, At, B1); PG8_BAR;
            PG8_LDA(At, 0, 1); PG8_STAGE(PG8_SA(0, 0), a2, voffA);
            PG8_BAR; PG8_WAIT_L(0); PG8_MMA(1, 0, At, B0); PG8_BAR; PG8_SCHED;
            PG8_STAGE(PG8_SB(0, 1), b2 + hstep, voffB);
            PG8_WAIT_V(6); PG8_BAR; PG8_MMA(1, 1, At, B1); PG8_BAR;
            PG8_LDB(B0, 1, 0); PG8_SCHED; PG8_LDA(At, 1, 0); PG8_STAGE(PG8_SA(0, 1), a2 + hstep, voffA);
            PG8_WAIT_L(8); PG8_BAR; PG8_WAIT_L(0); PG8_MMA(0, 0, At, B0); PG8_BAR; PG8_SCHED;
            PG8_LDB(B1, 1, 1); PG8_STAGE(PG8_SB(1, 0), b3, voffB);
            PG8_BAR; PG8_WAIT_L(0); PG8_MMA(0, 1, At, B1); PG8_BAR;
            PG8_LDA(At, 1, 1); PG8_STAGE(PG8_SA(1, 0), a3, voffA);
            PG8_BAR; PG8_WAIT_L(0); PG8_MMA(1, 0, At, B0); PG8_BAR; PG8_SCHED;
            PG8_STAGE(PG8_SB(1, 1), b3 + hstep, voffB);
            PG8_WAIT_V(6); PG8_BAR; PG8_MMA(1, 1, At, B1); PG8_BAR;
            }
        }
        if constexpr (ALIGN_EPI) { if (wr == 0) PG8_BAR; }
        if constexpr (!Epi::AFTER_DRAIN) { int ln_; asm volatile("v_mbcnt_lo_u32_b32 %0, -1, 0\n\tv_mbcnt_hi_u32_b32 %0, -1, %0" : "=v"(ln_)); E(acc, cur, wr, wc, ln_ & 15, ln_ >> 4); S.done(cur); }
        if (!has_next) { if constexpr (CHAIN_OUT) { if (wr == 1) PG8_BAR; return; } break; }
#pragma unroll
        for (int a = 0; a < 2; ++a)
#pragma unroll
            for (int b = 0; b < 2; ++b)
#pragma unroll
                for (int m = 0; m < 4; ++m)
#pragma unroll
                    for (int n = 0; n < 2; ++n) acc[a][b][m][n] = (f32x4){0.f, 0.f, 0.f, 0.f};
        cur = nxt; cA = nA; cB = nB; ++ui;
        if constexpr (ALIGN_EPI) { if (wr == 1) PG8_BAR; }
    }
    PG8_WAIT_V(0);
    if constexpr (!ALIGN_EPI) { if (wr == 0) PG8_BAR; }
    PG8_BAR;
    if constexpr (Epi::AFTER_DRAIN) { E.fused(acc, cur, wr, wc, fr, fq, lds, wid, lane); S.done(cur); }
#undef PG8_SA
#undef PG8_SB
#undef PG8_STAGE
#undef PG8_GLDS
#undef PG8_LD32
#undef PG8_LDA
#undef PG8_LDB
#undef PG8_MMA
#undef PG8_WAIT_V
#undef PG8_WAIT_L
#undef PG8_BAR
#undef PG8_SCHED
}
}

constexpr size_t MiB = 1u << 20;
constexpr size_t WS_CTL = 0, CTL_ZERO_BYTES = 1 * MiB;
constexpr size_t WS_WIN = 2 * MiB;
constexpr size_t WS_WOUT = 16 * MiB;
constexpr size_t WS_WST = 20 * MiB;
constexpr size_t WS_BT = 21 * MiB;
constexpr size_t WS_KMEAN = 22 * MiB;
constexpr size_t WS_LOFF = 23 * MiB;
constexpr size_t WS_ROWSS = 24 * MiB;
constexpr size_t WS_PL = 26 * MiB;
constexpr size_t WS_LIST = 30 * MiB;
constexpr size_t WS_SEL = 32 * MiB;
constexpr size_t WS_XB8 = 104 * MiB;
constexpr size_t WS_WIN8 = 456 * MiB;
constexpr size_t WS_XB = 40 * MiB;
constexpr size_t WS_PROJ = 168 * MiB;
constexpr size_t WS_MIX = 392 * MiB;
constexpr size_t WS_END = 462 * MiB;
constexpr size_t SUBSTRIDE = (size_t)MROWS * 512;
enum { T_U = 0, T_V = 1, T_ZA = 2, T_Q = 3, T_K = 4, T_VV = 5, T_ZB = 6 };

constexpr int NWAVES = 8;
constexpr int LDS_BYTES = 160 * 1024;
constexpr int RING_BYTES = 131072;

#define LAS __attribute__((address_space(3)))
typedef unsigned short bf16;
typedef unsigned v4u __attribute__((ext_vector_type(4)));
typedef float f32x4 __attribute__((ext_vector_type(4)));
#define LDS_WAIT() asm volatile("s_waitcnt lgkmcnt(0)" ::: "memory")
typedef float f32x2c __attribute__((ext_vector_type(2)));
typedef __bf16 bf16x2c __attribute__((ext_vector_type(2)));
__device__ __forceinline__ unsigned pk2(float lo, float hi) { const f32x2c v = {lo, hi}; return __builtin_bit_cast(unsigned, __builtin_convertvector(v, bf16x2c)); }
__device__ __forceinline__ unsigned f2bf(float f) { return pk2(f, f) & 0xffffu; }
__device__ __forceinline__ unsigned pk4_fp8(float a, float b, float c, float d) { int w = __builtin_amdgcn_cvt_pk_fp8_f32(a, b, 0, false); w = __builtin_amdgcn_cvt_pk_fp8_f32(c, d, w, true); return (unsigned)w; }
__device__ __forceinline__ float bflo(unsigned w) { return __uint_as_float(w << 16); }
__device__ __forceinline__ float bfhi(unsigned w) { return __uint_as_float(w & 0xffff0000u); }
__device__ __forceinline__ float wave_sum(float v) {
#pragma unroll
    for (int o = 1; o < 64; o <<= 1) v += lx_xor(v, o);
    return v;
}

__device__ __forceinline__ int lane_now() { int l; asm volatile("v_mbcnt_lo_u32_b32 %0, -1, 0\n\tv_mbcnt_hi_u32_b32 %0, -1, %0" : "=v"(l)); return l; }
struct Args { const float* in[10]; float* out; unsigned char* ws; int layer, pad; };

struct Ctx {
    unsigned char* lds;
    int tid, lane, wave, G, bid;
    const float *x, *norm_g, *w_in, *ln_g, *ln_b, *sgu_w, *sgu_b, *w_out, *rel_bias, *final_g;
    float* out; unsigned char* ws;
};

__device__ __forceinline__ void p0_transpose_item(const float* W, const float* gs, int K, int N, bf16* WT, float* scr, int item, int lane, unsigned char* W8 = nullptr) {
    const int nblk = N / 32, kb = item / nblk, nb = item % nblk, k0 = 64 * kb, n0 = 32 * nb;
    float wv[32];
#pragma unroll
    for (int i = 0; i < 32; ++i) wv[i] = W[(size_t)(k0 + 2 * i + (lane >> 5)) * N + n0 + (lane & 31)];
#pragma unroll
    for (int i = 0; i < 32; ++i) { const int kk = 2 * i + (lane >> 5); const float sc = gs ? gs[k0 + kk] : 1.0f; scr[kk * 33 + (lane & 31)] = wv[i] * sc; }
    LDS_WAIT(); asm volatile("" ::: "memory");
    const int c = lane & 7;
#pragma unroll
    for (int j = 0; j < 4; ++j) { const int n = (lane >> 3) + 8 * j; const float* s = scr + (8 * c) * 33 + n;
        const bool f8 = W8 && ((n0 >= 1536 && n0 < 2048) || n0 >= 2560);
        if (f8) { typedef unsigned u32x2v __attribute__((ext_vector_type(2)));
            const int r8 = (n0 < 2048 ? n0 - 1536 : n0 - 2048) + n;
            *(u32x2v*)(W8 + (size_t)r8 * 2 * K + k0 + 8 * c) = (u32x2v){pk4_fp8(32.f * s[0 * 33], 32.f * s[1 * 33], 32.f * s[2 * 33], 32.f * s[3 * 33]), pk4_fp8(32.f * s[4 * 33], 32.f * s[5 * 33], 32.f * s[6 * 33], 32.f * s[7 * 33])}; }
        else { const int rb = ((W8 && n0 >= 2048) ? n0 - 512 : n0) + n;
            v4u o; o.x = pk2(s[0 * 33], s[1 * 33]); o.y = pk2(s[2 * 33], s[3 * 33]); o.z = pk2(s[4 * 33], s[5 * 33]); o.w = pk2(s[6 * 33], s[7 * 33]);
            *(v4u*)(WT + (size_t)rb * K + k0 + 8 * c) = o; } }
    LDS_WAIT(); asm volatile("" ::: "memory");
}
__device__ __forceinline__ int rel_bucket(int d) {
    if (d < 16) return d;
    int b = 16;
    b += (d >= 19); b += (d >= 21); b += (d >= 24); b += (d >= 27); b += (d >= 31); b += (d >= 35); b += (d >= 40); b += (d >= 46);
    b += (d >= 52); b += (d >= 59); b += (d >= 67); b += (d >= 77); b += (d >= 87); b += (d >= 99); b += (d >= 113);
    return b;
}
__device__ __forceinline__ void phase_prologue(const Ctx& C) {
    float* scr = (float*)(C.lds + C.wave * 16384);
    const int gw = C.bid * NWAVES + C.wave, NGW = C.G * NWAVES;
    constexpr int I_IN = (DM / 64) * (DIN / 32), I_OUT = (DM / 64) * (DM / 32);
    constexpr int NITEMS = DEPTH * (I_IN + I_OUT);
    for (int it = gw; it < NITEMS; it += NGW) {
        const int l = it / (I_IN + I_OUT); int r = it % (I_IN + I_OUT);
        if (r < I_IN) p0_transpose_item(C.w_in + (size_t)l * DM * DIN, C.norm_g + l * DM, DM, DIN, (bf16*)(C.ws + WS_WIN) + (size_t)l * DIN * DM, scr, r, C.lane, C.ws + WS_WIN8 + (size_t)l * 1536 * 2 * DM);
        else p0_transpose_item(C.w_out + (size_t)l * DM * DM, nullptr, DM, DM, (bf16*)(C.ws + WS_WOUT) + (size_t)l * DM * DM, scr, r - I_IN, C.lane);
    }
    { float* km = (float*)(C.ws + WS_KMEAN); for (int e = C.bid * 512 + C.tid; e < DEPTH * NBH * NBLK * 64; e += C.G * 512) km[e] = 0.f; }
    { bf16* wst = (bf16*)(C.ws + WS_WST); const int gt = C.bid * 512 + C.tid, NT = C.G * 512;
      for (int e = gt; e < DEPTH * 8 * 128 * 128; e += NT) { const int s = e & 127, t = (e >> 7) & 127; wst[e] = (s <= t) ? (bf16)f2bf(C.sgu_w[e]) : (bf16)0; } }
    if (C.bid == 0) { float* bt = (float*)(C.ws + WS_BT); for (int e = C.tid; e < 8 * 128; e += 512) { const int h = e >> 7, d = e & 127; bt[e] = C.rel_bias[rel_bucket(d) * 8 + h] * LOG2E; } }
    { bf16* xb = (bf16*)(C.ws + WS_XB); float* rowss = (float*)(C.ws + WS_ROWSS);
      constexpr int UN = 4;
      for (int m0 = gw; m0 < MROWS; m0 += NGW * UN) {
        f32x4 v[UN][4];
#pragma unroll
        for (int k = 0; k < UN; ++k) { const f32x4* xr = (const f32x4*)(C.x + (size_t)(m0 + k * NGW) * DM) + C.lane;
#pragma unroll
            for (int j = 0; j < 4; ++j) v[k][j] = xr[64 * j]; }
#pragma unroll
        for (int k = 0; k < UN; ++k) { const int m = m0 + k * NGW;
            float s = 0.f;
#pragma unroll
            for (int j = 0; j < 4; ++j) s += (v[k][j].x * v[k][j].x + v[k][j].y * v[k][j].y) + (v[k][j].z * v[k][j].z + v[k][j].w * v[k][j].w);
            s = wave_sum(s);
            unsigned long long* o8 = (unsigned long long*)(xb + (size_t)m * DM) + C.lane;
#pragma unroll
            for (int j = 0; j < 4; ++j) o8[64 * j] = (unsigned long long)pk2(v[k][j].x, v[k][j].y) | ((unsigned long long)pk2(v[k][j].z, v[k][j].w) << 32);
            { unsigned* sw = (unsigned*)scr + 256 * k;
#pragma unroll
              for (int j = 0; j < 4; ++j) sw[64 * j + C.lane] = pk4_fp8(v[k][j].x, v[k][j].y, v[k][j].z, v[k][j].w);
              LDS_WAIT(); asm volatile("" ::: "memory");
              *(v4u*)(C.ws + WS_XB8 + (size_t)m * 2048 + 16 * C.lane) = *(const v4u*)(sw + 4 * C.lane); }
            if (C.lane < 16) rowss[(size_t)m * 16 + C.lane] = (C.lane == 0) ? s : 0.f; }
      } }
}

typedef short bf16x8 __attribute__((ext_vector_type(8)));
typedef short bf16x4s __attribute__((ext_vector_type(4)));
typedef float f32x16 __attribute__((ext_vector_type(16)));
typedef int v8i_t __attribute__((ext_vector_type(8)));
__device__ __forceinline__ int at_vpos(int kv) { return (kv & ~63) + 32 * ((kv >> 2) & 1) + 16 * ((kv >> 5) & 1) + (kv & 3) + 4 * ((kv >> 3) & 3); }
__device__ __forceinline__ int crow(int r, int hi) { return (r & 3) + 8 * (r >> 2) + 4 * hi; }
__device__ __forceinline__ unsigned cvtpk(float lo, float hi) { unsigned r; asm volatile("v_cvt_pk_bf16_f32 %0, %1, %2" : "=v"(r) : "v"(lo), "v"(hi)); return r; }
__device__ __forceinline__ void phase_gate(const Ctx& C, int layer) {
    const bf16* Q = (const bf16*)(C.ws + WS_PROJ) + (size_t)T_Q * SUBSTRIDE;
    const float* KM = (const float*)(C.ws + WS_KMEAN) + (size_t)layer * NBH * NBLK * 64;
    int* SEL = (int*)(C.ws + WS_SEL); int* LOFF = (int*)(C.ws + WS_LOFF); unsigned short* LIST = (unsigned short*)(C.ws + WS_LIST);
    int* cnt = (int*)(C.lds);
    int* offs = (int*)(C.lds + 256);
    unsigned char* kml = C.lds + 1024;
    const int lane = C.lane, ql = lane & 31, hi = lane >> 5;
    bf16x8 qfN[4]; f32x4 kmr[2];
#define GATE_LOAD(uu) do { const int bh_ = (uu) / 63, i_ = (uu) % 63 + 1, b_ = bh_ >> 3, h_ = bh_ & 7; \
        const bf16* qrow_ = Q + ((size_t)(b_ * SEQ + i_ * 256 + C.wave * 32 + ql)) * 512 + h_ * 64 + hi * 8; \
        _Pragma("unroll") for (int ks = 0; ks < 4; ++ks) qfN[ks] = *(const bf16x8*)(qrow_ + ks * 16); \
        const float* kp_ = KM + (size_t)bh_ * NBLK * 64 + C.tid * 8; kmr[0] = *(const f32x4*)kp_; kmr[1] = *(const f32x4*)(kp_ + 4); } while (0)
#define GATE_KML() do { *(v4u*)(kml + (C.tid >> 3) * 144 + (C.tid & 7) * 16) = (v4u){cvtpk(kmr[0][0], kmr[0][1]), cvtpk(kmr[0][2], kmr[0][3]), cvtpk(kmr[1][0], kmr[1][1]), cvtpk(kmr[1][2], kmr[1][3])}; } while (0)
    int u = C.bid;
    if (C.tid < 64) cnt[C.tid] = 0;
    if (u < NBH * 63) { GATE_LOAD(u); GATE_KML(); }
    __syncthreads();
    for (; u < NBH * 63; u += C.G) {
        const int bh = u / 63, i = u % 63 + 1;
        const int q = C.wave * 32 + ql, pos = i * 256 + q;
        bf16x8 qf[4];
#pragma unroll
        for (int ks = 0; ks < 4; ++ks) qf[ks] = qfN[ks];
        const bool more = u + C.G < NBH * 63;
        if (more) GATE_LOAD(u + C.G);
        float b0 = -INFINITY, b1 = -INFINITY, b2 = -INFINITY; int i0 = -1, i1 = -1, i2 = -1;
#define TOP3_INS(v, idx) do { const float v_ = (v); const int x_ = (idx); if (v_ > b0) { b2 = b1; i2 = i1; b1 = b0; i1 = i0; b0 = v_; i0 = x_; } else if (v_ > b1) { b2 = b1; i2 = i1; b1 = v_; i1 = x_; } else if (v_ > b2) { b2 = v_; i2 = x_; } } while (0)
#pragma unroll
        for (int nt = 0; nt < 2; ++nt) {
            f32x16 p = {};
#pragma unroll
            for (int ks = 0; ks < 4; ++ks) {
                const bf16x8 kw = *(const bf16x8*)(kml + (32 * nt + ql) * 144 + ks * 32 + hi * 16);
                p = __builtin_amdgcn_mfma_f32_32x32x16_bf16(kw, qf[ks], p, 0, 0, 0);
            }
#pragma unroll
            for (int r = 0; r < 16; ++r) { const int n = 32 * nt + crow(r, hi); if (n < i) TOP3_INS(p[r], n); }
        }
        { const float c0 = lx_xor(b0, 32), c1 = lx_xor(b1, 32), c2 = lx_xor(b2, 32);
          const int j0 = lx_xor(i0, 32), j1 = lx_xor(i1, 32), j2 = lx_xor(i2, 32);
          if (j0 >= 0) TOP3_INS(c0, j0);
          if (j1 >= 0) TOP3_INS(c1, j1);
          if (j2 >= 0) TOP3_INS(c2, j2); }
#undef TOP3_INS
        int p0 = 0, p1 = 0, p2 = 0;
        if (hi == 0) {
            if (CHECK_ATTN) { int* sp = SEL + ((size_t)bh * SEQ + pos) * 4; sp[0] = i0; sp[1] = i1; sp[2] = i2; sp[3] = -1; }
            p0 = atomicAdd(&cnt[i0], 1);
            if (i1 >= 0) p1 = atomicAdd(&cnt[i1], 1);
            if (i2 >= 0) p2 = atomicAdd(&cnt[i2], 1);
        }
        __syncthreads();
        if (C.tid < 64) {
            const int c = cnt[C.tid]; cnt[C.tid] = 0;
            int inc = c;
#pragma unroll
            for (int o = 1; o < 64; o <<= 1) { const int t = lx_up(inc, o); if (C.tid >= o) inc += t; }
            offs[C.tid + 1] = inc; if (C.tid == 0) offs[0] = 0;
            LOFF[(size_t)(bh * NBLK + i) * 80 + C.tid + 1] = inc; if (C.tid == 0) LOFF[(size_t)(bh * NBLK + i) * 80] = 0;
        }
        if (more) GATE_KML();
        __syncthreads();
        if (hi == 0) {
            unsigned short* lp = LIST + (size_t)(bh * NBLK + i) * 768;
            lp[offs[i0] + p0] = (unsigned short)(q | (0 << 8));
            if (i1 >= 0) lp[offs[i1] + p1] = (unsigned short)(q | (1 << 8));
            if (i2 >= 0) lp[offs[i2] + p2] = (unsigned short)(q | (2 << 8));
        }
    }
#undef GATE_LOAD
#undef GATE_KML
    if (CHECK_ATTN) { for (int e = C.bid * 512 + C.tid; e < NBH * 256; e += C.G * 512) { const int bh = e >> 8, qq = e & 255; int* sp = SEL + ((size_t)bh * SEQ + qq) * 4; sp[0] = -1; sp[1] = -1; sp[2] = -1; sp[3] = -1; } }
    __syncthreads();
}

__device__ __forceinline__ void phase_attn_simple(const Ctx& C, bf16* MIX) {
    const bf16* Q = (const bf16*)(C.ws + WS_PROJ) + (size_t)T_Q * SUBSTRIDE;
    const bf16* K = (const bf16*)(C.ws + WS_PROJ) + (size_t)T_K * SUBSTRIDE;
    const bf16* VV = (const bf16*)(C.ws + WS_PROJ) + (size_t)T_VV * SUBSTRIDE;
    const bf16* ZB = (const bf16*)(C.ws + WS_PROJ) + (size_t)T_ZB * SUBSTRIDE;
    const int* SEL = (const int*)(C.ws + WS_SEL); const float* BT = (const float*)(C.ws + WS_BT);
    const int gt = C.bid * 512 + C.tid, NT = C.G * 512;
    for (int item = gt; item < NBH * SEQ; item += NT) {
        const int bh = item >> 14, pos = item & (SEQ - 1), b = bh >> 3, h = bh & 7, own = pos >> 8;
        const size_t rowq = (size_t)(b * SEQ + pos);
        float qv[64], o[64];
        { const v4u* qp = (const v4u*)(Q + rowq * 512 + h * 64);
#pragma unroll
          for (int c = 0; c < 8; ++c) { const v4u v = qp[c]; qv[8 * c + 0] = bflo(v.x); qv[8 * c + 1] = bfhi(v.x); qv[8 * c + 2] = bflo(v.y); qv[8 * c + 3] = bfhi(v.y);
              qv[8 * c + 4] = bflo(v.z); qv[8 * c + 5] = bfhi(v.z); qv[8 * c + 6] = bflo(v.w); qv[8 * c + 7] = bfhi(v.w); } }
#pragma unroll
        for (int d = 0; d < 64; ++d) o[d] = 0.f;
        float m = -INFINITY, l = 0.f;
        const float* bt = BT + h * 128;
        for (int slot = 0; slot < 4; ++slot) {
            int blk, klim;
            if (slot == 0) { blk = own; klim = (pos & 255) + 1; } else { blk = SEL[(size_t)item * 4 + slot - 1]; klim = 256; if (blk < 0) klim = 0; }
            for (int kl = 0; kl < klim; ++kl) {
                const int kpos = blk * 256 + kl;
                const v4u* kp = (const v4u*)(K + ((size_t)(b * SEQ + kpos)) * 512 + h * 64);
                float a0 = 0.f, a1 = 0.f;
#pragma unroll
                for (int c = 0; c < 8; ++c) { const v4u v = kp[c];
                    a0 += qv[8 * c + 0] * bflo(v.x) + qv[8 * c + 2] * bflo(v.y) + qv[8 * c + 4] * bflo(v.z) + qv[8 * c + 6] * bflo(v.w);
                    a1 += qv[8 * c + 1] * bfhi(v.x) + qv[8 * c + 3] * bfhi(v.y) + qv[8 * c + 5] * bfhi(v.z) + qv[8 * c + 7] * bfhi(v.w); }
                int dd = pos - kpos; dd = dd > 127 ? 127 : dd;
                const float s = (a0 + a1) + bt[dd];
                if (s > m) { const float al = __builtin_amdgcn_exp2f(m - s); l *= al;
#pragma unroll
                    for (int d = 0; d < 64; ++d) o[d] *= al;
                    m = s; }
                const float p = __builtin_amdgcn_exp2f(s - m);
                l += p;
                const v4u* vp = (const v4u*)(VV + ((size_t)(b * SEQ + kpos)) * 512 + h * 64);
#pragma unroll
                for (int c = 0; c < 8; ++c) { const v4u v = vp[c];
                    o[8 * c + 0] += p * bflo(v.x); o[8 * c + 1] += p * bfhi(v.x); o[8 * c + 2] += p * bflo(v.y); o[8 * c + 3] += p * bfhi(v.y);
                    o[8 * c + 4] += p * bflo(v.z); o[8 * c + 5] += p * bfhi(v.z); o[8 * c + 6] += p * bflo(v.w); o[8 * c + 7] += p * bfhi(v.w); }
            }
        }
        const float rl = 1.0f / l;
        const v4u* zp = (const v4u*)(ZB + rowq * 512 + h * 64);
        v4u* op = (v4u*)(MIX + rowq * 1024 + 512 + h * 64);
#pragma unroll
        for (int c = 0; c < 8; ++c) { const v4u z = zp[c]; v4u w;
            w.x = pk2(o[8 * c + 0] * rl * pg8::act_silu(bflo(z.x)), o[8 * c + 1] * rl * pg8::act_silu(bfhi(z.x))); w.y = pk2(o[8 * c + 2] * rl * pg8::act_silu(bflo(z.y)), o[8 * c + 3] * rl * pg8::act_silu(bfhi(z.y)));
            w.z = pk2(o[8 * c + 4] * rl * pg8::act_silu(bflo(z.z)), o[8 * c + 5] * rl * pg8::act_silu(bfhi(z.z))); w.w = pk2(o[8 * c + 6] * rl * pg8::act_silu(bflo(z.w)), o[8 * c + 7] * rl * pg8::act_silu(bfhi(z.w)));
            op[c] = w; }
    }
}

constexpr int AT_KS = 0, AT_KPITCH = 144;
constexpr int AT_VT = 36864, AT_VPITCH = 272;
constexpr int AT_DT = AT_VT + 64 * AT_VPITCH;
constexpr int AT_ENT = AT_DT + 4096, AT_CAP = 4096;
constexpr int AT_PRE = AT_ENT + AT_CAP * 4;
constexpr int AT_OST = AT_PRE + 1024;
constexpr int AT_MISC = AT_OST + 8 * 4096;
constexpr int AT_NUNITS = NBLK * NBH;

typedef int v4i_t __attribute__((ext_vector_type(4)));
#ifndef ATTN_STATIC_PRIO
#define ATTN_STATIC_PRIO 1
#endif
#if ATTN_STATIC_PRIO
#define ATTN_PRIO_UP
#define ATTN_PRIO_DN
#else
#define ATTN_PRIO_UP __builtin_amdgcn_s_setprio(1)
#define ATTN_PRIO_DN __builtin_amdgcn_s_setprio(0)
#endif
struct QTile { unsigned ent; v4i_t qf[4]; };
__device__ __forceinline__ void attn_issue_q(QTile& T, const Ctx& C, const unsigned char* lds, int b, int h, int e0, int cnt) {
    const bf16* Q = (const bf16*)(C.ws + WS_PROJ) + (size_t)T_Q * SUBSTRIDE;
    const unsigned* ENT = (const unsigned*)(lds + AT_ENT);
    const int q = C.lane & 31, hi = C.lane >> 5;
    T.ent = ENT[(e0 + q < cnt) ? (e0 + q) : e0];
    const bf16* qrow = Q + ((size_t)(b * SEQ + (int)(T.ent & 16383u))) * 512 + h * 64 + hi * 8;
    asm volatile("global_load_dwordx4 %0, %4, off\n\tglobal_load_dwordx4 %1, %4, off offset:32\n\tglobal_load_dwordx4 %2, %4, off offset:64\n\tglobal_load_dwordx4 %3, %4, off offset:96"
                 : "=&v"(T.qf[0]), "=&v"(T.qf[1]), "=&v"(T.qf[2]), "=&v"(T.qf[3]) : "v"(qrow));
}
__device__ __forceinline__ void attn_wait_q(QTile& T) { asm volatile("s_waitcnt vmcnt(0)" : "+v"(T.qf[0]), "+v"(T.qf[1]), "+v"(T.qf[2]), "+v"(T.qf[3])); }
__device__ __forceinline__ void attn_tile(const Ctx& C, unsigned char* lds, const QTile& T, QTile& Tn, int bh, int e0, int cnt, int nkt2, const bool OWN) {
    bf16* PO = (bf16*)C.out; float* PL = (float*)(C.ws + WS_PL);
    const unsigned* ENT = (const unsigned*)(lds + AT_ENT);
    const int lane = C.lane, q = lane & 31, hi = lane >> 5;
    const unsigned ent = T.ent;
    const int pos = ent & 16383, qoff = (ent >> 16) & 1023;
    f32x16 o0 = {}, o1 = {}, ol = {};
    v8i_t pa8 = {};
    asm volatile("" : "+v"(pa8));
    const bool anybias = OWN ? true : (__any(qoff < 112) != 0);
    const unsigned char* kbase = lds + AT_KS + q * AT_KPITCH + hi * 16;
    const unsigned char* vbase = lds + AT_VT + q * AT_VPITCH + hi * 32;
    const float* et0 = (const float*)(lds + AT_DT) + (1023 - (256 + (OWN ? 0 : 256) + qoff - 4 * hi));
    bf16x8 kf[8];
#pragma unroll
    for (int ks = 0; ks < 4; ++ks) { kf[2 * ks] = *(const bf16x8*)(kbase + ks * 32); kf[2 * ks + 1] = *(const bf16x8*)(kbase + 32 * AT_KPITCH + ks * 32); }
    for (int kt2 = 0; kt2 < nkt2; ++kt2) {
        f32x16 p0, p1;
        if (anybias && (OWN || kt2 >= 2)) {
            const float* et = et0 + 64 * kt2;
#pragma unroll
            for (int r = 0; r < 16; ++r) { p0[r] = et[(r & 3) + 8 * (r >> 2)]; p1[r] = et[32 + (r & 3) + 8 * (r >> 2)]; }
#pragma unroll
            for (int ks = 0; ks < 4; ++ks) {
                p0 = __builtin_amdgcn_mfma_f32_32x32x16_bf16(kf[2 * ks], __builtin_bit_cast(bf16x8, T.qf[ks]), p0, 0, 0, 0);
                p1 = __builtin_amdgcn_mfma_f32_32x32x16_bf16(kf[2 * ks + 1], __builtin_bit_cast(bf16x8, T.qf[ks]), p1, 0, 0, 0);
            }
        } else {
            p0 = (f32x16){}; p1 = (f32x16){};
#pragma unroll
            for (int ks = 0; ks < 4; ++ks) {
                p0 = __builtin_amdgcn_mfma_f32_32x32x16_bf16(kf[2 * ks], __builtin_bit_cast(bf16x8, T.qf[ks]), p0, 0, 0, 0);
                p1 = __builtin_amdgcn_mfma_f32_32x32x16_bf16(kf[2 * ks + 1], __builtin_bit_cast(bf16x8, T.qf[ks]), p1, 0, 0, 0);
            }
        }
        v8i_t vb0, vb1;
        { typedef int v4i_t __attribute__((ext_vector_type(4)));
          const v4i_t a0 = *(const v4i_t*)(vbase + 64 * kt2), a1 = *(const v4i_t*)(vbase + 64 * kt2 + 16);
          const v4i_t c0 = *(const v4i_t*)(vbase + 32 * AT_VPITCH + 64 * kt2), c1 = *(const v4i_t*)(vbase + 32 * AT_VPITCH + 64 * kt2 + 16);
          vb0 = __builtin_shufflevector(a0, a1, 0, 1, 2, 3, 4, 5, 6, 7); vb1 = __builtin_shufflevector(c0, c1, 0, 1, 2, 3, 4, 5, 6, 7); }
#pragma unroll
        for (int r = 0; r < 16; ++r) { p0[r] = __builtin_amdgcn_exp2f(p0[r]); p1[r] = __builtin_amdgcn_exp2f(p1[r]); }
        { typedef short v2s_t __attribute__((ext_vector_type(2)));
#pragma unroll
          for (int i = 0; i < 4; ++i) {
              v2s_t w = __builtin_bit_cast(v2s_t, pa8[i]);
              w = __builtin_amdgcn_cvt_scalef32_pk_fp8_f32(w, p0[4 * i], p0[4 * i + 1], 16.0f, false); w = __builtin_amdgcn_cvt_scalef32_pk_fp8_f32(w, p0[4 * i + 2], p0[4 * i + 3], 16.0f, true);
              pa8[i] = __builtin_bit_cast(int, w);
              v2s_t z = __builtin_bit_cast(v2s_t, pa8[4 + i]);
              z = __builtin_amdgcn_cvt_scalef32_pk_fp8_f32(z, p1[4 * i], p1[4 * i + 1], 16.0f, false); z = __builtin_amdgcn_cvt_scalef32_pk_fp8_f32(z, p1[4 * i + 2], p1[4 * i + 3], 16.0f, true);
              pa8[4 + i] = __builtin_bit_cast(int, z);
          } }
        if (kt2 + 1 < nkt2) {
#pragma unroll
            for (int ks = 0; ks < 4; ++ks) { kf[2 * ks] = *(const bf16x8*)(kbase + (64 * kt2 + 64) * AT_KPITCH + ks * 32); kf[2 * ks + 1] = *(const bf16x8*)(kbase + (64 * kt2 + 96) * AT_KPITCH + ks * 32); }
        }
        ATTN_PRIO_UP;
        o0 = __builtin_amdgcn_mfma_scale_f32_32x32x64_f8f6f4(vb0, pa8, o0, 0, 0, 0, 0x7f7f7f7f, 0, (int)0x83838383);
        o1 = __builtin_amdgcn_mfma_scale_f32_32x32x64_f8f6f4(vb1, pa8, o1, 0, 0, 0, 0x7f7f7f7f, 0, (int)0x83838383);
        v8i_t ones8;
#pragma unroll
        for (int i = 0; i < 8; ++i) { int c_; asm volatile("v_mov_b32 %0, 0x38383838" : "=v"(c_)); ones8[i] = c_; }
        ol = __builtin_amdgcn_mfma_scale_f32_32x32x64_f8f6f4(ones8, pa8, ol, 0, 0, 0, 0x7f7f7f7f, 0, (int)0x83838383);
        ATTN_PRIO_DN;
    }
    const float l = ol[0];
    attn_wait_q(Tn);
    if (e0 + q < cnt) PL[((size_t)bh * SEQ + pos) * 4 + ((ent >> 14) & 3)] = l;
    { bf16* prow = PO + (((size_t)bh * SEQ + pos) * 4 + ((ent >> 14) & 3)) * 64 + hi * 8;
      const bool live = e0 + q < cnt;
#pragma unroll
      for (int j = 0; j < 2; ++j) {
          unsigned a0 = pg8::cvt_pk_bf16(o0[8 * j], o0[8 * j + 1]), a1 = pg8::cvt_pk_bf16(o0[8 * j + 2], o0[8 * j + 3]), b0 = pg8::cvt_pk_bf16(o0[8 * j + 4], o0[8 * j + 5]), b1 = pg8::cvt_pk_bf16(o0[8 * j + 6], o0[8 * j + 7]);
          { auto r0 = __builtin_amdgcn_permlane32_swap(a0, b0, false, false); a0 = r0[0]; b0 = r0[1]; auto r1 = __builtin_amdgcn_permlane32_swap(a1, b1, false, false); a1 = r1[0]; b1 = r1[1]; }
          unsigned c0 = pg8::cvt_pk_bf16(o1[8 * j], o1[8 * j + 1]), c1 = pg8::cvt_pk_bf16(o1[8 * j + 2], o1[8 * j + 3]), d0 = pg8::cvt_pk_bf16(o1[8 * j + 4], o1[8 * j + 5]), d1 = pg8::cvt_pk_bf16(o1[8 * j + 6], o1[8 * j + 7]);
          { auto r0 = __builtin_amdgcn_permlane32_swap(c0, d0, false, false); c0 = r0[0]; d0 = r0[1]; auto r1 = __builtin_amdgcn_permlane32_swap(c1, d1, false, false); c1 = r1[0]; d1 = r1[1]; }
          if (live) { *(v4u*)(prow + 16 * j) = (v4u){a0, a1, b0, b1}; *(v4u*)(prow + 32 + 16 * j) = (v4u){c0, c1, d0, d1}; }
      } }
}

__device__ __forceinline__ void phase_attn(const Ctx& C, int layer) {
    if (ATTN_STATIC_PRIO && C.wave >= 4) __builtin_amdgcn_s_setprio(2);
    unsigned char* lds = C.lds;
    const bf16* K = (const bf16*)(C.ws + WS_PROJ) + (size_t)T_K * SUBSTRIDE;
    const bf16* VV = (const bf16*)(C.ws + WS_PROJ) + (size_t)T_VV * SUBSTRIDE;
    const int* LOFF = (const int*)(C.ws + WS_LOFF); const unsigned short* LIST = (const unsigned short*)(C.ws + WS_LIST);
    const float* BT = (const float*)(C.ws + WS_BT);
    const int qg = C.bid & 7;
    unsigned* ctr = (unsigned*)(C.ws + WS_CTL) + 64 + 64 * layer;
    int qstep = 0;
    unsigned* ENT = (unsigned*)(lds + AT_ENT);
    int* PRE = (int*)(lds + AT_PRE); int* LO = PRE + 68;
    volatile unsigned* MISC = (volatile unsigned*)(lds + AT_MISC);
    int tid = C.tid;
    v4u kpre[4], vpre[4]; int lpre0 = 0, lpre1 = 0;
#define AT_LOADKV(uu) do { const int bh_ = (uu) & 15, n_ = (uu) >> 4; \
        const bf16* Kg = K + ((size_t)((bh_ >> 3) * SEQ + n_ * 256)) * 512 + (bh_ & 7) * 64; const bf16* Vg = VV + ((size_t)((bh_ >> 3) * SEQ + n_ * 256)) * 512 + (bh_ & 7) * 64; \
        _Pragma("unroll") for (int it = 0; it < 4; ++it) { const int idx = tid + 512 * it; kpre[it] = *(const v4u*)(Kg + (size_t)(idx >> 3) * 512 + (idx & 7) * 8); \
            vpre[it] = *(const v4u*)(Vg + (size_t)(idx >> 3) * 512 + (idx & 7) * 8); } \
        lpre0 = 0; lpre1 = 0; if (tid < 64 && n_ + 1 + tid < NBLK) { const int* lp_ = LOFF + ((size_t)(bh_ * NBLK + n_ + 1 + tid)) * 80 + n_; lpre0 = lp_[0]; lpre1 = lp_[1]; } } while (0)
#define AT_FETCH() ({ unsigned r_ = (unsigned)AT_NUNITS; while (qstep < 8) { const int g_ = (qg + qstep) & 7; const unsigned k_ = atomicAdd(ctr + 4 * g_, 1u); \
        if (k_ < 2u * NBLK) { r_ = (k_ >> 1) * 16 + 2 * g_ + (k_ & 1); break; } ++qstep; } r_; })
    if (tid == 0) MISC[0] = AT_FETCH();
    __syncthreads();
    int u = (int)MISC[0];
    if (u < AT_NUNITS) AT_LOADKV(u);
    while (u < AT_NUNITS) {
        asm volatile("" : "+v"(tid));
        Ctx Cu = C; Cu.tid = tid; Cu.lane = tid & 63;
        const int bh = u & 15, n = u >> 4, b = bh >> 3, h = bh & 7;
        if (tid == 0) MISC[1] = AT_FETCH();
#pragma unroll
        for (int it = 0; it < 4; ++it) { const int idx = tid + 512 * it;
            *(v4u*)(lds + AT_KS + (idx >> 3) * AT_KPITCH + (idx & 7) * 16) = kpre[it];
            const v4u v = vpre[it];
            unsigned char* vt = lds + AT_VT + (8 * (idx & 7)) * AT_VPITCH + at_vpos(idx >> 3);
            const unsigned w01 = pk4_fp8(bflo(v.x), bfhi(v.x), bflo(v.y), bfhi(v.y)), w23 = pk4_fp8(bflo(v.z), bfhi(v.z), bflo(v.w), bfhi(v.w));
            vt[0 * AT_VPITCH] = (unsigned char)(w01); vt[1 * AT_VPITCH] = (unsigned char)(w01 >> 8); vt[2 * AT_VPITCH] = (unsigned char)(w01 >> 16); vt[3 * AT_VPITCH] = (unsigned char)(w01 >> 24);
            vt[4 * AT_VPITCH] = (unsigned char)(w23); vt[5 * AT_VPITCH] = (unsigned char)(w23 >> 8); vt[6 * AT_VPITCH] = (unsigned char)(w23 >> 16); vt[7 * AT_VPITCH] = (unsigned char)(w23 >> 24); }
        { float* et_ = (float*)(lds + AT_DT);
#pragma unroll
          for (int k_ = 0; k_ < 2; ++k_) { const int j_ = tid + 512 * k_, d_ = j_ - 256; et_[1023 - j_] = d_ < 0 ? -INFINITY : (d_ < 128 ? BT[h * 128 + d_] - BT[h * 128 + 127] : 0.f);     } }
        if (tid < 64) {
            const int lo = lpre0; int inc = lpre1 - lpre0;
#pragma unroll
            for (int o = 1; o < 64; o <<= 1) { const int t = lx_up(inc, o); if (tid >= o) inc += t; }
            PRE[tid + 1] = inc; LO[tid] = lo; if (tid == 0) PRE[0] = 0;
        }
        __syncthreads();
        const int total = 256 + PRE[63 - n];
        const int unext = (int)MISC[1];
        if (unext < AT_NUNITS) AT_LOADKV(unext);
        for (int base = 0; base < total; base += AT_CAP) {
            const int cnt = (total - base < AT_CAP) ? (total - base) : AT_CAP;
            if (base == 0 && tid < 256) ENT[tid] = (unsigned)(n * 256 + tid) | (3u << 14) | ((unsigned)tid << 16);
            { const int e_lo = base > 256 ? base : 256, e_hi = base + cnt;
#pragma unroll 4
              for (int e = e_lo + tid; e < e_hi; e += 512) {
                  const int es = e - 256; int a = 0, z = 63 - n;
#pragma unroll
                  for (int it = 0; it < 6; ++it) { const int mid = (a + z) >> 1; const bool up = (z - a > 1) && (PRE[mid] <= es); const bool dn = (z - a > 1) && !up; a = up ? mid : a; z = dn ? mid : z; }
                  const int ii = a, i = n + 1 + ii;
                  const unsigned val = LIST[((size_t)(bh * NBLK + i)) * 768 + LO[ii] + (es - PRE[ii])]; const unsigned ql = val & 255u, j = val >> 8;
                  ENT[e - base] = (unsigned)(i * 256 + ql) | (j << 14) | ((ii == 0 ? ql : 400u) << 16);
              } }
            if (tid == 0) MISC[2] = 0u;
            __syncthreads();
            const int ntiles = (cnt + 31) >> 5;
            const int nown = (base == 0) ? 8 : 0;
#define AT_TICKET() ({ int tk_ = 0; if (Cu.lane == 0) tk_ = (int)atomicAdd((unsigned*)(lds + AT_MISC + 8), 1u); __builtin_amdgcn_readfirstlane(tk_); })
#define AT_TILEOF(tk_) (((tk_) < ntiles - nown) ? nown + (tk_) : (ntiles - 1 - (tk_)))
            { int tk = AT_TICKET();
              if (tk < ntiles) {
                  int tile = AT_TILEOF(tk);
                  QTile Tc; attn_issue_q(Tc, Cu, lds, b, h, tile * 32, cnt); attn_wait_q(Tc);
                  for (;;) {
                      const int tkn = AT_TICKET(); const bool more = tkn < ntiles; const int tilen = more ? AT_TILEOF(tkn) : 0;
                      QTile Tn; attn_issue_q(Tn, Cu, lds, b, h, tilen * 32, cnt);
                      { const bool own_ = tile < nown; attn_tile(Cu, lds, Tc, Tn, bh, tile * 32, cnt, own_ ? (tile >> 1) + 1 : 4, own_); }
                      if (!more) break;
                      Tc = Tn; tile = tilen;
                  }
              } }
#undef AT_TICKET
#undef AT_TILEOF
            __syncthreads();
        }
        u = unext;
    }
#undef AT_LOADKV
#undef AT_FETCH
    if (ATTN_STATIC_PRIO) __builtin_amdgcn_s_setprio(0);
}

__device__ __forceinline__ void phase_combine(const Ctx& C) {
    const bf16* PO = (const bf16*)C.out; const float* PL = (const float*)(C.ws + WS_PL);
    const bf16* ZB = (const bf16*)(C.ws + WS_PROJ) + (size_t)T_ZB * SUBSTRIDE;
    bf16* MIX = (bf16*)(C.ws + WS_MIX);
    const int gt = C.bid * 512 + C.tid, NT = C.G * 512;
    constexpr int UN = 4;
    for (int idx0 = gt; idx0 < MROWS * 64; idx0 += NT * UN) {
        f32x4 lv[UN]; v4u pv[UN][4]; v4u zv[UN];
#pragma unroll
        for (int k = 0; k < UN; ++k) {
            const int idx = idx0 + k * NT;
            const int ch = idx & 7, h = (idx >> 3) & 7, row = idx >> 6, b = row >> 14, pos = row & (SEQ - 1), i = pos >> 8;
            const size_t pb = ((size_t)(b * NH + h) * SEQ + pos) * 4;
            lv[k] = *(const f32x4*)(PL + pb);
#pragma unroll
            for (int j = 0; j < 4; ++j) pv[k][j] = (j == 3 || j < i) ? *(const v4u*)(PO + (pb + j) * 64 + ch * 8) : (v4u){0u, 0u, 0u, 0u};
            zv[k] = *(const v4u*)(ZB + (size_t)row * 512 + h * 64 + ch * 8);
        }
#pragma unroll
        for (int k = 0; k < UN; ++k) {
            const int idx = idx0 + k * NT;
            const int ch = idx & 7, h = (idx >> 3) & 7, row = idx >> 6, pos = row & (SEQ - 1), i = pos >> 8;
            float L = lv[k][3];
#pragma unroll
            for (int j = 0; j < 3; ++j) L += (j < i) ? lv[k][j] : 0.f;
            float acc[8];
#pragma unroll
            for (int e = 0; e < 8; ++e) acc[e] = 0.f;
#pragma unroll
            for (int j = 0; j < 4; ++j) { const v4u v = pv[k][j];
                acc[0] += bflo(v.x); acc[1] += bfhi(v.x); acc[2] += bflo(v.y); acc[3] += bfhi(v.y); acc[4] += bflo(v.z); acc[5] += bfhi(v.z); acc[6] += bflo(v.w); acc[7] += bfhi(v.w); }
            const float rl = 1.0f / L;
            const v4u z = zv[k];
            v4u w;
            w.x = pk2(acc[0] * rl * pg8::act_silu(bflo(z.x)), acc[1] * rl * pg8::act_silu(bfhi(z.x))); w.y = pk2(acc[2] * rl * pg8::act_silu(bflo(z.y)), acc[3] * rl * pg8::act_silu(bfhi(z.y)));
            w.z = pk2(acc[4] * rl * pg8::act_silu(bflo(z.z)), acc[5] * rl * pg8::act_silu(bfhi(z.z))); w.w = pk2(acc[6] * rl * pg8::act_silu(bflo(z.w)), acc[7] * rl * pg8::act_silu(bfhi(z.w)));
            *(v4u*)(MIX + (size_t)row * 1024 + 512 + h * 64 + ch * 8) = w;
        }
    }
}

constexpr int SG_VPITCH = 272, SG_MPITCH = 144, SG_WREG = 128 * SG_MPITCH;
constexpr int SG_STATS = 8 * SG_WREG;
constexpr int SG_MR = SG_STATS + 8192;
constexpr int SG_LN = SG_MR + 1024;
__device__ __forceinline__ void phase_sgu(const Ctx& C, int layer) {
    typedef float f32x2v __attribute__((ext_vector_type(2)));
    unsigned char* lds = C.lds;
    const bf16* U = (const bf16*)(C.ws + WS_PROJ) + (size_t)T_U * SUBSTRIDE;
    const bf16* V = (const bf16*)(C.ws + WS_PROJ) + (size_t)T_V * SUBSTRIDE;
    const bf16* ZA = (const bf16*)(C.ws + WS_PROJ) + (size_t)T_ZA * SUBSTRIDE;
    bf16* MIX = (bf16*)(C.ws + WS_MIX);
    const int g = C.wave; int lane = C.lane;
    const float* lng = C.ln_g + layer * 512 + g * 64; const float* lnb = C.ln_b + layer * 512 + g * 64;
    const bf16* Wg = (const bf16*)(C.ws + WS_WST) + ((size_t)(layer * 8 + g)) * 128 * 128;
    const float* bg = C.sgu_b + (layer * 8 + g) * 128;
    unsigned char* myreg = lds + g * SG_WREG;
    f32x2v* stats = (f32x2v*)(lds + SG_STATS); f32x2v* mr = (f32x2v*)(lds + SG_MR);
    float* lnl = (float*)(lds + SG_LN + g * 512);
    lnl[lane] = lng[lane]; lnl[64 + lane] = lnb[lane];
    for (int u = C.bid; u < MROWS / 128; u += C.G) {
        const size_t row0 = (size_t)u * 128;
        asm volatile("" : "+v"(lane));
        v4u xv[2][8];
#pragma unroll
        for (int rr = 0; rr < 2; ++rr) {
            const v4u* vp = (const v4u*)(V + (row0 + lane + 64 * rr) * 512 + g * 64);
#pragma unroll
            for (int c = 0; c < 8; ++c) xv[rr][c] = vp[c];
        }
#pragma unroll
        for (int rr = 0; rr < 2; ++rr) {
            float s1 = 0.f, s2 = 0.f;
#pragma unroll
            for (int c = 0; c < 8; ++c) { v4u v = xv[rr][c];
                v.x = pk2(pg8::act_gelu(bflo(v.x)), pg8::act_gelu(bfhi(v.x))); v.y = pk2(pg8::act_gelu(bflo(v.y)), pg8::act_gelu(bfhi(v.y)));
                v.z = pk2(pg8::act_gelu(bflo(v.z)), pg8::act_gelu(bfhi(v.z))); v.w = pk2(pg8::act_gelu(bflo(v.w)), pg8::act_gelu(bfhi(v.w))); xv[rr][c] = v;
                const float f0 = bflo(v.x), f1 = bfhi(v.x), f2 = bflo(v.y), f3 = bfhi(v.y), f4 = bflo(v.z), f5 = bfhi(v.z), f6 = bflo(v.w), f7 = bfhi(v.w);
                s1 += ((f0 + f1) + (f2 + f3)) + ((f4 + f5) + (f6 + f7));
                s2 += ((f0 * f0 + f1 * f1) + (f2 * f2 + f3 * f3)) + ((f4 * f4 + f5 * f5) + (f6 * f6 + f7 * f7)); }
            stats[g * 128 + lane + 64 * rr] = (f32x2v){s1, s2};
        }
        bf16x8 wf[4][8];
        { const bf16* wa = Wg + (size_t)(lane & 31) * 128 + (lane >> 5) * 8;
#pragma unroll
          for (int tt = 0; tt < 4; ++tt)
#pragma unroll
              for (int ks = 0; ks < 8; ++ks) if (tt >= (ks >> 1)) wf[tt][ks] = *(const bf16x8*)(wa + (size_t)tt * 32 * 128 + ks * 16); }
        __syncthreads();
        if (C.tid < 128) {
            float s1 = 0.f, s2 = 0.f;
#pragma unroll
            for (int w = 0; w < 8; ++w) { const f32x2v t = stats[w * 128 + C.tid]; s1 += t.x; s2 += t.y; }
            const float mean = s1 * (1.0f / 512.0f), var = s2 * (1.0f / 512.0f) - mean * mean;
            mr[C.tid] = (f32x2v){mean, 1.0f / sqrtf(var + LN_EPS)};
        }
        __syncthreads();
#pragma unroll
        for (int c = 0; c < 8; ++c) asm volatile("" : "+v"(xv[0][c]), "+v"(xv[1][c]));
        { const f32x2v m0 = mr[lane], m1 = mr[lane + 64];
          unsigned short* vt = (unsigned short*)(myreg + lane * 2);
#pragma unroll
          for (int c = 0; c < 8; ++c) {
              const v4u v0 = xv[0][c], v1 = xv[1][c];
              const float f0[8] = {bflo(v0.x), bfhi(v0.x), bflo(v0.y), bfhi(v0.y), bflo(v0.z), bfhi(v0.z), bflo(v0.w), bfhi(v0.w)};
              const float f1[8] = {bflo(v1.x), bfhi(v1.x), bflo(v1.y), bfhi(v1.y), bflo(v1.z), bfhi(v1.z), bflo(v1.w), bfhi(v1.w)};
#pragma unroll
              for (int e = 0; e < 8; ++e) { const int d = 8 * c + e; const float gg = lnl[d], bbv = lnl[64 + d];
                  vt[d * (SG_VPITCH / 2)] = (unsigned short)f2bf((f0[e] - m0.x) * m0.y * gg + bbv);
                  vt[d * (SG_VPITCH / 2) + 64] = (unsigned short)f2bf((f1[e] - m1.x) * m1.y * gg + bbv); }
              asm volatile("" ::: "memory");
          } }
        LDS_WAIT(); asm volatile("" ::: "memory");
        { const int q = lane & 31, hi = lane >> 5;
          unsigned pk[2][4][8];
#pragma unroll
          for (int dt = 0; dt < 2; ++dt) {
              const unsigned char* bb = myreg + (32 * dt + q) * SG_VPITCH + hi * 16;
              f32x16 acc[4];
#pragma unroll
              for (int tt = 0; tt < 4; ++tt) acc[tt] = (f32x16){};
#pragma unroll
              for (int ks = 0; ks < 8; ++ks) {
                  const bf16x8 b0 = *(const bf16x8*)(bb + ks * 32);
#pragma unroll
                  for (int tt = 0; tt < 4; ++tt) if (tt >= (ks >> 1)) acc[tt] = __builtin_amdgcn_mfma_f32_32x32x16_bf16(wf[tt][ks], b0, acc[tt], 0, 0, 0);
              }
#pragma unroll
              for (int tt = 0; tt < 4; ++tt)
#pragma unroll
                  for (int rp = 0; rp < 8; ++rp) pk[dt][tt][rp] = cvtpk(acc[tt][2 * rp], acc[tt][2 * rp + 1]);
          }
          LDS_WAIT(); asm volatile("" ::: "memory");
          unsigned char* mxb = myreg + (4 * hi) * SG_MPITCH + q * 2;
#pragma unroll
          for (int dt = 0; dt < 2; ++dt)
#pragma unroll
              for (int tt = 0; tt < 4; ++tt)
#pragma unroll
                  for (int r = 0; r < 16; ++r)
                      *(unsigned short*)(mxb + (32 * tt + (r & 3) + 8 * (r >> 2)) * SG_MPITCH + 64 * dt) = (unsigned short)((r & 1) ? (pk[dt][tt][r >> 1] >> 16) : (pk[dt][tt][r >> 1] & 0xffffu));
        }
        LDS_WAIT(); asm volatile("" ::: "memory");
        { const int ch = lane & 7, r8 = lane >> 3;
#pragma unroll 4
          for (int it = 0; it < 16; ++it) {
              const int t = it * 8 + r8;
              const v4u mv = *(const v4u*)(myreg + t * SG_MPITCH + ch * 16);
              const v4u uv = *(const v4u*)(U + (row0 + t) * 512 + g * 64 + ch * 8), zv = *(const v4u*)(ZA + (row0 + t) * 512 + g * 64 + ch * 8);
              const float bt = bg[t];
              v4u o;
#define SGU_Y(uw, mw, zw) pk2(pg8::act_gelu(bflo(uw)) * (bflo(mw) + bt) * pg8::act_silu(bflo(zw)), pg8::act_gelu(bfhi(uw)) * (bfhi(mw) + bt) * pg8::act_silu(bfhi(zw)))
              o.x = SGU_Y(uv.x, mv.x, zv.x); o.y = SGU_Y(uv.y, mv.y, zv.y); o.z = SGU_Y(uv.z, mv.z, zv.z); o.w = SGU_Y(uv.w, mv.w, zv.w);
#undef SGU_Y
              *(v4u*)(MIX + (row0 + t) * 1024 + g * 64 + ch * 8) = o;
          } }
        __syncthreads();
    }
}

__device__ __forceinline__ void phase_check_inject(const Ctx& C) {
    if (C.bid == 0 && C.tid == 0) C.out[0] = __uint_as_float(((const unsigned*)(C.ws + WS_CTL))[32]) * 1e6f;
}

#define GAS __attribute__((address_space(1)))
typedef GAS unsigned gu32;
#define RLX_AGENT __ATOMIC_RELAXED, __HIP_MEMORY_SCOPE_AGENT
constexpr int CW_BAR = 4096;
constexpr int LDS_BARST = LDS_BYTES - 64;
#define XB_TMO      128
#define XB_XCNT(j)  (256  + 64 * (j))
#define XB_XSUB(j)  (1280 + 64 * (j))
#define XB_XGEN(j)  (2304 + 64 * (j))
#define XB_TOP      3328
#define XB_TOPGEN   3392
#define XCD_BAR_WORDS 3456
#define XB_SPIN_CAP (1u << 18)

__device__ __forceinline__ unsigned xb_ld(unsigned* p)              { return __hip_atomic_load(p, __ATOMIC_RELAXED, __HIP_MEMORY_SCOPE_AGENT); }
__device__ __forceinline__ unsigned xb_add(unsigned* p, unsigned v) { return __hip_atomic_fetch_add(p, v, __ATOMIC_RELAXED, __HIP_MEMORY_SCOPE_AGENT); }
__device__ __forceinline__ unsigned xb_xcc_id() { return (unsigned)__builtin_amdgcn_s_getreg((3 << 11) | 20) & 0xFu; }
#define XB_SPIN(cond, bar) do { unsigned _sp = 0; while (cond) { __builtin_amdgcn_s_sleep(1); \
    if ((++_sp & 255u) == 0u) { if (xb_ld(&(bar)[XB_TMO])) break; if (_sp > XB_SPIN_CAP) { atomicAdd(&(bar)[XB_TMO], 1u); break; } } } } while (0)

struct XcdBarrier {
    unsigned* bar; unsigned x;
    volatile LAS unsigned* st;
};

__device__ __forceinline__ XcdBarrier xcd_barrier_post(unsigned* bar, volatile LAS unsigned* st) {
    XcdBarrier b; b.bar = bar; b.x = xb_xcc_id(); b.st = st;
    if (threadIdx.x == 0) (void)xb_add(&bar[XB_XCNT(b.x)], 1u);
    return b;
}
__device__ __forceinline__ void xcd_barrier_complete(unsigned* bar, unsigned x, unsigned& nloc, unsigned& nx) {
    const unsigned G = gridDim.x * gridDim.y * gridDim.z;
    unsigned sum, cnt, mine, sp = 0u;
    for (;;) {
        sum = 0u; cnt = 0u; mine = 0u;
#pragma unroll
        for (unsigned j = 0; j < 16; ++j) { const unsigned c = xb_ld(&bar[XB_XCNT(j)]); sum += c; cnt += (c > 0u) ? 1u : 0u; mine = (j == x) ? c : mine; }
        if (sum == G) break;
        __builtin_amdgcn_s_sleep(1);
        if ((++sp & 255u) == 0u) { if (xb_ld(&bar[XB_TMO])) break; if (sp > XB_SPIN_CAP) { atomicAdd(&bar[XB_TMO], 1u); break; } }
    }
    nloc = mine > 0u ? mine : 1u; nx = cnt > 0u ? cnt : 1u;
}

__device__ __forceinline__ void xcd_barrier(const XcdBarrier& b, const bool leader_thread) {
    asm volatile("s_waitcnt vmcnt(0)" ::: "memory");
    __syncthreads();
    if (leader_thread) {
        unsigned* bar = b.bar;
        __builtin_amdgcn_s_waitcnt(0);
        unsigned nloc = b.st[0], nx = b.st[1];
        if (nloc == 0u) { xcd_barrier_complete(bar, b.x, nloc, nx); b.st[0] = nloc; b.st[1] = nx; }
        const unsigned old = xb_add(&bar[XB_XSUB(b.x)], 1u);
        const unsigned gen = old / nloc;
        if (old + 1u == (gen + 1u) * nloc) {
            __builtin_amdgcn_fence(__ATOMIC_RELEASE, "agent");
            asm volatile("s_waitcnt vmcnt(0)" ::: "memory");
            const unsigned og = xb_add(&bar[XB_TOP], 1u);
            const unsigned tg = og / nx;
            if (og + 1u == (tg + 1u) * nx) xb_add(&bar[XB_TOPGEN], 1u);
            else XB_SPIN(xb_ld(&bar[XB_TOPGEN]) == tg, bar);
            __builtin_amdgcn_fence(__ATOMIC_ACQUIRE, "agent");
            xb_add(&bar[XB_XGEN(b.x)], 1u);
            asm volatile("s_waitcnt vmcnt(0)" ::: "memory");
        } else {
            XB_SPIN(xb_ld(&bar[XB_XGEN(b.x)]) == gen, bar);
            __builtin_amdgcn_fence(__ATOMIC_ACQUIRE, "agent");
            asm volatile("s_waitcnt vmcnt(0)" ::: "memory");
        }
    }
    __syncthreads();
}

template <int ST> __device__ __forceinline__ void run_stage(const Args& args, unsigned char* lds, int Lr, int wave_s) {
    const int L = Lr;
    Ctx C;
    { int t = wave_s * 64 + lane_now(); C.tid = t; }
    C.lds = lds; C.lane = C.tid & 63; C.wave = __builtin_amdgcn_readfirstlane(C.tid >> 6); C.G = gridDim.x; C.bid = blockIdx.x;
    C.x = args.in[0]; C.norm_g = args.in[1]; C.w_in = args.in[2]; C.ln_g = args.in[3]; C.ln_b = args.in[4]; C.sgu_w = args.in[5]; C.sgu_b = args.in[6];
    C.w_out = args.in[7]; C.rel_bias = args.in[8]; C.final_g = args.in[9]; C.out = args.out; C.ws = args.ws;
    asm volatile("" : "+s"(C.ws), "+s"(C.out), "+s"(C.x), "+s"(C.sgu_b), "+s"(C.ln_g), "+s"(C.ln_b));
    if constexpr (ST == 0) phase_prologue(C);
    else if constexpr (ST == 1) {
        float* rtab = (float*)(lds + RING_BYTES);
        const float* rowss = (const float*)(C.ws + WS_ROWSS);
        float* kmean = (float*)(C.ws + WS_KMEAN) + (size_t)L * NBH * NBLK * 64;
#define RTAB_BUILD(S_) do { pmA = -1; pmB = -1; pmC = -1; pmD = -1; \
          { pg8::Unit uu; for (int i = 0; S_.next(i, uu); ++i) { const int pmu = uu.pm; \
              if (pmu == pmA || pmu == pmB || pmu == pmC || pmu == pmD) continue; \
              if (pmA < 0) pmA = pmu; else if (pmB < 0) pmB = pmu; else if (pmC < 0) pmC = pmu; else if (pmD < 0) pmD = pmu; } } \
          _Pragma("unroll") for (int k = 0; k < 2; ++k) { const int e = C.tid + 512 * k, sl = e >> 8, pmk = sl == 0 ? pmA : sl == 1 ? pmB : sl == 2 ? pmC : pmD; \
              if (pmk >= 0) { const f32x4* rp = (const f32x4*)(rowss + ((size_t)pmk * 256 + (e & 255)) * 16); const f32x4 s0 = rp[0], s1 = rp[1], s2 = rp[2], s3 = rp[3]; \
                  const float ss = ((s0[0] + s0[1]) + (s0[2] + s0[3])) + ((s1[0] + s1[1]) + (s1[2] + s1[3])) + ((s2[0] + s2[1]) + (s2[2] + s2[3])) + ((s3[0] + s3[1]) + (s3[2] + s3[3])); \
                  rtab[e] = 1.0f / sqrtf(ss * (1.0f / 1024.0f) + NORM_EPS); } } \
          __syncthreads(); } while (0)
        int pmA, pmB, pmC, pmD;
        pg8::Gemm g1{(const pg8::bf16_t*)(C.ws + WS_XB), (const pg8::bf16_t*)(C.ws + WS_WIN) + (size_t)L * DIN * DM, MROWS, 2048, DM};
        pg8::Gemm g2{(const pg8::bf16_t*)(C.ws + WS_XB8), (const pg8::bf16_t*)(C.ws + WS_WIN8 + (size_t)L * 1536 * 2 * DM), MROWS, 1536, DM, DM / 2};
        pg8::StaticOrder S1; S1.init(MROWS, 2048, C.G, C.bid);
        pg8::StaticOrder S2; S2.init(MROWS, 1536, C.G, C.bid);
        RTAB_BUILD(S1);
        pg8::EpiProj E1{(pg8::bf16_t*)(C.ws + WS_PROJ), SUBSTRIDE, rtab, pmA, pmB, pmC, pmD, kmean, 0, 6, 1.0f};
        rtab += 1024;
        RTAB_BUILD(S2);
        pg8::EpiProj E2{(pg8::bf16_t*)(C.ws + WS_PROJ), SUBSTRIDE, rtab, pmA, pmB, pmC, pmD, kmean, 6, 2, 1.0f / 32.0f};
        pg8::Unit f2; const bool has2 = S2.next(0, f2);
        pg8::Unit f1; const bool has1 = S1.next(0, f1);
        if (has1 && has2) {
            const size_t tstep2 = (size_t)2 * pg8::HALF * DM * 2;
            pg8::gemm_phase<pg8::EpiProj, pg8::StaticOrder, true, true, false, false, true>((PG8_LAS unsigned char*)lds, g1, S1, E1, C.tid, (const char*)g2.A + (size_t)f2.pm * tstep2, (const char*)g2.Bt + (size_t)f2.pn * tstep2);
            C.tid = wave_s * 64 + lane_now();
            pg8::gemm_phase<pg8::EpiProj, pg8::StaticOrder, true, true, true, true, false>((PG8_LAS unsigned char*)lds, g2, S2, E2, C.tid);
        }
#undef RTAB_BUILD
    }
    else if constexpr (ST == 3) { phase_gate(C, L); phase_sgu(C, L); }
    else if constexpr (ST == 4) phase_attn(C, L);
    else if constexpr (ST == 5) phase_combine(C);
    else if constexpr (ST == 6) {
        pg8::Gemm g{(const pg8::bf16_t*)(C.ws + WS_MIX), (const pg8::bf16_t*)(C.ws + WS_WOUT) + (size_t)L * DM * DM, MROWS, DM, DM};
        pg8::StaticOrder S; S.init(MROWS, DM, C.G, C.bid);
        if (L == 0) { pg8::EpiRes E{(pg8::bf16_t*)(C.ws + WS_XB), (float*)(C.ws + WS_ROWSS), C.ws + WS_XB8};
            pg8::gemm_phase<pg8::EpiRes, pg8::StaticOrder, true, true>((PG8_LAS unsigned char*)lds, g, S, E, C.tid); }
        else { pg8::EpiFinal E{(const pg8::bf16_t*)(C.ws + WS_XB), C.out, C.final_g, (float*)(C.ws + WS_ROWSS), (unsigned*)(C.ws + WS_CTL) + 8192};
            pg8::gemm_phase<pg8::EpiFinal, pg8::StaticOrder, true, true>((PG8_LAS unsigned char*)lds, g, S, E, C.tid); }
    } else if constexpr (ST == 7) phase_check_inject(C);
    else if constexpr (ST == 8) phase_attn_simple(C, (bf16*)C.out);
    else if constexpr (ST == 9) {
        const bf16* A = (const bf16*)(C.ws + WS_MIX); const bf16* B = (const bf16*)C.out; unsigned* flag = (unsigned*)(C.ws + WS_CTL) + 32;
        float md = 0.f;
        for (size_t idx = (size_t)C.bid * 512 + C.tid; idx < (size_t)MROWS * 512; idx += (size_t)C.G * 512) {
            const size_t row = idx >> 9, col = 512 + (idx & 511);
            const float a = __uint_as_float((unsigned)A[row * 1024 + col] << 16), r = __uint_as_float((unsigned)B[row * 1024 + col] << 16);
            float sc = fabsf(r);
#pragma unroll
            for (int o = 1; o < 64; o <<= 1) sc = fmaxf(sc, lx_xor(sc, o));
            const float d = fabsf(a - r) / (0.02f + sc);
            md = (d > md || !(d == d)) ? (d == d ? d : 1e6f) : md;
        }
        atomicMax(flag, __float_as_uint(md));
    }
}
template <int SEL> __global__ void __launch_bounds__(NWAVES * 64, 2) fwd(Args args) {
    extern __shared__ __attribute__((aligned(16))) unsigned char lds[];
    const int wave_s = __builtin_amdgcn_readfirstlane((int)threadIdx.x >> 6);
    if constexpr (SEL >= 0) run_stage<SEL>(args, lds, args.layer, wave_s);
    else {
        if (args.pad == 0x7fffffff) cg::this_grid().sync();
        volatile LAS unsigned* bst = (volatile LAS unsigned*)((LAS unsigned char*)lds + LDS_BARST);
        if (threadIdx.x == 0) { bst[0] = 0u; bst[1] = 0u; }
        __syncthreads();
        XcdBarrier bar = xcd_barrier_post((unsigned*)(args.ws + WS_CTL) + CW_BAR, bst);
#define GRID_SYNC() do { XcdBarrier b2_ = bar; asm volatile("" : "+s"(b2_.bar), "+s"(b2_.x)); xcd_barrier(b2_, wave_s == 0 && lane_now() == 0); } while (0)
#define RUN(k, L) do { run_stage<k>(args, lds, L, wave_s); GRID_SYNC(); } while (0)
        RUN(0, 0);
        for (int L = 0; L < DEPTH; ++L) {
            RUN(1, L); RUN(3, L); RUN(4, L); RUN(5, L);
            if (L == DEPTH - 1) run_stage<6>(args, lds, L, wave_s); else RUN(6, L);
        }
    }
}

#ifndef MK_N_LAUNCHES
#define MK_N_LAUNCHES 1
#endif
template <int SEL> static void launch_stage(int grid, Args a, int layer, hipStream_t stream) {
    static bool attr = false;
    if (!attr) { (void)hipFuncSetAttribute((const void*)fwd<SEL>, hipFuncAttributeMaxDynamicSharedMemorySize, LDS_BYTES); attr = true; }
    a.layer = layer;
    hipLaunchKernelGGL(fwd<SEL>, dim3(grid), dim3(NWAVES * 64), LDS_BYTES, stream, a);
}
extern "C" void kernel_launch(void* const* d_in, const int* in_sizes, int n_in, void* d_out, int out_size, void* d_ws, size_t ws_size, hipStream_t stream) {
    static int grid = 0;
    if (grid == 0) {
        if (n_in != 10 || out_size != MROWS * DM || ws_size < WS_END) { fprintf(stderr, "kernel_launch: unexpected shapes (n_in %d out %d ws %zu)\n", n_in, out_size, ws_size); grid = -1; return; }
        int dev = 0, cus = 0;
        (void)hipGetDevice(&dev); (void)hipDeviceGetAttribute(&cus, hipDeviceAttributeMultiprocessorCount, dev);
        grid = cus;
        if (grid != 256) fprintf(stderr, "kernel_launch: %d CUs: the fused final-norm epilogue pairs the four column tiles of a row panel inside one round of a 256-workgroup grid\n", grid);
#if MK_N_LAUNCHES == 1
        int per_cu = 0;
        if (hipFuncSetAttribute((const void*)fwd<-1>, hipFuncAttributeMaxDynamicSharedMemorySize, LDS_BYTES) != hipSuccess) { fprintf(stderr, "kernel_launch: hipFuncSetAttribute failed\n"); grid = -1; return; }
        if (hipOccupancyMaxActiveBlocksPerMultiprocessor(&per_cu, (const void*)fwd<-1>, NWAVES * 64, LDS_BYTES) != hipSuccess || per_cu < 1) { fprintf(stderr, "kernel_launch: occupancy query says %d\n", per_cu); grid = -1; return; }
        (void)hipGetLastError();
#endif
    }
    if (grid < 0) return;
    (void)hipMemsetAsync((char*)d_ws + WS_CTL, 0, CTL_ZERO_BYTES, stream);
    Args a{};
    for (int i = 0; i < 10; ++i) a.in[i] = (const float*)d_in[i];
    a.out = (float*)d_out; a.ws = (unsigned char*)d_ws;
#if MK_N_LAUNCHES == 1
    void* kargs[] = {&a};
    hipError_t e = hipLaunchCooperativeKernel((const void*)fwd<-1>, dim3(grid), dim3(NWAVES * 64), kargs, LDS_BYTES, stream);
    if (e != hipSuccess) fprintf(stderr, "kernel_launch: cooperative launch failed: %s\n", hipGetErrorString(e));
#else
    launch_stage<0>(grid, a, 0, stream);
    for (int L = 0; L < DEPTH; ++L) {
        launch_stage<1>(grid, a, L, stream); launch_stage<3>(grid, a, L, stream);
        launch_stage<4>(grid, a, L, stream); launch_stage<5>(grid, a, L, stream);
        if (CHECK_ATTN && L == 0) { launch_stage<8>(grid, a, L, stream); launch_stage<9>(grid, a, L, stream); }
        launch_stage<6>(grid, a, L, stream);
    }
    if (CHECK_ATTN) launch_stage<7>(grid, a, 0, stream);
#endif
}
```

```cpp
#include <hip/hip_runtime.h>
#include <hip/hip_cooperative_groups.h>
#include <cstdio>
#include <cstdint>
namespace cg = cooperative_groups;

constexpr int BATCH = 2, SEQ = 16384, DM = 1024, MROWS = BATCH * SEQ, DIN = 3584, DSUB = 512;
constexpr int NH = 8, DH = 64, NBLK = SEQ / 256, NBH = BATCH * NH, DEPTH = 2;
constexpr float NORM_EPS = 1e-6f, LN_EPS = 1e-5f;
constexpr float LOG2E = 1.4426950408889634f;
#ifndef CHECK_ATTN
#define CHECK_ATTN 0
#endif
constexpr float QSCALE = 0.125f * LOG2E;
__device__ __forceinline__ int lx_lane() { int l; asm volatile("v_mbcnt_lo_u32_b32 %0, -1, 0\n\tv_mbcnt_hi_u32_b32 %0, -1, %0" : "=v"(l)); return l; }
__device__ __forceinline__ int lx_xor(int v, int m) { return __builtin_amdgcn_ds_bpermute((lx_lane() ^ m) << 2, v); }
__device__ __forceinline__ float lx_xor(float v, int m) { return __builtin_bit_cast(float, __builtin_amdgcn_ds_bpermute((lx_lane() ^ m) << 2, __builtin_bit_cast(int, v))); }
__device__ __forceinline__ int lx_up(int v, int d) { const int l = lx_lane(); return __builtin_amdgcn_ds_bpermute((l >= d ? l - d : l) << 2, v); }
namespace pg8 {
#define PG8_LAS __attribute__((address_space(3)))
typedef unsigned short bf16_t;
typedef short bf16x8 __attribute__((ext_vector_type(8)));
typedef float f32x4 __attribute__((ext_vector_type(4)));
typedef unsigned u32x4 __attribute__((ext_vector_type(4)));
typedef int pg8_v8i __attribute__((ext_vector_type(8)));
typedef int pg8_v4i __attribute__((ext_vector_type(4)));
constexpr int BM = 256, BK = 64, HALF = 128, HTB = HALF * BK * 2  , STAGE_BYTES = 8 * HTB, NXCD = 8, WGM = 8;

__host__ __device__ __forceinline__ int lds_byte(int r, int c) { const int st = (r >> 4) * 2 + (c >> 5), rr = r & 15, cc = c & 31, ob = rr * 64 + cc * 2; return st * 1024 + (ob ^ (((ob >> 9) & 1) << 5)); }
__host__ __device__ __forceinline__ void stage_rc(int b, int& R, int& C) { const int st = b / 1024, sb = b % 1024, swz = sb ^ (((sb >> 9) & 1) << 5); R = (st >> 1) * 16 + swz / 64; C = (st & 1) * 32 + (swz % 64) / 2; }
__host__ __device__ __forceinline__ int perm32(int rho) { const int n = rho >> 4, i = rho & 15; return 8 * (i >> 2) + 4 * n + (i & 3); }

struct Unit { int pm, pn; };
struct Gemm { const bf16_t* A; const bf16_t* Bt; int M, N, K; int kext = 0; };

struct StaticOrder {
    int nM, nN, nwg, G, c;
    __host__ __device__ void init(int M, int N, int G_, int c_) { nM = M / BM; nN = N / BM; nwg = nM * nN; G = G_; c = c_; }
    __host__ __device__ bool next(int i, Unit& u) const {
        const long L = (long)i * G + c; if (L >= nwg) return false;
        int wgid = (int)L; { const int q = nwg / NXCD, r = nwg % NXCD, xcd = wgid % NXCD, off = wgid / NXCD; wgid = (xcd < r ? xcd * (q + 1) : r * (q + 1) + (xcd - r) * q) + off; }
        const int nig = WGM * nN, gid = wgid / nig, fm = gid * WGM, gsz = (nM - fm) < WGM ? (nM - fm) : WGM;
        u.pm = fm + ((wgid % nig) % gsz); u.pn = (wgid % nig) / gsz; return true;
    }
    __device__ __forceinline__ void a_ready(const Unit&) const {}
    __device__ __forceinline__ void done(const Unit&) const {}
};

__device__ __forceinline__ unsigned cvt_pk_bf16(float lo, float hi) { unsigned r; asm volatile("v_cvt_pk_bf16_f32 %0, %1, %2" : "=v"(r) : "v"(lo), "v"(hi)); return r; }
typedef float f32x2 __attribute__((ext_vector_type(2)));
typedef float f32x2 __attribute__((ext_vector_type(2)));
__device__ __forceinline__ float act_gelu(float x) {
    const float u = x * (1.0f + 0.044715f * x * x);
    const float e = __builtin_amdgcn_exp2f(u * (-2.0f * 0.7978845608028654f * 1.4426950408889634f));
    return x * __builtin_amdgcn_rcpf(1.0f + e);
}
__device__ __forceinline__ float act_silu(float x) {
    const float e = __builtin_amdgcn_exp2f(x * (-1.4426950408889634f));
    return x * __builtin_amdgcn_rcpf(1.0f + e);
}
struct EpiProj {
    static constexpr bool PERM = true, AFTER_DRAIN = false;
    bf16_t* P; size_t sub_stride; const float* rstd_lds; int pm0, pm1, pm2, pm3; float* kmean; int pn_base, pn_hole; float oscale;
    __device__ __forceinline__ void operator()(const f32x4 (&acc)[2][2][4][2], const Unit& u, int wr, int wc, int fr, int fq) const {
        const int pnn = u.pn + pn_base + (u.pn >= pn_hole ? 2 : 0), t = pnn >> 1;
        bf16_t* base = P + (size_t)t * sub_stride;
        const int col0 = (pnn & 1) * 256 + wc * 32 + 8 * fq;
        const int row0 = u.pm * BM + wr * 64 + fr;
        const int slot = (u.pm == pm0) ? 0 : (u.pm == pm1) ? 1 : (u.pm == pm2) ? 2 : 3;
        const float* rt = rstd_lds + slot * 256 + wr * 64 + fr;
        const float qs = ((t == 3) ? (0.125f * 1.4426950408889634f) : 1.0f) * oscale;
        float ks[2][8];
#pragma unroll
        for (int bj = 0; bj < 2; ++bj)
#pragma unroll
            for (int e = 0; e < 8; ++e) ks[bj][e] = 0.f;
#pragma unroll
        for (int ai = 0; ai < 2; ++ai)
#pragma unroll
            for (int m = 0; m < 4; ++m) {
                const int row = row0 + ai * HALF + m * 16;
                const float rs = rt[ai * HALF + m * 16] * qs;
                bf16_t* rowp = base + (size_t)row * 512 + col0;
                if (t >= 5) {
                    int w8[2][2];
#pragma unroll
                    for (int bj = 0; bj < 2; ++bj) { const f32x4 v0 = acc[ai][bj][m][0] * rs, v1 = acc[ai][bj][m][1] * rs;
                        w8[bj][0] = __builtin_amdgcn_cvt_pk_fp8_f32(v0[0], v0[1], 0, false); w8[bj][0] = __builtin_amdgcn_cvt_pk_fp8_f32(v0[2], v0[3], w8[bj][0], true);
                        w8[bj][1] = __builtin_amdgcn_cvt_pk_fp8_f32(v1[0], v1[1], 0, false); w8[bj][1] = __builtin_amdgcn_cvt_pk_fp8_f32(v1[2], v1[3], w8[bj][1], true); }
                    auto r0 = __builtin_amdgcn_permlane16_swap((unsigned)w8[0][0], (unsigned)w8[1][0], false, false); auto r1 = __builtin_amdgcn_permlane16_swap((unsigned)w8[0][1], (unsigned)w8[1][1], false, false);
                    *(u32x4*)((unsigned char*)base + (size_t)row * 512 + col0 + ((fq & 1) ? HALF - 8 : 0)) = (u32x4){r0[0], r1[0], r0[1], r1[1]};
                    continue;
                }
#pragma unroll
                for (int bj = 0; bj < 2; ++bj) {
                    const f32x4 v0 = acc[ai][bj][m][0] * rs, v1 = acc[ai][bj][m][1] * rs;
                    if (t == 4) {
#pragma unroll
                        for (int e = 0; e < 4; ++e) { ks[bj][e] += v0[e]; ks[bj][4 + e] += v1[e]; }
                    }
                    u32x4 w; w.x = cvt_pk_bf16(v0[0], v0[1]); w.y = cvt_pk_bf16(v0[2], v0[3]); w.z = cvt_pk_bf16(v1[0], v1[1]); w.w = cvt_pk_bf16(v1[2], v1[3]);
                    *(u32x4*)(rowp + bj * HALF) = w;
                }
            }
        if (t == 4) {
            const int b = u.pm >> 6, n = u.pm & 63;
#pragma unroll
            for (int bj = 0; bj < 2; ++bj)
#pragma unroll
                for (int e = 0; e < 8; ++e) {
                    float v = ks[bj][e];
                    v += lx_xor(v, 1); v += lx_xor(v, 2); v += lx_xor(v, 4); v += lx_xor(v, 8);
                    if (fr == 0) { const int col = col0 + bj * HALF + e; atomicAdd(kmean + ((size_t)((b * 8 + (col >> 6)) * 64 + n)) * 64 + (col & 63), v * (1.0f / 256.0f)); }
                }
        }
    }
};
#define PG8_GAS __attribute__((address_space(1)))
struct EpiRes {
    static constexpr bool PERM = true, AFTER_DRAIN = false;
    bf16_t* xb; float* rowss; unsigned char* xb8;
    __device__ __forceinline__ void operator()(const f32x4 (&acc)[2][2][4][2], const Unit& u, int wr, int wc, int fr, int fq) const {
        const int col0 = u.pn * BM + wc * 32 + 8 * fq;
        PG8_GAS bf16_t* xbg = (PG8_GAS bf16_t*)xb; PG8_GAS float* rsg = (PG8_GAS float*)rowss;
        const unsigned ob = (unsigned)((u.pm * BM + wr * 64 + fr) * 1024 + col0) * 2u;
        u32x4 rr[2][4][2];
#pragma unroll
        for (int ai = 0; ai < 2; ++ai)
#pragma unroll
            for (int m = 0; m < 4; ++m)
#pragma unroll
                for (int bj = 0; bj < 2; ++bj) rr[ai][m][bj] = *(const PG8_GAS u32x4*)((const PG8_GAS char*)xbg + (ob + (unsigned)(((ai * HALF + m * 16) * 1024 + bj * HALF) * 2)));
#pragma unroll
        for (int ai = 0; ai < 2; ++ai)
#pragma unroll
            for (int m = 0; m < 4; ++m) {
                const int row = u.pm * BM + ai * HALF + wr * 64 + m * 16 + fr;
                float ss = 0.f; int w8[2][2];
#pragma unroll
                for (int bj = 0; bj < 2; ++bj) {
                    const u32x4 w0 = rr[ai][m][bj];
                    const f32x4 r0 = (f32x4){__uint_as_float(w0.x << 16), __uint_as_float(w0.x & 0xffff0000u), __uint_as_float(w0.y << 16), __uint_as_float(w0.y & 0xffff0000u)};
                    const f32x4 r1 = (f32x4){__uint_as_float(w0.z << 16), __uint_as_float(w0.z & 0xffff0000u), __uint_as_float(w0.w << 16), __uint_as_float(w0.w & 0xffff0000u)};
                    const f32x4 o0 = r0 + acc[ai][bj][m][0], o1 = r1 + acc[ai][bj][m][1];
                    ss += ((o0[0] * o0[0] + o0[1] * o0[1]) + (o0[2] * o0[2] + o0[3] * o0[3])) + ((o1[0] * o1[0] + o1[1] * o1[1]) + (o1[2] * o1[2] + o1[3] * o1[3]));
                    u32x4 w; w.x = cvt_pk_bf16(o0[0], o0[1]); w.y = cvt_pk_bf16(o0[2], o0[3]); w.z = cvt_pk_bf16(o1[0], o1[1]); w.w = cvt_pk_bf16(o1[2], o1[3]);
                    *(PG8_GAS u32x4*)((PG8_GAS char*)xbg + (ob + (unsigned)(((ai * HALF + m * 16) * 1024 + bj * HALF) * 2))) = w;
                    w8[bj][0] = __builtin_amdgcn_cvt_pk_fp8_f32(o0[0], o0[1], 0, false); w8[bj][0] = __builtin_amdgcn_cvt_pk_fp8_f32(o0[2], o0[3], w8[bj][0], true);
                    w8[bj][1] = __builtin_amdgcn_cvt_pk_fp8_f32(o1[0], o1[1], 0, false); w8[bj][1] = __builtin_amdgcn_cvt_pk_fp8_f32(o1[2], o1[3], w8[bj][1], true);
                }
                { auto r0 = __builtin_amdgcn_permlane16_swap((unsigned)w8[0][0], (unsigned)w8[1][0], false, false); auto r1 = __builtin_amdgcn_permlane16_swap((unsigned)w8[0][1], (unsigned)w8[1][1], false, false);
                  const unsigned o8 = (ob - (unsigned)col0) + (unsigned)((ai * HALF + m * 16) * 2048) + ((fq & 1) ? (unsigned)(HALF - 8) : 0u);
                  *(PG8_GAS u32x4*)((PG8_GAS unsigned char*)xb8 + o8) = (u32x4){r0[0], r1[0], r0[1], r1[1]}; }
                ss += lx_xor(ss, 16); ss += lx_xor(ss, 32);
                if (fq == 0) rsg[(size_t)row * 16 + u.pn * 4 + wc] = ss;
            }
    }
};
struct EpiFinal {
    static constexpr bool PERM = true, AFTER_DRAIN = false;
    const bf16_t* xb; float* out; const float* fg; float* slots; unsigned* cnt;
    __device__ __forceinline__ void operator()(f32x4 (&acc)[2][2][4][2], const Unit& u, int wr, int wc, int fr, int fq) const {
        const int col0 = u.pn * BM + wc * 32 + 8 * fq;
        const PG8_GAS bf16_t* xbg = (const PG8_GAS bf16_t*)xb; PG8_GAS float* outg = (PG8_GAS float*)out; const PG8_GAS float* slg = (const PG8_GAS float*)slots;
        const unsigned ob = (unsigned)((u.pm * BM + wr * 64 + fr) * 1024 + col0) * 2u;
        u32x4 rr[2][4][2];
#pragma unroll
        for (int ai = 0; ai < 2; ++ai)
#pragma unroll
            for (int m = 0; m < 4; ++m)
#pragma unroll
                for (int bj = 0; bj < 2; ++bj) rr[ai][m][bj] = *(const PG8_GAS u32x4*)((const PG8_GAS char*)xbg + (ob + (unsigned)(((ai * HALF + m * 16) * 1024 + bj * HALF) * 2)));
#pragma unroll
        for (int ai = 0; ai < 2; ++ai)
#pragma unroll
            for (int m = 0; m < 4; ++m) {
                const int row = u.pm * BM + ai * HALF + wr * 64 + m * 16 + fr;
                float ss = 0.f;
#pragma unroll
                for (int bj = 0; bj < 2; ++bj) {
                    const u32x4 w = rr[ai][m][bj];
                    const f32x4 r0 = (f32x4){__uint_as_float(w.x << 16), __uint_as_float(w.x & 0xffff0000u), __uint_as_float(w.y << 16), __uint_as_float(w.y & 0xffff0000u)};
                    const f32x4 r1 = (f32x4){__uint_as_float(w.z << 16), __uint_as_float(w.z & 0xffff0000u), __uint_as_float(w.w << 16), __uint_as_float(w.w & 0xffff0000u)};
                    const f32x4 o0 = r0 + acc[ai][bj][m][0], o1 = r1 + acc[ai][bj][m][1];
                    acc[ai][bj][m][0] = o0; acc[ai][bj][m][1] = o1;
                    ss += ((o0[0] * o0[0] + o0[1] * o0[1]) + (o0[2] * o0[2] + o0[3] * o0[3])) + ((o1[0] * o1[0] + o1[1] * o1[1]) + (o1[2] * o1[2] + o1[3] * o1[3]));
                }
                ss += lx_xor(ss, 16); ss += lx_xor(ss, 32);
                if (fq == 0) __hip_atomic_store(slots + (size_t)row * 16 + u.pn * 4 + wc, ss, __ATOMIC_RELAXED, __HIP_MEMORY_SCOPE_AGENT);
            }
        asm volatile("s_waitcnt vmcnt(0)" ::: "memory");
        unsigned* pc = cnt + 64 * u.pm;
        if (fr == 0 && fq == 0) __hip_atomic_fetch_add(pc, 1u, __ATOMIC_RELAXED, __HIP_MEMORY_SCOPE_AGENT);
        f32x4 g4[2][2];
#pragma unroll
        for (int bj = 0; bj < 2; ++bj)
#pragma unroll
            for (int n = 0; n < 2; ++n) g4[bj][n] = *(const PG8_GAS f32x4*)((const PG8_GAS float*)fg + col0 + bj * HALF + n * 4);
        for (unsigned spins = 0; spins < (1u << 22); ++spins) {
            if (__hip_atomic_load(pc, __ATOMIC_RELAXED, __HIP_MEMORY_SCOPE_AGENT) >= 32u) break;
            __builtin_amdgcn_s_sleep(2);
        }
        __builtin_amdgcn_fence(__ATOMIC_ACQUIRE, "agent");
        asm volatile("s_waitcnt vmcnt(0)" ::: "memory");
#pragma unroll
        for (int ai = 0; ai < 2; ++ai) {
            f32x4 sl[4][4];
#pragma unroll
            for (int m = 0; m < 4; ++m)
#pragma unroll
                for (int k = 0; k < 4; ++k) sl[m][k] = *(const PG8_GAS f32x4*)(slg + (size_t)(u.pm * BM + ai * HALF + wr * 64 + m * 16 + fr) * 16 + k * 4);
#pragma unroll
            for (int m = 0; m < 4; ++m) {
                const f32x4 s0 = sl[m][0], s1 = sl[m][1], s2 = sl[m][2], s3 = sl[m][3];
                const float tot = ((s0[0] + s0[1]) + (s0[2] + s0[3])) + ((s1[0] + s1[1]) + (s1[2] + s1[3])) + ((s2[0] + s2[1]) + (s2[2] + s2[3])) + ((s3[0] + s3[1]) + (s3[2] + s3[3]));
                const float rs = 1.0f / sqrtf(tot * (1.0f / 1024.0f) + 1e-6f);
#pragma unroll
                for (int bj = 0; bj < 2; ++bj)
#pragma unroll
                    for (int n = 0; n < 2; ++n) *(PG8_GAS f32x4*)((PG8_GAS char*)outg + (2u * ob + (unsigned)(((ai * HALF + m * 16) * 1024 + bj * HALF + n * 4) * 4))) = acc[ai][bj][m][n] * rs * g4[bj][n];
            }
        }
    }
};
template <class Epi, class Sched, bool ALIGN_EPI = false, bool SP2 = false, bool FP8 = false, bool CHAIN_IN = false, bool CHAIN_OUT = false>
__device__ __forceinline__ void gemm_phase(PG8_LAS unsigned char* lds, const Gemm g, const Sched& S, const Epi& E, const int tid, const char* chainA = nullptr, const char* chainB = nullptr) {
    static_assert(!(CHAIN_IN || CHAIN_OUT) || (SP2 && ALIGN_EPI), "chaining is written for the SP2 + ALIGN_EPI form");
    const int wid = __builtin_amdgcn_readfirstlane(tid >> 6), lane = tid & 63, wr = wid >> 2, wc = wid & 3, fr = lane & 15, fq = lane >> 4;
    const int K = g.K, nt = (g.kext ? g.kext : K) / BK;
    unsigned voffA[2], voffB[2];
#pragma unroll
    for (int i = 0; i < 2; ++i) { int R, C; stage_rc(tid * 16 + i * 8192, R, C); const int Rb = Epi::PERM ? ((R & ~31) + perm32(R & 31)) : R;
        voffA[i] = (unsigned)(R * K + C) * 2u; voffB[i] = (unsigned)(Rb * K + C) * 2u; }
    const size_t kstep = (size_t)(BK * 2);
    const size_t hstep = (size_t)HALF * K * 2;
    const size_t tstep = 2 * hstep;
    const unsigned ldsbase = (unsigned)(size_t)lds;
    const unsigned ldsw = (unsigned)wid * 1024u;
    const int aoff = lds_byte(wr * 64 + fr, fq * 8), boff = lds_byte(wc * 32 + fr, fq * 8);
#define PG8_SA(b, h) (((b) * 2 + (h)) * HTB)
#define PG8_SB(b, h) ((4 + (b) * 2 + (h)) * HTB)
#define PG8_GLDS(gbase_, voff_, ldsdst_) do { unsigned keep_; \
        asm volatile("s_mov_b32 %0, m0\n\ts_mov_b32 m0, %3\n\ts_nop 0\n\tglobal_load_lds_dwordx4 %1, %2\n\ts_mov_b32 m0, %0" : "=&s"(keep_) : "v"(voff_), "s"(gbase_), "s"(ldsdst_)); } while (0)
#define PG8_STAGE(bufoff, gbase, voff) do { _Pragma("unroll") for (int _i = 0; _i < 2; ++_i) { \
        if constexpr (FP8) PG8_GLDS((const char*)(gbase), (voff)[_i], (unsigned)__builtin_amdgcn_readfirstlane((int)(ldsbase + (unsigned)(bufoff) + ldsw + (unsigned)(_i * 8192)))); \
        else __builtin_amdgcn_global_load_lds((const unsigned*)((const char*)(gbase) + (voff)[_i]), (PG8_LAS unsigned*)(lds + (bufoff) + ldsw + _i * 8192), 16, 0, 0); } } while (0)
#define PG8_LD32(base_) __builtin_shufflevector(*(const PG8_LAS pg8_v4i*)(base_), *(const PG8_LAS pg8_v4i*)((base_) + 1024), 0, 1, 2, 3, 4, 5, 6, 7)
#define PG8_LDA(dst, b, h) do { if constexpr (FP8) { _Pragma("unroll") for (int m = 0; m < 4; ++m) dst##8[m] = PG8_LD32(lds + PG8_SA(b, h) + aoff + m * 2048); } \
        else { _Pragma("unroll") for (int m = 0; m < 4; ++m) _Pragma("unroll") for (int k = 0; k < 2; ++k) dst[m][k] = *(const PG8_LAS bf16x8*)(lds + PG8_SA(b, h) + aoff + m * 2048 + k * 1024); } } while (0)
#define PG8_LDB(dst, b, h) do { if constexpr (FP8) { _Pragma("unroll") for (int n = 0; n < 2; ++n) dst##8[n] = PG8_LD32(lds + PG8_SB(b, h) + boff + n * 2048); } \
        else { _Pragma("unroll") for (int n = 0; n < 2; ++n) _Pragma("unroll") for (int k = 0; k < 2; ++k) dst[n][k] = *(const PG8_LAS bf16x8*)(lds + PG8_SB(b, h) + boff + n * 2048 + k * 1024); } } while (0)
#define PG8_MMA(ai, bj, At, Bt) do { __builtin_amdgcn_s_setprio(1); \
        if constexpr (FP8) { _Pragma("unroll") for (int m = 0; m < 4; ++m) _Pragma("unroll") for (int n = 0; n < 2; ++n) \
            acc[ai][bj][m][n] = __builtin_amdgcn_mfma_scale_f32_16x16x128_f8f6f4(Bt##8[n], At##8[m], acc[ai][bj][m][n], 0, 0, 0, 0x7f7f7f7f, 0, 0x7f7f7f7f); } \
        else { _Pragma("unroll") for (int m = 0; m < 4; ++m) _Pragma("unroll") for (int n = 0; n < 2; ++n) _Pragma("unroll") for (int k = 0; k < 2; ++k) \
            acc[ai][bj][m][n] = __builtin_amdgcn_mfma_f32_16x16x32_bf16(Bt[n][k], At[m][k], acc[ai][bj][m][n], 0, 0, 0); } \
        __builtin_amdgcn_s_setprio(0); } while (0)
#define PG8_WAIT_V(n) asm volatile("s_waitcnt vmcnt(" #n ")" ::: "memory")
#define PG8_WAIT_L(n) asm volatile("s_waitcnt lgkmcnt(" #n ")" ::: "memory")
#define PG8_BAR __builtin_amdgcn_s_barrier()
#define PG8_SCHED __builtin_amdgcn_sched_barrier(0)
    Unit cur, nxt; int ui = 0;
    if (!S.next(0, cur)) return;
    f32x4 acc[2][2][4][2];
#pragma unroll
    for (int a = 0; a < 2; ++a)
#pragma unroll
        for (int b = 0; b < 2; ++b)
#pragma unroll
            for (int m = 0; m < 4; ++m)
#pragma unroll
                for (int n = 0; n < 2; ++n) acc[a][b][m][n] = (f32x4){0.f, 0.f, 0.f, 0.f};
    bf16x8 At[FP8 ? 1 : 4][2], B0[FP8 ? 1 : 2][2], B1[FP8 ? 1 : 2][2];
    pg8_v8i At8[FP8 ? 4 : 1], B08[FP8 ? 2 : 1], B18[FP8 ? 2 : 1];
    const char* cA = (const char*)g.A + (size_t)cur.pm * tstep; const char* cB = (const char*)g.Bt + (size_t)cur.pn * tstep;
    S.a_ready(cur);
    if constexpr (CHAIN_IN) { } else if constexpr (SP2) {
        PG8_STAGE(PG8_SB(0, 0), cB, voffB); PG8_STAGE(PG8_SB(0, 1), cB + hstep, voffB); PG8_STAGE(PG8_SA(0, 0), cA, voffA); PG8_STAGE(PG8_SA(0, 1), cA + hstep, voffA);
        if (wr == 1) PG8_BAR;
        PG8_WAIT_V(2); PG8_BAR;
        PG8_STAGE(PG8_SB(1, 0), cB + kstep, voffB); PG8_STAGE(PG8_SA(1, 0), cA + kstep, voffA); PG8_STAGE(PG8_SB(1, 1), cB + hstep + kstep, voffB);
        PG8_WAIT_V(6); PG8_BAR;
    } else {
        PG8_STAGE(PG8_SB(0, 0), cB, voffB); PG8_STAGE(PG8_SA(0, 0), cA, voffA); PG8_STAGE(PG8_SB(0, 1), cB + hstep, voffB); PG8_STAGE(PG8_SA(0, 1), cA + hstep, voffA);
        if (wr == 1) PG8_BAR;
        PG8_WAIT_V(4); PG8_BAR;
        PG8_STAGE(PG8_SB(1, 0), cB + kstep, voffB); PG8_STAGE(PG8_SA(1, 0), cA + kstep, voffA); PG8_STAGE(PG8_SB(1, 1), cB + hstep + kstep, voffB);
        PG8_WAIT_V(6); PG8_BAR;
    }
    for (;;) {
        const bool has_next = S.next(ui + 1, nxt);
        const char* nA = has_next ? (const char*)g.A + (size_t)nxt.pm * tstep : (CHAIN_OUT ? chainA : cA); const char* nB = has_next ? (const char*)g.Bt + (size_t)nxt.pn * tstep : (CHAIN_OUT ? chainB : cB);
#pragma unroll 1
        for (int t = 0; t < nt; t += 2) {
            const bool last = (t == nt - 2);
            const char* a1 = cA + (size_t)(t + 1) * kstep;
            const char* a2 = last ? nA : cA + (size_t)(t + 2) * kstep; const char* b2 = last ? nB : cB + (size_t)(t + 2) * kstep;
            const char* a3 = a2 + kstep; const char* b3 = b2 + kstep;
            if (last && has_next) S.a_ready(nxt);
            if constexpr (SP2) {
            PG8_LDB(B0, 0, 0); PG8_LDB(B1, 0, 1); PG8_SCHED; PG8_LDA(At, 0, 0); PG8_STAGE(PG8_SA(1, 1), a1 + hstep, voffA);
            PG8_WAIT_V(8); PG8_WAIT_L(0); PG8_BAR; PG8_MMA(0, 0, At, B0); PG8_MMA(0, 1, At, B1); PG8_BAR; PG8_SCHED;
            PG8_LDA(At, 0, 1); PG8_STAGE(PG8_SB(0, 0), b2, voffB); PG8_STAGE(PG8_SB(0, 1), b2 + hstep, voffB); PG8_STAGE(PG8_SA(0, 0), a2, voffA);
            PG8_WAIT_V(8); PG8_WAIT_L(0); PG8_BAR; PG8_MMA(1, 0, At, B0); PG8_MMA(1, 1, At, B1); PG8_BAR; PG8_SCHED;
            PG8_LDB(B0, 1, 0); PG8_LDB(B1, 1, 1); PG8_SCHED; PG8_LDA(At, 1, 0); PG8_STAGE(PG8_SA(0, 1), a2 + hstep, voffA);
            PG8_WAIT_V(8); PG8_WAIT_L(0); PG8_BAR; PG8_MMA(0, 0, At, B0); PG8_MMA(0, 1, At, B1); PG8_BAR; PG8_SCHED;
            PG8_LDA(At, 1, 1); PG8_STAGE(PG8_SB(1, 0), b3, voffB); PG8_STAGE(PG8_SB(1, 1), b3 + hstep, voffB); PG8_STAGE(PG8_SA(1, 0), a3, voffA);
            PG8_WAIT_V(8); PG8_WAIT_L(0); PG8_BAR; PG8_MMA(1, 0, At, B0); PG8_MMA(1, 1, At, B1); PG8_BAR; PG8_SCHED;
            } else {
            PG8_LDB(B0, 0, 0); PG8_SCHED; PG8_LDA(At, 0, 0); PG8_STAGE(PG8_SA(1, 1), a1 + hstep, voffA);
            PG8_WAIT_L(8); PG8_BAR; PG8_WAIT_L(0); PG8_MMA(0, 0, At, B0); PG8_BAR; PG8_SCHED;
            PG8_LDB(B1, 0, 1); PG8_STAGE(PG8_SB(0, 0), b2, voffB);
            PG8_BAR; PG8_WAIT_L(0); PG8_MMA(0, 1, At, B1); PG8_BAR;
            PG8_LDA(At, 0, 1); PG8_STAGE(PG8_SA(0, 0), a2, voffA);
            PG8_BAR; PG8_WAIT_L(0); PG8_MMA(1, 0, At, B0); PG8_BAR; PG8_SCHED;
            PG8_STAGE(PG8_SB(0, 1), b2 + hstep, voffB);
            PG8_WAIT_V(6); PG8_BAR; PG8_MMA(1, 1, At, B1); PG8_BAR;
            PG8_LDB(B0, 1, 0); PG8_SCHED; PG8_LDA(At, 1, 0); PG8_STAGE(PG8_SA(0, 1), a2 + hstep, voffA);
            PG8_WAIT_L(8); PG8_BAR; PG8_WAIT_L(0); PG8_MMA(0, 0, At, B0); PG8_BAR; PG8_SCHED;
            PG8_LDB(B1, 1, 1); PG8_STAGE(PG8_SB(1, 0), b3, voffB);
            PG8_BAR; PG8_WAIT_L(0); PG8_MMA(0, 1, At, B1); PG8_BAR;
            PG8_LDA(At, 1, 1); PG8_STAGE(PG8_SA(1, 0), a3, voffA);
            PG8_BAR; PG8_WAIT_L(0); PG8_MMA(1, 0, At, B0); PG8_BAR; PG8_SCHED;
            PG8_STAGE(PG8_SB(1, 1), b3 + hstep, voffB);
            PG8_WAIT_V(6); PG8_BAR; PG8_MMA(1, 1, At, B1); PG8_BAR;
            }
        }
        if constexpr (ALIGN_EPI) { if (wr == 0) PG8_BAR; }
        if constexpr (!Epi::AFTER_DRAIN) { int ln_; asm volatile("v_mbcnt_lo_u32_b32 %0, -1, 0\n\tv_mbcnt_hi_u32_b32 %0, -1, %0" : "=v"(ln_)); E(acc, cur, wr, wc, ln_ & 15, ln_ >> 4); S.done(cur); }
        if (!has_next) { if constexpr (CHAIN_OUT) { if (wr == 1) PG8_BAR; return; } break; }
#pragma unroll
        for (int a = 0; a < 2; ++a)
#pragma unroll
            for (int b = 0; b < 2; ++b)
#pragma unroll
                for (int m = 0; m < 4; ++m)
#pragma unroll
                    for (int n = 0; n < 2; ++n) acc[a][b][m][n] = (f32x4){0.f, 0.f, 0.f, 0.f};
        cur = nxt; cA = nA; cB = nB; ++ui;
        if constexpr (ALIGN_EPI) { if (wr == 1) PG8_BAR; }
    }
    PG8_WAIT_V(0);
    if constexpr (!ALIGN_EPI) { if (wr == 0) PG8_BAR; }
    PG8_BAR;
    if constexpr (Epi::AFTER_DRAIN) { E.fused(acc, cur, wr, wc, fr, fq, lds, wid, lane); S.done(cur); }
#undef PG8_SA
#undef PG8_SB
#undef PG8_STAGE
#undef PG8_GLDS
#undef PG8_LD32
#undef PG8_LDA
#undef PG8_LDB
#undef PG8_MMA
#undef PG8_WAIT_V
#undef PG8_WAIT_L
#undef PG8_BAR
#undef PG8_SCHED
}
}

constexpr size_t MiB = 1u << 20;
constexpr size_t WS_CTL = 0, CTL_ZERO_BYTES = 1 * MiB;
constexpr size_t WS_WIN = 2 * MiB;
constexpr size_t WS_WOUT = 16 * MiB;
constexpr size_t WS_WST = 20 * MiB;
constexpr size_t WS_BT = 21 * MiB;
constexpr size_t WS_KMEAN = 22 * MiB;
constexpr size_t WS_LOFF = 23 * MiB;
constexpr size_t WS_ROWSS = 24 * MiB;
constexpr size_t WS_PL = 26 * MiB;
constexpr size_t WS_LIST = 30 * MiB;
constexpr size_t WS_SEL = 32 * MiB;
constexpr size_t WS_XB8 = 104 * MiB;
constexpr size_t WS_WIN8 = 456 * MiB;
constexpr size_t WS_XB = 40 * MiB;
constexpr size_t WS_PROJ = 168 * MiB;
constexpr size_t WS_MIX = 392 * MiB;
constexpr size_t WS_END = 462 * MiB;
constexpr size_t SUBSTRIDE = (size_t)MROWS * 512;
enum { T_U = 0, T_V = 1, T_ZA = 2, T_Q = 3, T_K = 4, T_VV = 5, T_ZB = 6 };

constexpr int NWAVES = 8;
constexpr int LDS_BYTES = 160 * 1024;
constexpr int RING_BYTES = 131072;

#define LAS __attribute__((address_space(3)))
typedef unsigned short bf16;
typedef unsigned v4u __attribute__((ext_vector_type(4)));
typedef float f32x4 __attribute__((ext_vector_type(4)));
#define LDS_WAIT() asm volatile("s_waitcnt lgkmcnt(0)" ::: "memory")
typedef float f32x2c __attribute__((ext_vector_type(2)));
typedef __bf16 bf16x2c __attribute__((ext_vector_type(2)));
__device__ __forceinline__ unsigned pk2(float lo, float hi) { const f32x2c v = {lo, hi}; return __builtin_bit_cast(unsigned, __builtin_convertvector(v, bf16x2c)); }
__device__ __forceinline__ unsigned f2bf(float f) { return pk2(f, f) & 0xffffu; }
__device__ __forceinline__ unsigned pk4_fp8(float a, float b, float c, float d) { int w = __builtin_amdgcn_cvt_pk_fp8_f32(a, b, 0, false); w = __builtin_amdgcn_cvt_pk_fp8_f32(c, d, w, true); return (unsigned)w; }
__device__ __forceinline__ float bflo(unsigned w) { return __uint_as_float(w << 16); }
__device__ __forceinline__ float bfhi(unsigned w) { return __uint_as_float(w & 0xffff0000u); }
__device__ __forceinline__ float wave_sum(float v) {
#pragma unroll
    for (int o = 1; o < 64; o <<= 1) v += lx_xor(v, o);
    return v;
}

__device__ __forceinline__ int lane_now() { int l; asm volatile("v_mbcnt_lo_u32_b32 %0, -1, 0\n\tv_mbcnt_hi_u32_b32 %0, -1, %0" : "=v"(l)); return l; }
struct Args { const float* in[10]; float* out; unsigned char* ws; int layer, pad; };

struct Ctx {
    unsigned char* lds;
    int tid, lane, wave, G, bid;
    const float *x, *norm_g, *w_in, *ln_g, *ln_b, *sgu_w, *sgu_b, *w_out, *rel_bias, *final_g;
    float* out; unsigned char* ws;
};

__device__ __forceinline__ void p0_transpose_item(const float* W, const float* gs, int K, int N, bf16* WT, float* scr, int item, int lane, unsigned char* W8 = nullptr) {
    const int nblk = N / 32, kb = item / nblk, nb = item % nblk, k0 = 64 * kb, n0 = 32 * nb;
    float wv[32];
#pragma unroll
    for (int i = 0; i < 32; ++i) wv[i] = W[(size_t)(k0 + 2 * i + (lane >> 5)) * N + n0 + (lane & 31)];
#pragma unroll
    for (int i = 0; i < 32; ++i) { const int kk = 2 * i + (lane >> 5); const float sc = gs ? gs[k0 + kk] : 1.0f; scr[kk * 33 + (lane & 31)] = wv[i] * sc; }
    LDS_WAIT(); asm volatile("" ::: "memory");
    const int c = lane & 7;
#pragma unroll
    for (int j = 0; j < 4; ++j) { const int n = (lane >> 3) + 8 * j; const float* s = scr + (8 * c) * 33 + n;
        const bool f8 = W8 && ((n0 >= 1536 && n0 < 2048) || n0 >= 2560);
        if (f8) { typedef unsigned u32x2v __attribute__((ext_vector_type(2)));
            const int r8 = (n0 < 2048 ? n0 - 1536 : n0 - 2048) + n;
            *(u32x2v*)(W8 + (size_t)r8 * 2 * K + k0 + 8 * c) = (u32x2v){pk4_fp8(32.f * s[0 * 33], 32.f * s[1 * 33], 32.f * s[2 * 33], 32.f * s[3 * 33]), pk4_fp8(32.f * s[4 * 33], 32.f * s[5 * 33], 32.f * s[6 * 33], 32.f * s[7 * 33])}; }
        else { const int rb = ((W8 && n0 >= 2048) ? n0 - 512 : n0) + n;
            v4u o; o.x = pk2(s[0 * 33], s[1 * 33]); o.y = pk2(s[2 * 33], s[3 * 33]); o.z = pk2(s[4 * 33], s[5 * 33]); o.w = pk2(s[6 * 33], s[7 * 33]);
            *(v4u*)(WT + (size_t)rb * K + k0 + 8 * c) = o; } }
    LDS_WAIT(); asm volatile("" ::: "memory");
}
__device__ __forceinline__ int rel_bucket(int d) {
    if (d < 16) return d;
    int b = 16;
    b += (d >= 19); b += (d >= 21); b += (d >= 24); b += (d >= 27); b += (d >= 31); b += (d >= 35); b += (d >= 40); b += (d >= 46);
    b += (d >= 52); b += (d >= 59); b += (d >= 67); b += (d >= 77); b += (d >= 87); b += (d >= 99); b += (d >= 113);
    return b;
}
__device__ __forceinline__ void phase_prologue(const Ctx& C) {
    float* scr = (float*)(C.lds + C.wave * 16384);
    const int gw = C.bid * NWAVES + C.wave, NGW = C.G * NWAVES;
    constexpr int I_IN = (DM / 64) * (DIN / 32), I_OUT = (DM / 64) * (DM / 32);
    constexpr int NITEMS = DEPTH * (I_IN + I_OUT);
    for (int it = gw; it < NITEMS; it += NGW) {
        const int l = it / (I_IN + I_OUT); int r = it % (I_IN + I_OUT);
        if (r < I_IN) p0_transpose_item(C.w_in + (size_t)l * DM * DIN, C.norm_g + l * DM, DM, DIN, (bf16*)(C.ws + WS_WIN) + (size_t)l * DIN * DM, scr, r, C.lane, C.ws + WS_WIN8 + (size_t)l * 1536 * 2 * DM);
        else p0_transpose_item(C.w_out + (size_t)l * DM * DM, nullptr, DM, DM, (bf16*)(C.ws + WS_WOUT) + (size_t)l * DM * DM, scr, r - I_IN, C.lane);
    }
    { float* km = (float*)(C.ws + WS_KMEAN); for (int e = C.bid * 512 + C.tid; e < DEPTH * NBH * NBLK * 64; e += C.G * 512) km[e] = 0.f; }
    { bf16* wst = (bf16*)(C.ws + WS_WST); const int gt = C.bid * 512 + C.tid, NT = C.G * 512;
      for (int e = gt; e < DEPTH * 8 * 128 * 128; e += NT) { const int s = e & 127, t = (e >> 7) & 127; wst[e] = (s <= t) ? (bf16)f2bf(C.sgu_w[e]) : (bf16)0; } }
    if (C.bid == 0) { float* bt = (float*)(C.ws + WS_BT); for (int e = C.tid; e < 8 * 128; e += 512) { const int h = e >> 7, d = e & 127; bt[e] = C.rel_bias[rel_bucket(d) * 8 + h] * LOG2E; } }
    { bf16* xb = (bf16*)(C.ws + WS_XB); float* rowss = (float*)(C.ws + WS_ROWSS);
      constexpr int UN = 4;
      for (int m0 = gw; m0 < MROWS; m0 += NGW * UN) {
        f32x4 v[UN][4];
#pragma unroll
        for (int k = 0; k < UN; ++k) { const f32x4* xr = (const f32x4*)(C.x + (size_t)(m0 + k * NGW) * DM) + C.lane;
#pragma unroll
            for (int j = 0; j < 4; ++j) v[k][j] = xr[64 * j]; }
#pragma unroll
        for (int k = 0; k < UN; ++k) { const int m = m0 + k * NGW;
            float s = 0.f;
#pragma unroll
            for (int j = 0; j < 4; ++j) s += (v[k][j].x * v[k][j].x + v[k][j].y * v[k][j].y) + (v[k][j].z * v[k][j].z + v[k][j].w * v[k][j].w);
            s = wave_sum(s);
            unsigned long long* o8 = (unsigned long long*)(xb + (size_t)m * DM) + C.lane;
#pragma unroll
            for (int j = 0; j < 4; ++j) o8[64 * j] = (unsigned long long)pk2(v[k][j].x, v[k][j].y) | ((unsigned long long)pk2(v[k][j].z, v[k][j].w) << 32);
            { unsigned* sw = (unsigned*)scr + 256 * k;
#pragma unroll
              for (int j = 0; j < 4; ++j) sw[64 * j + C.lane] = pk4_fp8(v[k][j].x, v[k][j].y, v[k][j].z, v[k][j].w);
              LDS_WAIT(); asm volatile("" ::: "memory");
              *(v4u*)(C.ws + WS_XB8 + (size_t)m * 2048 + 16 * C.lane) = *(const v4u*)(sw + 4 * C.lane); }
            if (C.lane < 16) rowss[(size_t)m * 16 + C.lane] = (C.lane == 0) ? s : 0.f; }
      } }
}

typedef short bf16x8 __attribute__((ext_vector_type(8)));
typedef short bf16x4s __attribute__((ext_vector_type(4)));
typedef float f32x16 __attribute__((ext_vector_type(16)));
typedef int v8i_t __attribute__((ext_vector_type(8)));
__device__ __forceinline__ int at_vpos(int kv) { return (kv & ~63) + 32 * ((kv >> 2) & 1) + 16 * ((kv >> 5) & 1) + (kv & 3) + 4 * ((kv >> 3) & 3); }
__device__ __forceinline__ int crow(int r, int hi) { return (r & 3) + 8 * (r >> 2) + 4 * hi; }
__device__ __forceinline__ unsigned cvtpk(float lo, float hi) { unsigned r; asm volatile("v_cvt_pk_bf16_f32 %0, %1, %2" : "=v"(r) : "v"(lo), "v"(hi)); return r; }
__device__ __forceinline__ void phase_gate(const Ctx& C, int layer) {
    const bf16* Q = (const bf16*)(C.ws + WS_PROJ) + (size_t)T_Q * SUBSTRIDE;
    const float* KM = (const float*)(C.ws + WS_KMEAN) + (size_t)layer * NBH * NBLK * 64;
    int* SEL = (int*)(C.ws + WS_SEL); int* LOFF = (int*)(C.ws + WS_LOFF); unsigned short* LIST = (unsigned short*)(C.ws + WS_LIST);
    int* cnt = (int*)(C.lds);
    int* offs = (int*)(C.lds + 256);
    unsigned char* kml = C.lds + 1024;
    const int lane = C.lane, ql = lane & 31, hi = lane >> 5;
    bf16x8 qfN[4]; f32x4 kmr[2];
#define GATE_LOAD(uu) do { const int bh_ = (uu) / 63, i_ = (uu) % 63 + 1, b_ = bh_ >> 3, h_ = bh_ & 7; \
        const bf16* qrow_ = Q + ((size_t)(b_ * SEQ + i_ * 256 + C.wave * 32 + ql)) * 512 + h_ * 64 + hi * 8; \
        _Pragma("unroll") for (int ks = 0; ks < 4; ++ks) qfN[ks] = *(const bf16x8*)(qrow_ + ks * 16); \
        const float* kp_ = KM + (size_t)bh_ * NBLK * 64 + C.tid * 8; kmr[0] = *(const f32x4*)kp_; kmr[1] = *(const f32x4*)(kp_ + 4); } while (0)
#define GATE_KML() do { *(v4u*)(kml + (C.tid >> 3) * 144 + (C.tid & 7) * 16) = (v4u){cvtpk(kmr[0][0], kmr[0][1]), cvtpk(kmr[0][2], kmr[0][3]), cvtpk(kmr[1][0], kmr[1][1]), cvtpk(kmr[1][2], kmr[1][3])}; } while (0)
    int u = C.bid;
    if (C.tid < 64) cnt[C.tid] = 0;
    if (u < NBH * 63) { GATE_LOAD(u); GATE_KML(); }
    __syncthreads();
    for (; u < NBH * 63; u += C.G) {
        const int bh = u / 63, i = u % 63 + 1;
        const int q = C.wave * 32 + ql, pos = i * 256 + q;
        bf16x8 qf[4];
#pragma unroll
        for (int ks = 0; ks < 4; ++ks) qf[ks] = qfN[ks];
        const bool more = u + C.G < NBH * 63;
        if (more) GATE_LOAD(u + C.G);
        float b0 = -INFINITY, b1 = -INFINITY, b2 = -INFINITY; int i0 = -1, i1 = -1, i2 = -1;
#define TOP3_INS(v, idx) do { const float v_ = (v); const int x_ = (idx); if (v_ > b0) { b2 = b1; i2 = i1; b1 = b0; i1 = i0; b0 = v_; i0 = x_; } else if (v_ > b1) { b2 = b1; i2 = i1; b1 = v_; i1 = x_; } else if (v_ > b2) { b2 = v_; i2 = x_; } } while (0)
#pragma unroll
        for (int nt = 0; nt < 2; ++nt) {
            f32x16 p = {};
#pragma unroll
            for (int ks = 0; ks < 4; ++ks) {
                const bf16x8 kw = *(const bf16x8*)(kml + (32 * nt + ql) * 144 + ks * 32 + hi * 16);
                p = __builtin_amdgcn_mfma_f32_32x32x16_bf16(kw, qf[ks], p, 0, 0, 0);
            }
#pragma unroll
            for (int r = 0; r < 16; ++r) { const int n = 32 * nt + crow(r, hi); if (n < i) TOP3_INS(p[r], n); }
        }
        { const float c0 = lx_xor(b0, 32), c1 = lx_xor(b1, 32), c2 = lx_xor(b2, 32);
          const int j0 = lx_xor(i0, 32), j1 = lx_xor(i1, 32), j2 = lx_xor(i2, 32);
          if (j0 >= 0) TOP3_INS(c0, j0);
          if (j1 >= 0) TOP3_INS(c1, j1);
          if (j2 >= 0) TOP3_INS(c2, j2); }
#undef TOP3_INS
        int p0 = 0, p1 = 0, p2 = 0;
        if (hi == 0) {
            if (CHECK_ATTN) { int* sp = SEL + ((size_t)bh * SEQ + pos) * 4; sp[0] = i0; sp[1] = i1; sp[2] = i2; sp[3] = -1; }
            p0 = atomicAdd(&cnt[i0], 1);
            if (i1 >= 0) p1 = atomicAdd(&cnt[i1], 1);
            if (i2 >= 0) p2 = atomicAdd(&cnt[i2], 1);
        }
        __syncthreads();
        if (C.tid < 64) {
            const int c = cnt[C.tid]; cnt[C.tid] = 0;
            int inc = c;
#pragma unroll
            for (int o = 1; o < 64; o <<= 1) { const int t = lx_up(inc, o); if (C.tid >= o) inc += t; }
            offs[C.tid + 1] = inc; if (C.tid == 0) offs[0] = 0;
            LOFF[(size_t)(bh * NBLK + i) * 80 + C.tid + 1] = inc; if (C.tid == 0) LOFF[(size_t)(bh * NBLK + i) * 80] = 0;
        }
        if (more) GATE_KML();
        __syncthreads();
        if (hi == 0) {
            unsigned short* lp = LIST + (size_t)(bh * NBLK + i) * 768;
            lp[offs[i0] + p0] = (unsigned short)(q | (0 << 8));
            if (i1 >= 0) lp[offs[i1] + p1] = (unsigned short)(q | (1 << 8));
            if (i2 >= 0) lp[offs[i2] + p2] = (unsigned short)(q | (2 << 8));
        }
    }
#undef GATE_LOAD
#undef GATE_KML
    if (CHECK_ATTN) { for (int e = C.bid * 512 + C.tid; e < NBH * 256; e += C.G * 512) { const int bh = e >> 8, qq = e & 255; int* sp = SEL + ((size_t)bh * SEQ + qq) * 4; sp[0] = -1; sp[1] = -1; sp[2] = -1; sp[3] = -1; } }
    __syncthreads();
}

__device__ __forceinline__ void phase_attn_simple(const Ctx& C, bf16* MIX) {
    const bf16* Q = (const bf16*)(C.ws + WS_PROJ) + (size_t)T_Q * SUBSTRIDE;
    const bf16* K = (const bf16*)(C.ws + WS_PROJ) + (size_t)T_K * SUBSTRIDE;
    const bf16* VV = (const bf16*)(C.ws + WS_PROJ) + (size_t)T_VV * SUBSTRIDE;
    const bf16* ZB = (const bf16*)(C.ws + WS_PROJ) + (size_t)T_ZB * SUBSTRIDE;
    const int* SEL = (const int*)(C.ws + WS_SEL); const float* BT = (const float*)(C.ws + WS_BT);
    const int gt = C.bid * 512 + C.tid, NT = C.G * 512;
    for (int item = gt; item < NBH * SEQ; item += NT) {
        const int bh = item >> 14, pos = item & (SEQ - 1), b = bh >> 3, h = bh & 7, own = pos >> 8;
        const size_t rowq = (size_t)(b * SEQ + pos);
        float qv[64], o[64];
        { const v4u* qp = (const v4u*)(Q + rowq * 512 + h * 64);
#pragma unroll
          for (int c = 0; c < 8; ++c) { const v4u v = qp[c]; qv[8 * c + 0] = bflo(v.x); qv[8 * c + 1] = bfhi(v.x); qv[8 * c + 2] = bflo(v.y); qv[8 * c + 3] = bfhi(v.y);
              qv[8 * c + 4] = bflo(v.z); qv[8 * c + 5] = bfhi(v.z); qv[8 * c + 6] = bflo(v.w); qv[8 * c + 7] = bfhi(v.w); } }
#pragma unroll
        for (int d = 0; d < 64; ++d) o[d] = 0.f;
        float m = -INFINITY, l = 0.f;
        const float* bt = BT + h * 128;
        for (int slot = 0; slot < 4; ++slot) {
            int blk, klim;
            if (slot == 0) { blk = own; klim = (pos & 255) + 1; } else { blk = SEL[(size_t)item * 4 + slot - 1]; klim = 256; if (blk < 0) klim = 0; }
            for (int kl = 0; kl < klim; ++kl) {
                const int kpos = blk * 256 + kl;
                const v4u* kp = (const v4u*)(K + ((size_t)(b * SEQ + kpos)) * 512 + h * 64);
                float a0 = 0.f, a1 = 0.f;
#pragma unroll
                for (int c = 0; c < 8; ++c) { const v4u v = kp[c];
                    a0 += qv[8 * c + 0] * bflo(v.x) + qv[8 * c + 2] * bflo(v.y) + qv[8 * c + 4] * bflo(v.z) + qv[8 * c + 6] * bflo(v.w);
                    a1 += qv[8 * c + 1] * bfhi(v.x) + qv[8 * c + 3] * bfhi(v.y) + qv[8 * c + 5] * bfhi(v.z) + qv[8 * c + 7] * bfhi(v.w); }
                int dd = pos - kpos; dd = dd > 127 ? 127 : dd;
                const float s = (a0 + a1) + bt[dd];
                if (s > m) { const float al = __builtin_amdgcn_exp2f(m - s); l *= al;
#pragma unroll
                    for (int d = 0; d < 64; ++d) o[d] *= al;
                    m = s; }
                const float p = __builtin_amdgcn_exp2f(s - m);
                l += p;
                const v4u* vp = (const v4u*)(VV + ((size_t)(b * SEQ + kpos)) * 512 + h * 64);
#pragma unroll
                for (int c = 0; c < 8; ++c) { const v4u v = vp[c];
                    o[8 * c + 0] += p * bflo(v.x); o[8 * c + 1] += p * bfhi(v.x); o[8 * c + 2] += p * bflo(v.y); o[8 * c + 3] += p * bfhi(v.y);
                    o[8 * c + 4] += p * bflo(v.z); o[8 * c + 5] += p * bfhi(v.z); o[8 * c + 6] += p * bflo(v.w); o[8 * c + 7] += p * bfhi(v.w); }
            }
        }
        const float rl = 1.0f / l;
        const v4u* zp = (const v4u*)(ZB + rowq * 512 + h * 64);
        v4u* op = (v4u*)(MIX + rowq * 1024 + 512 + h * 64);
#pragma unroll
        for (int c = 0; c < 8; ++c) { const v4u z = zp[c]; v4u w;
            w.x = pk2(o[8 * c + 0] * rl * pg8::act_silu(bflo(z.x)), o[8 * c + 1] * rl * pg8::act_silu(bfhi(z.x))); w.y = pk2(o[8 * c + 2] * rl * pg8::act_silu(bflo(z.y)), o[8 * c + 3] * rl * pg8::act_silu(bfhi(z.y)));
            w.z = pk2(o[8 * c + 4] * rl * pg8::act_silu(bflo(z.z)), o[8 * c + 5] * rl * pg8::act_silu(bfhi(z.z))); w.w = pk2(o[8 * c + 6] * rl * pg8::act_silu(bflo(z.w)), o[8 * c + 7] * rl * pg8::act_silu(bfhi(z.w)));
            op[c] = w; }
    }
}

constexpr int AT_KS = 0, AT_KPITCH = 144;
constexpr int AT_VT = 36864, AT_VPITCH = 272;
constexpr int AT_DT = AT_VT + 64 * AT_VPITCH;
constexpr int AT_ENT = AT_DT + 4096, AT_CAP = 4096;
constexpr int AT_PRE = AT_ENT + AT_CAP * 4;
constexpr int AT_OST = AT_PRE + 1024;
constexpr int AT_MISC = AT_OST + 8 * 4096;
constexpr int AT_NUNITS = NBLK * NBH;

typedef int v4i_t __attribute__((ext_vector_type(4)));
#ifndef ATTN_STATIC_PRIO
#define ATTN_STATIC_PRIO 1
#endif
#if ATTN_STATIC_PRIO
#define ATTN_PRIO_UP
#define ATTN_PRIO_DN
#else
#define ATTN_PRIO_UP __builtin_amdgcn_s_setprio(1)
#define ATTN_PRIO_DN __builtin_amdgcn_s_setprio(0)
#endif
struct QTile { unsigned ent; v4i_t qf[4]; };
__device__ __forceinline__ void attn_issue_q(QTile& T, const Ctx& C, const unsigned char* lds, int b, int h, int e0, int cnt) {
    const bf16* Q = (const bf16*)(C.ws + WS_PROJ) + (size_t)T_Q * SUBSTRIDE;
    const unsigned* ENT = (const unsigned*)(lds + AT_ENT);
    const int q = C.lane & 31, hi = C.lane >> 5;
    T.ent = ENT[(e0 + q < cnt) ? (e0 + q) : e0];
    const bf16* qrow = Q + ((size_t)(b * SEQ + (int)(T.ent & 16383u))) * 512 + h * 64 + hi * 8;
    asm volatile("global_load_dwordx4 %0, %4, off\n\tglobal_load_dwordx4 %1, %4, off offset:32\n\tglobal_load_dwordx4 %2, %4, off offset:64\n\tglobal_load_dwordx4 %3, %4, off offset:96"
                 : "=&v"(T.qf[0]), "=&v"(T.qf[1]), "=&v"(T.qf[2]), "=&v"(T.qf[3]) : "v"(qrow));
}
__device__ __forceinline__ void attn_wait_q(QTile& T) { asm volatile("s_waitcnt vmcnt(0)" : "+v"(T.qf[0]), "+v"(T.qf[1]), "+v"(T.qf[2]), "+v"(T.qf[3])); }
__device__ __forceinline__ void attn_tile(const Ctx& C, unsigned char* lds, const QTile& T, QTile& Tn, int bh, int e0, int cnt, int nkt2, const bool OWN) {
    bf16* PO = (bf16*)C.out; float* PL = (float*)(C.ws + WS_PL);
    const unsigned* ENT = (const unsigned*)(lds + AT_ENT);
    const int lane = C.lane, q = lane & 31, hi = lane >> 5;
    const unsigned ent = T.ent;
    const int pos = ent & 16383, qoff = (ent >> 16) & 1023;
    f32x16 o0 = {}, o1 = {}, ol = {};
    v8i_t pa8 = {};
    asm volatile("" : "+v"(pa8));
    const bool anybias = OWN ? true : (__any(qoff < 112) != 0);
    const unsigned char* kbase = lds + AT_KS + q * AT_KPITCH + hi * 16;
    const unsigned char* vbase = lds + AT_VT + q * AT_VPITCH + hi * 32;
    const float* et0 = (const float*)(lds + AT_DT) + (1023 - (256 + (OWN ? 0 : 256) + qoff - 4 * hi));
    bf16x8 kf[8];
#pragma unroll
    for (int ks = 0; ks < 4; ++ks) { kf[2 * ks] = *(const bf16x8*)(kbase + ks * 32); kf[2 * ks + 1] = *(const bf16x8*)(kbase + 32 * AT_KPITCH + ks * 32); }
    for (int kt2 = 0; kt2 < nkt2; ++kt2) {
        f32x16 p0, p1;
        if (anybias && (OWN || kt2 >= 2)) {
            const float* et = et0 + 64 * kt2;
#pragma unroll
            for (int r = 0; r < 16; ++r) { p0[r] = et[(r & 3) + 8 * (r >> 2)]; p1[r] = et[32 + (r & 3) + 8 * (r >> 2)]; }
#pragma unroll
            for (int ks = 0; ks < 4; ++ks) {
                p0 = __builtin_amdgcn_mfma_f32_32x32x16_bf16(kf[2 * ks], __builtin_bit_cast(bf16x8, T.qf[ks]), p0, 0, 0, 0);
                p1 = __builtin_amdgcn_mfma_f32_32x32x16_bf16(kf[2 * ks + 1], __builtin_bit_cast(bf16x8, T.qf[ks]), p1, 0, 0, 0);
            }
        } else {
            p0 = (f32x16){}; p1 = (f32x16){};
#pragma unroll
            for (int ks = 0; ks < 4; ++ks) {
                p0 = __builtin_amdgcn_mfma_f32_32x32x16_bf16(kf[2 * ks], __builtin_bit_cast(bf16x8, T.qf[ks]), p0, 0, 0, 0);
                p1 = __builtin_amdgcn_mfma_f32_32x32x16_bf16(kf[2 * ks + 1], __builtin_bit_cast(bf16x8, T.qf[ks]), p1, 0, 0, 0);
            }
        }
        v8i_t vb0, vb1;
        { typedef int v4i_t __attribute__((ext_vector_type(4)));
          const v4i_t a0 = *(const v4i_t*)(vbase + 64 * kt2), a1 = *(const v4i_t*)(vbase + 64 * kt2 + 16);
          const v4i_t c0 = *(const v4i_t*)(vbase + 32 * AT_VPITCH + 64 * kt2), c1 = *(const v4i_t*)(vbase + 32 * AT_VPITCH + 64 * kt2 + 16);
          vb0 = __builtin_shufflevector(a0, a1, 0, 1, 2, 3, 4, 5, 6, 7); vb1 = __builtin_shufflevector(c0, c1, 0, 1, 2, 3, 4, 5, 6, 7); }
#pragma unroll
        for (int r = 0; r < 16; ++r) { p0[r] = __builtin_amdgcn_exp2f(p0[r]); p1[r] = __builtin_amdgcn_exp2f(p1[r]); }
        { typedef short v2s_t __attribute__((ext_vector_type(2)));
#pragma unroll
          for (int i = 0; i < 4; ++i) {
              v2s_t w = __builtin_bit_cast(v2s_t, pa8[i]);
              w = __builtin_amdgcn_cvt_scalef32_pk_fp8_f32(w, p0[4 * i], p0[4 * i + 1], 16.0f, false); w = __builtin_amdgcn_cvt_scalef32_pk_fp8_f32(w, p0[4 * i + 2], p0[4 * i + 3], 16.0f, true);
              pa8[i] = __builtin_bit_cast(int, w);
              v2s_t z = __builtin_bit_cast(v2s_t, pa8[4 + i]);
              z = __builtin_amdgcn_cvt_scalef32_pk_fp8_f32(z, p1[4 * i], p1[4 * i + 1], 16.0f, false); z = __builtin_amdgcn_cvt_scalef32_pk_fp8_f32(z, p1[4 * i + 2], p1[4 * i + 3], 16.0f, true);
              pa8[4 + i] = __builtin_bit_cast(int, z);
          } }
        if (kt2 + 1 < nkt2) {
#pragma unroll
            for (int ks = 0; ks < 4; ++ks) { kf[2 * ks] = *(const bf16x8*)(kbase + (64 * kt2 + 64) * AT_KPITCH + ks * 32); kf[2 * ks + 1] = *(const bf16x8*)(kbase + (64 * kt2 + 96) * AT_KPITCH + ks * 32); }
        }
        ATTN_PRIO_UP;
        o0 = __builtin_amdgcn_mfma_scale_f32_32x32x64_f8f6f4(vb0, pa8, o0, 0, 0, 0, 0x7f7f7f7f, 0, (int)0x83838383);
        o1 = __builtin_amdgcn_mfma_scale_f32_32x32x64_f8f6f4(vb1, pa8, o1, 0, 0, 0, 0x7f7f7f7f, 0, (int)0x83838383);
        v8i_t ones8;
#pragma unroll
        for (int i = 0; i < 8; ++i) { int c_; asm volatile("v_mov_b32 %0, 0x38383838" : "=v"(c_)); ones8[i] = c_; }
        ol = __builtin_amdgcn_mfma_scale_f32_32x32x64_f8f6f4(ones8, pa8, ol, 0, 0, 0, 0x7f7f7f7f, 0, (int)0x83838383);
        ATTN_PRIO_DN;
    }
    const float l = ol[0];
    attn_wait_q(Tn);
    if (e0 + q < cnt) PL[((size_t)bh * SEQ + pos) * 4 + ((ent >> 14) & 3)] = l;
    { bf16* prow = PO + (((size_t)bh * SEQ + pos) * 4 + ((ent >> 14) & 3)) * 64 + hi * 8;
      const bool live = e0 + q < cnt;
#pragma unroll
      for (int j = 0; j < 2; ++j) {
          unsigned a0 = pg8::cvt_pk_bf16(o0[8 * j], o0[8 * j + 1]), a1 = pg8::cvt_pk_bf16(o0[8 * j + 2], o0[8 * j + 3]), b0 = pg8::cvt_pk_bf16(o0[8 * j + 4], o0[8 * j + 5]), b1 = pg8::cvt_pk_bf16(o0[8 * j + 6], o0[8 * j + 7]);
          { auto r0 = __builtin_amdgcn_permlane32_swap(a0, b0, false, false); a0 = r0[0]; b0 = r0[1]; auto r1 = __builtin_amdgcn_permlane32_swap(a1, b1, false, false); a1 = r1[0]; b1 = r1[1]; }
          unsigned c0 = pg8::cvt_pk_bf16(o1[8 * j], o1[8 * j + 1]), c1 = pg8::cvt_pk_bf16(o1[8 * j + 2], o1[8 * j + 3]), d0 = pg8::cvt_pk_bf16(o1[8 * j + 4], o1[8 * j + 5]), d1 = pg8::cvt_pk_bf16(o1[8 * j + 6], o1[8 * j + 7]);
          { auto r0 = __builtin_amdgcn_permlane32_swap(c0, d0, false, false); c0 = r0[0]; d0 = r0[1]; auto r1 = __builtin_amdgcn_permlane32_swap(c1, d1, false, false); c1 = r1[0]; d1 = r1[1]; }
          if (live) { *(v4u*)(prow + 16 * j) = (v4u){a0, a1, b0, b1}; *(v4u*)(prow + 32 + 16 * j) = (v4u){c0, c1, d0, d1}; }
      } }
}

__device__ __forceinline__ void phase_attn(const Ctx& C, int layer) {
    if (ATTN_STATIC_PRIO && C.wave >= 4) __builtin_amdgcn_s_setprio(2);
    unsigned char* lds = C.lds;
    const bf16* K = (const bf16*)(C.ws + WS_PROJ) + (size_t)T_K * SUBSTRIDE;
    const bf16* VV = (const bf16*)(C.ws + WS_PROJ) + (size_t)T_VV * SUBSTRIDE;
    const int* LOFF = (const int*)(C.ws + WS_LOFF); const unsigned short* LIST = (const unsigned short*)(C.ws + WS_LIST);
    const float* BT = (const float*)(C.ws + WS_BT);
    const int qg = C.bid & 7;
    unsigned* ctr = (unsigned*)(C.ws + WS_CTL) + 64 + 64 * layer;
    int qstep = 0;
    unsigned* ENT = (unsigned*)(lds + AT_ENT);
    int* PRE = (int*)(lds + AT_PRE); int* LO = PRE + 68;
    volatile unsigned* MISC = (volatile unsigned*)(lds + AT_MISC);
    int tid = C.tid;
    v4u kpre[4], vpre[2]; int lpre0 = 0, lpre1 = 0;
#define AT_LOADKV(uu) do { const int bh_ = (uu) & 15, n_ = (uu) >> 4; \
        const bf16* Kg = K + ((size_t)((bh_ >> 3) * SEQ + n_ * 256)) * 512 + (bh_ & 7) * 64; const unsigned char* Vg = (const unsigned char*)VV + ((size_t)((bh_ >> 3) * SEQ + n_ * 256)) * 512 + (bh_ & 7) * 64; \
        _Pragma("unroll") for (int it = 0; it < 4; ++it) { const int idx = tid + 512 * it; kpre[it] = *(const v4u*)(Kg + (size_t)(idx >> 3) * 512 + (idx & 7) * 8); } \
        _Pragma("unroll") for (int it = 0; it < 2; ++it) { const int idx = tid + 512 * it; vpre[it] = *(const v4u*)(Vg + (size_t)(idx >> 2) * 512 + (idx & 3) * 16); }     \
        lpre0 = 0; lpre1 = 0; if (tid < 64 && n_ + 1 + tid < NBLK) { const int* lp_ = LOFF + ((size_t)(bh_ * NBLK + n_ + 1 + tid)) * 80 + n_; lpre0 = lp_[0]; lpre1 = lp_[1]; } } while (0)
#define AT_FETCH() ({ unsigned r_ = (unsigned)AT_NUNITS; while (qstep < 8) { const int g_ = (qg + qstep) & 7; const unsigned k_ = atomicAdd(ctr + 4 * g_, 1u); \
        if (k_ < 2u * NBLK) { r_ = (k_ >> 1) * 16 + 2 * g_ + (k_ & 1); break; } ++qstep; } r_; })
    if (tid == 0) MISC[0] = AT_FETCH();
    __syncthreads();
    int u = (int)MISC[0];
    if (u < AT_NUNITS) AT_LOADKV(u);
    while (u < AT_NUNITS) {
        asm volatile("" : "+v"(tid));
        Ctx Cu = C; Cu.tid = tid; Cu.lane = tid & 63;
        const int bh = u & 15, n = u >> 4, b = bh >> 3, h = bh & 7;
        if (tid == 0) MISC[1] = AT_FETCH();
#pragma unroll
        for (int it = 0; it < 4; ++it) { const int idx = tid + 512 * it;
            *(v4u*)(lds + AT_KS + (idx >> 3) * AT_KPITCH + (idx & 7) * 16) = kpre[it]; }
#pragma unroll
        for (int it = 0; it < 2; ++it) { const int idx = tid + 512 * it;
            const v4u v = vpre[it];
            unsigned char* vt = lds + AT_VT + (16 * (idx & 3)) * AT_VPITCH + at_vpos(idx >> 2);
            const unsigned w_[4] = {v.x, v.y, v.z, v.w};
#pragma unroll
            for (int e = 0; e < 16; ++e) vt[e * AT_VPITCH] = (unsigned char)(w_[e >> 2] >> (8 * (e & 3))); }
        { float* et_ = (float*)(lds + AT_DT);
#pragma unroll
          for (int k_ = 0; k_ < 2; ++k_) { const int j_ = tid + 512 * k_, d_ = j_ - 256; et_[1023 - j_] = d_ < 0 ? -INFINITY : (d_ < 128 ? BT[h * 128 + d_] - BT[h * 128 + 127] : 0.f);     } }
        if (tid < 64) {
            const int lo = lpre0; int inc = lpre1 - lpre0;
#pragma unroll
            for (int o = 1; o < 64; o <<= 1) { const int t = lx_up(inc, o); if (tid >= o) inc += t; }
            PRE[tid + 1] = inc; LO[tid] = lo; if (tid == 0) PRE[0] = 0;
        }
        __syncthreads();
        const int total = 256 + PRE[63 - n];
        const int unext = (int)MISC[1];
        if (unext < AT_NUNITS) AT_LOADKV(unext);
        for (int base = 0; base < total; base += AT_CAP) {
            const int cnt = (total - base < AT_CAP) ? (total - base) : AT_CAP;
            if (base == 0 && tid < 256) ENT[tid] = (unsigned)(n * 256 + tid) | (3u << 14) | ((unsigned)tid << 16);
            { const int e_lo = base > 256 ? base : 256, e_hi = base + cnt;
#pragma unroll 4
              for (int e = e_lo + tid; e < e_hi; e += 512) {
                  const int es = e - 256; int a = 0, z = 63 - n;
#pragma unroll
                  for (int it = 0; it < 6; ++it) { const int mid = (a + z) >> 1; const bool up = (z - a > 1) && (PRE[mid] <= es); const bool dn = (z - a > 1) && !up; a = up ? mid : a; z = dn ? mid : z; }
                  const int ii = a, i = n + 1 + ii;
                  const unsigned val = LIST[((size_t)(bh * NBLK + i)) * 768 + LO[ii] + (es - PRE[ii])]; const unsigned ql = val & 255u, j = val >> 8;
                  ENT[e - base] = (unsigned)(i * 256 + ql) | (j << 14) | ((ii == 0 ? ql : 400u) << 16);
              } }
            if (tid == 0) MISC[2] = 0u;
            __syncthreads();
            const int ntiles = (cnt + 31) >> 5;
            const int nown = (base == 0) ? 8 : 0;
#define AT_TICKET() ({ int tk_ = 0; if (Cu.lane == 0) tk_ = (int)atomicAdd((unsigned*)(lds + AT_MISC + 8), 1u); __builtin_amdgcn_readfirstlane(tk_); })
#define AT_TILEOF(tk_) (((tk_) < ntiles - nown) ? nown + (tk_) : (ntiles - 1 - (tk_)))
            { int tk = AT_TICKET();
              if (tk < ntiles) {
                  int tile = AT_TILEOF(tk);
                  QTile Tc; attn_issue_q(Tc, Cu, lds, b, h, tile * 32, cnt); attn_wait_q(Tc);
                  for (;;) {
                      const int tkn = AT_TICKET(); const bool more = tkn < ntiles; const int tilen = more ? AT_TILEOF(tkn) : 0;
                      QTile Tn; attn_issue_q(Tn, Cu, lds, b, h, tilen * 32, cnt);
                      { const bool own_ = tile < nown; attn_tile(Cu, lds, Tc, Tn, bh, tile * 32, cnt, own_ ? (tile >> 1) + 1 : 4, own_); }
                      if (!more) break;
                      Tc = Tn; tile = tilen;
                  }
              } }
#undef AT_TICKET
#undef AT_TILEOF
            __syncthreads();
        }
        u = unext;
    }
#undef AT_LOADKV
#undef AT_FETCH
    if (ATTN_STATIC_PRIO) __builtin_amdgcn_s_setprio(0);
}

__device__ __forceinline__ void phase_combine(const Ctx& C) {
    const bf16* PO = (const bf16*)C.out; const float* PL = (const float*)(C.ws + WS_PL);
    const bf16* ZB = (const bf16*)(C.ws + WS_PROJ) + (size_t)T_ZB * SUBSTRIDE;
    bf16* MIX = (bf16*)(C.ws + WS_MIX);
    const int gt = C.bid * 512 + C.tid, NT = C.G * 512;
    constexpr int UN = 4;
    for (int idx0 = gt; idx0 < MROWS * 64; idx0 += NT * UN) {
        typedef unsigned u32x2v __attribute__((ext_vector_type(2)));
        f32x4 lv[UN]; v4u pv[UN][4]; u32x2v zv[UN];
#pragma unroll
        for (int k = 0; k < UN; ++k) {
            const int idx = idx0 + k * NT;
            const int ch = idx & 7, h = (idx >> 3) & 7, row = idx >> 6, b = row >> 14, pos = row & (SEQ - 1), i = pos >> 8;
            const size_t pb = ((size_t)(b * NH + h) * SEQ + pos) * 4;
            lv[k] = *(const f32x4*)(PL + pb);
#pragma unroll
            for (int j = 0; j < 4; ++j) pv[k][j] = (j == 3 || j < i) ? *(const v4u*)(PO + (pb + j) * 64 + ch * 8) : (v4u){0u, 0u, 0u, 0u};
            zv[k] = *(const u32x2v*)((const unsigned char*)ZB + (size_t)row * 512 + h * 64 + ch * 8);
        }
#pragma unroll
        for (int k = 0; k < UN; ++k) {
            const int idx = idx0 + k * NT;
            const int ch = idx & 7, h = (idx >> 3) & 7, row = idx >> 6, pos = row & (SEQ - 1), i = pos >> 8;
            float L = lv[k][3];
#pragma unroll
            for (int j = 0; j < 3; ++j) L += (j < i) ? lv[k][j] : 0.f;
            float acc[8];
#pragma unroll
            for (int e = 0; e < 8; ++e) acc[e] = 0.f;
#pragma unroll
            for (int j = 0; j < 4; ++j) { const v4u v = pv[k][j];
                acc[0] += bflo(v.x); acc[1] += bfhi(v.x); acc[2] += bflo(v.y); acc[3] += bfhi(v.y); acc[4] += bflo(v.z); acc[5] += bfhi(v.z); acc[6] += bflo(v.w); acc[7] += bfhi(v.w); }
            const float rl = 1.0f / L;
            const u32x2v z = zv[k];
            const auto z01 = __builtin_amdgcn_cvt_pk_f32_fp8((int)z.x, false), z23 = __builtin_amdgcn_cvt_pk_f32_fp8((int)z.x, true), z45 = __builtin_amdgcn_cvt_pk_f32_fp8((int)z.y, false), z67 = __builtin_amdgcn_cvt_pk_f32_fp8((int)z.y, true);
            v4u w;
            w.x = pk2(acc[0] * rl * pg8::act_silu(z01[0]), acc[1] * rl * pg8::act_silu(z01[1])); w.y = pk2(acc[2] * rl * pg8::act_silu(z23[0]), acc[3] * rl * pg8::act_silu(z23[1]));
            w.z = pk2(acc[4] * rl * pg8::act_silu(z45[0]), acc[5] * rl * pg8::act_silu(z45[1])); w.w = pk2(acc[6] * rl * pg8::act_silu(z67[0]), acc[7] * rl * pg8::act_silu(z67[1]));
            *(v4u*)(MIX + (size_t)row * 1024 + 512 + h * 64 + ch * 8) = w;
        }
    }
}

constexpr int SG_VPITCH = 272, SG_MPITCH = 144, SG_WREG = 128 * SG_MPITCH;
constexpr int SG_STATS = 8 * SG_WREG;
constexpr int SG_MR = SG_STATS + 8192;
constexpr int SG_LN = SG_MR + 1024;
__device__ __forceinline__ void phase_sgu(const Ctx& C, int layer) {
    typedef float f32x2v __attribute__((ext_vector_type(2)));
    unsigned char* lds = C.lds;
    const bf16* U = (const bf16*)(C.ws + WS_PROJ) + (size_t)T_U * SUBSTRIDE;
    const bf16* V = (const bf16*)(C.ws + WS_PROJ) + (size_t)T_V * SUBSTRIDE;
    const bf16* ZA = (const bf16*)(C.ws + WS_PROJ) + (size_t)T_ZA * SUBSTRIDE;
    bf16* MIX = (bf16*)(C.ws + WS_MIX);
    const int g = C.wave; int lane = C.lane;
    const float* lng = C.ln_g + layer * 512 + g * 64; const float* lnb = C.ln_b + layer * 512 + g * 64;
    const bf16* Wg = (const bf16*)(C.ws + WS_WST) + ((size_t)(layer * 8 + g)) * 128 * 128;
    const float* bg = C.sgu_b + (layer * 8 + g) * 128;
    unsigned char* myreg = lds + g * SG_WREG;
    f32x2v* stats = (f32x2v*)(lds + SG_STATS); f32x2v* mr = (f32x2v*)(lds + SG_MR);
    float* lnl = (float*)(lds + SG_LN + g * 512);
    lnl[lane] = lng[lane]; lnl[64 + lane] = lnb[lane];
    for (int u = C.bid; u < MROWS / 128; u += C.G) {
        const size_t row0 = (size_t)u * 128;
        asm volatile("" : "+v"(lane));
        v4u xv[2][8];
#pragma unroll
        for (int rr = 0; rr < 2; ++rr) {
            const v4u* vp = (const v4u*)(V + (row0 + lane + 64 * rr) * 512 + g * 64);
#pragma unroll
            for (int c = 0; c < 8; ++c) xv[rr][c] = vp[c];
        }
#pragma unroll
        for (int rr = 0; rr < 2; ++rr) {
            float s1 = 0.f, s2 = 0.f;
#pragma unroll
            for (int c = 0; c < 8; ++c) { v4u v = xv[rr][c];
                v.x = pk2(pg8::act_gelu(bflo(v.x)), pg8::act_gelu(bfhi(v.x))); v.y = pk2(pg8::act_gelu(bflo(v.y)), pg8::act_gelu(bfhi(v.y)));
                v.z = pk2(pg8::act_gelu(bflo(v.z)), pg8::act_gelu(bfhi(v.z))); v.w = pk2(pg8::act_gelu(bflo(v.w)), pg8::act_gelu(bfhi(v.w))); xv[rr][c] = v;
                const float f0 = bflo(v.x), f1 = bfhi(v.x), f2 = bflo(v.y), f3 = bfhi(v.y), f4 = bflo(v.z), f5 = bfhi(v.z), f6 = bflo(v.w), f7 = bfhi(v.w);
                s1 += ((f0 + f1) + (f2 + f3)) + ((f4 + f5) + (f6 + f7));
                s2 += ((f0 * f0 + f1 * f1) + (f2 * f2 + f3 * f3)) + ((f4 * f4 + f5 * f5) + (f6 * f6 + f7 * f7)); }
            stats[g * 128 + lane + 64 * rr] = (f32x2v){s1, s2};
        }
        bf16x8 wf[4][8];
        { const bf16* wa = Wg + (size_t)(lane & 31) * 128 + (lane >> 5) * 8;
#pragma unroll
          for (int tt = 0; tt < 4; ++tt)
#pragma unroll
              for (int ks = 0; ks < 8; ++ks) if (tt >= (ks >> 1)) wf[tt][ks] = *(const bf16x8*)(wa + (size_t)tt * 32 * 128 + ks * 16); }
        __syncthreads();
        if (C.tid < 128) {
            float s1 = 0.f, s2 = 0.f;
#pragma unroll
            for (int w = 0; w < 8; ++w) { const f32x2v t = stats[w * 128 + C.tid]; s1 += t.x; s2 += t.y; }
            const float mean = s1 * (1.0f / 512.0f), var = s2 * (1.0f / 512.0f) - mean * mean;
            mr[C.tid] = (f32x2v){mean, 1.0f / sqrtf(var + LN_EPS)};
        }
        __syncthreads();
#pragma unroll
        for (int c = 0; c < 8; ++c) asm volatile("" : "+v"(xv[0][c]), "+v"(xv[1][c]));
        { const f32x2v m0 = mr[lane], m1 = mr[lane + 64];
          unsigned short* vt = (unsigned short*)(myreg + lane * 2);
#pragma unroll
          for (int c = 0; c < 8; ++c) {
              const v4u v0 = xv[0][c], v1 = xv[1][c];
              const float f0[8] = {bflo(v0.x), bfhi(v0.x), bflo(v0.y), bfhi(v0.y), bflo(v0.z), bfhi(v0.z), bflo(v0.w), bfhi(v0.w)};
              const float f1[8] = {bflo(v1.x), bfhi(v1.x), bflo(v1.y), bfhi(v1.y), bflo(v1.z), bfhi(v1.z), bflo(v1.w), bfhi(v1.w)};
#pragma unroll
              for (int e = 0; e < 8; ++e) { const int d = 8 * c + e; const float gg = lnl[d], bbv = lnl[64 + d];
                  vt[d * (SG_VPITCH / 2)] = (unsigned short)f2bf((f0[e] - m0.x) * m0.y * gg + bbv);
                  vt[d * (SG_VPITCH / 2) + 64] = (unsigned short)f2bf((f1[e] - m1.x) * m1.y * gg + bbv); }
              asm volatile("" ::: "memory");
          } }
        LDS_WAIT(); asm volatile("" ::: "memory");
        { const int q = lane & 31, hi = lane >> 5;
          unsigned pk[2][4][8];
#pragma unroll
          for (int dt = 0; dt < 2; ++dt) {
              const unsigned char* bb = myreg + (32 * dt + q) * SG_VPITCH + hi * 16;
              f32x16 acc[4];
#pragma unroll
              for (int tt = 0; tt < 4; ++tt) acc[tt] = (f32x16){};
#pragma unroll
              for (int ks = 0; ks < 8; ++ks) {
                  const bf16x8 b0 = *(const bf16x8*)(bb + ks * 32);
#pragma unroll
                  for (int tt = 0; tt < 4; ++tt) if (tt >= (ks >> 1)) acc[tt] = __builtin_amdgcn_mfma_f32_32x32x16_bf16(wf[tt][ks], b0, acc[tt], 0, 0, 0);
              }
#pragma unroll
              for (int tt = 0; tt < 4; ++tt)
#pragma unroll
                  for (int rp = 0; rp < 8; ++rp) pk[dt][tt][rp] = cvtpk(acc[tt][2 * rp], acc[tt][2 * rp + 1]);
          }
          LDS_WAIT(); asm volatile("" ::: "memory");
          unsigned char* mxb = myreg + (4 * hi) * SG_MPITCH + q * 2;
#pragma unroll
          for (int dt = 0; dt < 2; ++dt)
#pragma unroll
              for (int tt = 0; tt < 4; ++tt)
#pragma unroll
                  for (int r = 0; r < 16; ++r)
                      *(unsigned short*)(mxb + (32 * tt + (r & 3) + 8 * (r >> 2)) * SG_MPITCH + 64 * dt) = (unsigned short)((r & 1) ? (pk[dt][tt][r >> 1] >> 16) : (pk[dt][tt][r >> 1] & 0xffffu));
        }
        LDS_WAIT(); asm volatile("" ::: "memory");
        { const int ch = lane & 7, r8 = lane >> 3;
#pragma unroll 4
          for (int it = 0; it < 16; ++it) {
              const int t = it * 8 + r8;
              const v4u mv = *(const v4u*)(myreg + t * SG_MPITCH + ch * 16);
              const v4u uv = *(const v4u*)(U + (row0 + t) * 512 + g * 64 + ch * 8), zv = *(const v4u*)(ZA + (row0 + t) * 512 + g * 64 + ch * 8);
              const float bt = bg[t];
              v4u o;
#define SGU_Y(uw, mw, zw) pk2(pg8::act_gelu(bflo(uw)) * (bflo(mw) + bt) * pg8::act_silu(bflo(zw)), pg8::act_gelu(bfhi(uw)) * (bfhi(mw) + bt) * pg8::act_silu(bfhi(zw)))
              o.x = SGU_Y(uv.x, mv.x, zv.x); o.y = SGU_Y(uv.y, mv.y, zv.y); o.z = SGU_Y(uv.z, mv.z, zv.z); o.w = SGU_Y(uv.w, mv.w, zv.w);
#undef SGU_Y
              *(v4u*)(MIX + (row0 + t) * 1024 + g * 64 + ch * 8) = o;
          } }
        __syncthreads();
    }
}

__device__ __forceinline__ void phase_check_inject(const Ctx& C) {
    if (C.bid == 0 && C.tid == 0) C.out[0] = __uint_as_float(((const unsigned*)(C.ws + WS_CTL))[32]) * 1e6f;
}

#define GAS __attribute__((address_space(1)))
typedef GAS unsigned gu32;
#define RLX_AGENT __ATOMIC_RELAXED, __HIP_MEMORY_SCOPE_AGENT
constexpr int CW_BAR = 4096;
constexpr int LDS_BARST = LDS_BYTES - 64;
#define XB_TMO      128
#define XB_XCNT(j)  (256  + 64 * (j))
#define XB_XSUB(j)  (1280 + 64 * (j))
#define XB_XGEN(j)  (2304 + 64 * (j))
#define XB_TOP      3328
#define XB_TOPGEN   3392
#define XCD_BAR_WORDS 3456
#define XB_SPIN_CAP (1u << 18)

__device__ __forceinline__ unsigned xb_ld(unsigned* p)              { return __hip_atomic_load(p, __ATOMIC_RELAXED, __HIP_MEMORY_SCOPE_AGENT); }
__device__ __forceinline__ unsigned xb_add(unsigned* p, unsigned v) { return __hip_atomic_fetch_add(p, v, __ATOMIC_RELAXED, __HIP_MEMORY_SCOPE_AGENT); }
__device__ __forceinline__ unsigned xb_xcc_id() { return (unsigned)__builtin_amdgcn_s_getreg((3 << 11) | 20) & 0xFu; }
#define XB_SPIN(cond, bar) do { unsigned _sp = 0; while (cond) { __builtin_amdgcn_s_sleep(1); \
    if ((++_sp & 255u) == 0u) { if (xb_ld(&(bar)[XB_TMO])) break; if (_sp > XB_SPIN_CAP) { atomicAdd(&(bar)[XB_TMO], 1u); break; } } } } while (0)

struct XcdBarrier {
    unsigned* bar; unsigned x;
    volatile LAS unsigned* st;
};

__device__ __forceinline__ XcdBarrier xcd_barrier_post(unsigned* bar, volatile LAS unsigned* st) {
    XcdBarrier b; b.bar = bar; b.x = xb_xcc_id(); b.st = st;
    if (threadIdx.x == 0) (void)xb_add(&bar[XB_XCNT(b.x)], 1u);
    return b;
}
__device__ __forceinline__ void xcd_barrier_complete(unsigned* bar, unsigned x, unsigned& nloc, unsigned& nx) {
    const unsigned G = gridDim.x * gridDim.y * gridDim.z;
    unsigned sum, cnt, mine, sp = 0u;
    for (;;) {
        sum = 0u; cnt = 0u; mine = 0u;
#pragma unroll
        for (unsigned j = 0; j < 16; ++j) { const unsigned c = xb_ld(&bar[XB_XCNT(j)]); sum += c; cnt += (c > 0u) ? 1u : 0u; mine = (j == x) ? c : mine; }
        if (sum == G) break;
        __builtin_amdgcn_s_sleep(1);
        if ((++sp & 255u) == 0u) { if (xb_ld(&bar[XB_TMO])) break; if (sp > XB_SPIN_CAP) { atomicAdd(&bar[XB_TMO], 1u); break; } }
    }
    nloc = mine > 0u ? mine : 1u; nx = cnt > 0u ? cnt : 1u;
}

__device__ __forceinline__ void xcd_barrier(const XcdBarrier& b, const bool leader_thread) {
    asm volatile("s_waitcnt vmcnt(0)" ::: "memory");
    __syncthreads();
    if (leader_thread) {
        unsigned* bar = b.bar;
        __builtin_amdgcn_s_waitcnt(0);
        unsigned nloc = b.st[0], nx = b.st[1];
        if (nloc == 0u) { xcd_barrier_complete(bar, b.x, nloc, nx); b.st[0] = nloc; b.st[1] = nx; }
        const unsigned old = xb_add(&bar[XB_XSUB(b.x)], 1u);
        const unsigned gen = old / nloc;
        if (old + 1u == (gen + 1u) * nloc) {
            __builtin_amdgcn_fence(__ATOMIC_RELEASE, "agent");
            asm volatile("s_waitcnt vmcnt(0)" ::: "memory");
            const unsigned og = xb_add(&bar[XB_TOP], 1u);
            const unsigned tg = og / nx;
            if (og + 1u == (tg + 1u) * nx) xb_add(&bar[XB_TOPGEN], 1u);
            else XB_SPIN(xb_ld(&bar[XB_TOPGEN]) == tg, bar);
            __builtin_amdgcn_fence(__ATOMIC_ACQUIRE, "agent");
            xb_add(&bar[XB_XGEN(b.x)], 1u);
            asm volatile("s_waitcnt vmcnt(0)" ::: "memory");
        } else {
            XB_SPIN(xb_ld(&bar[XB_XGEN(b.x)]) == gen, bar);
            __builtin_amdgcn_fence(__ATOMIC_ACQUIRE, "agent");
            asm volatile("s_waitcnt vmcnt(0)" ::: "memory");
        }
    }
    __syncthreads();
}

template <int ST> __device__ __forceinline__ void run_stage(const Args& args, unsigned char* lds, int Lr, int wave_s) {
    const int L = Lr;
    Ctx C;
    { int t = wave_s * 64 + lane_now(); C.tid = t; }
    C.lds = lds; C.lane = C.tid & 63; C.wave = __builtin_amdgcn_readfirstlane(C.tid >> 6); C.G = gridDim.x; C.bid = blockIdx.x;
    C.x = args.in[0]; C.norm_g = args.in[1]; C.w_in = args.in[2]; C.ln_g = args.in[3]; C.ln_b = args.in[4]; C.sgu_w = args.in[5]; C.sgu_b = args.in[6];
    C.w_out = args.in[7]; C.rel_bias = args.in[8]; C.final_g = args.in[9]; C.out = args.out; C.ws = args.ws;
    asm volatile("" : "+s"(C.ws), "+s"(C.out), "+s"(C.x), "+s"(C.sgu_b), "+s"(C.ln_g), "+s"(C.ln_b));
    if constexpr (ST == 0) phase_prologue(C);
    else if constexpr (ST == 1) {
        float* rtab = (float*)(lds + RING_BYTES);
        const float* rowss = (const float*)(C.ws + WS_ROWSS);
        float* kmean = (float*)(C.ws + WS_KMEAN) + (size_t)L * NBH * NBLK * 64;
#define RTAB_BUILD(S_) do { pmA = -1; pmB = -1; pmC = -1; pmD = -1; \
          { pg8::Unit uu; for (int i = 0; S_.next(i, uu); ++i) { const int pmu = uu.pm; \
              if (pmu == pmA || pmu == pmB || pmu == pmC || pmu == pmD) continue; \
              if (pmA < 0) pmA = pmu; else if (pmB < 0) pmB = pmu; else if (pmC < 0) pmC = pmu; else if (pmD < 0) pmD = pmu; } } \
          _Pragma("unroll") for (int k = 0; k < 2; ++k) { const int e = C.tid + 512 * k, sl = e >> 8, pmk = sl == 0 ? pmA : sl == 1 ? pmB : sl == 2 ? pmC : pmD; \
              if (pmk >= 0) { const f32x4* rp = (const f32x4*)(rowss + ((size_t)pmk * 256 + (e & 255)) * 16); const f32x4 s0 = rp[0], s1 = rp[1], s2 = rp[2], s3 = rp[3]; \
                  const float ss = ((s0[0] + s0[1]) + (s0[2] + s0[3])) + ((s1[0] + s1[1]) + (s1[2] + s1[3])) + ((s2[0] + s2[1]) + (s2[2] + s2[3])) + ((s3[0] + s3[1]) + (s3[2] + s3[3])); \
                  rtab[e] = 1.0f / sqrtf(ss * (1.0f / 1024.0f) + NORM_EPS); } } \
          __syncthreads(); } while (0)
        int pmA, pmB, pmC, pmD;
        pg8::Gemm g1{(const pg8::bf16_t*)(C.ws + WS_XB), (const pg8::bf16_t*)(C.ws + WS_WIN) + (size_t)L * DIN * DM, MROWS, 2048, DM};
        pg8::Gemm g2{(const pg8::bf16_t*)(C.ws + WS_XB8), (const pg8::bf16_t*)(C.ws + WS_WIN8 + (size_t)L * 1536 * 2 * DM), MROWS, 1536, DM, DM / 2};
        pg8::StaticOrder S1; S1.init(MROWS, 2048, C.G, C.bid);
        pg8::StaticOrder S2; S2.init(MROWS, 1536, C.G, C.bid);
        RTAB_BUILD(S1);
        pg8::EpiProj E1{(pg8::bf16_t*)(C.ws + WS_PROJ), SUBSTRIDE, rtab, pmA, pmB, pmC, pmD, kmean, 0, 6, 1.0f};
        rtab += 1024;
        RTAB_BUILD(S2);
        pg8::EpiProj E2{(pg8::bf16_t*)(C.ws + WS_PROJ), SUBSTRIDE, rtab, pmA, pmB, pmC, pmD, kmean, 6, 2, 1.0f / 32.0f};
        pg8::Unit f2; const bool has2 = S2.next(0, f2);
        pg8::Unit f1; const bool has1 = S1.next(0, f1);
        if (has1 && has2) {
            const size_t tstep2 = (size_t)2 * pg8::HALF * DM * 2;
            pg8::gemm_phase<pg8::EpiProj, pg8::StaticOrder, true, true, false, false, true>((PG8_LAS unsigned char*)lds, g1, S1, E1, C.tid, (const char*)g2.A + (size_t)f2.pm * tstep2, (const char*)g2.Bt + (size_t)f2.pn * tstep2);
            C.tid = wave_s * 64 + lane_now();
            pg8::gemm_phase<pg8::EpiProj, pg8::StaticOrder, true, true, true, true, false>((PG8_LAS unsigned char*)lds, g2, S2, E2, C.tid);
        }
#undef RTAB_BUILD
    }
    else if constexpr (ST == 3) { phase_gate(C, L); phase_sgu(C, L); }
    else if constexpr (ST == 4) phase_attn(C, L);
    else if constexpr (ST == 5) phase_combine(C);
    else if constexpr (ST == 6) {
        pg8::Gemm g{(const pg8::bf16_t*)(C.ws + WS_MIX), (const pg8::bf16_t*)(C.ws + WS_WOUT) + (size_t)L * DM * DM, MROWS, DM, DM};
        pg8::StaticOrder S; S.init(MROWS, DM, C.G, C.bid);
        if (L == 0) { pg8::EpiRes E{(pg8::bf16_t*)(C.ws + WS_XB), (float*)(C.ws + WS_ROWSS), C.ws + WS_XB8};
            pg8::gemm_phase<pg8::EpiRes, pg8::StaticOrder, true, true>((PG8_LAS unsigned char*)lds, g, S, E, C.tid); }
        else { pg8::EpiFinal E{(const pg8::bf16_t*)(C.ws + WS_XB), C.out, C.final_g, (float*)(C.ws + WS_ROWSS), (unsigned*)(C.ws + WS_CTL) + 8192};
            pg8::gemm_phase<pg8::EpiFinal, pg8::StaticOrder, true, true>((PG8_LAS unsigned char*)lds, g, S, E, C.tid); }
    } else if constexpr (ST == 7) phase_check_inject(C);
    else if constexpr (ST == 8) phase_attn_simple(C, (bf16*)C.out);
    else if constexpr (ST == 9) {
        const bf16* A = (const bf16*)(C.ws + WS_MIX); const bf16* B = (const bf16*)C.out; unsigned* flag = (unsigned*)(C.ws + WS_CTL) + 32;
        float md = 0.f;
        for (size_t idx = (size_t)C.bid * 512 + C.tid; idx < (size_t)MROWS * 512; idx += (size_t)C.G * 512) {
            const size_t row = idx >> 9, col = 512 + (idx & 511);
            const float a = __uint_as_float((unsigned)A[row * 1024 + col] << 16), r = __uint_as_float((unsigned)B[row * 1024 + col] << 16);
            float sc = fabsf(r);
#pragma unroll
            for (int o = 1; o < 64; o <<= 1) sc = fmaxf(sc, lx_xor(sc, o));
            const float d = fabsf(a - r) / (0.02f + sc);
            md = (d > md || !(d == d)) ? (d == d ? d : 1e6f) : md;
        }
        atomicMax(flag, __float_as_uint(md));
    }
}
template <int SEL> __global__ void __launch_bounds__(NWAVES * 64, 2) fwd(Args args) {
    extern __shared__ __attribute__((aligned(16))) unsigned char lds[];
    const int wave_s = __builtin_amdgcn_readfirstlane((int)threadIdx.x >> 6);
    if constexpr (SEL >= 0) run_stage<SEL>(args, lds, args.layer, wave_s);
    else {
        if (args.pad == 0x7fffffff) cg::this_grid().sync();
        volatile LAS unsigned* bst = (volatile LAS unsigned*)((LAS unsigned char*)lds + LDS_BARST);
        if (threadIdx.x == 0) { bst[0] = 0u; bst[1] = 0u; }
        __syncthreads();
        XcdBarrier bar = xcd_barrier_post((unsigned*)(args.ws + WS_CTL) + CW_BAR, bst);
#define GRID_SYNC() do { XcdBarrier b2_ = bar; asm volatile("" : "+s"(b2_.bar), "+s"(b2_.x)); xcd_barrier(b2_, wave_s == 0 && lane_now() == 0); } while (0)
#define RUN(k, L) do { run_stage<k>(args, lds, L, wave_s); GRID_SYNC(); } while (0)
        RUN(0, 0);
        for (int L = 0; L < DEPTH; ++L) {
            RUN(1, L); RUN(3, L); RUN(4, L); RUN(5, L);
            if (L == DEPTH - 1) run_stage<6>(args, lds, L, wave_s); else RUN(6, L);
        }
    }
}

#ifndef MK_N_LAUNCHES
#define MK_N_LAUNCHES 1
#endif
template <int SEL> static void launch_stage(int grid, Args a, int layer, hipStream_t stream) {
    static bool attr = false;
    if (!attr) { (void)hipFuncSetAttribute((const void*)fwd<SEL>, hipFuncAttributeMaxDynamicSharedMemorySize, LDS_BYTES); attr = true; }
    a.layer = layer;
    hipLaunchKernelGGL(fwd<SEL>, dim3(grid), dim3(NWAVES * 64), LDS_BYTES, stream, a);
}
extern "C" void kernel_launch(void* const* d_in, const int* in_sizes, int n_in, void* d_out, int out_size, void* d_ws, size_t ws_size, hipStream_t stream) {
    static int grid = 0;
    if (grid == 0) {
        if (n_in != 10 || out_size != MROWS * DM || ws_size < WS_END) { fprintf(stderr, "kernel_launch: unexpected shapes (n_in %d out %d ws %zu)\n", n_in, out_size, ws_size); grid = -1; return; }
        int dev = 0, cus = 0;
        (void)hipGetDevice(&dev); (void)hipDeviceGetAttribute(&cus, hipDeviceAttributeMultiprocessorCount, dev);
        grid = cus;
        if (grid != 256) fprintf(stderr, "kernel_launch: %d CUs: the fused final-norm epilogue pairs the four column tiles of a row panel inside one round of a 256-workgroup grid\n", grid);
#if MK_N_LAUNCHES == 1
        int per_cu = 0;
        if (hipFuncSetAttribute((const void*)fwd<-1>, hipFuncAttributeMaxDynamicSharedMemorySize, LDS_BYTES) != hipSuccess) { fprintf(stderr, "kernel_launch: hipFuncSetAttribute failed\n"); grid = -1; return; }
        if (hipOccupancyMaxActiveBlocksPerMultiprocessor(&per_cu, (const void*)fwd<-1>, NWAVES * 64, LDS_BYTES) != hipSuccess || per_cu < 1) { fprintf(stderr, "kernel_launch: occupancy query says %d\n", per_cu); grid = -1; return; }
        (void)hipGetLastError();
#endif
    }
    if (grid < 0) return;
    (void)hipMemsetAsync((char*)d_ws + WS_CTL, 0, CTL_ZERO_BYTES, stream);
    Args a{};
    for (int i = 0; i < 10; ++i) a.in[i] = (const float*)d_in[i];
    a.out = (float*)d_out; a.ws = (unsigned char*)d_ws;
#if MK_N_LAUNCHES == 1
    void* kargs[] = {&a};
    hipError_t e = hipLaunchCooperativeKernel((const void*)fwd<-1>, dim3(grid), dim3(NWAVES * 64), kargs, LDS_BYTES, stream);
    if (e != hipSuccess) fprintf(stderr, "kernel_launch: cooperative launch failed: %s\n", hipGetErrorString(e));
#else
    launch_stage<0>(grid, a, 0, stream);
    for (int L = 0; L < DEPTH; ++L) {
        launch_stage<1>(grid, a, L, stream); launch_stage<3>(grid, a, L, stream);
        launch_stage<4>(grid, a, L, stream); launch_stage<5>(grid, a, L, stream);
        if (CHECK_ATTN && L == 0) { launch_stage<8>(grid, a, L, stream); launch_stage<9>(grid, a, L, stream); }
        launch_stage<6>(grid, a, L, stream);
    }
    if (CHECK_ATTN) launch_stage<7>(grid, a, 0, stream);
#endif
}
```

```cpp
#include <hip/hip_runtime.h>
#include <hip/hip_cooperative_groups.h>
#include <cstdio>
#include <cstdint>
namespace cg = cooperative_groups;

constexpr int BATCH = 2, SEQ = 16384, DM = 1024, MROWS = BATCH * SEQ, DIN = 3584, DSUB = 512;
constexpr int NH = 8, DH = 64, NBLK = SEQ / 256, NBH = BATCH * NH, DEPTH = 2;
constexpr float NORM_EPS = 1e-6f, LN_EPS = 1e-5f;
constexpr float LOG2E = 1.4426950408889634f;
#ifndef CHECK_ATTN
#define CHECK_ATTN 0
#endif
constexpr float QSCALE = 0.125f * LOG2E;
__device__ __forceinline__ int lx_lane() { int l; asm volatile("v_mbcnt_lo_u32_b32 %0, -1, 0\n\tv_mbcnt_hi_u32_b32 %0, -1, %0" : "=v"(l)); return l; }
__device__ __forceinline__ int lx_xor(int v, int m) { return __builtin_amdgcn_ds_bpermute((lx_lane() ^ m) << 2, v); }
__device__ __forceinline__ float lx_xor(float v, int m) { return __builtin_bit_cast(float, __builtin_amdgcn_ds_bpermute((lx_lane() ^ m) << 2, __builtin_bit_cast(int, v))); }
__device__ __forceinline__ int lx_up(int v, int d) { const int l = lx_lane(); return __builtin_amdgcn_ds_bpermute((l >= d ? l - d : l) << 2, v); }
namespace pg8 {
#define PG8_LAS __attribute__((address_space(3)))
typedef unsigned short bf16_t;
typedef short bf16x8 __attribute__((ext_vector_type(8)));
typedef float f32x4 __attribute__((ext_vector_type(4)));
typedef unsigned u32x4 __attribute__((ext_vector_type(4)));
typedef int pg8_v8i __attribute__((ext_vector_type(8)));
typedef int pg8_v4i __attribute__((ext_vector_type(4)));
constexpr int BM = 256, BK = 64, HALF = 128, HTB = HALF * BK * 2  , STAGE_BYTES = 8 * HTB, NXCD = 8, WGM = 8;

__host__ __device__ __forceinline__ int lds_byte(int r, int c) { const int st = (r >> 4) * 2 + (c >> 5), rr = r & 15, cc = c & 31, ob = rr * 64 + cc * 2; return st * 1024 + (ob ^ (((ob >> 9) & 1) << 5)); }
__host__ __device__ __forceinline__ void stage_rc(int b, int& R, int& C) { const int st = b / 1024, sb = b % 1024, swz = sb ^ (((sb >> 9) & 1) << 5); R = (st >> 1) * 16 + swz / 64; C = (st & 1) * 32 + (swz % 64) / 2; }
__host__ __device__ __forceinline__ int perm32(int rho) { const int n = rho >> 4, i = rho & 15; return 8 * (i >> 2) + 4 * n + (i & 3); }

struct Unit { int pm, pn; };
struct Gemm { const bf16_t* A; const bf16_t* Bt; int M, N, K; int kext = 0; };

struct StaticOrder {
    int nM, nN, nwg, G, c;
    __host__ __device__ void init(int M, int N, int G_, int c_) { nM = M / BM; nN = N / BM; nwg = nM * nN; G = G_; c = c_; }
    __host__ __device__ bool next(int i, Unit& u) const {
        const long L = (long)i * G + c; if (L >= nwg) return false;
        int wgid = (int)L; { const int q = nwg / NXCD, r = nwg % NXCD, xcd = wgid % NXCD, off = wgid / NXCD; wgid = (xcd < r ? xcd * (q + 1) : r * (q + 1) + (xcd - r) * q) + off; }
        const int nig = WGM * nN, gid = wgid / nig, fm = gid * WGM, gsz = (nM - fm) < WGM ? (nM - fm) : WGM;
        u.pm = fm + ((wgid % nig) % gsz); u.pn = (wgid % nig) / gsz; return true;
    }
    __device__ __forceinline__ void a_ready(const Unit&) const {}
    __device__ __forceinline__ void done(const Unit&) const {}
};

__device__ __forceinline__ unsigned cvt_pk_bf16(float lo, float hi) { unsigned r; asm volatile("v_cvt_pk_bf16_f32 %0, %1, %2" : "=v"(r) : "v"(lo), "v"(hi)); return r; }
typedef float f32x2 __attribute__((ext_vector_type(2)));
typedef float f32x2 __attribute__((ext_vector_type(2)));
__device__ __forceinline__ float act_gelu(float x) {
    const float u = x * (1.0f + 0.044715f * x * x);
    const float e = __builtin_amdgcn_exp2f(u * (-2.0f * 0.7978845608028654f * 1.4426950408889634f));
    return x * __builtin_amdgcn_rcpf(1.0f + e);
}
__device__ __forceinline__ float act_silu(float x) {
    const float e = __builtin_amdgcn_exp2f(x * (-1.4426950408889634f));
    return x * __builtin_amdgcn_rcpf(1.0f + e);
}
struct EpiProj {
    static constexpr bool PERM = true, AFTER_DRAIN = false;
    bf16_t* P; size_t sub_stride; const float* rstd_lds; int pm0, pm1, pm2, pm3; float* kmean; int pn_base, pn_hole; float oscale;
    __device__ __forceinline__ void operator()(const f32x4 (&acc)[2][2][4][2], const Unit& u, int wr, int wc, int fr, int fq) const {
        const int pnn = u.pn + pn_base + (u.pn >= pn_hole ? 2 : 0), t = pnn >> 1;
        bf16_t* base = P + (size_t)t * sub_stride;
        const int col0 = (pnn & 1) * 256 + wc * 32 + 8 * fq;
        const int row0 = u.pm * BM + wr * 64 + fr;
        const int slot = (u.pm == pm0) ? 0 : (u.pm == pm1) ? 1 : (u.pm == pm2) ? 2 : 3;
        const float* rt = rstd_lds + slot * 256 + wr * 64 + fr;
        const float qs = ((t == 3) ? (0.125f * 1.4426950408889634f) : 1.0f) * oscale;
        float ks[2][8];
#pragma unroll
        for (int bj = 0; bj < 2; ++bj)
#pragma unroll
            for (int e = 0; e < 8; ++e) ks[bj][e] = 0.f;
#pragma unroll
        for (int ai = 0; ai < 2; ++ai)
#pragma unroll
            for (int m = 0; m < 4; ++m) {
                const int row = row0 + ai * HALF + m * 16;
                const float rs = rt[ai * HALF + m * 16] * qs;
                bf16_t* rowp = base + (size_t)row * 512 + col0;
                if (t >= 5) {
                    int w8[2][2];
#pragma unroll
                    for (int bj = 0; bj < 2; ++bj) { const f32x4 v0 = acc[ai][bj][m][0] * rs, v1 = acc[ai][bj][m][1] * rs;
                        w8[bj][0] = __builtin_amdgcn_cvt_pk_fp8_f32(v0[0], v0[1], 0, false); w8[bj][0] = __builtin_amdgcn_cvt_pk_fp8_f32(v0[2], v0[3], w8[bj][0], true);
                        w8[bj][1] = __builtin_amdgcn_cvt_pk_fp8_f32(v1[0], v1[1], 0, false); w8[bj][1] = __builtin_amdgcn_cvt_pk_fp8_f32(v1[2], v1[3], w8[bj][1], true); }
                    auto r0 = __builtin_amdgcn_permlane16_swap((unsigned)w8[0][0], (unsigned)w8[1][0], false, false); auto r1 = __builtin_amdgcn_permlane16_swap((unsigned)w8[0][1], (unsigned)w8[1][1], false, false);
                    *(u32x4*)((unsigned char*)base + (size_t)row * 512 + col0 + ((fq & 1) ? HALF - 8 : 0)) = (u32x4){r0[0], r1[0], r0[1], r1[1]};
                    continue;
                }
#pragma unroll
                for (int bj = 0; bj < 2; ++bj) {
                    const f32x4 v0 = acc[ai][bj][m][0] * rs, v1 = acc[ai][bj][m][1] * rs;
                    if (t == 4) {
#pragma unroll
                        for (int e = 0; e < 4; ++e) { ks[bj][e] += v0[e]; ks[bj][4 + e] += v1[e]; }
                    }
                    u32x4 w; w.x = cvt_pk_bf16(v0[0], v0[1]); w.y = cvt_pk_bf16(v0[2], v0[3]); w.z = cvt_pk_bf16(v1[0], v1[1]); w.w = cvt_pk_bf16(v1[2], v1[3]);
                    *(u32x4*)(rowp + bj * HALF) = w;
                }
            }
        if (t == 4) {
            const int b = u.pm >> 6, n = u.pm & 63;
#pragma unroll
            for (int bj = 0; bj < 2; ++bj)
#pragma unroll
                for (int e = 0; e < 8; ++e) {
                    float v = ks[bj][e];
                    v += lx_xor(v, 1); v += lx_xor(v, 2); v += lx_xor(v, 4); v += lx_xor(v, 8);
                    if (fr == 0) { const int col = col0 + bj * HALF + e; atomicAdd(kmean + ((size_t)((b * 8 + (col >> 6)) * 64 + n)) * 64 + (col & 63), v * (1.0f / 256.0f)); }
                }
        }
    }
};
#define PG8_GAS __attribute__((address_space(1)))
struct EpiRes {
    static constexpr bool PERM = true, AFTER_DRAIN = false;
    bf16_t* xb; float* rowss; unsigned char* xb8;
    __device__ __forceinline__ void operator()(const f32x4 (&acc)[2][2][4][2], const Unit& u, int wr, int wc, int fr, int fq) const {
        const int col0 = u.pn * BM + wc * 32 + 8 * fq;
        PG8_GAS bf16_t* xbg = (PG8_GAS bf16_t*)xb; PG8_GAS float* rsg = (PG8_GAS float*)rowss;
        const unsigned ob = (unsigned)((u.pm * BM + wr * 64 + fr) * 1024 + col0) * 2u;
        u32x4 rr[2][4][2];
#pragma unroll
        for (int ai = 0; ai < 2; ++ai)
#pragma unroll
            for (int m = 0; m < 4; ++m)
#pragma unroll
                for (int bj = 0; bj < 2; ++bj) rr[ai][m][bj] = *(const PG8_GAS u32x4*)((const PG8_GAS char*)xbg + (ob + (unsigned)(((ai * HALF + m * 16) * 1024 + bj * HALF) * 2)));
#pragma unroll
        for (int ai = 0; ai < 2; ++ai)
#pragma unroll
            for (int m = 0; m < 4; ++m) {
                const int row = u.pm * BM + ai * HALF + wr * 64 + m * 16 + fr;
                float ss = 0.f; int w8[2][2];
#pragma unroll
                for (int bj = 0; bj < 2; ++bj) {
                    const u32x4 w0 = rr[ai][m][bj];
                    const f32x4 r0 = (f32x4){__uint_as_float(w0.x << 16), __uint_as_float(w0.x & 0xffff0000u), __uint_as_float(w0.y << 16), __uint_as_float(w0.y & 0xffff0000u)};
                    const f32x4 r1 = (f32x4){__uint_as_float(w0.z << 16), __uint_as_float(w0.z & 0xffff0000u), __uint_as_float(w0.w << 16), __uint_as_float(w0.w & 0xffff0000u)};
                    const f32x4 o0 = r0 + acc[ai][bj][m][0], o1 = r1 + acc[ai][bj][m][1];
                    ss += ((o0[0] * o0[0] + o0[1] * o0[1]) + (o0[2] * o0[2] + o0[3] * o0[3])) + ((o1[0] * o1[0] + o1[1] * o1[1]) + (o1[2] * o1[2] + o1[3] * o1[3]));
                    u32x4 w; w.x = cvt_pk_bf16(o0[0], o0[1]); w.y = cvt_pk_bf16(o0[2], o0[3]); w.z = cvt_pk_bf16(o1[0], o1[1]); w.w = cvt_pk_bf16(o1[2], o1[3]);
                    *(PG8_GAS u32x4*)((PG8_GAS char*)xbg + (ob + (unsigned)(((ai * HALF + m * 16) * 1024 + bj * HALF) * 2))) = w;
                    w8[bj][0] = __builtin_amdgcn_cvt_pk_fp8_f32(o0[0], o0[1], 0, false); w8[bj][0] = __builtin_amdgcn_cvt_pk_fp8_f32(o0[2], o0[3], w8[bj][0], true);
                    w8[bj][1] = __builtin_amdgcn_cvt_pk_fp8_f32(o1[0], o1[1], 0, false); w8[bj][1] = __builtin_amdgcn_cvt_pk_fp8_f32(o1[2], o1[3], w8[bj][1], true);
                }
                { auto r0 = __builtin_amdgcn_permlane16_swap((unsigned)w8[0][0], (unsigned)w8[1][0], false, false); auto r1 = __builtin_amdgcn_permlane16_swap((unsigned)w8[0][1], (unsigned)w8[1][1], false, false);
                  const unsigned o8 = (ob - (unsigned)col0) + (unsigned)((ai * HALF + m * 16) * 2048) + ((fq & 1) ? (unsigned)(HALF - 8) : 0u);
                  *(PG8_GAS u32x4*)((PG8_GAS unsigned char*)xb8 + o8) = (u32x4){r0[0], r1[0], r0[1], r1[1]}; }
                ss += lx_xor(ss, 16); ss += lx_xor(ss, 32);
                if (fq == 0) rsg[(size_t)row * 16 + u.pn * 4 + wc] = ss;
            }
    }
};
struct EpiFinal {
    static constexpr bool PERM = true, AFTER_DRAIN = false;
    const bf16_t* xb; float* out; const float* fg; float* slots; unsigned* cnt;
    __device__ __forceinline__ void operator()(f32x4 (&acc)[2][2][4][2], const Unit& u, int wr, int wc, int fr, int fq) const {
        const int col0 = u.pn * BM + wc * 32 + 8 * fq;
        const PG8_GAS bf16_t* xbg = (const PG8_GAS bf16_t*)xb; PG8_GAS float* outg = (PG8_GAS float*)out; const PG8_GAS float* slg = (const PG8_GAS float*)slots;
        const unsigned ob = (unsigned)((u.pm * BM + wr * 64 + fr) * 1024 + col0) * 2u;
        u32x4 rr[2][4][2];
#pragma unroll
        for (int ai = 0; ai < 2; ++ai)
#pragma unroll
            for (int m = 0; m < 4; ++m)
#pragma unroll
                for (int bj = 0; bj < 2; ++bj) rr[ai][m][bj] = *(const PG8_GAS u32x4*)((const PG8_GAS char*)xbg + (ob + (unsigned)(((ai * HALF + m * 16) * 1024 + bj * HALF) * 2)));
#pragma unroll
        for (int ai = 0; ai < 2; ++ai)
#pragma unroll
            for (int m = 0; m < 4; ++m) {
                const int row = u.pm * BM + ai * HALF + wr * 64 + m * 16 + fr;
                float ss = 0.f;
#pragma unroll
                for (int bj = 0; bj < 2; ++bj) {
                    const u32x4 w = rr[ai][m][bj];
                    const f32x4 r0 = (f32x4){__uint_as_float(w.x << 16), __uint_as_float(w.x & 0xffff0000u), __uint_as_float(w.y << 16), __uint_as_float(w.y & 0xffff0000u)};
                    const f32x4 r1 = (f32x4){__uint_as_float(w.z << 16), __uint_as_float(w.z & 0xffff0000u), __uint_as_float(w.w << 16), __uint_as_float(w.w & 0xffff0000u)};
                    const f32x4 o0 = r0 + acc[ai][bj][m][0], o1 = r1 + acc[ai][bj][m][1];
                    acc[ai][bj][m][0] = o0; acc[ai][bj][m][1] = o1;
                    ss += ((o0[0] * o0[0] + o0[1] * o0[1]) + (o0[2] * o0[2] + o0[3] * o0[3])) + ((o1[0] * o1[0] + o1[1] * o1[1]) + (o1[2] * o1[2] + o1[3] * o1[3]));
                }
                ss += lx_xor(ss, 16); ss += lx_xor(ss, 32);
                if (fq == 0) __hip_atomic_store(slots + (size_t)row * 16 + u.pn * 4 + wc, ss, __ATOMIC_RELAXED, __HIP_MEMORY_SCOPE_AGENT);
            }
        asm volatile("s_waitcnt vmcnt(0)" ::: "memory");
        unsigned* pc = cnt + 64 * u.pm;
        if (fr == 0 && fq == 0) __hip_atomic_fetch_add(pc, 1u, __ATOMIC_RELAXED, __HIP_MEMORY_SCOPE_AGENT);
        f32x4 g4[2][2];
#pragma unroll
        for (int bj = 0; bj < 2; ++bj)
#pragma unroll
            for (int n = 0; n < 2; ++n) g4[bj][n] = *(const PG8_GAS f32x4*)((const PG8_GAS float*)fg + col0 + bj * HALF + n * 4);
        for (unsigned spins = 0; spins < (1u << 22); ++spins) {
            if (__hip_atomic_load(pc, __ATOMIC_RELAXED, __HIP_MEMORY_SCOPE_AGENT) >= 32u) break;
            __builtin_amdgcn_s_sleep(2);
        }
        __builtin_amdgcn_fence(__ATOMIC_ACQUIRE, "agent");
        asm volatile("s_waitcnt vmcnt(0)" ::: "memory");
#pragma unroll
        for (int ai = 0; ai < 2; ++ai) {
            f32x4 sl[4][4];
#pragma unroll
            for (int m = 0; m < 4; ++m)
#pragma unroll
                for (int k = 0; k < 4; ++k) sl[m][k] = *(const PG8_GAS f32x4*)(slg + (size_t)(u.pm * BM + ai * HALF + wr * 64 + m * 16 + fr) * 16 + k * 4);
#pragma unroll
            for (int m = 0; m < 4; ++m) {
                const f32x4 s0 = sl[m][0], s1 = sl[m][1], s2 = sl[m][2], s3 = sl[m][3];
                const float tot = ((s0[0] + s0[1]) + (s0[2] + s0[3])) + ((s1[0] + s1[1]) + (s1[2] + s1[3])) + ((s2[0] + s2[1]) + (s2[2] + s2[3])) + ((s3[0] + s3[1]) + (s3[2] + s3[3]));
                const float rs = 1.0f / sqrtf(tot * (1.0f / 1024.0f) + 1e-6f);
#pragma unroll
                for (int bj = 0; bj < 2; ++bj)
#pragma unroll
                    for (int n = 0; n < 2; ++n) *(PG8_GAS f32x4*)((PG8_GAS char*)outg + (2u * ob + (unsigned)(((ai * HALF + m * 16) * 1024 + bj * HALF + n * 4) * 4))) = acc[ai][bj][m][n] * rs * g4[bj][n];
            }
        }
    }
};
template <class Epi, class Sched, bool ALIGN_EPI = false, bool SP2 = false, bool FP8 = false, bool CHAIN_IN = false, bool CHAIN_OUT = false>
__device__ __forceinline__ void gemm_phase(PG8_LAS unsigned char* lds, const Gemm g, const Sched& S, const Epi& E, const int tid, const char* chainA = nullptr, const char* chainB = nullptr) {
    static_assert(!(CHAIN_IN || CHAIN_OUT) || (SP2 && ALIGN_EPI), "chaining is written for the SP2 + ALIGN_EPI form");
    const int wid = __builtin_amdgcn_readfirstlane(tid >> 6), lane = tid & 63, wr = wid >> 2, wc = wid & 3, fr = lane & 15, fq = lane >> 4;
    const int K = g.K, nt = (g.kext ? g.kext : K) / BK;
    unsigned voffA[2], voffB[2];
#pragma unroll
    for (int i = 0; i < 2; ++i) { int R, C; stage_rc(tid * 16 + i * 8192, R, C); const int Rb = Epi::PERM ? ((R & ~31) + perm32(R & 31)) : R;
        voffA[i] = (unsigned)(R * K + C) * 2u; voffB[i] = (unsigned)(Rb * K + C) * 2u; }
    const size_t kstep = (size_t)(BK * 2);
    const size_t hstep = (size_t)HALF * K * 2;
    const size_t tstep = 2 * hstep;
    const unsigned ldsbase = (unsigned)(size_t)lds;
    const unsigned ldsw = (unsigned)wid * 1024u;
    const int aoff = lds_byte(wr * 64 + fr, fq * 8), boff = lds_byte(wc * 32 + fr, fq * 8);
#define PG8_SA(b, h) (((b) * 2 + (h)) * HTB)
#define PG8_SB(b, h) ((4 + (b) * 2 + (h)) * HTB)
#define PG8_GLDS(gbase_, voff_, ldsdst_) do { unsigned keep_; \
        asm volatile("s_mov_b32 %0, m0\n\ts_mov_b32 m0, %3\n\ts_nop 0\n\tglobal_load_lds_dwordx4 %1, %2\n\ts_mov_b32 m0, %0" : "=&s"(keep_) : "v"(voff_), "s"(gbase_), "s"(ldsdst_)); } while (0)
#define PG8_STAGE(bufoff, gbase, voff) do { _Pragma("unroll") for (int _i = 0; _i < 2; ++_i) { \
        if constexpr (FP8) PG8_GLDS((const char*)(gbase), (voff)[_i], (unsigned)__builtin_amdgcn_readfirstlane((int)(ldsbase + (unsigned)(bufoff) + ldsw + (unsigned)(_i * 8192)))); \
        else __builtin_amdgcn_global_load_lds((const unsigned*)((const char*)(gbase) + (voff)[_i]), (PG8_LAS unsigned*)(lds + (bufoff) + ldsw + _i * 8192), 16, 0, 0); } } while (0)
#define PG8_LD32(base_) __builtin_shufflevector(*(const PG8_LAS pg8_v4i*)(base_), *(const PG8_LAS pg8_v4i*)((base_) + 1024), 0, 1, 2, 3, 4, 5, 6, 7)
#define PG8_LDA(dst, b, h) do { if constexpr (FP8) { _Pragma("unroll") for (int m = 0; m < 4; ++m) dst##8[m] = PG8_LD32(lds + PG8_SA(b, h) + aoff + m * 2048); } \
        else { _Pragma("unroll") for (int m = 0; m < 4; ++m) _Pragma("unroll") for (int k = 0; k < 2; ++k) dst[m][k] = *(const PG8_LAS bf16x8*)(lds + PG8_SA(b, h) + aoff + m * 2048 + k * 1024); } } while (0)
#define PG8_LDB(dst, b, h) do { if constexpr (FP8) { _Pragma("unroll") for (int n = 0; n < 2; ++n) dst##8[n] = PG8_LD32(lds + PG8_SB(b, h) + boff + n * 2048); } \
        else { _Pragma("unroll") for (int n = 0; n < 2; ++n) _Pragma("unroll") for (int k = 0; k < 2; ++k) dst[n][k] = *(const PG8_LAS bf16x8*)(lds + PG8_SB(b, h) + boff + n * 2048 + k * 1024); } } while (0)
#define PG8_MMA(ai, bj, At, Bt) do { __builtin_amdgcn_s_setprio(1); \
        if constexpr (FP8) { _Pragma("unroll") for (int m = 0; m < 4; ++m) _Pragma("unroll") for (int n = 0; n < 2; ++n) \
            acc[ai][bj][m][n] = __builtin_amdgcn_mfma_scale_f32_16x16x128_f8f6f4(Bt##8[n], At##8[m], acc[ai][bj][m][n], 0, 0, 0, 0x7f7f7f7f, 0, 0x7f7f7f7f); } \
        else { _Pragma("unroll") for (int m = 0; m < 4; ++m) _Pragma("unroll") for (int n = 0; n < 2; ++n) _Pragma("unroll") for (int k = 0; k < 2; ++k) \
            acc[ai][bj][m][n] = __builtin_amdgcn_mfma_f32_16x16x32_bf16(Bt[n][k], At[m][k], acc[ai][bj][m][n], 0, 0, 0); } \
        __builtin_amdgcn_s_setprio(0); } while (0)
#define PG8_WAIT_V(n) asm volatile("s_waitcnt vmcnt(" #n ")" ::: "memory")
#define PG8_WAIT_L(n) asm volatile("s_waitcnt lgkmcnt(" #n ")" ::: "memory")
#define PG8_BAR __builtin_amdgcn_s_barrier()
#define PG8_SCHED __builtin_amdgcn_sched_barrier(0)
    Unit cur, nxt; int ui = 0;
    if (!S.next(0, cur)) return;
    f32x4 acc[2][2][4][2];
#pragma unroll
    for (int a = 0; a < 2; ++a)
#pragma unroll
        for (int b = 0; b < 2; ++b)
#pragma unroll
            for (int m = 0; m < 4; ++m)
#pragma unroll
                for (int n = 0; n < 2; ++n) acc[a][b][m][n] = (f32x4){0.f, 0.f, 0.f, 0.f};
    bf16x8 At[FP8 ? 1 : 4][2], B0[FP8 ? 1 : 2][2], B1[FP8 ? 1 : 2][2];
    pg8_v8i At8[FP8 ? 4 : 1], B08[FP8 ? 2 : 1], B18[FP8 ? 2 : 1];
    const char* cA = (const char*)g.A + (size_t)cur.pm * tstep; const char* cB = (const char*)g.Bt + (size_t)cur.pn * tstep;
    S.a_ready(cur);
    if constexpr (CHAIN_IN) { } else if constexpr (SP2) {
        PG8_STAGE(PG8_SB(0, 0), cB, voffB); PG8_STAGE(PG8_SB(0, 1), cB + hstep, voffB); PG8_STAGE(PG8_SA(0, 0), cA, voffA); PG8_STAGE(PG8_SA(0, 1), cA + hstep, voffA);
        if (wr == 1) PG8_BAR;
        PG8_WAIT_V(2); PG8_BAR;
        PG8_STAGE(PG8_SB(1, 0), cB + kstep, voffB); PG8_STAGE(PG8_SA(1, 0), cA + kstep, voffA); PG8_STAGE(PG8_SB(1, 1), cB + hstep + kstep, voffB);
        PG8_WAIT_V(6); PG8_BAR;
    } else {
        PG8_STAGE(PG8_SB(0, 0), cB, voffB); PG8_STAGE(PG8_SA(0, 0), cA, voffA); PG8_STAGE(PG8_SB(0, 1), cB + hstep, voffB); PG8_STAGE(PG8_SA(0, 1), cA + hstep, voffA);
        if (wr == 1) PG8_BAR;
        PG8_WAIT_V(4); PG8_BAR;
        PG8_STAGE(PG8_SB(1, 0), cB + kstep, voffB); PG8_STAGE(PG8_SA(1, 0), cA + kstep, voffA); PG8_STAGE(PG8_SB(1, 1), cB + hstep + kstep, voffB);
        PG8_WAIT_V(6); PG8_BAR;
    }
    for (;;) {
        const bool has_next = S.next(ui + 1, nxt);
        const char* nA = has_next ? (const char*)g.A + (size_t)nxt.pm * tstep : (CHAIN_OUT ? chainA : cA); const char* nB = has_next ? (const char*)g.Bt + (size_t)nxt.pn * tstep : (CHAIN_OUT ? chainB : cB);
#pragma unroll 1
        for (int t = 0; t < nt; t += 2) {
            const bool last = (t == nt - 2);
            const char* a1 = cA + (size_t)(t + 1) * kstep;
            const char* a2 = last ? nA : cA + (size_t)(t + 2) * kstep; const char* b2 = last ? nB : cB + (size_t)(t + 2) * kstep;
            const char* a3 = a2 + kstep; const char* b3 = b2 + kstep;
            if (last && has_next) S.a_ready(nxt);
            if constexpr (SP2) {
            PG8_LDB(B0, 0, 0); PG8_LDB(B1, 0, 1); PG8_SCHED; PG8_LDA(At, 0, 0); PG8_STAGE(PG8_SA(1, 1), a1 + hstep, voffA);
            PG8_WAIT_V(8); PG8_WAIT_L(0); PG8_BAR; PG8_MMA(0, 0, At, B0); PG8_MMA(0, 1, At, B1); PG8_BAR; PG8_SCHED;
            PG8_LDA(At, 0, 1); PG8_STAGE(PG8_SB(0, 0), b2, voffB); PG8_STAGE(PG8_SB(0, 1), b2 + hstep, voffB); PG8_STAGE(PG8_SA(0, 0), a2, voffA);
            PG8_WAIT_V(8); PG8_WAIT_L(0); PG8_BAR; PG8_MMA(1, 0, At, B0); PG8_MMA(1, 1, At, B1); PG8_BAR; PG8_SCHED;
            PG8_LDB(B0, 1, 0); PG8_LDB(B1, 1, 1); PG8_SCHED; PG8_LDA(At, 1, 0); PG8_STAGE(PG8_SA(0, 1), a2 + hstep, voffA);
            PG8_WAIT_V(8); PG8_WAIT_L(0); PG8_BAR; PG8_MMA(0, 0, At, B0); PG8_MMA(0, 1, At, B1); PG8_BAR; PG8_SCHED;
            PG8_LDA(At, 1, 1); PG8_STAGE(PG8_SB(1, 0), b3, voffB); PG8_STAGE(PG8_SB(1, 1), b3 + hstep, voffB); PG8_STAGE(PG8_SA(1, 0), a3, voffA);
            PG8_WAIT_V(8); PG8_WAIT_L(0); PG8_BAR; PG8_MMA(1, 0, At, B0); PG8_MMA(1, 1, At, B1); PG8_BAR; PG8_SCHED;
            } else {
            PG8_LDB(B0, 0, 0); PG8_SCHED; PG8_LDA(At, 0, 0); PG8_STAGE(PG8_SA(1, 1), a1 + hstep, voffA);
            PG8_WAIT_L(8); PG8_BAR; PG8_WAIT_L(0); PG8_MMA(0, 0, At, B0); PG8_BAR; PG8_SCHED;
            PG8_LDB(B1, 0, 1); PG8_STAGE(PG8_SB(0, 0), b2, voffB);
            PG8_BAR; PG8_WAIT_L(0); PG8_MMA(0, 1, At, B1); PG8_BAR;
            PG8_LDA(At, 0, 1); PG8_STAGE(PG8_SA(0, 0), a2, voffA);
            PG8_BAR; PG8_WAIT_L(0); PG8_MMA(1, 0, At, B0); PG8_BAR; PG8_SCHED;
            PG8_STAGE(PG8_SB(0, 1), b2 + hstep, voffB);
            PG8_WAIT_V(6); PG8_BAR; PG8_MMA(1, 1, At, B1); PG8_BAR;
            PG8_LDB(B0, 1, 0); PG8_SCHED; PG8_LDA(At, 1, 0); PG8_STAGE(PG8_SA(0, 1), a2 + hstep, voffA);
            PG8_WAIT_L(8); PG8_BAR; PG8_WAIT_L(0); PG8_MMA(0, 0, At, B0); PG8_BAR; PG8_SCHED;
            PG8_LDB(B1, 1, 1); PG8_STAGE(PG8_SB(1, 0), b3, voffB);
            PG8_BAR; PG8_WAIT_L(0); PG8_MMA(0, 1, At, B1); PG8_BAR;
            PG8_LDA(At, 1, 1); PG8_STAGE(PG8_SA(1, 0), a3, voffA);
            PG8_BAR; PG8_WAIT_L(0); PG8_MMA(1, 0, At, B0); PG8_BAR; PG8_SCHED;
            PG8_STAGE(PG8_SB(1, 1), b3 + hstep, voffB);
            PG8_WAIT_V(6); PG8_BAR; PG8_MMA(1, 1, At, B1); PG8_BAR;
            }
        }
        if constexpr (ALIGN_EPI) { if (wr == 0) PG8_BAR; }
        if constexpr (!Epi::AFTER_DRAIN) { int ln_; asm volatile("v_mbcnt_lo_u32_b32 %0, -1, 0\n\tv_mbcnt_hi_u32_b32 %0, -1, %0" : "=v"(ln_)); E(acc, cur, wr, wc, ln_ & 15, ln_ >> 4); S.done(cur); }
        if (!has_next) { if constexpr (CHAIN_OUT) { if (wr == 1) PG8_BAR; return; } break; }
#pragma unroll
        for (int a = 0; a < 2; ++a)
#pragma unroll
            for (int b = 0; b < 2; ++b)
#pragma unroll
                for (int m = 0; m < 4; ++m)
#pragma unroll
                    for (int n = 0; n < 2; ++n) acc[a][b][m][n] = (f32x4){0.f, 0.f, 0.f, 0.f};
        cur = nxt; cA = nA; cB = nB; ++ui;
        if constexpr (ALIGN_EPI) { if (wr == 1) PG8_BAR; }
    }
    PG8_WAIT_V(0);
    if constexpr (!ALIGN_EPI) { if (wr == 0) PG8_BAR; }
    PG8_BAR;
    if constexpr (Epi::AFTER_DRAIN) { E.fused(acc, cur, wr, wc, fr, fq, lds, wid, lane); S.done(cur); }
#undef PG8_SA
#undef PG8_SB
#undef PG8_STAGE
#undef PG8_GLDS
#undef PG8_LD32
#undef PG8_LDA
#undef PG8_LDB
#undef PG8_MMA
#undef PG8_WAIT_V
#undef PG8_WAIT_L
#undef PG8_BAR
#undef PG8_SCHED
}
}

constexpr size_t MiB = 1u << 20;
constexpr size_t WS_CTL = 0, CTL_ZERO_BYTES = 1 * MiB;
constexpr size_t WS_WIN = 2 * MiB;
constexpr size_t WS_WOUT = 16 * MiB;
constexpr size_t WS_WST = 20 * MiB;
constexpr size_t WS_BT = 21 * MiB;
constexpr size_t WS_KMEAN = 22 * MiB;
constexpr size_t WS_LOFF = 23 * MiB;
constexpr size_t WS_ROWSS = 24 * MiB;
constexpr size_t WS_PL = 26 * MiB;
constexpr size_t WS_LIST = 30 * MiB;
constexpr size_t WS_SEL = 32 * MiB;
constexpr size_t WS_XB8 = 104 * MiB;
constexpr size_t WS_WIN8 = 456 * MiB;
constexpr size_t WS_XB = 40 * MiB;
constexpr size_t WS_PROJ = 168 * MiB;
constexpr size_t WS_MIX = 392 * MiB;
constexpr size_t WS_END = 462 * MiB;
constexpr size_t SUBSTRIDE = (size_t)MROWS * 512;
enum { T_U = 0, T_V = 1, T_ZA = 2, T_Q = 3, T_K = 4, T_VV = 5, T_ZB = 6 };

constexpr int NWAVES = 8;
constexpr int LDS_BYTES = 160 * 1024;
constexpr int RING_BYTES = 131072;

#define LAS __attribute__((address_space(3)))
typedef unsigned short bf16;
typedef unsigned v4u __attribute__((ext_vector_type(4)));
typedef float f32x4 __attribute__((ext_vector_type(4)));
#define LDS_WAIT() asm volatile("s_waitcnt lgkmcnt(0)" ::: "memory")
typedef float f32x2c __attribute__((ext_vector_type(2)));
typedef __bf16 bf16x2c __attribute__((ext_vector_type(2)));
__device__ __forceinline__ unsigned pk2(float lo, float hi) { const f32x2c v = {lo, hi}; return __builtin_bit_cast(unsigned, __builtin_convertvector(v, bf16x2c)); }
__device__ __forceinline__ unsigned f2bf(float f) { return pk2(f, f) & 0xffffu; }
__device__ __forceinline__ f32x2c bfpair(unsigned w) { return (f32x2c){__builtin_bit_cast(float, w << 16), __builtin_bit_cast(float, w & 0xffff0000u)}; }
__device__ __forceinline__ unsigned pk2v(f32x2c v) { return __builtin_bit_cast(unsigned, __builtin_convertvector(v, bf16x2c)); }
__device__ __forceinline__ f32x2c exp2_pk(f32x2c v) { return (f32x2c){__builtin_amdgcn_exp2f(v.x), __builtin_amdgcn_exp2f(v.y)}; }
__device__ __forceinline__ f32x2c rcp_pk(f32x2c v) { return (f32x2c){__builtin_amdgcn_rcpf(v.x), __builtin_amdgcn_rcpf(v.y)}; }
__device__ __forceinline__ f32x2c gelu_pk(f32x2c x) {
    constexpr float K = -2.0f * 0.7978845608028654f * 1.4426950408889634f;
    const f32x2c e = exp2_pk(x * (x * x * (0.044715f * K) + K));
    return x * rcp_pk(e + 1.0f);
}
__device__ __forceinline__ f32x2c gelu_silu_pk(f32x2c u, f32x2c m, f32x2c z) {
    constexpr float K = -2.0f * 0.7978845608028654f * 1.4426950408889634f;
    const f32x2c eu = exp2_pk(u * (u * u * (0.044715f * K) + K)), ez = exp2_pk(z * (-1.4426950408889634f));
    return (u * z) * m * rcp_pk((eu + 1.0f) * (ez + 1.0f));
}
__device__ __forceinline__ unsigned pk4_fp8(float a, float b, float c, float d) { int w = __builtin_amdgcn_cvt_pk_fp8_f32(a, b, 0, false); w = __builtin_amdgcn_cvt_pk_fp8_f32(c, d, w, true); return (unsigned)w; }
__device__ __forceinline__ float bflo(unsigned w) { return __uint_as_float(w << 16); }
__device__ __forceinline__ float bfhi(unsigned w) { return __uint_as_float(w & 0xffff0000u); }
__device__ __forceinline__ float wave_sum(float v) {
#pragma unroll
    for (int o = 1; o < 64; o <<= 1) v += lx_xor(v, o);
    return v;
}

__device__ __forceinline__ int lane_now() { int l; asm volatile("v_mbcnt_lo_u32_b32 %0, -1, 0\n\tv_mbcnt_hi_u32_b32 %0, -1, %0" : "=v"(l)); return l; }
struct Args { const float* in[10]; float* out; unsigned char* ws; int layer, pad; };

struct Ctx {
    unsigned char* lds;
    int tid, lane, wave, G, bid;
    const float *x, *norm_g, *w_in, *ln_g, *ln_b, *sgu_w, *sgu_b, *w_out, *rel_bias, *final_g;
    float* out; unsigned char* ws;
};

__device__ __forceinline__ void p0_transpose_item(const float* W, const float* gs, int K, int N, bf16* WT, float* scr, int item, int lane, unsigned char* W8 = nullptr) {
    const int nblk = N / 32, kb = item / nblk, nb = item % nblk, k0 = 64 * kb, n0 = 32 * nb;
    float wv[32];
#pragma unroll
    for (int i = 0; i < 32; ++i) wv[i] = W[(size_t)(k0 + 2 * i + (lane >> 5)) * N + n0 + (lane & 31)];
#pragma unroll
    for (int i = 0; i < 32; ++i) { const int kk = 2 * i + (lane >> 5); const float sc = gs ? gs[k0 + kk] : 1.0f; scr[kk * 33 + (lane & 31)] = wv[i] * sc; }
    LDS_WAIT(); asm volatile("" ::: "memory");
    const int c = lane & 7;
#pragma unroll
    for (int j = 0; j < 4; ++j) { const int n = (lane >> 3) + 8 * j; const float* s = scr + (8 * c) * 33 + n;
        const bool f8 = W8 && ((n0 >= 1536 && n0 < 2048) || n0 >= 2560);
        if (f8) { typedef unsigned u32x2v __attribute__((ext_vector_type(2)));
            const int r8 = (n0 < 2048 ? n0 - 1536 : n0 - 2048) + n;
            *(u32x2v*)(W8 + (size_t)r8 * 2 * K + k0 + 8 * c) = (u32x2v){pk4_fp8(32.f * s[0 * 33], 32.f * s[1 * 33], 32.f * s[2 * 33], 32.f * s[3 * 33]), pk4_fp8(32.f * s[4 * 33], 32.f * s[5 * 33], 32.f * s[6 * 33], 32.f * s[7 * 33])}; }
        else { const int rb = ((W8 && n0 >= 2048) ? n0 - 512 : n0) + n;
            v4u o; o.x = pk2(s[0 * 33], s[1 * 33]); o.y = pk2(s[2 * 33], s[3 * 33]); o.z = pk2(s[4 * 33], s[5 * 33]); o.w = pk2(s[6 * 33], s[7 * 33]);
            *(v4u*)(WT + (size_t)rb * K + k0 + 8 * c) = o; } }
    LDS_WAIT(); asm volatile("" ::: "memory");
}
__device__ __forceinline__ int rel_bucket(int d) {
    if (d < 16) return d;
    int b = 16;
    b += (d >= 19); b += (d >= 21); b += (d >= 24); b += (d >= 27); b += (d >= 31); b += (d >= 35); b += (d >= 40); b += (d >= 46);
    b += (d >= 52); b += (d >= 59); b += (d >= 67); b += (d >= 77); b += (d >= 87); b += (d >= 99); b += (d >= 113);
    return b;
}
__device__ __forceinline__ void phase_prologue(const Ctx& C) {
    float* scr = (float*)(C.lds + C.wave * 16384);
    const int gw = C.bid * NWAVES + C.wave, NGW = C.G * NWAVES;
    constexpr int I_IN = (DM / 64) * (DIN / 32), I_OUT = (DM / 64) * (DM / 32);
    constexpr int NITEMS = DEPTH * (I_IN + I_OUT);
    for (int it = gw; it < NITEMS; it += NGW) {
        const int l = it / (I_IN + I_OUT); int r = it % (I_IN + I_OUT);
        if (r < I_IN) p0_transpose_item(C.w_in + (size_t)l * DM * DIN, C.norm_g + l * DM, DM, DIN, (bf16*)(C.ws + WS_WIN) + (size_t)l * DIN * DM, scr, r, C.lane, C.ws + WS_WIN8 + (size_t)l * 1536 * 2 * DM);
        else p0_transpose_item(C.w_out + (size_t)l * DM * DM, nullptr, DM, DM, (bf16*)(C.ws + WS_WOUT) + (size_t)l * DM * DM, scr, r - I_IN, C.lane);
    }
    { float* km = (float*)(C.ws + WS_KMEAN); for (int e = C.bid * 512 + C.tid; e < DEPTH * NBH * NBLK * 64; e += C.G * 512) km[e] = 0.f; }
    { bf16* wst = (bf16*)(C.ws + WS_WST); const int gt = C.bid * 512 + C.tid, NT = C.G * 512;
      for (int e = gt; e < DEPTH * 8 * 128 * 128; e += NT) { const int s = e & 127, t = (e >> 7) & 127; wst[e] = (s <= t) ? (bf16)f2bf(C.sgu_w[e]) : (bf16)0; } }
    if (C.bid == 0) { float* bt = (float*)(C.ws + WS_BT); for (int e = C.tid; e < 8 * 128; e += 512) { const int h = e >> 7, d = e & 127; bt[e] = C.rel_bias[rel_bucket(d) * 8 + h] * LOG2E; } }
    { bf16* xb = (bf16*)(C.ws + WS_XB); float* rowss = (float*)(C.ws + WS_ROWSS);
      constexpr int UN = 4;
      for (int m0 = gw; m0 < MROWS; m0 += NGW * UN) {
        f32x4 v[UN][4];
#pragma unroll
        for (int k = 0; k < UN; ++k) { const f32x4* xr = (const f32x4*)(C.x + (size_t)(m0 + k * NGW) * DM) + C.lane;
#pragma unroll
            for (int j = 0; j < 4; ++j) v[k][j] = xr[64 * j]; }
#pragma unroll
        for (int k = 0; k < UN; ++k) { const int m = m0 + k * NGW;
            float s = 0.f;
#pragma unroll
            for (int j = 0; j < 4; ++j) s += (v[k][j].x * v[k][j].x + v[k][j].y * v[k][j].y) + (v[k][j].z * v[k][j].z + v[k][j].w * v[k][j].w);
            s = wave_sum(s);
            unsigned long long* o8 = (unsigned long long*)(xb + (size_t)m * DM) + C.lane;
#pragma unroll
            for (int j = 0; j < 4; ++j) o8[64 * j] = (unsigned long long)pk2(v[k][j].x, v[k][j].y) | ((unsigned long long)pk2(v[k][j].z, v[k][j].w) << 32);
            { unsigned* sw = (unsigned*)scr + 256 * k;
#pragma unroll
              for (int j = 0; j < 4; ++j) sw[64 * j + C.lane] = pk4_fp8(v[k][j].x, v[k][j].y, v[k][j].z, v[k][j].w);
              LDS_WAIT(); asm volatile("" ::: "memory");
              *(v4u*)(C.ws + WS_XB8 + (size_t)m * 2048 + 16 * C.lane) = *(const v4u*)(sw + 4 * C.lane); }
            if (C.lane < 16) rowss[(size_t)m * 16 + C.lane] = (C.lane == 0) ? s : 0.f; }
      } }
}

typedef short bf16x8 __attribute__((ext_vector_type(8)));
typedef short bf16x4s __attribute__((ext_vector_type(4)));
typedef float f32x16 __attribute__((ext_vector_type(16)));
typedef int v8i_t __attribute__((ext_vector_type(8)));
__device__ __forceinline__ int at_vpos(int kv) { return (kv & ~63) + 32 * ((kv >> 2) & 1) + 16 * ((kv >> 5) & 1) + (kv & 3) + 4 * ((kv >> 3) & 3); }
__device__ __forceinline__ int crow(int r, int hi) { return (r & 3) + 8 * (r >> 2) + 4 * hi; }
__device__ __forceinline__ unsigned cvtpk(float lo, float hi) { unsigned r; asm volatile("v_cvt_pk_bf16_f32 %0, %1, %2" : "=v"(r) : "v"(lo), "v"(hi)); return r; }
__device__ __forceinline__ void phase_gate(const Ctx& C, int layer) {
    const bf16* Q = (const bf16*)(C.ws + WS_PROJ) + (size_t)T_Q * SUBSTRIDE;
    const float* KM = (const float*)(C.ws + WS_KMEAN) + (size_t)layer * NBH * NBLK * 64;
    int* SEL = (int*)(C.ws + WS_SEL); int* LOFF = (int*)(C.ws + WS_LOFF); unsigned short* LIST = (unsigned short*)(C.ws + WS_LIST);
    int* cnt = (int*)(C.lds);
    int* offs = (int*)(C.lds + 256);
    unsigned char* kml = C.lds + 1024;
    const int lane = C.lane, ql = lane & 31, hi = lane >> 5;
    bf16x8 qfN[4]; f32x4 kmr[2];
#define GATE_LOAD(uu) do { const int bh_ = (uu) / 63, i_ = (uu) % 63 + 1, b_ = bh_ >> 3, h_ = bh_ & 7; \
        const bf16* qrow_ = Q + ((size_t)(b_ * SEQ + i_ * 256 + C.wave * 32 + ql)) * 512 + h_ * 64 + hi * 8; \
        _Pragma("unroll") for (int ks = 0; ks < 4; ++ks) qfN[ks] = *(const bf16x8*)(qrow_ + ks * 16); \
        const float* kp_ = KM + (size_t)bh_ * NBLK * 64 + C.tid * 8; kmr[0] = *(const f32x4*)kp_; kmr[1] = *(const f32x4*)(kp_ + 4); } while (0)
#define GATE_KML() do { *(v4u*)(kml + (C.tid >> 3) * 144 + (C.tid & 7) * 16) = (v4u){cvtpk(kmr[0][0], kmr[0][1]), cvtpk(kmr[0][2], kmr[0][3]), cvtpk(kmr[1][0], kmr[1][1]), cvtpk(kmr[1][2], kmr[1][3])}; } while (0)
    int u = C.bid;
    if (C.tid < 64) cnt[C.tid] = 0;
    if (u < NBH * 63) { GATE_LOAD(u); GATE_KML(); }
    __syncthreads();
    for (; u < NBH * 63; u += C.G) {
        const int bh = u / 63, i = u % 63 + 1;
        const int q = C.wave * 32 + ql, pos = i * 256 + q;
        bf16x8 qf[4];
#pragma unroll
        for (int ks = 0; ks < 4; ++ks) qf[ks] = qfN[ks];
        const bool more = u + C.G < NBH * 63;
        if (more) GATE_LOAD(u + C.G);
        constexpr float NEGK = -3.0e38f;
        float b0 = NEGK, b1 = NEGK, b2 = NEGK;
        const unsigned hib = (unsigned)hi << 2;
#define TOP3_INS(key) do { const float k_ = (key); const float n0_ = fmaxf(b0, k_), n1_ = __builtin_amdgcn_fmed3f(b0, b1, k_), n2_ = __builtin_amdgcn_fmed3f(b1, b2, k_); b0 = n0_; b1 = n1_; b2 = n2_; } while (0)
#pragma unroll
        for (int nt = 0; nt < 2; ++nt) {
            f32x16 p = {};
#pragma unroll
            for (int ks = 0; ks < 4; ++ks) {
                const bf16x8 kw = *(const bf16x8*)(kml + (32 * nt + ql) * 144 + ks * 32 + hi * 16);
                p = __builtin_amdgcn_mfma_f32_32x32x16_bf16(kw, qf[ks], p, 0, 0, 0);
            }
#pragma unroll
            for (int r = 0; r < 16; ++r) { const unsigned n = (unsigned)(32 * nt + (r & 3) + 8 * (r >> 2)) | hib;
                const float key = __uint_as_float((__float_as_uint(p[r]) & ~63u) | n);
                TOP3_INS((int)n < i ? key : NEGK); }
        }
        { const float c0 = lx_xor(b0, 32), c1 = lx_xor(b1, 32), c2 = lx_xor(b2, 32);
          TOP3_INS(c0); TOP3_INS(c1); TOP3_INS(c2); }
#undef TOP3_INS
        const int i0 = (b0 > 0.5f * NEGK) ? (int)(__float_as_uint(b0) & 63u) : -1, i1 = (b1 > 0.5f * NEGK) ? (int)(__float_as_uint(b1) & 63u) : -1, i2 = (b2 > 0.5f * NEGK) ? (int)(__float_as_uint(b2) & 63u) : -1;
        int p0 = 0, p1 = 0, p2 = 0;
        if (hi == 0) {
            if (CHECK_ATTN) { int* sp = SEL + ((size_t)bh * SEQ + pos) * 4; sp[0] = i0; sp[1] = i1; sp[2] = i2; sp[3] = -1; }
            p0 = atomicAdd(&cnt[i0], 1);
            if (i1 >= 0) p1 = atomicAdd(&cnt[i1], 1);
            if (i2 >= 0) p2 = atomicAdd(&cnt[i2], 1);
        }
        __syncthreads();
        if (C.tid < 64) {
            const int c = cnt[C.tid]; cnt[C.tid] = 0;
            int inc = c;
#pragma unroll
            for (int o = 1; o < 64; o <<= 1) { const int t = lx_up(inc, o); if (C.tid >= o) inc += t; }
            offs[C.tid + 1] = inc; if (C.tid == 0) offs[0] = 0;
            LOFF[(size_t)(bh * NBLK + i) * 80 + C.tid + 1] = inc; if (C.tid == 0) LOFF[(size_t)(bh * NBLK + i) * 80] = 0;
        }
        if (more) GATE_KML();
        __syncthreads();
        if (hi == 0) {
            unsigned short* lp = LIST + (size_t)(bh * NBLK + i) * 768;
            lp[offs[i0] + p0] = (unsigned short)(q | (0 << 8));
            if (i1 >= 0) lp[offs[i1] + p1] = (unsigned short)(q | (1 << 8));
            if (i2 >= 0) lp[offs[i2] + p2] = (unsigned short)(q | (2 << 8));
        }
    }
#undef GATE_LOAD
#undef GATE_KML
    if (CHECK_ATTN) { for (int e = C.bid * 512 + C.tid; e < NBH * 256; e += C.G * 512) { const int bh = e >> 8, qq = e & 255; int* sp = SEL + ((size_t)bh * SEQ + qq) * 4; sp[0] = -1; sp[1] = -1; sp[2] = -1; sp[3] = -1; } }
    __syncthreads();
}

__device__ __forceinline__ void phase_attn_simple(const Ctx& C, bf16* MIX) {
    const bf16* Q = (const bf16*)(C.ws + WS_PROJ) + (size_t)T_Q * SUBSTRIDE;
    const bf16* K = (const bf16*)(C.ws + WS_PROJ) + (size_t)T_K * SUBSTRIDE;
    const bf16* VV = (const bf16*)(C.ws + WS_PROJ) + (size_t)T_VV * SUBSTRIDE;
    const bf16* ZB = (const bf16*)(C.ws + WS_PROJ) + (size_t)T_ZB * SUBSTRIDE;
    const int* SEL = (const int*)(C.ws + WS_SEL); const float* BT = (const float*)(C.ws + WS_BT);
    const int gt = C.bid * 512 + C.tid, NT = C.G * 512;
    for (int item = gt; item < NBH * SEQ; item += NT) {
        const int bh = item >> 14, pos = item & (SEQ - 1), b = bh >> 3, h = bh & 7, own = pos >> 8;
        const size_t rowq = (size_t)(b * SEQ + pos);
        float qv[64], o[64];
        { const v4u* qp = (const v4u*)(Q + rowq * 512 + h * 64);
#pragma unroll
          for (int c = 0; c < 8; ++c) { const v4u v = qp[c]; qv[8 * c + 0] = bflo(v.x); qv[8 * c + 1] = bfhi(v.x); qv[8 * c + 2] = bflo(v.y); qv[8 * c + 3] = bfhi(v.y);
              qv[8 * c + 4] = bflo(v.z); qv[8 * c + 5] = bfhi(v.z); qv[8 * c + 6] = bflo(v.w); qv[8 * c + 7] = bfhi(v.w); } }
#pragma unroll
        for (int d = 0; d < 64; ++d) o[d] = 0.f;
        float m = -INFINITY, l = 0.f;
        const float* bt = BT + h * 128;
        for (int slot = 0; slot < 4; ++slot) {
            int blk, klim;
            if (slot == 0) { blk = own; klim = (pos & 255) + 1; } else { blk = SEL[(size_t)item * 4 + slot - 1]; klim = 256; if (blk < 0) klim = 0; }
            for (int kl = 0; kl < klim; ++kl) {
                const int kpos = blk * 256 + kl;
                const v4u* kp = (const v4u*)(K + ((size_t)(b * SEQ + kpos)) * 512 + h * 64);
                float a0 = 0.f, a1 = 0.f;
#pragma unroll
                for (int c = 0; c < 8; ++c) { const v4u v = kp[c];
                    a0 += qv[8 * c + 0] * bflo(v.x) + qv[8 * c + 2] * bflo(v.y) + qv[8 * c + 4] * bflo(v.z) + qv[8 * c + 6] * bflo(v.w);
                    a1 += qv[8 * c + 1] * bfhi(v.x) + qv[8 * c + 3] * bfhi(v.y) + qv[8 * c + 5] * bfhi(v.z) + qv[8 * c + 7] * bfhi(v.w); }
                int dd = pos - kpos; dd = dd > 127 ? 127 : dd;
                const float s = (a0 + a1) + bt[dd];
                if (s > m) { const float al = __builtin_amdgcn_exp2f(m - s); l *= al;
#pragma unroll
                    for (int d = 0; d < 64; ++d) o[d] *= al;
                    m = s; }
                const float p = __builtin_amdgcn_exp2f(s - m);
                l += p;
                const v4u* vp = (const v4u*)(VV + ((size_t)(b * SEQ + kpos)) * 512 + h * 64);
#pragma unroll
                for (int c = 0; c < 8; ++c) { const v4u v = vp[c];
                    o[8 * c + 0] += p * bflo(v.x); o[8 * c + 1] += p * bfhi(v.x); o[8 * c + 2] += p * bflo(v.y); o[8 * c + 3] += p * bfhi(v.y);
                    o[8 * c + 4] += p * bflo(v.z); o[8 * c + 5] += p * bfhi(v.z); o[8 * c + 6] += p * bflo(v.w); o[8 * c + 7] += p * bfhi(v.w); }
            }
        }
        const float rl = 1.0f / l;
        const v4u* zp = (const v4u*)(ZB + rowq * 512 + h * 64);
        v4u* op = (v4u*)(MIX + rowq * 1024 + 512 + h * 64);
#pragma unroll
        for (int c = 0; c < 8; ++c) { const v4u z = zp[c]; v4u w;
            w.x = pk2(o[8 * c + 0] * rl * pg8::act_silu(bflo(z.x)), o[8 * c + 1] * rl * pg8::act_silu(bfhi(z.x))); w.y = pk2(o[8 * c + 2] * rl * pg8::act_silu(bflo(z.y)), o[8 * c + 3] * rl * pg8::act_silu(bfhi(z.y)));
            w.z = pk2(o[8 * c + 4] * rl * pg8::act_silu(bflo(z.z)), o[8 * c + 5] * rl * pg8::act_silu(bfhi(z.z))); w.w = pk2(o[8 * c + 6] * rl * pg8::act_silu(bflo(z.w)), o[8 * c + 7] * rl * pg8::act_silu(bfhi(z.w)));
            op[c] = w; }
    }
}

constexpr int AT_KS = 0, AT_KPITCH = 144;
constexpr int AT_VT = 36864, AT_VPITCH = 272;
constexpr int AT_DT = AT_VT + 64 * AT_VPITCH;
constexpr int AT_ENT = AT_DT + 4096, AT_CAP = 4096;
constexpr int AT_PRE = AT_ENT + AT_CAP * 4;
constexpr int AT_OST = AT_PRE + 1024;
constexpr int AT_MISC = AT_OST + 8 * 4096;
constexpr int AT_NUNITS = NBLK * NBH;

typedef int v4i_t __attribute__((ext_vector_type(4)));
#ifndef ATTN_STATIC_PRIO
#define ATTN_STATIC_PRIO 1
#endif
#if ATTN_STATIC_PRIO
#define ATTN_PRIO_UP
#define ATTN_PRIO_DN
#else
#define ATTN_PRIO_UP __builtin_amdgcn_s_setprio(1)
#define ATTN_PRIO_DN __builtin_amdgcn_s_setprio(0)
#endif
struct QTile { unsigned ent; v4i_t qf[4]; };
__device__ __forceinline__ void attn_issue_q(QTile& T, const Ctx& C, const unsigned char* lds, int b, int h, int e0, int cnt) {
    const bf16* Q = (const bf16*)(C.ws + WS_PROJ) + (size_t)T_Q * SUBSTRIDE;
    const unsigned* ENT = (const unsigned*)(lds + AT_ENT);
    const int q = C.lane & 31, hi = C.lane >> 5;
    T.ent = ENT[(e0 + q < cnt) ? (e0 + q) : e0];
    const bf16* qrow = Q + ((size_t)(b * SEQ + (int)(T.ent & 16383u))) * 512 + h * 64 + hi * 8;
    asm volatile("global_load_dwordx4 %0, %4, off\n\tglobal_load_dwordx4 %1, %4, off offset:32\n\tglobal_load_dwordx4 %2, %4, off offset:64\n\tglobal_load_dwordx4 %3, %4, off offset:96"
                 : "=&v"(T.qf[0]), "=&v"(T.qf[1]), "=&v"(T.qf[2]), "=&v"(T.qf[3]) : "v"(qrow));
}
__device__ __forceinline__ void attn_wait_q(QTile& T) { asm volatile("s_waitcnt vmcnt(0)" : "+v"(T.qf[0]), "+v"(T.qf[1]), "+v"(T.qf[2]), "+v"(T.qf[3])); }
__device__ __forceinline__ void attn_tile(const Ctx& C, unsigned char* lds, const QTile& T, QTile& Tn, int bh, int e0, int cnt, int nkt2, const bool OWN) {
    bf16* PO = (bf16*)C.out; float* PL = (float*)(C.ws + WS_PL);
    const unsigned* ENT = (const unsigned*)(lds + AT_ENT);
    const int lane = C.lane, q = lane & 31, hi = lane >> 5;
    const unsigned ent = T.ent;
    const int pos = ent & 16383, qoff = (ent >> 16) & 1023;
    f32x16 o0 = {}, o1 = {}, ol = {};
    v8i_t pa8 = {};
    asm volatile("" : "+v"(pa8));
    const bool anybias = OWN ? true : (__any(qoff < 112) != 0);
    const unsigned char* kbase = lds + AT_KS + q * AT_KPITCH + hi * 16;
    const unsigned char* vbase = lds + AT_VT + q * AT_VPITCH + hi * 32;
    const float* et0 = (const float*)(lds + AT_DT) + (1023 - (256 + (OWN ? 0 : 256) + qoff - 4 * hi));
    bf16x8 kf[8];
#pragma unroll
    for (int ks = 0; ks < 4; ++ks) { kf[2 * ks] = *(const bf16x8*)(kbase + ks * 32); kf[2 * ks + 1] = *(const bf16x8*)(kbase + 32 * AT_KPITCH + ks * 32); }
    for (int kt2 = 0; kt2 < nkt2; ++kt2) {
        f32x16 p0, p1;
        if (anybias && (OWN || kt2 >= 2)) {
            const float* et = et0 + 64 * kt2;
#pragma unroll
            for (int r = 0; r < 16; ++r) { p0[r] = et[(r & 3) + 8 * (r >> 2)]; p1[r] = et[32 + (r & 3) + 8 * (r >> 2)]; }
#pragma unroll
            for (int ks = 0; ks < 4; ++ks) {
                p0 = __builtin_amdgcn_mfma_f32_32x32x16_bf16(kf[2 * ks], __builtin_bit_cast(bf16x8, T.qf[ks]), p0, 0, 0, 0);
                p1 = __builtin_amdgcn_mfma_f32_32x32x16_bf16(kf[2 * ks + 1], __builtin_bit_cast(bf16x8, T.qf[ks]), p1, 0, 0, 0);
            }
        } else {
            p0 = (f32x16){}; p1 = (f32x16){};
#pragma unroll
            for (int ks = 0; ks < 4; ++ks) {
                p0 = __builtin_amdgcn_mfma_f32_32x32x16_bf16(kf[2 * ks], __builtin_bit_cast(bf16x8, T.qf[ks]), p0, 0, 0, 0);
                p1 = __builtin_amdgcn_mfma_f32_32x32x16_bf16(kf[2 * ks + 1], __builtin_bit_cast(bf16x8, T.qf[ks]), p1, 0, 0, 0);
            }
        }
        v8i_t vb0, vb1;
        { typedef int v4i_t __attribute__((ext_vector_type(4)));
          const v4i_t a0 = *(const v4i_t*)(vbase + 64 * kt2), a1 = *(const v4i_t*)(vbase + 64 * kt2 + 16);
          const v4i_t c0 = *(const v4i_t*)(vbase + 32 * AT_VPITCH + 64 * kt2), c1 = *(const v4i_t*)(vbase + 32 * AT_VPITCH + 64 * kt2 + 16);
          vb0 = __builtin_shufflevector(a0, a1, 0, 1, 2, 3, 4, 5, 6, 7); vb1 = __builtin_shufflevector(c0, c1, 0, 1, 2, 3, 4, 5, 6, 7); }
#pragma unroll
        for (int r = 0; r < 16; ++r) { p0[r] = __builtin_amdgcn_exp2f(p0[r]); p1[r] = __builtin_amdgcn_exp2f(p1[r]); }
        { typedef short v2s_t __attribute__((ext_vector_type(2)));
#pragma unroll
          for (int i = 0; i < 4; ++i) {
              v2s_t w = __builtin_bit_cast(v2s_t, pa8[i]);
              w = __builtin_amdgcn_cvt_scalef32_pk_fp8_f32(w, p0[4 * i], p0[4 * i + 1], 16.0f, false); w = __builtin_amdgcn_cvt_scalef32_pk_fp8_f32(w, p0[4 * i + 2], p0[4 * i + 3], 16.0f, true);
              pa8[i] = __builtin_bit_cast(int, w);
              v2s_t z = __builtin_bit_cast(v2s_t, pa8[4 + i]);
              z = __builtin_amdgcn_cvt_scalef32_pk_fp8_f32(z, p1[4 * i], p1[4 * i + 1], 16.0f, false); z = __builtin_amdgcn_cvt_scalef32_pk_fp8_f32(z, p1[4 * i + 2], p1[4 * i + 3], 16.0f, true);
              pa8[4 + i] = __builtin_bit_cast(int, z);
          } }
        if (kt2 + 1 < nkt2) {
#pragma unroll
            for (int ks = 0; ks < 4; ++ks) { kf[2 * ks] = *(const bf16x8*)(kbase + (64 * kt2 + 64) * AT_KPITCH + ks * 32); kf[2 * ks + 1] = *(const bf16x8*)(kbase + (64 * kt2 + 96) * AT_KPITCH + ks * 32); }
        }
        ATTN_PRIO_UP;
        o0 = __builtin_amdgcn_mfma_scale_f32_32x32x64_f8f6f4(vb0, pa8, o0, 0, 0, 0, 0x7f7f7f7f, 0, (int)0x83838383);
        o1 = __builtin_amdgcn_mfma_scale_f32_32x32x64_f8f6f4(vb1, pa8, o1, 0, 0, 0, 0x7f7f7f7f, 0, (int)0x83838383);
        v8i_t ones8;
#pragma unroll
        for (int i = 0; i < 8; ++i) { int c_; asm volatile("v_mov_b32 %0, 0x38383838" : "=v"(c_)); ones8[i] = c_; }
        ol = __builtin_amdgcn_mfma_scale_f32_32x32x64_f8f6f4(ones8, pa8, ol, 0, 0, 0, 0x7f7f7f7f, 0, (int)0x83838383);
        ATTN_PRIO_DN;
    }
    const float l = ol[0];
    attn_wait_q(Tn);
    if (e0 + q < cnt) PL[((size_t)bh * SEQ + pos) * 4 + ((ent >> 14) & 3)] = l;
    { bf16* prow = PO + (((size_t)bh * SEQ + pos) * 4 + ((ent >> 14) & 3)) * 64 + hi * 8;
      const bool live = e0 + q < cnt;
#pragma unroll
      for (int j = 0; j < 2; ++j) {
          unsigned a0 = pg8::cvt_pk_bf16(o0[8 * j], o0[8 * j + 1]), a1 = pg8::cvt_pk_bf16(o0[8 * j + 2], o0[8 * j + 3]), b0 = pg8::cvt_pk_bf16(o0[8 * j + 4], o0[8 * j + 5]), b1 = pg8::cvt_pk_bf16(o0[8 * j + 6], o0[8 * j + 7]);
          { auto r0 = __builtin_amdgcn_permlane32_swap(a0, b0, false, false); a0 = r0[0]; b0 = r0[1]; auto r1 = __builtin_amdgcn_permlane32_swap(a1, b1, false, false); a1 = r1[0]; b1 = r1[1]; }
          unsigned c0 = pg8::cvt_pk_bf16(o1[8 * j], o1[8 * j + 1]), c1 = pg8::cvt_pk_bf16(o1[8 * j + 2], o1[8 * j + 3]), d0 = pg8::cvt_pk_bf16(o1[8 * j + 4], o1[8 * j + 5]), d1 = pg8::cvt_pk_bf16(o1[8 * j + 6], o1[8 * j + 7]);
          { auto r0 = __builtin_amdgcn_permlane32_swap(c0, d0, false, false); c0 = r0[0]; d0 = r0[1]; auto r1 = __builtin_amdgcn_permlane32_swap(c1, d1, false, false); c1 = r1[0]; d1 = r1[1]; }
          if (live) { *(v4u*)(prow + 16 * j) = (v4u){a0, a1, b0, b1}; *(v4u*)(prow + 32 + 16 * j) = (v4u){c0, c1, d0, d1}; }
      } }
}

__device__ __forceinline__ void phase_attn(const Ctx& C, int layer) {
    if (ATTN_STATIC_PRIO && C.wave >= 4) __builtin_amdgcn_s_setprio(2);
    unsigned char* lds = C.lds;
    const bf16* K = (const bf16*)(C.ws + WS_PROJ) + (size_t)T_K * SUBSTRIDE;
    const bf16* VV = (const bf16*)(C.ws + WS_PROJ) + (size_t)T_VV * SUBSTRIDE;
    const int* LOFF = (const int*)(C.ws + WS_LOFF); const unsigned short* LIST = (const unsigned short*)(C.ws + WS_LIST);
    const float* BT = (const float*)(C.ws + WS_BT);
    const int qg = C.bid & 7;
    unsigned* ctr = (unsigned*)(C.ws + WS_CTL) + 64 + 64 * layer;
    int qstep = 0;
    unsigned* ENT = (unsigned*)(lds + AT_ENT);
    int* PRE = (int*)(lds + AT_PRE); int* LO = PRE + 68;
    volatile unsigned* MISC = (volatile unsigned*)(lds + AT_MISC);
    int tid = C.tid;
    v4u kpre[4], vpre[2]; int lpre0 = 0, lpre1 = 0;
#define AT_LOADKV(uu) do { const int bh_ = (uu) & 15, n_ = (uu) >> 4; \
        const bf16* Kg = K + ((size_t)((bh_ >> 3) * SEQ + n_ * 256)) * 512 + (bh_ & 7) * 64; const unsigned char* Vg = (const unsigned char*)VV + ((size_t)((bh_ >> 3) * SEQ + n_ * 256)) * 512 + (bh_ & 7) * 64; \
        _Pragma("unroll") for (int it = 0; it < 4; ++it) { const int idx = tid + 512 * it; kpre[it] = *(const v4u*)(Kg + (size_t)(idx >> 3) * 512 + (idx & 7) * 8); } \
        _Pragma("unroll") for (int it = 0; it < 2; ++it) { const int idx = tid + 512 * it; vpre[it] = *(const v4u*)(Vg + (size_t)(idx >> 2) * 512 + (idx & 3) * 16); }     \
        lpre0 = 0; lpre1 = 0; if (tid < 64 && n_ + 1 + tid < NBLK) { const int* lp_ = LOFF + ((size_t)(bh_ * NBLK + n_ + 1 + tid)) * 80 + n_; lpre0 = lp_[0]; lpre1 = lp_[1]; } } while (0)
#define AT_FETCH() ({ unsigned r_ = (unsigned)AT_NUNITS; while (qstep < 8) { const int g_ = (qg + qstep) & 7; const unsigned k_ = atomicAdd(ctr + 4 * g_, 1u); \
        if (k_ < 2u * NBLK) { r_ = (k_ >> 1) * 16 + 2 * g_ + (k_ & 1); break; } ++qstep; } r_; })
    if (tid == 0) MISC[0] = AT_FETCH();
    __syncthreads();
    int u = (int)MISC[0];
    if (u < AT_NUNITS) AT_LOADKV(u);
    while (u < AT_NUNITS) {
        asm volatile("" : "+v"(tid));
        Ctx Cu = C; Cu.tid = tid; Cu.lane = tid & 63;
        const int bh = u & 15, n = u >> 4, b = bh >> 3, h = bh & 7;
        if (tid == 0) MISC[1] = AT_FETCH();
#pragma unroll
        for (int it = 0; it < 4; ++it) { const int idx = tid + 512 * it;
            *(v4u*)(lds + AT_KS + (idx >> 3) * AT_KPITCH + (idx & 7) * 16) = kpre[it]; }
#pragma unroll
        for (int it = 0; it < 2; ++it) { const int idx = tid + 512 * it;
            const v4u v = vpre[it];
            unsigned char* vt = lds + AT_VT + (16 * (idx & 3)) * AT_VPITCH + at_vpos(idx >> 2);
            const unsigned w_[4] = {v.x, v.y, v.z, v.w};
#pragma unroll
            for (int e = 0; e < 16; ++e) vt[e * AT_VPITCH] = (unsigned char)(w_[e >> 2] >> (8 * (e & 3))); }
        { float* et_ = (float*)(lds + AT_DT);
#pragma unroll
          for (int k_ = 0; k_ < 2; ++k_) { const int j_ = tid + 512 * k_, d_ = j_ - 256; et_[1023 - j_] = d_ < 0 ? -INFINITY : (d_ < 128 ? BT[h * 128 + d_] - BT[h * 128 + 127] : 0.f);     } }
        if (tid < 64) {
            const int lo = lpre0; int inc = lpre1 - lpre0;
#pragma unroll
            for (int o = 1; o < 64; o <<= 1) { const int t = lx_up(inc, o); if (tid >= o) inc += t; }
            PRE[tid + 1] = inc; LO[tid] = lo; if (tid == 0) PRE[0] = 0;
        }
        __syncthreads();
        const int total = 256 + PRE[63 - n];
        const int unext = (int)MISC[1];
        if (unext < AT_NUNITS) AT_LOADKV(unext);
        for (int base = 0; base < total; base += AT_CAP) {
            const int cnt = (total - base < AT_CAP) ? (total - base) : AT_CAP;
            if (base == 0 && tid < 256) ENT[tid] = (unsigned)(n * 256 + tid) | (3u << 14) | ((unsigned)tid << 16);
            { const int e_lo = base > 256 ? base : 256, e_hi = base + cnt;
#pragma unroll 4
              for (int e = e_lo + tid; e < e_hi; e += 512) {
                  const int es = e - 256; int a = 0, z = 63 - n;
#pragma unroll
                  for (int it = 0; it < 6; ++it) { const int mid = (a + z) >> 1; const bool up = (z - a > 1) && (PRE[mid] <= es); const bool dn = (z - a > 1) && !up; a = up ? mid : a; z = dn ? mid : z; }
                  const int ii = a, i = n + 1 + ii;
                  const unsigned val = LIST[((size_t)(bh * NBLK + i)) * 768 + LO[ii] + (es - PRE[ii])]; const unsigned ql = val & 255u, j = val >> 8;
                  ENT[e - base] = (unsigned)(i * 256 + ql) | (j << 14) | ((ii == 0 ? ql : 400u) << 16);
              } }
            if (tid == 0) MISC[2] = 0u;
            __syncthreads();
            const int ntiles = (cnt + 31) >> 5;
            const int nown = (base == 0) ? 8 : 0;
#define AT_TICKET() ({ int tk_ = 0; if (Cu.lane == 0) tk_ = (int)atomicAdd((unsigned*)(lds + AT_MISC + 8), 1u); __builtin_amdgcn_readfirstlane(tk_); })
#define AT_TILEOF(tk_) (((tk_) < ntiles - nown) ? nown + (tk_) : (ntiles - 1 - (tk_)))
            { int tk = AT_TICKET();
              if (tk < ntiles) {
                  int tile = AT_TILEOF(tk);
                  QTile Tc; attn_issue_q(Tc, Cu, lds, b, h, tile * 32, cnt); attn_wait_q(Tc);
                  for (;;) {
                      const int tkn = AT_TICKET(); const bool more = tkn < ntiles; const int tilen = more ? AT_TILEOF(tkn) : 0;
                      QTile Tn; attn_issue_q(Tn, Cu, lds, b, h, tilen * 32, cnt);
                      { const bool own_ = tile < nown; attn_tile(Cu, lds, Tc, Tn, bh, tile * 32, cnt, own_ ? (tile >> 1) + 1 : 4, own_); }
                      if (!more) break;
                      Tc = Tn; tile = tilen;
                  }
              } }
#undef AT_TICKET
#undef AT_TILEOF
            __syncthreads();
        }
        u = unext;
    }
#undef AT_LOADKV
#undef AT_FETCH
    if (ATTN_STATIC_PRIO) __builtin_amdgcn_s_setprio(0);
}

__device__ __forceinline__ void phase_combine(const Ctx& C) {
    const bf16* PO = (const bf16*)C.out; const float* PL = (const float*)(C.ws + WS_PL);
    const bf16* ZB = (const bf16*)(C.ws + WS_PROJ) + (size_t)T_ZB * SUBSTRIDE;
    bf16* MIX = (bf16*)(C.ws + WS_MIX);
    const int gt = C.bid * 512 + C.tid, NT = C.G * 512;
    constexpr int UN = 4;
    for (int idx0 = gt; idx0 < MROWS * 64; idx0 += NT * UN) {
        typedef unsigned u32x2v __attribute__((ext_vector_type(2)));
        f32x4 lv[UN]; v4u pv[UN][4]; u32x2v zv[UN];
#pragma unroll
        for (int k = 0; k < UN; ++k) {
            const int idx = idx0 + k * NT;
            const int ch = idx & 7, h = (idx >> 3) & 7, row = idx >> 6, b = row >> 14, pos = row & (SEQ - 1), i = pos >> 8;
            const size_t pb = ((size_t)(b * NH + h) * SEQ + pos) * 4;
            lv[k] = *(const f32x4*)(PL + pb);
#pragma unroll
            for (int j = 0; j < 4; ++j) pv[k][j] = (j == 3 || j < i) ? *(const v4u*)(PO + (pb + j) * 64 + ch * 8) : (v4u){0u, 0u, 0u, 0u};
            zv[k] = *(const u32x2v*)((const unsigned char*)ZB + (size_t)row * 512 + h * 64 + ch * 8);
        }
#pragma unroll
        for (int k = 0; k < UN; ++k) {
            const int idx = idx0 + k * NT;
            const int ch = idx & 7, h = (idx >> 3) & 7, row = idx >> 6, pos = row & (SEQ - 1), i = pos >> 8;
            float L = lv[k][3];
#pragma unroll
            for (int j = 0; j < 3; ++j) L += (j < i) ? lv[k][j] : 0.f;
            float acc[8];
#pragma unroll
            for (int e = 0; e < 8; ++e) acc[e] = 0.f;
#pragma unroll
            for (int j = 0; j < 4; ++j) { const v4u v = pv[k][j];
                acc[0] += bflo(v.x); acc[1] += bfhi(v.x); acc[2] += bflo(v.y); acc[3] += bfhi(v.y); acc[4] += bflo(v.z); acc[5] += bfhi(v.z); acc[6] += bflo(v.w); acc[7] += bfhi(v.w); }
            const float rl = 1.0f / L;
            const u32x2v z = zv[k];
            const auto z01 = __builtin_amdgcn_cvt_pk_f32_fp8((int)z.x, false), z23 = __builtin_amdgcn_cvt_pk_f32_fp8((int)z.x, true), z45 = __builtin_amdgcn_cvt_pk_f32_fp8((int)z.y, false), z67 = __builtin_amdgcn_cvt_pk_f32_fp8((int)z.y, true);
            v4u w;
            w.x = pk2(acc[0] * rl * pg8::act_silu(z01[0]), acc[1] * rl * pg8::act_silu(z01[1])); w.y = pk2(acc[2] * rl * pg8::act_silu(z23[0]), acc[3] * rl * pg8::act_silu(z23[1]));
            w.z = pk2(acc[4] * rl * pg8::act_silu(z45[0]), acc[5] * rl * pg8::act_silu(z45[1])); w.w = pk2(acc[6] * rl * pg8::act_silu(z67[0]), acc[7] * rl * pg8::act_silu(z67[1]));
            *(v4u*)(MIX + (size_t)row * 1024 + 512 + h * 64 + ch * 8) = w;
        }
    }
}

constexpr int SG_VPITCH = 272, SG_MPITCH = 144, SG_WREG = 128 * SG_MPITCH;
constexpr int SG_STATS = 8 * SG_WREG;
constexpr int SG_MR = SG_STATS + 8192;
constexpr int SG_LN = SG_MR + 1024;
__device__ __forceinline__ void phase_sgu(const Ctx& C, int layer) {
    typedef float f32x2v __attribute__((ext_vector_type(2)));
    unsigned char* lds = C.lds;
    const bf16* U = (const bf16*)(C.ws + WS_PROJ) + (size_t)T_U * SUBSTRIDE;
    const bf16* V = (const bf16*)(C.ws + WS_PROJ) + (size_t)T_V * SUBSTRIDE;
    const bf16* ZA = (const bf16*)(C.ws + WS_PROJ) + (size_t)T_ZA * SUBSTRIDE;
    bf16* MIX = (bf16*)(C.ws + WS_MIX);
    const int g = C.wave; int lane = C.lane;
    const float* lng = C.ln_g + layer * 512 + g * 64; const float* lnb = C.ln_b + layer * 512 + g * 64;
    const bf16* Wg = (const bf16*)(C.ws + WS_WST) + ((size_t)(layer * 8 + g)) * 128 * 128;
    const float* bg = C.sgu_b + (layer * 8 + g) * 128;
    unsigned char* myreg = lds + g * SG_WREG;
    f32x2v* stats = (f32x2v*)(lds + SG_STATS); f32x2v* mr = (f32x2v*)(lds + SG_MR);
    float* lnl = (float*)(lds + SG_LN + g * 512);
    lnl[lane] = lng[lane]; lnl[64 + lane] = lnb[lane];
    for (int u = C.bid; u < MROWS / 128; u += C.G) {
        const size_t row0 = (size_t)u * 128;
        asm volatile("" : "+v"(lane));
        v4u xv[2][8];
#pragma unroll
        for (int rr = 0; rr < 2; ++rr) {
            const v4u* vp = (const v4u*)(V + (row0 + lane + 64 * rr) * 512 + g * 64);
#pragma unroll
            for (int c = 0; c < 8; ++c) xv[rr][c] = vp[c];
        }
#pragma unroll
        for (int rr = 0; rr < 2; ++rr) {
            float s1 = 0.f, s2 = 0.f;
#pragma unroll
            for (int c = 0; c < 8; ++c) { v4u v = xv[rr][c];
                v.x = pk2v(gelu_pk(bfpair(v.x))); v.y = pk2v(gelu_pk(bfpair(v.y))); v.z = pk2v(gelu_pk(bfpair(v.z))); v.w = pk2v(gelu_pk(bfpair(v.w))); xv[rr][c] = v;
                const float f0 = bflo(v.x), f1 = bfhi(v.x), f2 = bflo(v.y), f3 = bfhi(v.y), f4 = bflo(v.z), f5 = bfhi(v.z), f6 = bflo(v.w), f7 = bfhi(v.w);
                s1 += ((f0 + f1) + (f2 + f3)) + ((f4 + f5) + (f6 + f7));
                s2 += ((f0 * f0 + f1 * f1) + (f2 * f2 + f3 * f3)) + ((f4 * f4 + f5 * f5) + (f6 * f6 + f7 * f7)); }
            stats[g * 128 + lane + 64 * rr] = (f32x2v){s1, s2};
        }
        bf16x8 wf[4][8];
        { const bf16* wa = Wg + (size_t)(lane & 31) * 128 + (lane >> 5) * 8;
#pragma unroll
          for (int tt = 0; tt < 4; ++tt)
#pragma unroll
              for (int ks = 0; ks < 8; ++ks) if (tt >= (ks >> 1)) wf[tt][ks] = *(const bf16x8*)(wa + (size_t)tt * 32 * 128 + ks * 16); }
        __syncthreads();
        if (C.tid < 128) {
            float s1 = 0.f, s2 = 0.f;
#pragma unroll
            for (int w = 0; w < 8; ++w) { const f32x2v t = stats[w * 128 + C.tid]; s1 += t.x; s2 += t.y; }
            const float mean = s1 * (1.0f / 512.0f), var = s2 * (1.0f / 512.0f) - mean * mean;
            mr[C.tid] = (f32x2v){mean, 1.0f / sqrtf(var + LN_EPS)};
        }
        __syncthreads();
#pragma unroll
        for (int c = 0; c < 8; ++c) asm volatile("" : "+v"(xv[0][c]), "+v"(xv[1][c]));
        { const f32x2v m0 = mr[lane], m1 = mr[lane + 64];
          unsigned short* vt = (unsigned short*)(myreg + lane * 2);
#pragma unroll
          for (int c = 0; c < 8; ++c) {
              const v4u v0 = xv[0][c], v1 = xv[1][c];
              const float f0[8] = {bflo(v0.x), bfhi(v0.x), bflo(v0.y), bfhi(v0.y), bflo(v0.z), bfhi(v0.z), bflo(v0.w), bfhi(v0.w)};
              const float f1[8] = {bflo(v1.x), bfhi(v1.x), bflo(v1.y), bfhi(v1.y), bflo(v1.z), bfhi(v1.z), bflo(v1.w), bfhi(v1.w)};
#pragma unroll
              for (int e = 0; e < 8; ++e) { const int d = 8 * c + e; const float gg = lnl[d], bbv = lnl[64 + d];
                  vt[d * (SG_VPITCH / 2)] = (unsigned short)f2bf((f0[e] - m0.x) * m0.y * gg + bbv);
                  vt[d * (SG_VPITCH / 2) + 64] = (unsigned short)f2bf((f1[e] - m1.x) * m1.y * gg + bbv); }
              asm volatile("" ::: "memory");
          } }
        LDS_WAIT(); asm volatile("" ::: "memory");
        { const int q = lane & 31, hi = lane >> 5;
          unsigned pk[2][4][8];
#pragma unroll
          for (int dt = 0; dt < 2; ++dt) {
              const unsigned char* bb = myreg + (32 * dt + q) * SG_VPITCH + hi * 16;
              f32x16 acc[4];
#pragma unroll
              for (int tt = 0; tt < 4; ++tt) acc[tt] = (f32x16){};
#pragma unroll
              for (int ks = 0; ks < 8; ++ks) {
                  const bf16x8 b0 = *(const bf16x8*)(bb + ks * 32);
#pragma unroll
                  for (int tt = 0; tt < 4; ++tt) if (tt >= (ks >> 1)) acc[tt] = __builtin_amdgcn_mfma_f32_32x32x16_bf16(wf[tt][ks], b0, acc[tt], 0, 0, 0);
              }
#pragma unroll
              for (int tt = 0; tt < 4; ++tt)
#pragma unroll
                  for (int rp = 0; rp < 8; ++rp) pk[dt][tt][rp] = cvtpk(acc[tt][2 * rp], acc[tt][2 * rp + 1]);
          }
          LDS_WAIT(); asm volatile("" ::: "memory");
          unsigned char* mxb = myreg + (4 * hi) * SG_MPITCH + q * 2;
#pragma unroll
          for (int dt = 0; dt < 2; ++dt)
#pragma unroll
              for (int tt = 0; tt < 4; ++tt)
#pragma unroll
                  for (int r = 0; r < 16; ++r)
                      *(unsigned short*)(mxb + (32 * tt + (r & 3) + 8 * (r >> 2)) * SG_MPITCH + 64 * dt) = (unsigned short)((r & 1) ? (pk[dt][tt][r >> 1] >> 16) : (pk[dt][tt][r >> 1] & 0xffffu));
        }
        LDS_WAIT(); asm volatile("" ::: "memory");
        { const int ch = lane & 7, r8 = lane >> 3;
#pragma unroll 4
          for (int it = 0; it < 16; ++it) {
              const int t = it * 8 + r8;
              const v4u mv = *(const v4u*)(myreg + t * SG_MPITCH + ch * 16);
              const v4u uv = *(const v4u*)(U + (row0 + t) * 512 + g * 64 + ch * 8), zv = *(const v4u*)(ZA + (row0 + t) * 512 + g * 64 + ch * 8);
              const float bt = bg[t];
              v4u o;
#define SGU_Y(uw, mw, zw) pk2v(gelu_silu_pk(bfpair(uw), bfpair(mw) + bt, bfpair(zw)))
              o.x = SGU_Y(uv.x, mv.x, zv.x); o.y = SGU_Y(uv.y, mv.y, zv.y); o.z = SGU_Y(uv.z, mv.z, zv.z); o.w = SGU_Y(uv.w, mv.w, zv.w);
#undef SGU_Y
              *(v4u*)(MIX + (row0 + t) * 1024 + g * 64 + ch * 8) = o;
          } }
        __syncthreads();
    }
}

__device__ __forceinline__ void phase_check_inject(const Ctx& C) {
    if (C.bid == 0 && C.tid == 0) C.out[0] = __uint_as_float(((const unsigned*)(C.ws + WS_CTL))[32]) * 1e6f;
}

#define GAS __attribute__((address_space(1)))
typedef GAS unsigned gu32;
#define RLX_AGENT __ATOMIC_RELAXED, __HIP_MEMORY_SCOPE_AGENT
constexpr int CW_BAR = 4096;
constexpr int LDS_BARST = LDS_BYTES - 64;
#define XB_TMO      128
#define XB_XCNT(j)  (256  + 64 * (j))
#define XB_XSUB(j)  (1280 + 64 * (j))
#define XB_XGEN(j)  (2304 + 64 * (j))
#define XB_TOP      3328
#define XB_TOPGEN   3392
#define XCD_BAR_WORDS 3456
#define XB_SPIN_CAP (1u << 18)

__device__ __forceinline__ unsigned xb_ld(unsigned* p)              { return __hip_atomic_load(p, __ATOMIC_RELAXED, __HIP_MEMORY_SCOPE_AGENT); }
__device__ __forceinline__ unsigned xb_add(unsigned* p, unsigned v) { return __hip_atomic_fetch_add(p, v, __ATOMIC_RELAXED, __HIP_MEMORY_SCOPE_AGENT); }
__device__ __forceinline__ unsigned xb_xcc_id() { return (unsigned)__builtin_amdgcn_s_getreg((3 << 11) | 20) & 0xFu; }
#define XB_SPIN(cond, bar) do { unsigned _sp = 0; while (cond) { __builtin_amdgcn_s_sleep(1); \
    if ((++_sp & 255u) == 0u) { if (xb_ld(&(bar)[XB_TMO])) break; if (_sp > XB_SPIN_CAP) { atomicAdd(&(bar)[XB_TMO], 1u); break; } } } } while (0)

struct XcdBarrier {
    unsigned* bar; unsigned x;
    volatile LAS unsigned* st;
};

__device__ __forceinline__ XcdBarrier xcd_barrier_post(unsigned* bar, volatile LAS unsigned* st) {
    XcdBarrier b; b.bar = bar; b.x = xb_xcc_id(); b.st = st;
    if (threadIdx.x == 0) (void)xb_add(&bar[XB_XCNT(b.x)], 1u);
    return b;
}
__device__ __forceinline__ void xcd_barrier_complete(unsigned* bar, unsigned x, unsigned& nloc, unsigned& nx) {
    const unsigned G = gridDim.x * gridDim.y * gridDim.z;
    unsigned sum, cnt, mine, sp = 0u;
    for (;;) {
        sum = 0u; cnt = 0u; mine = 0u;
#pragma unroll
        for (unsigned j = 0; j < 16; ++j) { const unsigned c = xb_ld(&bar[XB_XCNT(j)]); sum += c; cnt += (c > 0u) ? 1u : 0u; mine = (j == x) ? c : mine; }
        if (sum == G) break;
        __builtin_amdgcn_s_sleep(1);
        if ((++sp & 255u) == 0u) { if (xb_ld(&bar[XB_TMO])) break; if (sp > XB_SPIN_CAP) { atomicAdd(&bar[XB_TMO], 1u); break; } }
    }
    nloc = mine > 0u ? mine : 1u; nx = cnt > 0u ? cnt : 1u;
}

__device__ __forceinline__ void xcd_barrier(const XcdBarrier& b, const bool leader_thread) {
    asm volatile("s_waitcnt vmcnt(0)" ::: "memory");
    __syncthreads();
    if (leader_thread) {
        unsigned* bar = b.bar;
        __builtin_amdgcn_s_waitcnt(0);
        unsigned nloc = b.st[0], nx = b.st[1];
        if (nloc == 0u) { xcd_barrier_complete(bar, b.x, nloc, nx); b.st[0] = nloc; b.st[1] = nx; }
        const unsigned old = xb_add(&bar[XB_XSUB(b.x)], 1u);
        const unsigned gen = old / nloc;
        if (old + 1u == (gen + 1u) * nloc) {
            __builtin_amdgcn_fence(__ATOMIC_RELEASE, "agent");
            asm volatile("s_waitcnt vmcnt(0)" ::: "memory");
            const unsigned og = xb_add(&bar[XB_TOP], 1u);
            const unsigned tg = og / nx;
            if (og + 1u == (tg + 1u) * nx) xb_add(&bar[XB_TOPGEN], 1u);
            else XB_SPIN(xb_ld(&bar[XB_TOPGEN]) == tg, bar);
            __builtin_amdgcn_fence(__ATOMIC_ACQUIRE, "agent");
            xb_add(&bar[XB_XGEN(b.x)], 1u);
            asm volatile("s_waitcnt vmcnt(0)" ::: "memory");
        } else {
            XB_SPIN(xb_ld(&bar[XB_XGEN(b.x)]) == gen, bar);
            __builtin_amdgcn_fence(__ATOMIC_ACQUIRE, "agent");
            asm volatile("s_waitcnt vmcnt(0)" ::: "memory");
        }
    }
    __syncthreads();
}

template <int ST> __device__ __forceinline__ void run_stage(const Args& args, unsigned char* lds, int Lr, int wave_s) {
    const int L = Lr;
    Ctx C;
    { int t = wave_s * 64 + lane_now(); C.tid = t; }
    C.lds = lds; C.lane = C.tid & 63; C.wave = __builtin_amdgcn_readfirstlane(C.tid >> 6); C.G = gridDim.x; C.bid = blockIdx.x;
    C.x = args.in[0]; C.norm_g = args.in[1]; C.w_in = args.in[2]; C.ln_g = args.in[3]; C.ln_b = args.in[4]; C.sgu_w = args.in[5]; C.sgu_b = args.in[6];
    C.w_out = args.in[7]; C.rel_bias = args.in[8]; C.final_g = args.in[9]; C.out = args.out; C.ws = args.ws;
    asm volatile("" : "+s"(C.ws), "+s"(C.out), "+s"(C.x), "+s"(C.sgu_b), "+s"(C.ln_g), "+s"(C.ln_b));
    if constexpr (ST == 0) phase_prologue(C);
    else if constexpr (ST == 1) {
        float* rtab = (float*)(lds + RING_BYTES);
        const float* rowss = (const float*)(C.ws + WS_ROWSS);
        float* kmean = (float*)(C.ws + WS_KMEAN) + (size_t)L * NBH * NBLK * 64;
#define RTAB_BUILD(S_) do { pmA = -1; pmB = -1; pmC = -1; pmD = -1; \
          { pg8::Unit uu; for (int i = 0; S_.next(i, uu); ++i) { const int pmu = uu.pm; \
              if (pmu == pmA || pmu == pmB || pmu == pmC || pmu == pmD) continue; \
              if (pmA < 0) pmA = pmu; else if (pmB < 0) pmB = pmu; else if (pmC < 0) pmC = pmu; else if (pmD < 0) pmD = pmu; } } \
          _Pragma("unroll") for (int k = 0; k < 2; ++k) { const int e = C.tid + 512 * k, sl = e >> 8, pmk = sl == 0 ? pmA : sl == 1 ? pmB : sl == 2 ? pmC : pmD; \
              if (pmk >= 0) { const f32x4* rp = (const f32x4*)(rowss + ((size_t)pmk * 256 + (e & 255)) * 16); const f32x4 s0 = rp[0], s1 = rp[1], s2 = rp[2], s3 = rp[3]; \
                  const float ss = ((s0[0] + s0[1]) + (s0[2] + s0[3])) + ((s1[0] + s1[1]) + (s1[2] + s1[3])) + ((s2[0] + s2[1]) + (s2[2] + s2[3])) + ((s3[0] + s3[1]) + (s3[2] + s3[3])); \
                  rtab[e] = 1.0f / sqrtf(ss * (1.0f / 1024.0f) + NORM_EPS); } } \
          __syncthreads(); } while (0)
        int pmA, pmB, pmC, pmD;
        pg8::Gemm g1{(const pg8::bf16_t*)(C.ws + WS_XB), (const pg8::bf16_t*)(C.ws + WS_WIN) + (size_t)L * DIN * DM, MROWS, 2048, DM};
        pg8::Gemm g2{(const pg8::bf16_t*)(C.ws + WS_XB8), (const pg8::bf16_t*)(C.ws + WS_WIN8 + (size_t)L * 1536 * 2 * DM), MROWS, 1536, DM, DM / 2};
        pg8::StaticOrder S1; S1.init(MROWS, 2048, C.G, C.bid);
        pg8::StaticOrder S2; S2.init(MROWS, 1536, C.G, C.bid);
        RTAB_BUILD(S1);
        pg8::EpiProj E1{(pg8::bf16_t*)(C.ws + WS_PROJ), SUBSTRIDE, rtab, pmA, pmB, pmC, pmD, kmean, 0, 6, 1.0f};
        rtab += 1024;
        RTAB_BUILD(S2);
        pg8::EpiProj E2{(pg8::bf16_t*)(C.ws + WS_PROJ), SUBSTRIDE, rtab, pmA, pmB, pmC, pmD, kmean, 6, 2, 1.0f / 32.0f};
        pg8::Unit f2; const bool has2 = S2.next(0, f2);
        pg8::Unit f1; const bool has1 = S1.next(0, f1);
        if (has1 && has2) {
            const size_t tstep2 = (size_t)2 * pg8::HALF * DM * 2;
            pg8::gemm_phase<pg8::EpiProj, pg8::StaticOrder, true, true, false, false, true>((PG8_LAS unsigned char*)lds, g1, S1, E1, C.tid, (const char*)g2.A + (size_t)f2.pm * tstep2, (const char*)g2.Bt + (size_t)f2.pn * tstep2);
            C.tid = wave_s * 64 + lane_now();
            pg8::gemm_phase<pg8::EpiProj, pg8::StaticOrder, true, true, true, true, false>((PG8_LAS unsigned char*)lds, g2, S2, E2, C.tid);
        }
#undef RTAB_BUILD
    }
    else if constexpr (ST == 3) { phase_gate(C, L); phase_sgu(C, L); }
    else if constexpr (ST == 4) phase_attn(C, L);
    else if constexpr (ST == 5) phase_combine(C);
    else if constexpr (ST == 6) {
        pg8::Gemm g{(const pg8::bf16_t*)(C.ws + WS_MIX), (const pg8::bf16_t*)(C.ws + WS_WOUT) + (size_t)L * DM * DM, MROWS, DM, DM};
        pg8::StaticOrder S; S.init(MROWS, DM, C.G, C.bid);
        if (L == 0) { pg8::EpiRes E{(pg8::bf16_t*)(C.ws + WS_XB), (float*)(C.ws + WS_ROWSS), C.ws + WS_XB8};
            pg8::gemm_phase<pg8::EpiRes, pg8::StaticOrder, true, true>((PG8_LAS unsigned char*)lds, g, S, E, C.tid); }
        else { pg8::EpiFinal E{(const pg8::bf16_t*)(C.ws + WS_XB), C.out, C.final_g, (float*)(C.ws + WS_ROWSS), (unsigned*)(C.ws + WS_CTL) + 8192};
            pg8::gemm_phase<pg8::EpiFinal, pg8::StaticOrder, true, true>((PG8_LAS unsigned char*)lds, g, S, E, C.tid); }
    } else if constexpr (ST == 7) phase_check_inject(C);
    else if constexpr (ST == 8) phase_attn_simple(C, (bf16*)C.out);
    else if constexpr (ST == 9) {
        const bf16* A = (const bf16*)(C.ws + WS_MIX); const bf16* B = (const bf16*)C.out; unsigned* flag = (unsigned*)(C.ws + WS_CTL) + 32;
        float md = 0.f;
        for (size_t idx = (size_t)C.bid * 512 + C.tid; idx < (size_t)MROWS * 512; idx += (size_t)C.G * 512) {
            const size_t row = idx >> 9, col = 512 + (idx & 511);
            const float a = __uint_as_float((unsigned)A[row * 1024 + col] << 16), r = __uint_as_float((unsigned)B[row * 1024 + col] << 16);
            float sc = fabsf(r);
#pragma unroll
            for (int o = 1; o < 64; o <<= 1) sc = fmaxf(sc, lx_xor(sc, o));
            const float d = fabsf(a - r) / (0.02f + sc);
            md = (d > md || !(d == d)) ? (d == d ? d : 1e6f) : md;
        }
        atomicMax(flag, __float_as_uint(md));
    }
}
template <int SEL> __global__ void __launch_bounds__(NWAVES * 64, 2) fwd(Args args) {
    extern __shared__ __attribute__((aligned(16))) unsigned char lds[];
    const int wave_s = __builtin_amdgcn_readfirstlane((int)threadIdx.x >> 6);
    if constexpr (SEL >= 0) run_stage<SEL>(args, lds, args.layer, wave_s);
    else {
        if (args.pad == 0x7fffffff) cg::this_grid().sync();
        volatile LAS unsigned* bst = (volatile LAS unsigned*)((LAS unsigned char*)lds + LDS_BARST);
        if (threadIdx.x == 0) { bst[0] = 0u; bst[1] = 0u; }
        __syncthreads();
        XcdBarrier bar = xcd_barrier_post((unsigned*)(args.ws + WS_CTL) + CW_BAR, bst);
#define GRID_SYNC() do { XcdBarrier b2_ = bar; asm volatile("" : "+s"(b2_.bar), "+s"(b2_.x)); xcd_barrier(b2_, wave_s == 0 && lane_now() == 0); } while (0)
#define RUN(k, L) do { run_stage<k>(args, lds, L, wave_s); GRID_SYNC(); } while (0)
        RUN(0, 0);
        for (int L = 0; L < DEPTH; ++L) {
            RUN(1, L); RUN(3, L); RUN(4, L); RUN(5, L);
            if (L == DEPTH - 1) run_stage<6>(args, lds, L, wave_s); else RUN(6, L);
        }
    }
}

#ifndef MK_N_LAUNCHES
#define MK_N_LAUNCHES 1
#endif
template <int SEL> static void launch_stage(int grid, Args a, int layer, hipStream_t stream) {
    static bool attr = false;
    if (!attr) { (void)hipFuncSetAttribute((const void*)fwd<SEL>, hipFuncAttributeMaxDynamicSharedMemorySize, LDS_BYTES); attr = true; }
    a.layer = layer;
    hipLaunchKernelGGL(fwd<SEL>, dim3(grid), dim3(NWAVES * 64), LDS_BYTES, stream, a);
}
extern "C" void kernel_launch(void* const* d_in, const int* in_sizes, int n_in, void* d_out, int out_size, void* d_ws, size_t ws_size, hipStream_t stream) {
    static int grid = 0;
    if (grid == 0) {
        if (n_in != 10 || out_size != MROWS * DM || ws_size < WS_END) { fprintf(stderr, "kernel_launch: unexpected shapes (n_in %d out %d ws %zu)\n", n_in, out_size, ws_size); grid = -1; return; }
        int dev = 0, cus = 0;
        (void)hipGetDevice(&dev); (void)hipDeviceGetAttribute(&cus, hipDeviceAttributeMultiprocessorCount, dev);
        grid = cus;
        if (grid != 256) fprintf(stderr, "kernel_launch: %d CUs: the fused final-norm epilogue pairs the four column tiles of a row panel inside one round of a 256-workgroup grid\n", grid);
#if MK_N_LAUNCHES == 1
        int per_cu = 0;
        if (hipFuncSetAttribute((const void*)fwd<-1>, hipFuncAttributeMaxDynamicSharedMemorySize, LDS_BYTES) != hipSuccess) { fprintf(stderr, "kernel_launch: hipFuncSetAttribute failed\n"); grid = -1; return; }
        if (hipOccupancyMaxActiveBlocksPerMultiprocessor(&per_cu, (const void*)fwd<-1>, NWAVES * 64, LDS_BYTES) != hipSuccess || per_cu < 1) { fprintf(stderr, "kernel_launch: occupancy query says %d\n", per_cu); grid = -1; return; }
        (void)hipGetLastError();
#endif
    }
    if (grid < 0) return;
    (void)hipMemsetAsync((char*)d_ws + WS_CTL, 0, CTL_ZERO_BYTES, stream);
    Args a{};
    for (int i = 0; i < 10; ++i) a.in[i] = (const float*)d_in[i];
    a.out = (float*)d_out; a.ws = (unsigned char*)d_ws;
#if MK_N_LAUNCHES == 1
    void* kargs[] = {&a};
    hipError_t e = hipLaunchCooperativeKernel((const void*)fwd<-1>, dim3(grid), dim3(NWAVES * 64), kargs, LDS_BYTES, stream);
    if (e != hipSuccess) fprintf(stderr, "kernel_launch: cooperative launch failed: %s\n", hipGetErrorString(e));
#else
    launch_stage<0>(grid, a, 0, stream);
    for (int L = 0; L < DEPTH; ++L) {
        launch_stage<1>(grid, a, L, stream); launch_stage<3>(grid, a, L, stream);
        launch_stage<4>(grid, a, L, stream); launch_stage<5>(grid, a, L, stream);
        if (CHECK_ATTN && L == 0) { launch_stage<8>(grid, a, L, stream); launch_stage<9>(grid, a, L, stream); }
        launch_stage<6>(grid, a, L, stream);
    }
    if (CHECK_ATTN) launch_stage<7>(grid, a, 0, stream);
#endif
}
```

```cpp
#include <hip/hip_runtime.h>
#include <hip/hip_cooperative_groups.h>
#include <cstdio>
#include <cstdint>
namespace cg = cooperative_groups;

constexpr int BATCH = 2, SEQ = 16384, DM = 1024, MROWS = BATCH * SEQ, DIN = 3584, DSUB = 512;
constexpr int NH = 8, DH = 64, NBLK = SEQ / 256, NBH = BATCH * NH, DEPTH = 2;
constexpr float NORM_EPS = 1e-6f, LN_EPS = 1e-5f;
constexpr float LOG2E = 1.4426950408889634f;
#ifndef CHECK_ATTN
#define CHECK_ATTN 0
#endif
constexpr float QSCALE = 0.125f * LOG2E;
__device__ __forceinline__ int lx_lane() { int l; asm volatile("v_mbcnt_lo_u32_b32 %0, -1, 0\n\tv_mbcnt_hi_u32_b32 %0, -1, %0" : "=v"(l)); return l; }
__device__ __forceinline__ int lx_xor(int v, int m) { return __builtin_amdgcn_ds_bpermute((lx_lane() ^ m) << 2, v); }
__device__ __forceinline__ float lx_xor(float v, int m) { return __builtin_bit_cast(float, __builtin_amdgcn_ds_bpermute((lx_lane() ^ m) << 2, __builtin_bit_cast(int, v))); }
__device__ __forceinline__ int lx_up(int v, int d) { const int l = lx_lane(); return __builtin_amdgcn_ds_bpermute((l >= d ? l - d : l) << 2, v); }
namespace pg8 {
#define PG8_LAS __attribute__((address_space(3)))
typedef unsigned short bf16_t;
typedef short bf16x8 __attribute__((ext_vector_type(8)));
typedef float f32x4 __attribute__((ext_vector_type(4)));
typedef unsigned u32x4 __attribute__((ext_vector_type(4)));
typedef int pg8_v8i __attribute__((ext_vector_type(8)));
typedef int pg8_v4i __attribute__((ext_vector_type(4)));
constexpr int BM = 256, BK = 64, HALF = 128, HTB = HALF * BK * 2  , STAGE_BYTES = 8 * HTB, NXCD = 8, WGM = 8;

__host__ __device__ __forceinline__ int lds_byte(int r, int c) { const int st = (r >> 4) * 2 + (c >> 5), rr = r & 15, cc = c & 31, ob = rr * 64 + cc * 2; return st * 1024 + (ob ^ (((ob >> 9) & 1) << 5)); }
__host__ __device__ __forceinline__ void stage_rc(int b, int& R, int& C) { const int st = b / 1024, sb = b % 1024, swz = sb ^ (((sb >> 9) & 1) << 5); R = (st >> 1) * 16 + swz / 64; C = (st & 1) * 32 + (swz % 64) / 2; }
__host__ __device__ __forceinline__ int perm32(int rho) { const int n = rho >> 4, i = rho & 15; return 8 * (i >> 2) + 4 * n + (i & 3); }

struct Unit { int pm, pn; };
struct Gemm { const bf16_t* A; const bf16_t* Bt; int M, N, K; int kext = 0; };

struct StaticOrder {
    int nM, nN, nwg, G, c;
    __host__ __device__ void init(int M, int N, int G_, int c_) { nM = M / BM; nN = N / BM; nwg = nM * nN; G = G_; c = c_; }
    __host__ __device__ bool next(int i, Unit& u) const {
        const long L = (long)i * G + c; if (L >= nwg) return false;
        int wgid = (int)L; { const int q = nwg / NXCD, r = nwg % NXCD, xcd = wgid % NXCD, off = wgid / NXCD; wgid = (xcd < r ? xcd * (q + 1) : r * (q + 1) + (xcd - r) * q) + off; }
        const int nig = WGM * nN, gid = wgid / nig, fm = gid * WGM, gsz = (nM - fm) < WGM ? (nM - fm) : WGM;
        u.pm = fm + ((wgid % nig) % gsz); u.pn = (wgid % nig) / gsz; return true;
    }
    __device__ __forceinline__ void a_ready(const Unit&) const {}
    __device__ __forceinline__ void done(const Unit&) const {}
};

__device__ __forceinline__ unsigned cvt_pk_bf16(float lo, float hi) { unsigned r; asm volatile("v_cvt_pk_bf16_f32 %0, %1, %2" : "=v"(r) : "v"(lo), "v"(hi)); return r; }
typedef float f32x2 __attribute__((ext_vector_type(2)));
typedef float f32x2 __attribute__((ext_vector_type(2)));
__device__ __forceinline__ float act_gelu(float x) {
    const float u = x * (1.0f + 0.044715f * x * x);
    const float e = __builtin_amdgcn_exp2f(u * (-2.0f * 0.7978845608028654f * 1.4426950408889634f));
    return x * __builtin_amdgcn_rcpf(1.0f + e);
}
__device__ __forceinline__ float act_silu(float x) {
    const float e = __builtin_amdgcn_exp2f(x * (-1.4426950408889634f));
    return x * __builtin_amdgcn_rcpf(1.0f + e);
}
struct EpiProj {
    static constexpr bool PERM = true, AFTER_DRAIN = false;
    bf16_t* P; size_t sub_stride; const float* rstd_lds; int pm0, pm1, pm2, pm3; float* kmean; int pn_base, pn_hole; float oscale;
    __device__ __forceinline__ void operator()(const f32x4 (&acc)[2][2][4][2], const Unit& u, int wr, int wc, int fr, int fq) const {
        const int pnn = u.pn + pn_base + (u.pn >= pn_hole ? 2 : 0), t = pnn >> 1;
        bf16_t* base = P + (size_t)t * sub_stride;
        const int col0 = (pnn & 1) * 256 + wc * 32 + 8 * fq;
        const int row0 = u.pm * BM + wr * 64 + fr;
        const int slot = (u.pm == pm0) ? 0 : (u.pm == pm1) ? 1 : (u.pm == pm2) ? 2 : 3;
        const float* rt = rstd_lds + slot * 256 + wr * 64 + fr;
        const float qs = ((t == 3) ? (0.125f * 1.4426950408889634f) : 1.0f) * oscale;
        float ks[2][8];
#pragma unroll
        for (int bj = 0; bj < 2; ++bj)
#pragma unroll
            for (int e = 0; e < 8; ++e) ks[bj][e] = 0.f;
#pragma unroll
        for (int ai = 0; ai < 2; ++ai)
#pragma unroll
            for (int m = 0; m < 4; ++m) {
                const int row = row0 + ai * HALF + m * 16;
                const float rs = rt[ai * HALF + m * 16] * qs;
                bf16_t* rowp = base + (size_t)row * 512 + col0;
                if (t >= 5) {
                    int w8[2][2];
#pragma unroll
                    for (int bj = 0; bj < 2; ++bj) { const f32x4 v0 = acc[ai][bj][m][0] * rs, v1 = acc[ai][bj][m][1] * rs;
                        w8[bj][0] = __builtin_amdgcn_cvt_pk_fp8_f32(v0[0], v0[1], 0, false); w8[bj][0] = __builtin_amdgcn_cvt_pk_fp8_f32(v0[2], v0[3], w8[bj][0], true);
                        w8[bj][1] = __builtin_amdgcn_cvt_pk_fp8_f32(v1[0], v1[1], 0, false); w8[bj][1] = __builtin_amdgcn_cvt_pk_fp8_f32(v1[2], v1[3], w8[bj][1], true); }
                    auto r0 = __builtin_amdgcn_permlane16_swap((unsigned)w8[0][0], (unsigned)w8[1][0], false, false); auto r1 = __builtin_amdgcn_permlane16_swap((unsigned)w8[0][1], (unsigned)w8[1][1], false, false);
                    *(u32x4*)((unsigned char*)base + (size_t)row * 512 + col0 + ((fq & 1) ? HALF - 8 : 0)) = (u32x4){r0[0], r1[0], r0[1], r1[1]};
                    continue;
                }
#pragma unroll
                for (int bj = 0; bj < 2; ++bj) {
                    const f32x4 v0 = acc[ai][bj][m][0] * rs, v1 = acc[ai][bj][m][1] * rs;
                    if (t == 4) {
#pragma unroll
                        for (int e = 0; e < 4; ++e) { ks[bj][e] += v0[e]; ks[bj][4 + e] += v1[e]; }
                    }
                    u32x4 w; w.x = cvt_pk_bf16(v0[0], v0[1]); w.y = cvt_pk_bf16(v0[2], v0[3]); w.z = cvt_pk_bf16(v1[0], v1[1]); w.w = cvt_pk_bf16(v1[2], v1[3]);
                    *(u32x4*)(rowp + bj * HALF) = w;
                }
            }
        if (t == 4) {
            const int b = u.pm >> 6, n = u.pm & 63;
#pragma unroll
            for (int bj = 0; bj < 2; ++bj)
#pragma unroll
                for (int e = 0; e < 8; ++e) {
                    float v = ks[bj][e];
                    v += lx_xor(v, 1); v += lx_xor(v, 2); v += lx_xor(v, 4); v += lx_xor(v, 8);
                    if (fr == 0) { const int col = col0 + bj * HALF + e; atomicAdd(kmean + ((size_t)((b * 8 + (col >> 6)) * 64 + n)) * 64 + (col & 63), v * (1.0f / 256.0f)); }
                }
        }
    }
};
#define PG8_GAS __attribute__((address_space(1)))
struct EpiRes {
    static constexpr bool PERM = true, AFTER_DRAIN = false;
    bf16_t* xb; float* rowss; unsigned char* xb8;
    __device__ __forceinline__ void operator()(const f32x4 (&acc)[2][2][4][2], const Unit& u, int wr, int wc, int fr, int fq) const {
        const int col0 = u.pn * BM + wc * 32 + 8 * fq;
        PG8_GAS bf16_t* xbg = (PG8_GAS bf16_t*)xb; PG8_GAS float* rsg = (PG8_GAS float*)rowss;
        const unsigned ob = (unsigned)((u.pm * BM + wr * 64 + fr) * 1024 + col0) * 2u;
        u32x4 rr[2][4][2];
#pragma unroll
        for (int ai = 0; ai < 2; ++ai)
#pragma unroll
            for (int m = 0; m < 4; ++m)
#pragma unroll
                for (int bj = 0; bj < 2; ++bj) rr[ai][m][bj] = *(const PG8_GAS u32x4*)((const PG8_GAS char*)xbg + (ob + (unsigned)(((ai * HALF + m * 16) * 1024 + bj * HALF) * 2)));
#pragma unroll
        for (int ai = 0; ai < 2; ++ai)
#pragma unroll
            for (int m = 0; m < 4; ++m) {
                const int row = u.pm * BM + ai * HALF + wr * 64 + m * 16 + fr;
                float ss = 0.f; int w8[2][2];
#pragma unroll
                for (int bj = 0; bj < 2; ++bj) {
                    const u32x4 w0 = rr[ai][m][bj];
                    const f32x4 r0 = (f32x4){__uint_as_float(w0.x << 16), __uint_as_float(w0.x & 0xffff0000u), __uint_as_float(w0.y << 16), __uint_as_float(w0.y & 0xffff0000u)};
                    const f32x4 r1 = (f32x4){__uint_as_float(w0.z << 16), __uint_as_float(w0.z & 0xffff0000u), __uint_as_float(w0.w << 16), __uint_as_float(w0.w & 0xffff0000u)};
                    const f32x4 o0 = r0 + acc[ai][bj][m][0], o1 = r1 + acc[ai][bj][m][1];
                    ss += ((o0[0] * o0[0] + o0[1] * o0[1]) + (o0[2] * o0[2] + o0[3] * o0[3])) + ((o1[0] * o1[0] + o1[1] * o1[1]) + (o1[2] * o1[2] + o1[3] * o1[3]));
                    u32x4 w; w.x = cvt_pk_bf16(o0[0], o0[1]); w.y = cvt_pk_bf16(o0[2], o0[3]); w.z = cvt_pk_bf16(o1[0], o1[1]); w.w = cvt_pk_bf16(o1[2], o1[3]);
                    *(PG8_GAS u32x4*)((PG8_GAS char*)xbg + (ob + (unsigned)(((ai * HALF + m * 16) * 1024 + bj * HALF) * 2))) = w;
                    w8[bj][0] = __builtin_amdgcn_cvt_pk_fp8_f32(o0[0], o0[1], 0, false); w8[bj][0] = __builtin_amdgcn_cvt_pk_fp8_f32(o0[2], o0[3], w8[bj][0], true);
                    w8[bj][1] = __builtin_amdgcn_cvt_pk_fp8_f32(o1[0], o1[1], 0, false); w8[bj][1] = __builtin_amdgcn_cvt_pk_fp8_f32(o1[2], o1[3], w8[bj][1], true);
                }
                { auto r0 = __builtin_amdgcn_permlane16_swap((unsigned)w8[0][0], (unsigned)w8[1][0], false, false); auto r1 = __builtin_amdgcn_permlane16_swap((unsigned)w8[0][1], (unsigned)w8[1][1], false, false);
                  const unsigned o8 = (ob - (unsigned)col0) + (unsigned)((ai * HALF + m * 16) * 2048) + ((fq & 1) ? (unsigned)(HALF - 8) : 0u);
                  *(PG8_GAS u32x4*)((PG8_GAS unsigned char*)xb8 + o8) = (u32x4){r0[0], r1[0], r0[1], r1[1]}; }
                ss += lx_xor(ss, 16); ss += lx_xor(ss, 32);
                if (fq == 0) rsg[(size_t)row * 16 + u.pn * 4 + wc] = ss;
            }
    }
};
struct EpiFinal {
    static constexpr bool PERM = true, AFTER_DRAIN = false;
    const bf16_t* xb; float* out; const float* fg; float* slots; unsigned* cnt;
    __device__ __forceinline__ void operator()(f32x4 (&acc)[2][2][4][2], const Unit& u, int wr, int wc, int fr, int fq) const {
        const int col0 = u.pn * BM + wc * 32 + 8 * fq;
        const PG8_GAS bf16_t* xbg = (const PG8_GAS bf16_t*)xb; PG8_GAS float* outg = (PG8_GAS float*)out; const PG8_GAS float* slg = (const PG8_GAS float*)slots;
        const unsigned ob = (unsigned)((u.pm * BM + wr * 64 + fr) * 1024 + col0) * 2u;
        u32x4 rr[2][4][2];
#pragma unroll
        for (int ai = 0; ai < 2; ++ai)
#pragma unroll
            for (int m = 0; m < 4; ++m)
#pragma unroll
                for (int bj = 0; bj < 2; ++bj) rr[ai][m][bj] = *(const PG8_GAS u32x4*)((const PG8_GAS char*)xbg + (ob + (unsigned)(((ai * HALF + m * 16) * 1024 + bj * HALF) * 2)));
#pragma unroll
        for (int ai = 0; ai < 2; ++ai)
#pragma unroll
            for (int m = 0; m < 4; ++m) {
                const int row = u.pm * BM + ai * HALF + wr * 64 + m * 16 + fr;
                float ss = 0.f;
#pragma unroll
                for (int bj = 0; bj < 2; ++bj) {
                    const u32x4 w = rr[ai][m][bj];
                    const f32x4 r0 = (f32x4){__uint_as_float(w.x << 16), __uint_as_float(w.x & 0xffff0000u), __uint_as_float(w.y << 16), __uint_as_float(w.y & 0xffff0000u)};
                    const f32x4 r1 = (f32x4){__uint_as_float(w.z << 16), __uint_as_float(w.z & 0xffff0000u), __uint_as_float(w.w << 16), __uint_as_float(w.w & 0xffff0000u)};
                    const f32x4 o0 = r0 + acc[ai][bj][m][0], o1 = r1 + acc[ai][bj][m][1];
                    acc[ai][bj][m][0] = o0; acc[ai][bj][m][1] = o1;
                    ss += ((o0[0] * o0[0] + o0[1] * o0[1]) + (o0[2] * o0[2] + o0[3] * o0[3])) + ((o1[0] * o1[0] + o1[1] * o1[1]) + (o1[2] * o1[2] + o1[3] * o1[3]));
                }
                ss += lx_xor(ss, 16); ss += lx_xor(ss, 32);
                if (fq == 0) __hip_atomic_store(slots + (size_t)row * 16 + u.pn * 4 + wc, ss, __ATOMIC_RELAXED, __HIP_MEMORY_SCOPE_AGENT);
            }
        asm volatile("s_waitcnt vmcnt(0)" ::: "memory");
        unsigned* pc = cnt + 64 * u.pm;
        if (fr == 0 && fq == 0) __hip_atomic_fetch_add(pc, 1u, __ATOMIC_RELAXED, __HIP_MEMORY_SCOPE_AGENT);
        f32x4 g4[2][2];
#pragma unroll
        for (int bj = 0; bj < 2; ++bj)
#pragma unroll
            for (int n = 0; n < 2; ++n) g4[bj][n] = *(const PG8_GAS f32x4*)((const PG8_GAS float*)fg + col0 + bj * HALF + n * 4);
        for (unsigned spins = 0; spins < (1u << 22); ++spins) {
            if (__hip_atomic_load(pc, __ATOMIC_RELAXED, __HIP_MEMORY_SCOPE_AGENT) >= 32u) break;
            __builtin_amdgcn_s_sleep(2);
        }
        __builtin_amdgcn_fence(__ATOMIC_ACQUIRE, "agent");
        asm volatile("s_waitcnt vmcnt(0)" ::: "memory");
#pragma unroll
        for (int ai = 0; ai < 2; ++ai) {
            f32x4 sl[4][4];
#pragma unroll
            for (int m = 0; m < 4; ++m)
#pragma unroll
                for (int k = 0; k < 4; ++k) sl[m][k] = *(const PG8_GAS f32x4*)(slg + (size_t)(u.pm * BM + ai * HALF + wr * 64 + m * 16 + fr) * 16 + k * 4);
#pragma unroll
            for (int m = 0; m < 4; ++m) {
                const f32x4 s0 = sl[m][0], s1 = sl[m][1], s2 = sl[m][2], s3 = sl[m][3];
                const float tot = ((s0[0] + s0[1]) + (s0[2] + s0[3])) + ((s1[0] + s1[1]) + (s1[2] + s1[3])) + ((s2[0] + s2[1]) + (s2[2] + s2[3])) + ((s3[0] + s3[1]) + (s3[2] + s3[3]));
                const float rs = 1.0f / sqrtf(tot * (1.0f / 1024.0f) + 1e-6f);
#pragma unroll
                for (int bj = 0; bj < 2; ++bj)
#pragma unroll
                    for (int n = 0; n < 2; ++n) *(PG8_GAS f32x4*)((PG8_GAS char*)outg + (2u * ob + (unsigned)(((ai * HALF + m * 16) * 1024 + bj * HALF + n * 4) * 4))) = acc[ai][bj][m][n] * rs * g4[bj][n];
            }
        }
    }
};
template <class Epi, class Sched, bool ALIGN_EPI = false, bool SP2 = false, bool FP8 = false, bool CHAIN_IN = false, bool CHAIN_OUT = false>
__device__ __forceinline__ void gemm_phase(PG8_LAS unsigned char* lds, const Gemm g, const Sched& S, const Epi& E, const int tid, const char* chainA = nullptr, const char* chainB = nullptr) {
    static_assert(!(CHAIN_IN || CHAIN_OUT) || (SP2 && ALIGN_EPI), "chaining is written for the SP2 + ALIGN_EPI form");
    const int wid = __builtin_amdgcn_readfirstlane(tid >> 6), lane = tid & 63, wr = wid >> 2, wc = wid & 3, fr = lane & 15, fq = lane >> 4;
    const int K = g.K, nt = (g.kext ? g.kext : K) / BK;
    unsigned voffA[2], voffB[2];
#pragma unroll
    for (int i = 0; i < 2; ++i) { int R, C; stage_rc(tid * 16 + i * 8192, R, C); const int Rb = Epi::PERM ? ((R & ~31) + perm32(R & 31)) : R;
        voffA[i] = (unsigned)(R * K + C) * 2u; voffB[i] = (unsigned)(Rb * K + C) * 2u; }
    const size_t kstep = (size_t)(BK * 2);
    const size_t hstep = (size_t)HALF * K * 2;
    const size_t tstep = 2 * hstep;
    const unsigned ldsbase = (unsigned)(size_t)lds;
    const unsigned ldsw = (unsigned)wid * 1024u;
    const int aoff = lds_byte(wr * 64 + fr, fq * 8), boff = lds_byte(wc * 32 + fr, fq * 8);
#define PG8_SA(b, h) (((b) * 2 + (h)) * HTB)
#define PG8_SB(b, h) ((4 + (b) * 2 + (h)) * HTB)
#define PG8_GLDS(gbase_, voff_, ldsdst_) do { unsigned keep_; \
        asm volatile("s_mov_b32 %0, m0\n\ts_mov_b32 m0, %3\n\ts_nop 0\n\tglobal_load_lds_dwordx4 %1, %2\n\ts_mov_b32 m0, %0" : "=&s"(keep_) : "v"(voff_), "s"(gbase_), "s"(ldsdst_)); } while (0)
#define PG8_STAGE(bufoff, gbase, voff) do { _Pragma("unroll") for (int _i = 0; _i < 2; ++_i) { \
        if constexpr (FP8) PG8_GLDS((const char*)(gbase), (voff)[_i], (unsigned)__builtin_amdgcn_readfirstlane((int)(ldsbase + (unsigned)(bufoff) + ldsw + (unsigned)(_i * 8192)))); \
        else __builtin_amdgcn_global_load_lds((const unsigned*)((const char*)(gbase) + (voff)[_i]), (PG8_LAS unsigned*)(lds + (bufoff) + ldsw + _i * 8192), 16, 0, 0); } } while (0)
#define PG8_LD32(base_) __builtin_shufflevector(*(const PG8_LAS pg8_v4i*)(base_), *(const PG8_LAS pg8_v4i*)((base_) + 1024), 0, 1, 2, 3, 4, 5, 6, 7)
#define PG8_LDA(dst, b, h) do { if constexpr (FP8) { _Pragma("unroll") for (int m = 0; m < 4; ++m) dst##8[m] = PG8_LD32(lds + PG8_SA(b, h) + aoff + m * 2048); } \
        else { _Pragma("unroll") for (int m = 0; m < 4; ++m) _Pragma("unroll") for (int k = 0; k < 2; ++k) dst[m][k] = *(const PG8_LAS bf16x8*)(lds + PG8_SA(b, h) + aoff + m * 2048 + k * 1024); } } while (0)
#define PG8_LDB(dst, b, h) do { if constexpr (FP8) { _Pragma("unroll") for (int n = 0; n < 2; ++n) dst##8[n] = PG8_LD32(lds + PG8_SB(b, h) + boff + n * 2048); } \
        else { _Pragma("unroll") for (int n = 0; n < 2; ++n) _Pragma("unroll") for (int k = 0; k < 2; ++k) dst[n][k] = *(const PG8_LAS bf16x8*)(lds + PG8_SB(b, h) + boff + n * 2048 + k * 1024); } } while (0)
#define PG8_MMA(ai, bj, At, Bt) do { __builtin_amdgcn_s_setprio(1); \
        if constexpr (FP8) { _Pragma("unroll") for (int m = 0; m < 4; ++m) _Pragma("unroll") for (int n = 0; n < 2; ++n) \
            acc[ai][bj][m][n] = __builtin_amdgcn_mfma_scale_f32_16x16x128_f8f6f4(Bt##8[n], At##8[m], acc[ai][bj][m][n], 0, 0, 0, 0x7f7f7f7f, 0, 0x7f7f7f7f); } \
        else { _Pragma("unroll") for (int m = 0; m < 4; ++m) _Pragma("unroll") for (int n = 0; n < 2; ++n) _Pragma("unroll") for (int k = 0; k < 2; ++k) \
            acc[ai][bj][m][n] = __builtin_amdgcn_mfma_f32_16x16x32_bf16(Bt[n][k], At[m][k], acc[ai][bj][m][n], 0, 0, 0); } \
        __builtin_amdgcn_s_setprio(0); } while (0)
#define PG8_WAIT_V(n) asm volatile("s_waitcnt vmcnt(" #n ")" ::: "memory")
#define PG8_WAIT_L(n) asm volatile("s_waitcnt lgkmcnt(" #n ")" ::: "memory")
#define PG8_BAR __builtin_amdgcn_s_barrier()
#define PG8_SCHED __builtin_amdgcn_sched_barrier(0)
    Unit cur, nxt; int ui = 0;
    if (!S.next(0, cur)) return;
    f32x4 acc[2][2][4][2];
#pragma unroll
    for (int a = 0; a < 2; ++a)
#pragma unroll
        for (int b = 0; b < 2; ++b)
#pragma unroll
            for (int m = 0; m < 4; ++m)
#pragma unroll
                for (int n = 0; n < 2; ++n) acc[a][b][m][n] = (f32x4){0.f, 0.f, 0.f, 0.f};
    bf16x8 At[FP8 ? 1 : 4][2], B0[FP8 ? 1 : 2][2], B1[FP8 ? 1 : 2][2];
    pg8_v8i At8[FP8 ? 4 : 1], B08[FP8 ? 2 : 1], B18[FP8 ? 2 : 1];
    const char* cA = (const char*)g.A + (size_t)cur.pm * tstep; const char* cB = (const char*)g.Bt + (size_t)cur.pn * tstep;
    S.a_ready(cur);
    if constexpr (CHAIN_IN) { } else if constexpr (SP2) {
        PG8_STAGE(PG8_SB(0, 0), cB, voffB); PG8_STAGE(PG8_SB(0, 1), cB + hstep, voffB); PG8_STAGE(PG8_SA(0, 0), cA, voffA); PG8_STAGE(PG8_SA(0, 1), cA + hstep, voffA);
        if (wr == 1) PG8_BAR;
        PG8_WAIT_V(2); PG8_BAR;
        PG8_STAGE(PG8_SB(1, 0), cB + kstep, voffB); PG8_STAGE(PG8_SA(1, 0), cA + kstep, voffA); PG8_STAGE(PG8_SB(1, 1), cB + hstep + kstep, voffB);
        PG8_WAIT_V(6); PG8_BAR;
    } else {
        PG8_STAGE(PG8_SB(0, 0), cB, voffB); PG8_STAGE(PG8_SA(0, 0), cA, voffA); PG8_STAGE(PG8_SB(0, 1), cB + hstep, voffB); PG8_STAGE(PG8_SA(0, 1), cA + hstep, voffA);
        if (wr == 1) PG8_BAR;
        PG8_WAIT_V(4); PG8_BAR;
        PG8_STAGE(PG8_SB(1, 0), cB + kstep, voffB); PG8_STAGE(PG8_SA(1, 0), cA + kstep, voffA); PG8_STAGE(PG8_SB(1, 1), cB + hstep + kstep, voffB);
        PG8_WAIT_V(6); PG8_BAR;
    }
    for (;;) {
        const bool has_next = S.next(ui + 1, nxt);
        const char* nA = has_next ? (const char*)g.A + (size_t)nxt.pm * tstep : (CHAIN_OUT ? chainA : cA); const char* nB = has_next ? (const char*)g.Bt + (size_t)nxt.pn * tstep : (CHAIN_OUT ? chainB : cB);
#pragma unroll 1
        for (int t = 0; t < nt; t += 2) {
            const bool last = (t == nt - 2);
            const char* a1 = cA + (size_t)(t + 1) * kstep;
            const char* a2 = last ? nA : cA + (size_t)(t + 2) * kstep; const char* b2 = last ? nB : cB + (size_t)(t + 2) * kstep;
            const char* a3 = a2 + kstep; const char* b3 = b2 + kstep;
            if (last && has_next) S.a_ready(nxt);
            if constexpr (SP2) {
            PG8_LDB(B0, 0, 0); PG8_LDB(B1, 0, 1); PG8_SCHED; PG8_LDA(At, 0, 0); PG8_STAGE(PG8_SA(1, 1), a1 + hstep, voffA);
            PG8_WAIT_V(8); PG8_WAIT_L(0); PG8_BAR; PG8_MMA(0, 0, At, B0); PG8_MMA(0, 1, At, B1); PG8_BAR; PG8_SCHED;
            PG8_LDA(At, 0, 1); PG8_STAGE(PG8_SB(0, 0), b2, voffB); PG8_STAGE(PG8_SB(0, 1), b2 + hstep, voffB); PG8_STAGE(PG8_SA(0, 0), a2, voffA);
            PG8_WAIT_V(8); PG8_WAIT_L(0); PG8_BAR; PG8_MMA(1, 0, At, B0); PG8_MMA(1, 1, At, B1); PG8_BAR; PG8_SCHED;
            PG8_LDB(B0, 1, 0); PG8_LDB(B1, 1, 1); PG8_SCHED; PG8_LDA(At, 1, 0); PG8_STAGE(PG8_SA(0, 1), a2 + hstep, voffA);
            PG8_WAIT_V(8); PG8_WAIT_L(0); PG8_BAR; PG8_MMA(0, 0, At, B0); PG8_MMA(0, 1, At, B1); PG8_BAR; PG8_SCHED;
            PG8_LDA(At, 1, 1); PG8_STAGE(PG8_SB(1, 0), b3, voffB); PG8_STAGE(PG8_SB(1, 1), b3 + hstep, voffB); PG8_STAGE(PG8_SA(1, 0), a3, voffA);
            PG8_WAIT_V(8); PG8_WAIT_L(0); PG8_BAR; PG8_MMA(1, 0, At, B0); PG8_MMA(1, 1, At, B1); PG8_BAR; PG8_SCHED;
            } else {
            PG8_LDB(B0, 0, 0); PG8_SCHED; PG8_LDA(At, 0, 0); PG8_STAGE(PG8_SA(1, 1), a1 + hstep, voffA);
            PG8_WAIT_L(8); PG8_BAR; PG8_WAIT_L(0); PG8_MMA(0, 0, At, B0); PG8_BAR; PG8_SCHED;
            PG8_LDB(B1, 0, 1); PG8_STAGE(PG8_SB(0, 0), b2, voffB);
            PG8_BAR; PG8_WAIT_L(0); PG8_MMA(0, 1, At, B1); PG8_BAR;
            PG8_LDA(At, 0, 1); PG8_STAGE(PG8_SA(0, 0), a2, voffA);
            PG8_BAR; PG8_WAIT_L(0); PG8_MMA(1, 0, At, B0); PG8_BAR; PG8_SCHED;
            PG8_STAGE(PG8_SB(0, 1), b2 + hstep, voffB);
            PG8_WAIT_V(6); PG8_BAR; PG8_MMA(1, 1, At, B1); PG8_BAR;
            PG8_LDB(B0, 1, 0); PG8_SCHED; PG8_LDA(At, 1, 0); PG8_STAGE(PG8_SA(0, 1), a2 + hstep, voffA);
            PG8_WAIT_L(8); PG8_BAR; PG8_WAIT_L(0); PG8_MMA(0, 0, At, B0); PG8_BAR; PG8_SCHED;
            PG8_LDB(B1, 1, 1); PG8_STAGE(PG8_SB(1, 0), b3, voffB);
            PG8_BAR; PG8_WAIT_L(0); PG8_MMA(0, 1, At, B1); PG8_BAR;
            PG8_LDA(At, 1, 1); PG8_STAGE(PG8_SA(1, 0), a3, voffA);
            PG8_BAR; PG8_WAIT_L(0); PG8_MMA(1, 0, At, B0); PG8_BAR; PG8_SCHED;
            PG8_STAGE(PG8_SB(1, 1), b3 + hstep, voffB);
            PG8_WAIT_V(6); PG8_BAR; PG8_MMA(1, 1, At, B1); PG8_BAR;
            }
        }
        if constexpr (ALIGN_EPI) { if (wr == 0) PG8_BAR; }
        if constexpr (!Epi::AFTER_DRAIN) { int ln_; asm volatile("v_mbcnt_lo_u32_b32 %0, -1, 0\n\tv_mbcnt_hi_u32_b32 %0, -1, %0" : "=v"(ln_)); E(acc, cur, wr, wc, ln_ & 15, ln_ >> 4); S.done(cur); }
        if (!has_next) { if constexpr (CHAIN_OUT) { if (wr == 1) PG8_BAR; return; } break; }
#pragma unroll
        for (int a = 0; a < 2; ++a)
#pragma unroll
            for (int b = 0; b < 2; ++b)
#pragma unroll
                for (int m = 0; m < 4; ++m)
#pragma unroll
                    for (int n = 0; n < 2; ++n) acc[a][b][m][n] = (f32x4){0.f, 0.f, 0.f, 0.f};
        cur = nxt; cA = nA; cB = nB; ++ui;
        if constexpr (ALIGN_EPI) { if (wr == 1) PG8_BAR; }
    }
    PG8_WAIT_V(0);
    if constexpr (!ALIGN_EPI) { if (wr == 0) PG8_BAR; }
    PG8_BAR;
    if constexpr (Epi::AFTER_DRAIN) { E.fused(acc, cur, wr, wc, fr, fq, lds, wid, lane); S.done(cur); }
#undef PG8_SA
#undef PG8_SB
#undef PG8_STAGE
#undef PG8_GLDS
#undef PG8_LD32
#undef PG8_LDA
#undef PG8_LDB
#undef PG8_MMA
#undef PG8_WAIT_V
#undef PG8_WAIT_L
#undef PG8_BAR
#undef PG8_SCHED
}
}

constexpr size_t MiB = 1u << 20;
constexpr size_t WS_CTL = 0, CTL_ZERO_BYTES = 1 * MiB;
constexpr size_t WS_WIN = 2 * MiB;
constexpr size_t WS_WOUT = 16 * MiB;
constexpr size_t WS_WST = 20 * MiB;
constexpr size_t WS_BT = 21 * MiB;
constexpr size_t WS_KMEAN = 22 * MiB;
constexpr size_t WS_LOFF = 23 * MiB;
constexpr size_t WS_ROWSS = 24 * MiB;
constexpr size_t WS_PL = 26 * MiB;
constexpr size_t WS_LIST = 30 * MiB;
constexpr size_t WS_SEL = 32 * MiB;
constexpr size_t WS_XB8 = 104 * MiB;
constexpr size_t WS_WIN8 = 456 * MiB;
constexpr size_t WS_XB = 40 * MiB;
constexpr size_t WS_PROJ = 168 * MiB;
constexpr size_t WS_MIX = 392 * MiB;
constexpr size_t WS_END = 462 * MiB;
constexpr size_t SUBSTRIDE = (size_t)MROWS * 512;
enum { T_U = 0, T_V = 1, T_ZA = 2, T_Q = 3, T_K = 4, T_VV = 5, T_ZB = 6 };

constexpr int NWAVES = 8;
constexpr int LDS_BYTES = 160 * 1024;
constexpr int RING_BYTES = 131072;

#define LAS __attribute__((address_space(3)))
typedef unsigned short bf16;
typedef unsigned v4u __attribute__((ext_vector_type(4)));
typedef float f32x4 __attribute__((ext_vector_type(4)));
#define LDS_WAIT() asm volatile("s_waitcnt lgkmcnt(0)" ::: "memory")
typedef float f32x2c __attribute__((ext_vector_type(2)));
typedef __bf16 bf16x2c __attribute__((ext_vector_type(2)));
__device__ __forceinline__ unsigned pk2(float lo, float hi) { const f32x2c v = {lo, hi}; return __builtin_bit_cast(unsigned, __builtin_convertvector(v, bf16x2c)); }
__device__ __forceinline__ unsigned f2bf(float f) { return pk2(f, f) & 0xffffu; }
__device__ __forceinline__ f32x2c bfpair(unsigned w) { return (f32x2c){__builtin_bit_cast(float, w << 16), __builtin_bit_cast(float, w & 0xffff0000u)}; }
__device__ __forceinline__ unsigned pk2v(f32x2c v) { return __builtin_bit_cast(unsigned, __builtin_convertvector(v, bf16x2c)); }
__device__ __forceinline__ f32x2c exp2_pk(f32x2c v) { return (f32x2c){__builtin_amdgcn_exp2f(v.x), __builtin_amdgcn_exp2f(v.y)}; }
__device__ __forceinline__ f32x2c rcp_pk(f32x2c v) { return (f32x2c){__builtin_amdgcn_rcpf(v.x), __builtin_amdgcn_rcpf(v.y)}; }
__device__ __forceinline__ f32x2c gelu_pk(f32x2c x) {
    constexpr float K = -2.0f * 0.7978845608028654f * 1.4426950408889634f;
    const f32x2c e = exp2_pk(x * (x * x * (0.044715f * K) + K));
    return x * rcp_pk(e + 1.0f);
}
__device__ __forceinline__ f32x2c gelu_silu_pk(f32x2c u, f32x2c m, f32x2c z) {
    constexpr float K = -2.0f * 0.7978845608028654f * 1.4426950408889634f;
    const f32x2c eu = exp2_pk(u * (u * u * (0.044715f * K) + K)), ez = exp2_pk(z * (-1.4426950408889634f));
    return (u * z) * m * rcp_pk((eu + 1.0f) * (ez + 1.0f));
}
__device__ __forceinline__ unsigned pk4_fp8(float a, float b, float c, float d) { int w = __builtin_amdgcn_cvt_pk_fp8_f32(a, b, 0, false); w = __builtin_amdgcn_cvt_pk_fp8_f32(c, d, w, true); return (unsigned)w; }
__device__ __forceinline__ float bflo(unsigned w) { return __uint_as_float(w << 16); }
__device__ __forceinline__ float bfhi(unsigned w) { return __uint_as_float(w & 0xffff0000u); }
__device__ __forceinline__ float wave_sum(float v) {
#pragma unroll
    for (int o = 1; o < 64; o <<= 1) v += lx_xor(v, o);
    return v;
}

__device__ __forceinline__ int lane_now() { int l; asm volatile("v_mbcnt_lo_u32_b32 %0, -1, 0\n\tv_mbcnt_hi_u32_b32 %0, -1, %0" : "=v"(l)); return l; }
struct Args { const float* in[10]; float* out; unsigned char* ws; int layer, pad; };

struct Ctx {
    unsigned char* lds;
    int tid, lane, wave, G, bid;
    const float *x, *norm_g, *w_in, *ln_g, *ln_b, *sgu_w, *sgu_b, *w_out, *rel_bias, *final_g;
    float* out; unsigned char* ws;
};

__device__ __forceinline__ void p0_transpose_item(const float* W, const float* gs, int K, int N, bf16* WT, float* scr, int item, int lane, unsigned char* W8 = nullptr) {
    const int nblk = N / 32, kb = item / nblk, nb = item % nblk, k0 = 64 * kb, n0 = 32 * nb;
    float wv[32];
#pragma unroll
    for (int i = 0; i < 32; ++i) wv[i] = W[(size_t)(k0 + 2 * i + (lane >> 5)) * N + n0 + (lane & 31)];
#pragma unroll
    for (int i = 0; i < 32; ++i) { const int kk = 2 * i + (lane >> 5); const float sc = gs ? gs[k0 + kk] : 1.0f; scr[kk * 33 + (lane & 31)] = wv[i] * sc; }
    LDS_WAIT(); asm volatile("" ::: "memory");
    const int c = lane & 7;
#pragma unroll
    for (int j = 0; j < 4; ++j) { const int n = (lane >> 3) + 8 * j; const float* s = scr + (8 * c) * 33 + n;
        const bool f8 = W8 && ((n0 >= 1536 && n0 < 2048) || n0 >= 2560);
        if (f8) { typedef unsigned u32x2v __attribute__((ext_vector_type(2)));
            const int r8 = (n0 < 2048 ? n0 - 1536 : n0 - 2048) + n;
            *(u32x2v*)(W8 + (size_t)r8 * 2 * K + k0 + 8 * c) = (u32x2v){pk4_fp8(32.f * s[0 * 33], 32.f * s[1 * 33], 32.f * s[2 * 33], 32.f * s[3 * 33]), pk4_fp8(32.f * s[4 * 33], 32.f * s[5 * 33], 32.f * s[6 * 33], 32.f * s[7 * 33])}; }
        else { const int rb = ((W8 && n0 >= 2048) ? n0 - 512 : n0) + n;
            v4u o; o.x = pk2(s[0 * 33], s[1 * 33]); o.y = pk2(s[2 * 33], s[3 * 33]); o.z = pk2(s[4 * 33], s[5 * 33]); o.w = pk2(s[6 * 33], s[7 * 33]);
            *(v4u*)(WT + (size_t)rb * K + k0 + 8 * c) = o; } }
    LDS_WAIT(); asm volatile("" ::: "memory");
}
__device__ __forceinline__ int rel_bucket(int d) {
    if (d < 16) return d;
    int b = 16;
    b += (d >= 19); b += (d >= 21); b += (d >= 24); b += (d >= 27); b += (d >= 31); b += (d >= 35); b += (d >= 40); b += (d >= 46);
    b += (d >= 52); b += (d >= 59); b += (d >= 67); b += (d >= 77); b += (d >= 87); b += (d >= 99); b += (d >= 113);
    return b;
}
__device__ __forceinline__ void phase_prologue(const Ctx& C) {
    float* scr = (float*)(C.lds + C.wave * 16384);
    const int gw = C.bid * NWAVES + C.wave, NGW = C.G * NWAVES;
    constexpr int I_IN = (DM / 64) * (DIN / 32), I_OUT = (DM / 64) * (DM / 32);
    constexpr int NITEMS = DEPTH * (I_IN + I_OUT);
    for (int it = gw; it < NITEMS; it += NGW) {
        const int l = it / (I_IN + I_OUT); int r = it % (I_IN + I_OUT);
        if (r < I_IN) p0_transpose_item(C.w_in + (size_t)l * DM * DIN, C.norm_g + l * DM, DM, DIN, (bf16*)(C.ws + WS_WIN) + (size_t)l * DIN * DM, scr, r, C.lane, C.ws + WS_WIN8 + (size_t)l * 1536 * 2 * DM);
        else p0_transpose_item(C.w_out + (size_t)l * DM * DM, nullptr, DM, DM, (bf16*)(C.ws + WS_WOUT) + (size_t)l * DM * DM, scr, r - I_IN, C.lane);
    }
    { float* km = (float*)(C.ws + WS_KMEAN); for (int e = C.bid * 512 + C.tid; e < DEPTH * NBH * NBLK * 64; e += C.G * 512) km[e] = 0.f; }
    { bf16* wst = (bf16*)(C.ws + WS_WST); const int gt = C.bid * 512 + C.tid, NT = C.G * 512;
      for (int e = gt; e < DEPTH * 8 * 128 * 128; e += NT) { const int s = e & 127, t = (e >> 7) & 127; wst[e] = (s <= t) ? (bf16)f2bf(C.sgu_w[e]) : (bf16)0; } }
    if (C.bid == 0) { float* bt = (float*)(C.ws + WS_BT); for (int e = C.tid; e < 8 * 128; e += 512) { const int h = e >> 7, d = e & 127; bt[e] = C.rel_bias[rel_bucket(d) * 8 + h] * LOG2E; } }
    { bf16* xb = (bf16*)(C.ws + WS_XB); float* rowss = (float*)(C.ws + WS_ROWSS);
      constexpr int UN = 4;
      for (int m0 = gw; m0 < MROWS; m0 += NGW * UN) {
        f32x4 v[UN][4];
#pragma unroll
        for (int k = 0; k < UN; ++k) { const f32x4* xr = (const f32x4*)(C.x + (size_t)(m0 + k * NGW) * DM) + C.lane;
#pragma unroll
            for (int j = 0; j < 4; ++j) v[k][j] = xr[64 * j]; }
#pragma unroll
        for (int k = 0; k < UN; ++k) { const int m = m0 + k * NGW;
            float s = 0.f;
#pragma unroll
            for (int j = 0; j < 4; ++j) s += (v[k][j].x * v[k][j].x + v[k][j].y * v[k][j].y) + (v[k][j].z * v[k][j].z + v[k][j].w * v[k][j].w);
            s = wave_sum(s);
            unsigned long long* o8 = (unsigned long long*)(xb + (size_t)m * DM) + C.lane;
#pragma unroll
            for (int j = 0; j < 4; ++j) o8[64 * j] = (unsigned long long)pk2(v[k][j].x, v[k][j].y) | ((unsigned long long)pk2(v[k][j].z, v[k][j].w) << 32);
            { unsigned* sw = (unsigned*)scr + 256 * k;
#pragma unroll
              for (int j = 0; j < 4; ++j) sw[64 * j + C.lane] = pk4_fp8(v[k][j].x, v[k][j].y, v[k][j].z, v[k][j].w);
              LDS_WAIT(); asm volatile("" ::: "memory");
              *(v4u*)(C.ws + WS_XB8 + (size_t)m * 2048 + 16 * C.lane) = *(const v4u*)(sw + 4 * C.lane); }
            if (C.lane < 16) rowss[(size_t)m * 16 + C.lane] = (C.lane == 0) ? s : 0.f; }
      } }
}

typedef short bf16x8 __attribute__((ext_vector_type(8)));
typedef short bf16x4s __attribute__((ext_vector_type(4)));
typedef float f32x16 __attribute__((ext_vector_type(16)));
typedef int v8i_t __attribute__((ext_vector_type(8)));
__device__ __forceinline__ int at_vpos(int kv) { return (kv & ~63) + 32 * ((kv >> 2) & 1) + 16 * ((kv >> 5) & 1) + (kv & 3) + 4 * ((kv >> 3) & 3); }
__device__ __forceinline__ int crow(int r, int hi) { return (r & 3) + 8 * (r >> 2) + 4 * hi; }
__device__ __forceinline__ unsigned cvtpk(float lo, float hi) { unsigned r; asm volatile("v_cvt_pk_bf16_f32 %0, %1, %2" : "=v"(r) : "v"(lo), "v"(hi)); return r; }
__device__ __forceinline__ void phase_gate(const Ctx& C, int layer) {
    const bf16* Q = (const bf16*)(C.ws + WS_PROJ) + (size_t)T_Q * SUBSTRIDE;
    const float* KM = (const float*)(C.ws + WS_KMEAN) + (size_t)layer * NBH * NBLK * 64;
    int* SEL = (int*)(C.ws + WS_SEL); int* LOFF = (int*)(C.ws + WS_LOFF); unsigned short* LIST = (unsigned short*)(C.ws + WS_LIST);
    int* cnt = (int*)(C.lds);
    int* offs = (int*)(C.lds + 256);
    unsigned char* kml = C.lds + 1024;
    const int lane = C.lane, ql = lane & 31, hi = lane >> 5;
    bf16x8 qfN[4]; f32x4 kmr[2];
#define GATE_LOAD(uu) do { const int bh_ = (uu) / 63, i_ = (uu) % 63 + 1, b_ = bh_ >> 3, h_ = bh_ & 7; \
        const bf16* qrow_ = Q + ((size_t)(b_ * SEQ + i_ * 256 + C.wave * 32 + ql)) * 512 + h_ * 64 + hi * 8; \
        _Pragma("unroll") for (int ks = 0; ks < 4; ++ks) qfN[ks] = *(const bf16x8*)(qrow_ + ks * 16); \
        const float* kp_ = KM + (size_t)bh_ * NBLK * 64 + C.tid * 8; kmr[0] = *(const f32x4*)kp_; kmr[1] = *(const f32x4*)(kp_ + 4); } while (0)
#define GATE_KML() do { *(v4u*)(kml + (C.tid >> 3) * 144 + (C.tid & 7) * 16) = (v4u){cvtpk(kmr[0][0], kmr[0][1]), cvtpk(kmr[0][2], kmr[0][3]), cvtpk(kmr[1][0], kmr[1][1]), cvtpk(kmr[1][2], kmr[1][3])}; } while (0)
    int u = C.bid;
    if (C.tid < 64) cnt[C.tid] = 0;
    if (u < NBH * 63) { GATE_LOAD(u); GATE_KML(); }
    __syncthreads();
    for (; u < NBH * 63; u += C.G) {
        const int bh = u / 63, i = u % 63 + 1;
        const int q = C.wave * 32 + ql, pos = i * 256 + q;
        bf16x8 qf[4];
#pragma unroll
        for (int ks = 0; ks < 4; ++ks) qf[ks] = qfN[ks];
        const bool more = u + C.G < NBH * 63;
        if (more) GATE_LOAD(u + C.G);
        constexpr float NEGK = -3.0e38f;
        float b0 = NEGK, b1 = NEGK, b2 = NEGK;
        const unsigned hib = (unsigned)hi << 2;
#define TOP3_INS(key) do { const float k_ = (key); const float n0_ = fmaxf(b0, k_), n1_ = __builtin_amdgcn_fmed3f(b0, b1, k_), n2_ = __builtin_amdgcn_fmed3f(b1, b2, k_); b0 = n0_; b1 = n1_; b2 = n2_; } while (0)
#pragma unroll
        for (int nt = 0; nt < 2; ++nt) {
            f32x16 p = {};
#pragma unroll
            for (int ks = 0; ks < 4; ++ks) {
                const bf16x8 kw = *(const bf16x8*)(kml + (32 * nt + ql) * 144 + ks * 32 + hi * 16);
                p = __builtin_amdgcn_mfma_f32_32x32x16_bf16(kw, qf[ks], p, 0, 0, 0);
            }
#pragma unroll
            for (int r = 0; r < 16; ++r) { const unsigned n = (unsigned)(32 * nt + (r & 3) + 8 * (r >> 2)) | hib;
                const float key = __uint_as_float((__float_as_uint(p[r]) & ~63u) | n);
                TOP3_INS((int)n < i ? key : NEGK); }
        }
        { const float c0 = lx_xor(b0, 32), c1 = lx_xor(b1, 32), c2 = lx_xor(b2, 32);
          TOP3_INS(c0); TOP3_INS(c1); TOP3_INS(c2); }
#undef TOP3_INS
        const int i0 = (b0 > 0.5f * NEGK) ? (int)(__float_as_uint(b0) & 63u) : -1, i1 = (b1 > 0.5f * NEGK) ? (int)(__float_as_uint(b1) & 63u) : -1, i2 = (b2 > 0.5f * NEGK) ? (int)(__float_as_uint(b2) & 63u) : -1;
        int p0 = 0, p1 = 0, p2 = 0;
        if (hi == 0) {
            if (CHECK_ATTN) { int* sp = SEL + ((size_t)bh * SEQ + pos) * 4; sp[0] = i0; sp[1] = i1; sp[2] = i2; sp[3] = -1; }
            p0 = atomicAdd(&cnt[i0], 1);
            if (i1 >= 0) p1 = atomicAdd(&cnt[i1], 1);
            if (i2 >= 0) p2 = atomicAdd(&cnt[i2], 1);
        }
        __syncthreads();
        if (C.tid < 64) {
            const int c = cnt[C.tid]; cnt[C.tid] = 0;
            int inc = c;
#pragma unroll
            for (int o = 1; o < 64; o <<= 1) { const int t = lx_up(inc, o); if (C.tid >= o) inc += t; }
            offs[C.tid + 1] = inc; if (C.tid == 0) offs[0] = 0;
            LOFF[(size_t)(bh * NBLK + i) * 80 + C.tid + 1] = inc; if (C.tid == 0) LOFF[(size_t)(bh * NBLK + i) * 80] = 0;
        }
        if (more) GATE_KML();
        __syncthreads();
        if (hi == 0) {
            unsigned short* lp = LIST + (size_t)(bh * NBLK + i) * 768;
            lp[offs[i0] + p0] = (unsigned short)(q | (0 << 8));
            if (i1 >= 0) lp[offs[i1] + p1] = (unsigned short)(q | (1 << 8));
            if (i2 >= 0) lp[offs[i2] + p2] = (unsigned short)(q | (2 << 8));
        }
    }
#undef GATE_LOAD
#undef GATE_KML
    if (CHECK_ATTN) { for (int e = C.bid * 512 + C.tid; e < NBH * 256; e += C.G * 512) { const int bh = e >> 8, qq = e & 255; int* sp = SEL + ((size_t)bh * SEQ + qq) * 4; sp[0] = -1; sp[1] = -1; sp[2] = -1; sp[3] = -1; } }
    __syncthreads();
}

__device__ __forceinline__ void phase_attn_simple(const Ctx& C, bf16* MIX) {
    const bf16* Q = (const bf16*)(C.ws + WS_PROJ) + (size_t)T_Q * SUBSTRIDE;
    const bf16* K = (const bf16*)(C.ws + WS_PROJ) + (size_t)T_K * SUBSTRIDE;
    const bf16* VV = (const bf16*)(C.ws + WS_PROJ) + (size_t)T_VV * SUBSTRIDE;
    const bf16* ZB = (const bf16*)(C.ws + WS_PROJ) + (size_t)T_ZB * SUBSTRIDE;
    const int* SEL = (const int*)(C.ws + WS_SEL); const float* BT = (const float*)(C.ws + WS_BT);
    const int gt = C.bid * 512 + C.tid, NT = C.G * 512;
    for (int item = gt; item < NBH * SEQ; item += NT) {
        const int bh = item >> 14, pos = item & (SEQ - 1), b = bh >> 3, h = bh & 7, own = pos >> 8;
        const size_t rowq = (size_t)(b * SEQ + pos);
        float qv[64], o[64];
        { const v4u* qp = (const v4u*)(Q + rowq * 512 + h * 64);
#pragma unroll
          for (int c = 0; c < 8; ++c) { const v4u v = qp[c]; qv[8 * c + 0] = bflo(v.x); qv[8 * c + 1] = bfhi(v.x); qv[8 * c + 2] = bflo(v.y); qv[8 * c + 3] = bfhi(v.y);
              qv[8 * c + 4] = bflo(v.z); qv[8 * c + 5] = bfhi(v.z); qv[8 * c + 6] = bflo(v.w); qv[8 * c + 7] = bfhi(v.w); } }
#pragma unroll
        for (int d = 0; d < 64; ++d) o[d] = 0.f;
        float m = -INFINITY, l = 0.f;
        const float* bt = BT + h * 128;
        for (int slot = 0; slot < 4; ++slot) {
            int blk, klim;
            if (slot == 0) { blk = own; klim = (pos & 255) + 1; } else { blk = SEL[(size_t)item * 4 + slot - 1]; klim = 256; if (blk < 0) klim = 0; }
            for (int kl = 0; kl < klim; ++kl) {
                const int kpos = blk * 256 + kl;
                const v4u* kp = (const v4u*)(K + ((size_t)(b * SEQ + kpos)) * 512 + h * 64);
                float a0 = 0.f, a1 = 0.f;
#pragma unroll
                for (int c = 0; c < 8; ++c) { const v4u v = kp[c];
                    a0 += qv[8 * c + 0] * bflo(v.x) + qv[8 * c + 2] * bflo(v.y) + qv[8 * c + 4] * bflo(v.z) + qv[8 * c + 6] * bflo(v.w);
                    a1 += qv[8 * c + 1] * bfhi(v.x) + qv[8 * c + 3] * bfhi(v.y) + qv[8 * c + 5] * bfhi(v.z) + qv[8 * c + 7] * bfhi(v.w); }
                int dd = pos - kpos; dd = dd > 127 ? 127 : dd;
                const float s = (a0 + a1) + bt[dd];
                if (s > m) { const float al = __builtin_amdgcn_exp2f(m - s); l *= al;
#pragma unroll
                    for (int d = 0; d < 64; ++d) o[d] *= al;
                    m = s; }
                const float p = __builtin_amdgcn_exp2f(s - m);
                l += p;
                const v4u* vp = (const v4u*)(VV + ((size_t)(b * SEQ + kpos)) * 512 + h * 64);
#pragma unroll
                for (int c = 0; c < 8; ++c) { const v4u v = vp[c];
                    o[8 * c + 0] += p * bflo(v.x); o[8 * c + 1] += p * bfhi(v.x); o[8 * c + 2] += p * bflo(v.y); o[8 * c + 3] += p * bfhi(v.y);
                    o[8 * c + 4] += p * bflo(v.z); o[8 * c + 5] += p * bfhi(v.z); o[8 * c + 6] += p * bflo(v.w); o[8 * c + 7] += p * bfhi(v.w); }
            }
        }
        const float rl = 1.0f / l;
        const v4u* zp = (const v4u*)(ZB + rowq * 512 + h * 64);
        v4u* op = (v4u*)(MIX + rowq * 1024 + 512 + h * 64);
#pragma unroll
        for (int c = 0; c < 8; ++c) { const v4u z = zp[c]; v4u w;
            w.x = pk2(o[8 * c + 0] * rl * pg8::act_silu(bflo(z.x)), o[8 * c + 1] * rl * pg8::act_silu(bfhi(z.x))); w.y = pk2(o[8 * c + 2] * rl * pg8::act_silu(bflo(z.y)), o[8 * c + 3] * rl * pg8::act_silu(bfhi(z.y)));
            w.z = pk2(o[8 * c + 4] * rl * pg8::act_silu(bflo(z.z)), o[8 * c + 5] * rl * pg8::act_silu(bfhi(z.z))); w.w = pk2(o[8 * c + 6] * rl * pg8::act_silu(bflo(z.w)), o[8 * c + 7] * rl * pg8::act_silu(bfhi(z.w)));
            op[c] = w; }
    }
}

constexpr int AT_KS = 0, AT_KPITCH = 144;
constexpr int AT_VT = 36864, AT_VPITCH = 272;
constexpr int AT_DT = AT_VT + 64 * AT_VPITCH;
constexpr int AT_ENT = AT_DT + 4096, AT_CAP = 4096;
constexpr int AT_PRE = AT_ENT + AT_CAP * 4;
constexpr int AT_OST = AT_PRE + 1024;
constexpr int AT_MISC = AT_OST + 8 * 4096;
constexpr int AT_NUNITS = NBLK * NBH;

typedef int v4i_t __attribute__((ext_vector_type(4)));
#ifndef ATTN_STATIC_PRIO
#define ATTN_STATIC_PRIO 1
#endif
#if ATTN_STATIC_PRIO
#define ATTN_PRIO_UP
#define ATTN_PRIO_DN
#else
#define ATTN_PRIO_UP __builtin_amdgcn_s_setprio(1)
#define ATTN_PRIO_DN __builtin_amdgcn_s_setprio(0)
#endif
struct QTile { unsigned ent; v4i_t qf[4]; };
__device__ __forceinline__ void attn_issue_q(QTile& T, const Ctx& C, const unsigned char* lds, int b, int h, int e0, int cnt) {
    const bf16* Q = (const bf16*)(C.ws + WS_PROJ) + (size_t)T_Q * SUBSTRIDE;
    const unsigned* ENT = (const unsigned*)(lds + AT_ENT);
    const int q = C.lane & 31, hi = C.lane >> 5;
    T.ent = ENT[(e0 + q < cnt) ? (e0 + q) : e0];
    const bf16* qrow = Q + ((size_t)(b * SEQ + (int)(T.ent & 16383u))) * 512 + h * 64 + hi * 8;
    asm volatile("global_load_dwordx4 %0, %4, off\n\tglobal_load_dwordx4 %1, %4, off offset:32\n\tglobal_load_dwordx4 %2, %4, off offset:64\n\tglobal_load_dwordx4 %3, %4, off offset:96"
                 : "=&v"(T.qf[0]), "=&v"(T.qf[1]), "=&v"(T.qf[2]), "=&v"(T.qf[3]) : "v"(qrow));
}
__device__ __forceinline__ void attn_wait_q(QTile& T) { asm volatile("s_waitcnt vmcnt(0)" : "+v"(T.qf[0]), "+v"(T.qf[1]), "+v"(T.qf[2]), "+v"(T.qf[3])); }
__device__ __forceinline__ void attn_tile(const Ctx& C, unsigned char* lds, const QTile& T, QTile& Tn, int bh, int e0, int cnt, int nkt2, const bool OWN) {
    bf16* PO = (bf16*)C.out; float* PL = (float*)(C.ws + WS_PL);
    const unsigned* ENT = (const unsigned*)(lds + AT_ENT);
    const int lane = C.lane, q = lane & 31, hi = lane >> 5;
    const unsigned ent = T.ent;
    const int pos = ent & 16383, qoff = (ent >> 16) & 1023;
    f32x16 o0 = {}, o1 = {}, ol = {};
    v8i_t pa8 = {};
    asm volatile("" : "+v"(pa8));
    const bool anybias = OWN ? true : (__any(qoff < 112) != 0);
    const unsigned char* kbase = lds + AT_KS + q * AT_KPITCH + hi * 16;
    const unsigned char* vbase = lds + AT_VT + q * AT_VPITCH + hi * 32;
    const float* et0 = (const float*)(lds + AT_DT) + (1023 - (256 + (OWN ? 0 : 256) + qoff - 4 * hi));
    bf16x8 kf[8];
#pragma unroll
    for (int ks = 0; ks < 4; ++ks) { kf[2 * ks] = *(const bf16x8*)(kbase + ks * 32); kf[2 * ks + 1] = *(const bf16x8*)(kbase + 32 * AT_KPITCH + ks * 32); }
    for (int kt2 = 0; kt2 < nkt2; ++kt2) {
        f32x16 p0, p1;
        if (anybias && (OWN || kt2 >= 2)) {
            const float* et = et0 + 64 * kt2;
#pragma unroll
            for (int r = 0; r < 16; ++r) { p0[r] = et[(r & 3) + 8 * (r >> 2)]; p1[r] = et[32 + (r & 3) + 8 * (r >> 2)]; }
#pragma unroll
            for (int ks = 0; ks < 4; ++ks) {
                p0 = __builtin_amdgcn_mfma_f32_32x32x16_bf16(kf[2 * ks], __builtin_bit_cast(bf16x8, T.qf[ks]), p0, 0, 0, 0);
                p1 = __builtin_amdgcn_mfma_f32_32x32x16_bf16(kf[2 * ks + 1], __builtin_bit_cast(bf16x8, T.qf[ks]), p1, 0, 0, 0);
            }
        } else {
            p0 = (f32x16){}; p1 = (f32x16){};
#pragma unroll
            for (int ks = 0; ks < 4; ++ks) {
                p0 = __builtin_amdgcn_mfma_f32_32x32x16_bf16(kf[2 * ks], __builtin_bit_cast(bf16x8, T.qf[ks]), p0, 0, 0, 0);
                p1 = __builtin_amdgcn_mfma_f32_32x32x16_bf16(kf[2 * ks + 1], __builtin_bit_cast(bf16x8, T.qf[ks]), p1, 0, 0, 0);
            }
        }
        v8i_t vb0, vb1;
        { typedef int v4i_t __attribute__((ext_vector_type(4)));
          const v4i_t a0 = *(const v4i_t*)(vbase + 64 * kt2), a1 = *(const v4i_t*)(vbase + 64 * kt2 + 16);
          const v4i_t c0 = *(const v4i_t*)(vbase + 32 * AT_VPITCH + 64 * kt2), c1 = *(const v4i_t*)(vbase + 32 * AT_VPITCH + 64 * kt2 + 16);
          vb0 = __builtin_shufflevector(a0, a1, 0, 1, 2, 3, 4, 5, 6, 7); vb1 = __builtin_shufflevector(c0, c1, 0, 1, 2, 3, 4, 5, 6, 7); }
#pragma unroll
        for (int r = 0; r < 16; ++r) { p0[r] = __builtin_amdgcn_exp2f(p0[r]); p1[r] = __builtin_amdgcn_exp2f(p1[r]); }
        { typedef short v2s_t __attribute__((ext_vector_type(2)));
#pragma unroll
          for (int i = 0; i < 4; ++i) {
              v2s_t w = __builtin_bit_cast(v2s_t, pa8[i]);
              w = __builtin_amdgcn_cvt_scalef32_pk_fp8_f32(w, p0[4 * i], p0[4 * i + 1], 16.0f, false); w = __builtin_amdgcn_cvt_scalef32_pk_fp8_f32(w, p0[4 * i + 2], p0[4 * i + 3], 16.0f, true);
              pa8[i] = __builtin_bit_cast(int, w);
              v2s_t z = __builtin_bit_cast(v2s_t, pa8[4 + i]);
              z = __builtin_amdgcn_cvt_scalef32_pk_fp8_f32(z, p1[4 * i], p1[4 * i + 1], 16.0f, false); z = __builtin_amdgcn_cvt_scalef32_pk_fp8_f32(z, p1[4 * i + 2], p1[4 * i + 3], 16.0f, true);
              pa8[4 + i] = __builtin_bit_cast(int, z);
          } }
        if (kt2 + 1 < nkt2) {
#pragma unroll
            for (int ks = 0; ks < 4; ++ks) { kf[2 * ks] = *(const bf16x8*)(kbase + (64 * kt2 + 64) * AT_KPITCH + ks * 32); kf[2 * ks + 1] = *(const bf16x8*)(kbase + (64 * kt2 + 96) * AT_KPITCH + ks * 32); }
        }
        ATTN_PRIO_UP;
        o0 = __builtin_amdgcn_mfma_scale_f32_32x32x64_f8f6f4(vb0, pa8, o0, 0, 0, 0, 0x7f7f7f7f, 0, (int)0x83838383);
        o1 = __builtin_amdgcn_mfma_scale_f32_32x32x64_f8f6f4(vb1, pa8, o1, 0, 0, 0, 0x7f7f7f7f, 0, (int)0x83838383);
        v8i_t ones8;
#pragma unroll
        for (int i = 0; i < 8; ++i) { int c_; asm volatile("v_mov_b32 %0, 0x38383838" : "=v"(c_)); ones8[i] = c_; }
        ol = __builtin_amdgcn_mfma_scale_f32_32x32x64_f8f6f4(ones8, pa8, ol, 0, 0, 0, 0x7f7f7f7f, 0, (int)0x83838383);
        ATTN_PRIO_DN;
    }
    const float l = ol[0];
    attn_wait_q(Tn);
    if (e0 + q < cnt) PL[((size_t)bh * SEQ + pos) * 4 + ((ent >> 14) & 3)] = l;
    { unsigned char* prow = (unsigned char*)PO + (((size_t)bh * SEQ + pos) * 4 + ((ent >> 14) & 3)) * 64 + hi * 16;
      const bool live = e0 + q < cnt;
      const float rl = __builtin_amdgcn_rcpf(l);
      unsigned w0[4], w1[4];
#pragma unroll
      for (int g_ = 0; g_ < 4; ++g_) { w0[g_] = pk4_fp8(o0[4 * g_] * rl, o0[4 * g_ + 1] * rl, o0[4 * g_ + 2] * rl, o0[4 * g_ + 3] * rl); w1[g_] = pk4_fp8(o1[4 * g_] * rl, o1[4 * g_ + 1] * rl, o1[4 * g_ + 2] * rl, o1[4 * g_ + 3] * rl); }
      { auto r0 = __builtin_amdgcn_permlane32_swap(w0[0], w0[2], false, false); w0[0] = r0[0]; w0[2] = r0[1]; auto r1 = __builtin_amdgcn_permlane32_swap(w0[1], w0[3], false, false); w0[1] = r1[0]; w0[3] = r1[1];
        auto r2 = __builtin_amdgcn_permlane32_swap(w1[0], w1[2], false, false); w1[0] = r2[0]; w1[2] = r2[1]; auto r3 = __builtin_amdgcn_permlane32_swap(w1[1], w1[3], false, false); w1[1] = r3[0]; w1[3] = r3[1]; }
      if (live) { *(v4u*)(prow) = (v4u){w0[0], w0[2], w0[1], w0[3]}; *(v4u*)(prow + 32) = (v4u){w1[0], w1[2], w1[1], w1[3]}; }
    }
}

__device__ __forceinline__ void phase_attn(const Ctx& C, int layer) {
    if (ATTN_STATIC_PRIO && C.wave >= 4) __builtin_amdgcn_s_setprio(2);
    unsigned char* lds = C.lds;
    const bf16* K = (const bf16*)(C.ws + WS_PROJ) + (size_t)T_K * SUBSTRIDE;
    const bf16* VV = (const bf16*)(C.ws + WS_PROJ) + (size_t)T_VV * SUBSTRIDE;
    const int* LOFF = (const int*)(C.ws + WS_LOFF); const unsigned short* LIST = (const unsigned short*)(C.ws + WS_LIST);
    const float* BT = (const float*)(C.ws + WS_BT);
    const int qg = C.bid & 7;
    unsigned* ctr = (unsigned*)(C.ws + WS_CTL) + 64 + 64 * layer;
    int qstep = 0;
    unsigned* ENT = (unsigned*)(lds + AT_ENT);
    int* PRE = (int*)(lds + AT_PRE); int* LO = PRE + 68;
    volatile unsigned* MISC = (volatile unsigned*)(lds + AT_MISC);
    int tid = C.tid;
    v4u kpre[4], vpre[2]; int lpre0 = 0, lpre1 = 0;
#define AT_LOADKV(uu) do { const int bh_ = (uu) & 15, n_ = (uu) >> 4; \
        const bf16* Kg = K + ((size_t)((bh_ >> 3) * SEQ + n_ * 256)) * 512 + (bh_ & 7) * 64; const unsigned char* Vg = (const unsigned char*)VV + ((size_t)((bh_ >> 3) * SEQ + n_ * 256)) * 512 + (bh_ & 7) * 64; \
        _Pragma("unroll") for (int it = 0; it < 4; ++it) { const int idx = tid + 512 * it; kpre[it] = *(const v4u*)(Kg + (size_t)(idx >> 3) * 512 + (idx & 7) * 8); } \
        _Pragma("unroll") for (int it = 0; it < 2; ++it) { const int idx = tid + 512 * it; vpre[it] = *(const v4u*)(Vg + (size_t)(idx >> 2) * 512 + (idx & 3) * 16); }     \
        lpre0 = 0; lpre1 = 0; if (tid < 64 && n_ + 1 + tid < NBLK) { const int* lp_ = LOFF + ((size_t)(bh_ * NBLK + n_ + 1 + tid)) * 80 + n_; lpre0 = lp_[0]; lpre1 = lp_[1]; } } while (0)
#define AT_FETCH() ({ unsigned r_ = (unsigned)AT_NUNITS; while (qstep < 8) { const int g_ = (qg + qstep) & 7; const unsigned k_ = atomicAdd(ctr + 4 * g_, 1u); \
        if (k_ < 2u * NBLK) { r_ = (k_ >> 1) * 16 + 2 * g_ + (k_ & 1); break; } ++qstep; } r_; })
    if (tid == 0) MISC[0] = AT_FETCH();
    __syncthreads();
    int u = (int)MISC[0];
    if (u < AT_NUNITS) AT_LOADKV(u);
    while (u < AT_NUNITS) {
        asm volatile("" : "+v"(tid));
        Ctx Cu = C; Cu.tid = tid; Cu.lane = tid & 63;
        const int bh = u & 15, n = u >> 4, b = bh >> 3, h = bh & 7;
        if (tid == 0) MISC[1] = AT_FETCH();
#pragma unroll
        for (int it = 0; it < 4; ++it) { const int idx = tid + 512 * it;
            *(v4u*)(lds + AT_KS + (idx >> 3) * AT_KPITCH + (idx & 7) * 16) = kpre[it]; }
#pragma unroll
        for (int it = 0; it < 2; ++it) { const int idx = tid + 512 * it;
            const v4u v = vpre[it];
            unsigned char* vt = lds + AT_VT + (16 * (idx & 3)) * AT_VPITCH + at_vpos(idx >> 2);
            const unsigned w_[4] = {v.x, v.y, v.z, v.w};
#pragma unroll
            for (int e = 0; e < 16; ++e) vt[e * AT_VPITCH] = (unsigned char)(w_[e >> 2] >> (8 * (e & 3))); }
        { float* et_ = (float*)(lds + AT_DT);
#pragma unroll
          for (int k_ = 0; k_ < 2; ++k_) { const int j_ = tid + 512 * k_, d_ = j_ - 256; et_[1023 - j_] = d_ < 0 ? -INFINITY : (d_ < 128 ? BT[h * 128 + d_] - BT[h * 128 + 127] : 0.f);     } }
        if (tid < 64) {
            const int lo = lpre0; int inc = lpre1 - lpre0;
#pragma unroll
            for (int o = 1; o < 64; o <<= 1) { const int t = lx_up(inc, o); if (tid >= o) inc += t; }
            PRE[tid + 1] = inc; LO[tid] = lo; if (tid == 0) PRE[0] = 0;
        }
        __syncthreads();
        const int total = 256 + PRE[63 - n];
        const int unext = (int)MISC[1];
        if (unext < AT_NUNITS) AT_LOADKV(unext);
        for (int base = 0; base < total; base += AT_CAP) {
            const int cnt = (total - base < AT_CAP) ? (total - base) : AT_CAP;
            if (base == 0 && tid < 256) ENT[tid] = (unsigned)(n * 256 + tid) | (3u << 14) | ((unsigned)tid << 16);
            { const int e_lo = base > 256 ? base : 256, e_hi = base + cnt;
#pragma unroll 4
              for (int e = e_lo + tid; e < e_hi; e += 512) {
                  const int es = e - 256; int a = 0, z = 63 - n;
#pragma unroll
                  for (int it = 0; it < 6; ++it) { const int mid = (a + z) >> 1; const bool up = (z - a > 1) && (PRE[mid] <= es); const bool dn = (z - a > 1) && !up; a = up ? mid : a; z = dn ? mid : z; }
                  const int ii = a, i = n + 1 + ii;
                  const unsigned val = LIST[((size_t)(bh * NBLK + i)) * 768 + LO[ii] + (es - PRE[ii])]; const unsigned ql = val & 255u, j = val >> 8;
                  ENT[e - base] = (unsigned)(i * 256 + ql) | (j << 14) | ((ii == 0 ? ql : 400u) << 16);
              } }
            if (tid == 0) MISC[2] = 0u;
            __syncthreads();
            const int ntiles = (cnt + 31) >> 5;
            const int nown = (base == 0) ? 8 : 0;
#define AT_TICKET() ({ int tk_ = 0; if (Cu.lane == 0) tk_ = (int)atomicAdd((unsigned*)(lds + AT_MISC + 8), 1u); __builtin_amdgcn_readfirstlane(tk_); })
#define AT_TILEOF(tk_) (((tk_) < ntiles - nown) ? nown + (tk_) : (ntiles - 1 - (tk_)))
            { int tk = AT_TICKET();
              if (tk < ntiles) {
                  int tile = AT_TILEOF(tk);
                  QTile Tc; attn_issue_q(Tc, Cu, lds, b, h, tile * 32, cnt); attn_wait_q(Tc);
                  for (;;) {
                      const int tkn = AT_TICKET(); const bool more = tkn < ntiles; const int tilen = more ? AT_TILEOF(tkn) : 0;
                      QTile Tn; attn_issue_q(Tn, Cu, lds, b, h, tilen * 32, cnt);
                      { const bool own_ = tile < nown; attn_tile(Cu, lds, Tc, Tn, bh, tile * 32, cnt, own_ ? (tile >> 1) + 1 : 4, own_); }
                      if (!more) break;
                      Tc = Tn; tile = tilen;
                  }
              } }
#undef AT_TICKET
#undef AT_TILEOF
            __syncthreads();
        }
        u = unext;
    }
#undef AT_LOADKV
#undef AT_FETCH
    if (ATTN_STATIC_PRIO) __builtin_amdgcn_s_setprio(0);
}

__device__ __forceinline__ void phase_combine(const Ctx& C) {
    typedef float f2_t __attribute__((ext_vector_type(2)));
    const unsigned char* PO = (const unsigned char*)C.out; const float* PL = (const float*)(C.ws + WS_PL);
    const unsigned char* ZB = (const unsigned char*)((const bf16*)(C.ws + WS_PROJ) + (size_t)T_ZB * SUBSTRIDE);
    bf16* MIX = (bf16*)(C.ws + WS_MIX);
    const int gt = C.bid * 512 + C.tid, NT = C.G * 512;
    constexpr int UN = 4;
    for (int idx0 = gt; idx0 < MROWS * 32; idx0 += NT * UN) {
        f32x4 lv[UN]; v4u pv[UN][4]; v4u zv[UN];
#pragma unroll
        for (int k = 0; k < UN; ++k) {
            const int idx = idx0 + k * NT;
            const int c4 = idx & 3, h = (idx >> 2) & 7, row = idx >> 5, b = row >> 14, pos = row & (SEQ - 1), i = pos >> 8;
            const size_t pb = ((size_t)(b * NH + h) * SEQ + pos) * 4;
            lv[k] = *(const f32x4*)(PL + pb);
#pragma unroll
            for (int j = 0; j < 4; ++j) pv[k][j] = (j == 3 || j < i) ? *(const v4u*)(PO + (pb + j) * 64 + c4 * 16) : (v4u){0u, 0u, 0u, 0u};
            zv[k] = *(const v4u*)(ZB + (size_t)row * 512 + h * 64 + c4 * 16);
        }
#pragma unroll
        for (int k = 0; k < UN; ++k) {
            const int idx = idx0 + k * NT;
            const int c4 = idx & 3, h = (idx >> 2) & 7, row = idx >> 5, pos = row & (SEQ - 1), i = pos >> 8;
            float lw[4]; lw[3] = lv[k][3];
#pragma unroll
            for (int j = 0; j < 3; ++j) lw[j] = (j < i) ? lv[k][j] : 0.f;
            const float rl = __builtin_amdgcn_rcpf((lw[0] + lw[1]) + (lw[2] + lw[3]));
            f2_t acc[8];
#pragma unroll
            for (int e = 0; e < 8; ++e) acc[e] = (f2_t){0.f, 0.f};
#pragma unroll
            for (int j = 0; j < 4; ++j) { const unsigned w_[4] = {pv[k][j].x, pv[k][j].y, pv[k][j].z, pv[k][j].w}; const float wj = lw[j] * rl;
#pragma unroll
                for (int d = 0; d < 4; ++d) { acc[2 * d] += __builtin_amdgcn_cvt_pk_f32_fp8((int)w_[d], false) * wj; acc[2 * d + 1] += __builtin_amdgcn_cvt_pk_f32_fp8((int)w_[d], true) * wj; } }
            const unsigned z_[4] = {zv[k].x, zv[k].y, zv[k].z, zv[k].w};
            unsigned o_[8];
#pragma unroll
            for (int d = 0; d < 4; ++d) {
                const f2_t za = __builtin_amdgcn_cvt_pk_f32_fp8((int)z_[d], false), zb = __builtin_amdgcn_cvt_pk_f32_fp8((int)z_[d], true);
                const f2_t ea = exp2_pk(za * (-1.4426950408889634f)), eb = exp2_pk(zb * (-1.4426950408889634f));
                o_[2 * d] = pk2v(acc[2 * d] * za * rcp_pk(ea + 1.0f)); o_[2 * d + 1] = pk2v(acc[2 * d + 1] * zb * rcp_pk(eb + 1.0f));
            }
            v4u* op = (v4u*)(MIX + (size_t)row * 1024 + 512 + h * 64 + c4 * 16);
            op[0] = (v4u){o_[0], o_[1], o_[2], o_[3]}; op[1] = (v4u){o_[4], o_[5], o_[6], o_[7]};
        }
    }
}

constexpr int SG_VPITCH = 272, SG_MPITCH = 144, SG_WREG = 128 * SG_MPITCH;
constexpr int SG_STATS = 8 * SG_WREG;
constexpr int SG_MR = SG_STATS + 8192;
constexpr int SG_LN = SG_MR + 1024;
__device__ __forceinline__ void phase_sgu(const Ctx& C, int layer) {
    typedef float f32x2v __attribute__((ext_vector_type(2)));
    unsigned char* lds = C.lds;
    const bf16* U = (const bf16*)(C.ws + WS_PROJ) + (size_t)T_U * SUBSTRIDE;
    const bf16* V = (const bf16*)(C.ws + WS_PROJ) + (size_t)T_V * SUBSTRIDE;
    const bf16* ZA = (const bf16*)(C.ws + WS_PROJ) + (size_t)T_ZA * SUBSTRIDE;
    bf16* MIX = (bf16*)(C.ws + WS_MIX);
    const int g = C.wave; int lane = C.lane;
    const float* lng = C.ln_g + layer * 512 + g * 64; const float* lnb = C.ln_b + layer * 512 + g * 64;
    const bf16* Wg = (const bf16*)(C.ws + WS_WST) + ((size_t)(layer * 8 + g)) * 128 * 128;
    const float* bg = C.sgu_b + (layer * 8 + g) * 128;
    unsigned char* myreg = lds + g * SG_WREG;
    f32x2v* stats = (f32x2v*)(lds + SG_STATS); f32x2v* mr = (f32x2v*)(lds + SG_MR);
    float* lnl = (float*)(lds + SG_LN + g * 512);
    lnl[lane] = lng[lane]; lnl[64 + lane] = lnb[lane];
    for (int u = C.bid; u < MROWS / 128; u += C.G) {
        const size_t row0 = (size_t)u * 128;
        asm volatile("" : "+v"(lane));
        v4u xv[2][8];
#pragma unroll
        for (int rr = 0; rr < 2; ++rr) {
            const v4u* vp = (const v4u*)(V + (row0 + lane + 64 * rr) * 512 + g * 64);
#pragma unroll
            for (int c = 0; c < 8; ++c) xv[rr][c] = vp[c];
        }
#pragma unroll
        for (int rr = 0; rr < 2; ++rr) {
            float s1 = 0.f, s2 = 0.f;
#pragma unroll
            for (int c = 0; c < 8; ++c) { v4u v = xv[rr][c];
                v.x = pk2v(gelu_pk(bfpair(v.x))); v.y = pk2v(gelu_pk(bfpair(v.y))); v.z = pk2v(gelu_pk(bfpair(v.z))); v.w = pk2v(gelu_pk(bfpair(v.w))); xv[rr][c] = v;
                const float f0 = bflo(v.x), f1 = bfhi(v.x), f2 = bflo(v.y), f3 = bfhi(v.y), f4 = bflo(v.z), f5 = bfhi(v.z), f6 = bflo(v.w), f7 = bfhi(v.w);
                s1 += ((f0 + f1) + (f2 + f3)) + ((f4 + f5) + (f6 + f7));
                s2 += ((f0 * f0 + f1 * f1) + (f2 * f2 + f3 * f3)) + ((f4 * f4 + f5 * f5) + (f6 * f6 + f7 * f7)); }
            stats[g * 128 + lane + 64 * rr] = (f32x2v){s1, s2};
        }
        bf16x8 wf[4][8];
        { const bf16* wa = Wg + (size_t)(lane & 31) * 128 + (lane >> 5) * 8;
#pragma unroll
          for (int tt = 0; tt < 4; ++tt)
#pragma unroll
              for (int ks = 0; ks < 8; ++ks) if (tt >= (ks >> 1)) wf[tt][ks] = *(const bf16x8*)(wa + (size_t)tt * 32 * 128 + ks * 16); }
        __syncthreads();
        if (C.tid < 128) {
            float s1 = 0.f, s2 = 0.f;
#pragma unroll
            for (int w = 0; w < 8; ++w) { const f32x2v t = stats[w * 128 + C.tid]; s1 += t.x; s2 += t.y; }
            const float mean = s1 * (1.0f / 512.0f), var = s2 * (1.0f / 512.0f) - mean * mean;
            mr[C.tid] = (f32x2v){mean, 1.0f / sqrtf(var + LN_EPS)};
        }
        __syncthreads();
#pragma unroll
        for (int c = 0; c < 8; ++c) asm volatile("" : "+v"(xv[0][c]), "+v"(xv[1][c]));
        { const f32x2v m0 = mr[lane], m1 = mr[lane + 64];
          unsigned short* vt = (unsigned short*)(myreg + lane * 2);
#pragma unroll
          for (int c = 0; c < 8; ++c) {
              const v4u v0 = xv[0][c], v1 = xv[1][c];
              const float f0[8] = {bflo(v0.x), bfhi(v0.x), bflo(v0.y), bfhi(v0.y), bflo(v0.z), bfhi(v0.z), bflo(v0.w), bfhi(v0.w)};
              const float f1[8] = {bflo(v1.x), bfhi(v1.x), bflo(v1.y), bfhi(v1.y), bflo(v1.z), bfhi(v1.z), bflo(v1.w), bfhi(v1.w)};
#pragma unroll
              for (int e = 0; e < 8; ++e) { const int d = 8 * c + e; const float gg = lnl[d], bbv = lnl[64 + d];
                  vt[d * (SG_VPITCH / 2)] = (unsigned short)f2bf((f0[e] - m0.x) * m0.y * gg + bbv);
                  vt[d * (SG_VPITCH / 2) + 64] = (unsigned short)f2bf((f1[e] - m1.x) * m1.y * gg + bbv); }
              asm volatile("" ::: "memory");
          } }
        LDS_WAIT(); asm volatile("" ::: "memory");
        { const int q = lane & 31, hi = lane >> 5;
          unsigned pk[2][4][8];
#pragma unroll
          for (int dt = 0; dt < 2; ++dt) {
              const unsigned char* bb = myreg + (32 * dt + q) * SG_VPITCH + hi * 16;
              f32x16 acc[4];
#pragma unroll
              for (int tt = 0; tt < 4; ++tt) acc[tt] = (f32x16){};
#pragma unroll
              for (int ks = 0; ks < 8; ++ks) {
                  const bf16x8 b0 = *(const bf16x8*)(bb + ks * 32);
#pragma unroll
                  for (int tt = 0; tt < 4; ++tt) if (tt >= (ks >> 1)) acc[tt] = __builtin_amdgcn_mfma_f32_32x32x16_bf16(wf[tt][ks], b0, acc[tt], 0, 0, 0);
              }
#pragma unroll
              for (int tt = 0; tt < 4; ++tt)
#pragma unroll
                  for (int rp = 0; rp < 8; ++rp) pk[dt][tt][rp] = cvtpk(acc[tt][2 * rp], acc[tt][2 * rp + 1]);
          }
          LDS_WAIT(); asm volatile("" ::: "memory");
          unsigned char* mxb = myreg + (4 * hi) * SG_MPITCH + q * 2;
#pragma unroll
          for (int dt = 0; dt < 2; ++dt)
#pragma unroll
              for (int tt = 0; tt < 4; ++tt)
#pragma unroll
                  for (int r = 0; r < 16; ++r)
                      *(unsigned short*)(mxb + (32 * tt + (r & 3) + 8 * (r >> 2)) * SG_MPITCH + 64 * dt) = (unsigned short)((r & 1) ? (pk[dt][tt][r >> 1] >> 16) : (pk[dt][tt][r >> 1] & 0xffffu));
        }
        LDS_WAIT(); asm volatile("" ::: "memory");
        { const int ch = lane & 7, r8 = lane >> 3;
#pragma unroll 4
          for (int it = 0; it < 16; ++it) {
              const int t = it * 8 + r8;
              const v4u mv = *(const v4u*)(myreg + t * SG_MPITCH + ch * 16);
              const v4u uv = *(const v4u*)(U + (row0 + t) * 512 + g * 64 + ch * 8), zv = *(const v4u*)(ZA + (row0 + t) * 512 + g * 64 + ch * 8);
              const float bt = bg[t];
              v4u o;
#define SGU_Y(uw, mw, zw) pk2v(gelu_silu_pk(bfpair(uw), bfpair(mw) + bt, bfpair(zw)))
              o.x = SGU_Y(uv.x, mv.x, zv.x); o.y = SGU_Y(uv.y, mv.y, zv.y); o.z = SGU_Y(uv.z, mv.z, zv.z); o.w = SGU_Y(uv.w, mv.w, zv.w);
#undef SGU_Y
              *(v4u*)(MIX + (row0 + t) * 1024 + g * 64 + ch * 8) = o;
          } }
        __syncthreads();
    }
}

__device__ __forceinline__ void phase_check_inject(const Ctx& C) {
    if (C.bid == 0 && C.tid == 0) C.out[0] = __uint_as_float(((const unsigned*)(C.ws + WS_CTL))[32]) * 1e6f;
}

#define GAS __attribute__((address_space(1)))
typedef GAS unsigned gu32;
#define RLX_AGENT __ATOMIC_RELAXED, __HIP_MEMORY_SCOPE_AGENT
constexpr int CW_BAR = 4096;
constexpr int LDS_BARST = LDS_BYTES - 64;
#define XB_TMO      128
#define XB_XCNT(j)  (256  + 64 * (j))
#define XB_XSUB(j)  (1280 + 64 * (j))
#define XB_XGEN(j)  (2304 + 64 * (j))
#define XB_TOP      3328
#define XB_TOPGEN   3392
#define XCD_BAR_WORDS 3456
#define XB_SPIN_CAP (1u << 18)

__device__ __forceinline__ unsigned xb_ld(unsigned* p)              { return __hip_atomic_load(p, __ATOMIC_RELAXED, __HIP_MEMORY_SCOPE_AGENT); }
__device__ __forceinline__ unsigned xb_add(unsigned* p, unsigned v) { return __hip_atomic_fetch_add(p, v, __ATOMIC_RELAXED, __HIP_MEMORY_SCOPE_AGENT); }
__device__ __forceinline__ unsigned xb_xcc_id() { return (unsigned)__builtin_amdgcn_s_getreg((3 << 11) | 20) & 0xFu; }
#define XB_SPIN(cond, bar) do { unsigned _sp = 0; while (cond) { __builtin_amdgcn_s_sleep(1); \
    if ((++_sp & 255u) == 0u) { if (xb_ld(&(bar)[XB_TMO])) break; if (_sp > XB_SPIN_CAP) { atomicAdd(&(bar)[XB_TMO], 1u); break; } } } } while (0)

struct XcdBarrier {
    unsigned* bar; unsigned x;
    volatile LAS unsigned* st;
};

__device__ __forceinline__ XcdBarrier xcd_barrier_post(unsigned* bar, volatile LAS unsigned* st) {
    XcdBarrier b; b.bar = bar; b.x = xb_xcc_id(); b.st = st;
    if (threadIdx.x == 0) (void)xb_add(&bar[XB_XCNT(b.x)], 1u);
    return b;
}
__device__ __forceinline__ void xcd_barrier_complete(unsigned* bar, unsigned x, unsigned& nloc, unsigned& nx) {
    const unsigned G = gridDim.x * gridDim.y * gridDim.z;
    unsigned sum, cnt, mine, sp = 0u;
    for (;;) {
        sum = 0u; cnt = 0u; mine = 0u;
#pragma unroll
        for (unsigned j = 0; j < 16; ++j) { const unsigned c = xb_ld(&bar[XB_XCNT(j)]); sum += c; cnt += (c > 0u) ? 1u : 0u; mine = (j == x) ? c : mine; }
        if (sum == G) break;
        __builtin_amdgcn_s_sleep(1);
        if ((++sp & 255u) == 0u) { if (xb_ld(&bar[XB_TMO])) break; if (sp > XB_SPIN_CAP) { atomicAdd(&bar[XB_TMO], 1u); break; } }
    }
    nloc = mine > 0u ? mine : 1u; nx = cnt > 0u ? cnt : 1u;
}

__device__ __forceinline__ void xcd_barrier(const XcdBarrier& b, const bool leader_thread) {
    asm volatile("s_waitcnt vmcnt(0)" ::: "memory");
    __syncthreads();
    if (leader_thread) {
        unsigned* bar = b.bar;
        __builtin_amdgcn_s_waitcnt(0);
        unsigned nloc = b.st[0], nx = b.st[1];
        if (nloc == 0u) { xcd_barrier_complete(bar, b.x, nloc, nx); b.st[0] = nloc; b.st[1] = nx; }
        const unsigned old = xb_add(&bar[XB_XSUB(b.x)], 1u);
        const unsigned gen = old / nloc;
        if (old + 1u == (gen + 1u) * nloc) {
            __builtin_amdgcn_fence(__ATOMIC_RELEASE, "agent");
            asm volatile("s_waitcnt vmcnt(0)" ::: "memory");
            const unsigned og = xb_add(&bar[XB_TOP], 1u);
            const unsigned tg = og / nx;
            if (og + 1u == (tg + 1u) * nx) xb_add(&bar[XB_TOPGEN], 1u);
            else XB_SPIN(xb_ld(&bar[XB_TOPGEN]) == tg, bar);
            __builtin_amdgcn_fence(__ATOMIC_ACQUIRE, "agent");
            xb_add(&bar[XB_XGEN(b.x)], 1u);
            asm volatile("s_waitcnt vmcnt(0)" ::: "memory");
        } else {
            XB_SPIN(xb_ld(&bar[XB_XGEN(b.x)]) == gen, bar);
            __builtin_amdgcn_fence(__ATOMIC_ACQUIRE, "agent");
            asm volatile("s_waitcnt vmcnt(0)" ::: "memory");
        }
    }
    __syncthreads();
}

template <int ST> __device__ __forceinline__ void run_stage(const Args& args, unsigned char* lds, int Lr, int wave_s) {
    const int L = Lr;
    Ctx C;
    { int t = wave_s * 64 + lane_now(); C.tid = t; }
    C.lds = lds; C.lane = C.tid & 63; C.wave = __builtin_amdgcn_readfirstlane(C.tid >> 6); C.G = gridDim.x; C.bid = blockIdx.x;
    C.x = args.in[0]; C.norm_g = args.in[1]; C.w_in = args.in[2]; C.ln_g = args.in[3]; C.ln_b = args.in[4]; C.sgu_w = args.in[5]; C.sgu_b = args.in[6];
    C.w_out = args.in[7]; C.rel_bias = args.in[8]; C.final_g = args.in[9]; C.out = args.out; C.ws = args.ws;
    asm volatile("" : "+s"(C.ws), "+s"(C.out), "+s"(C.x), "+s"(C.sgu_b), "+s"(C.ln_g), "+s"(C.ln_b));
    if constexpr (ST == 0) phase_prologue(C);
    else if constexpr (ST == 1) {
        float* rtab = (float*)(lds + RING_BYTES);
        const float* rowss = (const float*)(C.ws + WS_ROWSS);
        float* kmean = (float*)(C.ws + WS_KMEAN) + (size_t)L * NBH * NBLK * 64;
#define RTAB_BUILD(S_) do { pmA = -1; pmB = -1; pmC = -1; pmD = -1; \
          { pg8::Unit uu; for (int i = 0; S_.next(i, uu); ++i) { const int pmu = uu.pm; \
              if (pmu == pmA || pmu == pmB || pmu == pmC || pmu == pmD) continue; \
              if (pmA < 0) pmA = pmu; else if (pmB < 0) pmB = pmu; else if (pmC < 0) pmC = pmu; else if (pmD < 0) pmD = pmu; } } \
          _Pragma("unroll") for (int k = 0; k < 2; ++k) { const int e = C.tid + 512 * k, sl = e >> 8, pmk = sl == 0 ? pmA : sl == 1 ? pmB : sl == 2 ? pmC : pmD; \
              if (pmk >= 0) { const f32x4* rp = (const f32x4*)(rowss + ((size_t)pmk * 256 + (e & 255)) * 16); const f32x4 s0 = rp[0], s1 = rp[1], s2 = rp[2], s3 = rp[3]; \
                  const float ss = ((s0[0] + s0[1]) + (s0[2] + s0[3])) + ((s1[0] + s1[1]) + (s1[2] + s1[3])) + ((s2[0] + s2[1]) + (s2[2] + s2[3])) + ((s3[0] + s3[1]) + (s3[2] + s3[3])); \
                  rtab[e] = 1.0f / sqrtf(ss * (1.0f / 1024.0f) + NORM_EPS); } } \
          __syncthreads(); } while (0)
        int pmA, pmB, pmC, pmD;
        pg8::Gemm g1{(const pg8::bf16_t*)(C.ws + WS_XB), (const pg8::bf16_t*)(C.ws + WS_WIN) + (size_t)L * DIN * DM, MROWS, 2048, DM};
        pg8::Gemm g2{(const pg8::bf16_t*)(C.ws + WS_XB8), (const pg8::bf16_t*)(C.ws + WS_WIN8 + (size_t)L * 1536 * 2 * DM), MROWS, 1536, DM, DM / 2};
        pg8::StaticOrder S1; S1.init(MROWS, 2048, C.G, C.bid);
        pg8::StaticOrder S2; S2.init(MROWS, 1536, C.G, C.bid);
        RTAB_BUILD(S1);
        pg8::EpiProj E1{(pg8::bf16_t*)(C.ws + WS_PROJ), SUBSTRIDE, rtab, pmA, pmB, pmC, pmD, kmean, 0, 6, 1.0f};
        rtab += 1024;
        RTAB_BUILD(S2);
        pg8::EpiProj E2{(pg8::bf16_t*)(C.ws + WS_PROJ), SUBSTRIDE, rtab, pmA, pmB, pmC, pmD, kmean, 6, 2, 1.0f / 32.0f};
        pg8::Unit f2; const bool has2 = S2.next(0, f2);
        pg8::Unit f1; const bool has1 = S1.next(0, f1);
        if (has1 && has2) {
            const size_t tstep2 = (size_t)2 * pg8::HALF * DM * 2;
            pg8::gemm_phase<pg8::EpiProj, pg8::StaticOrder, true, true, false, false, true>((PG8_LAS unsigned char*)lds, g1, S1, E1, C.tid, (const char*)g2.A + (size_t)f2.pm * tstep2, (const char*)g2.Bt + (size_t)f2.pn * tstep2);
            C.tid = wave_s * 64 + lane_now();
            pg8::gemm_phase<pg8::EpiProj, pg8::StaticOrder, true, true, true, true, false>((PG8_LAS unsigned char*)lds, g2, S2, E2, C.tid);
        }
#undef RTAB_BUILD
    }
    else if constexpr (ST == 3) { phase_gate(C, L); phase_sgu(C, L); }
    else if constexpr (ST == 4) phase_attn(C, L);
    else if constexpr (ST == 5) phase_combine(C);
    else if constexpr (ST == 6) {
        pg8::Gemm g{(const pg8::bf16_t*)(C.ws + WS_MIX), (const pg8::bf16_t*)(C.ws + WS_WOUT) + (size_t)L * DM * DM, MROWS, DM, DM};
        pg8::StaticOrder S; S.init(MROWS, DM, C.G, C.bid);
        if (L == 0) { pg8::EpiRes E{(pg8::bf16_t*)(C.ws + WS_XB), (float*)(C.ws + WS_ROWSS), C.ws + WS_XB8};
            pg8::gemm_phase<pg8::EpiRes, pg8::StaticOrder, true, true>((PG8_LAS unsigned char*)lds, g, S, E, C.tid); }
        else { pg8::EpiFinal E{(const pg8::bf16_t*)(C.ws + WS_XB), C.out, C.final_g, (float*)(C.ws + WS_ROWSS), (unsigned*)(C.ws + WS_CTL) + 8192};
            pg8::gemm_phase<pg8::EpiFinal, pg8::StaticOrder, true, true>((PG8_LAS unsigned char*)lds, g, S, E, C.tid); }
    } else if constexpr (ST == 7) phase_check_inject(C);
    else if constexpr (ST == 8) phase_attn_simple(C, (bf16*)C.out);
    else if constexpr (ST == 9) {
        const bf16* A = (const bf16*)(C.ws + WS_MIX); const bf16* B = (const bf16*)C.out; unsigned* flag = (unsigned*)(C.ws + WS_CTL) + 32;
        float md = 0.f;
        for (size_t idx = (size_t)C.bid * 512 + C.tid; idx < (size_t)MROWS * 512; idx += (size_t)C.G * 512) {
            const size_t row = idx >> 9, col = 512 + (idx & 511);
            const float a = __uint_as_float((unsigned)A[row * 1024 + col] << 16), r = __uint_as_float((unsigned)B[row * 1024 + col] << 16);
            float sc = fabsf(r);
#pragma unroll
            for (int o = 1; o < 64; o <<= 1) sc = fmaxf(sc, lx_xor(sc, o));
            const float d = fabsf(a - r) / (0.02f + sc);
            md = (d > md || !(d == d)) ? (d == d ? d : 1e6f) : md;
        }
        atomicMax(flag, __float_as_uint(md));
    }
}
template <int SEL> __global__ void __launch_bounds__(NWAVES * 64, 2) fwd(Args args) {
    extern __shared__ __attribute__((aligned(16))) unsigned char lds[];
    const int wave_s = __builtin_amdgcn_readfirstlane((int)threadIdx.x >> 6);
    if constexpr (SEL >= 0) run_stage<SEL>(args, lds, args.layer, wave_s);
    else {
        if (args.pad == 0x7fffffff) cg::this_grid().sync();
        volatile LAS unsigned* bst = (volatile LAS unsigned*)((LAS unsigned char*)lds + LDS_BARST);
        if (threadIdx.x == 0) { bst[0] = 0u; bst[1] = 0u; }
        __syncthreads();
        XcdBarrier bar = xcd_barrier_post((unsigned*)(args.ws + WS_CTL) + CW_BAR, bst);
#define GRID_SYNC() do { XcdBarrier b2_ = bar; asm volatile("" : "+s"(b2_.bar), "+s"(b2_.x)); xcd_barrier(b2_, wave_s == 0 && lane_now() == 0); } while (0)
#define RUN(k, L) do { run_stage<k>(args, lds, L, wave_s); GRID_SYNC(); } while (0)
        RUN(0, 0);
        for (int L = 0; L < DEPTH; ++L) {
            RUN(1, L); RUN(3, L); RUN(4, L); RUN(5, L);
            if (L == DEPTH - 1) run_stage<6>(args, lds, L, wave_s); else RUN(6, L);
        }
    }
}

#ifndef MK_N_LAUNCHES
#define MK_N_LAUNCHES 1
#endif
template <int SEL> static void launch_stage(int grid, Args a, int layer, hipStream_t stream) {
    static bool attr = false;
    if (!attr) { (void)hipFuncSetAttribute((const void*)fwd<SEL>, hipFuncAttributeMaxDynamicSharedMemorySize, LDS_BYTES); attr = true; }
    a.layer = layer;
    hipLaunchKernelGGL(fwd<SEL>, dim3(grid), dim3(NWAVES * 64), LDS_BYTES, stream, a);
}
extern "C" void kernel_launch(void* const* d_in, const int* in_sizes, int n_in, void* d_out, int out_size, void* d_ws, size_t ws_size, hipStream_t stream) {
    static int grid = 0;
    if (grid == 0) {
        if (n_in != 10 || out_size != MROWS * DM || ws_size < WS_END) { fprintf(stderr, "kernel_launch: unexpected shapes (n_in %d out %d ws %zu)\n", n_in, out_size, ws_size); grid = -1; return; }
        int dev = 0, cus = 0;
        (void)hipGetDevice(&dev); (void)hipDeviceGetAttribute(&cus, hipDeviceAttributeMultiprocessorCount, dev);
        grid = cus;
        if (grid != 256) fprintf(stderr, "kernel_launch: %d CUs: the fused final-norm epilogue pairs the four column tiles of a row panel inside one round of a 256-workgroup grid\n", grid);
#if MK_N_LAUNCHES == 1
        int per_cu = 0;
        if (hipFuncSetAttribute((const void*)fwd<-1>, hipFuncAttributeMaxDynamicSharedMemorySize, LDS_BYTES) != hipSuccess) { fprintf(stderr, "kernel_launch: hipFuncSetAttribute failed\n"); grid = -1; return; }
        if (hipOccupancyMaxActiveBlocksPerMultiprocessor(&per_cu, (const void*)fwd<-1>, NWAVES * 64, LDS_BYTES) != hipSuccess || per_cu < 1) { fprintf(stderr, "kernel_launch: occupancy query says %d\n", per_cu); grid = -1; return; }
        (void)hipGetLastError();
#endif
    }
    if (grid < 0) return;
    (void)hipMemsetAsync((char*)d_ws + WS_CTL, 0, CTL_ZERO_BYTES, stream);
    Args a{};
    for (int i = 0; i < 10; ++i) a.in[i] = (const float*)d_in[i];
    a.out = (float*)d_out; a.ws = (unsigned char*)d_ws;
#if MK_N_LAUNCHES == 1
    void* kargs[] = {&a};
    hipError_t e = hipLaunchCooperativeKernel((const void*)fwd<-1>, dim3(grid), dim3(NWAVES * 64), kargs, LDS_BYTES, stream);
    if (e != hipSuccess) fprintf(stderr, "kernel_launch: cooperative launch failed: %s\n", hipGetErrorString(e));
#else
    launch_stage<0>(grid, a, 0, stream);
    for (int L = 0; L < DEPTH; ++L) {
        launch_stage<1>(grid, a, L, stream); launch_stage<3>(grid, a, L, stream);
        launch_stage<4>(grid, a, L, stream); launch_stage<5>(grid, a, L, stream);
        if (CHECK_ATTN && L == 0) { launch_stage<8>(grid, a, L, stream); launch_stage<9>(grid, a, L, stream); }
        launch_stage<6>(grid, a, L, stream);
    }
    if (CHECK_ATTN) launch_stage<7>(grid, a, 0, stream);
#endif
}
```
